# Optimizing an MI355X kernel written in HIP

```python
import jax, jax.numpy as jnp
from jax import lax
import numpy as np

D_MODEL = 2048
BATCH = 4
SEQ = 2048
DEPTH = 2

GRID_W = 64
CTX_LEN = 256
EPS = 1e-6
ROPE_BASE = 10000.0
Q_BLOCK = 128

ML_HEADS = 4
ML_HEAD_DIM = 256
ML_WIDTH = ML_HEADS * ML_HEAD_DIM
ML_CHUNK = 64
ML_GATES = 2 * 2 * ML_HEADS
ML_FORGET_BIAS = 3.0

LA_HEADS = 8
LA_NOPE = 128
LA_ROPE = 64
LA_VDIM = 128
LA_Q_RANK = 512
LA_KV_RANK = 256
LA_WIDTH = LA_HEADS * LA_VDIM

GA_HEADS = 8
GA_KV_HEADS = 2
GA_HEAD_DIM = 128
GA_WIDTH = GA_HEADS * GA_HEAD_DIM
GA_KV_WIDTH = GA_KV_HEADS * GA_HEAD_DIM

N_BRANCH = 3

N_EXPERTS = 16
EXPERT_FF = 1024
CAPACITY_FACTOR = 2

PROJ_LAYOUT = (('ml_q', ML_WIDTH), ('ml_k', ML_WIDTH), ('ml_v', ML_WIDTH), ('ml_o', ML_WIDTH), ('ml_g', ML_GATES),
               ('la_cq', LA_Q_RANK), ('la_ckv', LA_KV_RANK), ('la_kr', LA_ROPE),
               ('ga_q', GA_WIDTH), ('ga_k', GA_KV_WIDTH), ('ga_v', GA_KV_WIDTH),
               ('gate', N_BRANCH * D_MODEL))
PROJ_WIDTH = (4 * ML_WIDTH + ML_GATES + LA_Q_RANK + LA_KV_RANK + LA_ROPE
              + GA_WIDTH + 2 * GA_KV_WIDTH + N_BRANCH * D_MODEL)

kernel_name = 'hybrid_mlstm_mla_gqa_ecmoe_dit'


def rms_norm(x, gain=None):
    xf = x.astype(jnp.float32)
    y = xf * lax.rsqrt(jnp.mean(xf * xf, axis=-1, keepdims=True) + EPS)
    if gain is not None:
        y = y * gain.astype(jnp.float32)
    return y.astype(x.dtype)


def modulate(x, shift, scale):
    return rms_norm(x) * (1 + scale) + shift


def to_heads(t, n):
    b, n_tok, w = t.shape
    return t.reshape(b, n_tok, n, w // n).transpose(0, 2, 1, 3)


def merge_heads(t):
    b, n, n_tok, d = t.shape
    return t.transpose(0, 2, 1, 3).reshape(b, n_tok, n * d)


def split_columns(p):
    out = {}
    off = 0
    for name, size in PROJ_LAYOUT:
        out[name] = p[..., off:off + size]
        off += size
    return out


def axial_rope_tables(n_tok, dim):
    rows = n_tok // GRID_W
    quarter = dim // 4
    inv = ROPE_BASE ** (-jnp.arange(quarter, dtype=jnp.float32) / quarter)
    row = jnp.broadcast_to(jnp.arange(rows, dtype=jnp.float32)[:, None], (rows, GRID_W)).reshape(-1)
    col = jnp.broadcast_to(jnp.arange(GRID_W, dtype=jnp.float32)[None, :], (rows, GRID_W)).reshape(-1)
    ang = jnp.concatenate([row[:, None] * inv[None, :], col[:, None] * inv[None, :]], axis=-1)
    return jnp.cos(ang), jnp.sin(ang)


def apply_axial_rope(x, cos, sin):
    q4 = x.shape[-1] // 4
    xr = x.astype(jnp.float32).reshape(*x.shape[:-1], 2, 2, q4)
    a, b = xr[..., 0, :], xr[..., 1, :]
    c = cos.reshape(-1, 2, q4)
    s = sin.reshape(-1, 2, q4)
    out = jnp.stack([a * c - b * s, a * s + b * c], axis=-2)
    return out.reshape(x.shape).astype(x.dtype)


def block_attention(q, k, v):
    b, kh, g, n_tok, dk = q.shape
    nb = n_tok // Q_BLOCK
    qb = jnp.moveaxis(q.reshape(b, kh, g, nb, Q_BLOCK, dk), 3, 0)

    def one_block(q_blk):
        s = jnp.einsum('bkgqd,bktd->bkgqt', q_blk, k).astype(jnp.float32)
        p = jax.nn.softmax(s, axis=-1).astype(v.dtype)
        return jnp.einsum('bkgqt,bktd->bkgqd', p, v)

    o = lax.map(one_block, qb)
    return jnp.moveaxis(o, 0, 3).reshape(b, kh, g, n_tok, -1)


def grouped_attention(q, k, v):
    b, h, n_tok, dk = q.shape
    kh = k.shape[1]
    qg = (q * dk ** -0.5).reshape(b, kh, h // kh, n_tok, dk)
    o = block_attention(qg, k, v)
    return merge_heads(o.reshape(b, h, n_tok, -1))


def mlstm_chunkwise(q, k, v, i_pre, f_pre, state):
    b, h, n_tok, dk = q.shape
    nc = n_tok // ML_CHUNK
    q = q * dk ** -0.5
    log_f = jax.nn.log_sigmoid(f_pre)
    log_i = i_pre

    def to_chunks(a):
        return jnp.moveaxis(a.reshape(b, h, nc, ML_CHUNK, *a.shape[3:]), 2, 0)

    tri = jnp.tril(jnp.ones((ML_CHUNK, ML_CHUNK), dtype=bool))

    def step(carry, inp):
        c_mat, n_vec, m = carry
        qc, kc, vc, li, lf = inp
        cum = jnp.cumsum(lf, axis=-1)
        dmat = jnp.where(tri, cum[..., :, None] - cum[..., None, :] + li[..., None, :], -jnp.inf)
        inter = cum + m[..., None]
        m_row = jnp.maximum(inter, jnp.max(dmat, axis=-1))
        w = jnp.exp(dmat - m_row[..., None])
        s = jnp.einsum('bhld,bhsd->bhls', qc, kc) * w
        w_inter = jnp.exp(inter - m_row)
        num = jnp.einsum('bhls,bhse->bhle', s, vc) + w_inter[..., None] * jnp.einsum('bhed,bhld->bhle', c_mat, qc)
        den = jnp.sum(s, axis=-1) + w_inter * jnp.einsum('bhd,bhld->bhl', n_vec, qc)
        h_out = num / jnp.maximum(jnp.abs(den), jnp.exp(-m_row))[..., None]
        g = cum[..., -1:] - cum + li
        m_new = jnp.maximum(cum[..., -1] + m, jnp.max(g, axis=-1))
        wk = jnp.exp(g - m_new[..., None])
        decay = jnp.exp(cum[..., -1] + m - m_new)
        c_new = decay[..., None, None] * c_mat + jnp.einsum('bhse,bhsd->bhed', wk[..., None] * vc, kc)
        n_new = decay[..., None] * n_vec + jnp.einsum('bhs,bhsd->bhd', wk, kc)
        return (c_new, n_new, m_new), h_out

    state, hs = lax.scan(step, state, tuple(to_chunks(a) for a in (q, k, v, log_i, log_f)))
    return jnp.moveaxis(hs, 0, 2).reshape(b, h, n_tok, -1), state


def mlstm_branch(p_ctx, p_lat, gate_bias, norm_gain):
    def prep(p):
        bsz, n_tok, _ = p['ml_q'].shape
        q = to_heads(p['ml_q'], ML_HEADS).astype(jnp.float32)
        k = to_heads(p['ml_k'], ML_HEADS).astype(jnp.float32)
        v = to_heads(p['ml_v'], ML_HEADS).astype(jnp.float32)
        g = (p['ml_g'] + gate_bias).astype(jnp.float32).reshape(bsz, n_tok, 2, 2, ML_HEADS)
        return q, k, v, jnp.transpose(g, (2, 3, 0, 4, 1))

    q_c, k_c, v_c, g_c = prep(p_ctx)
    q_l, k_l, v_l, g_l = prep(p_lat)
    bsz = q_c.shape[0]
    h_c = jnp.zeros_like(v_c)
    h_l = jnp.zeros_like(v_l)
    for d in range(2):
        rev = (lambda t: jnp.flip(t, axis=2)) if d == 1 else (lambda t: t)
        state0 = (jnp.zeros((bsz, ML_HEADS, ML_HEAD_DIM, ML_HEAD_DIM), jnp.float32),
                  jnp.zeros((bsz, ML_HEADS, ML_HEAD_DIM), jnp.float32),
                  jnp.zeros((bsz, ML_HEADS), jnp.float32))
        o_c, state_c = mlstm_chunkwise(rev(q_c), rev(k_c), rev(v_c), rev(g_c[d, 0]), rev(g_c[d, 1]), state0)
        o_l, _ = mlstm_chunkwise(rev(q_l), rev(k_l), rev(v_l), rev(g_l[d, 0]), rev(g_l[d, 1]), state_c)
        h_c = h_c + rev(o_c)
        h_l = h_l + rev(o_l)

    def finish(h, p):
        h = rms_norm(h, norm_gain.reshape(ML_HEADS, 1, ML_HEAD_DIM))
        return (merge_heads(h) * jax.nn.sigmoid(p['ml_o'].astype(jnp.float32))).astype(p['ml_o'].dtype)

    return finish(h_c, p_ctx), finish(h_l, p_lat)


def mla_q(p, q_gain, w_uq, rope):
    q = to_heads(rms_norm(p['la_cq'], q_gain) @ w_uq, LA_HEADS)
    if rope is not None:
        q = jnp.concatenate([q[..., :LA_NOPE], apply_axial_rope(q[..., LA_NOPE:], *rope)], axis=-1)
    return q


def mla_kv(p, kv_gain, w_ukv, rope):
    kv = to_heads(rms_norm(p['la_ckv'], kv_gain) @ w_ukv, LA_HEADS)
    k_nope, v = kv[..., :LA_NOPE], kv[..., LA_NOPE:]
    k_rope = p['la_kr'][:, None]
    if rope is not None:
        k_rope = apply_axial_rope(k_rope, *rope)
    k = jnp.concatenate([k_nope, jnp.broadcast_to(k_rope, k_nope.shape[:-1] + (LA_ROPE,))], axis=-1)
    return k, v


def gqa_q(p, gain, rope):
    q = rms_norm(to_heads(p['ga_q'], GA_HEADS), gain)
    return q if rope is None else apply_axial_rope(q, *rope)


def gqa_kv(p, gain, rope):
    k = rms_norm(to_heads(p['ga_k'], GA_KV_HEADS), gain)
    if rope is not None:
        k = apply_axial_rope(k, *rope)
    return k, to_heads(p['ga_v'], GA_KV_HEADS)


def merge_branches(gate_pre, y_ml, y_la, y_ga, w_br_ml, w_br_la, w_br_ga, w_out):
    g = jax.nn.sigmoid(gate_pre.astype(jnp.float32)).astype(y_la.dtype)
    g = g.reshape(*g.shape[:-1], N_BRANCH, D_MODEL)
    merged = (g[..., 0, :] * (y_ml @ w_br_ml) + g[..., 1, :] * (y_la @ w_br_la)
              + g[..., 2, :] * (y_ga @ w_br_ga))
    return merged @ w_out


def token_mixer(h_lat, h_ctx, w_in, ml_gate_bias, ml_norm, la_q_norm, la_kv_norm, la_w_uq, la_w_ukv,
                ga_q_norm, ga_k_norm, w_br_ml, w_br_la, w_br_ga, w_out, rope_la, rope_ga, need_ctx):
    p_lat = split_columns(h_lat @ w_in)
    p_ctx = split_columns(h_ctx @ w_in)
    y_ml_c, y_ml_l = mlstm_branch(p_ctx, p_lat, ml_gate_bias, ml_norm)
    kla_c, vla_c = mla_kv(p_ctx, la_kv_norm, la_w_ukv, None)
    kla_l, vla_l = mla_kv(p_lat, la_kv_norm, la_w_ukv, rope_la)
    y_la_l = grouped_attention(mla_q(p_lat, la_q_norm, la_w_uq, rope_la),
                               jnp.concatenate([kla_c, kla_l], axis=2), jnp.concatenate([vla_c, vla_l], axis=2))
    kga_c, vga_c = gqa_kv(p_ctx, ga_k_norm, None)
    kga_l, vga_l = gqa_kv(p_lat, ga_k_norm, rope_ga)
    y_ga_l = grouped_attention(gqa_q(p_lat, ga_q_norm, rope_ga),
                               jnp.concatenate([kga_c, kga_l], axis=2), jnp.concatenate([vga_c, vga_l], axis=2))
    y_lat = merge_branches(p_lat['gate'], y_ml_l, y_la_l, y_ga_l, w_br_ml, w_br_la, w_br_ga, w_out)
    if not need_ctx:
        return y_lat, None
    y_la_c = grouped_attention(mla_q(p_ctx, la_q_norm, la_w_uq, None), kla_c, vla_c)
    y_ga_c = grouped_attention(gqa_q(p_ctx, ga_q_norm, None), kga_c, vga_c)
    y_ctx = merge_branches(p_ctx['gate'], y_ml_c, y_la_c, y_ga_c, w_br_ml, w_br_la, w_br_ga, w_out)
    return y_lat, y_ctx


def expert_choice_ffn(h, w_router, w_e1, w_e3, w_e2):
    n_tok, d = h.shape[1], h.shape[2]
    cap = CAPACITY_FACTOR * n_tok // N_EXPERTS
    aff = jax.nn.softmax((h @ w_router).astype(jnp.float32), axis=-1)
    vals, idx = lax.top_k(jnp.swapaxes(aff, 1, 2), cap)
    xg = jax.vmap(lambda hb, ib: hb[ib])(h, idx)
    a = jnp.einsum('becd,edf->becf', xg, w_e1)
    u = jnp.einsum('becd,edf->becf', xg, w_e3)
    y = jnp.einsum('becf,efd->becd', jax.nn.silu(a) * u, w_e2) * vals[..., None].astype(h.dtype)
    return jax.vmap(lambda ib, yb: jnp.zeros((n_tok, d), h.dtype).at[ib].add(yb))(idx, y)


def setup_inputs(seed: int = 0) -> dict:
    key = jax.random.key(seed)
    ks = jax.random.split(key, 28)
    f32 = jnp.float32

    def nrm(k, shape, fan_in, s=1.0):
        return jax.random.normal(k, shape, f32) * (s * fan_in ** -0.5)

    def gain(k, shape):
        return 1.0 + 0.05 * jax.random.normal(k, shape, f32)

    gate_base = jnp.array([0.0, ML_FORGET_BIAS], f32)[None, None, :, None]
    ml_gate_bias = (gate_base + 0.1 * jax.random.normal(ks[7], (DEPTH, 2, 2, ML_HEADS), f32)).reshape(DEPTH, ML_GATES)
    return {
        'x': jax.random.normal(ks[0], (BATCH, SEQ, D_MODEL), f32),
        'c': jax.random.normal(ks[1], (BATCH, D_MODEL), f32),
        'ctx': jax.random.normal(ks[2], (BATCH, CTX_LEN, D_MODEL), f32),
        'c_ctx': jax.random.normal(ks[3], (D_MODEL,), f32),
        'w_mod': nrm(ks[4], (DEPTH, D_MODEL, 6 * D_MODEL), D_MODEL, 0.5),
        'b_mod': 0.02 * jax.random.normal(ks[5], (DEPTH, 6 * D_MODEL), f32),
        'w_in': nrm(ks[6], (DEPTH, D_MODEL, PROJ_WIDTH), D_MODEL),
        'ml_gate_bias': ml_gate_bias,
        'ml_norm': gain(ks[8], (DEPTH, ML_WIDTH)),
        'la_q_norm': gain(ks[9], (DEPTH, LA_Q_RANK)),
        'la_kv_norm': gain(ks[10], (DEPTH, LA_KV_RANK)),
        'la_w_uq': nrm(ks[11], (DEPTH, LA_Q_RANK, LA_HEADS * (LA_NOPE + LA_ROPE)), LA_Q_RANK),
        'la_w_ukv': nrm(ks[12], (DEPTH, LA_KV_RANK, LA_HEADS * (LA_NOPE + LA_VDIM)), LA_KV_RANK),
        'ga_q_norm': gain(ks[13], (DEPTH, GA_HEAD_DIM)),
        'ga_k_norm': gain(ks[14], (DEPTH, GA_HEAD_DIM)),
        'w_br_ml': nrm(ks[15], (DEPTH, ML_WIDTH, D_MODEL), ML_WIDTH),
        'w_br_la': nrm(ks[16], (DEPTH, LA_WIDTH, D_MODEL), LA_WIDTH),
        'w_br_ga': nrm(ks[17], (DEPTH, GA_WIDTH, D_MODEL), GA_WIDTH),
        'w_out': nrm(ks[18], (DEPTH, D_MODEL, D_MODEL), D_MODEL),
        'w_router': nrm(ks[19], (DEPTH, D_MODEL, N_EXPERTS), D_MODEL),
        'w_e1': nrm(ks[20], (DEPTH, N_EXPERTS, D_MODEL, EXPERT_FF), D_MODEL),
        'w_e3': nrm(ks[21], (DEPTH, N_EXPERTS, D_MODEL, EXPERT_FF), D_MODEL),
        'w_e2': nrm(ks[22], (DEPTH, N_EXPERTS, EXPERT_FF, D_MODEL), EXPERT_FF),
        'final_norm': gain(ks[23], (D_MODEL,)),
    }


def reference(x, c, ctx, c_ctx, w_mod, b_mod, w_in, ml_gate_bias, ml_norm, la_q_norm, la_kv_norm, la_w_uq,
              la_w_ukv, ga_q_norm, ga_k_norm, w_br_ml, w_br_la, w_br_ga, w_out, w_router, w_e1, w_e3, w_e2,
              final_norm):
    n_lat = x.shape[1]
    rope_la = axial_rope_tables(n_lat, LA_ROPE)
    rope_ga = axial_rope_tables(n_lat, GA_HEAD_DIM)
    x_lat, x_ctx = x, ctx
    for l in range(DEPTH):
        need_ctx = l < DEPTH - 1
        mods_l = (jax.nn.silu(c) @ w_mod[l] + b_mod[l])[:, None, :]
        mods_c = jax.nn.silu(c_ctx) @ w_mod[l] + b_mod[l]
        sh1_l, sc1_l, g1_l, sh2_l, sc2_l, g2_l = jnp.split(mods_l, 6, axis=-1)
        sh1_c, sc1_c, g1_c, sh2_c, sc2_c, g2_c = jnp.split(mods_c, 6, axis=-1)
        y_lat, y_ctx = token_mixer(modulate(x_lat, sh1_l, sc1_l), modulate(x_ctx, sh1_c, sc1_c), w_in[l],
                                   ml_gate_bias[l], ml_norm[l], la_q_norm[l], la_kv_norm[l], la_w_uq[l],
                                   la_w_ukv[l], ga_q_norm[l], ga_k_norm[l], w_br_ml[l], w_br_la[l], w_br_ga[l],
                                   w_out[l], rope_la, rope_ga, need_ctx)
        x_lat = x_lat + g1_l * y_lat
        x_lat = x_lat + g2_l * expert_choice_ffn(modulate(x_lat, sh2_l, sc2_l), w_router[l], w_e1[l], w_e3[l], w_e2[l])
        if need_ctx:
            x_ctx = x_ctx + g1_c * y_ctx
            x_ctx = x_ctx + g2_c * expert_choice_ffn(modulate(x_ctx, sh2_c, sc2_c), w_router[l], w_e1[l], w_e3[l], w_e2[l])
    return rms_norm(x_lat, final_norm)
```

```cpp
#include <hip/hip_runtime.h>
#include <cstdio>
#include <cstdint>

#define GAS __attribute__((address_space(1)))
#define LAS __attribute__((address_space(3)))
#define DI __device__ __forceinline__
typedef unsigned short bf16_t;
typedef short bf16x8 __attribute__((ext_vector_type(8)));
typedef short s16x4 __attribute__((ext_vector_type(4)));
typedef float f32x2 __attribute__((ext_vector_type(2)));
typedef float f32x4 __attribute__((ext_vector_type(4)));
typedef float f32x8 __attribute__((ext_vector_type(8)));
typedef float f32x16 __attribute__((ext_vector_type(16)));
typedef unsigned u32x2 __attribute__((ext_vector_type(2)));
typedef unsigned u32x4 __attribute__((ext_vector_type(4)));

constexpr int DM = 2048, NBATCH = 4, SEQ = 2048, CTXL = 256, DEPTH = 2;
constexpr int MLAT = NBATCH * SEQ, MCTX = NBATCH * CTXL, MTOT = MLAT + MCTX;
constexpr int PROJW = 12624, NP = 12800;
constexpr int C_MLQ = 0, C_MLK = 1024, C_MLV = 2048, C_MLO = 3072, C_CQ = 4096, C_CKV = 4608, C_GQ = 4864, C_GK = 5888, C_GV = 6144, C_GATE = 6400, C_X = 12544;
constexpr int XW = 80;
constexpr int NEXP = 16, EFF = 1024, ESLOT = 1280;
constexpr float EPS = 1e-6f;
constexpr int NWAVES = 8, NTHR = 512;

constexpr size_t al256(size_t x) { return (x + 255) / 256 * 256; }
constexpr size_t WS_CTL = 0, CTL_BYTES = 2u << 20;
constexpr int CW_BAR = 1024;
constexpr int CW_QUEUE = 8192;
constexpr size_t WS_MODS = 1u << 20;
constexpr size_t WS_ROPE_LA = WS_CTL + CTL_BYTES;
constexpr size_t WS_ROPE_GA = WS_ROPE_LA + al256((size_t)2048 * 32 * 2 * 4);
constexpr size_t WS_W = WS_ROPE_GA + al256((size_t)2048 * 64 * 2 * 4);
constexpr size_t W_IN = 0, W_UQ = W_IN + (size_t)NP * DM * 2, W_UKV = W_UQ + (size_t)1536 * 512 * 2, W_BR = W_UKV + (size_t)2048 * 256 * 2,
                 W_OUT = W_BR + (size_t)3 * 2048 * 1024 * 2, W_E13 = W_OUT + (size_t)2048 * 2048 * 2, W_E2 = W_E13 + (size_t)NEXP * 2048 * 2048 * 2,
                 W_LAYER = W_E2 + (size_t)NEXP * 2048 * 1024 * 2;
constexpr size_t WS_H = WS_W + 2 * W_LAYER;
constexpr size_t WS_P = WS_H + (size_t)MTOT * DM * 2;
constexpr size_t WS_AG = WS_P;
constexpr size_t WS_ACT = WS_AG + (size_t)NEXP * ESLOT * DM * 2;
static_assert(WS_ACT + (size_t)NEXP * ESLOT * EFF * 2 <= WS_P + (size_t)MTOT * NP * 2, "overlay");
constexpr size_t WS_X80 = WS_P + (size_t)MTOT * NP * 2;
constexpr size_t WS_CQN = WS_X80 + al256((size_t)MTOT * XW * 4);
constexpr size_t WS_CKVN = WS_CQN + (size_t)MTOT * 512 * 2;
constexpr size_t WS_QG = WS_CKVN + (size_t)MTOT * 256 * 2;
constexpr size_t WS_KG = WS_QG + (size_t)MTOT * 1024 * 2;
constexpr size_t WS_KR = WS_KG + (size_t)MTOT * 256 * 2;
constexpr size_t WS_QLA = WS_KR + (size_t)MTOT * 64 * 2;
constexpr size_t WS_KVLA = WS_QLA + (size_t)MTOT * 1536 * 2;
constexpr size_t WS_YCAT = WS_KVLA + (size_t)MTOT * 2048 * 2;
constexpr size_t WS_MF32 = WS_YCAT + (size_t)MTOT * 3072 * 2;
constexpr size_t WS_MLH = WS_MF32;
constexpr size_t WS_MBF = WS_MF32 + (size_t)MTOT * DM * 4;
constexpr size_t WS_X1 = WS_MBF + (size_t)MTOT * DM * 2;
constexpr size_t WS_AFF = WS_X1 + (size_t)MTOT * DM * 4;
constexpr size_t WS_ROWS = WS_AFF + (size_t)MTOT * 16 * 4;
constexpr size_t WS_VALS = WS_ROWS + (size_t)NEXP * ESLOT * 4;
constexpr size_t WS_TOK = WS_VALS + (size_t)NEXP * ESLOT * 4;
constexpr size_t WS_MPART = WS_TOK + (size_t)MTOT * 16 * 4;
constexpr size_t WS_END = WS_MPART + (size_t)16 * 2 * 5 * 12288 * 4;
constexpr size_t WS_YE = WS_AG;

constexpr int RING_BYTES = 131072;
constexpr int MISC_OFF = RING_BYTES + 1024;
constexpr int LDS_BYTES = 147456;

DI float bf2f(unsigned short b) { return __uint_as_float(((unsigned)b) << 16); }
DI unsigned f2bf(float f) { unsigned u = __float_as_uint(f); return (u + 0x7fffu + ((u >> 16) & 1u)) >> 16; }
DI unsigned pk2(float lo, float hi) { unsigned r; asm volatile("v_cvt_pk_bf16_f32 %0, %1, %2" : "=v"(r) : "v"(lo), "v"(hi)); return r; }
DI float wave_sum(float v) {
#pragma unroll
    for (int o = 1; o < 64; o <<= 1) v += __shfl_xor(v, o);
    return v;
}
DI float wave_max(float v) {
#pragma unroll
    for (int o = 1; o < 64; o <<= 1) v = fmaxf(v, __shfl_xor(v, o));
    return v;
}
DI float sigmoidf_(float x) { return 1.f / (1.f + __expf(-x)); }
DI float siluf_(float x) { return x / (1.f + __expf(-x)); }
#define LDS_WAIT() asm volatile("s_waitcnt lgkmcnt(0)" ::: "memory")
#define VM_WAIT() asm volatile("s_waitcnt vmcnt(0)" ::: "memory")

#define XB_TMO      128
#define XB_XCNT(j)  (256  + 64 * (j))
#define XB_XSUB(j)  (1280 + 64 * (j))
#define XB_XGEN(j)  (2304 + 64 * (j))
#define XB_TOP      3328
#define XB_TOPGEN   3392
#define XCD_BAR_WORDS 3456
#define XB_SPIN_CAP (1u << 20)

DI unsigned xb_ld(unsigned* p)              { return __hip_atomic_load(p, __ATOMIC_RELAXED, __HIP_MEMORY_SCOPE_AGENT); }
DI unsigned xb_add(unsigned* p, unsigned v) { return __hip_atomic_fetch_add(p, v, __ATOMIC_RELAXED, __HIP_MEMORY_SCOPE_AGENT); }
DI unsigned xb_xcc_id() { return (unsigned)__builtin_amdgcn_s_getreg((3 << 11) | 20) & 0xFu; }
#define XB_SPIN(cond, bar) do { unsigned _sp = 0; while (cond) { __builtin_amdgcn_s_sleep(1); \
    if ((++_sp & 255u) == 0u) { if (xb_ld(&(bar)[XB_TMO])) break; if (_sp > XB_SPIN_CAP) { atomicAdd(&(bar)[XB_TMO], 1u); break; } } } } while (0)

struct XcdBarrier { unsigned* bar; unsigned x; volatile LAS unsigned* st; };

DI XcdBarrier xcd_barrier_post(unsigned* bar, volatile LAS unsigned* st) {
    XcdBarrier b; b.bar = bar; b.x = xb_xcc_id(); b.st = st;
    if (threadIdx.x == 0) (void)xb_add(&bar[XB_XCNT(b.x)], 1u);
    return b;
}
DI void xcd_barrier_complete(unsigned* bar, unsigned x, unsigned& nloc, unsigned& nx) {
    const unsigned G = gridDim.x * gridDim.y * gridDim.z;
    unsigned sum, cnt, mine, sp = 0u;
    for (;;) {
        sum = 0u; cnt = 0u; mine = 0u;
#pragma unroll
        for (unsigned j = 0; j < 16; ++j) { const unsigned c = xb_ld(&bar[XB_XCNT(j)]); sum += c; cnt += (c > 0u) ? 1u : 0u; mine = (j == x) ? c : mine; }
        if (sum == G) break;
        __builtin_amdgcn_s_sleep(1);
        if ((++sp & 255u) == 0u) { if (xb_ld(&bar[XB_TMO])) break; if (sp > XB_SPIN_CAP) { atomicAdd(&bar[XB_TMO], 1u); break; } }
    }
    nloc = mine > 0u ? mine : 1u; nx = cnt > 0u ? cnt : 1u;
}
DI void xcd_barrier(const XcdBarrier& b) {
    asm volatile("s_waitcnt vmcnt(0)" ::: "memory");
    __syncthreads();
    if (threadIdx.x == 0) {
        unsigned* bar = b.bar; asm volatile("" : "+s"(bar));
        __builtin_amdgcn_s_waitcnt(0);
        unsigned nloc = b.st[0], nx = b.st[1];
        unsigned bx = b.x; asm volatile("" : "+s"(bx));
        if (nloc == 0u) { xcd_barrier_complete(bar, bx, nloc, nx); b.st[0] = nloc; b.st[1] = nx; }
        const unsigned old = xb_add(&bar[XB_XSUB(bx)], 1u);
        const unsigned gen = old / nloc;
        if (old + 1u == (gen + 1u) * nloc) {
            __builtin_amdgcn_fence(__ATOMIC_RELEASE, "agent");
            asm volatile("s_waitcnt vmcnt(0)" ::: "memory");
            const unsigned og = xb_add(&bar[XB_TOP], 1u);
            const unsigned tg = og / nx;
            if (og + 1u == (tg + 1u) * nx) xb_add(&bar[XB_TOPGEN], 1u);
            else XB_SPIN(xb_ld(&bar[XB_TOPGEN]) == tg, bar);
            __builtin_amdgcn_fence(__ATOMIC_ACQUIRE, "agent");
            xb_add(&bar[XB_XGEN(bx)], 1u);
            asm volatile("s_waitcnt vmcnt(0)" ::: "memory");
        } else {
            XB_SPIN(xb_ld(&bar[XB_XGEN(bx)]) == gen, bar);
            __builtin_amdgcn_fence(__ATOMIC_ACQUIRE, "agent");
            asm volatile("s_waitcnt vmcnt(0)" ::: "memory");
        }
    }
    __syncthreads();
}

struct Args { const float* in[24]; float* out; unsigned char* ws; int ph_lo, ph_hi; };
enum { I_X = 0, I_C, I_CTX, I_CCTX, I_WMOD, I_BMOD, I_WIN, I_GBIAS, I_MLNORM, I_LAQN, I_LAKVN, I_UQ, I_UKV, I_GAQN, I_GAKN, I_BRML, I_BRLA, I_BRGA, I_WOUT, I_WROUTER, I_WE1, I_WE3, I_WE2, I_FNORM };

struct Frame {
    LAS unsigned char* lds;
    unsigned char* ws;
    int tid, lane, wave, G, vcu, gw, ngw;
};

DI int mods_row(int row) { return row < MLAT ? (row >> 11) : 4; }
DI const float* mods_ptr(const Frame& F, int l, int row, int which  ) {
    return (const float*)(F.ws + WS_MODS) + ((size_t)(l * 5 + mods_row(row)) * 6 + which) * DM;
}

namespace pg8 {
constexpr int BM = 256, BK = 64, HALF = 128, HTB = HALF * BK * 2, STAGE_BYTES = 8 * HTB, NXCD = 8, WGM = 8;
__host__ __device__ __forceinline__ int lds_byte(int r, int c) { const int st = (r >> 4) * 2 + (c >> 5), rr = r & 15, cc = c & 31, ob = rr * 64 + cc * 2; return st * 1024 + (ob ^ (((ob >> 9) & 1) << 5)); }
__host__ __device__ __forceinline__ void stage_rc(int b, int& R, int& C) { const int st = b / 1024, sb = b % 1024, swz = sb ^ (((sb >> 9) & 1) << 5); R = (st >> 1) * 16 + swz / 64; C = (st & 1) * 32 + (swz % 64) / 2; }
__host__ __device__ __forceinline__ int perm32(int rho) { const int n = rho >> 4, i = rho & 15; return 8 * (i >> 2) + 4 * n + (i & 3); }

struct Unit { const char* pa; const char* pb; int pm, pn, aux, nt; };

DI void tile_of(int L, int nM, int nN, int& pm, int& pn) {
    const int nwg = nM * nN; int wgid = L;
    { const int q = nwg / NXCD, r = nwg % NXCD, xcd = wgid % NXCD, off = wgid / NXCD; wgid = (xcd < r ? xcd * (q + 1) : r * (q + 1) + (xcd - r) * q) + off; }
    const int nig = WGM * nN, gid = wgid / nig, fm = gid * WGM, gsz = (nM - fm) < WGM ? (nM - fm) : WGM;
    pm = fm + ((wgid % nig) % gsz); pn = (wgid % nig) / gsz;
}

template <class Epi, class Sched>
DI void gemm_phase(LAS unsigned char* lds, const int lda  , const int ldb  , const Sched& S, const Epi& E) {
    int tid = threadIdx.x; asm volatile("" : "+v"(tid));
    const int wid = __builtin_amdgcn_readfirstlane(tid >> 6), lane = tid & 63, wr = wid >> 2, wc = wid & 3, fr = lane & 15, fq = lane >> 4;
    unsigned voffA[2], voffB[2];
#pragma unroll
    for (int i = 0; i < 2; ++i) { int R, C; stage_rc(tid * 16 + i * 8192, R, C); const int Rb = (R & ~31) + perm32(R & 31);
        voffA[i] = (unsigned)(R * lda + C * 2); voffB[i] = (unsigned)(Rb * ldb + C * 2); }
    const size_t kstep = (size_t)(BK * 2);
    const size_t hstepA = (size_t)HALF * lda, hstepB = (size_t)HALF * ldb;
    const unsigned ldsw = (unsigned)wid * 1024u;
    const int aoff = lds_byte(wr * 64 + fr, fq * 8), boff = lds_byte(wc * 32 + fr, fq * 8);
#define PG8_SA(b, h) (((b) * 2 + (h)) * HTB)
#define PG8_SB(b, h) ((4 + (b) * 2 + (h)) * HTB)
#define PG8_STAGE(bufoff, gbase, voff) do { _Pragma("unroll") for (int _i = 0; _i < 2; ++_i) \
        __builtin_amdgcn_global_load_lds((const unsigned*)((const char*)(gbase) + (voff)[_i]), (LAS unsigned*)(lds + (bufoff) + ldsw + _i * 8192), 16, 0, 0); } while (0)
#define PG8_LDA(dst, b, h) do { _Pragma("unroll") for (int m = 0; m < 4; ++m) _Pragma("unroll") for (int k = 0; k < 2; ++k) dst[m][k] = *(const LAS bf16x8*)(lds + PG8_SA(b, h) + aoff + m * 2048 + k * 1024); } while (0)
#define PG8_LDB(dst, b, h) do { _Pragma("unroll") for (int n = 0; n < 2; ++n) _Pragma("unroll") for (int k = 0; k < 2; ++k) dst[n][k] = *(const LAS bf16x8*)(lds + PG8_SB(b, h) + boff + n * 2048 + k * 1024); } while (0)
#define PG8_MMA(ai, bj, At, Bt) do { __builtin_amdgcn_s_setprio(1); _Pragma("unroll") for (int m = 0; m < 4; ++m) _Pragma("unroll") for (int n = 0; n < 2; ++n) _Pragma("unroll") for (int k = 0; k < 2; ++k) \
        acc[ai][bj][m][n] = __builtin_amdgcn_mfma_f32_16x16x32_bf16(Bt[n][k], At[m][k], acc[ai][bj][m][n], 0, 0, 0); __builtin_amdgcn_s_setprio(0); } while (0)
#define PG8_WAIT_V(n) asm volatile("s_waitcnt vmcnt(" #n ")" ::: "memory")
#define PG8_WAIT_L(n) asm volatile("s_waitcnt lgkmcnt(" #n ")" ::: "memory")
#define PG8_BAR __builtin_amdgcn_s_barrier()
#define PG8_SCHED __builtin_amdgcn_sched_barrier(0)
    Unit cur, nxt; int ui = 0;
    if (!S.next(0, cur)) return;
    f32x4 acc[2][2][4][2];
#pragma unroll
    for (int a = 0; a < 2; ++a)
#pragma unroll
        for (int b = 0; b < 2; ++b)
#pragma unroll
            for (int m = 0; m < 4; ++m)
#pragma unroll
                for (int n = 0; n < 2; ++n) acc[a][b][m][n] = (f32x4){0.f, 0.f, 0.f, 0.f};
    bf16x8 At[4][2], B0[2][2], B1[2][2];
    const char* cA = cur.pa; const char* cB = cur.pb;
    PG8_STAGE(PG8_SB(0, 0), cB, voffB); PG8_STAGE(PG8_SA(0, 0), cA, voffA); PG8_STAGE(PG8_SB(0, 1), cB + hstepB, voffB); PG8_STAGE(PG8_SA(0, 1), cA + hstepA, voffA);
    if (wr == 1) PG8_BAR;
    PG8_WAIT_V(4); PG8_BAR;
    PG8_STAGE(PG8_SB(1, 0), cB + kstep, voffB); PG8_STAGE(PG8_SA(1, 0), cA + kstep, voffA); PG8_STAGE(PG8_SB(1, 1), cB + hstepB + kstep, voffB);
    PG8_WAIT_V(6); PG8_BAR;
    for (;;) {
        const bool has_next = S.next(ui + 1, nxt);
        const char* nA = has_next ? nxt.pa : cA; const char* nB = has_next ? nxt.pb : cB;
        const int nt = cur.nt;
        for (int t = 0; t < nt; t += 2) {
            const bool last = (t == nt - 2);
            const char* a1 = cA + (size_t)(t + 1) * kstep;
            const char* a2 = last ? nA : cA + (size_t)(t + 2) * kstep; const char* b2 = last ? nB : cB + (size_t)(t + 2) * kstep;
            const char* a3 = a2 + kstep; const char* b3 = b2 + kstep;
            PG8_LDB(B0, 0, 0); PG8_SCHED; PG8_LDA(At, 0, 0); PG8_STAGE(PG8_SA(1, 1), a1 + hstepA, voffA);
            PG8_WAIT_L(8); PG8_BAR; PG8_WAIT_L(0); PG8_MMA(0, 0, At, B0); PG8_BAR; PG8_SCHED;
            PG8_LDB(B1, 0, 1); PG8_STAGE(PG8_SB(0, 0), b2, voffB);
            PG8_BAR; PG8_WAIT_L(0); PG8_MMA(0, 1, At, B1); PG8_BAR;
            PG8_LDA(At, 0, 1); PG8_STAGE(PG8_SA(0, 0), a2, voffA);
            PG8_BAR; PG8_WAIT_L(0); PG8_MMA(1, 0, At, B0); PG8_BAR; PG8_SCHED;
            PG8_STAGE(PG8_SB(0, 1), b2 + hstepB, voffB);
            PG8_WAIT_V(6); PG8_BAR; PG8_MMA(1, 1, At, B1); PG8_BAR;
            PG8_LDB(B0, 1, 0); PG8_SCHED; PG8_LDA(At, 1, 0); PG8_STAGE(PG8_SA(0, 1), a2 + hstepA, voffA);
            PG8_WAIT_L(8); PG8_BAR; PG8_WAIT_L(0); PG8_MMA(0, 0, At, B0); PG8_BAR; PG8_SCHED;
            PG8_LDB(B1, 1, 1); PG8_STAGE(PG8_SB(1, 0), b3, voffB);
            PG8_BAR; PG8_WAIT_L(0); PG8_MMA(0, 1, At, B1); PG8_BAR;
            PG8_LDA(At, 1, 1); PG8_STAGE(PG8_SA(1, 0), a3, voffA);
            PG8_BAR; PG8_WAIT_L(0); PG8_MMA(1, 0, At, B0); PG8_BAR; PG8_SCHED;
            PG8_STAGE(PG8_SB(1, 1), b3 + hstepB, voffB);
            PG8_WAIT_V(6); PG8_BAR; PG8_MMA(1, 1, At, B1); PG8_BAR;
        }
        E(acc, cur, wr, wc, fr, fq);
        if (!has_next) break;
#pragma unroll
        for (int a = 0; a < 2; ++a)
#pragma unroll
            for (int b = 0; b < 2; ++b)
#pragma unroll
                for (int m = 0; m < 4; ++m)
#pragma unroll
                    for (int n = 0; n < 2; ++n) acc[a][b][m][n] = (f32x4){0.f, 0.f, 0.f, 0.f};
        cur = nxt; cA = nA; cB = nB; ++ui;
    }
    PG8_WAIT_V(0);
    if (wr == 0) PG8_BAR;
    PG8_BAR;
#undef PG8_SA
#undef PG8_SB
#undef PG8_STAGE
#undef PG8_LDA
#undef PG8_LDB
#undef PG8_MMA
#undef PG8_WAIT_V
#undef PG8_WAIT_L
#undef PG8_BAR
#undef PG8_SCHED
}
}
using pg8::Unit;

struct SchedDense {
    const char* A; const char* Bt; int lda, ldb, nM, nN, nt, G, c;
    DI bool next(int i, Unit& u) const {
        const long L = (long)i * G + c; if (L >= (long)nM * nN) return false;
        int pm, pn; pg8::tile_of((int)L, nM, nN, pm, pn);
        u.pm = pm; u.pn = pn; u.aux = 0; u.nt = nt; u.pa = A + (size_t)pm * 256 * lda; u.pb = Bt + (size_t)pn * 256 * ldb; return true;
    }
};

struct SchedProj {
    const char* A; const char* Bt; int l, G, c;
    DI bool next(int i, Unit& u) const {
        const long L = (long)i * G + c; int pm, pn;
        if (l == 0) { if (L >= 36 * 50) return false; pg8::tile_of((int)L, 36, 50, pm, pn); }
        else { if (L >= 32 * 50 + 48) return false;
            if (L < 32 * 50) pg8::tile_of((int)L, 32, 50, pm, pn);
            else { const int r = (int)L - 32 * 50, j = r % 12; pm = 32 + r / 12; pn = j < 8 ? 4 + j : (j == 8 ? 18 : (j == 9 ? 23 : (j == 10 ? 24 : 49))); } }
        u.pm = pm; u.pn = pn; u.aux = 0; u.nt = 32; u.pa = A + (size_t)pm * 256 * (DM * 2); u.pb = Bt + (size_t)pn * 256 * (DM * 2); return true;
    }
};

#define EPI_FOREACH(...) \
    _Pragma("unroll") for (int ai = 0; ai < 2; ++ai) _Pragma("unroll") for (int m = 0; m < 4; ++m) { const int row = u.pm * 256 + ai * 128 + wr * 64 + m * 16 + fr; \
    _Pragma("unroll") for (int bj = 0; bj < 2; ++bj) { const int col = u.pn * 256 + bj * 128 + wc * 32 + 8 * fq; const f32x4 v0 = acc[ai][bj][m][0], v1 = acc[ai][bj][m][1]; __VA_ARGS__ } }

DI u32x4 pack8(const f32x4 v0, const f32x4 v1) { u32x4 w; w.x = pk2(v0[0], v0[1]); w.y = pk2(v0[2], v0[3]); w.z = pk2(v1[0], v1[1]); w.w = pk2(v1[2], v1[3]); return w; }

struct EpiStoreBf16 {
    bf16_t* O; int ldc;
    DI void operator()(const f32x4 (&acc)[2][2][4][2], const Unit& u, int wr, int wc, int fr, int fq) const {
        EPI_FOREACH({ *(u32x4*)(O + (size_t)row * ldc + col) = pack8(v0, v1); })
    }
};
struct EpiProj {
    bf16_t* P; float* X80;
    DI void operator()(const f32x4 (&acc)[2][2][4][2], const Unit& u, int wr, int wc, int fr, int fq) const {
        if (u.pn < 49) { EPI_FOREACH({ *(u32x4*)(P + (size_t)row * NP + col) = pack8(v0, v1); }) }
        else {
            EPI_FOREACH({ const int c = col - C_X; if (bj == 0 && c < XW) { *(f32x4*)(X80 + (size_t)row * XW + c) = v0; *(f32x4*)(X80 + (size_t)row * XW + c + 4) = v1; } })
        }
    }
};

DI int win_src_col(int n) {
    if (n < 4096) return n;
    if (n < 4608) return n - 4096 + 4112;
    if (n < 4864) return n - 4608 + 4624;
    if (n < 5888) return n - 4864 + 4944;
    if (n < 6144) return n - 5888 + 5968;
    if (n < 6400) return n - 6144 + 6224;
    if (n < 12544) return n - 6400 + 6480;
    if (n < 12608) return n - 12544 + 4880;
    if (n < 12624) return n - 12608 + 4096;
    return -1;
}
DI void transpose_item(const float* W, int ldw, int K, bf16_t* WT, int k0, int n0, int srcc, LAS float* scr, int lane) {
#pragma unroll 8
    for (int i = 0; i < 32; ++i) { const int kk = 2 * i + (lane >> 5); scr[kk * 33 + (lane & 31)] = srcc >= 0 ? W[(size_t)(k0 + kk) * ldw + srcc] : 0.f; }
    LDS_WAIT(); asm volatile("" ::: "memory");
    const int c = lane & 7;
#pragma unroll
    for (int j = 0; j < 4; ++j) { const int n = (lane >> 3) + 8 * j; const LAS float* s = scr + (8 * c) * 33 + n;
        u32x4 o; o.x = pk2(s[0 * 33], s[1 * 33]); o.y = pk2(s[2 * 33], s[3 * 33]); o.z = pk2(s[4 * 33], s[5 * 33]); o.w = pk2(s[6 * 33], s[7 * 33]);
        *(u32x4*)(WT + (size_t)(n0 + n) * K + k0 + 8 * c) = o; }
    LDS_WAIT(); asm volatile("" ::: "memory");
}

constexpr int IT_IN = 32 * 400, IT_UQ = 8 * 48, IT_UKV = 4 * 64, IT_BR = 16 * 64, IT_OUT = 32 * 64, IT_E13 = 32 * 64, IT_E2 = 16 * 64;
constexpr int IT_EARLY = IT_IN + IT_UQ + IT_UKV, IT_LAYER = IT_EARLY + 3 * IT_BR + IT_OUT + NEXP * IT_E13 + NEXP * IT_E2;
DI void convert_item(const Frame& F, const Args& a, int l, int r, LAS float* scr) {
    unsigned char* wl = F.ws + WS_W + (size_t)l * W_LAYER;
    const int ln = F.lane & 31;
    if (r < IT_IN) { const int kb = r / 400, nb = r % 400; transpose_item(a.in[I_WIN] + (size_t)l * DM * PROJW, PROJW, DM, (bf16_t*)(wl + W_IN), 64 * kb, 32 * nb, win_src_col(32 * nb + ln), scr, F.lane); return; } r -= IT_IN;
    if (r < IT_UQ) { const int kb = r / 48, nb = r % 48; transpose_item(a.in[I_UQ] + (size_t)l * 512 * 1536, 1536, 512, (bf16_t*)(wl + W_UQ), 64 * kb, 32 * nb, 32 * nb + ln, scr, F.lane); return; } r -= IT_UQ;
    if (r < IT_UKV) { const int kb = r / 64, nb = r % 64; transpose_item(a.in[I_UKV] + (size_t)l * 256 * 2048, 2048, 256, (bf16_t*)(wl + W_UKV), 64 * kb, 32 * nb, 32 * nb + ln, scr, F.lane); return; } r -= IT_UKV;
    if (r < 3 * IT_BR) { const int br = r / IT_BR, q = r % IT_BR, kb = q / 64, nb = q % 64;
        transpose_item(a.in[I_BRML + br] + (size_t)l * 1024 * 2048, 2048, 1024, (bf16_t*)(wl + W_BR) + (size_t)br * 2048 * 1024, 64 * kb, 32 * nb, 32 * nb + ln, scr, F.lane); return; } r -= 3 * IT_BR;
    if (r < IT_OUT) { const int kb = r / 64, nb = r % 64; transpose_item(a.in[I_WOUT] + (size_t)l * 2048 * 2048, 2048, 2048, (bf16_t*)(wl + W_OUT), 64 * kb, 32 * nb, 32 * nb + ln, scr, F.lane); return; } r -= IT_OUT;
    if (r < NEXP * IT_E13) { const int e = r / IT_E13, q = r % IT_E13, kb = q / 64, nb = q % 64;
        const int n0 = 32 * nb, j = n0 >> 8, half = (n0 >> 7) & 1, cc = n0 & 127;
        transpose_item(a.in[half ? I_WE3 : I_WE1] + ((size_t)l * NEXP + e) * 2048 * 1024, 1024, 2048, (bf16_t*)(wl + W_E13) + (size_t)e * 2048 * 2048, 64 * kb, n0, j * 128 + cc + ln, scr, F.lane); return; } r -= NEXP * IT_E13;
    { const int e = r / IT_E2, q = r % IT_E2, kb = q / 64, nb = q % 64;
        transpose_item(a.in[I_WE2] + ((size_t)l * NEXP + e) * 1024 * 2048, 2048, 1024, (bf16_t*)(wl + W_E2) + (size_t)e * 2048 * 1024, 64 * kb, 32 * nb, 32 * nb + ln, scr, F.lane); }
}

DI void phase_prologue(const Frame& F, const Args& a, int rep) {
    LAS float* scr = (LAS float*)(F.lds + F.wave * 16384);
    if (rep == 0) {
        const float* c = a.in[I_C]; const float* cctx = a.in[I_CCTX]; const float* wmod = a.in[I_WMOD];
        constexpr int NIT = 2 * 48 * 16;
        for (int it = F.gw; it < NIT; it += F.ngw) {
            const int l = it / 768, rem = it % 768, cb = rem / 16, kp = rem % 16, k0 = kp * 128, j0 = cb * 256 + F.lane * 4;
#pragma unroll
            for (int i = 0; i < 10; ++i) { const int idx = F.lane + 64 * i, r = idx >> 7, kk = idx & 127; const float v = r < 4 ? c[r * DM + k0 + kk] : cctx[k0 + kk]; scr[idx] = siluf_(v); }
            LDS_WAIT(); asm volatile("" ::: "memory");
            f32x4 acc[5];
#pragma unroll
            for (int r = 0; r < 5; ++r) acc[r] = (f32x4){0.f, 0.f, 0.f, 0.f};
            const float* wp = wmod + ((size_t)l * DM + k0) * (6 * DM) + j0;
#pragma unroll 4
            for (int kk = 0; kk < 128; ++kk) { const f32x4 w = *(const f32x4*)(wp + (size_t)kk * (6 * DM));
#pragma unroll
                for (int r = 0; r < 5; ++r) acc[r] += w * scr[r * 128 + kk]; }
#pragma unroll
            for (int r = 0; r < 5; ++r) *(f32x4*)((float*)(F.ws + WS_MPART) + ((size_t)(kp * 2 + l) * 5 + r) * (6 * DM) + j0) = acc[r];
            LDS_WAIT(); asm volatile("" ::: "memory");
        }
    }
    {
        float* rla = (float*)(F.ws + WS_ROPE_LA); float* rga = (float*)(F.ws + WS_ROPE_GA);
        const int gt = F.gw * 64 + F.lane, ngt = F.ngw * 64;
        for (int i = gt; i < 2048 * 32; i += ngt) { const int t = i >> 5, aidx = i & 31, ax = aidx >> 4, fi = aidx & 15;
            const float inv = exp2f(-(float)fi * (13.287712379549449f / 16.f)); const float ang = (float)(ax ? (t & 63) : (t >> 6)) * inv;
            rla[2 * i] = cosf(ang); rla[2 * i + 1] = sinf(ang); }
        for (int i = gt; i < 2048 * 64; i += ngt) { const int t = i >> 6, aidx = i & 63, ax = aidx >> 5, fi = aidx & 31;
            const float inv = exp2f(-(float)fi * (13.287712379549449f / 32.f)); const float ang = (float)(ax ? (t & 63) : (t >> 6)) * inv;
            rga[2 * i] = cosf(ang); rga[2 * i + 1] = sinf(ang); }
    }
    for (int it = F.gw; it < IT_EARLY; it += F.ngw) convert_item(F, a, 0, it, scr);
}

DI void phase_mods_reduce(const Frame& F, const Args& a) {
    float* mods = (float*)(F.ws + WS_MODS); const float* part = (const float*)(F.ws + WS_MPART); const float* bmod = a.in[I_BMOD];
    const int gt = F.gw * 64 + F.lane, ngt = F.ngw * 64;
    for (int i = gt; i < 2 * 5 * 12288 / 4; i += ngt) { const int l = i / (5 * 3072), j4 = i % 3072;
        f32x4 s = *(const f32x4*)(bmod + (size_t)l * 12288 + 4 * j4);
#pragma unroll
        for (int kp = 0; kp < 16; ++kp) s += *(const f32x4*)(part + (size_t)kp * (2 * 5 * 12288) + 4 * (size_t)i);
        *(f32x4*)(mods + 4 * (size_t)i) = s; }
}

DI const float* resid_row(const Frame& F, const Args& a, int l, int row) {
    if (l == 0) return row < MLAT ? a.in[I_X] + (size_t)row * DM : a.in[I_CTX] + (size_t)(row - MLAT) * DM;
    return (const float*)(F.ws + WS_X1) + (size_t)row * DM;
}
DI void combine_row(const Frame& F, int lp, int row, f32x4 (&v)[8]) {
    const float* X1 = (const float*)(F.ws + WS_X1) + (size_t)row * DM; const int* tok = (const int*)(F.ws + WS_TOK) + (size_t)row * 16; const bf16_t* YE = (const bf16_t*)(F.ws + WS_YE);
    f32x4 s[8];
#pragma unroll
    for (int j = 0; j < 8; ++j) { v[j] = *(const f32x4*)(X1 + 4 * F.lane + 256 * j); s[j] = (f32x4){0.f, 0.f, 0.f, 0.f}; }
    for (int e = 0; e < NEXP; ++e) { const int slot = __builtin_amdgcn_readfirstlane(tok[e]);
        if (slot >= 0) { const bf16_t* yr = YE + ((size_t)e * ESLOT + slot) * DM;
#pragma unroll
            for (int j = 0; j < 8; ++j) { const s16x4 y = *(const s16x4*)(yr + 4 * F.lane + 256 * j);
                s[j] += (f32x4){bf2f((unsigned short)y[0]), bf2f((unsigned short)y[1]), bf2f((unsigned short)y[2]), bf2f((unsigned short)y[3])}; } } }
    const float* g2 = mods_ptr(F, lp, row, 5);
#pragma unroll
    for (int j = 0; j < 8; ++j) v[j] += s[j] * *(const f32x4*)(g2 + 4 * F.lane + 256 * j);
}
DI void modulate_vals(const Frame& F, const f32x4 (&v)[8], const float* sh, const float* sc, bf16_t* hrow, f32x4 (&hv)[8]) {
    float ss = 0.f;
#pragma unroll
    for (int j = 0; j < 8; ++j) ss += v[j].x * v[j].x + v[j].y * v[j].y + v[j].z * v[j].z + v[j].w * v[j].w;
    const float rs = rsqrtf(wave_sum(ss) * (1.f / DM) + EPS);
#pragma unroll
    for (int j = 0; j < 8; ++j) { const f32x4 s1 = *(const f32x4*)(sc + 4 * F.lane + 256 * j), s0 = *(const f32x4*)(sh + 4 * F.lane + 256 * j);
        const f32x4 h = v[j] * rs * (s1 + 1.f) + s0; hv[j] = h;
        u32x2 w; w.x = pk2(h.x, h.y); w.y = pk2(h.z, h.w); *(u32x2*)(hrow + 4 * F.lane + 256 * j) = w; }
}
DI void phase_mod1(const Frame& F, const Args& a, int l) {
    bf16_t* H = (bf16_t*)(F.ws + WS_H);
    for (int row = F.gw; row < MTOT; row += F.ngw) { f32x4 v[8], hv[8];
        if (l == 0) { const float* xr = resid_row(F, a, 0, row);
#pragma unroll
            for (int j = 0; j < 8; ++j) v[j] = *(const f32x4*)(xr + 4 * F.lane + 256 * j); }
        else { combine_row(F, l - 1, row, v); float* xw = (float*)(F.ws + WS_X1) + (size_t)row * DM;
#pragma unroll
            for (int j = 0; j < 8; ++j) *(f32x4*)(xw + 4 * F.lane + 256 * j) = v[j]; }
        modulate_vals(F, v, mods_ptr(F, l, row, 0), mods_ptr(F, l, row, 1), H + (size_t)row * DM, hv); }
}
DI void phase_mod2(const Frame& F, const Args& a, int l, int nrows) {
    bf16_t* H = (bf16_t*)(F.ws + WS_H); float* AFF = (float*)(F.ws + WS_AFF);
    LAS float* wr = (LAS float*)F.lds;
    const float* wsrc = a.in[I_WROUTER] + (size_t)l * DM * NEXP;
    for (int i = F.tid; i < DM * NEXP / 4; i += NTHR) ((LAS f32x4*)wr)[i] = ((const f32x4*)wsrc)[i];
    __syncthreads();
    for (int row = F.gw; row < nrows; row += F.ngw) { f32x4 hv[8];
        { f32x4 v[8]; const float* xr = (const float*)(F.ws + WS_X1) + (size_t)row * DM;
#pragma unroll
          for (int j = 0; j < 8; ++j) v[j] = *(const f32x4*)(xr + 4 * F.lane + 256 * j);
          modulate_vals(F, v, mods_ptr(F, l, row, 3), mods_ptr(F, l, row, 4), H + (size_t)row * DM, hv); }
        float lg[16];
#pragma unroll
        for (int e = 0; e < 16; ++e) lg[e] = 0.f;
#pragma unroll
        for (int j = 0; j < 8; ++j)
#pragma unroll
            for (int i = 0; i < 4; ++i) { const int c = 4 * F.lane + 256 * j + i; const float h = hv[j][i];
#pragma unroll
                for (int q = 0; q < 4; ++q) { const f32x4 w = *(const LAS f32x4*)(wr + c * 16 + 4 * q); lg[4 * q] += h * w.x; lg[4 * q + 1] += h * w.y; lg[4 * q + 2] += h * w.z; lg[4 * q + 3] += h * w.w; } }
        float mx = -1e30f;
#pragma unroll
        for (int e = 0; e < 16; ++e) { lg[e] = wave_sum(lg[e]); mx = fmaxf(mx, lg[e]); }
        float den = 0.f;
#pragma unroll
        for (int e = 0; e < 16; ++e) { lg[e] = __expf(lg[e] - mx); den += lg[e]; }
        const float inv = 1.f / den;
        float mine = 0.f;
#pragma unroll
        for (int e = 0; e < 16; ++e) mine = (F.lane == e) ? lg[e] * inv : mine;
        if (F.lane < 16) AFF[(size_t)row * 16 + F.lane] = mine;
    }
    __syncthreads();
}

DI void phase_postproj(const Frame& F, const Args& a, int l) {
    const bf16_t* P = (const bf16_t*)(F.ws + WS_P); const float* X80 = (const float*)(F.ws + WS_X80);
    bf16_t* CQN = (bf16_t*)(F.ws + WS_CQN); bf16_t* CKVN = (bf16_t*)(F.ws + WS_CKVN); bf16_t* QG = (bf16_t*)(F.ws + WS_QG); bf16_t* KG = (bf16_t*)(F.ws + WS_KG); bf16_t* KR = (bf16_t*)(F.ws + WS_KR);
    const float* qn = a.in[I_LAQN] + l * 512; const float* kvn = a.in[I_LAKVN] + l * 256; const float* gqn = a.in[I_GAQN] + l * 128; const float* gkn = a.in[I_GAKN] + l * 128;
    const float* rla = (const float*)(F.ws + WS_ROPE_LA); const float* rga = (const float*)(F.ws + WS_ROPE_GA);
    const int lane = F.lane;
    for (int row = F.gw; row < MTOT; row += F.ngw) {
        const bf16_t* pr = P + (size_t)row * NP; const bool lat = row < MLAT; const int t = row & 2047; const bool needq = lat || l == 0;
        if (needq) {
            const bf16x8 x = *(const bf16x8*)(pr + C_CQ + 8 * lane); float f[8]; float ss = 0.f;
#pragma unroll
            for (int i = 0; i < 8; ++i) { f[i] = bf2f((unsigned short)x[i]); ss += f[i] * f[i]; }
            const float rs = rsqrtf(wave_sum(ss) * (1.f / 512.f) + EPS);
            const f32x4 g0 = *(const f32x4*)(qn + 8 * lane), g1 = *(const f32x4*)(qn + 8 * lane + 4);
            u32x4 w; w.x = pk2(f[0] * rs * g0.x, f[1] * rs * g0.y); w.y = pk2(f[2] * rs * g0.z, f[3] * rs * g0.w); w.z = pk2(f[4] * rs * g1.x, f[5] * rs * g1.y); w.w = pk2(f[6] * rs * g1.z, f[7] * rs * g1.w);
            *(u32x4*)(CQN + (size_t)row * 512 + 8 * lane) = w;
        }
        {
            const s16x4 x = *(const s16x4*)(pr + C_CKV + 4 * lane); float f[4]; float ss = 0.f;
#pragma unroll
            for (int i = 0; i < 4; ++i) { f[i] = bf2f((unsigned short)x[i]); ss += f[i] * f[i]; }
            const float rs = rsqrtf(wave_sum(ss) * (1.f / 256.f) + EPS);
            const f32x4 g0 = *(const f32x4*)(kvn + 4 * lane);
            u32x2 w; w.x = pk2(f[0] * rs * g0.x, f[1] * rs * g0.y); w.y = pk2(f[2] * rs * g0.z, f[3] * rs * g0.w);
            *(u32x2*)(CKVN + (size_t)row * 256 + 4 * lane) = w;
        }
        const int ax = lane >> 5, fi = lane & 31;
        const float cs = rga[((size_t)t * 64 + lane) * 2], sn = rga[((size_t)t * 64 + lane) * 2 + 1];
        for (int hh = needq ? 0 : 8; hh < 10; ++hh) {
            const bf16_t* src = hh < 8 ? pr + C_GQ + hh * 128 : pr + C_GK + (hh - 8) * 128;
            const float* gn = hh < 8 ? gqn : gkn;
            const float xa = bf2f(src[ax * 64 + fi]), xb = bf2f(src[ax * 64 + 32 + fi]);
            const float rs = rsqrtf(wave_sum(xa * xa + xb * xb) * (1.f / 128.f) + EPS);
            const float ya = xa * rs * gn[ax * 64 + fi], yb = xb * rs * gn[ax * 64 + 32 + fi];
            const float oa = lat ? ya * cs - yb * sn : ya, ob = lat ? ya * sn + yb * cs : yb;
            bf16_t* dst = hh < 8 ? QG + (size_t)row * 1024 + hh * 128 : KG + (size_t)row * 256 + (hh - 8) * 128;
            dst[ax * 64 + fi] = (bf16_t)f2bf(oa); dst[ax * 64 + 32 + fi] = (bf16_t)f2bf(ob);
        }
        {
            const int l32 = lane & 31, ax2 = l32 >> 4, f2 = l32 & 15;
            const float xa = X80[(size_t)row * XW + ax2 * 32 + f2], xb = X80[(size_t)row * XW + ax2 * 32 + 16 + f2];
            const float c2 = rla[((size_t)t * 32 + l32) * 2], s2 = rla[((size_t)t * 32 + l32) * 2 + 1];
            const float oa = lat ? xa * c2 - xb * s2 : xa, ob = lat ? xa * s2 + xb * c2 : xb;
            if (lane < 32) { KR[(size_t)row * 64 + ax2 * 32 + f2] = (bf16_t)f2bf(oa); KR[(size_t)row * 64 + ax2 * 32 + 16 + f2] = (bf16_t)f2bf(ob); }
        }
    }
}

namespace att {
constexpr int QBLK = 32, KVBLK = 64;
#define SBAR() __builtin_amdgcn_sched_barrier(0)
DI int crow(int r, int hi) { return (r & 3) + 8 * (r >> 2) + 4 * hi; }
DI int v_st(int k, int c) { const int kk = (k & ~0xC) | ((k & 4) << 1) | ((k & 8) >> 1); return ((kk >> 3) * 4 + (c >> 5)) * 512 + ((kk & 7) * 32 + (c & 31)) * 2; }
DI int v_rd_base(int lane) { return ((lane & 3) << 3) | (((lane >> 2) & 3) << 6) | (((lane >> 4) & 1) << 5) | (((lane >> 5) & 1) << 8); }
constexpr int v_rd_off(int d0, int ks, int half) { return d0 * 512 + ks * 4096 + half * 2048; }
template <int OFF> DI s16x4 tr_read(int vb) { s16x4 r; asm volatile("ds_read_b64_tr_b16 %0, %1 offset:%2" : "=&v"(r) : "v"(vb), "i"(OFF) : "memory"); return r; }
template <int D0> DI void pv_one(f32x16& od, int vb, bf16x8 pa0, bf16x8 pa1, bf16x8 pa2, bf16x8 pa3) {
  const s16x4 l0 = tr_read<v_rd_off(D0, 0, 0)>(vb), h0 = tr_read<v_rd_off(D0, 0, 1)>(vb), l1 = tr_read<v_rd_off(D0, 1, 0)>(vb), h1 = tr_read<v_rd_off(D0, 1, 1)>(vb);
  const s16x4 l2 = tr_read<v_rd_off(D0, 2, 0)>(vb), h2 = tr_read<v_rd_off(D0, 2, 1)>(vb), l3 = tr_read<v_rd_off(D0, 3, 0)>(vb), h3 = tr_read<v_rd_off(D0, 3, 1)>(vb);
  asm volatile("s_waitcnt lgkmcnt(0)" ::: "memory"); SBAR();
#define PK(L, H) (bf16x8){L[0], L[1], L[2], L[3], H[0], H[1], H[2], H[3]}
  od = __builtin_amdgcn_mfma_f32_32x32x16_bf16(pa0, PK(l0, h0), od, 0, 0, 0);
  od = __builtin_amdgcn_mfma_f32_32x32x16_bf16(pa1, PK(l1, h1), od, 0, 0, 0);
  od = __builtin_amdgcn_mfma_f32_32x32x16_bf16(pa2, PK(l2, h2), od, 0, 0, 0);
  od = __builtin_amdgcn_mfma_f32_32x32x16_bf16(pa3, PK(l3, h3), od, 0, 0, 0);
#undef PK
}
DI void pv_d0(f32x16* o, int vb, bf16x8 pa0, bf16x8 pa1, bf16x8 pa2, bf16x8 pa3) {
  pv_one<0>(o[0], vb, pa0, pa1, pa2, pa3); pv_one<1>(o[1], vb, pa0, pa1, pa2, pa3); pv_one<2>(o[2], vb, pa0, pa1, pa2, pa3); pv_one<3>(o[3], vb, pa0, pa1, pa2, pa3);
}
template <int DKX, int LDQ, int LDK, int LDV, int LDO, int SDEPTH = 1>
DI void attn_body(const bf16_t* __restrict__ Qb, const bf16_t* __restrict__ Km, const bf16_t* __restrict__ Kx, const bf16_t* __restrict__ Vm, bf16_t* __restrict__ Ob,
                  int kr0, int nt0, int kr1, int nt1, float scale, const float* __restrict__ ropeq  , char* lds) {
  constexpr int ND0 = 8 + DKX / 16, KROWB = (128 + DKX) * 2, SHM_V = KVBLK * 128 * 2, SHM_K = KVBLK * KROWB;
  constexpr float THR = 8.f;
#define KSWZ(row, colB) ((row) * KROWB + ((colB) ^ (((row) & 7) << 4)))
  int tid = threadIdx.x; asm volatile("" : "+v"(tid));
  const int wid = __builtin_amdgcn_readfirstlane(tid >> 6), lane = tid & 63, r32 = lane & 31, hi = lane >> 5;
  char* V_lds = lds; char* K_lds = lds + 2 * SHM_V;
  float* ws = (float*)(lds + 2 * SHM_V + 2 * SHM_K) + wid * 64; float* li_l = ws; float* al_l = ws + 32;
  const float C = scale * 1.4426950408889634f;
  float m_reg = -1e30f, l_reg = 0; f32x16 o[4] = {}; bf16x8 qr[8];
  const bf16_t* Qw = Qb + (long)(wid * QBLK + r32) * LDQ + hi * 8;
#pragma unroll
  for (int d0 = 0; d0 < 8; ++d0) qr[d0] = *reinterpret_cast<const bf16x8*>(Qw + d0 * 16);
  char* QX = lds + 2 * SHM_V + 2 * SHM_K + 2048 + (wid * 4 * 64 + lane) * 16;
  if constexpr (DKX > 0) {
#pragma unroll
    for (int ax = 0; ax < 2; ++ax) {
      const bf16x8 xa = *reinterpret_cast<const bf16x8*>(Qw + 128 + ax * 32), xb = *reinterpret_cast<const bf16x8*>(Qw + 128 + ax * 32 + 16);
      if (ropeq) {
        const float* cs = ropeq + ((size_t)(wid * QBLK + r32) * 32 + ax * 16 + hi * 8) * 2;
        float oa[8], ob[8];
#pragma unroll
        for (int j = 0; j < 8; ++j) { const float c = cs[2 * j], sn = cs[2 * j + 1], a = bf2f((unsigned short)xa[j]), b = bf2f((unsigned short)xb[j]); oa[j] = a * c - b * sn; ob[j] = a * sn + b * c; }
        u32x4 wa = {pk2(oa[0], oa[1]), pk2(oa[2], oa[3]), pk2(oa[4], oa[5]), pk2(oa[6], oa[7])}, wb = {pk2(ob[0], ob[1]), pk2(ob[2], ob[3]), pk2(ob[4], ob[5]), pk2(ob[6], ob[7])};
        *reinterpret_cast<u32x4*>(QX + (2 * ax) * 1024) = wa; *reinterpret_cast<u32x4*>(QX + (2 * ax + 1) * 1024) = wb;
      } else { *reinterpret_cast<bf16x8*>(QX + (2 * ax) * 1024) = xa; *reinterpret_cast<bf16x8*>(QX + (2 * ax + 1) * 1024) = xb; }
    }
  }
  const int sr = tid >> 4, sc = (tid & 15) * 8, vst0 = v_st(sr, sc), vst1 = v_st(32 + sr, sc);
  const int xr = tid >> 3, xc = (tid & 7) * 8;
  const int vb0 = (int)(uintptr_t)V_lds + v_rd_base(lane);
  const int offV = sr * LDV + sc, offK = sr * LDK + sc, offX = xr * 64 + xc;
  struct { bf16x8 vs0, vs1, ks0, ks1, kx; } sr_[SDEPTH];
  const int NT = nt0 + nt1;
#define TROW(j) ((j) < nt0 ? kr0 + (j) * KVBLK : kr1 + ((j) - nt0) * KVBLK)
#define SLOAD(i, j) do { const long _r = TROW(j); const bf16_t* _vt = Vm + _r * LDV; const bf16_t* _kt = Km + _r * LDK; \
    sr_[i].vs0 = *(const bf16x8*)(_vt + offV); sr_[i].vs1 = *(const bf16x8*)(_vt + offV + 32 * LDV); \
    sr_[i].ks0 = *(const bf16x8*)(_kt + offK); sr_[i].ks1 = *(const bf16x8*)(_kt + offK + 32 * LDK); \
    if constexpr (DKX > 0) sr_[i].kx = *(const bf16x8*)(Kx + _r * 64 + offX); } while (0)
#define SWRITE(b, i) do { *(bf16x8*)(V_lds + (b) * SHM_V + vst0) = sr_[i].vs0; *(bf16x8*)(V_lds + (b) * SHM_V + vst1) = sr_[i].vs1; const int kc = sc * 2; \
    *(bf16x8*)(K_lds + (b) * SHM_K + KSWZ(sr, kc)) = sr_[i].ks0; *(bf16x8*)(K_lds + (b) * SHM_K + KSWZ(32 + sr, kc)) = sr_[i].ks1; \
    if constexpr (DKX > 0) *(bf16x8*)(K_lds + (b) * SHM_K + KSWZ(xr, 256 + xc * 2)) = sr_[i].kx; } while (0)
#define SWAIT() do { if constexpr (SDEPTH == 1) asm volatile("s_waitcnt vmcnt(0)" ::: "memory"); else if constexpr (DKX > 0) asm volatile("s_waitcnt vmcnt(5)" ::: "memory"); else asm volatile("s_waitcnt vmcnt(4)" ::: "memory"); } while (0)
#define RESC(a) do { if (__any((a) < 1.f)) { if (hi == 0) al_l[r32] = (a); asm volatile("s_waitcnt lgkmcnt(0)" ::: "memory"); \
    for (int d = 0; d < 4; ++d) for (int r = 0; r < 16; ++r) o[d][r] *= al_l[crow(r, hi)]; } } while (0)
#define QKT(p0, p1, Ks) do { p0 = f32x16{}; p1 = f32x16{}; _Pragma("unroll") for (int d0 = 0; d0 < ND0; ++d0) { const int cb = (d0 * 16 + hi * 8) * 2; \
    const bf16x8 b0 = *reinterpret_cast<const bf16x8*>((Ks) + KSWZ(r32, cb)); const bf16x8 b1 = *reinterpret_cast<const bf16x8*>((Ks) + KSWZ(32 + r32, cb)); \
    const bf16x8 qf = d0 < 8 ? qr[d0 < 8 ? d0 : 0] : *reinterpret_cast<const bf16x8*>(QX + (d0 - 8) * 1024); \
    p0 = __builtin_amdgcn_mfma_f32_32x32x16_bf16(b0, qf, p0, 0, 0, 0); p1 = __builtin_amdgcn_mfma_f32_32x32x16_bf16(b1, qf, p1, 0, 0, 0); if (DKX > 0 && (d0 & 1) == 1) SBAR(); } } while (0)
#define PARTIAL_SM(p0, p1, mn, alpha) do { float pmax = p0[0]; for (int r = 1; r < 16; ++r) pmax = fmaxf(pmax, p0[r]); for (int r = 0; r < 16; ++r) pmax = fmaxf(pmax, p1[r]); \
    { auto rr = __builtin_amdgcn_permlane32_swap(__float_as_uint(pmax), __float_as_uint(pmax), false, false); pmax = fmaxf(__uint_as_float(rr[0]), __uint_as_float(rr[1])); } \
    if (__builtin_expect(__all((pmax - m_reg) * scale <= THR), 1)) { mn = m_reg; alpha = 1.f; } \
    else { mn = fmaxf(m_reg, pmax); alpha = __builtin_amdgcn_exp2f((m_reg - mn) * C); m_reg = mn; } \
    const float mnC = -mn * C; for (int r = 0; r < 16; ++r) p0[r] = fmaf(p0[r], C, mnC); for (int r = 0; r < 16; ++r) p1[r] = fmaf(p1[r], C, mnC); \
    for (int r = 0; r < 16; ++r) p0[r] = __builtin_amdgcn_exp2f(p0[r]); } while (0)
#define PK4(P, BASE, OUT) do { unsigned a0 = pk2(P[BASE + 0], P[BASE + 1]), a1 = pk2(P[BASE + 2], P[BASE + 3]); \
    unsigned b0 = pk2(P[BASE + 4], P[BASE + 5]), b1 = pk2(P[BASE + 6], P[BASE + 7]); \
    auto r0 = __builtin_amdgcn_permlane32_swap(a0, b0, false, false); auto r1 = __builtin_amdgcn_permlane32_swap(a1, b1, false, false); \
    u32x4 w = {r0[0], r1[0], r0[1], r1[1]}; OUT = *reinterpret_cast<bf16x8*>(&w); } while (0)
#define FINISH_SM(p0, p1, alpha) do { for (int r = 0; r < 16; ++r) p1[r] = __builtin_amdgcn_exp2f(p1[r]); \
    float ps = 0; for (int r = 0; r < 16; ++r) ps += p0[r]; for (int r = 0; r < 16; ++r) ps += p1[r]; \
    { auto rr = __builtin_amdgcn_permlane32_swap(__float_as_uint(ps), __float_as_uint(ps), false, false); ps = __uint_as_float(rr[0]) + __uint_as_float(rr[1]); } \
    l_reg = l_reg * alpha + ps; PK4(p0, 0, pa0); PK4(p0, 8, pa1); PK4(p1, 0, pa2); PK4(p1, 8, pa3); } while (0)
  f32x16 pA0, pA1, pB0, pB1; float mnA, mnB, alA, alB; bf16x8 pa0, pa1, pa2, pa3;
  constexpr int SE = 0, SO = SDEPTH - 1;
  SLOAD(SE, 0); asm volatile("s_waitcnt vmcnt(0)" ::: "memory"); SWRITE(0, SE); __syncthreads();
  QKT(pA0, pA1, K_lds); PARTIAL_SM(pA0, pA1, mnA, alA);
  SLOAD(SO, 1); if constexpr (SDEPTH == 2) { if (2 < NT) SLOAD(SE, 2); }
  SWAIT(); SWRITE(1, SO); __syncthreads();
  for (int j = 1; j + 1 < NT; j += 2) {
    SBAR(); QKT(pB0, pB1, K_lds + SHM_K);
    FINISH_SM(pA0, pA1, alA); SBAR();
    SLOAD(SO, j + SDEPTH); SBAR();
    pv_d0(o, vb0, pa0, pa1, pa2, pa3); PARTIAL_SM(pB0, pB1, mnB, alB);
    __syncthreads(); SWAIT(); SWRITE(0, SE);
    RESC(alB); __syncthreads();
    SBAR(); QKT(pA0, pA1, K_lds);
    FINISH_SM(pB0, pB1, alB); SBAR();
    if (SDEPTH == 1 || j + 3 < NT) SLOAD(SE, j + 1 + SDEPTH); SBAR();
    pv_d0(o, vb0 + (int)SHM_V, pa0, pa1, pa2, pa3); PARTIAL_SM(pA0, pA1, mnA, alA);
    __syncthreads(); SWAIT(); SWRITE(1, SO);
    RESC(alA); __syncthreads();
  }
  SBAR(); QKT(pB0, pB1, K_lds + SHM_K);
  FINISH_SM(pA0, pA1, alA); SBAR();
  pv_d0(o, vb0, pa0, pa1, pa2, pa3); PARTIAL_SM(pB0, pB1, mnB, alB);
  __syncthreads(); RESC(alB);
  FINISH_SM(pB0, pB1, alB); SBAR();
  pv_d0(o, vb0 + (int)SHM_V, pa0, pa1, pa2, pa3);
  if (hi == 0) li_l[r32] = l_reg; asm volatile("s_waitcnt lgkmcnt(0)" ::: "memory");
  float rli[16];
#pragma unroll
  for (int r = 0; r < 16; ++r) rli[r] = __builtin_amdgcn_rcpf(li_l[crow(r, hi)]);
  bf16_t* Ow = Ob + (long)(wid * QBLK) * LDO;
#pragma unroll
  for (int r = 0; r < 16; ++r) { const int orow = crow(r, hi);
#pragma unroll
    for (int d0 = 0; d0 < 4; ++d0) Ow[(long)orow * LDO + d0 * 32 + r32] = (bf16_t)f2bf(o[d0][r] * rli[r]); }
  __syncthreads();
#undef KSWZ
#undef TROW
#undef SLOAD
#undef SWRITE
#undef SWAIT
#undef RESC
#undef QKT
#undef PARTIAL_SM
#undef PK4
#undef FINISH_SM
}
}

namespace ml {
constexpr int LD = 264, ROWB = LD * 2, QS_OFF = 0, KS_OFF = 64 * ROWB, VS_OFF = 2 * 64 * ROWB, NV_OFF = 3 * 64 * ROWB, SC_OFF = NV_OFF + 1024, ML_END = SC_OFF + 2048;
static_assert(ML_END <= LDS_BYTES - 1024, "mlstm lds");
#define MFMA32(a, b, c) __builtin_amdgcn_mfma_f32_32x32x16_bf16((a), (b), (c), 0, 0, 0)
DI bf16x8 pack_step(const f32x16& x, int s) {
    u32x4 p;
    asm volatile("v_cvt_pk_bf16_f32 %0, %4, %5\n\tv_cvt_pk_bf16_f32 %1, %6, %7\n\tv_cvt_pk_bf16_f32 %2, %8, %9\n\tv_cvt_pk_bf16_f32 %3, %10, %11\n\ts_nop 1"
                 : "=&v"(p[0]), "=&v"(p[1]), "=&v"(p[2]), "=&v"(p[3])
                 : "v"(x[8 * s]), "v"(x[8 * s + 1]), "v"(x[8 * s + 2]), "v"(x[8 * s + 3]), "v"(x[8 * s + 4]), "v"(x[8 * s + 5]), "v"(x[8 * s + 6]), "v"(x[8 * s + 7]));
    return __builtin_bit_cast(bf16x8, p);
}
DI bf16x8 ld_perm(const LAS unsigned char* p) {
    const s16x4 lo = *(const LAS s16x4*)p, hi = *(const LAS s16x4*)(p + 16);
    return (bf16x8){lo[0], lo[1], lo[2], lo[3], hi[0], hi[1], hi[2], hi[3]};
}
DI int crow(int r, int hi) { return (r & 3) + 8 * (r >> 2) + 4 * hi; }
template <int OFF> DI s16x4 tr_rd(unsigned addr) { s16x4 r; asm volatile("ds_read_b64_tr_b16 %0, %1 offset:%2" : "=&v"(r) : "v"(addr), "i"(OFF) : "memory"); return r; }
#define TR_WAIT() do { asm volatile("s_waitcnt lgkmcnt(0)" ::: "memory"); __builtin_amdgcn_sched_barrier(0); } while (0)
#define CAT8(L, H) (bf16x8){L[0], L[1], L[2], L[3], H[0], H[1], H[2], H[3]}

DI void mlstm_stream(const Frame& F, const Args& a, int l, int stream, bool ctx_out) {
    const int b = stream >> 3, hd = (stream >> 1) & 3, dir = stream & 1;
    const int tid = F.tid, w = F.wave;
    LAS unsigned char* lds = F.lds;
    const unsigned ldsb = (unsigned)(uintptr_t)lds;
    const bf16_t* P = (const bf16_t*)(F.ws + WS_P); const float* X80 = (const float*)(F.ws + WS_X80);
    float* MLH = (float*)(F.ws + WS_MLH) + (size_t)dir * MTOT * 1024;
    const float* gb = a.in[I_GBIAS] + l * 16;
    const float gbi = gb[dir * 8 + hd], gbf = gb[dir * 8 + 4 + hd];
    LAS float* NV = (LAS float*)(lds + NV_OFF);
    LAS float* SC = (LAS float*)(lds + SC_OFF);
    f32x16 CT[8];
#pragma unroll
    for (int i = 0; i < 8; ++i) CT[i] = f32x16{};
    if (tid < 256) NV[tid] = 0.f;
    float m_prev = 0.f;
    const int sgn = dir ? -1 : 1;
#define CHUNK_ROW0(c) ((c) < 4 ? MLAT + b * CTXL + (dir ? 255 - (c) * 64 : (c) * 64) : b * SEQ + (dir ? 2047 - ((c) - 4) * 64 : ((c) - 4) * 64))
    bf16x8 pq[4], pk[4], pv[4]; float pgi, pgf;
#define PREFETCH(c) do { int ln_ = F.lane; asm volatile("" : "+v"(ln_)); const int r0_ = CHUNK_ROW0(c); \
        const bf16_t* pr_ = P + (size_t)(r0_ + sgn * ((w << 3) | (ln_ >> 3))) * NP + hd * 256 + 8 * (ln_ & 7); \
        _Pragma("unroll") for (int j = 0; j < 4; ++j) { pq[j] = *(const bf16x8*)(pr_ + C_MLQ + 64 * j); pk[j] = *(const bf16x8*)(pr_ + C_MLK + 64 * j); pv[j] = *(const bf16x8*)(pr_ + C_MLV + 64 * j); } \
        const float* xg_ = X80 + (size_t)(r0_ + sgn * ln_) * XW + 64 + dir * 8 + hd; pgi = xg_[0]; pgf = xg_[4]; } while (0)
    PREFETCH(0);
#ifndef MK_MLX
#define MK_MLX 1
#endif
    for (int cc = 0; cc < 36 * MK_MLX; ++cc) {
        const int c = cc % 36;
        if (MK_MLX > 1 && cc == 36) { __syncthreads();
#pragma unroll
            for (int i = 0; i < 8; ++i) CT[i] = f32x16{};
            if (tid < 256) NV[tid] = 0.f; m_prev = 0.f; }
        int lane = F.lane; asm volatile("" : "+v"(lane));
        const int r32 = lane & 31, hi = lane >> 5, ldi = (w << 3) | (lane >> 3), cg = lane & 7, g16 = lane >> 4, q4 = (lane & 15) >> 2, p4 = lane & 3;
        const int row0 = CHUNK_ROW0(c);
        const float ipre = pgi + gbi, fpre = pgf + gbf;
        const float lf = fminf(fpre, 0.f) - __logf(1.f + __expf(-fabsf(fpre)));
        float cum = lf;
#pragma unroll
        for (int o = 1; o < 64; o <<= 1) { const float t = __shfl_up(cum, o); if (lane >= o) cum += t; }
        const float bb = ipre - cum;
        float pmx = bb;
#pragma unroll
        for (int o = 1; o < 64; o <<= 1) { const float t = __shfl_up(pmx, o); if (lane >= o) pmx = fmaxf(pmx, t); }
        const float aa = fmaxf(m_prev, pmx);
        const float cum_end = __shfl(cum, 63), a_end = __shfl(aa, 63);
        const float decay = __expf(m_prev - a_end), m_new = cum_end + a_end;
        __syncthreads();
#pragma unroll
        for (int j = 0; j < 4; ++j) { const int ch = cg + 8 * j; const bf16x8 qv = pq[j];
            u32x4 qs;
            qs.x = pk2(bf2f((unsigned short)qv[0]) * 0.0625f, bf2f((unsigned short)qv[1]) * 0.0625f); qs.y = pk2(bf2f((unsigned short)qv[2]) * 0.0625f, bf2f((unsigned short)qv[3]) * 0.0625f);
            qs.z = pk2(bf2f((unsigned short)qv[4]) * 0.0625f, bf2f((unsigned short)qv[5]) * 0.0625f); qs.w = pk2(bf2f((unsigned short)qv[6]) * 0.0625f, bf2f((unsigned short)qv[7]) * 0.0625f);
            *(LAS u32x4*)(lds + QS_OFF + (ldi * LD + 8 * ch) * 2) = qs;
            *(LAS bf16x8*)(lds + KS_OFF + (ldi * LD + 8 * ch) * 2) = pk[j];
            *(LAS bf16x8*)(lds + VS_OFF + (ldi * LD + 8 * ch) * 2) = pv[j]; }
        if (w == 0) { SC[lane] = bb; SC[64 + lane] = aa; SC[128 + lane] = __expf(m_prev - aa); SC[192 + lane] = __expf(-cum - aa); SC[256 + lane] = __expf(bb - a_end); }
        __syncthreads();
        float nq = 0.f;
        {
            const LAS unsigned char* qrow = lds + QS_OFF + lane * ROWB;
#pragma unroll 4
            for (int d8 = 0; d8 < 32; ++d8) { const bf16x8 qv = *(const LAS bf16x8*)(qrow + d8 * 16); const f32x4 n0 = *(const LAS f32x4*)(NV + 8 * d8), n1 = *(const LAS f32x4*)(NV + 8 * d8 + 4);
                nq += bf2f((unsigned short)qv[0]) * n0.x + bf2f((unsigned short)qv[1]) * n0.y + bf2f((unsigned short)qv[2]) * n0.z + bf2f((unsigned short)qv[3]) * n0.w
                    + bf2f((unsigned short)qv[4]) * n1.x + bf2f((unsigned short)qv[5]) * n1.y + bf2f((unsigned short)qv[6]) * n1.z + bf2f((unsigned short)qv[7]) * n1.w; }
        }
        const bool want_out = (c >= 4) || ctx_out;
        if (want_out) {
            const unsigned va0 = ldsb + VS_OFF + ((4 * (g16 >> 1) + q4) * LD + 32 * w + 16 * (g16 & 1) + 4 * p4) * 2;
#pragma unroll
            for (int lt = 0; lt < 2; ++lt) {
                const int lcol = 32 * lt + r32;
                const float a_l = SC[64 + lcol], wI_l = SC[128 + lcol], fl_l = SC[192 + lcol], nq_l = __shfl(nq, lcol);
                f32x16 N = f32x16{};
#pragma unroll
                for (int dt = 0; dt < 8; ++dt)
#pragma unroll
                    for (int ks = 0; ks < 2; ++ks) {
                        const bf16x8 qa = ld_perm(lds + QS_OFF + (lcol * LD + 32 * dt + 16 * ks + 4 * hi) * 2);
                        N = MFMA32(pack_step(CT[dt], ks), qa, N); if (ks == 1 && (dt & 1)) __builtin_amdgcn_sched_barrier(0); }
#pragma unroll
                for (int r = 0; r < 16; ++r) N[r] *= wI_l;
                float den = 0.f;
#pragma unroll
                for (int st = 0; st <= lt; ++st) {
                    f32x16 S = f32x16{};
#pragma unroll
                    for (int ks = 0; ks < 16; ++ks) {
                        const bf16x8 ka = *(const LAS bf16x8*)(lds + KS_OFF + ((32 * st + r32) * LD + 16 * ks + 8 * hi) * 2);
                        const bf16x8 qb = *(const LAS bf16x8*)(lds + QS_OFF + (lcol * LD + 16 * ks + 8 * hi) * 2);
                        S = MFMA32(ka, qb, S); }
                    const s16x4 v00 = st == 0 ? tr_rd<0>(va0) : tr_rd<32 * ROWB>(va0), v01 = st == 0 ? tr_rd<8 * ROWB>(va0) : tr_rd<40 * ROWB>(va0);
                    const s16x4 v10 = st == 0 ? tr_rd<16 * ROWB>(va0) : tr_rd<48 * ROWB>(va0), v11 = st == 0 ? tr_rd<24 * ROWB>(va0) : tr_rd<56 * ROWB>(va0);
#pragma unroll
                    for (int r = 0; r < 16; ++r) { const int srow = 32 * st + crow(r, hi); const float dd = __expf(SC[srow] - a_l);
                        const float v = (srow <= lcol) ? S[r] * dd : 0.f; S[r] = v; den += v; }
                    TR_WAIT();
                    N = MFMA32(CAT8(v00, v01), pack_step(S, 0), N);
                    N = MFMA32(CAT8(v10, v11), pack_step(S, 1), N);
                }
                den += __shfl_xor(den, 32);
                den += wI_l * nq_l;
                const float inv = 1.f / fmaxf(fabsf(den), fl_l);
                float* orow = MLH + (size_t)(row0 + sgn * lcol) * 1024 + hd * 256 + 32 * w + 4 * hi;
#pragma unroll
                for (int g = 0; g < 4; ++g) *(f32x4*)(orow + 8 * g) = (f32x4){N[4 * g] * inv, N[4 * g + 1] * inv, N[4 * g + 2] * inv, N[4 * g + 3] * inv};
                __builtin_amdgcn_sched_barrier(0);
            }
        }
        __builtin_amdgcn_sched_barrier(0);
        { const int cn = (cc + 1 < 36 * MK_MLX) ? (cc + 1) % 36 : 35; PREFETCH(cn); }
        __builtin_amdgcn_sched_barrier(0);
        {
            const unsigned vb0 = ldsb + VS_OFF + ((8 * (g16 >> 1) + q4) * LD + 32 * w + 16 * (g16 & 1) + 4 * p4) * 2;
            const unsigned kb0 = ldsb + KS_OFF + ((8 * (g16 >> 1) + q4) * LD + 16 * (g16 & 1) + 4 * p4) * 2;
            const s16x4 b00 = tr_rd<0>(vb0), b01 = tr_rd<4 * ROWB>(vb0), b10 = tr_rd<16 * ROWB>(vb0), b11 = tr_rd<20 * ROWB>(vb0);
            const s16x4 b20 = tr_rd<32 * ROWB>(vb0), b21 = tr_rd<36 * ROWB>(vb0), b30 = tr_rd<48 * ROWB>(vb0), b31 = tr_rd<52 * ROWB>(vb0);
            TR_WAIT();
            bf16x8 vb[4];
#define SCALE8(dst, L, H, ks) do { const f32x4 w0 = *(const LAS f32x4*)(SC + 256 + 16 * (ks) + 8 * hi), w1 = *(const LAS f32x4*)(SC + 256 + 16 * (ks) + 8 * hi + 4); \
            u32x4 t_; t_.x = pk2(bf2f((unsigned short)L[0]) * w0.x, bf2f((unsigned short)L[1]) * w0.y); t_.y = pk2(bf2f((unsigned short)L[2]) * w0.z, bf2f((unsigned short)L[3]) * w0.w); \
            t_.z = pk2(bf2f((unsigned short)H[0]) * w1.x, bf2f((unsigned short)H[1]) * w1.y); t_.w = pk2(bf2f((unsigned short)H[2]) * w1.z, bf2f((unsigned short)H[3]) * w1.w); dst = __builtin_bit_cast(bf16x8, t_); } while (0)
            SCALE8(vb[0], b00, b01, 0); SCALE8(vb[1], b10, b11, 1); SCALE8(vb[2], b20, b21, 2); SCALE8(vb[3], b30, b31, 3);
#undef SCALE8
#define UPD(dt) do { const s16x4 k00 = tr_rd<(dt) * 64>(kb0), k01 = tr_rd<(dt) * 64 + 4 * ROWB>(kb0), k10 = tr_rd<(dt) * 64 + 16 * ROWB>(kb0), k11 = tr_rd<(dt) * 64 + 20 * ROWB>(kb0); \
            const s16x4 k20 = tr_rd<(dt) * 64 + 32 * ROWB>(kb0), k21 = tr_rd<(dt) * 64 + 36 * ROWB>(kb0), k30 = tr_rd<(dt) * 64 + 48 * ROWB>(kb0), k31 = tr_rd<(dt) * 64 + 52 * ROWB>(kb0); \
            _Pragma("unroll") for (int r = 0; r < 16; ++r) CT[dt][r] *= decay; \
            TR_WAIT(); \
            CT[dt] = MFMA32(CAT8(k00, k01), vb[0], CT[dt]); CT[dt] = MFMA32(CAT8(k10, k11), vb[1], CT[dt]); CT[dt] = MFMA32(CAT8(k20, k21), vb[2], CT[dt]); CT[dt] = MFMA32(CAT8(k30, k31), vb[3], CT[dt]); } while (0)
            UPD(0); UPD(1); UPD(2); UPD(3); UPD(4); UPD(5); UPD(6); UPD(7);
#undef UPD
        }
        __syncthreads();
        if (tid < 256) { float sacc = 0.f;
#pragma unroll 8
            for (int q = 0; q < 64; ++q) sacc += bf2f(*(const LAS unsigned short*)(lds + KS_OFF + (q * LD + tid) * 2)) * SC[256 + q];
            NV[tid] = decay * NV[tid] + sacc; }
        m_prev = m_new;
    }
    __syncthreads();
#undef CHUNK_ROW0
#undef PREFETCH
}
#undef MFMA32
#undef TR_WAIT
#undef CAT8
}

DI void phase_mixers(const Frame& F, const Args& a, int l, char* ldsg, int npass) {
    unsigned* head0 = (unsigned*)(F.ws + WS_CTL) + CW_QUEUE + 64 * l;
    volatile LAS unsigned* MISC = (volatile LAS unsigned*)(F.lds + LDS_BYTES - 64);
    const int n_ml = 32, n_la = 256, n_ga = 256, n_cx = (l == 0) ? 32 : 0, n_mix = n_ml + n_la + n_ga + 2 * n_cx;
    const int total = n_mix;
    const bf16_t* QLA = (const bf16_t*)(F.ws + WS_QLA); const bf16_t* KVLA = (const bf16_t*)(F.ws + WS_KVLA); const bf16_t* KR = (const bf16_t*)(F.ws + WS_KR);
    const bf16_t* QG = (const bf16_t*)(F.ws + WS_QG); const bf16_t* KG = (const bf16_t*)(F.ws + WS_KG); const bf16_t* P = (const bf16_t*)(F.ws + WS_P);
    bf16_t* YCAT = (bf16_t*)(F.ws + WS_YCAT);
#ifndef MK_MIX
#define MK_MIX 7
#endif
#define GRAB(u) do { __syncthreads(); if (F.tid == 0) MISC[4] = __hip_atomic_fetch_add(head, 1u, __ATOMIC_RELAXED, __HIP_MEMORY_SCOPE_AGENT); __syncthreads(); u = __builtin_amdgcn_readfirstlane((int)MISC[4]); } while (0)
    for (int pass = 0; pass < npass; ++pass) {
    unsigned* head = head0 + 128 * pass;
    int u0;
    GRAB(u0);
    while (u0 < n_ml) { if (MK_MIX & 1) ml::mlstm_stream(F, a, l, u0, l == 0); GRAB(u0); }
    while (u0 < n_mix) {
        int u = u0 - n_ml;
        if (u < n_la) { const int b = u >> 6, h = (u >> 3) & 7, qb = u & 7; const long q0 = (long)b * SEQ + qb * 256;
            if (MK_MIX & 2) att::attn_body<64, 1536, 2048, 2048, 3072>(QLA + q0 * 1536 + h * 192, KVLA + h * 256, KR, KVLA + h * 256 + 128, YCAT + q0 * 3072 + 1024 + h * 128,
                                                      MLAT + b * CTXL, 4, b * SEQ, 32, 0.07216878364870322f, (const float*)(F.ws + WS_ROPE_LA) + (size_t)qb * 256 * 64, ldsg); }
        else if (u < n_la + n_ga) { u -= n_la; const int b = u >> 6, h = (u >> 3) & 7, qb = u & 7; const long q0 = (long)b * SEQ + qb * 256;
            if (MK_MIX & 4) att::attn_body<0, 1024, 256, NP, 3072>(QG + q0 * 1024 + h * 128, KG + (h >> 2) * 128, nullptr, P + C_GV + (h >> 2) * 128, YCAT + q0 * 3072 + 2048 + h * 128,
                                                  MLAT + b * CTXL, 4, b * SEQ, 32, 0.08838834764831845f, nullptr, ldsg); }
        else if (u < n_la + n_ga + n_cx) { u -= n_la + n_ga; const int b = u >> 3, h = u & 7; const long q0 = (long)MLAT + b * CTXL;
            if (MK_MIX & 2) att::attn_body<64, 1536, 2048, 2048, 3072>(QLA + q0 * 1536 + h * 192, KVLA + h * 256, KR, KVLA + h * 256 + 128, YCAT + q0 * 3072 + 1024 + h * 128,
                                                      MLAT + b * CTXL, 4, 0, 0, 0.07216878364870322f, nullptr, ldsg); }
        else { u -= n_la + n_ga + n_cx; const int b = u >> 3, h = u & 7; const long q0 = (long)MLAT + b * CTXL;
            if (MK_MIX & 4) att::attn_body<0, 1024, 256, NP, 3072>(QG + q0 * 1024 + h * 128, KG + (h >> 2) * 128, nullptr, P + C_GV + (h >> 2) * 128, YCAT + q0 * 3072 + 2048 + h * 128,
                                                  MLAT + b * CTXL, 4, 0, 0, 0.08838834764831845f, nullptr, ldsg); }
        GRAB(u0);
    }
    }
#undef GRAB
}

DI void phase_convert_tail(const Frame& F0, const Args& a, int l) {
    Frame F = F0; { int t_ = threadIdx.x; asm volatile("" : "+v"(t_)); F.tid = t_; F.lane = t_ & 63; F.wave = __builtin_amdgcn_readfirstlane(t_ >> 6); }
    constexpr int CVB = 64;
    unsigned* head = (unsigned*)(F.ws + WS_CTL) + CW_QUEUE + 64 * l + 32;
    volatile LAS unsigned* MISC = (volatile LAS unsigned*)(F.lds + LDS_BYTES - 64);
    const int n_cv = ((IT_LAYER - IT_EARLY) + ((l == 0) ? IT_EARLY : 0)) / CVB;
    LAS float* scr = (LAS float*)(F.lds + F.wave * 16384);
    for (;;) {
        __syncthreads();
        if (F.tid == 0) MISC[4] = __hip_atomic_fetch_add(head, 1u, __ATOMIC_RELAXED, __HIP_MEMORY_SCOPE_AGENT);
        __syncthreads();
        const int blk = __builtin_amdgcn_readfirstlane((int)MISC[4]);
        if (blk >= n_cv) break;
#pragma unroll 1
        for (int q = 0; q < CVB / NWAVES; ++q) { const int r = blk * CVB + q * NWAVES + F.wave;
            if (r < IT_LAYER - IT_EARLY) convert_item(F, a, l, IT_EARLY + r, scr); else convert_item(F, a, 1, r - (IT_LAYER - IT_EARLY), scr); }
    }
}

DI void phase_mlfin(const Frame& F, const Args& a, int l, int nrows) {
    const float* H0 = (const float*)(F.ws + WS_MLH); const float* H1 = H0 + (size_t)MTOT * 1024;
    const bf16_t* P = (const bf16_t*)(F.ws + WS_P); bf16_t* YCAT = (bf16_t*)(F.ws + WS_YCAT); const float* gn = a.in[I_MLNORM] + l * 1024;
    for (int row = F.gw; row < nrows; row += F.ngw) {
#pragma unroll
        for (int hd = 0; hd < 4; ++hd) { const int c = hd * 256 + 4 * F.lane;
            const f32x4 v = *(const f32x4*)(H0 + (size_t)row * 1024 + c) + *(const f32x4*)(H1 + (size_t)row * 1024 + c);
            const float rs = rsqrtf(wave_sum(v.x * v.x + v.y * v.y + v.z * v.z + v.w * v.w) * (1.f / 256.f) + EPS);
            const f32x4 g = *(const f32x4*)(gn + c); const s16x4 og = *(const s16x4*)(P + (size_t)row * NP + C_MLO + c);
            u32x2 w; w.x = pk2(v.x * rs * g.x * sigmoidf_(bf2f((unsigned short)og[0])), v.y * rs * g.y * sigmoidf_(bf2f((unsigned short)og[1])));
            w.y = pk2(v.z * rs * g.z * sigmoidf_(bf2f((unsigned short)og[2])), v.w * rs * g.w * sigmoidf_(bf2f((unsigned short)og[3])));
            *(u32x2*)(YCAT + (size_t)row * 3072 + c) = w; }
    }
}

struct SchedMerge {
    const char* Y; const char* Bt; int nM, G, c;
    DI bool next(int i, Unit& u) const {
        const int k = i / 3, br = i - 3 * k; const long L = (long)k * G + c; if (L >= (long)nM * 8) return false;
        int pm, pn; pg8::tile_of((int)L, nM, 8, pm, pn);
        u.pm = pm; u.pn = pn; u.aux = br; u.nt = 16; u.pa = Y + (size_t)pm * 256 * 6144 + br * 2048; u.pb = Bt + ((size_t)br * 2048 + pn * 256) * 2048; return true;
    }
};
struct EpiMerge {
    const bf16_t* P; float* MF; bf16_t* MB;
    DI void operator()(const f32x4 (&acc)[2][2][4][2], const Unit& u, int wr, int wc, int fr, int fq) const {
        const int br = u.aux;
        EPI_FOREACH({
            const bf16x8 gp = *(const bf16x8*)(P + (size_t)row * NP + C_GATE + br * 2048 + col);
            f32x4 g0, g1;
            g0.x = sigmoidf_(bf2f((unsigned short)gp[0])); g0.y = sigmoidf_(bf2f((unsigned short)gp[1])); g0.z = sigmoidf_(bf2f((unsigned short)gp[2])); g0.w = sigmoidf_(bf2f((unsigned short)gp[3]));
            g1.x = sigmoidf_(bf2f((unsigned short)gp[4])); g1.y = sigmoidf_(bf2f((unsigned short)gp[5])); g1.z = sigmoidf_(bf2f((unsigned short)gp[6])); g1.w = sigmoidf_(bf2f((unsigned short)gp[7]));
            float* mp = MF + (size_t)row * DM + col;
            f32x4 r0 = v0 * g0, r1 = v1 * g1;
            if (br > 0) { r0 += *(const f32x4*)mp; r1 += *(const f32x4*)(mp + 4); }
            if (br < 2) { *(f32x4*)mp = r0; *(f32x4*)(mp + 4) = r1; }
            else *(u32x4*)(MB + (size_t)row * DM + col) = pack8(r0, r1);
        })
    }
};
struct EpiOut {
    const float* xin; const float* ctxin; float* X1; const float* mods; int l;
    DI void operator()(const f32x4 (&acc)[2][2][4][2], const Unit& u, int wr, int wc, int fr, int fq) const {
        EPI_FOREACH({
            const float* rp = (l == 0) ? (row < MLAT ? xin + (size_t)row * DM : ctxin + (size_t)(row - MLAT) * DM) : X1 + (size_t)row * DM;
            const float* gp = mods + ((size_t)(l * 5 + mods_row(row)) * 6 + 2) * DM + col;
            float* op = X1 + (size_t)row * DM + col;
            *(f32x4*)op = *(const f32x4*)(rp + col) + *(const f32x4*)gp * v0; *(f32x4*)(op + 4) = *(const f32x4*)(rp + col + 4) + *(const f32x4*)(gp + 4) * v1;
        })
    }
};
DI void phase_topk(const Frame& F, const Args& a, int l, int bid) {
    const float* AFF = (const float*)(F.ws + WS_AFF); const bf16_t* H = (const bf16_t*)(F.ws + WS_H);
    int* ROWS = (int*)(F.ws + WS_ROWS); float* VALS = (float*)(F.ws + WS_VALS); bf16_t* AG = (bf16_t*)(F.ws + WS_AG); int* TOK = (int*)(F.ws + WS_TOK);
    LAS float* vals = (LAS float*)F.lds; LAS int* lst = (LAS int*)(F.lds + 8192); LAS int* cnt = (LAS int*)(F.lds + 8192 + 4096);
    const int nitems = (l == 0) ? 256 + 64 + 16 : 256;
    for (int it = bid; it < nitems; it += F.G) {
        if (it >= 320) {
            const int e = it - 320;
            for (int s = F.tid; s < 128; s += NTHR) { ROWS[e * ESLOT + 1152 + s] = -1; VALS[e * ESLOT + 1152 + s] = 0.f; }
            u32x4* dst = (u32x4*)(AG + ((size_t)e * ESLOT + 1152) * DM);
            unsigned z = 0u; asm volatile("" : "+v"(z));
            for (int i = F.tid; i < 128 * DM / 8; i += NTHR) dst[i] = (u32x4){z, z, z, z};
            continue;
        }
        const int lat = it < 256, b = lat ? (it >> 6) : ((it - 256) >> 4), e = lat ? ((it >> 2) & 15) : ((it - 256) & 15), qtr = lat ? (it & 3) : 0;
        const int ntok = lat ? SEQ : CTXL, cap = ntok >> 3, rowbase = lat ? b * SEQ : MLAT + b * CTXL, slotbase = lat ? b * 256 : 1024 + b * 32;
        __syncthreads();
        for (int i = F.tid; i < ntok; i += NTHR) vals[i] = AFF[(size_t)(rowbase + i) * 16 + e];
        if (F.tid == 0) cnt[0] = 0;
        __syncthreads();
        {
            const int i = qtr * 512 + F.tid; const bool act = i < ntok; const float v = act ? vals[i] : 0.f; int rk = 0;
            for (int j = 0; j < ntok; j += 4) { const f32x4 vj = *(const LAS f32x4*)(vals + j);
                rk += (vj.x > v || (vj.x == v && j < i)) + (vj.y > v || (vj.y == v && j + 1 < i)) + (vj.z > v || (vj.z == v && j + 2 < i)) + (vj.w > v || (vj.w == v && j + 3 < i)); }
            if (act) { TOK[(size_t)(rowbase + i) * 16 + e] = rk < cap ? slotbase + rk : -1;
                if (rk < cap) { const int p = atomicAdd((int*)cnt, 1); lst[2 * p] = i; lst[2 * p + 1] = rk; ROWS[e * ESLOT + slotbase + rk] = rowbase + i; VALS[e * ESLOT + slotbase + rk] = v; } }
        }
        __syncthreads();
        const int n = cnt[0];
        for (int s = F.wave; s < n; s += 2 * NWAVES) {
            const int s2 = s + NWAVES; const bool two = s2 < n;
            const u32x4* src0 = (const u32x4*)(H + (size_t)(rowbase + lst[2 * s]) * DM); u32x4* dst0 = (u32x4*)(AG + ((size_t)e * ESLOT + slotbase + lst[2 * s + 1]) * DM);
            const u32x4* src1 = (const u32x4*)(H + (size_t)(rowbase + lst[2 * (two ? s2 : s)]) * DM); u32x4* dst1 = (u32x4*)(AG + ((size_t)e * ESLOT + slotbase + lst[2 * (two ? s2 : s) + 1]) * DM);
            u32x4 r0[4], r1[4];
#pragma unroll
            for (int q = 0; q < 4; ++q) { r0[q] = src0[F.lane + 64 * q]; r1[q] = src1[F.lane + 64 * q]; }
#pragma unroll
            for (int q = 0; q < 4; ++q) { dst0[F.lane + 64 * q] = r0[q]; dst1[F.lane + 64 * q] = r1[q]; }
        }
    }
    __syncthreads();
}
struct SchedMoe {
    const char* A; const char* Bt; int lda, ldb, nMt, nt, G, c;
    DI bool next(int i, Unit& u) const {
        const long L = (long)i * G + c; if (L >= (long)NEXP * nMt * 8) return false;
        const int e = (int)L / (nMt * 8), rem = (int)L % (nMt * 8), mt = rem % nMt, pn = rem / nMt;
        u.pm = e * 5 + mt; u.pn = pn; u.aux = e; u.nt = nt; u.pa = A + ((size_t)e * ESLOT + mt * 256) * lda; u.pb = Bt + ((size_t)e * 2048 + pn * 256) * ldb; return true;
    }
};
struct EpiMoe1 {
    bf16_t* ACT;
    DI void operator()(const f32x4 (&acc)[2][2][4][2], const Unit& u, int wr, int wc, int fr, int fq) const {
#pragma unroll
        for (int ai = 0; ai < 2; ++ai)
#pragma unroll
            for (int m = 0; m < 4; ++m) { const int row = u.pm * 256 + ai * 128 + wr * 64 + m * 16 + fr; const int col = u.pn * 128 + wc * 32 + 8 * fq;
                f32x4 r0, r1;
#pragma unroll
                for (int i = 0; i < 4; ++i) { r0[i] = siluf_(acc[ai][0][m][0][i]) * acc[ai][1][m][0][i]; r1[i] = siluf_(acc[ai][0][m][1][i]) * acc[ai][1][m][1][i]; }
                *(u32x4*)(ACT + (size_t)row * EFF + col) = pack8(r0, r1); }
    }
};
struct EpiMoe2 {
    const float* VALS; bf16_t* YE;
    DI void operator()(const f32x4 (&acc)[2][2][4][2], const Unit& u, int wr, int wc, int fr, int fq) const {
        EPI_FOREACH({ const float val = VALS[row]; *(u32x4*)(YE + (size_t)row * DM + col) = pack8(v0 * val, v1 * val); })
    }
};
DI void phase_final(const Frame& F, const Args& a) {
    const float* g = a.in[I_FNORM];
    for (int row = F.gw; row < MLAT; row += F.ngw) {
        f32x4 v[8]; float ss = 0.f;
        combine_row(F, DEPTH - 1, row, v);
#pragma unroll
        for (int j = 0; j < 8; ++j) ss += v[j].x * v[j].x + v[j].y * v[j].y + v[j].z * v[j].z + v[j].w * v[j].w;
        const float rs = rsqrtf(wave_sum(ss) * (1.f / DM) + EPS);
#pragma unroll
        for (int j = 0; j < 8; ++j) *(f32x4*)(a.out + (size_t)row * DM + 4 * F.lane + 256 * j) = v[j] * rs * *(const f32x4*)(g + 4 * F.lane + 256 * j);
    }
}

#ifndef MK_LAST_PHASE
#define MK_LAST_PHASE 1000
#endif
constexpr int PH_PER_LAYER = 12, N_PHASES = 2 + 2 * PH_PER_LAYER + 1;
__global__ void __launch_bounds__(NTHR, 2) mega(const Args args) {
    extern __shared__ __attribute__((aligned(16))) unsigned char lds[];
    Frame F0;
    F0.lds = (LAS unsigned char*)lds; F0.ws = args.ws;
    F0.tid = threadIdx.x; F0.lane = F0.tid & 63; F0.wave = __builtin_amdgcn_readfirstlane(F0.tid >> 6);
    F0.G = gridDim.x; { const int bx = blockIdx.x; F0.vcu = (F0.G % 8 == 0) ? (bx % 8) * (F0.G / 8) + bx / 8 : bx; }
    F0.gw = F0.vcu * NWAVES + F0.wave; F0.ngw = F0.G * NWAVES;
    volatile LAS unsigned* MISC = (volatile LAS unsigned*)(F0.lds + LDS_BYTES - 64);
    if (F0.tid < 16) MISC[F0.tid] = 0u;
    __syncthreads();
    unsigned* ctl = (unsigned*)(F0.ws + WS_CTL);
    XcdBarrier bar = xcd_barrier_post(ctl + CW_BAR, MISC + 8);
    const int lo = args.ph_lo, hi = args.ph_hi;
    int ph = 0, bid = 0;
#ifndef MK_EN
#define MK_EN 0xFFFF
#endif
#define EN(x) ((MK_EN >> (x)) & 1)
#ifndef MK_REP
#define MK_REP 0
#endif
#ifndef MK_BARX
#define MK_BARX 0
#endif
#define REP(pid_) ((MK_REP >> (pid_)) & 1)
#define PHASE(pid_, ...) if (EN(pid_) && lo <= ph && ph < hi) { Frame F = F0; { unsigned long long w_ = (unsigned long long)F0.ws; asm volatile("" : "+s"(w_)); F.ws = (unsigned char*)w_; \
        asm volatile("" : "+s"(F.G), "+s"(F.vcu)); F.ngw = F.G * NWAVES; bid = blockIdx.x; asm volatile("" : "+s"(bid)); \
        int t_ = threadIdx.x; asm volatile("" : "+v"(t_)); F.tid = t_; F.lane = t_ & 63; F.wave = __builtin_amdgcn_readfirstlane(t_ >> 6); F.gw = F.vcu * NWAVES + F.wave; } \
        { const int rep = 0; (void)rep; __VA_ARGS__ } if (REP(pid_)) { const int rep = 1; (void)rep; __VA_ARGS__ } \
        if (ph + 1 < hi) { xcd_barrier(bar); if (MK_BARX) xcd_barrier(bar); } } ++ph;

#define PHASE5(...) if (EN(5) && lo <= ph && ph < hi) { Frame F = F0; { unsigned long long w_ = (unsigned long long)F0.ws; asm volatile("" : "+s"(w_)); F.ws = (unsigned char*)w_; \
        asm volatile("" : "+s"(F.G), "+s"(F.vcu)); F.ngw = F.G * NWAVES; bid = blockIdx.x; asm volatile("" : "+s"(bid)); \
        int t_ = threadIdx.x; asm volatile("" : "+v"(t_)); F.tid = t_; F.lane = t_ & 63; F.wave = __builtin_amdgcn_readfirstlane(t_ >> 6); F.gw = F.vcu * NWAVES + F.wave; } \
        { __VA_ARGS__ } if (ph + 1 < hi) { xcd_barrier(bar); if (MK_BARX) xcd_barrier(bar); } } ++ph;
    PHASE(0, phase_prologue(F, args, rep);)
    PHASE(14, phase_mods_reduce(F, args);)
    for (int l = 0; l < DEPTH; ++l) {
        const size_t wlo = WS_W + (size_t)l * W_LAYER;
        const int nM = (l == 0) ? 36 : 32;
        PHASE(1, phase_mod1(F, args, l);)
        PHASE(2, {
            SchedProj S{(const char*)(F.ws + WS_H), (const char*)(F.ws + wlo + W_IN), l, F.G, bid};
            EpiProj E{(bf16_t*)(F.ws + WS_P), (float*)(F.ws + WS_X80)};
            pg8::gemm_phase(F.lds, DM * 2, DM * 2, S, E); })
        PHASE(3, phase_postproj(F, args, l);)
        PHASE(4, {
            { SchedDense S{(const char*)(F.ws + WS_CQN), (const char*)(F.ws + wlo + W_UQ), 512 * 2, 512 * 2, nM, 6, 8, F.G, bid};
              EpiStoreBf16 E{(bf16_t*)(F.ws + WS_QLA), 1536}; pg8::gemm_phase(F.lds, 512 * 2, 512 * 2, S, E); }
            { SchedDense S{(const char*)(F.ws + WS_CKVN), (const char*)(F.ws + wlo + W_UKV), 256 * 2, 256 * 2, 36, 8, 4, F.G, (bid + 128) % F.G};
              EpiStoreBf16 E{(bf16_t*)(F.ws + WS_KVLA), 2048}; pg8::gemm_phase(F.lds, 256 * 2, 256 * 2, S, E); } })
        PHASE5(phase_mixers(F, args, l, (char*)lds, 1 + REP(5)); phase_convert_tail(F, args, l);)
        PHASE(6, phase_mlfin(F, args, l, nM * 256);)
        PHASE(7, {
            SchedMerge S{(const char*)(F.ws + WS_YCAT), (const char*)(F.ws + wlo + W_BR), nM, F.G, bid};
            EpiMerge E{(const bf16_t*)(F.ws + WS_P), (float*)(F.ws + WS_MF32), (bf16_t*)(F.ws + WS_MBF)};
            pg8::gemm_phase(F.lds, 3072 * 2, 1024 * 2, S, E); })
        PHASE(8, {
            SchedDense S{(const char*)(F.ws + WS_MBF), (const char*)(F.ws + wlo + W_OUT), DM * 2, DM * 2, nM, 8, 32, F.G, bid};
            EpiOut E{args.in[I_X], args.in[I_CTX], (float*)(F.ws + WS_X1), (const float*)(F.ws + WS_MODS), l};
            if (rep == 0 || l == 0) pg8::gemm_phase(F.lds, DM * 2, DM * 2, S, E); })
        PHASE(9, phase_mod2(F, args, l, nM * 256);)
        PHASE(10, phase_topk(F, args, l, bid);)
        PHASE(11, {
            SchedMoe S{(const char*)(F.ws + WS_AG), (const char*)(F.ws + wlo + W_E13), DM * 2, DM * 2, (l == 0) ? 5 : 4, 32, F.G, bid};
            EpiMoe1 E{(bf16_t*)(F.ws + WS_ACT)};
            pg8::gemm_phase(F.lds, DM * 2, DM * 2, S, E); })
        PHASE(12, {
            SchedMoe S{(const char*)(F.ws + WS_ACT), (const char*)(F.ws + wlo + W_E2), EFF * 2, EFF * 2, (l == 0) ? 5 : 4, 16, F.G, bid};
            EpiMoe2 E{(const float*)(F.ws + WS_VALS), (bf16_t*)(F.ws + WS_YE)};
            pg8::gemm_phase(F.lds, EFF * 2, EFF * 2, S, E); })
    }
    PHASE(13, phase_final(F, args);)
#undef PHASE
}


extern "C" void kernel_launch(void* const* d_in, const int* in_sizes, int n_in, void* d_out, int out_size, void* d_ws, size_t ws_size, hipStream_t stream) {
    static int grid = 0;
    if (grid == 0) {
        if (n_in != 24 || out_size != MLAT * DM || ws_size < WS_END) { fprintf(stderr, "kernel_launch: unexpected shapes: n_in %d out %d ws %zu (need %zu)\n", n_in, out_size, ws_size, (size_t)WS_END); grid = -1; return; }
        int dev = 0, cus = 0, per_cu = 0;
        if (hipGetDevice(&dev) != hipSuccess || hipDeviceGetAttribute(&cus, hipDeviceAttributeMultiprocessorCount, dev) != hipSuccess) { grid = -1; return; }
        if (hipFuncSetAttribute((const void*)mega, hipFuncAttributeMaxDynamicSharedMemorySize, LDS_BYTES) != hipSuccess) { fprintf(stderr, "kernel_launch: hipFuncSetAttribute failed\n"); grid = -1; return; }
        if (hipOccupancyMaxActiveBlocksPerMultiprocessor(&per_cu, (const void*)mega, NTHR, LDS_BYTES) != hipSuccess || per_cu < 1) { fprintf(stderr, "kernel_launch: occupancy query says %d blocks per CU\n", per_cu); }
        (void)hipGetLastError();
        grid = cus;
    }
    if (grid < 0) return;
    if (hipMemsetAsync((char*)d_ws + WS_CTL, 0, CTL_BYTES, stream) != hipSuccess) return;
    Args a{};
    for (int i = 0; i < 24; ++i) a.in[i] = (const float*)d_in[i];
    a.out = (float*)d_out; a.ws = (unsigned char*)d_ws; a.ph_lo = 0; a.ph_hi = N_PHASES < MK_LAST_PHASE ? N_PHASES : MK_LAST_PHASE;
    hipLaunchKernelGGL(mega, dim3(grid), dim3(NTHR), LDS_BYTES, stream, a);
}
```

```cpp
#include <hip/hip_runtime.h>
#include <cstdio>
#include <cstdint>

#define GAS __attribute__((address_space(1)))
#define LAS __attribute__((address_space(3)))
#define DI __device__ __forceinline__
typedef unsigned short bf16_t;
typedef short bf16x8 __attribute__((ext_vector_type(8)));
typedef short s16x4 __attribute__((ext_vector_type(4)));
typedef float f32x2 __attribute__((ext_vector_type(2)));
typedef float f32x4 __attribute__((ext_vector_type(4)));
typedef float f32x8 __attribute__((ext_vector_type(8)));
typedef float f32x16 __attribute__((ext_vector_type(16)));
typedef unsigned u32x2 __attribute__((ext_vector_type(2)));
typedef unsigned u32x4 __attribute__((ext_vector_type(4)));

constexpr int DM = 2048, NBATCH = 4, SEQ = 2048, CTXL = 256, DEPTH = 2;
constexpr int MLAT = NBATCH * SEQ, MCTX = NBATCH * CTXL, MTOT = MLAT + MCTX;
constexpr int PROJW = 12624, NP = 12800;
constexpr int C_MLQ = 0, C_MLK = 1024, C_MLV = 2048, C_MLO = 3072, C_CQ = 4096, C_CKV = 4608, C_GQ = 4864, C_GK = 5888, C_GV = 6144, C_GATE = 6400, C_X = 12544;
constexpr int XW = 80;
constexpr int NEXP = 16, EFF = 1024, ESLOT = 1280;
constexpr float EPS = 1e-6f;
constexpr int NWAVES = 8, NTHR = 512;

constexpr size_t al256(size_t x) { return (x + 255) / 256 * 256; }
constexpr size_t WS_CTL = 0, CTL_BYTES = 2u << 20;
constexpr int CW_BAR = 1024;
constexpr int CW_QUEUE = 8192;
constexpr size_t WS_MODS = 1u << 20;
constexpr size_t WS_ROPE_LA = WS_CTL + CTL_BYTES;
constexpr size_t WS_ROPE_GA = WS_ROPE_LA + al256((size_t)2048 * 32 * 2 * 4);
constexpr size_t WS_W = WS_ROPE_GA + al256((size_t)2048 * 64 * 2 * 4);
constexpr size_t W_IN = 0, W_UQ = W_IN + (size_t)NP * DM * 2, W_UKV = W_UQ + (size_t)1536 * 512 * 2, W_BR = W_UKV + (size_t)2048 * 256 * 2,
                 W_OUT = W_BR + (size_t)3 * 2048 * 1024 * 2, W_E13 = W_OUT + (size_t)2048 * 2048 * 2, W_E2 = W_E13 + (size_t)NEXP * 2048 * 2048 * 2,
                 W_LAYER = W_E2 + (size_t)NEXP * 2048 * 1024 * 2;
constexpr size_t WS_H = WS_W + 2 * W_LAYER;
constexpr size_t WS_P = WS_H + (size_t)MTOT * DM * 2;
constexpr size_t WS_AG = WS_P;
constexpr size_t WS_ACT = WS_AG + (size_t)NEXP * ESLOT * DM * 2;
static_assert(WS_ACT + (size_t)NEXP * ESLOT * EFF * 2 <= WS_P + (size_t)MTOT * NP * 2, "overlay");
constexpr size_t WS_X80 = WS_P + (size_t)MTOT * NP * 2;
constexpr size_t WS_CQN = WS_X80 + al256((size_t)MTOT * XW * 4);
constexpr size_t WS_CKVN = WS_CQN + (size_t)MTOT * 512 * 2;
constexpr size_t WS_QG = WS_CKVN + (size_t)MTOT * 256 * 2;
constexpr size_t WS_KG = WS_QG + (size_t)MTOT * 1024 * 2;
constexpr size_t WS_KR = WS_KG + (size_t)MTOT * 256 * 2;
constexpr size_t WS_QLA = WS_KR + (size_t)MTOT * 64 * 2;
constexpr size_t WS_KVLA = WS_QLA + (size_t)MTOT * 1536 * 2;
constexpr size_t WS_YCAT = WS_KVLA + (size_t)MTOT * 2048 * 2;
constexpr size_t WS_MF32 = WS_YCAT + (size_t)MTOT * 3072 * 2;
constexpr size_t WS_MLH = WS_MF32;
constexpr size_t WS_MBF = WS_MF32 + (size_t)MTOT * DM * 4;
constexpr size_t WS_X1 = WS_MBF + (size_t)MTOT * DM * 2;
constexpr size_t WS_AFF = WS_X1 + (size_t)MTOT * DM * 4;
constexpr size_t WS_ROWS = WS_AFF + (size_t)MTOT * 16 * 4;
constexpr size_t WS_VALS = WS_ROWS + (size_t)NEXP * ESLOT * 4;
constexpr size_t WS_TOK = WS_VALS + (size_t)NEXP * ESLOT * 4;
constexpr size_t WS_MPART = WS_TOK + (size_t)MTOT * 16 * 4;
constexpr size_t WS_END = WS_MPART + (size_t)16 * 2 * 5 * 12288 * 4;
constexpr size_t WS_YE = WS_AG;

constexpr int RING_BYTES = 131072;
constexpr int MISC_OFF = RING_BYTES + 1024;
constexpr int LDS_BYTES = 147456;

DI float bf2f(unsigned short b) { return __uint_as_float(((unsigned)b) << 16); }
DI unsigned f2bf(float f) { unsigned u = __float_as_uint(f); return (u + 0x7fffu + ((u >> 16) & 1u)) >> 16; }
DI unsigned pk2(float lo, float hi) { unsigned r; asm volatile("v_cvt_pk_bf16_f32 %0, %1, %2" : "=v"(r) : "v"(lo), "v"(hi)); return r; }
DI float wave_sum(float v) {
#pragma unroll
    for (int o = 1; o < 64; o <<= 1) v += __shfl_xor(v, o);
    return v;
}
DI float wave_max(float v) {
#pragma unroll
    for (int o = 1; o < 64; o <<= 1) v = fmaxf(v, __shfl_xor(v, o));
    return v;
}
DI float sigmoidf_(float x) { return 1.f / (1.f + __expf(-x)); }
DI float siluf_(float x) { return x / (1.f + __expf(-x)); }
#define LDS_WAIT() asm volatile("s_waitcnt lgkmcnt(0)" ::: "memory")
#define VM_WAIT() asm volatile("s_waitcnt vmcnt(0)" ::: "memory")

#define XB_TMO      128
#define XB_XCNT(j)  (256  + 64 * (j))
#define XB_XSUB(j)  (1280 + 64 * (j))
#define XB_XGEN(j)  (2304 + 64 * (j))
#define XB_TOP      3328
#define XB_TOPGEN   3392
#define XCD_BAR_WORDS 3456
#define XB_SPIN_CAP (1u << 20)

DI unsigned xb_ld(unsigned* p)              { return __hip_atomic_load(p, __ATOMIC_RELAXED, __HIP_MEMORY_SCOPE_AGENT); }
DI unsigned xb_add(unsigned* p, unsigned v) { return __hip_atomic_fetch_add(p, v, __ATOMIC_RELAXED, __HIP_MEMORY_SCOPE_AGENT); }
DI unsigned xb_xcc_id() { return (unsigned)__builtin_amdgcn_s_getreg((3 << 11) | 20) & 0xFu; }
#define XB_SPIN(cond, bar) do { unsigned _sp = 0; while (cond) { __builtin_amdgcn_s_sleep(1); \
    if ((++_sp & 255u) == 0u) { if (xb_ld(&(bar)[XB_TMO])) break; if (_sp > XB_SPIN_CAP) { atomicAdd(&(bar)[XB_TMO], 1u); break; } } } } while (0)

struct XcdBarrier { unsigned* bar; unsigned x; volatile LAS unsigned* st; };

DI XcdBarrier xcd_barrier_post(unsigned* bar, volatile LAS unsigned* st) {
    XcdBarrier b; b.bar = bar; b.x = xb_xcc_id(); b.st = st;
    if (threadIdx.x == 0) (void)xb_add(&bar[XB_XCNT(b.x)], 1u);
    return b;
}
DI void xcd_barrier_complete(unsigned* bar, unsigned x, unsigned& nloc, unsigned& nx) {
    const unsigned G = gridDim.x * gridDim.y * gridDim.z;
    unsigned sum, cnt, mine, sp = 0u;
    for (;;) {
        sum = 0u; cnt = 0u; mine = 0u;
#pragma unroll
        for (unsigned j = 0; j < 16; ++j) { const unsigned c = xb_ld(&bar[XB_XCNT(j)]); sum += c; cnt += (c > 0u) ? 1u : 0u; mine = (j == x) ? c : mine; }
        if (sum == G) break;
        __builtin_amdgcn_s_sleep(1);
        if ((++sp & 255u) == 0u) { if (xb_ld(&bar[XB_TMO])) break; if (sp > XB_SPIN_CAP) { atomicAdd(&bar[XB_TMO], 1u); break; } }
    }
    nloc = mine > 0u ? mine : 1u; nx = cnt > 0u ? cnt : 1u;
}
DI void xcd_barrier(const XcdBarrier& b) {
    asm volatile("s_waitcnt vmcnt(0)" ::: "memory");
    __syncthreads();
    if (threadIdx.x == 0) {
        unsigned* bar = b.bar; asm volatile("" : "+s"(bar));
        __builtin_amdgcn_s_waitcnt(0);
        unsigned nloc = b.st[0], nx = b.st[1];
        unsigned bx = b.x; asm volatile("" : "+s"(bx));
        if (nloc == 0u) { xcd_barrier_complete(bar, bx, nloc, nx); b.st[0] = nloc; b.st[1] = nx; }
        const unsigned old = xb_add(&bar[XB_XSUB(bx)], 1u);
        const unsigned gen = old / nloc;
        if (old + 1u == (gen + 1u) * nloc) {
            __builtin_amdgcn_fence(__ATOMIC_RELEASE, "agent");
            asm volatile("s_waitcnt vmcnt(0)" ::: "memory");
            const unsigned og = xb_add(&bar[XB_TOP], 1u);
            const unsigned tg = og / nx;
            if (og + 1u == (tg + 1u) * nx) xb_add(&bar[XB_TOPGEN], 1u);
            else XB_SPIN(xb_ld(&bar[XB_TOPGEN]) == tg, bar);
            __builtin_amdgcn_fence(__ATOMIC_ACQUIRE, "agent");
            xb_add(&bar[XB_XGEN(bx)], 1u);
            asm volatile("s_waitcnt vmcnt(0)" ::: "memory");
        } else {
            XB_SPIN(xb_ld(&bar[XB_XGEN(bx)]) == gen, bar);
            __builtin_amdgcn_fence(__ATOMIC_ACQUIRE, "agent");
            asm volatile("s_waitcnt vmcnt(0)" ::: "memory");
        }
    }
    __syncthreads();
}

struct Args { const float* in[24]; float* out; unsigned char* ws; int ph_lo, ph_hi; };
enum { I_X = 0, I_C, I_CTX, I_CCTX, I_WMOD, I_BMOD, I_WIN, I_GBIAS, I_MLNORM, I_LAQN, I_LAKVN, I_UQ, I_UKV, I_GAQN, I_GAKN, I_BRML, I_BRLA, I_BRGA, I_WOUT, I_WROUTER, I_WE1, I_WE3, I_WE2, I_FNORM };

struct Frame {
    LAS unsigned char* lds;
    unsigned char* ws;
    int tid, lane, wave, G, vcu, gw, ngw;
};

DI int mods_row(int row) { return row < MLAT ? (row >> 11) : 4; }
DI const float* mods_ptr(const Frame& F, int l, int row, int which  ) {
    return (const float*)(F.ws + WS_MODS) + ((size_t)(l * 5 + mods_row(row)) * 6 + which) * DM;
}

namespace pg8 {
constexpr int BM = 256, BK = 64, HALF = 128, HTB = HALF * BK * 2, STAGE_BYTES = 8 * HTB, NXCD = 8, WGM = 8;
__host__ __device__ __forceinline__ int lds_byte(int r, int c) { const int st = (r >> 4) * 2 + (c >> 5), rr = r & 15, cc = c & 31, ob = rr * 64 + cc * 2; return st * 1024 + (ob ^ (((ob >> 9) & 1) << 5)); }
__host__ __device__ __forceinline__ void stage_rc(int b, int& R, int& C) { const int st = b / 1024, sb = b % 1024, swz = sb ^ (((sb >> 9) & 1) << 5); R = (st >> 1) * 16 + swz / 64; C = (st & 1) * 32 + (swz % 64) / 2; }
__host__ __device__ __forceinline__ int perm32(int rho) { const int n = rho >> 4, i = rho & 15; return 8 * (i >> 2) + 4 * n + (i & 3); }

struct Unit { const char* pa; const char* pb; int pm, pn, aux, nt; };

DI void tile_of(int L, int nM, int nN, int& pm, int& pn) {
    const int nwg = nM * nN; int wgid = L;
    { const int q = nwg / NXCD, r = nwg % NXCD, xcd = wgid % NXCD, off = wgid / NXCD; wgid = (xcd < r ? xcd * (q + 1) : r * (q + 1) + (xcd - r) * q) + off; }
    const int nig = WGM * nN, gid = wgid / nig, fm = gid * WGM, gsz = (nM - fm) < WGM ? (nM - fm) : WGM;
    pm = fm + ((wgid % nig) % gsz); pn = (wgid % nig) / gsz;
}

template <class Epi, class Sched>
DI void gemm_phase(LAS unsigned char* lds, const int lda  , const int ldb  , const Sched& S, const Epi& E) {
    int tid = threadIdx.x; asm volatile("" : "+v"(tid));
    const int wid = __builtin_amdgcn_readfirstlane(tid >> 6), lane = tid & 63, wr = wid >> 2, wc = wid & 3, fr = lane & 15, fq = lane >> 4;
    unsigned voffA[2], voffB[2];
#pragma unroll
    for (int i = 0; i < 2; ++i) { int R, C; stage_rc(tid * 16 + i * 8192, R, C); const int Rb = (R & ~31) + perm32(R & 31);
        voffA[i] = (unsigned)(R * lda + C * 2); voffB[i] = (unsigned)(Rb * ldb + C * 2); }
    const size_t kstep = (size_t)(BK * 2);
    const size_t hstepA = (size_t)HALF * lda, hstepB = (size_t)HALF * ldb;
    const unsigned ldsw = (unsigned)wid * 1024u;
    const int aoff = lds_byte(wr * 64 + fr, fq * 8), boff = lds_byte(wc * 32 + fr, fq * 8);
#define PG8_SA(b, h) (((b) * 2 + (h)) * HTB)
#define PG8_SB(b, h) ((4 + (b) * 2 + (h)) * HTB)
#define PG8_STAGE(bufoff, gbase, voff) do { _Pragma("unroll") for (int _i = 0; _i < 2; ++_i) \
        __builtin_amdgcn_global_load_lds((const unsigned*)((const char*)(gbase) + (voff)[_i]), (LAS unsigned*)(lds + (bufoff) + ldsw + _i * 8192), 16, 0, 0); } while (0)
#define PG8_LDA(dst, b, h) do { _Pragma("unroll") for (int m = 0; m < 4; ++m) _Pragma("unroll") for (int k = 0; k < 2; ++k) dst[m][k] = *(const LAS bf16x8*)(lds + PG8_SA(b, h) + aoff + m * 2048 + k * 1024); } while (0)
#define PG8_LDB(dst, b, h) do { _Pragma("unroll") for (int n = 0; n < 2; ++n) _Pragma("unroll") for (int k = 0; k < 2; ++k) dst[n][k] = *(const LAS bf16x8*)(lds + PG8_SB(b, h) + boff + n * 2048 + k * 1024); } while (0)
#define PG8_MMA(ai, bj, At, Bt) do { __builtin_amdgcn_s_setprio(1); _Pragma("unroll") for (int m = 0; m < 4; ++m) _Pragma("unroll") for (int n = 0; n < 2; ++n) _Pragma("unroll") for (int k = 0; k < 2; ++k) \
        acc[ai][bj][m][n] = __builtin_amdgcn_mfma_f32_16x16x32_bf16(Bt[n][k], At[m][k], acc[ai][bj][m][n], 0, 0, 0); __builtin_amdgcn_s_setprio(0); } while (0)
#define PG8_WAIT_V(n) asm volatile("s_waitcnt vmcnt(" #n ")" ::: "memory")
#define PG8_WAIT_L(n) asm volatile("s_waitcnt lgkmcnt(" #n ")" ::: "memory")
#define PG8_BAR __builtin_amdgcn_s_barrier()
#define PG8_SCHED __builtin_amdgcn_sched_barrier(0)
    Unit cur, nxt; int ui = 0;
    if (!S.next(0, cur)) return;
    f32x4 acc[2][2][4][2];
#pragma unroll
    for (int a = 0; a < 2; ++a)
#pragma unroll
        for (int b = 0; b < 2; ++b)
#pragma unroll
            for (int m = 0; m < 4; ++m)
#pragma unroll
                for (int n = 0; n < 2; ++n) acc[a][b][m][n] = (f32x4){0.f, 0.f, 0.f, 0.f};
    bf16x8 At[4][2], B0[2][2], B1[2][2];
    const char* cA = cur.pa; const char* cB = cur.pb;
    PG8_STAGE(PG8_SB(0, 0), cB, voffB); PG8_STAGE(PG8_SA(0, 0), cA, voffA); PG8_STAGE(PG8_SB(0, 1), cB + hstepB, voffB); PG8_STAGE(PG8_SA(0, 1), cA + hstepA, voffA);
    if (wr == 1) PG8_BAR;
    PG8_WAIT_V(4); PG8_BAR;
    PG8_STAGE(PG8_SB(1, 0), cB + kstep, voffB); PG8_STAGE(PG8_SA(1, 0), cA + kstep, voffA); PG8_STAGE(PG8_SB(1, 1), cB + hstepB + kstep, voffB);
    PG8_WAIT_V(6); PG8_BAR;
    for (;;) {
        const bool has_next = S.next(ui + 1, nxt);
        const char* nA = has_next ? nxt.pa : cA; const char* nB = has_next ? nxt.pb : cB;
        const int nt = cur.nt;
        for (int t = 0; t < nt; t += 2) {
            const bool last = (t == nt - 2);
            const char* a1 = cA + (size_t)(t + 1) * kstep;
            const char* a2 = last ? nA : cA + (size_t)(t + 2) * kstep; const char* b2 = last ? nB : cB + (size_t)(t + 2) * kstep;
            const char* a3 = a2 + kstep; const char* b3 = b2 + kstep;
            PG8_LDB(B0, 0, 0); PG8_SCHED; PG8_LDA(At, 0, 0); PG8_STAGE(PG8_SA(1, 1), a1 + hstepA, voffA);
            PG8_WAIT_L(8); PG8_BAR; PG8_WAIT_L(0); PG8_MMA(0, 0, At, B0); PG8_BAR; PG8_SCHED;
            PG8_LDB(B1, 0, 1); PG8_STAGE(PG8_SB(0, 0), b2, voffB);
            PG8_BAR; PG8_WAIT_L(0); PG8_MMA(0, 1, At, B1); PG8_BAR;
            PG8_LDA(At, 0, 1); PG8_STAGE(PG8_SA(0, 0), a2, voffA);
            PG8_BAR; PG8_WAIT_L(0); PG8_MMA(1, 0, At, B0); PG8_BAR; PG8_SCHED;
            PG8_STAGE(PG8_SB(0, 1), b2 + hstepB, voffB);
            PG8_WAIT_V(6); PG8_BAR; PG8_MMA(1, 1, At, B1); PG8_BAR;
            PG8_LDB(B0, 1, 0); PG8_SCHED; PG8_LDA(At, 1, 0); PG8_STAGE(PG8_SA(0, 1), a2 + hstepA, voffA);
            PG8_WAIT_L(8); PG8_BAR; PG8_WAIT_L(0); PG8_MMA(0, 0, At, B0); PG8_BAR; PG8_SCHED;
            PG8_LDB(B1, 1, 1); PG8_STAGE(PG8_SB(1, 0), b3, voffB);
            PG8_BAR; PG8_WAIT_L(0); PG8_MMA(0, 1, At, B1); PG8_BAR;
            PG8_LDA(At, 1, 1); PG8_STAGE(PG8_SA(1, 0), a3, voffA);
            PG8_BAR; PG8_WAIT_L(0); PG8_MMA(1, 0, At, B0); PG8_BAR; PG8_SCHED;
            PG8_STAGE(PG8_SB(1, 1), b3 + hstepB, voffB);
            PG8_WAIT_V(6); PG8_BAR; PG8_MMA(1, 1, At, B1); PG8_BAR;
        }
        E(acc, cur, wr, wc, fr, fq);
        if (!has_next) break;
#pragma unroll
        for (int a = 0; a < 2; ++a)
#pragma unroll
            for (int b = 0; b < 2; ++b)
#pragma unroll
                for (int m = 0; m < 4; ++m)
#pragma unroll
                    for (int n = 0; n < 2; ++n) acc[a][b][m][n] = (f32x4){0.f, 0.f, 0.f, 0.f};
        cur = nxt; cA = nA; cB = nB; ++ui;
    }
    PG8_WAIT_V(0);
    if (wr == 0) PG8_BAR;
    PG8_BAR;
#undef PG8_SA
#undef PG8_SB
#undef PG8_STAGE
#undef PG8_LDA
#undef PG8_LDB
#undef PG8_MMA
#undef PG8_WAIT_V
#undef PG8_WAIT_L
#undef PG8_BAR
#undef PG8_SCHED
}
}
using pg8::Unit;

struct SchedDense {
    const char* A; const char* Bt; int lda, ldb, nM, nN, nt, G, c;
    DI bool next(int i, Unit& u) const {
        const long L = (long)i * G + c; if (L >= (long)nM * nN) return false;
        int pm, pn; pg8::tile_of((int)L, nM, nN, pm, pn);
        u.pm = pm; u.pn = pn; u.aux = 0; u.nt = nt; u.pa = A + (size_t)pm * 256 * lda; u.pb = Bt + (size_t)pn * 256 * ldb; return true;
    }
};

struct SchedProj {
    const char* A; const char* Bt; int l, G, c;
    DI bool next(int i, Unit& u) const {
        const long L = (long)i * G + c; int pm, pn;
        if (l == 0) { if (L >= 36 * 50) return false; pg8::tile_of((int)L, 36, 50, pm, pn); }
        else { if (L >= 32 * 50 + 48) return false;
            if (L < 32 * 50) pg8::tile_of((int)L, 32, 50, pm, pn);
            else { const int r = (int)L - 32 * 50, j = r % 12; pm = 32 + r / 12; pn = j < 8 ? 4 + j : (j == 8 ? 18 : (j == 9 ? 23 : (j == 10 ? 24 : 49))); } }
        u.pm = pm; u.pn = pn; u.aux = 0; u.nt = 32; u.pa = A + (size_t)pm * 256 * (DM * 2); u.pb = Bt + (size_t)pn * 256 * (DM * 2); return true;
    }
};

#define EPI_FOREACH(...) \
    _Pragma("unroll") for (int ai = 0; ai < 2; ++ai) _Pragma("unroll") for (int m = 0; m < 4; ++m) { const int row = u.pm * 256 + ai * 128 + wr * 64 + m * 16 + fr; \
    _Pragma("unroll") for (int bj = 0; bj < 2; ++bj) { const int col = u.pn * 256 + bj * 128 + wc * 32 + 8 * fq; const f32x4 v0 = acc[ai][bj][m][0], v1 = acc[ai][bj][m][1]; __VA_ARGS__ } }

DI u32x4 pack8(const f32x4 v0, const f32x4 v1) { u32x4 w; w.x = pk2(v0[0], v0[1]); w.y = pk2(v0[2], v0[3]); w.z = pk2(v1[0], v1[1]); w.w = pk2(v1[2], v1[3]); return w; }

struct EpiStoreBf16 {
    bf16_t* O; int ldc;
    DI void operator()(const f32x4 (&acc)[2][2][4][2], const Unit& u, int wr, int wc, int fr, int fq) const {
        EPI_FOREACH({ *(u32x4*)(O + (size_t)row * ldc + col) = pack8(v0, v1); })
    }
};
struct EpiProj {
    bf16_t* P; float* X80;
    DI void operator()(const f32x4 (&acc)[2][2][4][2], const Unit& u, int wr, int wc, int fr, int fq) const {
        if (u.pn < 49) { EPI_FOREACH({ *(u32x4*)(P + (size_t)row * NP + col) = pack8(v0, v1); }) }
        else {
            EPI_FOREACH({ const int c = col - C_X; if (bj == 0 && c < XW) { *(f32x4*)(X80 + (size_t)row * XW + c) = v0; *(f32x4*)(X80 + (size_t)row * XW + c + 4) = v1; } })
        }
    }
};

DI int win_src_col(int n) {
    if (n < 4096) return n;
    if (n < 4608) return n - 4096 + 4112;
    if (n < 4864) return n - 4608 + 4624;
    if (n < 5888) return n - 4864 + 4944;
    if (n < 6144) return n - 5888 + 5968;
    if (n < 6400) return n - 6144 + 6224;
    if (n < 12544) return n - 6400 + 6480;
    if (n < 12608) return n - 12544 + 4880;
    if (n < 12624) return n - 12608 + 4096;
    return -1;
}
DI void transpose_item(const float* W, int ldw, int K, bf16_t* WT, int k0, int n0, int srcc, LAS float* scr, int lane) {
#pragma unroll 8
    for (int i = 0; i < 32; ++i) { const int kk = 2 * i + (lane >> 5); scr[kk * 33 + (lane & 31)] = srcc >= 0 ? W[(size_t)(k0 + kk) * ldw + srcc] : 0.f; }
    LDS_WAIT(); asm volatile("" ::: "memory");
    const int c = lane & 7;
#pragma unroll
    for (int j = 0; j < 4; ++j) { const int n = (lane >> 3) + 8 * j; const LAS float* s = scr + (8 * c) * 33 + n;
        u32x4 o; o.x = pk2(s[0 * 33], s[1 * 33]); o.y = pk2(s[2 * 33], s[3 * 33]); o.z = pk2(s[4 * 33], s[5 * 33]); o.w = pk2(s[6 * 33], s[7 * 33]);
        *(u32x4*)(WT + (size_t)(n0 + n) * K + k0 + 8 * c) = o; }
    LDS_WAIT(); asm volatile("" ::: "memory");
}

constexpr int IT_IN = 32 * 400, IT_UQ = 8 * 48, IT_UKV = 4 * 64, IT_BR = 16 * 64, IT_OUT = 32 * 64, IT_E13 = 32 * 64, IT_E2 = 16 * 64;
constexpr int IT_EARLY = IT_IN + IT_UQ + IT_UKV, IT_LAYER = IT_EARLY + 3 * IT_BR + IT_OUT + NEXP * IT_E13 + NEXP * IT_E2;
DI void convert_item(const Frame& F, const Args& a, int l, int r, LAS float* scr) {
    unsigned char* wl = F.ws + WS_W + (size_t)l * W_LAYER;
    const int ln = F.lane & 31;
    if (r < IT_IN) { const int kb = r / 400, nb = r % 400; transpose_item(a.in[I_WIN] + (size_t)l * DM * PROJW, PROJW, DM, (bf16_t*)(wl + W_IN), 64 * kb, 32 * nb, win_src_col(32 * nb + ln), scr, F.lane); return; } r -= IT_IN;
    if (r < IT_UQ) { const int kb = r / 48, nb = r % 48; transpose_item(a.in[I_UQ] + (size_t)l * 512 * 1536, 1536, 512, (bf16_t*)(wl + W_UQ), 64 * kb, 32 * nb, 32 * nb + ln, scr, F.lane); return; } r -= IT_UQ;
    if (r < IT_UKV) { const int kb = r / 64, nb = r % 64; transpose_item(a.in[I_UKV] + (size_t)l * 256 * 2048, 2048, 256, (bf16_t*)(wl + W_UKV), 64 * kb, 32 * nb, 32 * nb + ln, scr, F.lane); return; } r -= IT_UKV;
    if (r < 3 * IT_BR) { const int br = r / IT_BR, q = r % IT_BR, kb = q / 64, nb = q % 64;
        transpose_item(a.in[I_BRML + br] + (size_t)l * 1024 * 2048, 2048, 1024, (bf16_t*)(wl + W_BR) + (size_t)br * 2048 * 1024, 64 * kb, 32 * nb, 32 * nb + ln, scr, F.lane); return; } r -= 3 * IT_BR;
    if (r < IT_OUT) { const int kb = r / 64, nb = r % 64; transpose_item(a.in[I_WOUT] + (size_t)l * 2048 * 2048, 2048, 2048, (bf16_t*)(wl + W_OUT), 64 * kb, 32 * nb, 32 * nb + ln, scr, F.lane); return; } r -= IT_OUT;
    if (r < NEXP * IT_E13) { const int e = r / IT_E13, q = r % IT_E13, kb = q / 64, nb = q % 64;
        const int n0 = 32 * nb, j = n0 >> 8, half = (n0 >> 7) & 1, cc = n0 & 127;
        transpose_item(a.in[half ? I_WE3 : I_WE1] + ((size_t)l * NEXP + e) * 2048 * 1024, 1024, 2048, (bf16_t*)(wl + W_E13) + (size_t)e * 2048 * 2048, 64 * kb, n0, j * 128 + cc + ln, scr, F.lane); return; } r -= NEXP * IT_E13;
    { const int e = r / IT_E2, q = r % IT_E2, kb = q / 64, nb = q % 64;
        transpose_item(a.in[I_WE2] + ((size_t)l * NEXP + e) * 1024 * 2048, 2048, 1024, (bf16_t*)(wl + W_E2) + (size_t)e * 2048 * 1024, 64 * kb, 32 * nb, 32 * nb + ln, scr, F.lane); }
}

DI void phase_prologue(const Frame& F, const Args& a, int rep) {
    LAS float* scr = (LAS float*)(F.lds + F.wave * 16384);
    if (rep == 0) {
        const float* c = a.in[I_C]; const float* cctx = a.in[I_CCTX]; const float* wmod = a.in[I_WMOD];
        constexpr int NIT = 2 * 48 * 16;
        for (int it = F.gw; it < NIT; it += F.ngw) {
            const int l = it / 768, rem = it % 768, cb = rem / 16, kp = rem % 16, k0 = kp * 128, j0 = cb * 256 + F.lane * 4;
#pragma unroll
            for (int i = 0; i < 10; ++i) { const int idx = F.lane + 64 * i, r = idx >> 7, kk = idx & 127; const float v = r < 4 ? c[r * DM + k0 + kk] : cctx[k0 + kk]; scr[idx] = siluf_(v); }
            LDS_WAIT(); asm volatile("" ::: "memory");
            f32x4 acc[5];
#pragma unroll
            for (int r = 0; r < 5; ++r) acc[r] = (f32x4){0.f, 0.f, 0.f, 0.f};
            const float* wp = wmod + ((size_t)l * DM + k0) * (6 * DM) + j0;
#pragma unroll 4
            for (int kk = 0; kk < 128; ++kk) { const f32x4 w = *(const f32x4*)(wp + (size_t)kk * (6 * DM));
#pragma unroll
                for (int r = 0; r < 5; ++r) acc[r] += w * scr[r * 128 + kk]; }
#pragma unroll
            for (int r = 0; r < 5; ++r) *(f32x4*)((float*)(F.ws + WS_MPART) + ((size_t)(kp * 2 + l) * 5 + r) * (6 * DM) + j0) = acc[r];
            LDS_WAIT(); asm volatile("" ::: "memory");
        }
    }
    {
        float* rla = (float*)(F.ws + WS_ROPE_LA); float* rga = (float*)(F.ws + WS_ROPE_GA);
        const int gt = F.gw * 64 + F.lane, ngt = F.ngw * 64;
        for (int i = gt; i < 2048 * 32; i += ngt) { const int t = i >> 5, aidx = i & 31, ax = aidx >> 4, fi = aidx & 15;
            const float inv = exp2f(-(float)fi * (13.287712379549449f / 16.f)); const float ang = (float)(ax ? (t & 63) : (t >> 6)) * inv;
            rla[2 * i] = cosf(ang); rla[2 * i + 1] = sinf(ang); }
        for (int i = gt; i < 2048 * 64; i += ngt) { const int t = i >> 6, aidx = i & 63, ax = aidx >> 5, fi = aidx & 31;
            const float inv = exp2f(-(float)fi * (13.287712379549449f / 32.f)); const float ang = (float)(ax ? (t & 63) : (t >> 6)) * inv;
            rga[2 * i] = cosf(ang); rga[2 * i + 1] = sinf(ang); }
    }
    for (int it = F.gw; it < IT_EARLY; it += F.ngw) convert_item(F, a, 0, it, scr);
}

DI void phase_mods_reduce(const Frame& F, const Args& a) {
    float* mods = (float*)(F.ws + WS_MODS); const float* part = (const float*)(F.ws + WS_MPART); const float* bmod = a.in[I_BMOD];
    const int gt = F.gw * 64 + F.lane, ngt = F.ngw * 64;
    for (int i = gt; i < 2 * 5 * 12288 / 4; i += ngt) { const int l = i / (5 * 3072), j4 = i % 3072;
        f32x4 s = *(const f32x4*)(bmod + (size_t)l * 12288 + 4 * j4);
#pragma unroll
        for (int kp = 0; kp < 16; ++kp) s += *(const f32x4*)(part + (size_t)kp * (2 * 5 * 12288) + 4 * (size_t)i);
        *(f32x4*)(mods + 4 * (size_t)i) = s; }
}

DI const float* resid_row(const Frame& F, const Args& a, int l, int row) {
    if (l == 0) return row < MLAT ? a.in[I_X] + (size_t)row * DM : a.in[I_CTX] + (size_t)(row - MLAT) * DM;
    return (const float*)(F.ws + WS_X1) + (size_t)row * DM;
}
DI void combine_row(const Frame& F, int lp, int row, f32x4 (&v)[8]) {
    const float* X1 = (const float*)(F.ws + WS_X1) + (size_t)row * DM; const int* tok = (const int*)(F.ws + WS_TOK) + (size_t)row * 16; const bf16_t* YE = (const bf16_t*)(F.ws + WS_YE);
    f32x4 s[8];
#pragma unroll
    for (int j = 0; j < 8; ++j) { v[j] = *(const f32x4*)(X1 + 4 * F.lane + 256 * j); s[j] = (f32x4){0.f, 0.f, 0.f, 0.f}; }
    for (int e = 0; e < NEXP; ++e) { const int slot = __builtin_amdgcn_readfirstlane(tok[e]);
        if (slot >= 0) { const bf16_t* yr = YE + ((size_t)e * ESLOT + slot) * DM;
#pragma unroll
            for (int j = 0; j < 8; ++j) { const s16x4 y = *(const s16x4*)(yr + 4 * F.lane + 256 * j);
                s[j] += (f32x4){bf2f((unsigned short)y[0]), bf2f((unsigned short)y[1]), bf2f((unsigned short)y[2]), bf2f((unsigned short)y[3])}; } } }
    const float* g2 = mods_ptr(F, lp, row, 5);
#pragma unroll
    for (int j = 0; j < 8; ++j) v[j] += s[j] * *(const f32x4*)(g2 + 4 * F.lane + 256 * j);
}
DI void modulate_vals(const Frame& F, const f32x4 (&v)[8], const float* sh, const float* sc, bf16_t* hrow, f32x4 (&hv)[8]) {
    float ss = 0.f;
#pragma unroll
    for (int j = 0; j < 8; ++j) ss += v[j].x * v[j].x + v[j].y * v[j].y + v[j].z * v[j].z + v[j].w * v[j].w;
    const float rs = rsqrtf(wave_sum(ss) * (1.f / DM) + EPS);
#pragma unroll
    for (int j = 0; j < 8; ++j) { const f32x4 s1 = *(const f32x4*)(sc + 4 * F.lane + 256 * j), s0 = *(const f32x4*)(sh + 4 * F.lane + 256 * j);
        const f32x4 h = v[j] * rs * (s1 + 1.f) + s0; hv[j] = h;
        u32x2 w; w.x = pk2(h.x, h.y); w.y = pk2(h.z, h.w); *(u32x2*)(hrow + 4 * F.lane + 256 * j) = w; }
}
DI void phase_mod1(const Frame& F, const Args& a, int l) {
    bf16_t* H = (bf16_t*)(F.ws + WS_H);
    for (int row = F.gw; row < MTOT; row += F.ngw) { f32x4 v[8], hv[8];
        if (l == 0) { const float* xr = resid_row(F, a, 0, row);
#pragma unroll
            for (int j = 0; j < 8; ++j) v[j] = *(const f32x4*)(xr + 4 * F.lane + 256 * j); }
        else { combine_row(F, l - 1, row, v); float* xw = (float*)(F.ws + WS_X1) + (size_t)row * DM;
#pragma unroll
            for (int j = 0; j < 8; ++j) *(f32x4*)(xw + 4 * F.lane + 256 * j) = v[j]; }
        modulate_vals(F, v, mods_ptr(F, l, row, 0), mods_ptr(F, l, row, 1), H + (size_t)row * DM, hv); }
}
DI void phase_mod2(const Frame& F, const Args& a, int l, int nrows) {
    bf16_t* H = (bf16_t*)(F.ws + WS_H); float* AFF = (float*)(F.ws + WS_AFF);
    LAS float* wr = (LAS float*)F.lds;
    const float* wsrc = a.in[I_WROUTER] + (size_t)l * DM * NEXP;
    for (int i = F.tid; i < DM * NEXP / 4; i += NTHR) ((LAS f32x4*)wr)[i] = ((const f32x4*)wsrc)[i];
    __syncthreads();
    for (int row = F.gw; row < nrows; row += F.ngw) { f32x4 hv[8];
        { f32x4 v[8]; const float* xr = (const float*)(F.ws + WS_X1) + (size_t)row * DM;
#pragma unroll
          for (int j = 0; j < 8; ++j) v[j] = *(const f32x4*)(xr + 4 * F.lane + 256 * j);
          modulate_vals(F, v, mods_ptr(F, l, row, 3), mods_ptr(F, l, row, 4), H + (size_t)row * DM, hv); }
        float lg[16];
#pragma unroll
        for (int e = 0; e < 16; ++e) lg[e] = 0.f;
#pragma unroll
        for (int j = 0; j < 8; ++j)
#pragma unroll
            for (int i = 0; i < 4; ++i) { const int c = 4 * F.lane + 256 * j + i; const float h = hv[j][i];
#pragma unroll
                for (int q = 0; q < 4; ++q) { const f32x4 w = *(const LAS f32x4*)(wr + c * 16 + 4 * q); lg[4 * q] += h * w.x; lg[4 * q + 1] += h * w.y; lg[4 * q + 2] += h * w.z; lg[4 * q + 3] += h * w.w; } }
        float mx = -1e30f;
#pragma unroll
        for (int e = 0; e < 16; ++e) { lg[e] = wave_sum(lg[e]); mx = fmaxf(mx, lg[e]); }
        float den = 0.f;
#pragma unroll
        for (int e = 0; e < 16; ++e) { lg[e] = __expf(lg[e] - mx); den += lg[e]; }
        const float inv = 1.f / den;
        float mine = 0.f;
#pragma unroll
        for (int e = 0; e < 16; ++e) mine = (F.lane == e) ? lg[e] * inv : mine;
        if (F.lane < 16) AFF[(size_t)row * 16 + F.lane] = mine;
    }
    __syncthreads();
}

DI void phase_postproj(const Frame& F, const Args& a, int l) {
    const bf16_t* P = (const bf16_t*)(F.ws + WS_P); const float* X80 = (const float*)(F.ws + WS_X80);
    bf16_t* CQN = (bf16_t*)(F.ws + WS_CQN); bf16_t* CKVN = (bf16_t*)(F.ws + WS_CKVN); bf16_t* QG = (bf16_t*)(F.ws + WS_QG); bf16_t* KG = (bf16_t*)(F.ws + WS_KG); bf16_t* KR = (bf16_t*)(F.ws + WS_KR);
    const float* qn = a.in[I_LAQN] + l * 512; const float* kvn = a.in[I_LAKVN] + l * 256; const float* gqn = a.in[I_GAQN] + l * 128; const float* gkn = a.in[I_GAKN] + l * 128;
    const float* rla = (const float*)(F.ws + WS_ROPE_LA); const float* rga = (const float*)(F.ws + WS_ROPE_GA);
    const int lane = F.lane;
    for (int row = F.gw; row < MTOT; row += F.ngw) {
        const bf16_t* pr = P + (size_t)row * NP; const bool lat = row < MLAT; const int t = row & 2047; const bool needq = lat || l == 0;
        if (needq) {
            const bf16x8 x = *(const bf16x8*)(pr + C_CQ + 8 * lane); float f[8]; float ss = 0.f;
#pragma unroll
            for (int i = 0; i < 8; ++i) { f[i] = bf2f((unsigned short)x[i]); ss += f[i] * f[i]; }
            const float rs = rsqrtf(wave_sum(ss) * (1.f / 512.f) + EPS);
            const f32x4 g0 = *(const f32x4*)(qn + 8 * lane), g1 = *(const f32x4*)(qn + 8 * lane + 4);
            u32x4 w; w.x = pk2(f[0] * rs * g0.x, f[1] * rs * g0.y); w.y = pk2(f[2] * rs * g0.z, f[3] * rs * g0.w); w.z = pk2(f[4] * rs * g1.x, f[5] * rs * g1.y); w.w = pk2(f[6] * rs * g1.z, f[7] * rs * g1.w);
            *(u32x4*)(CQN + (size_t)row * 512 + 8 * lane) = w;
        }
        {
            const s16x4 x = *(const s16x4*)(pr + C_CKV + 4 * lane); float f[4]; float ss = 0.f;
#pragma unroll
            for (int i = 0; i < 4; ++i) { f[i] = bf2f((unsigned short)x[i]); ss += f[i] * f[i]; }
            const float rs = rsqrtf(wave_sum(ss) * (1.f / 256.f) + EPS);
            const f32x4 g0 = *(const f32x4*)(kvn + 4 * lane);
            u32x2 w; w.x = pk2(f[0] * rs * g0.x, f[1] * rs * g0.y); w.y = pk2(f[2] * rs * g0.z, f[3] * rs * g0.w);
            *(u32x2*)(CKVN + (size_t)row * 256 + 4 * lane) = w;
        }
        const int ax = lane >> 5, fi = lane & 31;
        const float cs = rga[((size_t)t * 64 + lane) * 2], sn = rga[((size_t)t * 64 + lane) * 2 + 1];
        for (int hh = needq ? 0 : 8; hh < 10; ++hh) {
            const bf16_t* src = hh < 8 ? pr + C_GQ + hh * 128 : pr + C_GK + (hh - 8) * 128;
            const float* gn = hh < 8 ? gqn : gkn;
            const float xa = bf2f(src[ax * 64 + fi]), xb = bf2f(src[ax * 64 + 32 + fi]);
            const float rs = rsqrtf(wave_sum(xa * xa + xb * xb) * (1.f / 128.f) + EPS);
            const float ya = xa * rs * gn[ax * 64 + fi], yb = xb * rs * gn[ax * 64 + 32 + fi];
            const float oa = lat ? ya * cs - yb * sn : ya, ob = lat ? ya * sn + yb * cs : yb;
            bf16_t* dst = hh < 8 ? QG + (size_t)row * 1024 + hh * 128 : KG + (size_t)row * 256 + (hh - 8) * 128;
            dst[ax * 64 + fi] = (bf16_t)f2bf(oa); dst[ax * 64 + 32 + fi] = (bf16_t)f2bf(ob);
        }
        {
            const int l32 = lane & 31, ax2 = l32 >> 4, f2 = l32 & 15;
            const float xa = X80[(size_t)row * XW + ax2 * 32 + f2], xb = X80[(size_t)row * XW + ax2 * 32 + 16 + f2];
            const float c2 = rla[((size_t)t * 32 + l32) * 2], s2 = rla[((size_t)t * 32 + l32) * 2 + 1];
            const float oa = lat ? xa * c2 - xb * s2 : xa, ob = lat ? xa * s2 + xb * c2 : xb;
            if (lane < 32) { KR[(size_t)row * 64 + ax2 * 32 + f2] = (bf16_t)f2bf(oa); KR[(size_t)row * 64 + ax2 * 32 + 16 + f2] = (bf16_t)f2bf(ob); }
        }
    }
}

namespace att {
constexpr int QBLK = 32, KVBLK = 64;
#define SBAR() __builtin_amdgcn_sched_barrier(0)
DI int crow(int r, int hi) { return (r & 3) + 8 * (r >> 2) + 4 * hi; }
DI int v_st(int k, int c) { const int kk = (k & ~0xC) | ((k & 4) << 1) | ((k & 8) >> 1); return ((kk >> 3) * 4 + (c >> 5)) * 512 + ((kk & 7) * 32 + (c & 31)) * 2; }
DI int v_rd_base(int lane) { return ((lane & 3) << 3) | (((lane >> 2) & 3) << 6) | (((lane >> 4) & 1) << 5) | (((lane >> 5) & 1) << 8); }
constexpr int v_rd_off(int d0, int ks, int half) { return d0 * 512 + ks * 4096 + half * 2048; }
template <int OFF> DI s16x4 tr_read(int vb) { s16x4 r; asm volatile("ds_read_b64_tr_b16 %0, %1 offset:%2" : "=&v"(r) : "v"(vb), "i"(OFF) : "memory"); return r; }
template <int D0> DI void pv_one(f32x16& od, int vb, bf16x8 pa0, bf16x8 pa1, bf16x8 pa2, bf16x8 pa3) {
  const s16x4 l0 = tr_read<v_rd_off(D0, 0, 0)>(vb), h0 = tr_read<v_rd_off(D0, 0, 1)>(vb), l1 = tr_read<v_rd_off(D0, 1, 0)>(vb), h1 = tr_read<v_rd_off(D0, 1, 1)>(vb);
  const s16x4 l2 = tr_read<v_rd_off(D0, 2, 0)>(vb), h2 = tr_read<v_rd_off(D0, 2, 1)>(vb), l3 = tr_read<v_rd_off(D0, 3, 0)>(vb), h3 = tr_read<v_rd_off(D0, 3, 1)>(vb);
  asm volatile("s_waitcnt lgkmcnt(0)" ::: "memory"); SBAR();
#define PK(L, H) (bf16x8){L[0], L[1], L[2], L[3], H[0], H[1], H[2], H[3]}
  od = __builtin_amdgcn_mfma_f32_32x32x16_bf16(pa0, PK(l0, h0), od, 0, 0, 0);
  od = __builtin_amdgcn_mfma_f32_32x32x16_bf16(pa1, PK(l1, h1), od, 0, 0, 0);
  od = __builtin_amdgcn_mfma_f32_32x32x16_bf16(pa2, PK(l2, h2), od, 0, 0, 0);
  od = __builtin_amdgcn_mfma_f32_32x32x16_bf16(pa3, PK(l3, h3), od, 0, 0, 0);
#undef PK
}
DI void pv_d0(f32x16* o, int vb, bf16x8 pa0, bf16x8 pa1, bf16x8 pa2, bf16x8 pa3) {
  pv_one<0>(o[0], vb, pa0, pa1, pa2, pa3); pv_one<1>(o[1], vb, pa0, pa1, pa2, pa3); pv_one<2>(o[2], vb, pa0, pa1, pa2, pa3); pv_one<3>(o[3], vb, pa0, pa1, pa2, pa3);
}
template <int DKX, int LDQ, int LDK, int LDV, int LDO, int SDEPTH = 1>
DI void attn_body(const bf16_t* __restrict__ Qb, const bf16_t* __restrict__ Km, const bf16_t* __restrict__ Kx, const bf16_t* __restrict__ Vm, bf16_t* __restrict__ Ob,
                  int kr0, int nt0, int kr1, int nt1, float scale, const float* __restrict__ ropeq  , char* lds) {
  constexpr int ND0 = 8 + DKX / 16, KROWB = (128 + DKX) * 2, SHM_V = KVBLK * 128 * 2, SHM_K = KVBLK * KROWB;
  constexpr float THR = 8.f;
#define KSWZ(row, colB) ((row) * KROWB + ((colB) ^ (((row) & 7) << 4)))
  int tid = threadIdx.x; asm volatile("" : "+v"(tid));
  const int wid = __builtin_amdgcn_readfirstlane(tid >> 6), lane = tid & 63, r32 = lane & 31, hi = lane >> 5;
  char* V_lds = lds; char* K_lds = lds + 2 * SHM_V;
  float* ws = (float*)(lds + 2 * SHM_V + 2 * SHM_K) + wid * 64; float* li_l = ws; float* al_l = ws + 32;
  const float C = scale * 1.4426950408889634f;
  float m_reg = -1e30f, l_reg = 0; f32x16 o[4] = {}; bf16x8 qr[8];
  const bf16_t* Qw = Qb + (long)(wid * QBLK + r32) * LDQ + hi * 8;
#pragma unroll
  for (int d0 = 0; d0 < 8; ++d0) qr[d0] = *reinterpret_cast<const bf16x8*>(Qw + d0 * 16);
  char* QX = lds + 2 * SHM_V + 2 * SHM_K + 2048 + (wid * 4 * 64 + lane) * 16;
  if constexpr (DKX > 0) {
#pragma unroll
    for (int ax = 0; ax < 2; ++ax) {
      const bf16x8 xa = *reinterpret_cast<const bf16x8*>(Qw + 128 + ax * 32), xb = *reinterpret_cast<const bf16x8*>(Qw + 128 + ax * 32 + 16);
      if (ropeq) {
        const float* cs = ropeq + ((size_t)(wid * QBLK + r32) * 32 + ax * 16 + hi * 8) * 2;
        float oa[8], ob[8];
#pragma unroll
        for (int j = 0; j < 8; ++j) { const float c = cs[2 * j], sn = cs[2 * j + 1], a = bf2f((unsigned short)xa[j]), b = bf2f((unsigned short)xb[j]); oa[j] = a * c - b * sn; ob[j] = a * sn + b * c; }
        u32x4 wa = {pk2(oa[0], oa[1]), pk2(oa[2], oa[3]), pk2(oa[4], oa[5]), pk2(oa[6], oa[7])}, wb = {pk2(ob[0], ob[1]), pk2(ob[2], ob[3]), pk2(ob[4], ob[5]), pk2(ob[6], ob[7])};
        *reinterpret_cast<u32x4*>(QX + (2 * ax) * 1024) = wa; *reinterpret_cast<u32x4*>(QX + (2 * ax + 1) * 1024) = wb;
      } else { *reinterpret_cast<bf16x8*>(QX + (2 * ax) * 1024) = xa; *reinterpret_cast<bf16x8*>(QX + (2 * ax + 1) * 1024) = xb; }
    }
  }
  const int sr = tid >> 4, sc = (tid & 15) * 8, vst0 = v_st(sr, sc), vst1 = v_st(32 + sr, sc);
  const int xr = tid >> 3, xc = (tid & 7) * 8;
  const int vb0 = (int)(uintptr_t)V_lds + v_rd_base(lane);
  const int offV = sr * LDV + sc, offK = sr * LDK + sc, offX = xr * 64 + xc;
  struct { bf16x8 vs0, vs1, ks0, ks1, kx; } sr_[SDEPTH];
  const int NT = nt0 + nt1;
#define TROW(j) ((j) < nt0 ? kr0 + (j) * KVBLK : kr1 + ((j) - nt0) * KVBLK)
#define SLOAD(i, j) do { const long _r = TROW(j); const bf16_t* _vt = Vm + _r * LDV; const bf16_t* _kt = Km + _r * LDK; \
    sr_[i].vs0 = *(const bf16x8*)(_vt + offV); sr_[i].vs1 = *(const bf16x8*)(_vt + offV + 32 * LDV); \
    sr_[i].ks0 = *(const bf16x8*)(_kt + offK); sr_[i].ks1 = *(const bf16x8*)(_kt + offK + 32 * LDK); \
    if constexpr (DKX > 0) sr_[i].kx = *(const bf16x8*)(Kx + _r * 64 + offX); } while (0)
#define SWRITE(b, i) do { *(bf16x8*)(V_lds + (b) * SHM_V + vst0) = sr_[i].vs0; *(bf16x8*)(V_lds + (b) * SHM_V + vst1) = sr_[i].vs1; const int kc = sc * 2; \
    *(bf16x8*)(K_lds + (b) * SHM_K + KSWZ(sr, kc)) = sr_[i].ks0; *(bf16x8*)(K_lds + (b) * SHM_K + KSWZ(32 + sr, kc)) = sr_[i].ks1; \
    if constexpr (DKX > 0) *(bf16x8*)(K_lds + (b) * SHM_K + KSWZ(xr, 256 + xc * 2)) = sr_[i].kx; } while (0)
#define SWAIT() do { if constexpr (SDEPTH == 1) asm volatile("s_waitcnt vmcnt(0)" ::: "memory"); else if constexpr (DKX > 0) asm volatile("s_waitcnt vmcnt(5)" ::: "memory"); else asm volatile("s_waitcnt vmcnt(4)" ::: "memory"); } while (0)
#define RESC(a) do { if (__any((a) < 1.f)) { if (hi == 0) al_l[r32] = (a); asm volatile("s_waitcnt lgkmcnt(0)" ::: "memory"); \
    for (int d = 0; d < 4; ++d) for (int r = 0; r < 16; ++r) o[d][r] *= al_l[crow(r, hi)]; } } while (0)
#define QKT(p0, p1, Ks) do { p0 = f32x16{}; p1 = f32x16{}; _Pragma("unroll") for (int d0 = 0; d0 < ND0; ++d0) { const int cb = (d0 * 16 + hi * 8) * 2; \
    const bf16x8 b0 = *reinterpret_cast<const bf16x8*>((Ks) + KSWZ(r32, cb)); const bf16x8 b1 = *reinterpret_cast<const bf16x8*>((Ks) + KSWZ(32 + r32, cb)); \
    const bf16x8 qf = d0 < 8 ? qr[d0 < 8 ? d0 : 0] : *reinterpret_cast<const bf16x8*>(QX + (d0 - 8) * 1024); \
    p0 = __builtin_amdgcn_mfma_f32_32x32x16_bf16(b0, qf, p0, 0, 0, 0); p1 = __builtin_amdgcn_mfma_f32_32x32x16_bf16(b1, qf, p1, 0, 0, 0); if (DKX > 0 && (d0 & 1) == 1) SBAR(); } } while (0)
#define PARTIAL_SM(p0, p1, mn, alpha) do { float pmax = p0[0]; for (int r = 1; r < 16; ++r) pmax = fmaxf(pmax, p0[r]); for (int r = 0; r < 16; ++r) pmax = fmaxf(pmax, p1[r]); \
    { auto rr = __builtin_amdgcn_permlane32_swap(__float_as_uint(pmax), __float_as_uint(pmax), false, false); pmax = fmaxf(__uint_as_float(rr[0]), __uint_as_float(rr[1])); } \
    if (__builtin_expect(__all((pmax - m_reg) * scale <= THR), 1)) { mn = m_reg; alpha = 1.f; } \
    else { mn = fmaxf(m_reg, pmax); alpha = __builtin_amdgcn_exp2f((m_reg - mn) * C); m_reg = mn; } \
    const float mnC = -mn * C; for (int r = 0; r < 16; ++r) p0[r] = fmaf(p0[r], C, mnC); for (int r = 0; r < 16; ++r) p1[r] = fmaf(p1[r], C, mnC); \
    for (int r = 0; r < 16; ++r) p0[r] = __builtin_amdgcn_exp2f(p0[r]); } while (0)
#define PK4(P, BASE, OUT) do { unsigned a0 = pk2(P[BASE + 0], P[BASE + 1]), a1 = pk2(P[BASE + 2], P[BASE + 3]); \
    unsigned b0 = pk2(P[BASE + 4], P[BASE + 5]), b1 = pk2(P[BASE + 6], P[BASE + 7]); \
    auto r0 = __builtin_amdgcn_permlane32_swap(a0, b0, false, false); auto r1 = __builtin_amdgcn_permlane32_swap(a1, b1, false, false); \
    u32x4 w = {r0[0], r1[0], r0[1], r1[1]}; OUT = *reinterpret_cast<bf16x8*>(&w); } while (0)
#define FINISH_SM(p0, p1, alpha) do { for (int r = 0; r < 16; ++r) p1[r] = __builtin_amdgcn_exp2f(p1[r]); \
    float ps = 0; for (int r = 0; r < 16; ++r) ps += p0[r]; for (int r = 0; r < 16; ++r) ps += p1[r]; \
    { auto rr = __builtin_amdgcn_permlane32_swap(__float_as_uint(ps), __float_as_uint(ps), false, false); ps = __uint_as_float(rr[0]) + __uint_as_float(rr[1]); } \
    l_reg = l_reg * alpha + ps; PK4(p0, 0, pa0); PK4(p0, 8, pa1); PK4(p1, 0, pa2); PK4(p1, 8, pa3); } while (0)
  f32x16 pA0, pA1, pB0, pB1; float mnA, mnB, alA, alB; bf16x8 pa0, pa1, pa2, pa3;
  constexpr int SE = 0, SO = SDEPTH - 1;
  SLOAD(SE, 0); asm volatile("s_waitcnt vmcnt(0)" ::: "memory"); SWRITE(0, SE); __syncthreads();
  QKT(pA0, pA1, K_lds); PARTIAL_SM(pA0, pA1, mnA, alA);
  SLOAD(SO, 1); if constexpr (SDEPTH == 2) { if (2 < NT) SLOAD(SE, 2); }
  SWAIT(); SWRITE(1, SO); __syncthreads();
  for (int j = 1; j + 1 < NT; j += 2) {
    SBAR(); QKT(pB0, pB1, K_lds + SHM_K);
    FINISH_SM(pA0, pA1, alA); SBAR();
    SLOAD(SO, j + SDEPTH); SBAR();
    pv_d0(o, vb0, pa0, pa1, pa2, pa3); PARTIAL_SM(pB0, pB1, mnB, alB);
    __syncthreads(); SWAIT(); SWRITE(0, SE);
    RESC(alB); __syncthreads();
    SBAR(); QKT(pA0, pA1, K_lds);
    FINISH_SM(pB0, pB1, alB); SBAR();
    if (SDEPTH == 1 || j + 3 < NT) SLOAD(SE, j + 1 + SDEPTH); SBAR();
    pv_d0(o, vb0 + (int)SHM_V, pa0, pa1, pa2, pa3); PARTIAL_SM(pA0, pA1, mnA, alA);
    __syncthreads(); SWAIT(); SWRITE(1, SO);
    RESC(alA); __syncthreads();
  }
  SBAR(); QKT(pB0, pB1, K_lds + SHM_K);
  FINISH_SM(pA0, pA1, alA); SBAR();
  pv_d0(o, vb0, pa0, pa1, pa2, pa3); PARTIAL_SM(pB0, pB1, mnB, alB);
  __syncthreads(); RESC(alB);
  FINISH_SM(pB0, pB1, alB); SBAR();
  pv_d0(o, vb0 + (int)SHM_V, pa0, pa1, pa2, pa3);
  if (hi == 0) li_l[r32] = l_reg; asm volatile("s_waitcnt lgkmcnt(0)" ::: "memory");
  float rli[16];
#pragma unroll
  for (int r = 0; r < 16; ++r) rli[r] = __builtin_amdgcn_rcpf(li_l[crow(r, hi)]);
  bf16_t* Ow = Ob + (long)(wid * QBLK) * LDO;
#pragma unroll
  for (int r = 0; r < 16; ++r) { const int orow = crow(r, hi);
#pragma unroll
    for (int d0 = 0; d0 < 4; ++d0) Ow[(long)orow * LDO + d0 * 32 + r32] = (bf16_t)f2bf(o[d0][r] * rli[r]); }
  __syncthreads();
#undef KSWZ
#undef TROW
#undef SLOAD
#undef SWRITE
#undef SWAIT
#undef RESC
#undef QKT
#undef PARTIAL_SM
#undef PK4
#undef FINISH_SM
}
}

namespace ml {
constexpr int LD = 264, ROWB = LD * 2, QS_OFF = 0, KS_OFF = 64 * ROWB, VS_OFF = 2 * 64 * ROWB, NV_OFF = 3 * 64 * ROWB, SC_OFF = NV_OFF + 1024, ML_END = SC_OFF + 2048;
static_assert(ML_END <= LDS_BYTES - 1024, "mlstm lds");
#define MFMA32(a, b, c) __builtin_amdgcn_mfma_f32_32x32x16_bf16((a), (b), (c), 0, 0, 0)
DI bf16x8 pack_step(const f32x16& x, int s) {
    u32x4 p;
    asm volatile("v_cvt_pk_bf16_f32 %0, %4, %5\n\tv_cvt_pk_bf16_f32 %1, %6, %7\n\tv_cvt_pk_bf16_f32 %2, %8, %9\n\tv_cvt_pk_bf16_f32 %3, %10, %11\n\ts_nop 1"
                 : "=&v"(p[0]), "=&v"(p[1]), "=&v"(p[2]), "=&v"(p[3])
                 : "v"(x[8 * s]), "v"(x[8 * s + 1]), "v"(x[8 * s + 2]), "v"(x[8 * s + 3]), "v"(x[8 * s + 4]), "v"(x[8 * s + 5]), "v"(x[8 * s + 6]), "v"(x[8 * s + 7]));
    return __builtin_bit_cast(bf16x8, p);
}
DI bf16x8 ld_perm(const LAS unsigned char* p) {
    const s16x4 lo = *(const LAS s16x4*)p, hi = *(const LAS s16x4*)(p + 16);
    return (bf16x8){lo[0], lo[1], lo[2], lo[3], hi[0], hi[1], hi[2], hi[3]};
}
DI int crow(int r, int hi) { return (r & 3) + 8 * (r >> 2) + 4 * hi; }
template <int OFF> DI s16x4 tr_rd(unsigned addr) { s16x4 r; asm volatile("ds_read_b64_tr_b16 %0, %1 offset:%2" : "=&v"(r) : "v"(addr), "i"(OFF) : "memory"); return r; }
#define TR_WAIT() do { asm volatile("s_waitcnt lgkmcnt(0)" ::: "memory"); __builtin_amdgcn_sched_barrier(0); } while (0)
#define CAT8(L, H) (bf16x8){L[0], L[1], L[2], L[3], H[0], H[1], H[2], H[3]}

DI void mlstm_stream(const Frame& F, const Args& a, int l, int stream, bool ctx_out) {
    const int b = stream >> 3, hd = (stream >> 1) & 3, dir = stream & 1;
    const int tid = F.tid, w = F.wave;
    LAS unsigned char* lds = F.lds;
    const unsigned ldsb = (unsigned)(uintptr_t)lds;
    const bf16_t* P = (const bf16_t*)(F.ws + WS_P); const float* X80 = (const float*)(F.ws + WS_X80);
    float* MLH = (float*)(F.ws + WS_MLH) + (size_t)dir * MTOT * 1024;
    const float* gb = a.in[I_GBIAS] + l * 16;
    const float gbi = gb[dir * 8 + hd], gbf = gb[dir * 8 + 4 + hd];
    LAS float* NV = (LAS float*)(lds + NV_OFF);
    LAS float* SC = (LAS float*)(lds + SC_OFF);
    f32x16 CT[8];
#pragma unroll
    for (int i = 0; i < 8; ++i) CT[i] = f32x16{};
    if (tid < 256) NV[tid] = 0.f;
    float m_prev = 0.f;
    const int sgn = dir ? -1 : 1;
#define CHUNK_ROW0(c) ((c) < 4 ? MLAT + b * CTXL + (dir ? 255 - (c) * 64 : (c) * 64) : b * SEQ + (dir ? 2047 - ((c) - 4) * 64 : ((c) - 4) * 64))
    bf16x8 pq[4], pk[4], pv[4]; float pgi, pgf;
#define PREFETCH(c) do { int ln_ = F.lane; asm volatile("" : "+v"(ln_)); const int r0_ = CHUNK_ROW0(c); \
        const bf16_t* pr_ = P + (size_t)(r0_ + sgn * ((w << 3) | (ln_ >> 3))) * NP + hd * 256 + 8 * (ln_ & 7); \
        _Pragma("unroll") for (int j = 0; j < 4; ++j) { pq[j] = *(const bf16x8*)(pr_ + C_MLQ + 64 * j); pk[j] = *(const bf16x8*)(pr_ + C_MLK + 64 * j); pv[j] = *(const bf16x8*)(pr_ + C_MLV + 64 * j); } \
        const float* xg_ = X80 + (size_t)(r0_ + sgn * ln_) * XW + 64 + dir * 8 + hd; pgi = xg_[0]; pgf = xg_[4]; } while (0)
    PREFETCH(0);
#ifndef MK_MLX
#define MK_MLX 1
#endif
    for (int cc = 0; cc < 36 * MK_MLX; ++cc) {
        const int c = cc % 36;
        if (MK_MLX > 1 && cc == 36) { __syncthreads();
#pragma unroll
            for (int i = 0; i < 8; ++i) CT[i] = f32x16{};
            if (tid < 256) NV[tid] = 0.f; m_prev = 0.f; }
        int lane = F.lane; asm volatile("" : "+v"(lane));
        const int r32 = lane & 31, hi = lane >> 5, ldi = (w << 3) | (lane >> 3), cg = lane & 7, g16 = lane >> 4, q4 = (lane & 15) >> 2, p4 = lane & 3;
        const int row0 = CHUNK_ROW0(c);
        const float ipre = pgi + gbi, fpre = pgf + gbf;
        const float lf = fminf(fpre, 0.f) - __logf(1.f + __expf(-fabsf(fpre)));
        float cum = lf;
#pragma unroll
        for (int o = 1; o < 64; o <<= 1) { const float t = __shfl_up(cum, o); if (lane >= o) cum += t; }
        const float bb = ipre - cum;
        float pmx = bb;
#pragma unroll
        for (int o = 1; o < 64; o <<= 1) { const float t = __shfl_up(pmx, o); if (lane >= o) pmx = fmaxf(pmx, t); }
        const float aa = fmaxf(m_prev, pmx);
        const float cum_end = __shfl(cum, 63), a_end = __shfl(aa, 63);
        const float decay = __expf(m_prev - a_end), m_new = cum_end + a_end;
        __syncthreads();
#pragma unroll
        for (int j = 0; j < 4; ++j) { const int ch = cg + 8 * j; const bf16x8 qv = pq[j];
            u32x4 qs;
            qs.x = pk2(bf2f((unsigned short)qv[0]) * 0.0625f, bf2f((unsigned short)qv[1]) * 0.0625f); qs.y = pk2(bf2f((unsigned short)qv[2]) * 0.0625f, bf2f((unsigned short)qv[3]) * 0.0625f);
            qs.z = pk2(bf2f((unsigned short)qv[4]) * 0.0625f, bf2f((unsigned short)qv[5]) * 0.0625f); qs.w = pk2(bf2f((unsigned short)qv[6]) * 0.0625f, bf2f((unsigned short)qv[7]) * 0.0625f);
            *(LAS u32x4*)(lds + QS_OFF + (ldi * LD + 8 * ch) * 2) = qs;
            *(LAS bf16x8*)(lds + KS_OFF + (ldi * LD + 8 * ch) * 2) = pk[j];
            *(LAS bf16x8*)(lds + VS_OFF + (ldi * LD + 8 * ch) * 2) = pv[j]; }
        {
            float part = 0.f;
#pragma unroll
            for (int j = 0; j < 4; ++j) { const int ch = cg + 8 * j; const bf16x8 qv = pq[j]; const f32x4 n0 = *(const LAS f32x4*)(NV + 8 * ch), n1 = *(const LAS f32x4*)(NV + 8 * ch + 4);
                part += bf2f((unsigned short)qv[0]) * n0.x + bf2f((unsigned short)qv[1]) * n0.y + bf2f((unsigned short)qv[2]) * n0.z + bf2f((unsigned short)qv[3]) * n0.w
                      + bf2f((unsigned short)qv[4]) * n1.x + bf2f((unsigned short)qv[5]) * n1.y + bf2f((unsigned short)qv[6]) * n1.z + bf2f((unsigned short)qv[7]) * n1.w; }
            part += __shfl_xor(part, 1); part += __shfl_xor(part, 2); part += __shfl_xor(part, 4);
            if (cg == 0) SC[320 + ldi] = part * 0.0625f; }
        if (w == 0) { SC[lane] = bb; SC[64 + lane] = aa; SC[128 + lane] = __expf(m_prev - aa); SC[192 + lane] = __expf(-cum - aa); SC[256 + lane] = __expf(bb - a_end); }
        __syncthreads();
        const bool want_out = (c >= 4) || ctx_out;
        if (want_out) {
            const unsigned va0 = ldsb + VS_OFF + ((4 * (g16 >> 1) + q4) * LD + 32 * w + 16 * (g16 & 1) + 4 * p4) * 2;
#pragma unroll
            for (int lt = 0; lt < 2; ++lt) {
                const int lcol = 32 * lt + r32;
                const float a_l = SC[64 + lcol], wI_l = SC[128 + lcol], fl_l = SC[192 + lcol], nq_l = SC[320 + lcol];
                f32x16 N = f32x16{};
#pragma unroll
                for (int dt = 0; dt < 8; ++dt)
#pragma unroll
                    for (int ks = 0; ks < 2; ++ks) {
                        const bf16x8 qa = ld_perm(lds + QS_OFF + (lcol * LD + 32 * dt + 16 * ks + 4 * hi) * 2);
                        N = MFMA32(pack_step(CT[dt], ks), qa, N); if (ks == 1 && (dt & 1)) __builtin_amdgcn_sched_barrier(0); }
#pragma unroll
                for (int r = 0; r < 16; ++r) N[r] *= wI_l;
                float den = 0.f;
#pragma unroll
                for (int st = 0; st <= lt; ++st) {
                    f32x16 S = f32x16{};
#pragma unroll
                    for (int ks = 0; ks < 16; ++ks) {
                        const bf16x8 ka = *(const LAS bf16x8*)(lds + KS_OFF + ((32 * st + r32) * LD + 16 * ks + 8 * hi) * 2);
                        const bf16x8 qb = *(const LAS bf16x8*)(lds + QS_OFF + (lcol * LD + 16 * ks + 8 * hi) * 2);
                        S = MFMA32(ka, qb, S); }
                    const s16x4 v00 = st == 0 ? tr_rd<0>(va0) : tr_rd<32 * ROWB>(va0), v01 = st == 0 ? tr_rd<8 * ROWB>(va0) : tr_rd<40 * ROWB>(va0);
                    const s16x4 v10 = st == 0 ? tr_rd<16 * ROWB>(va0) : tr_rd<48 * ROWB>(va0), v11 = st == 0 ? tr_rd<24 * ROWB>(va0) : tr_rd<56 * ROWB>(va0);
#pragma unroll
                    for (int r = 0; r < 16; ++r) { const int srow = 32 * st + crow(r, hi); const float dd = __expf(SC[srow] - a_l);
                        const float v = (srow <= lcol) ? S[r] * dd : 0.f; S[r] = v; den += v; }
                    TR_WAIT();
                    N = MFMA32(CAT8(v00, v01), pack_step(S, 0), N);
                    N = MFMA32(CAT8(v10, v11), pack_step(S, 1), N);
                }
                den += __shfl_xor(den, 32);
                den += wI_l * nq_l;
                const float inv = 1.f / fmaxf(fabsf(den), fl_l);
                float* orow = MLH + (size_t)(row0 + sgn * lcol) * 1024 + hd * 256 + 32 * w + 4 * hi;
#pragma unroll
                for (int g = 0; g < 4; ++g) *(f32x4*)(orow + 8 * g) = (f32x4){N[4 * g] * inv, N[4 * g + 1] * inv, N[4 * g + 2] * inv, N[4 * g + 3] * inv};
                __builtin_amdgcn_sched_barrier(0);
            }
        }
        __builtin_amdgcn_sched_barrier(0);
        { const int cn = (cc + 1 < 36 * MK_MLX) ? (cc + 1) % 36 : 35; PREFETCH(cn); }
        __builtin_amdgcn_sched_barrier(0);
        {
            const unsigned vb0 = ldsb + VS_OFF + ((8 * (g16 >> 1) + q4) * LD + 32 * w + 16 * (g16 & 1) + 4 * p4) * 2;
            const unsigned kb0 = ldsb + KS_OFF + ((8 * (g16 >> 1) + q4) * LD + 16 * (g16 & 1) + 4 * p4) * 2;
            const s16x4 b00 = tr_rd<0>(vb0), b01 = tr_rd<4 * ROWB>(vb0), b10 = tr_rd<16 * ROWB>(vb0), b11 = tr_rd<20 * ROWB>(vb0);
            const s16x4 b20 = tr_rd<32 * ROWB>(vb0), b21 = tr_rd<36 * ROWB>(vb0), b30 = tr_rd<48 * ROWB>(vb0), b31 = tr_rd<52 * ROWB>(vb0);
            TR_WAIT();
            bf16x8 vb[4];
#define SCALE8(dst, L, H, ks) do { const f32x4 w0 = *(const LAS f32x4*)(SC + 256 + 16 * (ks) + 8 * hi), w1 = *(const LAS f32x4*)(SC + 256 + 16 * (ks) + 8 * hi + 4); \
            u32x4 t_; t_.x = pk2(bf2f((unsigned short)L[0]) * w0.x, bf2f((unsigned short)L[1]) * w0.y); t_.y = pk2(bf2f((unsigned short)L[2]) * w0.z, bf2f((unsigned short)L[3]) * w0.w); \
            t_.z = pk2(bf2f((unsigned short)H[0]) * w1.x, bf2f((unsigned short)H[1]) * w1.y); t_.w = pk2(bf2f((unsigned short)H[2]) * w1.z, bf2f((unsigned short)H[3]) * w1.w); dst = __builtin_bit_cast(bf16x8, t_); } while (0)
            SCALE8(vb[0], b00, b01, 0); SCALE8(vb[1], b10, b11, 1); SCALE8(vb[2], b20, b21, 2); SCALE8(vb[3], b30, b31, 3);
#undef SCALE8
#define UPD(dt) do { const s16x4 k00 = tr_rd<(dt) * 64>(kb0), k01 = tr_rd<(dt) * 64 + 4 * ROWB>(kb0), k10 = tr_rd<(dt) * 64 + 16 * ROWB>(kb0), k11 = tr_rd<(dt) * 64 + 20 * ROWB>(kb0); \
            const s16x4 k20 = tr_rd<(dt) * 64 + 32 * ROWB>(kb0), k21 = tr_rd<(dt) * 64 + 36 * ROWB>(kb0), k30 = tr_rd<(dt) * 64 + 48 * ROWB>(kb0), k31 = tr_rd<(dt) * 64 + 52 * ROWB>(kb0); \
            _Pragma("unroll") for (int r = 0; r < 16; ++r) CT[dt][r] *= decay; \
            TR_WAIT(); \
            CT[dt] = MFMA32(CAT8(k00, k01), vb[0], CT[dt]); CT[dt] = MFMA32(CAT8(k10, k11), vb[1], CT[dt]); CT[dt] = MFMA32(CAT8(k20, k21), vb[2], CT[dt]); CT[dt] = MFMA32(CAT8(k30, k31), vb[3], CT[dt]); } while (0)
            UPD(0); UPD(1); UPD(2); UPD(3); UPD(4); UPD(5); UPD(6); UPD(7);
#undef UPD
        }
        __syncthreads();
        if (tid < 256) { float sacc = 0.f;
#pragma unroll 8
            for (int q = 0; q < 64; ++q) sacc += bf2f(*(const LAS unsigned short*)(lds + KS_OFF + (q * LD + tid) * 2)) * SC[256 + q];
            NV[tid] = decay * NV[tid] + sacc; }
        m_prev = m_new;
    }
    __syncthreads();
#undef CHUNK_ROW0
#undef PREFETCH
}
#undef MFMA32
#undef TR_WAIT
#undef CAT8
}

DI void phase_mixers(const Frame& F, const Args& a, int l, char* ldsg, int npass) {
    unsigned* head0 = (unsigned*)(F.ws + WS_CTL) + CW_QUEUE + 64 * l;
    volatile LAS unsigned* MISC = (volatile LAS unsigned*)(F.lds + LDS_BYTES - 64);
    const int n_ml = 32, n_la = 256, n_ga = 256, n_cx = (l == 0) ? 32 : 0, n_mix = n_ml + n_la + n_ga + 2 * n_cx;
    const int total = n_mix;
    const bf16_t* QLA = (const bf16_t*)(F.ws + WS_QLA); const bf16_t* KVLA = (const bf16_t*)(F.ws + WS_KVLA); const bf16_t* KR = (const bf16_t*)(F.ws + WS_KR);
    const bf16_t* QG = (const bf16_t*)(F.ws + WS_QG); const bf16_t* KG = (const bf16_t*)(F.ws + WS_KG); const bf16_t* P = (const bf16_t*)(F.ws + WS_P);
    bf16_t* YCAT = (bf16_t*)(F.ws + WS_YCAT);
#ifndef MK_MIX
#define MK_MIX 7
#endif
#define GRAB(u) do { __syncthreads(); if (F.tid == 0) MISC[4] = __hip_atomic_fetch_add(head, 1u, __ATOMIC_RELAXED, __HIP_MEMORY_SCOPE_AGENT); __syncthreads(); u = __builtin_amdgcn_readfirstlane((int)MISC[4]); } while (0)
    for (int pass = 0; pass < npass; ++pass) {
    unsigned* head = head0 + 128 * pass;
    int u0;
    GRAB(u0);
    while (u0 < n_ml) { if (MK_MIX & 1) ml::mlstm_stream(F, a, l, u0, l == 0); GRAB(u0); }
    while (u0 < n_mix) {
        int u = u0 - n_ml;
        if (u < n_la) { const int b = u >> 6, h = (u >> 3) & 7, qb = u & 7; const long q0 = (long)b * SEQ + qb * 256;
            if (MK_MIX & 2) att::attn_body<64, 1536, 2048, 2048, 3072>(QLA + q0 * 1536 + h * 192, KVLA + h * 256, KR, KVLA + h * 256 + 128, YCAT + q0 * 3072 + 1024 + h * 128,
                                                      MLAT + b * CTXL, 4, b * SEQ, 32, 0.07216878364870322f, (const float*)(F.ws + WS_ROPE_LA) + (size_t)qb * 256 * 64, ldsg); }
        else if (u < n_la + n_ga) { u -= n_la; const int b = u >> 6, h = (u >> 3) & 7, qb = u & 7; const long q0 = (long)b * SEQ + qb * 256;
            if (MK_MIX & 4) att::attn_body<0, 1024, 256, NP, 3072>(QG + q0 * 1024 + h * 128, KG + (h >> 2) * 128, nullptr, P + C_GV + (h >> 2) * 128, YCAT + q0 * 3072 + 2048 + h * 128,
                                                  MLAT + b * CTXL, 4, b * SEQ, 32, 0.08838834764831845f, nullptr, ldsg); }
        else if (u < n_la + n_ga + n_cx) { u -= n_la + n_ga; const int b = u >> 3, h = u & 7; const long q0 = (long)MLAT + b * CTXL;
            if (MK_MIX & 2) att::attn_body<64, 1536, 2048, 2048, 3072>(QLA + q0 * 1536 + h * 192, KVLA + h * 256, KR, KVLA + h * 256 + 128, YCAT + q0 * 3072 + 1024 + h * 128,
                                                      MLAT + b * CTXL, 4, 0, 0, 0.07216878364870322f, nullptr, ldsg); }
        else { u -= n_la + n_ga + n_cx; const int b = u >> 3, h = u & 7; const long q0 = (long)MLAT + b * CTXL;
            if (MK_MIX & 4) att::attn_body<0, 1024, 256, NP, 3072>(QG + q0 * 1024 + h * 128, KG + (h >> 2) * 128, nullptr, P + C_GV + (h >> 2) * 128, YCAT + q0 * 3072 + 2048 + h * 128,
                                                  MLAT + b * CTXL, 4, 0, 0, 0.08838834764831845f, nullptr, ldsg); }
        GRAB(u0);
    }
    }
#undef GRAB
}

DI void phase_convert_tail(const Frame& F0, const Args& a, int l) {
    Frame F = F0; { int t_ = threadIdx.x; asm volatile("" : "+v"(t_)); F.tid = t_; F.lane = t_ & 63; F.wave = __builtin_amdgcn_readfirstlane(t_ >> 6); }
    constexpr int CVB = 64;
    unsigned* head = (unsigned*)(F.ws + WS_CTL) + CW_QUEUE + 64 * l + 32;
    volatile LAS unsigned* MISC = (volatile LAS unsigned*)(F.lds + LDS_BYTES - 64);
    const int n_cv = ((IT_LAYER - IT_EARLY) + ((l == 0) ? IT_EARLY : 0)) / CVB;
    LAS float* scr = (LAS float*)(F.lds + F.wave * 16384);
    for (;;) {
        __syncthreads();
        if (F.tid == 0) MISC[4] = __hip_atomic_fetch_add(head, 1u, __ATOMIC_RELAXED, __HIP_MEMORY_SCOPE_AGENT);
        __syncthreads();
        const int blk = __builtin_amdgcn_readfirstlane((int)MISC[4]);
        if (blk >= n_cv) break;
#pragma unroll 1
        for (int q = 0; q < CVB / NWAVES; ++q) { const int r = blk * CVB + q * NWAVES + F.wave;
            if (r < IT_LAYER - IT_EARLY) convert_item(F, a, l, IT_EARLY + r, scr); else convert_item(F, a, 1, r - (IT_LAYER - IT_EARLY), scr); }
    }
}

DI void phase_mlfin(const Frame& F, const Args& a, int l, int nrows) {
    const float* H0 = (const float*)(F.ws + WS_MLH); const float* H1 = H0 + (size_t)MTOT * 1024;
    const bf16_t* P = (const bf16_t*)(F.ws + WS_P); bf16_t* YCAT = (bf16_t*)(F.ws + WS_YCAT); const float* gn = a.in[I_MLNORM] + l * 1024;
    for (int row = F.gw; row < nrows; row += F.ngw) {
#pragma unroll
        for (int hd = 0; hd < 4; ++hd) { const int c = hd * 256 + 4 * F.lane;
            const f32x4 v = *(const f32x4*)(H0 + (size_t)row * 1024 + c) + *(const f32x4*)(H1 + (size_t)row * 1024 + c);
            const float rs = rsqrtf(wave_sum(v.x * v.x + v.y * v.y + v.z * v.z + v.w * v.w) * (1.f / 256.f) + EPS);
            const f32x4 g = *(const f32x4*)(gn + c); const s16x4 og = *(const s16x4*)(P + (size_t)row * NP + C_MLO + c);
            u32x2 w; w.x = pk2(v.x * rs * g.x * sigmoidf_(bf2f((unsigned short)og[0])), v.y * rs * g.y * sigmoidf_(bf2f((unsigned short)og[1])));
            w.y = pk2(v.z * rs * g.z * sigmoidf_(bf2f((unsigned short)og[2])), v.w * rs * g.w * sigmoidf_(bf2f((unsigned short)og[3])));
            *(u32x2*)(YCAT + (size_t)row * 3072 + c) = w; }
    }
}

struct SchedMerge {
    const char* Y; const char* Bt; int nM, G, c;
    DI bool next(int i, Unit& u) const {
        const int k = i / 3, br = i - 3 * k; const long L = (long)k * G + c; if (L >= (long)nM * 8) return false;
        int pm, pn; pg8::tile_of((int)L, nM, 8, pm, pn);
        u.pm = pm; u.pn = pn; u.aux = br; u.nt = 16; u.pa = Y + (size_t)pm * 256 * 6144 + br * 2048; u.pb = Bt + ((size_t)br * 2048 + pn * 256) * 2048; return true;
    }
};
struct EpiMerge {
    const bf16_t* P; bf16_t* ZG; bf16_t* MB;
    DI void operator()(const f32x4 (&acc)[2][2][4][2], const Unit& u, int wr, int wc, int fr, int fq) const {
        const int br = u.aux;
        EPI_FOREACH({
            const bf16x8 gp = *(const bf16x8*)(P + (size_t)row * NP + C_GATE + br * 2048 + col);
            f32x4 g0, g1;
            g0.x = sigmoidf_(bf2f((unsigned short)gp[0])); g0.y = sigmoidf_(bf2f((unsigned short)gp[1])); g0.z = sigmoidf_(bf2f((unsigned short)gp[2])); g0.w = sigmoidf_(bf2f((unsigned short)gp[3]));
            g1.x = sigmoidf_(bf2f((unsigned short)gp[4])); g1.y = sigmoidf_(bf2f((unsigned short)gp[5])); g1.z = sigmoidf_(bf2f((unsigned short)gp[6])); g1.w = sigmoidf_(bf2f((unsigned short)gp[7]));
            f32x4 r0 = v0 * g0, r1 = v1 * g1;
            const size_t off = (size_t)row * DM + col;
            if (br < 2) *(u32x4*)(ZG + (size_t)br * MTOT * DM + off) = pack8(r0, r1);
            else { const bf16x8 z0 = *(const bf16x8*)(ZG + off), z1 = *(const bf16x8*)(ZG + (size_t)MTOT * DM + off);
                r0 += (f32x4){bf2f((unsigned short)z0[0]) + bf2f((unsigned short)z1[0]), bf2f((unsigned short)z0[1]) + bf2f((unsigned short)z1[1]), bf2f((unsigned short)z0[2]) + bf2f((unsigned short)z1[2]), bf2f((unsigned short)z0[3]) + bf2f((unsigned short)z1[3])};
                r1 += (f32x4){bf2f((unsigned short)z0[4]) + bf2f((unsigned short)z1[4]), bf2f((unsigned short)z0[5]) + bf2f((unsigned short)z1[5]), bf2f((unsigned short)z0[6]) + bf2f((unsigned short)z1[6]), bf2f((unsigned short)z0[7]) + bf2f((unsigned short)z1[7])};
                *(u32x4*)(MB + off) = pack8(r0, r1); }
        })
    }
};
struct EpiOut {
    const float* xin; const float* ctxin; float* X1; const float* mods; int l;
    DI void operator()(const f32x4 (&acc)[2][2][4][2], const Unit& u, int wr, int wc, int fr, int fq) const {
        EPI_FOREACH({
            const float* rp = (l == 0) ? (row < MLAT ? xin + (size_t)row * DM : ctxin + (size_t)(row - MLAT) * DM) : X1 + (size_t)row * DM;
            const float* gp = mods + ((size_t)(l * 5 + mods_row(row)) * 6 + 2) * DM + col;
            float* op = X1 + (size_t)row * DM + col;
            *(f32x4*)op = *(const f32x4*)(rp + col) + *(const f32x4*)gp * v0; *(f32x4*)(op + 4) = *(const f32x4*)(rp + col + 4) + *(const f32x4*)(gp + 4) * v1;
        })
    }
};
DI void phase_topk(const Frame& F, const Args& a, int l, int bid) {
    const float* AFF = (const float*)(F.ws + WS_AFF); const bf16_t* H = (const bf16_t*)(F.ws + WS_H);
    int* ROWS = (int*)(F.ws + WS_ROWS); float* VALS = (float*)(F.ws + WS_VALS); bf16_t* AG = (bf16_t*)(F.ws + WS_AG); int* TOK = (int*)(F.ws + WS_TOK);
    LAS float* vals = (LAS float*)F.lds; LAS int* lst = (LAS int*)(F.lds + 8192); LAS int* cnt = (LAS int*)(F.lds + 8192 + 4096);
    const int nitems = (l == 0) ? 256 + 64 + 16 : 256;
    for (int it = bid; it < nitems; it += F.G) {
        if (it >= 320) {
            const int e = it - 320;
            for (int s = F.tid; s < 128; s += NTHR) { ROWS[e * ESLOT + 1152 + s] = -1; VALS[e * ESLOT + 1152 + s] = 0.f; }
            u32x4* dst = (u32x4*)(AG + ((size_t)e * ESLOT + 1152) * DM);
            unsigned z = 0u; asm volatile("" : "+v"(z));
            for (int i = F.tid; i < 128 * DM / 8; i += NTHR) dst[i] = (u32x4){z, z, z, z};
            continue;
        }
        const int lat = it < 256, b = lat ? (it >> 6) : ((it - 256) >> 4), e = lat ? ((it >> 2) & 15) : ((it - 256) & 15), qtr = lat ? (it & 3) : 0;
        const int ntok = lat ? SEQ : CTXL, cap = ntok >> 3, rowbase = lat ? b * SEQ : MLAT + b * CTXL, slotbase = lat ? b * 256 : 1024 + b * 32;
        __syncthreads();
        for (int i = F.tid; i < ntok; i += NTHR) vals[i] = AFF[(size_t)(rowbase + i) * 16 + e];
        if (F.tid == 0) cnt[0] = 0;
        __syncthreads();
        {
            const int i = qtr * 512 + F.tid; const bool act = i < ntok; const float v = act ? vals[i] : 0.f; int rk = 0;
            for (int j = 0; j < ntok; j += 4) { const f32x4 vj = *(const LAS f32x4*)(vals + j);
                rk += (vj.x > v || (vj.x == v && j < i)) + (vj.y > v || (vj.y == v && j + 1 < i)) + (vj.z > v || (vj.z == v && j + 2 < i)) + (vj.w > v || (vj.w == v && j + 3 < i)); }
            if (act) { TOK[(size_t)(rowbase + i) * 16 + e] = rk < cap ? slotbase + rk : -1;
                if (rk < cap) { const int p = atomicAdd((int*)cnt, 1); lst[2 * p] = i; lst[2 * p + 1] = rk; ROWS[e * ESLOT + slotbase + rk] = rowbase + i; VALS[e * ESLOT + slotbase + rk] = v; } }
        }
        __syncthreads();
        const int n = cnt[0];
        for (int s = F.wave; s < n; s += 2 * NWAVES) {
            const int s2 = s + NWAVES; const bool two = s2 < n;
            const u32x4* src0 = (const u32x4*)(H + (size_t)(rowbase + lst[2 * s]) * DM); u32x4* dst0 = (u32x4*)(AG + ((size_t)e * ESLOT + slotbase + lst[2 * s + 1]) * DM);
            const u32x4* src1 = (const u32x4*)(H + (size_t)(rowbase + lst[2 * (two ? s2 : s)]) * DM); u32x4* dst1 = (u32x4*)(AG + ((size_t)e * ESLOT + slotbase + lst[2 * (two ? s2 : s) + 1]) * DM);
            u32x4 r0[4], r1[4];
#pragma unroll
            for (int q = 0; q < 4; ++q) { r0[q] = src0[F.lane + 64 * q]; r1[q] = src1[F.lane + 64 * q]; }
#pragma unroll
            for (int q = 0; q < 4; ++q) { dst0[F.lane + 64 * q] = r0[q]; dst1[F.lane + 64 * q] = r1[q]; }
        }
    }
    __syncthreads();
}
struct SchedMoe {
    const char* A; const char* Bt; int lda, ldb, nMt, nt, G, c;
    DI bool next(int i, Unit& u) const {
        const long L = (long)i * G + c; if (L >= (long)NEXP * nMt * 8) return false;
        const int e = (int)L / (nMt * 8), rem = (int)L % (nMt * 8), mt = rem % nMt, pn = rem / nMt;
        u.pm = e * 5 + mt; u.pn = pn; u.aux = e; u.nt = nt; u.pa = A + ((size_t)e * ESLOT + mt * 256) * lda; u.pb = Bt + ((size_t)e * 2048 + pn * 256) * ldb; return true;
    }
};
struct EpiMoe1 {
    bf16_t* ACT;
    DI void operator()(const f32x4 (&acc)[2][2][4][2], const Unit& u, int wr, int wc, int fr, int fq) const {
#pragma unroll
        for (int ai = 0; ai < 2; ++ai)
#pragma unroll
            for (int m = 0; m < 4; ++m) { const int row = u.pm * 256 + ai * 128 + wr * 64 + m * 16 + fr; const int col = u.pn * 128 + wc * 32 + 8 * fq;
                f32x4 r0, r1;
#pragma unroll
                for (int i = 0; i < 4; ++i) { r0[i] = siluf_(acc[ai][0][m][0][i]) * acc[ai][1][m][0][i]; r1[i] = siluf_(acc[ai][0][m][1][i]) * acc[ai][1][m][1][i]; }
                *(u32x4*)(ACT + (size_t)row * EFF + col) = pack8(r0, r1); }
    }
};
struct EpiMoe2 {
    const float* VALS; bf16_t* YE;
    DI void operator()(const f32x4 (&acc)[2][2][4][2], const Unit& u, int wr, int wc, int fr, int fq) const {
        EPI_FOREACH({ const float val = VALS[row]; *(u32x4*)(YE + (size_t)row * DM + col) = pack8(v0 * val, v1 * val); })
    }
};
DI void phase_final(const Frame& F, const Args& a) {
    const float* g = a.in[I_FNORM];
    for (int row = F.gw; row < MLAT; row += F.ngw) {
        f32x4 v[8]; float ss = 0.f;
        combine_row(F, DEPTH - 1, row, v);
#pragma unroll
        for (int j = 0; j < 8; ++j) ss += v[j].x * v[j].x + v[j].y * v[j].y + v[j].z * v[j].z + v[j].w * v[j].w;
        const float rs = rsqrtf(wave_sum(ss) * (1.f / DM) + EPS);
#pragma unroll
        for (int j = 0; j < 8; ++j) *(f32x4*)(a.out + (size_t)row * DM + 4 * F.lane + 256 * j) = v[j] * rs * *(const f32x4*)(g + 4 * F.lane + 256 * j);
    }
}

#ifndef MK_LAST_PHASE
#define MK_LAST_PHASE 1000
#endif
constexpr int PH_PER_LAYER = 12, N_PHASES = 2 + 2 * PH_PER_LAYER + 1;
__global__ void __launch_bounds__(NTHR, 2) mega(const Args args) {
    extern __shared__ __attribute__((aligned(16))) unsigned char lds[];
    Frame F0;
    F0.lds = (LAS unsigned char*)lds; F0.ws = args.ws;
    F0.tid = threadIdx.x; F0.lane = F0.tid & 63; F0.wave = __builtin_amdgcn_readfirstlane(F0.tid >> 6);
    F0.G = gridDim.x; { const int bx = blockIdx.x; F0.vcu = (F0.G % 8 == 0) ? (bx % 8) * (F0.G / 8) + bx / 8 : bx; }
    F0.gw = F0.vcu * NWAVES + F0.wave; F0.ngw = F0.G * NWAVES;
    volatile LAS unsigned* MISC = (volatile LAS unsigned*)(F0.lds + LDS_BYTES - 64);
    if (F0.tid < 16) MISC[F0.tid] = 0u;
    __syncthreads();
    unsigned* ctl = (unsigned*)(F0.ws + WS_CTL);
    XcdBarrier bar = xcd_barrier_post(ctl + CW_BAR, MISC + 8);
    const int lo = args.ph_lo, hi = args.ph_hi;
    int ph = 0, bid = 0;
#ifndef MK_EN
#define MK_EN 0xFFFF
#endif
#define EN(x) ((MK_EN >> (x)) & 1)
#ifndef MK_REP
#define MK_REP 0
#endif
#ifndef MK_BARX
#define MK_BARX 0
#endif
#define REP(pid_) ((MK_REP >> (pid_)) & 1)
#define PHASE(pid_, ...) if (EN(pid_) && lo <= ph && ph < hi) { Frame F = F0; { unsigned long long w_ = (unsigned long long)F0.ws; asm volatile("" : "+s"(w_)); F.ws = (unsigned char*)w_; \
        asm volatile("" : "+s"(F.G), "+s"(F.vcu)); F.ngw = F.G * NWAVES; bid = blockIdx.x; asm volatile("" : "+s"(bid)); \
        int t_ = threadIdx.x; asm volatile("" : "+v"(t_)); F.tid = t_; F.lane = t_ & 63; F.wave = __builtin_amdgcn_readfirstlane(t_ >> 6); F.gw = F.vcu * NWAVES + F.wave; } \
        { const int rep = 0; (void)rep; __VA_ARGS__ } if (REP(pid_)) { const int rep = 1; (void)rep; __VA_ARGS__ } \
        if (ph + 1 < hi) { xcd_barrier(bar); if (MK_BARX) xcd_barrier(bar); } } ++ph;

#define PHASE5(...) if (EN(5) && lo <= ph && ph < hi) { Frame F = F0; { unsigned long long w_ = (unsigned long long)F0.ws; asm volatile("" : "+s"(w_)); F.ws = (unsigned char*)w_; \
        asm volatile("" : "+s"(F.G), "+s"(F.vcu)); F.ngw = F.G * NWAVES; bid = blockIdx.x; asm volatile("" : "+s"(bid)); \
        int t_ = threadIdx.x; asm volatile("" : "+v"(t_)); F.tid = t_; F.lane = t_ & 63; F.wave = __builtin_amdgcn_readfirstlane(t_ >> 6); F.gw = F.vcu * NWAVES + F.wave; } \
        { __VA_ARGS__ } if (ph + 1 < hi) { xcd_barrier(bar); if (MK_BARX) xcd_barrier(bar); } } ++ph;
    PHASE(0, phase_prologue(F, args, rep);)
    PHASE(14, phase_mods_reduce(F, args);)
    for (int l = 0; l < DEPTH; ++l) {
        const size_t wlo = WS_W + (size_t)l * W_LAYER;
        const int nM = (l == 0) ? 36 : 32;
        PHASE(1, phase_mod1(F, args, l);)
        PHASE(2, {
            SchedProj S{(const char*)(F.ws + WS_H), (const char*)(F.ws + wlo + W_IN), l, F.G, bid};
            EpiProj E{(bf16_t*)(F.ws + WS_P), (float*)(F.ws + WS_X80)};
            pg8::gemm_phase(F.lds, DM * 2, DM * 2, S, E); })
        PHASE(3, phase_postproj(F, args, l);)
        PHASE(4, {
            { SchedDense S{(const char*)(F.ws + WS_CQN), (const char*)(F.ws + wlo + W_UQ), 512 * 2, 512 * 2, nM, 6, 8, F.G, bid};
              EpiStoreBf16 E{(bf16_t*)(F.ws + WS_QLA), 1536}; pg8::gemm_phase(F.lds, 512 * 2, 512 * 2, S, E); }
            { SchedDense S{(const char*)(F.ws + WS_CKVN), (const char*)(F.ws + wlo + W_UKV), 256 * 2, 256 * 2, 36, 8, 4, F.G, (bid + 128) % F.G};
              EpiStoreBf16 E{(bf16_t*)(F.ws + WS_KVLA), 2048}; pg8::gemm_phase(F.lds, 256 * 2, 256 * 2, S, E); } })
        PHASE5(phase_mixers(F, args, l, (char*)lds, 1 + REP(5)); phase_convert_tail(F, args, l);)
        PHASE(6, phase_mlfin(F, args, l, nM * 256);)
        PHASE(7, {
            SchedMerge S{(const char*)(F.ws + WS_YCAT), (const char*)(F.ws + wlo + W_BR), nM, F.G, bid};
            EpiMerge E{(const bf16_t*)(F.ws + WS_P), (bf16_t*)(F.ws + WS_MF32), (bf16_t*)(F.ws + WS_MBF)};
            pg8::gemm_phase(F.lds, 3072 * 2, 1024 * 2, S, E); })
        PHASE(8, {
            SchedDense S{(const char*)(F.ws + WS_MBF), (const char*)(F.ws + wlo + W_OUT), DM * 2, DM * 2, nM, 8, 32, F.G, bid};
            EpiOut E{args.in[I_X], args.in[I_CTX], (float*)(F.ws + WS_X1), (const float*)(F.ws + WS_MODS), l};
            if (rep == 0 || l == 0) pg8::gemm_phase(F.lds, DM * 2, DM * 2, S, E); })
        PHASE(9, phase_mod2(F, args, l, nM * 256);)
        PHASE(10, phase_topk(F, args, l, bid);)
        PHASE(11, {
            SchedMoe S{(const char*)(F.ws + WS_AG), (const char*)(F.ws + wlo + W_E13), DM * 2, DM * 2, (l == 0) ? 5 : 4, 32, F.G, bid};
            EpiMoe1 E{(bf16_t*)(F.ws + WS_ACT)};
            pg8::gemm_phase(F.lds, DM * 2, DM * 2, S, E); })
        PHASE(12, {
            SchedMoe S{(const char*)(F.ws + WS_ACT), (const char*)(F.ws + wlo + W_E2), EFF * 2, EFF * 2, (l == 0) ? 5 : 4, 16, F.G, bid};
            EpiMoe2 E{(const float*)(F.ws + WS_VALS), (bf16_t*)(F.ws + WS_YE)};
            pg8::gemm_phase(F.lds, EFF * 2, EFF * 2, S, E); })
    }
    PHASE(13, phase_final(F, args);)
#undef PHASE
}


extern "C" void kernel_launch(void* const* d_in, const int* in_sizes, int n_in, void* d_out, int out_size, void* d_ws, size_t ws_size, hipStream_t stream) {
    static int grid = 0;
    if (grid == 0) {
        if (n_in != 24 || out_size != MLAT * DM || ws_size < WS_END) { fprintf(stderr, "kernel_launch: unexpected shapes: n_in %d out %d ws %zu (need %zu)\n", n_in, out_size, ws_size, (size_t)WS_END); grid = -1; return; }
        int dev = 0, cus = 0, per_cu = 0;
        if (hipGetDevice(&dev) != hipSuccess || hipDeviceGetAttribute(&cus, hipDeviceAttributeMultiprocessorCount, dev) != hipSuccess) { grid = -1; return; }
        if (hipFuncSetAttribute((const void*)mega, hipFuncAttributeMaxDynamicSharedMemorySize, LDS_BYTES) != hipSuccess) { fprintf(stderr, "kernel_launch: hipFuncSetAttribute failed\n"); grid = -1; return; }
        if (hipOccupancyMaxActiveBlocksPerMultiprocessor(&per_cu, (const void*)mega, NTHR, LDS_BYTES) != hipSuccess || per_cu < 1) { fprintf(stderr, "kernel_launch: occupancy query says %d blocks per CU\n", per_cu); }
        (void)hipGetLastError();
        grid = cus;
    }
    if (grid < 0) return;
    if (hipMemsetAsync((char*)d_ws + WS_CTL, 0, CTL_BYTES, stream) != hipSuccess) return;
    Args a{};
    for (int i = 0; i < 24; ++i) a.in[i] = (const float*)d_in[i];
    a.out = (float*)d_out; a.ws = (unsigned char*)d_ws; a.ph_lo = 0; a.ph_hi = N_PHASES < MK_LAST_PHASE ? N_PHASES : MK_LAST_PHASE;
    hipLaunchKernelGGL(mega, dim3(grid), dim3(NTHR), LDS_BYTES, stream, a);
}
```

```cpp
#include <hip/hip_runtime.h>
#include <cstdio>
#include <cstdint>

#define GAS __attribute__((address_space(1)))
#define LAS __attribute__((address_space(3)))
#define DI __device__ __forceinline__
typedef unsigned short bf16_t;
typedef short bf16x8 __attribute__((ext_vector_type(8)));
typedef short s16x4 __attribute__((ext_vector_type(4)));
typedef float f32x2 __attribute__((ext_vector_type(2)));
typedef float f32x4 __attribute__((ext_vector_type(4)));
typedef float f32x8 __attribute__((ext_vector_type(8)));
typedef float f32x16 __attribute__((ext_vector_type(16)));
typedef unsigned u32x2 __attribute__((ext_vector_type(2)));
typedef unsigned u32x4 __attribute__((ext_vector_type(4)));

constexpr int DM = 2048, NBATCH = 4, SEQ = 2048, CTXL = 256, DEPTH = 2;
constexpr int MLAT = NBATCH * SEQ, MCTX = NBATCH * CTXL, MTOT = MLAT + MCTX;
constexpr int PROJW = 12624, NP = 12800;
constexpr int C_MLQ = 0, C_MLK = 1024, C_MLV = 2048, C_MLO = 3072, C_CQ = 4096, C_CKV = 4608, C_GQ = 4864, C_GK = 5888, C_GV = 6144, C_GATE = 6400, C_X = 12544;
constexpr int XW = 80;
constexpr int NEXP = 16, EFF = 1024, ESLOT = 1280;
constexpr float EPS = 1e-6f;
constexpr int NWAVES = 8, NTHR = 512;

constexpr size_t al256(size_t x) { return (x + 255) / 256 * 256; }
constexpr size_t WS_CTL = 0, CTL_BYTES = 2u << 20;
constexpr int CW_BAR = 1024;
constexpr int CW_QUEUE = 8192;
constexpr size_t WS_MODS = 1u << 20;
constexpr size_t WS_ROPE_LA = WS_CTL + CTL_BYTES;
constexpr size_t WS_ROPE_GA = WS_ROPE_LA + al256((size_t)2048 * 32 * 2 * 4);
constexpr size_t WS_W = WS_ROPE_GA + al256((size_t)2048 * 64 * 2 * 4);
constexpr size_t W_IN = 0, W_UQ = W_IN + (size_t)NP * DM * 2, W_UKV = W_UQ + (size_t)1536 * 512 * 2, W_BR = W_UKV + (size_t)2048 * 256 * 2,
                 W_OUT = W_BR + (size_t)3 * 2048 * 1024 * 2, W_E13 = W_OUT + (size_t)2048 * 2048 * 2, W_E2 = W_E13 + (size_t)NEXP * 2048 * 2048 * 2,
                 W_LAYER = W_E2 + (size_t)NEXP * 2048 * 1024 * 2;
constexpr size_t WS_H = WS_W + 2 * W_LAYER;
constexpr size_t WS_P = WS_H + (size_t)MTOT * DM * 2;
constexpr size_t WS_AG = WS_P;
constexpr size_t WS_ACT = WS_AG + (size_t)NEXP * ESLOT * DM * 2;
static_assert(WS_ACT + (size_t)NEXP * ESLOT * EFF * 2 <= WS_P + (size_t)MTOT * NP * 2, "overlay");
constexpr size_t WS_X80 = WS_P + (size_t)MTOT * NP * 2;
constexpr size_t WS_CQN = WS_X80 + al256((size_t)MTOT * XW * 4);
constexpr size_t WS_CKVN = WS_CQN + (size_t)MTOT * 512 * 2;
constexpr size_t WS_QG = WS_CKVN + (size_t)MTOT * 256 * 2;
constexpr size_t WS_KG = WS_QG + (size_t)MTOT * 1024 * 2;
constexpr size_t WS_KR = WS_KG + (size_t)MTOT * 256 * 2;
constexpr size_t WS_QLA = WS_KR + (size_t)MTOT * 64 * 2;
constexpr size_t WS_KVLA = WS_QLA + (size_t)MTOT * 1536 * 2;
constexpr size_t WS_YCAT = WS_KVLA + (size_t)MTOT * 2048 * 2;
constexpr size_t WS_MF32 = WS_YCAT + (size_t)MTOT * 3072 * 2;
constexpr size_t WS_MLH = WS_MF32;
constexpr size_t WS_MBF = WS_MF32 + (size_t)MTOT * DM * 4;
constexpr size_t WS_X1 = WS_MBF + (size_t)MTOT * DM * 2;
constexpr size_t WS_AFF = WS_X1 + (size_t)MTOT * DM * 4;
constexpr size_t WS_ROWS = WS_AFF + (size_t)MTOT * 16 * 4;
constexpr size_t WS_VALS = WS_ROWS + (size_t)NEXP * ESLOT * 4;
constexpr size_t WS_TOK = WS_VALS + (size_t)NEXP * ESLOT * 4;
constexpr size_t WS_MPART = WS_TOK + (size_t)MTOT * 16 * 4;
constexpr size_t WS_END = WS_MPART + (size_t)16 * 2 * 5 * 12288 * 4;
constexpr size_t WS_YE = WS_AG;

constexpr int RING_BYTES = 131072;
constexpr int MISC_OFF = RING_BYTES + 1024;
constexpr int LDS_BYTES = 147456;

DI float bf2f(unsigned short b) { return __uint_as_float(((unsigned)b) << 16); }
DI unsigned f2bf(float f) { unsigned u = __float_as_uint(f); return (u + 0x7fffu + ((u >> 16) & 1u)) >> 16; }
DI unsigned pk2(float lo, float hi) { unsigned r; asm volatile("v_cvt_pk_bf16_f32 %0, %1, %2" : "=v"(r) : "v"(lo), "v"(hi)); return r; }
DI float wave_sum(float v) {
#pragma unroll
    for (int o = 1; o < 64; o <<= 1) v += __shfl_xor(v, o);
    return v;
}
DI float wave_max(float v) {
#pragma unroll
    for (int o = 1; o < 64; o <<= 1) v = fmaxf(v, __shfl_xor(v, o));
    return v;
}
DI float sigmoidf_(float x) { return 1.f / (1.f + __expf(-x)); }
DI float siluf_(float x) { return x / (1.f + __expf(-x)); }
#define LDS_WAIT() asm volatile("s_waitcnt lgkmcnt(0)" ::: "memory")
#define VM_WAIT() asm volatile("s_waitcnt vmcnt(0)" ::: "memory")

#define XB_TMO      128
#define XB_XCNT(j)  (256  + 64 * (j))
#define XB_XSUB(j)  (1280 + 64 * (j))
#define XB_XGEN(j)  (2304 + 64 * (j))
#define XB_TOP      3328
#define XB_TOPGEN   3392
#define XCD_BAR_WORDS 3456
#define XB_SPIN_CAP (1u << 20)

DI unsigned xb_ld(unsigned* p)              { return __hip_atomic_load(p, __ATOMIC_RELAXED, __HIP_MEMORY_SCOPE_AGENT); }
DI unsigned xb_add(unsigned* p, unsigned v) { return __hip_atomic_fetch_add(p, v, __ATOMIC_RELAXED, __HIP_MEMORY_SCOPE_AGENT); }
DI unsigned xb_xcc_id() { return (unsigned)__builtin_amdgcn_s_getreg((3 << 11) | 20) & 0xFu; }
#define XB_SPIN(cond, bar) do { unsigned _sp = 0; while (cond) { __builtin_amdgcn_s_sleep(1); \
    if ((++_sp & 255u) == 0u) { if (xb_ld(&(bar)[XB_TMO])) break; if (_sp > XB_SPIN_CAP) { atomicAdd(&(bar)[XB_TMO], 1u); break; } } } } while (0)

struct XcdBarrier { unsigned* bar; unsigned x; volatile LAS unsigned* st; };

DI XcdBarrier xcd_barrier_post(unsigned* bar, volatile LAS unsigned* st) {
    XcdBarrier b; b.bar = bar; b.x = xb_xcc_id(); b.st = st;
    if (threadIdx.x == 0) (void)xb_add(&bar[XB_XCNT(b.x)], 1u);
    return b;
}
DI void xcd_barrier_complete(unsigned* bar, unsigned x, unsigned& nloc, unsigned& nx) {
    const unsigned G = gridDim.x * gridDim.y * gridDim.z;
    unsigned sum, cnt, mine, sp = 0u;
    for (;;) {
        sum = 0u; cnt = 0u; mine = 0u;
#pragma unroll
        for (unsigned j = 0; j < 16; ++j) { const unsigned c = xb_ld(&bar[XB_XCNT(j)]); sum += c; cnt += (c > 0u) ? 1u : 0u; mine = (j == x) ? c : mine; }
        if (sum == G) break;
        __builtin_amdgcn_s_sleep(1);
        if ((++sp & 255u) == 0u) { if (xb_ld(&bar[XB_TMO])) break; if (sp > XB_SPIN_CAP) { atomicAdd(&bar[XB_TMO], 1u); break; } }
    }
    nloc = mine > 0u ? mine : 1u; nx = cnt > 0u ? cnt : 1u;
}
DI void xcd_barrier(const XcdBarrier& b) {
    asm volatile("s_waitcnt vmcnt(0)" ::: "memory");
    __syncthreads();
    if (threadIdx.x == 0) {
        unsigned* bar = b.bar; asm volatile("" : "+s"(bar));
        __builtin_amdgcn_s_waitcnt(0);
        unsigned nloc = b.st[0], nx = b.st[1];
        unsigned bx = b.x; asm volatile("" : "+s"(bx));
        if (nloc == 0u) { xcd_barrier_complete(bar, bx, nloc, nx); b.st[0] = nloc; b.st[1] = nx; }
        const unsigned old = xb_add(&bar[XB_XSUB(bx)], 1u);
        const unsigned gen = old / nloc;
        if (old + 1u == (gen + 1u) * nloc) {
            __builtin_amdgcn_fence(__ATOMIC_RELEASE, "agent");
            asm volatile("s_waitcnt vmcnt(0)" ::: "memory");
            const unsigned og = xb_add(&bar[XB_TOP], 1u);
            const unsigned tg = og / nx;
            if (og + 1u == (tg + 1u) * nx) xb_add(&bar[XB_TOPGEN], 1u);
            else XB_SPIN(xb_ld(&bar[XB_TOPGEN]) == tg, bar);
            __builtin_amdgcn_fence(__ATOMIC_ACQUIRE, "agent");
            xb_add(&bar[XB_XGEN(bx)], 1u);
            asm volatile("s_waitcnt vmcnt(0)" ::: "memory");
        } else {
            XB_SPIN(xb_ld(&bar[XB_XGEN(bx)]) == gen, bar);
            __builtin_amdgcn_fence(__ATOMIC_ACQUIRE, "agent");
            asm volatile("s_waitcnt vmcnt(0)" ::: "memory");
        }
    }
    __syncthreads();
}

struct Args { const float* in[24]; float* out; unsigned char* ws; int ph_lo, ph_hi; };
enum { I_X = 0, I_C, I_CTX, I_CCTX, I_WMOD, I_BMOD, I_WIN, I_GBIAS, I_MLNORM, I_LAQN, I_LAKVN, I_UQ, I_UKV, I_GAQN, I_GAKN, I_BRML, I_BRLA, I_BRGA, I_WOUT, I_WROUTER, I_WE1, I_WE3, I_WE2, I_FNORM };

struct Frame {
    LAS unsigned char* lds;
    unsigned char* ws;
    int tid, lane, wave, G, vcu, gw, ngw;
};

DI int mods_row(int row) { return row < MLAT ? (row >> 11) : 4; }
DI const float* mods_ptr(const Frame& F, int l, int row, int which  ) {
    return (const float*)(F.ws + WS_MODS) + ((size_t)(l * 5 + mods_row(row)) * 6 + which) * DM;
}

namespace pg8 {
constexpr int BM = 256, BK = 64, HALF = 128, HTB = HALF * BK * 2, STAGE_BYTES = 8 * HTB, NXCD = 8, WGM = 8;
__host__ __device__ __forceinline__ int lds_byte(int r, int c) { const int st = (r >> 4) * 2 + (c >> 5), rr = r & 15, cc = c & 31, ob = rr * 64 + cc * 2; return st * 1024 + (ob ^ (((ob >> 9) & 1) << 5)); }
__host__ __device__ __forceinline__ void stage_rc(int b, int& R, int& C) { const int st = b / 1024, sb = b % 1024, swz = sb ^ (((sb >> 9) & 1) << 5); R = (st >> 1) * 16 + swz / 64; C = (st & 1) * 32 + (swz % 64) / 2; }
__host__ __device__ __forceinline__ int perm32(int rho) { const int n = rho >> 4, i = rho & 15; return 8 * (i >> 2) + 4 * n + (i & 3); }

struct Unit { const char* pa; const char* pb; int pm, pn, aux, nt; };

DI void tile_of(int L, int nM, int nN, int& pm, int& pn) {
    const int nwg = nM * nN; int wgid = L;
    { const int q = nwg / NXCD, r = nwg % NXCD, xcd = wgid % NXCD, off = wgid / NXCD; wgid = (xcd < r ? xcd * (q + 1) : r * (q + 1) + (xcd - r) * q) + off; }
    const int nig = WGM * nN, gid = wgid / nig, fm = gid * WGM, gsz = (nM - fm) < WGM ? (nM - fm) : WGM;
    pm = fm + ((wgid % nig) % gsz); pn = (wgid % nig) / gsz;
}

template <class Epi, class Sched>
DI void gemm_phase(LAS unsigned char* lds, const int lda  , const int ldb  , const Sched& S, const Epi& E) {
    int tid = threadIdx.x; asm volatile("" : "+v"(tid));
    const int wid = __builtin_amdgcn_readfirstlane(tid >> 6), lane = tid & 63, wr = wid >> 2, wc = wid & 3, fr = lane & 15, fq = lane >> 4;
    unsigned voffA[2], voffB[2];
#pragma unroll
    for (int i = 0; i < 2; ++i) { int R, C; stage_rc(tid * 16 + i * 8192, R, C); const int Rb = (R & ~31) + perm32(R & 31);
        voffA[i] = (unsigned)(R * lda + C * 2); voffB[i] = (unsigned)(Rb * ldb + C * 2); }
    const size_t kstep = (size_t)(BK * 2);
    const size_t hstepA = (size_t)HALF * lda, hstepB = (size_t)HALF * ldb;
    const unsigned ldsw = (unsigned)wid * 1024u;
    const int aoff = lds_byte(wr * 64 + fr, fq * 8), boff = lds_byte(wc * 32 + fr, fq * 8);
#define PG8_SA(b, h) (((b) * 2 + (h)) * HTB)
#define PG8_SB(b, h) ((4 + (b) * 2 + (h)) * HTB)
#define PG8_STAGE(bufoff, gbase, voff) do { _Pragma("unroll") for (int _i = 0; _i < 2; ++_i) \
        __builtin_amdgcn_global_load_lds((const unsigned*)((const char*)(gbase) + (voff)[_i]), (LAS unsigned*)(lds + (bufoff) + ldsw + _i * 8192), 16, 0, 0); } while (0)
#define PG8_LDA(dst, b, h) do { _Pragma("unroll") for (int m = 0; m < 4; ++m) _Pragma("unroll") for (int k = 0; k < 2; ++k) dst[m][k] = *(const LAS bf16x8*)(lds + PG8_SA(b, h) + aoff + m * 2048 + k * 1024); } while (0)
#define PG8_LDB(dst, b, h) do { _Pragma("unroll") for (int n = 0; n < 2; ++n) _Pragma("unroll") for (int k = 0; k < 2; ++k) dst[n][k] = *(const LAS bf16x8*)(lds + PG8_SB(b, h) + boff + n * 2048 + k * 1024); } while (0)
#define PG8_MMA(ai, bj, At, Bt) do { __builtin_amdgcn_s_setprio(1); _Pragma("unroll") for (int m = 0; m < 4; ++m) _Pragma("unroll") for (int n = 0; n < 2; ++n) _Pragma("unroll") for (int k = 0; k < 2; ++k) \
        acc[ai][bj][m][n] = __builtin_amdgcn_mfma_f32_16x16x32_bf16(Bt[n][k], At[m][k], acc[ai][bj][m][n], 0, 0, 0); __builtin_amdgcn_s_setprio(0); } while (0)
#define PG8_WAIT_V(n) asm volatile("s_waitcnt vmcnt(" #n ")" ::: "memory")
#define PG8_WAIT_L(n) asm volatile("s_waitcnt lgkmcnt(" #n ")" ::: "memory")
#define PG8_BAR __builtin_amdgcn_s_barrier()
#define PG8_SCHED __builtin_amdgcn_sched_barrier(0)
    Unit cur, nxt; int ui = 0;
    if (!S.next(0, cur)) return;
    f32x4 acc[2][2][4][2];
#pragma unroll
    for (int a = 0; a < 2; ++a)
#pragma unroll
        for (int b = 0; b < 2; ++b)
#pragma unroll
            for (int m = 0; m < 4; ++m)
#pragma unroll
                for (int n = 0; n < 2; ++n) acc[a][b][m][n] = (f32x4){0.f, 0.f, 0.f, 0.f};
    bf16x8 At[4][2], B0[2][2], B1[2][2];
    const char* cA = cur.pa; const char* cB = cur.pb;
    PG8_STAGE(PG8_SB(0, 0), cB, voffB); PG8_STAGE(PG8_SA(0, 0), cA, voffA); PG8_STAGE(PG8_SB(0, 1), cB + hstepB, voffB); PG8_STAGE(PG8_SA(0, 1), cA + hstepA, voffA);
    if (wr == 1) PG8_BAR;
    PG8_WAIT_V(4); PG8_BAR;
    PG8_STAGE(PG8_SB(1, 0), cB + kstep, voffB); PG8_STAGE(PG8_SA(1, 0), cA + kstep, voffA); PG8_STAGE(PG8_SB(1, 1), cB + hstepB + kstep, voffB);
    PG8_WAIT_V(6); PG8_BAR;
    for (;;) {
        const bool has_next = S.next(ui + 1, nxt);
        const char* nA = has_next ? nxt.pa : cA; const char* nB = has_next ? nxt.pb : cB;
        const int nt = cur.nt;
        for (int t = 0; t < nt; t += 2) {
            const bool last = (t == nt - 2);
            const char* a1 = cA + (size_t)(t + 1) * kstep;
            const char* a2 = last ? nA : cA + (size_t)(t + 2) * kstep; const char* b2 = last ? nB : cB + (size_t)(t + 2) * kstep;
            const char* a3 = a2 + kstep; const char* b3 = b2 + kstep;
            PG8_LDB(B0, 0, 0); PG8_SCHED; PG8_LDA(At, 0, 0); PG8_STAGE(PG8_SA(1, 1), a1 + hstepA, voffA);
            PG8_WAIT_L(8); PG8_BAR; PG8_WAIT_L(0); PG8_MMA(0, 0, At, B0); PG8_BAR; PG8_SCHED;
            PG8_LDB(B1, 0, 1); PG8_STAGE(PG8_SB(0, 0), b2, voffB);
            PG8_BAR; PG8_WAIT_L(0); PG8_MMA(0, 1, At, B1); PG8_BAR;
            PG8_LDA(At, 0, 1); PG8_STAGE(PG8_SA(0, 0), a2, voffA);
            PG8_BAR; PG8_WAIT_L(0); PG8_MMA(1, 0, At, B0); PG8_BAR; PG8_SCHED;
            PG8_STAGE(PG8_SB(0, 1), b2 + hstepB, voffB);
            PG8_WAIT_V(6); PG8_BAR; PG8_MMA(1, 1, At, B1); PG8_BAR;
            PG8_LDB(B0, 1, 0); PG8_SCHED; PG8_LDA(At, 1, 0); PG8_STAGE(PG8_SA(0, 1), a2 + hstepA, voffA);
            PG8_WAIT_L(8); PG8_BAR; PG8_WAIT_L(0); PG8_MMA(0, 0, At, B0); PG8_BAR; PG8_SCHED;
            PG8_LDB(B1, 1, 1); PG8_STAGE(PG8_SB(1, 0), b3, voffB);
            PG8_BAR; PG8_WAIT_L(0); PG8_MMA(0, 1, At, B1); PG8_BAR;
            PG8_LDA(At, 1, 1); PG8_STAGE(PG8_SA(1, 0), a3, voffA);
            PG8_BAR; PG8_WAIT_L(0); PG8_MMA(1, 0, At, B0); PG8_BAR; PG8_SCHED;
            PG8_STAGE(PG8_SB(1, 1), b3 + hstepB, voffB);
            PG8_WAIT_V(6); PG8_BAR; PG8_MMA(1, 1, At, B1); PG8_BAR;
        }
        E(acc, cur, wr, wc, fr, fq);
        if (!has_next) break;
#pragma unroll
        for (int a = 0; a < 2; ++a)
#pragma unroll
            for (int b = 0; b < 2; ++b)
#pragma unroll
                for (int m = 0; m < 4; ++m)
#pragma unroll
                    for (int n = 0; n < 2; ++n) acc[a][b][m][n] = (f32x4){0.f, 0.f, 0.f, 0.f};
        cur = nxt; cA = nA; cB = nB; ++ui;
    }
    PG8_WAIT_V(0);
    if (wr == 0) PG8_BAR;
    PG8_BAR;
#undef PG8_SA
#undef PG8_SB
#undef PG8_STAGE
#undef PG8_LDA
#undef PG8_LDB
#undef PG8_MMA
#undef PG8_WAIT_V
#undef PG8_WAIT_L
#undef PG8_BAR
#undef PG8_SCHED
}
}
using pg8::Unit;

struct SchedDense {
    const char* A; const char* Bt; int lda, ldb, nM, nN, nt, G, c;
    DI bool next(int i, Unit& u) const {
        const long L = (long)i * G + c; if (L >= (long)nM * nN) return false;
        int pm, pn; pg8::tile_of((int)L, nM, nN, pm, pn);
        u.pm = pm; u.pn = pn; u.aux = 0; u.nt = nt; u.pa = A + (size_t)pm * 256 * lda; u.pb = Bt + (size_t)pn * 256 * ldb; return true;
    }
};

struct SchedProj {
    const char* A; const char* Bt; int l, G, c;
    DI bool next(int i, Unit& u) const {
        const long L = (long)i * G + c; int pm, pn;
        if (l == 0) { if (L >= 36 * 50) return false; pg8::tile_of((int)L, 36, 50, pm, pn); }
        else { if (L >= 32 * 50 + 48) return false;
            if (L < 32 * 50) pg8::tile_of((int)L, 32, 50, pm, pn);
            else { const int r = (int)L - 32 * 50, j = r % 12; pm = 32 + r / 12; pn = j < 8 ? 4 + j : (j == 8 ? 18 : (j == 9 ? 23 : (j == 10 ? 24 : 49))); } }
        u.pm = pm; u.pn = pn; u.aux = 0; u.nt = 32; u.pa = A + (size_t)pm * 256 * (DM * 2); u.pb = Bt + (size_t)pn * 256 * (DM * 2); return true;
    }
};

#define EPI_FOREACH(...) \
    _Pragma("unroll") for (int ai = 0; ai < 2; ++ai) _Pragma("unroll") for (int m = 0; m < 4; ++m) { const int row = u.pm * 256 + ai * 128 + wr * 64 + m * 16 + fr; \
    _Pragma("unroll") for (int bj = 0; bj < 2; ++bj) { const int col = u.pn * 256 + bj * 128 + wc * 32 + 8 * fq; const f32x4 v0 = acc[ai][bj][m][0], v1 = acc[ai][bj][m][1]; __VA_ARGS__ } }

DI u32x4 pack8(const f32x4 v0, const f32x4 v1) { u32x4 w; w.x = pk2(v0[0], v0[1]); w.y = pk2(v0[2], v0[3]); w.z = pk2(v1[0], v1[1]); w.w = pk2(v1[2], v1[3]); return w; }

struct EpiStoreBf16 {
    bf16_t* O; int ldc;
    DI void operator()(const f32x4 (&acc)[2][2][4][2], const Unit& u, int wr, int wc, int fr, int fq) const {
        EPI_FOREACH({ *(u32x4*)(O + (size_t)row * ldc + col) = pack8(v0, v1); })
    }
};
struct EpiProj {
    bf16_t* P; float* X80;
    DI void operator()(const f32x4 (&acc)[2][2][4][2], const Unit& u, int wr, int wc, int fr, int fq) const {
        if (u.pn < 49) { EPI_FOREACH({ *(u32x4*)(P + (size_t)row * NP + col) = pack8(v0, v1); }) }
        else {
            EPI_FOREACH({ const int c = col - C_X; if (bj == 0 && c < XW) { *(f32x4*)(X80 + (size_t)row * XW + c) = v0; *(f32x4*)(X80 + (size_t)row * XW + c + 4) = v1; } })
        }
    }
};

DI int win_src_col(int n) {
    if (n < 4096) return n;
    if (n < 4608) return n - 4096 + 4112;
    if (n < 4864) return n - 4608 + 4624;
    if (n < 5888) return n - 4864 + 4944;
    if (n < 6144) return n - 5888 + 5968;
    if (n < 6400) return n - 6144 + 6224;
    if (n < 12544) return n - 6400 + 6480;
    if (n < 12608) return n - 12544 + 4880;
    if (n < 12624) return n - 12608 + 4096;
    return -1;
}
DI void transpose_item(const float* W, int ldw, int K, bf16_t* WT, int k0, int n0, int srcc, LAS float* scr, int lane) {
#pragma unroll 8
    for (int i = 0; i < 32; ++i) { const int kk = 2 * i + (lane >> 5); scr[kk * 33 + (lane & 31)] = srcc >= 0 ? W[(size_t)(k0 + kk) * ldw + srcc] : 0.f; }
    LDS_WAIT(); asm volatile("" ::: "memory");
    const int c = lane & 7;
#pragma unroll
    for (int j = 0; j < 4; ++j) { const int n = (lane >> 3) + 8 * j; const LAS float* s = scr + (8 * c) * 33 + n;
        u32x4 o; o.x = pk2(s[0 * 33], s[1 * 33]); o.y = pk2(s[2 * 33], s[3 * 33]); o.z = pk2(s[4 * 33], s[5 * 33]); o.w = pk2(s[6 * 33], s[7 * 33]);
        *(u32x4*)(WT + (size_t)(n0 + n) * K + k0 + 8 * c) = o; }
    LDS_WAIT(); asm volatile("" ::: "memory");
}

constexpr int IT_IN = 32 * 400, IT_UQ = 8 * 48, IT_UKV = 4 * 64, IT_BR = 16 * 64, IT_OUT = 32 * 64, IT_E13 = 32 * 64, IT_E2 = 16 * 64;
constexpr int IT_EARLY = IT_IN + IT_UQ + IT_UKV, IT_LAYER = IT_EARLY + 3 * IT_BR + IT_OUT + NEXP * IT_E13 + NEXP * IT_E2;
DI void convert_item(const Frame& F, const Args& a, int l, int r, LAS float* scr) {
    unsigned char* wl = F.ws + WS_W + (size_t)l * W_LAYER;
    const int ln = F.lane & 31;
    if (r < IT_IN) { const int kb = r / 400, nb = r % 400; transpose_item(a.in[I_WIN] + (size_t)l * DM * PROJW, PROJW, DM, (bf16_t*)(wl + W_IN), 64 * kb, 32 * nb, win_src_col(32 * nb + ln), scr, F.lane); return; } r -= IT_IN;
    if (r < IT_UQ) { const int kb = r / 48, nb = r % 48; transpose_item(a.in[I_UQ] + (size_t)l * 512 * 1536, 1536, 512, (bf16_t*)(wl + W_UQ), 64 * kb, 32 * nb, 32 * nb + ln, scr, F.lane); return; } r -= IT_UQ;
    if (r < IT_UKV) { const int kb = r / 64, nb = r % 64; transpose_item(a.in[I_UKV] + (size_t)l * 256 * 2048, 2048, 256, (bf16_t*)(wl + W_UKV), 64 * kb, 32 * nb, 32 * nb + ln, scr, F.lane); return; } r -= IT_UKV;
    if (r < 3 * IT_BR) { const int br = r / IT_BR, q = r % IT_BR, kb = q / 64, nb = q % 64;
        transpose_item(a.in[I_BRML + br] + (size_t)l * 1024 * 2048, 2048, 1024, (bf16_t*)(wl + W_BR) + (size_t)br * 2048 * 1024, 64 * kb, 32 * nb, 32 * nb + ln, scr, F.lane); return; } r -= 3 * IT_BR;
    if (r < IT_OUT) { const int kb = r / 64, nb = r % 64; transpose_item(a.in[I_WOUT] + (size_t)l * 2048 * 2048, 2048, 2048, (bf16_t*)(wl + W_OUT), 64 * kb, 32 * nb, 32 * nb + ln, scr, F.lane); return; } r -= IT_OUT;
    if (r < NEXP * IT_E13) { const int e = r / IT_E13, q = r % IT_E13, kb = q / 64, nb = q % 64;
        const int n0 = 32 * nb, j = n0 >> 8, half = (n0 >> 7) & 1, cc = n0 & 127;
        transpose_item(a.in[half ? I_WE3 : I_WE1] + ((size_t)l * NEXP + e) * 2048 * 1024, 1024, 2048, (bf16_t*)(wl + W_E13) + (size_t)e * 2048 * 2048, 64 * kb, n0, j * 128 + cc + ln, scr, F.lane); return; } r -= NEXP * IT_E13;
    { const int e = r / IT_E2, q = r % IT_E2, kb = q / 64, nb = q % 64;
        transpose_item(a.in[I_WE2] + ((size_t)l * NEXP + e) * 1024 * 2048, 2048, 1024, (bf16_t*)(wl + W_E2) + (size_t)e * 2048 * 1024, 64 * kb, 32 * nb, 32 * nb + ln, scr, F.lane); }
}

DI void phase_prologue(const Frame& F, const Args& a, int rep) {
    LAS float* scr = (LAS float*)(F.lds + F.wave * 16384);
    if (rep == 0) {
        const float* c = a.in[I_C]; const float* cctx = a.in[I_CCTX]; const float* wmod = a.in[I_WMOD];
        constexpr int NIT = 2 * 48 * 16;
        for (int it = F.gw; it < NIT; it += F.ngw) {
            const int l = it / 768, rem = it % 768, cb = rem / 16, kp = rem % 16, k0 = kp * 128, j0 = cb * 256 + F.lane * 4;
#pragma unroll
            for (int i = 0; i < 10; ++i) { const int idx = F.lane + 64 * i, r = idx >> 7, kk = idx & 127; const float v = r < 4 ? c[r * DM + k0 + kk] : cctx[k0 + kk]; scr[idx] = siluf_(v); }
            LDS_WAIT(); asm volatile("" ::: "memory");
            f32x4 acc[5];
#pragma unroll
            for (int r = 0; r < 5; ++r) acc[r] = (f32x4){0.f, 0.f, 0.f, 0.f};
            const float* wp = wmod + ((size_t)l * DM + k0) * (6 * DM) + j0;
#pragma unroll 4
            for (int kk = 0; kk < 128; ++kk) { const f32x4 w = *(const f32x4*)(wp + (size_t)kk * (6 * DM));
#pragma unroll
                for (int r = 0; r < 5; ++r) acc[r] += w * scr[r * 128 + kk]; }
#pragma unroll
            for (int r = 0; r < 5; ++r) *(f32x4*)((float*)(F.ws + WS_MPART) + ((size_t)(kp * 2 + l) * 5 + r) * (6 * DM) + j0) = acc[r];
            LDS_WAIT(); asm volatile("" ::: "memory");
        }
    }
    {
        float* rla = (float*)(F.ws + WS_ROPE_LA); float* rga = (float*)(F.ws + WS_ROPE_GA);
        const int gt = F.gw * 64 + F.lane, ngt = F.ngw * 64;
        for (int i = gt; i < 2048 * 32; i += ngt) { const int t = i >> 5, aidx = i & 31, ax = aidx >> 4, fi = aidx & 15;
            const float inv = exp2f(-(float)fi * (13.287712379549449f / 16.f)); const float ang = (float)(ax ? (t & 63) : (t >> 6)) * inv;
            rla[2 * i] = cosf(ang); rla[2 * i + 1] = sinf(ang); }
        for (int i = gt; i < 2048 * 64; i += ngt) { const int t = i >> 6, aidx = i & 63, ax = aidx >> 5, fi = aidx & 31;
            const float inv = exp2f(-(float)fi * (13.287712379549449f / 32.f)); const float ang = (float)(ax ? (t & 63) : (t >> 6)) * inv;
            rga[2 * i] = cosf(ang); rga[2 * i + 1] = sinf(ang); }
    }
    for (int it = F.gw; it < IT_EARLY; it += F.ngw) convert_item(F, a, 0, it, scr);
}

DI void phase_mods_reduce(const Frame& F, const Args& a) {
    float* mods = (float*)(F.ws + WS_MODS); const float* part = (const float*)(F.ws + WS_MPART); const float* bmod = a.in[I_BMOD];
    const int gt = F.gw * 64 + F.lane, ngt = F.ngw * 64;
    for (int i = gt; i < 2 * 5 * 12288 / 4; i += ngt) { const int l = i / (5 * 3072), j4 = i % 3072;
        f32x4 s = *(const f32x4*)(bmod + (size_t)l * 12288 + 4 * j4);
#pragma unroll
        for (int kp = 0; kp < 16; ++kp) s += *(const f32x4*)(part + (size_t)kp * (2 * 5 * 12288) + 4 * (size_t)i);
        *(f32x4*)(mods + 4 * (size_t)i) = s; }
}

DI const float* resid_row(const Frame& F, const Args& a, int l, int row) {
    if (l == 0) return row < MLAT ? a.in[I_X] + (size_t)row * DM : a.in[I_CTX] + (size_t)(row - MLAT) * DM;
    return (const float*)(F.ws + WS_X1) + (size_t)row * DM;
}
DI void combine_row(const Frame& F, int lp, int row, f32x4 (&v)[8]) {
    const float* X1 = (const float*)(F.ws + WS_X1) + (size_t)row * DM; const int* tok = (const int*)(F.ws + WS_TOK) + (size_t)row * 16; const bf16_t* YE = (const bf16_t*)(F.ws + WS_YE);
    f32x4 s[8];
#pragma unroll
    for (int j = 0; j < 8; ++j) { v[j] = *(const f32x4*)(X1 + 4 * F.lane + 256 * j); s[j] = (f32x4){0.f, 0.f, 0.f, 0.f}; }
    for (int e = 0; e < NEXP; ++e) { const int slot = __builtin_amdgcn_readfirstlane(tok[e]);
        if (slot >= 0) { const bf16_t* yr = YE + ((size_t)e * ESLOT + slot) * DM;
#pragma unroll
            for (int j = 0; j < 8; ++j) { const s16x4 y = *(const s16x4*)(yr + 4 * F.lane + 256 * j);
                s[j] += (f32x4){bf2f((unsigned short)y[0]), bf2f((unsigned short)y[1]), bf2f((unsigned short)y[2]), bf2f((unsigned short)y[3])}; } } }
    const float* g2 = mods_ptr(F, lp, row, 5);
#pragma unroll
    for (int j = 0; j < 8; ++j) v[j] += s[j] * *(const f32x4*)(g2 + 4 * F.lane + 256 * j);
}
DI void modulate_vals(const Frame& F, const f32x4 (&v)[8], const float* sh, const float* sc, bf16_t* hrow, f32x4 (&hv)[8]) {
    float ss = 0.f;
#pragma unroll
    for (int j = 0; j < 8; ++j) ss += v[j].x * v[j].x + v[j].y * v[j].y + v[j].z * v[j].z + v[j].w * v[j].w;
    const float rs = rsqrtf(wave_sum(ss) * (1.f / DM) + EPS);
#pragma unroll
    for (int j = 0; j < 8; ++j) { const f32x4 s1 = *(const f32x4*)(sc + 4 * F.lane + 256 * j), s0 = *(const f32x4*)(sh + 4 * F.lane + 256 * j);
        const f32x4 h = v[j] * rs * (s1 + 1.f) + s0; hv[j] = h;
        u32x2 w; w.x = pk2(h.x, h.y); w.y = pk2(h.z, h.w); *(u32x2*)(hrow + 4 * F.lane + 256 * j) = w; }
}
DI void phase_mod1(const Frame& F, const Args& a, int l) {
    bf16_t* H = (bf16_t*)(F.ws + WS_H);
    for (int row = F.gw; row < MTOT; row += F.ngw) { f32x4 v[8], hv[8];
        if (l == 0) { const float* xr = resid_row(F, a, 0, row);
#pragma unroll
            for (int j = 0; j < 8; ++j) v[j] = *(const f32x4*)(xr + 4 * F.lane + 256 * j); }
        else { combine_row(F, l - 1, row, v); float* xw = (float*)(F.ws + WS_X1) + (size_t)row * DM;
#pragma unroll
            for (int j = 0; j < 8; ++j) *(f32x4*)(xw + 4 * F.lane + 256 * j) = v[j]; }
        modulate_vals(F, v, mods_ptr(F, l, row, 0), mods_ptr(F, l, row, 1), H + (size_t)row * DM, hv); }
}
DI void phase_mod2(const Frame& F, const Args& a, int l, int nrows) {
    bf16_t* H = (bf16_t*)(F.ws + WS_H); float* AFF = (float*)(F.ws + WS_AFF);
    LAS float* wr = (LAS float*)F.lds;
    const float* wsrc = a.in[I_WROUTER] + (size_t)l * DM * NEXP;
    for (int i = F.tid; i < DM * NEXP / 4; i += NTHR) ((LAS f32x4*)wr)[i] = ((const f32x4*)wsrc)[i];
    __syncthreads();
    for (int row = F.gw; row < nrows; row += F.ngw) { f32x4 hv[8];
        { f32x4 v[8]; const float* xr = (const float*)(F.ws + WS_X1) + (size_t)row * DM;
#pragma unroll
          for (int j = 0; j < 8; ++j) v[j] = *(const f32x4*)(xr + 4 * F.lane + 256 * j);
          modulate_vals(F, v, mods_ptr(F, l, row, 3), mods_ptr(F, l, row, 4), H + (size_t)row * DM, hv); }
        float lg[16];
#pragma unroll
        for (int e = 0; e < 16; ++e) lg[e] = 0.f;
#pragma unroll
        for (int j = 0; j < 8; ++j)
#pragma unroll
            for (int i = 0; i < 4; ++i) { const int c = 4 * F.lane + 256 * j + i; const float h = hv[j][i];
#pragma unroll
                for (int q = 0; q < 4; ++q) { const f32x4 w = *(const LAS f32x4*)(wr + c * 16 + 4 * q); lg[4 * q] += h * w.x; lg[4 * q + 1] += h * w.y; lg[4 * q + 2] += h * w.z; lg[4 * q + 3] += h * w.w; } }
        float mx = -1e30f;
#pragma unroll
        for (int e = 0; e < 16; ++e) { lg[e] = wave_sum(lg[e]); mx = fmaxf(mx, lg[e]); }
        float den = 0.f;
#pragma unroll
        for (int e = 0; e < 16; ++e) { lg[e] = __expf(lg[e] - mx); den += lg[e]; }
        const float inv = 1.f / den;
        float mine = 0.f;
#pragma unroll
        for (int e = 0; e < 16; ++e) mine = (F.lane == e) ? lg[e] * inv : mine;
        if (F.lane < 16) AFF[(size_t)row * 16 + F.lane] = mine;
    }
    __syncthreads();
}

DI void phase_postproj(const Frame& F, const Args& a, int l) {
    const bf16_t* P = (const bf16_t*)(F.ws + WS_P); const float* X80 = (const float*)(F.ws + WS_X80);
    bf16_t* CQN = (bf16_t*)(F.ws + WS_CQN); bf16_t* CKVN = (bf16_t*)(F.ws + WS_CKVN); bf16_t* QG = (bf16_t*)(F.ws + WS_QG); bf16_t* KG = (bf16_t*)(F.ws + WS_KG); bf16_t* KR = (bf16_t*)(F.ws + WS_KR);
    const float* qn = a.in[I_LAQN] + l * 512; const float* kvn = a.in[I_LAKVN] + l * 256; const float* gqn = a.in[I_GAQN] + l * 128; const float* gkn = a.in[I_GAKN] + l * 128;
    const float* rla = (const float*)(F.ws + WS_ROPE_LA); const float* rga = (const float*)(F.ws + WS_ROPE_GA);
    const int lane = F.lane;
    for (int row = F.gw; row < MTOT; row += F.ngw) {
        const bf16_t* pr = P + (size_t)row * NP; const bool lat = row < MLAT; const int t = row & 2047; const bool needq = lat || l == 0;
        if (needq) {
            const bf16x8 x = *(const bf16x8*)(pr + C_CQ + 8 * lane); float f[8]; float ss = 0.f;
#pragma unroll
            for (int i = 0; i < 8; ++i) { f[i] = bf2f((unsigned short)x[i]); ss += f[i] * f[i]; }
            const float rs = rsqrtf(wave_sum(ss) * (1.f / 512.f) + EPS);
            const f32x4 g0 = *(const f32x4*)(qn + 8 * lane), g1 = *(const f32x4*)(qn + 8 * lane + 4);
            u32x4 w; w.x = pk2(f[0] * rs * g0.x, f[1] * rs * g0.y); w.y = pk2(f[2] * rs * g0.z, f[3] * rs * g0.w); w.z = pk2(f[4] * rs * g1.x, f[5] * rs * g1.y); w.w = pk2(f[6] * rs * g1.z, f[7] * rs * g1.w);
            *(u32x4*)(CQN + (size_t)row * 512 + 8 * lane) = w;
        }
        {
            const s16x4 x = *(const s16x4*)(pr + C_CKV + 4 * lane); float f[4]; float ss = 0.f;
#pragma unroll
            for (int i = 0; i < 4; ++i) { f[i] = bf2f((unsigned short)x[i]); ss += f[i] * f[i]; }
            const float rs = rsqrtf(wave_sum(ss) * (1.f / 256.f) + EPS);
            const f32x4 g0 = *(const f32x4*)(kvn + 4 * lane);
            u32x2 w; w.x = pk2(f[0] * rs * g0.x, f[1] * rs * g0.y); w.y = pk2(f[2] * rs * g0.z, f[3] * rs * g0.w);
            *(u32x2*)(CKVN + (size_t)row * 256 + 4 * lane) = w;
        }
        const int ax = lane >> 5, fi = lane & 31;
        const float cs = rga[((size_t)t * 64 + lane) * 2], sn = rga[((size_t)t * 64 + lane) * 2 + 1];
        for (int hh = needq ? 0 : 8; hh < 10; ++hh) {
            const bf16_t* src = hh < 8 ? pr + C_GQ + hh * 128 : pr + C_GK + (hh - 8) * 128;
            const float* gn = hh < 8 ? gqn : gkn;
            const float xa = bf2f(src[ax * 64 + fi]), xb = bf2f(src[ax * 64 + 32 + fi]);
            const float rs = rsqrtf(wave_sum(xa * xa + xb * xb) * (1.f / 128.f) + EPS);
            const float ya = xa * rs * gn[ax * 64 + fi], yb = xb * rs * gn[ax * 64 + 32 + fi];
            const float oa = lat ? ya * cs - yb * sn : ya, ob = lat ? ya * sn + yb * cs : yb;
            bf16_t* dst = hh < 8 ? QG + (size_t)row * 1024 + hh * 128 : KG + (size_t)row * 256 + (hh - 8) * 128;
            dst[ax * 64 + fi] = (bf16_t)f2bf(oa); dst[ax * 64 + 32 + fi] = (bf16_t)f2bf(ob);
        }
        {
            const int l32 = lane & 31, ax2 = l32 >> 4, f2 = l32 & 15;
            const float xa = X80[(size_t)row * XW + ax2 * 32 + f2], xb = X80[(size_t)row * XW + ax2 * 32 + 16 + f2];
            const float c2 = rla[((size_t)t * 32 + l32) * 2], s2 = rla[((size_t)t * 32 + l32) * 2 + 1];
            const float oa = lat ? xa * c2 - xb * s2 : xa, ob = lat ? xa * s2 + xb * c2 : xb;
            if (lane < 32) { KR[(size_t)row * 64 + ax2 * 32 + f2] = (bf16_t)f2bf(oa); KR[(size_t)row * 64 + ax2 * 32 + 16 + f2] = (bf16_t)f2bf(ob); }
        }
    }
}

namespace att {
constexpr int QBLK = 32, KVBLK = 64;
#define SBAR() __builtin_amdgcn_sched_barrier(0)
DI int crow(int r, int hi) { return (r & 3) + 8 * (r >> 2) + 4 * hi; }
DI int v_st(int k, int c) { const int kk = (k & ~0xC) | ((k & 4) << 1) | ((k & 8) >> 1); return ((kk >> 3) * 4 + (c >> 5)) * 512 + ((kk & 7) * 32 + (c & 31)) * 2; }
DI int v_rd_base(int lane) { return ((lane & 3) << 3) | (((lane >> 2) & 3) << 6) | (((lane >> 4) & 1) << 5) | (((lane >> 5) & 1) << 8); }
constexpr int v_rd_off(int d0, int ks, int half) { return d0 * 512 + ks * 4096 + half * 2048; }
template <int OFF> DI s16x4 tr_read(int vb) { s16x4 r; asm volatile("ds_read_b64_tr_b16 %0, %1 offset:%2" : "=&v"(r) : "v"(vb), "i"(OFF) : "memory"); return r; }
template <int D0> DI void pv_one(f32x16& od, int vb, bf16x8 pa0, bf16x8 pa1, bf16x8 pa2, bf16x8 pa3) {
  const s16x4 l0 = tr_read<v_rd_off(D0, 0, 0)>(vb), h0 = tr_read<v_rd_off(D0, 0, 1)>(vb), l1 = tr_read<v_rd_off(D0, 1, 0)>(vb), h1 = tr_read<v_rd_off(D0, 1, 1)>(vb);
  const s16x4 l2 = tr_read<v_rd_off(D0, 2, 0)>(vb), h2 = tr_read<v_rd_off(D0, 2, 1)>(vb), l3 = tr_read<v_rd_off(D0, 3, 0)>(vb), h3 = tr_read<v_rd_off(D0, 3, 1)>(vb);
  asm volatile("s_waitcnt lgkmcnt(0)" ::: "memory"); SBAR();
#define PK(L, H) (bf16x8){L[0], L[1], L[2], L[3], H[0], H[1], H[2], H[3]}
  od = __builtin_amdgcn_mfma_f32_32x32x16_bf16(pa0, PK(l0, h0), od, 0, 0, 0);
  od = __builtin_amdgcn_mfma_f32_32x32x16_bf16(pa1, PK(l1, h1), od, 0, 0, 0);
  od = __builtin_amdgcn_mfma_f32_32x32x16_bf16(pa2, PK(l2, h2), od, 0, 0, 0);
  od = __builtin_amdgcn_mfma_f32_32x32x16_bf16(pa3, PK(l3, h3), od, 0, 0, 0);
#undef PK
}
DI void pv_d0(f32x16* o, int vb, bf16x8 pa0, bf16x8 pa1, bf16x8 pa2, bf16x8 pa3) {
  pv_one<0>(o[0], vb, pa0, pa1, pa2, pa3); pv_one<1>(o[1], vb, pa0, pa1, pa2, pa3); pv_one<2>(o[2], vb, pa0, pa1, pa2, pa3); pv_one<3>(o[3], vb, pa0, pa1, pa2, pa3);
}
template <int DKX, int LDQ, int LDK, int LDV, int LDO, int SDEPTH = 1>
DI void attn_body(const bf16_t* __restrict__ Qb, const bf16_t* __restrict__ Km, const bf16_t* __restrict__ Kx, const bf16_t* __restrict__ Vm, bf16_t* __restrict__ Ob,
                  int kr0, int nt0, int kr1, int nt1, float scale, const float* __restrict__ ropeq  , char* lds) {
  constexpr int ND0 = 8 + DKX / 16, KROWB = (128 + DKX) * 2, SHM_V = KVBLK * 128 * 2, SHM_K = KVBLK * KROWB;
  constexpr float THR = 8.f;
#define KSWZ(row, colB) ((row) * KROWB + ((colB) ^ (((row) & 7) << 4)))
  int tid = threadIdx.x; asm volatile("" : "+v"(tid));
  const int wid = __builtin_amdgcn_readfirstlane(tid >> 6), lane = tid & 63, r32 = lane & 31, hi = lane >> 5;
  char* V_lds = lds; char* K_lds = lds + 2 * SHM_V;
  float* ws = (float*)(lds + 2 * SHM_V + 2 * SHM_K) + wid * 64; float* li_l = ws; float* al_l = ws + 32;
  const float C = scale * 1.4426950408889634f;
  float m_reg = -1e30f, l_reg = 0; f32x16 o[4] = {}; bf16x8 qr[8];
  const bf16_t* Qw = Qb + (long)(wid * QBLK + r32) * LDQ + hi * 8;
#pragma unroll
  for (int d0 = 0; d0 < 8; ++d0) qr[d0] = *reinterpret_cast<const bf16x8*>(Qw + d0 * 16);
  char* QX = lds + 2 * SHM_V + 2 * SHM_K + 2048 + (wid * 4 * 64 + lane) * 16;
  if constexpr (DKX > 0) {
#pragma unroll
    for (int ax = 0; ax < 2; ++ax) {
      const bf16x8 xa = *reinterpret_cast<const bf16x8*>(Qw + 128 + ax * 32), xb = *reinterpret_cast<const bf16x8*>(Qw + 128 + ax * 32 + 16);
      if (ropeq) {
        const float* cs = ropeq + ((size_t)(wid * QBLK + r32) * 32 + ax * 16 + hi * 8) * 2;
        float oa[8], ob[8];
#pragma unroll
        for (int j = 0; j < 8; ++j) { const float c = cs[2 * j], sn = cs[2 * j + 1], a = bf2f((unsigned short)xa[j]), b = bf2f((unsigned short)xb[j]); oa[j] = a * c - b * sn; ob[j] = a * sn + b * c; }
        u32x4 wa = {pk2(oa[0], oa[1]), pk2(oa[2], oa[3]), pk2(oa[4], oa[5]), pk2(oa[6], oa[7])}, wb = {pk2(ob[0], ob[1]), pk2(ob[2], ob[3]), pk2(ob[4], ob[5]), pk2(ob[6], ob[7])};
        *reinterpret_cast<u32x4*>(QX + (2 * ax) * 1024) = wa; *reinterpret_cast<u32x4*>(QX + (2 * ax + 1) * 1024) = wb;
      } else { *reinterpret_cast<bf16x8*>(QX + (2 * ax) * 1024) = xa; *reinterpret_cast<bf16x8*>(QX + (2 * ax + 1) * 1024) = xb; }
    }
  }
  const int sr = tid >> 4, sc = (tid & 15) * 8, vst0 = v_st(sr, sc), vst1 = v_st(32 + sr, sc);
  const int xr = tid >> 3, xc = (tid & 7) * 8;
  const int vb0 = (int)(uintptr_t)V_lds + v_rd_base(lane);
  const int offV = sr * LDV + sc, offK = sr * LDK + sc, offX = xr * 64 + xc;
  struct { bf16x8 vs0, vs1, ks0, ks1, kx; } sr_[SDEPTH];
  const int NT = nt0 + nt1;
#define TROW(j) ((j) < nt0 ? kr0 + (j) * KVBLK : kr1 + ((j) - nt0) * KVBLK)
#define SLOAD(i, j) do { const long _r = TROW(j); const bf16_t* _vt = Vm + _r * LDV; const bf16_t* _kt = Km + _r * LDK; \
    sr_[i].vs0 = *(const bf16x8*)(_vt + offV); sr_[i].vs1 = *(const bf16x8*)(_vt + offV + 32 * LDV); \
    sr_[i].ks0 = *(const bf16x8*)(_kt + offK); sr_[i].ks1 = *(const bf16x8*)(_kt + offK + 32 * LDK); \
    if constexpr (DKX > 0) sr_[i].kx = *(const bf16x8*)(Kx + _r * 64 + offX); } while (0)
#define SWRITE(b, i) do { *(bf16x8*)(V_lds + (b) * SHM_V + vst0) = sr_[i].vs0; *(bf16x8*)(V_lds + (b) * SHM_V + vst1) = sr_[i].vs1; const int kc = sc * 2; \
    *(bf16x8*)(K_lds + (b) * SHM_K + KSWZ(sr, kc)) = sr_[i].ks0; *(bf16x8*)(K_lds + (b) * SHM_K + KSWZ(32 + sr, kc)) = sr_[i].ks1; \
    if constexpr (DKX > 0) *(bf16x8*)(K_lds + (b) * SHM_K + KSWZ(xr, 256 + xc * 2)) = sr_[i].kx; } while (0)
#define SWAIT() do { if constexpr (SDEPTH == 1) asm volatile("s_waitcnt vmcnt(0)" ::: "memory"); else if constexpr (DKX > 0) asm volatile("s_waitcnt vmcnt(5)" ::: "memory"); else asm volatile("s_waitcnt vmcnt(4)" ::: "memory"); } while (0)
#define RESC(a) do { if (__any((a) < 1.f)) { if (hi == 0) al_l[r32] = (a); asm volatile("s_waitcnt lgkmcnt(0)" ::: "memory"); \
    for (int d = 0; d < 4; ++d) for (int r = 0; r < 16; ++r) o[d][r] *= al_l[crow(r, hi)]; } } while (0)
#define QKT(p0, p1, Ks) do { p0 = f32x16{}; p1 = f32x16{}; _Pragma("unroll") for (int d0 = 0; d0 < ND0; ++d0) { const int cb = (d0 * 16 + hi * 8) * 2; \
    const bf16x8 b0 = *reinterpret_cast<const bf16x8*>((Ks) + KSWZ(r32, cb)); const bf16x8 b1 = *reinterpret_cast<const bf16x8*>((Ks) + KSWZ(32 + r32, cb)); \
    const bf16x8 qf = d0 < 8 ? qr[d0 < 8 ? d0 : 0] : *reinterpret_cast<const bf16x8*>(QX + (d0 - 8) * 1024); \
    p0 = __builtin_amdgcn_mfma_f32_32x32x16_bf16(b0, qf, p0, 0, 0, 0); p1 = __builtin_amdgcn_mfma_f32_32x32x16_bf16(b1, qf, p1, 0, 0, 0); if (DKX > 0 && (d0 & 1) == 1) SBAR(); } } while (0)
#define PARTIAL_SM(p0, p1, mn, alpha) do { float pmax = p0[0]; for (int r = 1; r < 16; ++r) pmax = fmaxf(pmax, p0[r]); for (int r = 0; r < 16; ++r) pmax = fmaxf(pmax, p1[r]); \
    { auto rr = __builtin_amdgcn_permlane32_swap(__float_as_uint(pmax), __float_as_uint(pmax), false, false); pmax = fmaxf(__uint_as_float(rr[0]), __uint_as_float(rr[1])); } \
    if (__builtin_expect(__all((pmax - m_reg) * scale <= THR), 1)) { mn = m_reg; alpha = 1.f; } \
    else { mn = fmaxf(m_reg, pmax); alpha = __builtin_amdgcn_exp2f((m_reg - mn) * C); m_reg = mn; } \
    const float mnC = -mn * C; for (int r = 0; r < 16; ++r) p0[r] = fmaf(p0[r], C, mnC); for (int r = 0; r < 16; ++r) p1[r] = fmaf(p1[r], C, mnC); \
    for (int r = 0; r < 16; ++r) p0[r] = __builtin_amdgcn_exp2f(p0[r]); } while (0)
#define PK4(P, BASE, OUT) do { unsigned a0 = pk2(P[BASE + 0], P[BASE + 1]), a1 = pk2(P[BASE + 2], P[BASE + 3]); \
    unsigned b0 = pk2(P[BASE + 4], P[BASE + 5]), b1 = pk2(P[BASE + 6], P[BASE + 7]); \
    auto r0 = __builtin_amdgcn_permlane32_swap(a0, b0, false, false); auto r1 = __builtin_amdgcn_permlane32_swap(a1, b1, false, false); \
    u32x4 w = {r0[0], r1[0], r0[1], r1[1]}; OUT = *reinterpret_cast<bf16x8*>(&w); } while (0)
#define FINISH_SM(p0, p1, alpha) do { for (int r = 0; r < 16; ++r) p1[r] = __builtin_amdgcn_exp2f(p1[r]); \
    float ps = 0; for (int r = 0; r < 16; ++r) ps += p0[r]; for (int r = 0; r < 16; ++r) ps += p1[r]; \
    { auto rr = __builtin_amdgcn_permlane32_swap(__float_as_uint(ps), __float_as_uint(ps), false, false); ps = __uint_as_float(rr[0]) + __uint_as_float(rr[1]); } \
    l_reg = l_reg * alpha + ps; PK4(p0, 0, pa0); PK4(p0, 8, pa1); PK4(p1, 0, pa2); PK4(p1, 8, pa3); } while (0)
  f32x16 pA0, pA1, pB0, pB1; float mnA, mnB, alA, alB; bf16x8 pa0, pa1, pa2, pa3;
  constexpr int SE = 0, SO = SDEPTH - 1;
  SLOAD(SE, 0); asm volatile("s_waitcnt vmcnt(0)" ::: "memory"); SWRITE(0, SE); __syncthreads();
  QKT(pA0, pA1, K_lds); PARTIAL_SM(pA0, pA1, mnA, alA);
  SLOAD(SO, 1); if constexpr (SDEPTH == 2) { if (2 < NT) SLOAD(SE, 2); }
  SWAIT(); SWRITE(1, SO); __syncthreads();
  for (int j = 1; j + 1 < NT; j += 2) {
    SBAR(); QKT(pB0, pB1, K_lds + SHM_K);
    FINISH_SM(pA0, pA1, alA); SBAR();
    SLOAD(SO, j + SDEPTH); SBAR();
    pv_d0(o, vb0, pa0, pa1, pa2, pa3); PARTIAL_SM(pB0, pB1, mnB, alB);
    __syncthreads(); SWAIT(); SWRITE(0, SE);
    RESC(alB); __syncthreads();
    SBAR(); QKT(pA0, pA1, K_lds);
    FINISH_SM(pB0, pB1, alB); SBAR();
    if (SDEPTH == 1 || j + 3 < NT) SLOAD(SE, j + 1 + SDEPTH); SBAR();
    pv_d0(o, vb0 + (int)SHM_V, pa0, pa1, pa2, pa3); PARTIAL_SM(pA0, pA1, mnA, alA);
    __syncthreads(); SWAIT(); SWRITE(1, SO);
    RESC(alA); __syncthreads();
  }
  SBAR(); QKT(pB0, pB1, K_lds + SHM_K);
  FINISH_SM(pA0, pA1, alA); SBAR();
  pv_d0(o, vb0, pa0, pa1, pa2, pa3); PARTIAL_SM(pB0, pB1, mnB, alB);
  __syncthreads(); RESC(alB);
  FINISH_SM(pB0, pB1, alB); SBAR();
  pv_d0(o, vb0 + (int)SHM_V, pa0, pa1, pa2, pa3);
  if (hi == 0) li_l[r32] = l_reg; asm volatile("s_waitcnt lgkmcnt(0)" ::: "memory");
  float rli[16];
#pragma unroll
  for (int r = 0; r < 16; ++r) rli[r] = __builtin_amdgcn_rcpf(li_l[crow(r, hi)]);
  bf16_t* Ow = Ob + (long)(wid * QBLK) * LDO;
#pragma unroll
  for (int r = 0; r < 16; ++r) { const int orow = crow(r, hi);
#pragma unroll
    for (int d0 = 0; d0 < 4; ++d0) Ow[(long)orow * LDO + d0 * 32 + r32] = (bf16_t)f2bf(o[d0][r] * rli[r]); }
  __syncthreads();
#undef KSWZ
#undef TROW
#undef SLOAD
#undef SWRITE
#undef SWAIT
#undef RESC
#undef QKT
#undef PARTIAL_SM
#undef PK4
#undef FINISH_SM
}
}

namespace ml {
constexpr int LD = 264, ROWB = LD * 2, QS_OFF = 0, KS_OFF = 64 * ROWB, VS_OFF = 2 * 64 * ROWB, NV_OFF = 3 * 64 * ROWB, SC_OFF = NV_OFF + 1024, ML_END = SC_OFF + 2048;
static_assert(ML_END <= LDS_BYTES - 1024, "mlstm lds");
#define MFMA32(a, b, c) __builtin_amdgcn_mfma_f32_32x32x16_bf16((a), (b), (c), 0, 0, 0)
DI bf16x8 pack_step(const f32x16& x, int s) {
    u32x4 p;
    asm volatile("v_cvt_pk_bf16_f32 %0, %4, %5\n\tv_cvt_pk_bf16_f32 %1, %6, %7\n\tv_cvt_pk_bf16_f32 %2, %8, %9\n\tv_cvt_pk_bf16_f32 %3, %10, %11\n\ts_nop 1"
                 : "=&v"(p[0]), "=&v"(p[1]), "=&v"(p[2]), "=&v"(p[3])
                 : "v"(x[8 * s]), "v"(x[8 * s + 1]), "v"(x[8 * s + 2]), "v"(x[8 * s + 3]), "v"(x[8 * s + 4]), "v"(x[8 * s + 5]), "v"(x[8 * s + 6]), "v"(x[8 * s + 7]));
    return __builtin_bit_cast(bf16x8, p);
}
DI bf16x8 ld_perm(const LAS unsigned char* p) {
    const s16x4 lo = *(const LAS s16x4*)p, hi = *(const LAS s16x4*)(p + 16);
    return (bf16x8){lo[0], lo[1], lo[2], lo[3], hi[0], hi[1], hi[2], hi[3]};
}
DI int crow(int r, int hi) { return (r & 3) + 8 * (r >> 2) + 4 * hi; }
template <int OFF> DI s16x4 tr_rd(unsigned addr) { s16x4 r; asm volatile("ds_read_b64_tr_b16 %0, %1 offset:%2" : "=&v"(r) : "v"(addr), "i"(OFF) : "memory"); return r; }
#define TR_WAIT() do { asm volatile("s_waitcnt lgkmcnt(0)" ::: "memory"); __builtin_amdgcn_sched_barrier(0); } while (0)
#define CAT8(L, H) (bf16x8){L[0], L[1], L[2], L[3], H[0], H[1], H[2], H[3]}

DI void mlstm_stream(const Frame& F, const Args& a, int l, int stream, bool ctx_out) {
    const int b = stream >> 3, hd = (stream >> 1) & 3, dir = stream & 1;
    const int tid = F.tid, w = F.wave;
    LAS unsigned char* lds = F.lds;
    const unsigned ldsb = (unsigned)(uintptr_t)lds;
    const bf16_t* P = (const bf16_t*)(F.ws + WS_P); const float* X80 = (const float*)(F.ws + WS_X80);
    float* MLH = (float*)(F.ws + WS_MLH) + (size_t)dir * MTOT * 1024;
    const float* gb = a.in[I_GBIAS] + l * 16;
    const float gbi = gb[dir * 8 + hd], gbf = gb[dir * 8 + 4 + hd];
    LAS float* NV = (LAS float*)(lds + NV_OFF);
    LAS float* SC = (LAS float*)(lds + SC_OFF);
    f32x16 CT[8];
#pragma unroll
    for (int i = 0; i < 8; ++i) CT[i] = f32x16{};
    if (tid < 256) NV[tid] = 0.f;
    float m_prev = 0.f;
    const int sgn = dir ? -1 : 1;
#define CHUNK_ROW0(c) ((c) < 4 ? MLAT + b * CTXL + (dir ? 255 - (c) * 64 : (c) * 64) : b * SEQ + (dir ? 2047 - ((c) - 4) * 64 : ((c) - 4) * 64))
    bf16x8 pq[4], pk[4], pv[4]; float pgi, pgf;
#define PREFETCH(c) do { int ln_ = F.lane; asm volatile("" : "+v"(ln_)); const int r0_ = CHUNK_ROW0(c); \
        const bf16_t* pr_ = P + (size_t)(r0_ + sgn * ((w << 3) | (ln_ >> 3))) * NP + hd * 256 + 8 * (ln_ & 7); \
        _Pragma("unroll") for (int j = 0; j < 4; ++j) { pq[j] = *(const bf16x8*)(pr_ + C_MLQ + 64 * j); pk[j] = *(const bf16x8*)(pr_ + C_MLK + 64 * j); pv[j] = *(const bf16x8*)(pr_ + C_MLV + 64 * j); } \
        const float* xg_ = X80 + (size_t)(r0_ + sgn * ln_) * XW + 64 + dir * 8 + hd; pgi = xg_[0]; pgf = xg_[4]; } while (0)
    PREFETCH(0);
#ifndef MK_MLX
#define MK_MLX 1
#endif
    for (int cc = 0; cc < 36 * MK_MLX; ++cc) {
        const int c = cc % 36;
        if (MK_MLX > 1 && cc == 36) { __syncthreads();
#pragma unroll
            for (int i = 0; i < 8; ++i) CT[i] = f32x16{};
            if (tid < 256) NV[tid] = 0.f; m_prev = 0.f; }
        int lane = F.lane; asm volatile("" : "+v"(lane));
        const int r32 = lane & 31, hi = lane >> 5, ldi = (w << 3) | (lane >> 3), cg = lane & 7, g16 = lane >> 4, q4 = (lane & 15) >> 2, p4 = lane & 3;
        const int row0 = CHUNK_ROW0(c);
        const float ipre = pgi + gbi, fpre = pgf + gbf;
        const float lf = fminf(fpre, 0.f) - __logf(1.f + __expf(-fabsf(fpre)));
        float cum = lf;
#pragma unroll
        for (int o = 1; o < 64; o <<= 1) { const float t = __shfl_up(cum, o); if (lane >= o) cum += t; }
        const float bb = ipre - cum;
        float pmx = bb;
#pragma unroll
        for (int o = 1; o < 64; o <<= 1) { const float t = __shfl_up(pmx, o); if (lane >= o) pmx = fmaxf(pmx, t); }
        const float aa = fmaxf(m_prev, pmx);
        const float cum_end = __shfl(cum, 63), a_end = __shfl(aa, 63);
        const float decay = __expf(m_prev - a_end), m_new = cum_end + a_end;
        __syncthreads();
#pragma unroll
        for (int j = 0; j < 4; ++j) { const int ch = cg + 8 * j; const bf16x8 qv = pq[j];
            u32x4 qs;
            qs.x = pk2(bf2f((unsigned short)qv[0]) * 0.0625f, bf2f((unsigned short)qv[1]) * 0.0625f); qs.y = pk2(bf2f((unsigned short)qv[2]) * 0.0625f, bf2f((unsigned short)qv[3]) * 0.0625f);
            qs.z = pk2(bf2f((unsigned short)qv[4]) * 0.0625f, bf2f((unsigned short)qv[5]) * 0.0625f); qs.w = pk2(bf2f((unsigned short)qv[6]) * 0.0625f, bf2f((unsigned short)qv[7]) * 0.0625f);
            *(LAS u32x4*)(lds + QS_OFF + (ldi * LD + 8 * ch) * 2) = qs;
            *(LAS bf16x8*)(lds + KS_OFF + (ldi * LD + 8 * ch) * 2) = pk[j];
            *(LAS bf16x8*)(lds + VS_OFF + (ldi * LD + 8 * ch) * 2) = pv[j]; }
        {
            float part = 0.f;
#pragma unroll
            for (int j = 0; j < 4; ++j) { const int ch = cg + 8 * j; const bf16x8 qv = pq[j]; const f32x4 n0 = *(const LAS f32x4*)(NV + 8 * ch), n1 = *(const LAS f32x4*)(NV + 8 * ch + 4);
                part += bf2f((unsigned short)qv[0]) * n0.x + bf2f((unsigned short)qv[1]) * n0.y + bf2f((unsigned short)qv[2]) * n0.z + bf2f((unsigned short)qv[3]) * n0.w
                      + bf2f((unsigned short)qv[4]) * n1.x + bf2f((unsigned short)qv[5]) * n1.y + bf2f((unsigned short)qv[6]) * n1.z + bf2f((unsigned short)qv[7]) * n1.w; }
            part += __shfl_xor(part, 1); part += __shfl_xor(part, 2); part += __shfl_xor(part, 4);
            if (cg == 0) SC[320 + ldi] = part * 0.0625f; }
        if (w == 0) { SC[lane] = bb; SC[64 + lane] = aa; SC[128 + lane] = __expf(m_prev - aa); SC[192 + lane] = __expf(-cum - aa); SC[256 + lane] = __expf(bb - a_end); }
        __syncthreads();
        const bool want_out = (c >= 4) || ctx_out;
        if (want_out) {
            const unsigned va0 = ldsb + VS_OFF + ((4 * (g16 >> 1) + q4) * LD + 32 * w + 16 * (g16 & 1) + 4 * p4) * 2;
#pragma unroll
            for (int lt = 0; lt < 2; ++lt) {
                const int lcol = 32 * lt + r32;
                const float a_l = SC[64 + lcol], wI_l = SC[128 + lcol], fl_l = SC[192 + lcol], nq_l = SC[320 + lcol];
                f32x16 N = f32x16{};
#pragma unroll
                for (int dt = 0; dt < 8; ++dt)
#pragma unroll
                    for (int ks = 0; ks < 2; ++ks) {
                        const bf16x8 qa = ld_perm(lds + QS_OFF + (lcol * LD + 32 * dt + 16 * ks + 4 * hi) * 2);
                        N = MFMA32(pack_step(CT[dt], ks), qa, N); if (ks == 1 && (dt & 1)) __builtin_amdgcn_sched_barrier(0); }
#pragma unroll
                for (int r = 0; r < 16; ++r) N[r] *= wI_l;
                float den = 0.f;
#pragma unroll
                for (int st = 0; st <= lt; ++st) {
                    f32x16 S = f32x16{};
#pragma unroll
                    for (int ks = 0; ks < 16; ++ks) {
                        const bf16x8 ka = *(const LAS bf16x8*)(lds + KS_OFF + ((32 * st + r32) * LD + 16 * ks + 8 * hi) * 2);
                        const bf16x8 qb = *(const LAS bf16x8*)(lds + QS_OFF + (lcol * LD + 16 * ks + 8 * hi) * 2);
                        S = MFMA32(ka, qb, S); }
                    const s16x4 v00 = st == 0 ? tr_rd<0>(va0) : tr_rd<32 * ROWB>(va0), v01 = st == 0 ? tr_rd<8 * ROWB>(va0) : tr_rd<40 * ROWB>(va0);
                    const s16x4 v10 = st == 0 ? tr_rd<16 * ROWB>(va0) : tr_rd<48 * ROWB>(va0), v11 = st == 0 ? tr_rd<24 * ROWB>(va0) : tr_rd<56 * ROWB>(va0);
#pragma unroll
                    for (int r = 0; r < 16; ++r) { const int srow = 32 * st + crow(r, hi); const float dd = __expf(SC[srow] - a_l);
                        const float v = (srow <= lcol) ? S[r] * dd : 0.f; S[r] = v; den += v; }
                    TR_WAIT();
                    N = MFMA32(CAT8(v00, v01), pack_step(S, 0), N);
                    N = MFMA32(CAT8(v10, v11), pack_step(S, 1), N);
                }
                den += __shfl_xor(den, 32);
                den += wI_l * nq_l;
                const float inv = 1.f / fmaxf(fabsf(den), fl_l);
                float* orow = MLH + (size_t)(row0 + sgn * lcol) * 1024 + hd * 256 + 32 * w + 4 * hi;
#pragma unroll
                for (int g = 0; g < 4; ++g) *(f32x4*)(orow + 8 * g) = (f32x4){N[4 * g] * inv, N[4 * g + 1] * inv, N[4 * g + 2] * inv, N[4 * g + 3] * inv};
                __builtin_amdgcn_sched_barrier(0);
            }
        }
        __builtin_amdgcn_sched_barrier(0);
        { const int cn = (cc + 1 < 36 * MK_MLX) ? (cc + 1) % 36 : 35; PREFETCH(cn); }
        __builtin_amdgcn_sched_barrier(0);
        {
            const unsigned vb0 = ldsb + VS_OFF + ((8 * (g16 >> 1) + q4) * LD + 32 * w + 16 * (g16 & 1) + 4 * p4) * 2;
            const unsigned kb0 = ldsb + KS_OFF + ((8 * (g16 >> 1) + q4) * LD + 16 * (g16 & 1) + 4 * p4) * 2;
            const s16x4 b00 = tr_rd<0>(vb0), b01 = tr_rd<4 * ROWB>(vb0), b10 = tr_rd<16 * ROWB>(vb0), b11 = tr_rd<20 * ROWB>(vb0);
            const s16x4 b20 = tr_rd<32 * ROWB>(vb0), b21 = tr_rd<36 * ROWB>(vb0), b30 = tr_rd<48 * ROWB>(vb0), b31 = tr_rd<52 * ROWB>(vb0);
            TR_WAIT();
            bf16x8 vb[4];
#define SCALE8(dst, L, H, ks) do { const f32x4 w0 = *(const LAS f32x4*)(SC + 256 + 16 * (ks) + 8 * hi), w1 = *(const LAS f32x4*)(SC + 256 + 16 * (ks) + 8 * hi + 4); \
            u32x4 t_; t_.x = pk2(bf2f((unsigned short)L[0]) * w0.x, bf2f((unsigned short)L[1]) * w0.y); t_.y = pk2(bf2f((unsigned short)L[2]) * w0.z, bf2f((unsigned short)L[3]) * w0.w); \
            t_.z = pk2(bf2f((unsigned short)H[0]) * w1.x, bf2f((unsigned short)H[1]) * w1.y); t_.w = pk2(bf2f((unsigned short)H[2]) * w1.z, bf2f((unsigned short)H[3]) * w1.w); dst = __builtin_bit_cast(bf16x8, t_); } while (0)
            SCALE8(vb[0], b00, b01, 0); SCALE8(vb[1], b10, b11, 1); SCALE8(vb[2], b20, b21, 2); SCALE8(vb[3], b30, b31, 3);
#undef SCALE8
#define UPD(dt) do { const s16x4 k00 = tr_rd<(dt) * 64>(kb0), k01 = tr_rd<(dt) * 64 + 4 * ROWB>(kb0), k10 = tr_rd<(dt) * 64 + 16 * ROWB>(kb0), k11 = tr_rd<(dt) * 64 + 20 * ROWB>(kb0); \
            const s16x4 k20 = tr_rd<(dt) * 64 + 32 * ROWB>(kb0), k21 = tr_rd<(dt) * 64 + 36 * ROWB>(kb0), k30 = tr_rd<(dt) * 64 + 48 * ROWB>(kb0), k31 = tr_rd<(dt) * 64 + 52 * ROWB>(kb0); \
            _Pragma("unroll") for (int r = 0; r < 16; ++r) CT[dt][r] *= decay; \
            TR_WAIT(); \
            CT[dt] = MFMA32(CAT8(k00, k01), vb[0], CT[dt]); CT[dt] = MFMA32(CAT8(k10, k11), vb[1], CT[dt]); CT[dt] = MFMA32(CAT8(k20, k21), vb[2], CT[dt]); CT[dt] = MFMA32(CAT8(k30, k31), vb[3], CT[dt]); } while (0)
            UPD(0); UPD(1); UPD(2); UPD(3); UPD(4); UPD(5); UPD(6); UPD(7);
#undef UPD
        }
        __syncthreads();
        if (tid < 256) { float sacc = 0.f;
#pragma unroll 8
            for (int q = 0; q < 64; ++q) sacc += bf2f(*(const LAS unsigned short*)(lds + KS_OFF + (q * LD + tid) * 2)) * SC[256 + q];
            NV[tid] = decay * NV[tid] + sacc; }
        m_prev = m_new;
    }
    __syncthreads();
#undef CHUNK_ROW0
#undef PREFETCH
}

namespace u2 {
constexpr int LDQ = 264, ROWQ = LDQ * 2, LDV = 136, ROWV = LDV * 2, LDW = 72, ROWW = LDW * 2;
constexpr int QS = 0, KS = 64 * ROWQ, VS = 2 * 64 * ROWQ, SW = VS + 64 * ROWV, NV_O = SW + 64 * ROWW, SC_O = NV_O + 1024, SCN = 448, END = SC_O + 2 * SCN * 4;
static_assert(END <= LDS_BYTES - 1024, "mlstm2 lds");
}
DI void mlstm_unit2(const Frame& F, const Args& a, int l, int unit, bool ctx_out) {
    using namespace u2;
    const int stream = unit >> 1, half = unit & 1, b = stream >> 3, hd = (stream >> 1) & 3, dir = stream & 1;
    const int tid = F.tid, w = F.wave;
    LAS unsigned char* lds = F.lds;
    const unsigned ldsb = (unsigned)(uintptr_t)lds;
    const bf16_t* P = (const bf16_t*)(F.ws + WS_P); const float* X80 = (const float*)(F.ws + WS_X80);
    float* MLH = (float*)(F.ws + WS_MLH) + (size_t)dir * MTOT * 1024;
    const float* gb = a.in[I_GBIAS] + l * 16;
    const float gbi = gb[dir * 8 + hd], gbf = gb[dir * 8 + 4 + hd];
    LAS float* NV = (LAS float*)(lds + NV_O);
    const int sgn = dir ? -1 : 1;
#define CHUNK_ROW0(c) ((c) < 4 ? MLAT + b * CTXL + (dir ? 255 - (c) * 64 : (c) * 64) : b * SEQ + (dir ? 2047 - ((c) - 4) * 64 : ((c) - 4) * 64))
    const bool helper = w >= 4;
    bf16x8 pq[8], pk[8], pv[4]; float pgi = 0.f, pgf = 0.f; float m_prev = 0.f;
#define PREFETCH(c) do { int ht_ = tid - 256; asm volatile("" : "+v"(ht_)); const int r0_ = CHUNK_ROW0(c); \
        const bf16_t* pr_ = P + (size_t)(r0_ + sgn * (ht_ >> 2)) * NP + hd * 256 + 8 * (ht_ & 3); \
        _Pragma("unroll") for (int j = 0; j < 8; ++j) { pq[j] = *(const bf16x8*)(pr_ + C_MLQ + 32 * j); pk[j] = *(const bf16x8*)(pr_ + C_MLK + 32 * j); } \
        _Pragma("unroll") for (int j = 0; j < 4; ++j) pv[j] = *(const bf16x8*)(pr_ + C_MLV + 128 * half + 32 * j); \
        const float* xg_ = X80 + (size_t)(r0_ + sgn * (ht_ & 63)) * XW + 64 + dir * 8 + hd; pgi = xg_[0]; pgf = xg_[4]; } while (0)
#define SCALARS(sb) do { int ln_ = F.lane; asm volatile("" : "+v"(ln_)); LAS float* SCw = (LAS float*)(lds + SC_O) + (sb) * SCN; \
        const float ipre = pgi + gbi, fpre = pgf + gbf; const float lf = fminf(fpre, 0.f) - __logf(1.f + __expf(-fabsf(fpre))); \
        float cum = lf; _Pragma("unroll") for (int o = 1; o < 64; o <<= 1) { const float t = __shfl_up(cum, o); if (ln_ >= o) cum += t; } \
        const float bb = ipre - cum; float pmx = bb; _Pragma("unroll") for (int o = 1; o < 64; o <<= 1) { const float t = __shfl_up(pmx, o); if (ln_ >= o) pmx = fmaxf(pmx, t); } \
        const float aa = fmaxf(m_prev, pmx); const float cum_end = __shfl(cum, 63), a_end = __shfl(aa, 63); \
        if (w == 4) { SCw[ln_] = bb; SCw[64 + ln_] = aa; SCw[128 + ln_] = __expf(m_prev - aa); SCw[192 + ln_] = __expf(-cum - aa); SCw[256 + ln_] = __expf(bb - a_end); if (ln_ == 0) SCw[384] = __expf(m_prev - a_end); } \
        m_prev = cum_end + a_end; } while (0)
#define WRITE_Q() do { int ht_ = tid - 256; asm volatile("" : "+v"(ht_)); const int hp_ = ht_ >> 2, hg_ = ht_ & 3; \
        _Pragma("unroll") for (int j = 0; j < 8; ++j) { const bf16x8 qv = pq[j]; u32x4 qs; \
            qs.x = pk2(bf2f((unsigned short)qv[0]) * 0.0625f, bf2f((unsigned short)qv[1]) * 0.0625f); qs.y = pk2(bf2f((unsigned short)qv[2]) * 0.0625f, bf2f((unsigned short)qv[3]) * 0.0625f); \
            qs.z = pk2(bf2f((unsigned short)qv[4]) * 0.0625f, bf2f((unsigned short)qv[5]) * 0.0625f); qs.w = pk2(bf2f((unsigned short)qv[6]) * 0.0625f, bf2f((unsigned short)qv[7]) * 0.0625f); \
            *(LAS u32x4*)(lds + QS + (hp_ * LDQ + 8 * (hg_ + 4 * j)) * 2) = qs; } } while (0)
#define WRITE_KV() do { int ht_ = tid - 256; asm volatile("" : "+v"(ht_)); const int hp_ = ht_ >> 2, hg_ = ht_ & 3; \
        _Pragma("unroll") for (int j = 0; j < 8; ++j) *(LAS bf16x8*)(lds + KS + (hp_ * LDQ + 8 * (hg_ + 4 * j)) * 2) = pk[j]; \
        _Pragma("unroll") for (int j = 0; j < 4; ++j) *(LAS bf16x8*)(lds + VS + (hp_ * LDV + 8 * (hg_ + 4 * j)) * 2) = pv[j]; } while (0)
    LAS float* DEN = (LAS float*)(lds + END);
    static_assert(END + 768 <= LDS_BYTES - 1024, "mlstm2 lds den");
    __syncthreads();
    if (helper) { NV[tid - 256] = 0.f; PREFETCH(0); SCALARS(0); WRITE_Q(); WRITE_KV(); }
    __syncthreads();
    if (!helper) {
      f32x16 CT[8];
#pragma unroll
      for (int i = 0; i < 8; ++i) CT[i] = f32x16{};
      for (int c = 0; c < 36; ++c) {
        const int sb = c & 1;
        const LAS float* SC = (const LAS float*)(lds + SC_O) + sb * SCN;
        const bool want_out = (c >= 4) || ctx_out;
        int lane = F.lane; asm volatile("" : "+v"(lane));
        const int r32 = lane & 31, hi = lane >> 5, g16 = lane >> 4, q4 = (lane & 15) >> 2, p4 = lane & 3;
        const int row0 = CHUNK_ROW0(c);
        f32x16 N0 = f32x16{}, N1 = f32x16{};
        {
            if (want_out) {
#pragma unroll
                for (int dt = 0; dt < 8; ++dt)
#pragma unroll
                    for (int ks = 0; ks < 2; ++ks) {
                        const bf16x8 cf = pack_step(CT[dt], ks);
                        const bf16x8 qa0 = ld_perm(lds + QS + (r32 * LDQ + 32 * dt + 16 * ks + 4 * hi) * 2), qa1 = ld_perm(lds + QS + ((32 + r32) * LDQ + 32 * dt + 16 * ks + 4 * hi) * 2);
                        N0 = MFMA32(cf, qa0, N0); N1 = MFMA32(cf, qa1, N1); if (ks == 1 && (dt & 1)) __builtin_amdgcn_sched_barrier(0); }
                const float wI0 = SC[128 + r32], wI1 = SC[128 + 32 + r32];
#pragma unroll
                for (int r = 0; r < 16; ++r) { N0[r] *= wI0; N1[r] *= wI1; }
            }
        }
        __syncthreads();
        {
            if (want_out) {
                const unsigned va0 = ldsb + VS + ((8 * (g16 >> 1) + q4) * LDV + 32 * w + 16 * (g16 & 1) + 4 * p4) * 2;
                const s16x4 a00 = tr_rd<0>(va0), a01 = tr_rd<4 * ROWV>(va0), a10 = tr_rd<16 * ROWV>(va0), a11 = tr_rd<20 * ROWV>(va0);
                const s16x4 a20 = tr_rd<32 * ROWV>(va0), a21 = tr_rd<36 * ROWV>(va0), a30 = tr_rd<48 * ROWV>(va0), a31 = tr_rd<52 * ROWV>(va0);
                const LAS unsigned char* sw0 = lds + SW + (r32 * LDW + 8 * hi) * 2; const LAS unsigned char* sw1 = sw0 + 32 * ROWW;
                const bf16x8 s00 = *(const LAS bf16x8*)(sw0), s01 = *(const LAS bf16x8*)(sw0 + 32);
                const bf16x8 s10 = *(const LAS bf16x8*)(sw1), s11 = *(const LAS bf16x8*)(sw1 + 32), s12 = *(const LAS bf16x8*)(sw1 + 64), s13 = *(const LAS bf16x8*)(sw1 + 96);
                TR_WAIT();
                N0 = MFMA32(CAT8(a00, a01), s00, N0); N0 = MFMA32(CAT8(a10, a11), s01, N0);
                N1 = MFMA32(CAT8(a00, a01), s10, N1); N1 = MFMA32(CAT8(a10, a11), s11, N1); N1 = MFMA32(CAT8(a20, a21), s12, N1); N1 = MFMA32(CAT8(a30, a31), s13, N1);
                {
                    const float den0 = DEN[r32] + SC[128 + r32] * SC[320 + r32];
                    const float den1 = DEN[64 + 32 + r32] + DEN[128 + 32 + r32] + SC[128 + 32 + r32] * SC[320 + 32 + r32];
                    const float inv0 = 1.f / fmaxf(fabsf(den0), SC[192 + r32]), inv1 = 1.f / fmaxf(fabsf(den1), SC[192 + 32 + r32]);
                    float* o0 = MLH + (size_t)(row0 + sgn * r32) * 1024 + hd * 256 + 128 * half + 32 * w + 4 * hi; float* o1 = MLH + (size_t)(row0 + sgn * (32 + r32)) * 1024 + hd * 256 + 128 * half + 32 * w + 4 * hi;
#pragma unroll
                    for (int g = 0; g < 4; ++g) { *(f32x4*)(o0 + 8 * g) = (f32x4){N0[4 * g] * inv0, N0[4 * g + 1] * inv0, N0[4 * g + 2] * inv0, N0[4 * g + 3] * inv0};
                        *(f32x4*)(o1 + 8 * g) = (f32x4){N1[4 * g] * inv1, N1[4 * g + 1] * inv1, N1[4 * g + 2] * inv1, N1[4 * g + 3] * inv1}; }
                }
            }
            __builtin_amdgcn_sched_barrier(0);
            {
                const float decay = SC[384];
                const unsigned vb0 = ldsb + VS + ((8 * (g16 >> 1) + q4) * LDV + 32 * w + 16 * (g16 & 1) + 4 * p4) * 2;
                const unsigned kb0 = ldsb + KS + ((8 * (g16 >> 1) + q4) * LDQ + 16 * (g16 & 1) + 4 * p4) * 2;
                const s16x4 b00 = tr_rd<0>(vb0), b01 = tr_rd<4 * ROWV>(vb0), b10 = tr_rd<16 * ROWV>(vb0), b11 = tr_rd<20 * ROWV>(vb0);
                const s16x4 b20 = tr_rd<32 * ROWV>(vb0), b21 = tr_rd<36 * ROWV>(vb0), b30 = tr_rd<48 * ROWV>(vb0), b31 = tr_rd<52 * ROWV>(vb0);
                TR_WAIT();
                bf16x8 vb[4];
#define SCALE8(dst, L, H, ks) do { const f32x4 w0 = *(const LAS f32x4*)(SC + 256 + 16 * (ks) + 8 * hi), w1 = *(const LAS f32x4*)(SC + 256 + 16 * (ks) + 8 * hi + 4); \
                u32x4 t_; t_.x = pk2(bf2f((unsigned short)L[0]) * w0.x, bf2f((unsigned short)L[1]) * w0.y); t_.y = pk2(bf2f((unsigned short)L[2]) * w0.z, bf2f((unsigned short)L[3]) * w0.w); \
                t_.z = pk2(bf2f((unsigned short)H[0]) * w1.x, bf2f((unsigned short)H[1]) * w1.y); t_.w = pk2(bf2f((unsigned short)H[2]) * w1.z, bf2f((unsigned short)H[3]) * w1.w); dst = __builtin_bit_cast(bf16x8, t_); } while (0)
                SCALE8(vb[0], b00, b01, 0); SCALE8(vb[1], b10, b11, 1); SCALE8(vb[2], b20, b21, 2); SCALE8(vb[3], b30, b31, 3);
#undef SCALE8
#define UPD(dt) do { const s16x4 k00 = tr_rd<(dt) * 64>(kb0), k01 = tr_rd<(dt) * 64 + 4 * ROWQ>(kb0), k10 = tr_rd<(dt) * 64 + 16 * ROWQ>(kb0), k11 = tr_rd<(dt) * 64 + 20 * ROWQ>(kb0); \
                const s16x4 k20 = tr_rd<(dt) * 64 + 32 * ROWQ>(kb0), k21 = tr_rd<(dt) * 64 + 36 * ROWQ>(kb0), k30 = tr_rd<(dt) * 64 + 48 * ROWQ>(kb0), k31 = tr_rd<(dt) * 64 + 52 * ROWQ>(kb0); \
                _Pragma("unroll") for (int r = 0; r < 16; ++r) CT[dt][r] *= decay; \
                TR_WAIT(); \
                CT[dt] = MFMA32(CAT8(k00, k01), vb[0], CT[dt]); CT[dt] = MFMA32(CAT8(k10, k11), vb[1], CT[dt]); CT[dt] = MFMA32(CAT8(k20, k21), vb[2], CT[dt]); CT[dt] = MFMA32(CAT8(k30, k31), vb[3], CT[dt]); } while (0)
                UPD(0); UPD(1); UPD(2); UPD(3); UPD(4); UPD(5); UPD(6); UPD(7);
#undef UPD
            }
        }
        __syncthreads();
        __syncthreads();
      }
    } else {
      for (int c = 0; c < 36; ++c) {
        const int sb = c & 1;
        const LAS float* SC = (const LAS float*)(lds + SC_O) + sb * SCN;
        const bool want_out = (c >= 4) || ctx_out;
        int lane = F.lane; asm volatile("" : "+v"(lane));
        const int r32 = lane & 31, hi = lane >> 5, g16 = lane >> 4, q4 = (lane & 15) >> 2, p4 = lane & 3;
        const int row0 = CHUNK_ROW0(c);
        {
            if (want_out) {
                if (w < 7) {
                    const int st = (w == 6) ? 1 : 0, lt = (w == 4) ? 0 : 1, lcol = 32 * lt + r32;
                    f32x16 S = f32x16{};
#pragma unroll
                    for (int ks = 0; ks < 16; ++ks) {
                        const bf16x8 ka = *(const LAS bf16x8*)(lds + KS + ((32 * st + r32) * LDQ + 16 * ks + 8 * hi) * 2);
                        const bf16x8 qb = *(const LAS bf16x8*)(lds + QS + (lcol * LDQ + 16 * ks + 8 * hi) * 2);
                        S = MFMA32(ka, qb, S); }
                    const float a_l = SC[64 + lcol]; float den = 0.f;
#pragma unroll
                    for (int r = 0; r < 16; ++r) { const int srow = 32 * st + crow(r, hi); const float dd = __expf(SC[srow] - a_l);
                        const float v = (srow <= lcol) ? S[r] * dd : 0.f; S[r] = v; den += v; }
                    den += __shfl_xor(den, 32);
                    if (hi == 0) DEN[(w - 4) * 64 + lcol] = den;
#pragma unroll
                    for (int g = 0; g < 4; ++g) { u32x2 t_; t_.x = pk2(S[4 * g], S[4 * g + 1]); t_.y = pk2(S[4 * g + 2], S[4 * g + 3]);
                        *(LAS u32x2*)(lds + SW + (lcol * LDW + 32 * st + 8 * g + 4 * hi) * 2) = t_; }
                } else {
                    float nq = 0.f; const LAS unsigned char* qrow = lds + QS + lane * ROWQ;
#pragma unroll 4
                    for (int d8 = 0; d8 < 32; ++d8) { const bf16x8 qv = *(const LAS bf16x8*)(qrow + d8 * 16); const f32x4 n0 = *(const LAS f32x4*)(NV + 8 * d8), n1 = *(const LAS f32x4*)(NV + 8 * d8 + 4);
                        nq += bf2f((unsigned short)qv[0]) * n0.x + bf2f((unsigned short)qv[1]) * n0.y + bf2f((unsigned short)qv[2]) * n0.z + bf2f((unsigned short)qv[3]) * n0.w
                            + bf2f((unsigned short)qv[4]) * n1.x + bf2f((unsigned short)qv[5]) * n1.y + bf2f((unsigned short)qv[6]) * n1.z + bf2f((unsigned short)qv[7]) * n1.w; }
                    ((LAS float*)(lds + SC_O) + sb * SCN)[320 + lane] = nq;
                }
            }
            { const int cn = c + 1 < 36 ? c + 1 : 35; PREFETCH(cn); }
        }
        __syncthreads();
        {
            {
                const int d = tid - 256; const float decay = SC[384]; float sacc = 0.f;
#pragma unroll 8
                for (int q = 0; q < 64; ++q) sacc += bf2f(*(const LAS unsigned short*)(lds + KS + (q * LDQ + d) * 2)) * SC[256 + q];
                NV[d] = decay * NV[d] + sacc;
            }
            SCALARS(sb ^ 1);
            WRITE_Q();
        }
        __syncthreads();
        WRITE_KV();
        __syncthreads();
      }
    }
#undef CHUNK_ROW0
#undef PREFETCH
#undef SCALARS
#undef WRITE_Q
#undef WRITE_KV
}
#undef MFMA32
#undef TR_WAIT
#undef CAT8
}

DI void phase_mixers(const Frame& F, const Args& a, int l, char* ldsg, int npass) {
    unsigned* head0 = (unsigned*)(F.ws + WS_CTL) + CW_QUEUE + 64 * l;
    volatile LAS unsigned* MISC = (volatile LAS unsigned*)(F.lds + LDS_BYTES - 64);
    const int n_ml = 64, n_la = 256, n_ga = 256, n_cx = (l == 0) ? 32 : 0, n_mix = n_ml + n_la + n_ga + 2 * n_cx;
    const int total = n_mix;
    const bf16_t* QLA = (const bf16_t*)(F.ws + WS_QLA); const bf16_t* KVLA = (const bf16_t*)(F.ws + WS_KVLA); const bf16_t* KR = (const bf16_t*)(F.ws + WS_KR);
    const bf16_t* QG = (const bf16_t*)(F.ws + WS_QG); const bf16_t* KG = (const bf16_t*)(F.ws + WS_KG); const bf16_t* P = (const bf16_t*)(F.ws + WS_P);
    bf16_t* YCAT = (bf16_t*)(F.ws + WS_YCAT);
#ifndef MK_MIX
#define MK_MIX 7
#endif
#define GRAB(u) do { __syncthreads(); if (F.tid == 0) MISC[4] = __hip_atomic_fetch_add(head, 1u, __ATOMIC_RELAXED, __HIP_MEMORY_SCOPE_AGENT); __syncthreads(); u = __builtin_amdgcn_readfirstlane((int)MISC[4]); } while (0)
    for (int pass = 0; pass < npass; ++pass) {
    unsigned* head = head0 + 128 * pass;
    int u0;
    GRAB(u0);
    while (u0 < n_ml) { if (MK_MIX & 1) ml::mlstm_unit2(F, a, l, u0, l == 0); GRAB(u0); }
    while (u0 < n_mix) {
        int u = u0 - n_ml;
        if (u < n_la) { const int b = u >> 6, h = (u >> 3) & 7, qb = u & 7; const long q0 = (long)b * SEQ + qb * 256;
            if (MK_MIX & 2) att::attn_body<64, 1536, 2048, 2048, 3072>(QLA + q0 * 1536 + h * 192, KVLA + h * 256, KR, KVLA + h * 256 + 128, YCAT + q0 * 3072 + 1024 + h * 128,
                                                      MLAT + b * CTXL, 4, b * SEQ, 32, 0.07216878364870322f, (const float*)(F.ws + WS_ROPE_LA) + (size_t)qb * 256 * 64, ldsg); }
        else if (u < n_la + n_ga) { u -= n_la; const int b = u >> 6, h = (u >> 3) & 7, qb = u & 7; const long q0 = (long)b * SEQ + qb * 256;
            if (MK_MIX & 4) att::attn_body<0, 1024, 256, NP, 3072>(QG + q0 * 1024 + h * 128, KG + (h >> 2) * 128, nullptr, P + C_GV + (h >> 2) * 128, YCAT + q0 * 3072 + 2048 + h * 128,
                                                  MLAT + b * CTXL, 4, b * SEQ, 32, 0.08838834764831845f, nullptr, ldsg); }
        else if (u < n_la + n_ga + n_cx) { u -= n_la + n_ga; const int b = u >> 3, h = u & 7; const long q0 = (long)MLAT + b * CTXL;
            if (MK_MIX & 2) att::attn_body<64, 1536, 2048, 2048, 3072>(QLA + q0 * 1536 + h * 192, KVLA + h * 256, KR, KVLA + h * 256 + 128, YCAT + q0 * 3072 + 1024 + h * 128,
                                                      MLAT + b * CTXL, 4, 0, 0, 0.07216878364870322f, nullptr, ldsg); }
        else { u -= n_la + n_ga + n_cx; const int b = u >> 3, h = u & 7; const long q0 = (long)MLAT + b * CTXL;
            if (MK_MIX & 4) att::attn_body<0, 1024, 256, NP, 3072>(QG + q0 * 1024 + h * 128, KG + (h >> 2) * 128, nullptr, P + C_GV + (h >> 2) * 128, YCAT + q0 * 3072 + 2048 + h * 128,
                                                  MLAT + b * CTXL, 4, 0, 0, 0.08838834764831845f, nullptr, ldsg); }
        GRAB(u0);
    }
    }
#undef GRAB
}

DI void phase_convert_tail(const Frame& F0, const Args& a, int l) {
    Frame F = F0; { int t_ = threadIdx.x; asm volatile("" : "+v"(t_)); F.tid = t_; F.lane = t_ & 63; F.wave = __builtin_amdgcn_readfirstlane(t_ >> 6); }
    constexpr int CVB = 64;
    unsigned* head = (unsigned*)(F.ws + WS_CTL) + CW_QUEUE + 64 * l + 32;
    volatile LAS unsigned* MISC = (volatile LAS unsigned*)(F.lds + LDS_BYTES - 64);
    const int n_cv = ((IT_LAYER - IT_EARLY) + ((l == 0) ? IT_EARLY : 0)) / CVB;
    LAS float* scr = (LAS float*)(F.lds + F.wave * 16384);
    for (;;) {
        __syncthreads();
        if (F.tid == 0) MISC[4] = __hip_atomic_fetch_add(head, 1u, __ATOMIC_RELAXED, __HIP_MEMORY_SCOPE_AGENT);
        __syncthreads();
        const int blk = __builtin_amdgcn_readfirstlane((int)MISC[4]);
        if (blk >= n_cv) break;
#pragma unroll 1
        for (int q = 0; q < CVB / NWAVES; ++q) { const int r = blk * CVB + q * NWAVES + F.wave;
            if (r < IT_LAYER - IT_EARLY) convert_item(F, a, l, IT_EARLY + r, scr); else convert_item(F, a, 1, r - (IT_LAYER - IT_EARLY), scr); }
    }
}

DI void phase_mlfin(const Frame& F, const Args& a, int l, int nrows) {
    const float* H0 = (const float*)(F.ws + WS_MLH); const float* H1 = H0 + (size_t)MTOT * 1024;
    const bf16_t* P = (const bf16_t*)(F.ws + WS_P); bf16_t* YCAT = (bf16_t*)(F.ws + WS_YCAT); const float* gn = a.in[I_MLNORM] + l * 1024;
    for (int row = F.gw; row < nrows; row += F.ngw) {
#pragma unroll
        for (int hd = 0; hd < 4; ++hd) { const int c = hd * 256 + 4 * F.lane;
            const f32x4 v = *(const f32x4*)(H0 + (size_t)row * 1024 + c) + *(const f32x4*)(H1 + (size_t)row * 1024 + c);
            const float rs = rsqrtf(wave_sum(v.x * v.x + v.y * v.y + v.z * v.z + v.w * v.w) * (1.f / 256.f) + EPS);
            const f32x4 g = *(const f32x4*)(gn + c); const s16x4 og = *(const s16x4*)(P + (size_t)row * NP + C_MLO + c);
            u32x2 w; w.x = pk2(v.x * rs * g.x * sigmoidf_(bf2f((unsigned short)og[0])), v.y * rs * g.y * sigmoidf_(bf2f((unsigned short)og[1])));
            w.y = pk2(v.z * rs * g.z * sigmoidf_(bf2f((unsigned short)og[2])), v.w * rs * g.w * sigmoidf_(bf2f((unsigned short)og[3])));
            *(u32x2*)(YCAT + (size_t)row * 3072 + c) = w; }
    }
}

struct SchedMerge {
    const char* Y; const char* Bt; int nM, G, c;
    DI bool next(int i, Unit& u) const {
        const int k = i / 3, br = i - 3 * k; const long L = (long)k * G + c; if (L >= (long)nM * 8) return false;
        int pm, pn; pg8::tile_of((int)L, nM, 8, pm, pn);
        u.pm = pm; u.pn = pn; u.aux = br; u.nt = 16; u.pa = Y + (size_t)pm * 256 * 6144 + br * 2048; u.pb = Bt + ((size_t)br * 2048 + pn * 256) * 2048; return true;
    }
};
struct EpiMerge {
    const bf16_t* P; bf16_t* ZG; bf16_t* MB;
    DI void operator()(const f32x4 (&acc)[2][2][4][2], const Unit& u, int wr, int wc, int fr, int fq) const {
        const int br = u.aux;
        EPI_FOREACH({
            const bf16x8 gp = *(const bf16x8*)(P + (size_t)row * NP + C_GATE + br * 2048 + col);
            f32x4 g0, g1;
            g0.x = sigmoidf_(bf2f((unsigned short)gp[0])); g0.y = sigmoidf_(bf2f((unsigned short)gp[1])); g0.z = sigmoidf_(bf2f((unsigned short)gp[2])); g0.w = sigmoidf_(bf2f((unsigned short)gp[3]));
            g1.x = sigmoidf_(bf2f((unsigned short)gp[4])); g1.y = sigmoidf_(bf2f((unsigned short)gp[5])); g1.z = sigmoidf_(bf2f((unsigned short)gp[6])); g1.w = sigmoidf_(bf2f((unsigned short)gp[7]));
            f32x4 r0 = v0 * g0, r1 = v1 * g1;
            const size_t off = (size_t)row * DM + col;
            if (br < 2) *(u32x4*)(ZG + (size_t)br * MTOT * DM + off) = pack8(r0, r1);
            else { const bf16x8 z0 = *(const bf16x8*)(ZG + off), z1 = *(const bf16x8*)(ZG + (size_t)MTOT * DM + off);
                r0 += (f32x4){bf2f((unsigned short)z0[0]) + bf2f((unsigned short)z1[0]), bf2f((unsigned short)z0[1]) + bf2f((unsigned short)z1[1]), bf2f((unsigned short)z0[2]) + bf2f((unsigned short)z1[2]), bf2f((unsigned short)z0[3]) + bf2f((unsigned short)z1[3])};
                r1 += (f32x4){bf2f((unsigned short)z0[4]) + bf2f((unsigned short)z1[4]), bf2f((unsigned short)z0[5]) + bf2f((unsigned short)z1[5]), bf2f((unsigned short)z0[6]) + bf2f((unsigned short)z1[6]), bf2f((unsigned short)z0[7]) + bf2f((unsigned short)z1[7])};
                *(u32x4*)(MB + off) = pack8(r0, r1); }
        })
    }
};
struct EpiOut {
    const float* xin; const float* ctxin; float* X1; const float* mods; int l;
    DI void operator()(const f32x4 (&acc)[2][2][4][2], const Unit& u, int wr, int wc, int fr, int fq) const {
        EPI_FOREACH({
            const float* rp = (l == 0) ? (row < MLAT ? xin + (size_t)row * DM : ctxin + (size_t)(row - MLAT) * DM) : X1 + (size_t)row * DM;
            const float* gp = mods + ((size_t)(l * 5 + mods_row(row)) * 6 + 2) * DM + col;
            float* op = X1 + (size_t)row * DM + col;
            *(f32x4*)op = *(const f32x4*)(rp + col) + *(const f32x4*)gp * v0; *(f32x4*)(op + 4) = *(const f32x4*)(rp + col + 4) + *(const f32x4*)(gp + 4) * v1;
        })
    }
};
DI void phase_topk(const Frame& F, const Args& a, int l, int bid) {
    const float* AFF = (const float*)(F.ws + WS_AFF); const bf16_t* H = (const bf16_t*)(F.ws + WS_H);
    int* ROWS = (int*)(F.ws + WS_ROWS); float* VALS = (float*)(F.ws + WS_VALS); bf16_t* AG = (bf16_t*)(F.ws + WS_AG); int* TOK = (int*)(F.ws + WS_TOK);
    LAS float* vals = (LAS float*)F.lds; LAS int* lst = (LAS int*)(F.lds + 8192); LAS int* cnt = (LAS int*)(F.lds + 8192 + 4096);
    const int nitems = (l == 0) ? 256 + 64 + 16 : 256;
    for (int it = bid; it < nitems; it += F.G) {
        if (it >= 320) {
            const int e = it - 320;
            for (int s = F.tid; s < 128; s += NTHR) { ROWS[e * ESLOT + 1152 + s] = -1; VALS[e * ESLOT + 1152 + s] = 0.f; }
            u32x4* dst = (u32x4*)(AG + ((size_t)e * ESLOT + 1152) * DM);
            unsigned z = 0u; asm volatile("" : "+v"(z));
            for (int i = F.tid; i < 128 * DM / 8; i += NTHR) dst[i] = (u32x4){z, z, z, z};
            continue;
        }
        const int lat = it < 256, b = lat ? (it >> 6) : ((it - 256) >> 4), e = lat ? ((it >> 2) & 15) : ((it - 256) & 15), qtr = lat ? (it & 3) : 0;
        const int ntok = lat ? SEQ : CTXL, cap = ntok >> 3, rowbase = lat ? b * SEQ : MLAT + b * CTXL, slotbase = lat ? b * 256 : 1024 + b * 32;
        __syncthreads();
        for (int i = F.tid; i < ntok; i += NTHR) vals[i] = AFF[(size_t)(rowbase + i) * 16 + e];
        if (F.tid == 0) cnt[0] = 0;
        __syncthreads();
        {
            const int i = qtr * 512 + F.tid; const bool act = i < ntok; const float v = act ? vals[i] : 0.f; int rk = 0;
            for (int j = 0; j < ntok; j += 4) { const f32x4 vj = *(const LAS f32x4*)(vals + j);
                rk += (vj.x > v || (vj.x == v && j < i)) + (vj.y > v || (vj.y == v && j + 1 < i)) + (vj.z > v || (vj.z == v && j + 2 < i)) + (vj.w > v || (vj.w == v && j + 3 < i)); }
            if (act) { TOK[(size_t)(rowbase + i) * 16 + e] = rk < cap ? slotbase + rk : -1;
                if (rk < cap) { const int p = atomicAdd((int*)cnt, 1); lst[2 * p] = i; lst[2 * p + 1] = rk; ROWS[e * ESLOT + slotbase + rk] = rowbase + i; VALS[e * ESLOT + slotbase + rk] = v; } }
        }
        __syncthreads();
        const int n = cnt[0];
        for (int s = F.wave; s < n; s += 2 * NWAVES) {
            const int s2 = s + NWAVES; const bool two = s2 < n;
            const u32x4* src0 = (const u32x4*)(H + (size_t)(rowbase + lst[2 * s]) * DM); u32x4* dst0 = (u32x4*)(AG + ((size_t)e * ESLOT + slotbase + lst[2 * s + 1]) * DM);
            const u32x4* src1 = (const u32x4*)(H + (size_t)(rowbase + lst[2 * (two ? s2 : s)]) * DM); u32x4* dst1 = (u32x4*)(AG + ((size_t)e * ESLOT + slotbase + lst[2 * (two ? s2 : s) + 1]) * DM);
            u32x4 r0[4], r1[4];
#pragma unroll
            for (int q = 0; q < 4; ++q) { r0[q] = src0[F.lane + 64 * q]; r1[q] = src1[F.lane + 64 * q]; }
#pragma unroll
            for (int q = 0; q < 4; ++q) { dst0[F.lane + 64 * q] = r0[q]; dst1[F.lane + 64 * q] = r1[q]; }
        }
    }
    __syncthreads();
}
struct SchedMoe {
    const char* A; const char* Bt; int lda, ldb, nMt, nt, G, c;
    DI bool next(int i, Unit& u) const {
        const long L = (long)i * G + c; if (L >= (long)NEXP * nMt * 8) return false;
        const int e = (int)L / (nMt * 8), rem = (int)L % (nMt * 8), mt = rem % nMt, pn = rem / nMt;
        u.pm = e * 5 + mt; u.pn = pn; u.aux = e; u.nt = nt; u.pa = A + ((size_t)e * ESLOT + mt * 256) * lda; u.pb = Bt + ((size_t)e * 2048 + pn * 256) * ldb; return true;
    }
};
struct EpiMoe1 {
    bf16_t* ACT;
    DI void operator()(const f32x4 (&acc)[2][2][4][2], const Unit& u, int wr, int wc, int fr, int fq) const {
#pragma unroll
        for (int ai = 0; ai < 2; ++ai)
#pragma unroll
            for (int m = 0; m < 4; ++m) { const int row = u.pm * 256 + ai * 128 + wr * 64 + m * 16 + fr; const int col = u.pn * 128 + wc * 32 + 8 * fq;
                f32x4 r0, r1;
#pragma unroll
                for (int i = 0; i < 4; ++i) { r0[i] = siluf_(acc[ai][0][m][0][i]) * acc[ai][1][m][0][i]; r1[i] = siluf_(acc[ai][0][m][1][i]) * acc[ai][1][m][1][i]; }
                *(u32x4*)(ACT + (size_t)row * EFF + col) = pack8(r0, r1); }
    }
};
struct EpiMoe2 {
    const float* VALS; bf16_t* YE;
    DI void operator()(const f32x4 (&acc)[2][2][4][2], const Unit& u, int wr, int wc, int fr, int fq) const {
        EPI_FOREACH({ const float val = VALS[row]; *(u32x4*)(YE + (size_t)row * DM + col) = pack8(v0 * val, v1 * val); })
    }
};
DI void phase_final(const Frame& F, const Args& a) {
    const float* g = a.in[I_FNORM];
    for (int row = F.gw; row < MLAT; row += F.ngw) {
        f32x4 v[8]; float ss = 0.f;
        combine_row(F, DEPTH - 1, row, v);
#pragma unroll
        for (int j = 0; j < 8; ++j) ss += v[j].x * v[j].x + v[j].y * v[j].y + v[j].z * v[j].z + v[j].w * v[j].w;
        const float rs = rsqrtf(wave_sum(ss) * (1.f / DM) + EPS);
#pragma unroll
        for (int j = 0; j < 8; ++j) *(f32x4*)(a.out + (size_t)row * DM + 4 * F.lane + 256 * j) = v[j] * rs * *(const f32x4*)(g + 4 * F.lane + 256 * j);
    }
}

#ifndef MK_LAST_PHASE
#define MK_LAST_PHASE 1000
#endif
constexpr int PH_PER_LAYER = 12, N_PHASES = 2 + 2 * PH_PER_LAYER + 1;
__global__ void __launch_bounds__(NTHR, 2) mega(const Args args) {
    extern __shared__ __attribute__((aligned(16))) unsigned char lds[];
    Frame F0;
    F0.lds = (LAS unsigned char*)lds; F0.ws = args.ws;
    F0.tid = threadIdx.x; F0.lane = F0.tid & 63; F0.wave = __builtin_amdgcn_readfirstlane(F0.tid >> 6);
    F0.G = gridDim.x; { const int bx = blockIdx.x; F0.vcu = (F0.G % 8 == 0) ? (bx % 8) * (F0.G / 8) + bx / 8 : bx; }
    F0.gw = F0.vcu * NWAVES + F0.wave; F0.ngw = F0.G * NWAVES;
    volatile LAS unsigned* MISC = (volatile LAS unsigned*)(F0.lds + LDS_BYTES - 64);
    if (F0.tid < 16) MISC[F0.tid] = 0u;
    __syncthreads();
    unsigned* ctl = (unsigned*)(F0.ws + WS_CTL);
    XcdBarrier bar = xcd_barrier_post(ctl + CW_BAR, MISC + 8);
    const int lo = args.ph_lo, hi = args.ph_hi;
    int ph = 0, bid = 0;
#ifndef MK_EN
#define MK_EN 0xFFFF
#endif
#define EN(x) ((MK_EN >> (x)) & 1)
#ifndef MK_REP
#define MK_REP 0
#endif
#ifndef MK_BARX
#define MK_BARX 0
#endif
#define REP(pid_) ((MK_REP >> (pid_)) & 1)
#define PHASE(pid_, ...) if (EN(pid_) && lo <= ph && ph < hi) { Frame F = F0; { unsigned long long w_ = (unsigned long long)F0.ws; asm volatile("" : "+s"(w_)); F.ws = (unsigned char*)w_; \
        asm volatile("" : "+s"(F.G), "+s"(F.vcu)); F.ngw = F.G * NWAVES; bid = blockIdx.x; asm volatile("" : "+s"(bid)); \
        int t_ = threadIdx.x; asm volatile("" : "+v"(t_)); F.tid = t_; F.lane = t_ & 63; F.wave = __builtin_amdgcn_readfirstlane(t_ >> 6); F.gw = F.vcu * NWAVES + F.wave; } \
        { const int rep = 0; (void)rep; __VA_ARGS__ } if (REP(pid_)) { const int rep = 1; (void)rep; __VA_ARGS__ } \
        if (ph + 1 < hi) { xcd_barrier(bar); if (MK_BARX) xcd_barrier(bar); } } ++ph;

#define PHASE5(...) if (EN(5) && lo <= ph && ph < hi) { Frame F = F0; { unsigned long long w_ = (unsigned long long)F0.ws; asm volatile("" : "+s"(w_)); F.ws = (unsigned char*)w_; \
        asm volatile("" : "+s"(F.G), "+s"(F.vcu)); F.ngw = F.G * NWAVES; bid = blockIdx.x; asm volatile("" : "+s"(bid)); \
        int t_ = threadIdx.x; asm volatile("" : "+v"(t_)); F.tid = t_; F.lane = t_ & 63; F.wave = __builtin_amdgcn_readfirstlane(t_ >> 6); F.gw = F.vcu * NWAVES + F.wave; } \
        { __VA_ARGS__ } if (ph + 1 < hi) { xcd_barrier(bar); if (MK_BARX) xcd_barrier(bar); } } ++ph;
    PHASE(0, phase_prologue(F, args, rep);)
    PHASE(14, phase_mods_reduce(F, args);)
    for (int l = 0; l < DEPTH; ++l) {
        const size_t wlo = WS_W + (size_t)l * W_LAYER;
        const int nM = (l == 0) ? 36 : 32;
        PHASE(1, phase_mod1(F, args, l);)
        PHASE(2, {
            SchedProj S{(const char*)(F.ws + WS_H), (const char*)(F.ws + wlo + W_IN), l, F.G, bid};
            EpiProj E{(bf16_t*)(F.ws + WS_P), (float*)(F.ws + WS_X80)};
            pg8::gemm_phase(F.lds, DM * 2, DM * 2, S, E); })
        PHASE(3, phase_postproj(F, args, l);)
        PHASE(4, {
            { SchedDense S{(const char*)(F.ws + WS_CQN), (const char*)(F.ws + wlo + W_UQ), 512 * 2, 512 * 2, nM, 6, 8, F.G, bid};
              EpiStoreBf16 E{(bf16_t*)(F.ws + WS_QLA), 1536}; pg8::gemm_phase(F.lds, 512 * 2, 512 * 2, S, E); }
            { SchedDense S{(const char*)(F.ws + WS_CKVN), (const char*)(F.ws + wlo + W_UKV), 256 * 2, 256 * 2, 36, 8, 4, F.G, (bid + 128) % F.G};
              EpiStoreBf16 E{(bf16_t*)(F.ws + WS_KVLA), 2048}; pg8::gemm_phase(F.lds, 256 * 2, 256 * 2, S, E); } })
        PHASE5(phase_mixers(F, args, l, (char*)lds, 1 + REP(5)); phase_convert_tail(F, args, l);)
        PHASE(6, phase_mlfin(F, args, l, nM * 256);)
        PHASE(7, {
            SchedMerge S{(const char*)(F.ws + WS_YCAT), (const char*)(F.ws + wlo + W_BR), nM, F.G, bid};
            EpiMerge E{(const bf16_t*)(F.ws + WS_P), (bf16_t*)(F.ws + WS_MF32), (bf16_t*)(F.ws + WS_MBF)};
            pg8::gemm_phase(F.lds, 3072 * 2, 1024 * 2, S, E); })
        PHASE(8, {
            SchedDense S{(const char*)(F.ws + WS_MBF), (const char*)(F.ws + wlo + W_OUT), DM * 2, DM * 2, nM, 8, 32, F.G, bid};
            EpiOut E{args.in[I_X], args.in[I_CTX], (float*)(F.ws + WS_X1), (const float*)(F.ws + WS_MODS), l};
            if (rep == 0 || l == 0) pg8::gemm_phase(F.lds, DM * 2, DM * 2, S, E); })
        PHASE(9, phase_mod2(F, args, l, nM * 256);)
        PHASE(10, phase_topk(F, args, l, bid);)
        PHASE(11, {
            SchedMoe S{(const char*)(F.ws + WS_AG), (const char*)(F.ws + wlo + W_E13), DM * 2, DM * 2, (l == 0) ? 5 : 4, 32, F.G, bid};
            EpiMoe1 E{(bf16_t*)(F.ws + WS_ACT)};
            pg8::gemm_phase(F.lds, DM * 2, DM * 2, S, E); })
        PHASE(12, {
            SchedMoe S{(const char*)(F.ws + WS_ACT), (const char*)(F.ws + wlo + W_E2), EFF * 2, EFF * 2, (l == 0) ? 5 : 4, 16, F.G, bid};
            EpiMoe2 E{(const float*)(F.ws + WS_VALS), (bf16_t*)(F.ws + WS_YE)};
            pg8::gemm_phase(F.lds, EFF * 2, EFF * 2, S, E); })
    }
    PHASE(13, phase_final(F, args);)
#undef PHASE
}


extern "C" void kernel_launch(void* const* d_in, const int* in_sizes, int n_in, void* d_out, int out_size, void* d_ws, size_t ws_size, hipStream_t stream) {
    static int grid = 0;
    if (grid == 0) {
        if (n_in != 24 || out_size != MLAT * DM || ws_size < WS_END) { fprintf(stderr, "kernel_launch: unexpected shapes: n_in %d out %d ws %zu (need %zu)\n", n_in, out_size, ws_size, (size_t)WS_END); grid = -1; return; }
        int dev = 0, cus = 0, per_cu = 0;
        if (hipGetDevice(&dev) != hipSuccess || hipDeviceGetAttribute(&cus, hipDeviceAttributeMultiprocessorCount, dev) != hipSuccess) { grid = -1; return; }
        if (hipFuncSetAttribute((const void*)mega, hipFuncAttributeMaxDynamicSharedMemorySize, LDS_BYTES) != hipSuccess) { fprintf(stderr, "kernel_launch: hipFuncSetAttribute failed\n"); grid = -1; return; }
        if (hipOccupancyMaxActiveBlocksPerMultiprocessor(&per_cu, (const void*)mega, NTHR, LDS_BYTES) != hipSuccess || per_cu < 1) { fprintf(stderr, "kernel_launch: occupancy query says %d blocks per CU\n", per_cu); }
        (void)hipGetLastError();
        grid = cus;
    }
    if (grid < 0) return;
    if (hipMemsetAsync((char*)d_ws + WS_CTL, 0, CTL_BYTES, stream) != hipSuccess) return;
    Args a{};
    for (int i = 0; i < 24; ++i) a.in[i] = (const float*)d_in[i];
    a.out = (float*)d_out; a.ws = (unsigned char*)d_ws; a.ph_lo = 0; a.ph_hi = N_PHASES < MK_LAST_PHASE ? N_PHASES : MK_LAST_PHASE;
    hipLaunchKernelGGL(mega, dim3(grid), dim3(NTHR), LDS_BYTES, stream, a);
}
```

```cpp
#include <hip/hip_runtime.h>
#include <cstdio>
#include <cstdint>

#define GAS __attribute__((address_space(1)))
#define LAS __attribute__((address_space(3)))
#define DI __device__ __forceinline__
typedef unsigned short bf16_t;
typedef short bf16x8 __attribute__((ext_vector_type(8)));
typedef short s16x4 __attribute__((ext_vector_type(4)));
typedef float f32x2 __attribute__((ext_vector_type(2)));
typedef float f32x4 __attribute__((ext_vector_type(4)));
typedef float f32x8 __attribute__((ext_vector_type(8)));
typedef float f32x16 __attribute__((ext_vector_type(16)));
typedef unsigned u32x2 __attribute__((ext_vector_type(2)));
typedef unsigned u32x4 __attribute__((ext_vector_type(4)));

constexpr int DM = 2048, NBATCH = 4, SEQ = 2048, CTXL = 256, DEPTH = 2;
constexpr int MLAT = NBATCH * SEQ, MCTX = NBATCH * CTXL, MTOT = MLAT + MCTX;
constexpr int PROJW = 12624, NP = 12800;
constexpr int C_MLQ = 0, C_MLK = 1024, C_MLV = 2048, C_MLO = 3072, C_CQ = 4096, C_CKV = 4608, C_GQ = 4864, C_GK = 5888, C_GV = 6144, C_GATE = 6400, C_X = 12544;
constexpr int XW = 80;
constexpr int NEXP = 16, EFF = 1024, ESLOT = 1280;
constexpr float EPS = 1e-6f;
constexpr int NWAVES = 8, NTHR = 512;

constexpr size_t al256(size_t x) { return (x + 255) / 256 * 256; }
constexpr size_t WS_CTL = 0, CTL_BYTES = 2u << 20;
constexpr int CW_BAR = 1024;
constexpr int CW_QUEUE = 8192;
constexpr int CW_CVHEAD = 12288;
constexpr int CW_MCNT = 20480;
constexpr int CW_MLDONE = 28672;
constexpr int CW_PHDONE = 32768;
constexpr size_t WS_MODS = 1u << 20;
constexpr size_t WS_ROPE_LA = WS_CTL + CTL_BYTES;
constexpr size_t WS_ROPE_GA = WS_ROPE_LA + al256((size_t)2048 * 32 * 2 * 4);
constexpr size_t WS_W = WS_ROPE_GA + al256((size_t)2048 * 64 * 2 * 4);
constexpr size_t W_IN = 0, W_UQ = W_IN + (size_t)NP * DM * 2, W_UKV = W_UQ + (size_t)1536 * 512 * 2, W_BR = W_UKV + (size_t)2048 * 256 * 2,
                 W_OUT = W_BR + (size_t)3 * 2048 * 1024 * 2, W_E13 = W_OUT + (size_t)2048 * 2048 * 2, W_E2 = W_E13 + (size_t)NEXP * 2048 * 2048 * 2,
                 W_LAYER = W_E2 + (size_t)NEXP * 2048 * 1024 * 2;
constexpr size_t WS_H = WS_W + 2 * W_LAYER;
constexpr size_t WS_P = WS_H + (size_t)MTOT * DM * 2;
constexpr size_t WS_AG = WS_P;
constexpr size_t WS_ACT = WS_AG + (size_t)NEXP * ESLOT * DM * 2;
static_assert(WS_ACT + (size_t)NEXP * ESLOT * EFF * 2 <= WS_P + (size_t)MTOT * NP * 2, "overlay");
constexpr size_t WS_X80 = WS_P + (size_t)MTOT * NP * 2;
constexpr size_t WS_CQN = WS_X80 + al256((size_t)MTOT * XW * 4);
constexpr size_t WS_CKVN = WS_CQN + (size_t)MTOT * 512 * 2;
constexpr size_t WS_QG = WS_CKVN + (size_t)MTOT * 256 * 2;
constexpr size_t WS_KG = WS_QG + (size_t)MTOT * 1024 * 2;
constexpr size_t WS_KR = WS_KG + (size_t)MTOT * 256 * 2;
constexpr size_t WS_QLA = WS_KR + (size_t)MTOT * 64 * 2;
constexpr size_t WS_KVLA = WS_QLA + (size_t)MTOT * 1536 * 2;
constexpr size_t WS_YCAT = WS_KVLA + (size_t)MTOT * 2048 * 2;
constexpr size_t WS_MF32 = WS_YCAT + (size_t)MTOT * 3072 * 2;
constexpr size_t WS_MLH = WS_MF32;
constexpr size_t WS_MBF = WS_MF32 + (size_t)MTOT * DM * 4;
constexpr size_t WS_X1 = WS_MBF + (size_t)MTOT * DM * 2;
constexpr size_t WS_AFF = WS_X1 + (size_t)MTOT * DM * 4;
constexpr size_t WS_ROWS = WS_AFF + (size_t)MTOT * 16 * 4;
constexpr size_t WS_VALS = WS_ROWS + (size_t)NEXP * ESLOT * 4;
constexpr size_t WS_TOK = WS_VALS + (size_t)NEXP * ESLOT * 4;
constexpr size_t WS_MPART = WS_TOK + (size_t)MTOT * 16 * 4;
constexpr size_t WS_END = WS_MPART + (size_t)16 * 2 * 5 * 12288 * 4;
constexpr size_t WS_YE = WS_AG;

constexpr int RING_BYTES = 131072;
constexpr int MISC_OFF = RING_BYTES + 1024;
constexpr int LDS_BYTES = 147456;

DI float bf2f(unsigned short b) { return __uint_as_float(((unsigned)b) << 16); }
DI unsigned f2bf(float f) { unsigned u = __float_as_uint(f); return (u + 0x7fffu + ((u >> 16) & 1u)) >> 16; }
DI unsigned pk2(float lo, float hi) { unsigned r; asm volatile("v_cvt_pk_bf16_f32 %0, %1, %2" : "=v"(r) : "v"(lo), "v"(hi)); return r; }
DI int lane_id_() { int l = __builtin_amdgcn_mbcnt_hi(~0u, __builtin_amdgcn_mbcnt_lo(~0u, 0u)); asm volatile("" : "+v"(l)); return l; }
DI float bperm_f(float v, int srclane) { return __int_as_float(__builtin_amdgcn_ds_bpermute(srclane << 2, __float_as_int(v))); }
DI float shx(float v, int o) { return bperm_f(v, lane_id_() ^ o); }
DI float shl_(float v, int src) { return bperm_f(v, src); }
DI float shu(float v, int o) { const int l = lane_id_(); return bperm_f(v, l >= o ? l - o : l); }
DI float wave_sum(float v) { const int l = lane_id_();
#pragma unroll
    for (int o = 1; o < 64; o <<= 1) v += bperm_f(v, l ^ o);
    return v;
}
DI float wave_max(float v) { const int l = lane_id_();
#pragma unroll
    for (int o = 1; o < 64; o <<= 1) v = fmaxf(v, bperm_f(v, l ^ o));
    return v;
}
DI float sigmoidf_(float x) { return __builtin_amdgcn_rcpf(1.f + __expf(-x)); }
DI float siluf_(float x) { return x * __builtin_amdgcn_rcpf(1.f + __expf(-x)); }
#define LDS_WAIT() asm volatile("s_waitcnt lgkmcnt(0)" ::: "memory")
#define VM_WAIT() asm volatile("s_waitcnt vmcnt(0)" ::: "memory")

#define XB_TMO      128
#define XB_XCNT(j)  (256  + 64 * (j))
#define XB_XSUB(j)  (1280 + 64 * (j))
#define XB_XGEN(j)  (2304 + 64 * (j))
#define XB_TOP      3328
#define XB_TOPGEN   3392
#define XCD_BAR_WORDS 3456
#define XB_SPIN_CAP (1u << 20)

DI unsigned xb_ld(unsigned* p)              { return __hip_atomic_load(p, __ATOMIC_RELAXED, __HIP_MEMORY_SCOPE_AGENT); }
DI unsigned xb_add(unsigned* p, unsigned v) { return __hip_atomic_fetch_add(p, v, __ATOMIC_RELAXED, __HIP_MEMORY_SCOPE_AGENT); }
DI unsigned xb_xcc_id() { return (unsigned)__builtin_amdgcn_s_getreg((3 << 11) | 20) & 0xFu; }
#define XB_SPIN(cond, bar) do { unsigned _sp = 0; while (cond) { __builtin_amdgcn_s_sleep(1); \
    if ((++_sp & 255u) == 0u) { if (xb_ld(&(bar)[XB_TMO])) break; if (_sp > XB_SPIN_CAP) { atomicAdd(&(bar)[XB_TMO], 1u); break; } } } } while (0)

struct XcdBarrier { unsigned* bar; unsigned x; volatile LAS unsigned* st; };

DI XcdBarrier xcd_barrier_post(unsigned* bar, volatile LAS unsigned* st) {
    XcdBarrier b; b.bar = bar; b.x = xb_xcc_id(); b.st = st;
    if (threadIdx.x == 0) (void)xb_add(&bar[XB_XCNT(b.x)], 1u);
    return b;
}
DI void xcd_barrier_complete(unsigned* bar, unsigned x, unsigned& nloc, unsigned& nx) {
    const unsigned G = gridDim.x * gridDim.y * gridDim.z;
    unsigned sum, cnt, mine, sp = 0u;
    for (;;) {
        sum = 0u; cnt = 0u; mine = 0u;
#pragma unroll
        for (unsigned j = 0; j < 16; ++j) { const unsigned c = xb_ld(&bar[XB_XCNT(j)]); sum += c; cnt += (c > 0u) ? 1u : 0u; mine = (j == x) ? c : mine; }
        if (sum == G) break;
        __builtin_amdgcn_s_sleep(1);
        if ((++sp & 255u) == 0u) { if (xb_ld(&bar[XB_TMO])) break; if (sp > XB_SPIN_CAP) { atomicAdd(&bar[XB_TMO], 1u); break; } }
    }
    nloc = mine > 0u ? mine : 1u; nx = cnt > 0u ? cnt : 1u;
}
DI void xcd_barrier(const XcdBarrier& b) {
    asm volatile("s_waitcnt vmcnt(0)" ::: "memory");
    __syncthreads();
    if (threadIdx.x == 0) {
        unsigned* bar = b.bar; asm volatile("" : "+s"(bar));
        __builtin_amdgcn_s_waitcnt(0);
        unsigned nloc = b.st[0], nx = b.st[1];
        unsigned bx = b.x; asm volatile("" : "+s"(bx));
        if (nloc == 0u) { xcd_barrier_complete(bar, bx, nloc, nx); b.st[0] = nloc; b.st[1] = nx; }
        const unsigned old = xb_add(&bar[XB_XSUB(bx)], 1u);
        const unsigned gen = old / nloc;
        if (old + 1u == (gen + 1u) * nloc) {
            __builtin_amdgcn_fence(__ATOMIC_RELEASE, "agent");
            asm volatile("s_waitcnt vmcnt(0)" ::: "memory");
            const unsigned og = xb_add(&bar[XB_TOP], 1u);
            const unsigned tg = og / nx;
            if (og + 1u == (tg + 1u) * nx) xb_add(&bar[XB_TOPGEN], 1u);
            else XB_SPIN(xb_ld(&bar[XB_TOPGEN]) == tg, bar);
            __builtin_amdgcn_fence(__ATOMIC_ACQUIRE, "agent");
            xb_add(&bar[XB_XGEN(bx)], 1u);
            asm volatile("s_waitcnt vmcnt(0)" ::: "memory");
        } else {
            XB_SPIN(xb_ld(&bar[XB_XGEN(bx)]) == gen, bar);
            __builtin_amdgcn_fence(__ATOMIC_ACQUIRE, "agent");
            asm volatile("s_waitcnt vmcnt(0)" ::: "memory");
        }
    }
    __syncthreads();
}

struct Args { const float* in[24]; float* out; unsigned char* ws; int ph_lo, ph_hi; };
enum { I_X = 0, I_C, I_CTX, I_CCTX, I_WMOD, I_BMOD, I_WIN, I_GBIAS, I_MLNORM, I_LAQN, I_LAKVN, I_UQ, I_UKV, I_GAQN, I_GAKN, I_BRML, I_BRLA, I_BRGA, I_WOUT, I_WROUTER, I_WE1, I_WE3, I_WE2, I_FNORM };

struct Frame {
    LAS unsigned char* lds;
    unsigned char* ws;
    int tid, lane, wave, G, vcu, gw, ngw;
};

DI int mods_row(int row) { return row < MLAT ? (row >> 11) : 4; }
DI const float* mods_ptr(const Frame& F, int l, int row, int which  ) {
    return (const float*)(F.ws + WS_MODS) + ((size_t)(l * 5 + mods_row(row)) * 6 + which) * DM;
}

namespace pg8 {
constexpr int BM = 256, BK = 64, HALF = 128, HTB = HALF * BK * 2, STAGE_BYTES = 8 * HTB, NXCD = 8, WGM = 8;
__host__ __device__ __forceinline__ int lds_byte(int r, int c) { const int st = (r >> 4) * 2 + (c >> 5), rr = r & 15, cc = c & 31, ob = rr * 64 + cc * 2; return st * 1024 + (ob ^ (((ob >> 9) & 1) << 5)); }
__host__ __device__ __forceinline__ void stage_rc(int b, int& R, int& C) { const int st = b / 1024, sb = b % 1024, swz = sb ^ (((sb >> 9) & 1) << 5); R = (st >> 1) * 16 + swz / 64; C = (st & 1) * 32 + (swz % 64) / 2; }
__host__ __device__ __forceinline__ int perm32(int rho) { const int n = rho >> 4, i = rho & 15; return 8 * (i >> 2) + 4 * n + (i & 3); }

struct Unit { const char* pa; const char* pb; int pm, pn, aux, nt; };

DI void tile_of(int L, int nM, int nN, int& pm, int& pn) {
    const int nwg = nM * nN; int wgid = L;
    { const int q = nwg / NXCD, r = nwg % NXCD, xcd = wgid % NXCD, off = wgid / NXCD; wgid = (xcd < r ? xcd * (q + 1) : r * (q + 1) + (xcd - r) * q) + off; }
    const int nig = WGM * nN, gid = wgid / nig, fm = gid * WGM, gsz = (nM - fm) < WGM ? (nM - fm) : WGM;
    pm = fm + ((wgid % nig) % gsz); pn = (wgid % nig) / gsz;
}

template <bool GATHER = false, class Epi, class Sched>
DI void gemm_phase(LAS unsigned char* lds, const int lda  , const int ldb  , const Sched& S, const Epi& E, const int* rows = nullptr) {
    int tid = threadIdx.x; asm volatile("" : "+v"(tid));
    const int wid = __builtin_amdgcn_readfirstlane(tid >> 6), lane = tid & 63, wr = wid >> 2, wc = wid & 3, fr = lane & 15, fq = lane >> 4;
    unsigned vA0[2], vA1[2], nA0[2], nA1[2], voffB[2]; int sR[2], sC[2];
#pragma unroll
    for (int i = 0; i < 2; ++i) { int R, C; stage_rc(tid * 16 + i * 8192, R, C); const int Rb = (R & ~31) + perm32(R & 31); sR[i] = R; sC[i] = C;
        vA0[i] = (unsigned)(R * lda + C * 2); vA1[i] = (unsigned)((R + HALF) * lda + C * 2); nA0[i] = vA0[i]; nA1[i] = vA1[i]; voffB[i] = (unsigned)(Rb * ldb + C * 2); }
#define PG8_GATHER_OFFS(u_, d0, d1) do { if (GATHER) { _Pragma("unroll") for (int i = 0; i < 2; ++i) { const int r0_ = rows[(u_).pm * 256 + sR[i]], r1_ = rows[(u_).pm * 256 + HALF + sR[i]]; \
        d0[i] = (unsigned)((r0_ < 0 ? 0 : r0_) * lda + sC[i] * 2); d1[i] = (unsigned)((r1_ < 0 ? 0 : r1_) * lda + sC[i] * 2); } } } while (0)
    const size_t kstep = (size_t)(BK * 2);
    const size_t hstepB = (size_t)HALF * ldb;
    const unsigned ldsw = (unsigned)wid * 1024u;
    const int aoff = lds_byte(wr * 64 + fr, fq * 8), boff = lds_byte(wc * 32 + fr, fq * 8);
#define PG8_SA(b, h) (((b) * 2 + (h)) * HTB)
#define PG8_SB(b, h) ((4 + (b) * 2 + (h)) * HTB)
#define PG8_STAGE(bufoff, gbase, voff) do { _Pragma("unroll") for (int _i = 0; _i < 2; ++_i) \
        __builtin_amdgcn_global_load_lds((const unsigned*)((const char*)(gbase) + (voff)[_i]), (LAS unsigned*)(lds + (bufoff) + ldsw + _i * 8192), 16, 0, 0); } while (0)
#define PG8_LDA(dst, b, h) do { _Pragma("unroll") for (int m = 0; m < 4; ++m) _Pragma("unroll") for (int k = 0; k < 2; ++k) dst[m][k] = *(const LAS bf16x8*)(lds + PG8_SA(b, h) + aoff + m * 2048 + k * 1024); } while (0)
#define PG8_LDB(dst, b, h) do { _Pragma("unroll") for (int n = 0; n < 2; ++n) _Pragma("unroll") for (int k = 0; k < 2; ++k) dst[n][k] = *(const LAS bf16x8*)(lds + PG8_SB(b, h) + boff + n * 2048 + k * 1024); } while (0)
#define PG8_MMA(ai, bj, At, Bt) do { __builtin_amdgcn_s_setprio(1); _Pragma("unroll") for (int m = 0; m < 4; ++m) _Pragma("unroll") for (int n = 0; n < 2; ++n) _Pragma("unroll") for (int k = 0; k < 2; ++k) \
        acc[ai][bj][m][n] = __builtin_amdgcn_mfma_f32_16x16x32_bf16(Bt[n][k], At[m][k], acc[ai][bj][m][n], 0, 0, 0); __builtin_amdgcn_s_setprio(0); } while (0)
#define PG8_WAIT_V(n) asm volatile("s_waitcnt vmcnt(" #n ")" ::: "memory")
#define PG8_WAIT_L(n) asm volatile("s_waitcnt lgkmcnt(" #n ")" ::: "memory")
#define PG8_BAR __builtin_amdgcn_s_barrier()
#define PG8_SCHED __builtin_amdgcn_sched_barrier(0)
    Unit cur, nxt; int ui = 0;
    if (!S.next(0, cur)) return;
    f32x4 acc[2][2][4][2];
#pragma unroll
    for (int a = 0; a < 2; ++a)
#pragma unroll
        for (int b = 0; b < 2; ++b)
#pragma unroll
            for (int m = 0; m < 4; ++m)
#pragma unroll
                for (int n = 0; n < 2; ++n) acc[a][b][m][n] = (f32x4){0.f, 0.f, 0.f, 0.f};
    bf16x8 At[4][2], B0[2][2], B1[2][2];
    const char* cA = cur.pa; const char* cB = cur.pb;
    PG8_GATHER_OFFS(cur, vA0, vA1);
    PG8_STAGE(PG8_SB(0, 0), cB, voffB); PG8_STAGE(PG8_SA(0, 0), cA, vA0); PG8_STAGE(PG8_SB(0, 1), cB + hstepB, voffB); PG8_STAGE(PG8_SA(0, 1), cA, vA1);
    if (wr == 1) PG8_BAR;
    PG8_WAIT_V(4); PG8_BAR;
    PG8_STAGE(PG8_SB(1, 0), cB + kstep, voffB); PG8_STAGE(PG8_SA(1, 0), cA + kstep, vA0); PG8_STAGE(PG8_SB(1, 1), cB + hstepB + kstep, voffB);
    PG8_WAIT_V(6); PG8_BAR;
    for (;;) {
        const bool has_next = S.next(ui + 1, nxt);
        const char* nA = has_next ? nxt.pa : cA; const char* nB = has_next ? nxt.pb : cB;
        if (GATHER) { if (has_next) PG8_GATHER_OFFS(nxt, nA0, nA1); else { _Pragma("unroll") for (int i = 0; i < 2; ++i) { nA0[i] = vA0[i]; nA1[i] = vA1[i]; } } }
        const int nt = cur.nt;
        for (int t = 0; t < nt; t += 2) {
            const bool last = (t == nt - 2);
            const char* a1 = cA + (size_t)(t + 1) * kstep;
            const char* a2 = last ? nA : cA + (size_t)(t + 2) * kstep; const char* b2 = last ? nB : cB + (size_t)(t + 2) * kstep;
            const char* a3 = a2 + kstep; const char* b3 = b2 + kstep;
            unsigned wA0[2], wA1[2];
            _Pragma("unroll") for (int i = 0; i < 2; ++i) { wA0[i] = last ? nA0[i] : vA0[i]; wA1[i] = last ? nA1[i] : vA1[i]; }
            PG8_LDB(B0, 0, 0); PG8_SCHED; PG8_LDA(At, 0, 0); PG8_STAGE(PG8_SA(1, 1), a1, vA1);
            PG8_WAIT_L(8); PG8_BAR; PG8_WAIT_L(0); PG8_MMA(0, 0, At, B0); PG8_BAR; PG8_SCHED;
            PG8_LDB(B1, 0, 1); PG8_STAGE(PG8_SB(0, 0), b2, voffB);
            PG8_BAR; PG8_WAIT_L(0); PG8_MMA(0, 1, At, B1); PG8_BAR;
            PG8_LDA(At, 0, 1); PG8_STAGE(PG8_SA(0, 0), a2, wA0);
            PG8_BAR; PG8_WAIT_L(0); PG8_MMA(1, 0, At, B0); PG8_BAR; PG8_SCHED;
            PG8_STAGE(PG8_SB(0, 1), b2 + hstepB, voffB);
            PG8_WAIT_V(6); PG8_BAR; PG8_MMA(1, 1, At, B1); PG8_BAR;
            PG8_LDB(B0, 1, 0); PG8_SCHED; PG8_LDA(At, 1, 0); PG8_STAGE(PG8_SA(0, 1), a2, wA1);
            PG8_WAIT_L(8); PG8_BAR; PG8_WAIT_L(0); PG8_MMA(0, 0, At, B0); PG8_BAR; PG8_SCHED;
            PG8_LDB(B1, 1, 1); PG8_STAGE(PG8_SB(1, 0), b3, voffB);
            PG8_BAR; PG8_WAIT_L(0); PG8_MMA(0, 1, At, B1); PG8_BAR;
            PG8_LDA(At, 1, 1); PG8_STAGE(PG8_SA(1, 0), a3, wA0);
            PG8_BAR; PG8_WAIT_L(0); PG8_MMA(1, 0, At, B0); PG8_BAR; PG8_SCHED;
            PG8_STAGE(PG8_SB(1, 1), b3 + hstepB, voffB);
            PG8_WAIT_V(6); PG8_BAR; PG8_MMA(1, 1, At, B1); PG8_BAR;
        }
        E(acc, cur, wr, wc, fr, fq);
        if (!has_next) break;
#pragma unroll
        for (int a = 0; a < 2; ++a)
#pragma unroll
            for (int b = 0; b < 2; ++b)
#pragma unroll
                for (int m = 0; m < 4; ++m)
#pragma unroll
                    for (int n = 0; n < 2; ++n) acc[a][b][m][n] = (f32x4){0.f, 0.f, 0.f, 0.f};
        cur = nxt; cA = nA; cB = nB; ++ui;
        if (GATHER) { _Pragma("unroll") for (int i = 0; i < 2; ++i) { vA0[i] = nA0[i]; vA1[i] = nA1[i]; } }
    }
    PG8_WAIT_V(0);
    if (wr == 0) PG8_BAR;
    PG8_BAR;
#undef PG8_GATHER_OFFS
#undef PG8_SA
#undef PG8_SB
#undef PG8_STAGE
#undef PG8_LDA
#undef PG8_LDB
#undef PG8_MMA
#undef PG8_WAIT_V
#undef PG8_WAIT_L
#undef PG8_BAR
#undef PG8_SCHED
}
}
using pg8::Unit;

struct SchedDense {
    const char* A; const char* Bt; int lda, ldb, nM, nN, nt, G, c;
    DI bool next(int i, Unit& u) const {
        const long L = (long)i * G + c; if (L >= (long)nM * nN) return false;
        int pm, pn; pg8::tile_of((int)L, nM, nN, pm, pn);
        u.pm = pm; u.pn = pn; u.aux = 0; u.nt = nt; u.pa = A + (size_t)pm * 256 * lda; u.pb = Bt + (size_t)pn * 256 * ldb; return true;
    }
};

struct SchedProj {
    const char* A; const char* Bt; int l, G, c;
    DI bool next(int i, Unit& u) const {
        const long L = (long)i * G + c; int pm, pn;
        if (l == 0) { if (L >= 36 * 49) return false; pg8::tile_of((int)L, 36, 49, pm, pn); }
        else { if (L >= 32 * 49 + 44) return false;
            if (L < 32 * 49) pg8::tile_of((int)L, 32, 49, pm, pn);
            else { const int r = (int)L - 32 * 49, j = r % 11; pm = 32 + r / 11; pn = j < 8 ? 4 + j : (j == 8 ? 18 : (j == 9 ? 23 : 24)); } }
        u.pm = pm; u.pn = pn; u.aux = 0; u.nt = 32; u.pa = A + (size_t)pm * 256 * (DM * 2); u.pb = Bt + (size_t)pn * 256 * (DM * 2); return true;
    }
};

#define EPI_FOREACH(...) \
    _Pragma("unroll") for (int ai = 0; ai < 2; ++ai) _Pragma("unroll") for (int m = 0; m < 4; ++m) { const int row = u.pm * 256 + ai * 128 + wr * 64 + m * 16 + fr; \
    _Pragma("unroll") for (int bj = 0; bj < 2; ++bj) { const int col = u.pn * 256 + bj * 128 + wc * 32 + 8 * fq; const f32x4 v0 = acc[ai][bj][m][0], v1 = acc[ai][bj][m][1]; __VA_ARGS__ } }

DI u32x4 pack8(const f32x4 v0, const f32x4 v1) { u32x4 w; w.x = pk2(v0[0], v0[1]); w.y = pk2(v0[2], v0[3]); w.z = pk2(v1[0], v1[1]); w.w = pk2(v1[2], v1[3]); return w; }

struct EpiStoreBf16 {
    bf16_t* O; int ldc;
    DI void operator()(const f32x4 (&acc)[2][2][4][2], const Unit& u, int wr, int wc, int fr, int fq) const {
        EPI_FOREACH({ *(u32x4*)(O + (size_t)row * ldc + col) = pack8(v0, v1); })
    }
};
struct EpiProj {
    bf16_t* P;
    DI void operator()(const f32x4 (&acc)[2][2][4][2], const Unit& u, int wr, int wc, int fr, int fq) const {
        EPI_FOREACH({ *(u32x4*)(P + (size_t)row * NP + col) = pack8(v0, v1); })
    }
};
struct EpiX {
    bf16_t* KR; float* X80; const float* rla;
    DI void operator()(const f32x4 (&acc)[2][2][4][2], const Unit& u, int wr, int wc, int fr, int fq) const {
#pragma unroll
        for (int ai = 0; ai < 2; ++ai)
#pragma unroll
            for (int m = 0; m < 4; ++m) { const int row = u.pm * 256 + ai * 128 + wr * 64 + m * 16 + fr; const bool lat = row < MLAT; const int t = row & 2047;
#pragma unroll
                for (int n = 0; n < 2; ++n) { const f32x4 v = acc[ai][0][m][n];
                    f32x4 pr; pr.x = shx(v.x, 32); pr.y = shx(v.y, 32); pr.z = shx(v.z, 32); pr.w = shx(v.w, 32);
                    if (wc < 2) {
                        const int idx = 8 * (fq & 1) + 4 * n; f32x4 o = v;
                        if (lat) { const float* cs = rla + ((size_t)t * 32 + wc * 16 + idx) * 2; const f32x4 c0 = *(const f32x4*)cs, c1 = *(const f32x4*)(cs + 4);
                            if (fq < 2) { o.x = v.x * c0.x - pr.x * c0.y; o.y = v.y * c0.z - pr.y * c0.w; o.z = v.z * c1.x - pr.z * c1.y; o.w = v.w * c1.z - pr.w * c1.w; }
                            else        { o.x = pr.x * c0.y + v.x * c0.x; o.y = pr.y * c0.w + v.y * c0.z; o.z = pr.z * c1.y + v.z * c1.x; o.w = pr.w * c1.w + v.w * c1.z; } }
                        u32x2 w2; w2.x = pk2(o.x, o.y); w2.y = pk2(o.z, o.w);
                        *(u32x2*)(KR + (size_t)row * 64 + 32 * wc + 8 * fq + 4 * n) = w2;
                    } else if (wc == 2 && fq < 2) *(f32x4*)(X80 + (size_t)row * XW + 64 + 8 * fq + 4 * n) = v;
                } }
    }
};

DI int win_src_col(int n) {
    if (n < 4096) return n;
    if (n < 4608) return n - 4096 + 4112;
    if (n < 4864) return n - 4608 + 4624;
    if (n < 5888) return n - 4864 + 4944;
    if (n < 6144) return n - 5888 + 5968;
    if (n < 6400) return n - 6144 + 6224;
    if (n < 12544) return n - 6400 + 6480;
    if (n < 12608) return n - 12544 + 4880;
    if (n < 12624) return n - 12608 + 4096;
    return -1;
}
DI void transpose_item(const float* W, int ldw, int K, bf16_t* WT, int k0, int n0, int srcc, LAS float* scr, int lane) {
#pragma unroll 8
    for (int i = 0; i < 32; ++i) { const int kk = 2 * i + (lane >> 5); scr[kk * 33 + (lane & 31)] = srcc >= 0 ? W[(size_t)(k0 + kk) * ldw + srcc] : 0.f; }
    LDS_WAIT(); asm volatile("" ::: "memory");
    const int c = lane & 7;
#pragma unroll
    for (int j = 0; j < 4; ++j) { const int n = (lane >> 3) + 8 * j; const LAS float* s = scr + (8 * c) * 33 + n;
        u32x4 o; o.x = pk2(s[0 * 33], s[1 * 33]); o.y = pk2(s[2 * 33], s[3 * 33]); o.z = pk2(s[4 * 33], s[5 * 33]); o.w = pk2(s[6 * 33], s[7 * 33]);
        *(u32x4*)(WT + (size_t)(n0 + n) * K + k0 + 8 * c) = o; }
    LDS_WAIT(); asm volatile("" ::: "memory");
}

constexpr int IT_IN = 32 * 400, IT_UQ = 8 * 48, IT_UKV = 4 * 64, IT_BR = 16 * 64, IT_OUT = 32 * 64, IT_E13 = 32 * 64, IT_E2 = 16 * 64;
constexpr int IT_EARLY = IT_IN + IT_UQ + IT_UKV, IT_LAYER = IT_EARLY + 3 * IT_BR + IT_OUT + NEXP * IT_E13 + NEXP * IT_E2;
struct CvDesc { const float* src; size_t ld2; bf16_t* dst; int K; };
DI CvDesc cv_make(const float* W, int ldw, int K, bf16_t* WT, int k0, int n0, int srcc, int lane) {
    CvDesc d; d.src = srcc >= 0 ? W + (size_t)(k0 + (lane >> 5)) * ldw + srcc : nullptr; d.ld2 = 2 * (size_t)ldw; d.dst = WT + (size_t)n0 * K + k0; d.K = K; return d; }
DI CvDesc cv_desc(const Frame& F, const Args& a, int l, int r) {
    unsigned char* wl = F.ws + WS_W + (size_t)l * W_LAYER;
    const int lane = F.lane, ln = lane & 31;
    if (r < IT_IN) { const int kb = r / 400, nb = r % 400; return cv_make(a.in[I_WIN] + (size_t)l * DM * PROJW, PROJW, DM, (bf16_t*)(wl + W_IN), 64 * kb, 32 * nb, win_src_col(32 * nb + ln), lane); } r -= IT_IN;
    if (r < IT_UQ) { const int kb = r / 48, nb = r % 48; return cv_make(a.in[I_UQ] + (size_t)l * 512 * 1536, 1536, 512, (bf16_t*)(wl + W_UQ), 64 * kb, 32 * nb, 32 * nb + ln, lane); } r -= IT_UQ;
    if (r < IT_UKV) { const int kb = r / 64, nb = r % 64; return cv_make(a.in[I_UKV] + (size_t)l * 256 * 2048, 2048, 256, (bf16_t*)(wl + W_UKV), 64 * kb, 32 * nb, 32 * nb + ln, lane); } r -= IT_UKV;
    if (r < 3 * IT_BR) { const int br = r / IT_BR, q = r % IT_BR, kb = q / 64, nb = q % 64;
        return cv_make(a.in[I_BRML + br] + (size_t)l * 1024 * 2048, 2048, 1024, (bf16_t*)(wl + W_BR) + (size_t)br * 2048 * 1024, 64 * kb, 32 * nb, 32 * nb + ln, lane); } r -= 3 * IT_BR;
    if (r < IT_OUT) { const int kb = r / 64, nb = r % 64; return cv_make(a.in[I_WOUT] + (size_t)l * 2048 * 2048, 2048, 2048, (bf16_t*)(wl + W_OUT), 64 * kb, 32 * nb, 32 * nb + ln, lane); } r -= IT_OUT;
    if (r < NEXP * IT_E13) { const int e = r / IT_E13, q = r % IT_E13, kb = q / 64, nb = q % 64;
        const int n0 = 32 * nb, j = n0 >> 8, half = (n0 >> 7) & 1, cc = n0 & 127;
        return cv_make(a.in[half ? I_WE3 : I_WE1] + ((size_t)l * NEXP + e) * 2048 * 1024, 1024, 2048, (bf16_t*)(wl + W_E13) + (size_t)e * 2048 * 2048, 64 * kb, n0, j * 128 + cc + ln, lane); } r -= NEXP * IT_E13;
    { const int e = r / IT_E2, q = r % IT_E2, kb = q / 64, nb = q % 64;
        return cv_make(a.in[I_WE2] + ((size_t)l * NEXP + e) * 1024 * 2048, 2048, 1024, (bf16_t*)(wl + W_E2) + (size_t)e * 2048 * 1024, 64 * kb, 32 * nb, 32 * nb + ln, lane); }
}
DI void cv_load(const CvDesc& d, float (&v)[32]) {
#pragma unroll
    for (int i = 0; i < 32; ++i) v[i] = d.src ? __builtin_nontemporal_load(d.src + (size_t)i * d.ld2) : 0.f;
}
DI void cv_store(const CvDesc& d, const float (&v)[32], LAS float* scr, int lane) {
#pragma unroll
    for (int i = 0; i < 32; ++i) scr[(2 * i + (lane >> 5)) * 33 + (lane & 31)] = v[i];
    LDS_WAIT(); asm volatile("" ::: "memory");
    const int c = lane & 7;
#pragma unroll
    for (int j = 0; j < 4; ++j) { const int n = (lane >> 3) + 8 * j; const LAS float* s = scr + (8 * c) * 33 + n;
        u32x4 o; o.x = pk2(s[0 * 33], s[1 * 33]); o.y = pk2(s[2 * 33], s[3 * 33]); o.z = pk2(s[4 * 33], s[5 * 33]); o.w = pk2(s[6 * 33], s[7 * 33]);
        *(u32x4*)(d.dst + (size_t)n * d.K + 8 * c) = o; }
    LDS_WAIT(); asm volatile("" ::: "memory");
}
DI void convert_range(const Frame& F, const Args& a, int first, int stride, int n_items, LAS float* scr) {
    int it = first; if (it >= n_items) return;
    CvDesc cur = cv_desc(F, a, it / IT_LAYER, it % IT_LAYER); float v[32]; cv_load(cur, v);
    for (;;) {
        const int nx = it + stride; const bool hn = nx < n_items; const int pn = hn ? nx : it;
        const CvDesc nd = cv_desc(F, a, pn / IT_LAYER, pn % IT_LAYER); float wv[32]; cv_load(nd, wv);
        cv_store(cur, v, scr, F.lane);
        if (!hn) break;
        cur = nd; it = nx;
#pragma unroll
        for (int i = 0; i < 32; ++i) v[i] = wv[i];
    }
}
DI void convert_item(const Frame& F, const Args& a, int l, int r, LAS float* scr) {
    const CvDesc d = cv_desc(F, a, l, r); float v[32]; cv_load(d, v); cv_store(d, v, scr, F.lane);
}

DI void phase_prologue(const Frame& F, const Args& a, int rep) {
    LAS float* scr = (LAS float*)(F.lds + F.wave * 16384);
    if (rep == 0) {
        const float* c = a.in[I_C]; const float* cctx = a.in[I_CCTX]; const float* wmod = a.in[I_WMOD];
        constexpr int NIT = 2 * 48 * 16;
        for (int it = F.gw; it < NIT; it += F.ngw) {
            const int l = it / 768, rem = it % 768, cb = rem / 16, kp = rem % 16, k0 = kp * 128, j0 = cb * 256 + F.lane * 4;
#pragma unroll
            for (int i = 0; i < 10; ++i) { const int idx = F.lane + 64 * i, r = idx >> 7, kk = idx & 127; const float v = r < 4 ? c[r * DM + k0 + kk] : cctx[k0 + kk]; scr[idx] = siluf_(v); }
            LDS_WAIT(); asm volatile("" ::: "memory");
            f32x4 acc[5];
#pragma unroll
            for (int r = 0; r < 5; ++r) acc[r] = (f32x4){0.f, 0.f, 0.f, 0.f};
            const float* wp = wmod + ((size_t)l * DM + k0) * (6 * DM) + j0;
#pragma unroll 8
            for (int kk = 0; kk < 128; ++kk) { const f32x4 w = __builtin_nontemporal_load((const f32x4*)(wp + (size_t)kk * (6 * DM)));
#pragma unroll
                for (int r = 0; r < 5; ++r) acc[r] += w * scr[r * 128 + kk]; }
#pragma unroll
            for (int r = 0; r < 5; ++r) *(f32x4*)((float*)(F.ws + WS_MPART) + ((size_t)(kp * 2 + l) * 5 + r) * (6 * DM) + j0) = acc[r];
            LDS_WAIT(); asm volatile("" ::: "memory");
        }
    }
    {
        float* rla = (float*)(F.ws + WS_ROPE_LA); float* rga = (float*)(F.ws + WS_ROPE_GA);
        const int gt = F.gw * 64 + F.lane, ngt = F.ngw * 64;
        for (int i = gt; i < 2048 * 32; i += ngt) { const int t = i >> 5, aidx = i & 31, ax = aidx >> 4, fi = aidx & 15;
            const float inv = exp2f(-(float)fi * (13.287712379549449f / 16.f)); const float ang = (float)(ax ? (t & 63) : (t >> 6)) * inv;
            rla[2 * i] = cosf(ang); rla[2 * i + 1] = sinf(ang); }
        for (int i = gt; i < 2048 * 64; i += ngt) { const int t = i >> 6, aidx = i & 63, ax = aidx >> 5, fi = aidx & 31;
            const float inv = exp2f(-(float)fi * (13.287712379549449f / 32.f)); const float ang = (float)(ax ? (t & 63) : (t >> 6)) * inv;
            rga[2 * i] = cosf(ang); rga[2 * i + 1] = sinf(ang); }
    }
#ifndef MK_CONVTAIL
#define MK_CONVTAIL 0
#endif
#ifndef MK_FILL
#define MK_FILL 0
#endif
#ifndef MK_CVSIDE
#define MK_CVSIDE 2
#endif
#ifndef MK_CVFROM
#define MK_CVFROM IT_EARLY
#endif
    if (MK_CONVTAIL) { for (int it = F.gw; it < IT_EARLY; it += F.ngw) convert_item(F, a, 0, it, scr); }
    else convert_range(F, a, F.gw, F.ngw, MK_CVSIDE ? MK_CVFROM : (MK_FILL ? IT_LAYER : 2 * IT_LAYER), scr);
}

DI void phase_mods_reduce(const Frame& F, const Args& a) {
    float* mods = (float*)(F.ws + WS_MODS); const float* part = (const float*)(F.ws + WS_MPART); const float* bmod = a.in[I_BMOD];
    const int gt = F.gw * 64 + F.lane, ngt = F.ngw * 64;
    for (int i = gt; i < 2 * 5 * 12288 / 4; i += ngt) { const int l = i / (5 * 3072), j4 = i % 3072;
        f32x4 s = *(const f32x4*)(bmod + (size_t)l * 12288 + 4 * j4);
#pragma unroll
        for (int kp = 0; kp < 16; ++kp) s += *(const f32x4*)(part + (size_t)kp * (2 * 5 * 12288) + 4 * (size_t)i);
        *(f32x4*)(mods + 4 * (size_t)i) = s; }
}

DI const float* resid_row(const Frame& F, const Args& a, int l, int row) {
    if (l == 0) return row < MLAT ? a.in[I_X] + (size_t)row * DM : a.in[I_CTX] + (size_t)(row - MLAT) * DM;
    return (const float*)(F.ws + WS_X1) + (size_t)row * DM;
}
DI void load_row(const float* p, int lane, f32x4 (&v)[8]) {
#pragma unroll
    for (int j = 0; j < 8; ++j) v[j] = *(const f32x4*)(p + 4 * lane + 256 * j);
}
template <bool G2LDS = false>
DI void combine_row(const Frame& F, int lp, int row, const f32x4 (&x)[8], int tokv, f32x4 (&v)[8], const LAS float* g2l = nullptr) {
    const bf16_t* YE = (const bf16_t*)(F.ws + WS_YE);
    f32x4 s[8];
#pragma unroll
    for (int j = 0; j < 8; ++j) s[j] = (f32x4){0.f, 0.f, 0.f, 0.f};
    unsigned mask = (unsigned)__ballot(tokv >= 0) & 0xffffu;
    while (mask) {
        const int e0 = __builtin_ctz(mask); mask &= mask - 1u; const bool two = mask != 0u; const int e1 = two ? __builtin_ctz(mask) : e0; mask &= mask - 1u;
        const int slot0 = __builtin_amdgcn_readlane(tokv, e0), slot1 = __builtin_amdgcn_readlane(tokv, e1);
        const bf16_t* y0r = YE + ((size_t)e0 * ESLOT + slot0) * DM; const bf16_t* y1r = YE + ((size_t)e1 * ESLOT + slot1) * DM;
        s16x4 y0[8], y1[8];
#pragma unroll
        for (int j = 0; j < 8; ++j) { y0[j] = *(const s16x4*)(y0r + 4 * F.lane + 256 * j); y1[j] = *(const s16x4*)(y1r + 4 * F.lane + 256 * j); }
#pragma unroll
        for (int j = 0; j < 8; ++j) s[j] += (f32x4){bf2f((unsigned short)y0[j][0]), bf2f((unsigned short)y0[j][1]), bf2f((unsigned short)y0[j][2]), bf2f((unsigned short)y0[j][3])};
        if (two) {
#pragma unroll
            for (int j = 0; j < 8; ++j) s[j] += (f32x4){bf2f((unsigned short)y1[j][0]), bf2f((unsigned short)y1[j][1]), bf2f((unsigned short)y1[j][2]), bf2f((unsigned short)y1[j][3])}; }
    }
    if (G2LDS) {
#pragma unroll
        for (int j = 0; j < 8; ++j) v[j] = x[j] + s[j] * *(const LAS f32x4*)(g2l + 4 * F.lane + 256 * j); }
    else { const float* g2 = mods_ptr(F, lp, row, 5);
#pragma unroll
        for (int j = 0; j < 8; ++j) v[j] = x[j] + s[j] * *(const f32x4*)(g2 + 4 * F.lane + 256 * j); }
}
DI void modulate_vals(const Frame& F, const f32x4 (&v)[8], const float* sh, const float* sc, bf16_t* hrow, f32x4 (&hv)[8]) {
    float ss = 0.f;
#pragma unroll
    for (int j = 0; j < 8; ++j) ss += v[j].x * v[j].x + v[j].y * v[j].y + v[j].z * v[j].z + v[j].w * v[j].w;
    const float rs = rsqrtf(wave_sum(ss) * (1.f / DM) + EPS);
#pragma unroll
    for (int j = 0; j < 8; ++j) { const f32x4 s1 = *(const f32x4*)(sc + 4 * F.lane + 256 * j), s0 = *(const f32x4*)(sh + 4 * F.lane + 256 * j);
        const f32x4 h = v[j] * rs * (s1 + 1.f) + s0; hv[j] = h;
        u32x2 w; w.x = pk2(h.x, h.y); w.y = pk2(h.z, h.w); *(u32x2*)(hrow + 4 * F.lane + 256 * j) = w; }
}
DI void phase_mod1(const Frame& F, const Args& a, int l) {
    bf16_t* H = (bf16_t*)(F.ws + WS_H); const int* TOK = (const int*)(F.ws + WS_TOK);
    LAS float* ms = (LAS float*)F.lds;
    { const float* MODS = (const float*)(F.ws + WS_MODS);
      for (int i = F.tid; i < 5 * 3 * 512; i += NTHR) { const int r = i / 1536, w = (i / 512) % 3, c4 = i % 512;
          if (w == 2 && l == 0) continue;
          const int ll = w == 2 ? l - 1 : l, which = w == 2 ? 5 : w;
          f32x4 val = *(const f32x4*)(MODS + ((size_t)(ll * 5 + r) * 6 + which) * DM + 4 * c4); if (w == 1) val += 1.f;
          *(LAS f32x4*)(ms + (size_t)(r * 3 + w) * DM + 4 * c4) = val; }
      __syncthreads(); }
    int row = F.gw; if (row >= MTOT) return;
    f32x4 cur[8]; int tcur = 0;
    load_row(resid_row(F, a, l, row), F.lane, cur); if (l > 0) tcur = TOK[(size_t)row * 16 + (F.lane & 15)];
    for (;;) {
        const int nrow = row + F.ngw; const bool hn = nrow < MTOT; const int pr = hn ? nrow : row;
        f32x4 nxt[8]; int tnxt = 0;
        load_row(resid_row(F, a, l, pr), F.lane, nxt); if (l > 0) tnxt = TOK[(size_t)pr * 16 + (F.lane & 15)];
        f32x4 v[8];
        if (l == 0) {
#pragma unroll
            for (int j = 0; j < 8; ++j) v[j] = cur[j]; }
        const LAS float* mr = ms + (size_t)mods_row(row) * 3 * DM;
        if (l != 0) { combine_row<true>(F, l - 1, row, cur, tcur, v, mr + 2 * DM); float* xw = (float*)(F.ws + WS_X1) + (size_t)row * DM;
#pragma unroll
            for (int j = 0; j < 8; ++j) *(f32x4*)(xw + 4 * F.lane + 256 * j) = v[j]; }
        { float ss = 0.f;
#pragma unroll
          for (int j = 0; j < 8; ++j) ss += v[j].x * v[j].x + v[j].y * v[j].y + v[j].z * v[j].z + v[j].w * v[j].w;
          const float rs = rsqrtf(wave_sum(ss) * (1.f / DM) + EPS);
          bf16_t* hrow = H + (size_t)row * DM;
#pragma unroll
          for (int j = 0; j < 8; ++j) { const f32x4 h = v[j] * rs * *(const LAS f32x4*)(mr + DM + 4 * F.lane + 256 * j) + *(const LAS f32x4*)(mr + 4 * F.lane + 256 * j);
              u32x2 w; w.x = pk2(h.x, h.y); w.y = pk2(h.z, h.w); *(u32x2*)(hrow + 4 * F.lane + 256 * j) = w; } }
        if (!hn) break;
#pragma unroll
        for (int j = 0; j < 8; ++j) cur[j] = nxt[j];
        tcur = tnxt; row = nrow;
    }
}
DI void phase_mod2(const Frame& F, const Args& a, int l, int nrows) {
    bf16_t* H = (bf16_t*)(F.ws + WS_H); float* AFF = (float*)(F.ws + WS_AFF);
    LAS float* wr = (LAS float*)F.lds;
    const float* wsrc = a.in[I_WROUTER] + (size_t)l * DM * NEXP;
    for (int i = F.tid; i < DM * NEXP / 4; i += NTHR) { const f32x4 w4 = ((const f32x4*)wsrc)[i]; const int c = i >> 2, e0 = (i & 3) * 4;
        wr[(e0 + 0) * DM + c] = w4.x; wr[(e0 + 1) * DM + c] = w4.y; wr[(e0 + 2) * DM + c] = w4.z; wr[(e0 + 3) * DM + c] = w4.w; }
    __syncthreads();
    const float* X1 = (const float*)(F.ws + WS_X1);
    auto router = [&](const f32x4 (&hv)[8], int row) {
        float lg[16];
#pragma unroll
        for (int e = 0; e < 16; ++e) lg[e] = 0.f;
#pragma unroll
        for (int j = 0; j < 8; ++j)
#pragma unroll
            for (int e = 0; e < 16; ++e) { const f32x4 w = *(const LAS f32x4*)(wr + e * DM + 4 * F.lane + 256 * j); lg[e] += hv[j].x * w.x + hv[j].y * w.y + hv[j].z * w.z + hv[j].w * w.w; }
        float mx = -1e30f;
#pragma unroll
        for (int e = 0; e < 16; ++e) { lg[e] = wave_sum(lg[e]); mx = fmaxf(mx, lg[e]); }
        float den = 0.f;
#pragma unroll
        for (int e = 0; e < 16; ++e) { lg[e] = __expf(lg[e] - mx); den += lg[e]; }
        const float inv = 1.f / den;
        float mine = 0.f;
#pragma unroll
        for (int e = 0; e < 16; ++e) mine = (F.lane == e) ? lg[e] * inv : mine;
        if (F.lane < 16) AFF[(size_t)F.lane * MTOT + row] = mine;
    };
    const int crow = MLAT + F.gw; const bool hasc = crow < nrows;
    f32x4 cur[8];
    for (int base = 4 * F.gw; base < MLAT; base += 4 * F.ngw) {
        load_row(X1 + (size_t)base * DM, F.lane, cur);
        f32x4 s1[8], s0[8];
        { const float* sh = mods_ptr(F, l, base, 3); const float* sc = mods_ptr(F, l, base, 4);
#pragma unroll
          for (int j = 0; j < 8; ++j) { s1[j] = *(const f32x4*)(sc + 4 * F.lane + 256 * j) + 1.f; s0[j] = *(const f32x4*)(sh + 4 * F.lane + 256 * j); } }
#pragma unroll 1
        for (int k = 0; k < 4; ++k) { const int row = base + k; f32x4 hv[8];
            { const int pr = k < 3 ? row + 1 : (hasc ? crow : row); f32x4 nxt[8]; load_row(X1 + (size_t)pr * DM, F.lane, nxt);
              float ss = 0.f;
#pragma unroll
              for (int j = 0; j < 8; ++j) ss += cur[j].x * cur[j].x + cur[j].y * cur[j].y + cur[j].z * cur[j].z + cur[j].w * cur[j].w;
              const float rs = rsqrtf(wave_sum(ss) * (1.f / DM) + EPS);
              bf16_t* hrow = H + (size_t)row * DM;
#pragma unroll
              for (int j = 0; j < 8; ++j) { const f32x4 h = cur[j] * rs * s1[j] + s0[j]; hv[j] = h;
                  u32x2 w; w.x = pk2(h.x, h.y); w.y = pk2(h.z, h.w); *(u32x2*)(hrow + 4 * F.lane + 256 * j) = w; }
#pragma unroll
              for (int j = 0; j < 8; ++j) cur[j] = nxt[j]; }
            router(hv, row);
        }
    }
    if (hasc) {
        if (4 * F.gw >= MLAT) load_row(X1 + (size_t)crow * DM, F.lane, cur);
        for (int row = crow; row < nrows; row += F.ngw) { f32x4 hv[8];
            modulate_vals(F, cur, mods_ptr(F, l, row, 3), mods_ptr(F, l, row, 4), H + (size_t)row * DM, hv);
            router(hv, row);
            if (row + F.ngw < nrows) load_row(X1 + (size_t)(row + F.ngw) * DM, F.lane, cur); }
    }
    __syncthreads();
}

DI void phase_postproj(const Frame& F, const Args& a, int l) {
    const bf16_t* P = (const bf16_t*)(F.ws + WS_P);
    bf16_t* CQN = (bf16_t*)(F.ws + WS_CQN); bf16_t* CKVN = (bf16_t*)(F.ws + WS_CKVN); bf16_t* QG = (bf16_t*)(F.ws + WS_QG); bf16_t* KG = (bf16_t*)(F.ws + WS_KG);
    const float* qn = a.in[I_LAQN] + l * 512; const float* kvn = a.in[I_LAKVN] + l * 256; const float* gqn = a.in[I_GAQN] + l * 128; const float* gkn = a.in[I_GAKN] + l * 128;
    const float* rga = (const float*)(F.ws + WS_ROPE_GA);
    const int lane = F.lane;
    const f32x4 qg0 = *(const f32x4*)(qn + 8 * lane), qg1 = *(const f32x4*)(qn + 8 * lane + 4), kg0 = *(const f32x4*)(kvn + 4 * lane);
    const int hq = lane >> 4, ax = (lane >> 3) & 1, seg = lane & 7, eo = ax * 64 + 4 * seg;
    const f32x4 gqa = *(const f32x4*)(gqn + eo), gqb = *(const f32x4*)(gqn + eo + 32), gka = *(const f32x4*)(gkn + eo), gkb = *(const f32x4*)(gkn + eo + 32);
    struct Raw { bf16x8 xq; s16x4 xkv; s16x4 ha[3], hb[3]; f32x4 r0, r1; };
    auto load = [&](int row, Raw& R) { const bf16_t* pr = P + (size_t)row * NP; const int t = row & 2047;
        R.xq = *(const bf16x8*)(pr + C_CQ + 8 * lane); R.xkv = *(const s16x4*)(pr + C_CKV + 4 * lane);
#pragma unroll
        for (int p = 0; p < 3; ++p) { const int hh = p < 2 ? 4 * p + hq : 8 + (hq & 1); const bf16_t* src = pr + C_GQ + hh * 128;
            R.ha[p] = *(const s16x4*)(src + eo); R.hb[p] = *(const s16x4*)(src + eo + 32); }
        const float* rp = rga + ((size_t)t * 64 + ax * 32 + 4 * seg) * 2; R.r0 = *(const f32x4*)rp; R.r1 = *(const f32x4*)(rp + 4); };
    static_assert(C_GK == C_GQ + 8 * 128, "q and k heads contiguous");
    int row = F.gw; if (row >= MTOT) return;
    Raw cur; load(row, cur);
    for (;;) {
        const int nrow = row + F.ngw; const bool hn = nrow < MTOT; Raw nxt; load(hn ? nrow : row, nxt);
        const bool lat = row < MLAT; const bool needq = lat || l == 0;
        if (needq) {
            float f[8]; float ss = 0.f;
#pragma unroll
            for (int i = 0; i < 8; ++i) { f[i] = bf2f((unsigned short)cur.xq[i]); ss += f[i] * f[i]; }
            const float rs = rsqrtf(wave_sum(ss) * (1.f / 512.f) + EPS);
            u32x4 w; w.x = pk2(f[0] * rs * qg0.x, f[1] * rs * qg0.y); w.y = pk2(f[2] * rs * qg0.z, f[3] * rs * qg0.w); w.z = pk2(f[4] * rs * qg1.x, f[5] * rs * qg1.y); w.w = pk2(f[6] * rs * qg1.z, f[7] * rs * qg1.w);
            *(u32x4*)(CQN + (size_t)row * 512 + 8 * lane) = w;
        }
        {
            float f[4]; float ss = 0.f;
#pragma unroll
            for (int i = 0; i < 4; ++i) { f[i] = bf2f((unsigned short)cur.xkv[i]); ss += f[i] * f[i]; }
            const float rs = rsqrtf(wave_sum(ss) * (1.f / 256.f) + EPS);
            u32x2 w; w.x = pk2(f[0] * rs * kg0.x, f[1] * rs * kg0.y); w.y = pk2(f[2] * rs * kg0.z, f[3] * rs * kg0.w);
            *(u32x2*)(CKVN + (size_t)row * 256 + 4 * lane) = w;
        }
        const float cs[4] = {cur.r0.x, cur.r0.z, cur.r1.x, cur.r1.z}, sn[4] = {cur.r0.y, cur.r0.w, cur.r1.y, cur.r1.w};
        const int ln = lane_id_();
#pragma unroll
        for (int p = 0; p < 3; ++p) {
            if (p < 2 && !needq) continue;
            float xa[4], xb[4]; float ss = 0.f;
#pragma unroll
            for (int i = 0; i < 4; ++i) { xa[i] = bf2f((unsigned short)cur.ha[p][i]); xb[i] = bf2f((unsigned short)cur.hb[p][i]); ss += xa[i] * xa[i] + xb[i] * xb[i]; }
#pragma unroll
            for (int o = 1; o < 16; o <<= 1) ss += bperm_f(ss, ln ^ o);
            const float rs = rsqrtf(ss * (1.f / 128.f) + EPS);
            const f32x4 ga = p < 2 ? gqa : gka, gb = p < 2 ? gqb : gkb;
            float oa[4], ob[4];
#pragma unroll
            for (int i = 0; i < 4; ++i) { const float ya = xa[i] * rs * ga[i], yb = xb[i] * rs * gb[i]; oa[i] = lat ? ya * cs[i] - yb * sn[i] : ya; ob[i] = lat ? ya * sn[i] + yb * cs[i] : yb; }
            bf16_t* dst = p < 2 ? QG + (size_t)row * 1024 + (4 * p + hq) * 128 : KG + (size_t)row * 256 + (hq & 1) * 128;
            if (p < 2 || hq < 2) { u32x2 wa, wb; wa.x = pk2(oa[0], oa[1]); wa.y = pk2(oa[2], oa[3]); wb.x = pk2(ob[0], ob[1]); wb.y = pk2(ob[2], ob[3]);
                *(u32x2*)(dst + eo) = wa; *(u32x2*)(dst + eo + 32) = wb; }
        }
        if (!hn) break;
        cur = nxt; row = nrow;
    }
}

namespace att {
constexpr int QBLK = 32, KVBLK = 64;
#define SBAR() __builtin_amdgcn_sched_barrier(0)
DI int crow(int r, int hi) { return (r & 3) + 8 * (r >> 2) + 4 * hi; }
DI int v_st(int k, int c) { const int kk = (k & ~0xC) | ((k & 4) << 1) | ((k & 8) >> 1); return ((kk >> 3) * 4 + (c >> 5)) * 512 + ((kk & 7) * 32 + (c & 31)) * 2; }
DI int v_rd_base(int lane) { return ((lane & 3) << 3) | (((lane >> 2) & 3) << 6) | (((lane >> 4) & 1) << 5) | (((lane >> 5) & 1) << 8); }
constexpr int v_rd_off(int d0, int ks, int half) { return d0 * 512 + ks * 4096 + half * 2048; }
template <int OFF> DI s16x4 tr_read(int vb) { s16x4 r; asm volatile("ds_read_b64_tr_b16 %0, %1 offset:%2" : "=&v"(r) : "v"(vb), "i"(OFF) : "memory"); return r; }
template <int D0> DI void pv_one(f32x16& od, int vb, bf16x8 pa0, bf16x8 pa1, bf16x8 pa2, bf16x8 pa3) {
  const s16x4 l0 = tr_read<v_rd_off(D0, 0, 0)>(vb), h0 = tr_read<v_rd_off(D0, 0, 1)>(vb), l1 = tr_read<v_rd_off(D0, 1, 0)>(vb), h1 = tr_read<v_rd_off(D0, 1, 1)>(vb);
  const s16x4 l2 = tr_read<v_rd_off(D0, 2, 0)>(vb), h2 = tr_read<v_rd_off(D0, 2, 1)>(vb), l3 = tr_read<v_rd_off(D0, 3, 0)>(vb), h3 = tr_read<v_rd_off(D0, 3, 1)>(vb);
  asm volatile("s_waitcnt lgkmcnt(0)" ::: "memory"); SBAR();
#define PK(L, H) (bf16x8){L[0], L[1], L[2], L[3], H[0], H[1], H[2], H[3]}
  od = __builtin_amdgcn_mfma_f32_32x32x16_bf16(pa0, PK(l0, h0), od, 0, 0, 0);
  od = __builtin_amdgcn_mfma_f32_32x32x16_bf16(pa1, PK(l1, h1), od, 0, 0, 0);
  od = __builtin_amdgcn_mfma_f32_32x32x16_bf16(pa2, PK(l2, h2), od, 0, 0, 0);
  od = __builtin_amdgcn_mfma_f32_32x32x16_bf16(pa3, PK(l3, h3), od, 0, 0, 0);
#undef PK
}
DI void pv_d0(f32x16* o, int vb, bf16x8 pa0, bf16x8 pa1, bf16x8 pa2, bf16x8 pa3) {
  pv_one<0>(o[0], vb, pa0, pa1, pa2, pa3); pv_one<1>(o[1], vb, pa0, pa1, pa2, pa3); pv_one<2>(o[2], vb, pa0, pa1, pa2, pa3); pv_one<3>(o[3], vb, pa0, pa1, pa2, pa3);
}
template <int DKX, int LDQ, int LDK, int LDV, int LDO, int SDEPTH = 1>
DI void attn_body(const bf16_t* __restrict__ Qb, const bf16_t* __restrict__ Km, const bf16_t* __restrict__ Kx, const bf16_t* __restrict__ Vm, bf16_t* __restrict__ Ob,
                  int kr0, int nt0, int kr1, int nt1, float scale, const float* __restrict__ ropeq  , char* lds) {
  constexpr int ND0 = 8 + DKX / 16, KROWB = (128 + DKX) * 2, SHM_V = KVBLK * 128 * 2, SHM_K = KVBLK * KROWB;
  constexpr float THR = 8.f;
#define KSWZ(row, colB) ((row) * KROWB + ((colB) ^ (((row) & 7) << 4)))
  int tid = threadIdx.x; asm volatile("" : "+v"(tid));
  const int wid = __builtin_amdgcn_readfirstlane(tid >> 6), lane = tid & 63, r32 = lane & 31, hi = lane >> 5;
  char* V_lds = lds; char* K_lds = lds + 2 * SHM_V;
  float* ws = (float*)(lds + 2 * SHM_V + 2 * SHM_K) + wid * 64; float* li_l = ws; float* al_l = ws + 32;
  const float C = scale * 1.4426950408889634f;
  float m_reg = -1e30f, l_reg = 0; f32x16 o[4] = {}; bf16x8 qr[8];
  const bf16_t* Qw = Qb + (long)(wid * QBLK + r32) * LDQ + hi * 8;
#pragma unroll
  for (int d0 = 0; d0 < 8; ++d0) qr[d0] = *reinterpret_cast<const bf16x8*>(Qw + d0 * 16);
  char* QX = lds + 2 * SHM_V + 2 * SHM_K + 2048 + (wid * 4 * 64 + lane) * 16;
  if constexpr (DKX > 0) {
#pragma unroll
    for (int ax = 0; ax < 2; ++ax) {
      const bf16x8 xa = *reinterpret_cast<const bf16x8*>(Qw + 128 + ax * 32), xb = *reinterpret_cast<const bf16x8*>(Qw + 128 + ax * 32 + 16);
      if (ropeq) {
        const float* cs = ropeq + ((size_t)(wid * QBLK + r32) * 32 + ax * 16 + hi * 8) * 2;
        float oa[8], ob[8];
#pragma unroll
        for (int j = 0; j < 8; ++j) { const float c = cs[2 * j], sn = cs[2 * j + 1], a = bf2f((unsigned short)xa[j]), b = bf2f((unsigned short)xb[j]); oa[j] = a * c - b * sn; ob[j] = a * sn + b * c; }
        u32x4 wa = {pk2(oa[0], oa[1]), pk2(oa[2], oa[3]), pk2(oa[4], oa[5]), pk2(oa[6], oa[7])}, wb = {pk2(ob[0], ob[1]), pk2(ob[2], ob[3]), pk2(ob[4], ob[5]), pk2(ob[6], ob[7])};
        *reinterpret_cast<u32x4*>(QX + (2 * ax) * 1024) = wa; *reinterpret_cast<u32x4*>(QX + (2 * ax + 1) * 1024) = wb;
      } else { *reinterpret_cast<bf16x8*>(QX + (2 * ax) * 1024) = xa; *reinterpret_cast<bf16x8*>(QX + (2 * ax + 1) * 1024) = xb; }
    }
  }
  const int sr = tid >> 4, sc = (tid & 15) * 8, vst0 = v_st(sr, sc), vst1 = v_st(32 + sr, sc);
  const int xr = tid >> 3, xc = (tid & 7) * 8;
  const int vb0 = (int)(uintptr_t)V_lds + v_rd_base(lane);
  const int offV = sr * LDV + sc, offK = sr * LDK + sc, offX = xr * 64 + xc;
  struct { bf16x8 vs0, vs1, ks0, ks1, kx; } sr_[SDEPTH];
  const int NT = nt0 + nt1;
#define TROW(j) ((j) < nt0 ? kr0 + (j) * KVBLK : kr1 + ((j) - nt0) * KVBLK)
#define SLOAD(i, j) do { const long _r = TROW(j); const bf16_t* _vt = Vm + _r * LDV; const bf16_t* _kt = Km + _r * LDK; \
    sr_[i].vs0 = *(const bf16x8*)(_vt + offV); sr_[i].vs1 = *(const bf16x8*)(_vt + offV + 32 * LDV); \
    sr_[i].ks0 = *(const bf16x8*)(_kt + offK); sr_[i].ks1 = *(const bf16x8*)(_kt + offK + 32 * LDK); \
    if constexpr (DKX > 0) sr_[i].kx = *(const bf16x8*)(Kx + _r * 64 + offX); } while (0)
#define SWRITE(b, i) do { *(bf16x8*)(V_lds + (b) * SHM_V + vst0) = sr_[i].vs0; *(bf16x8*)(V_lds + (b) * SHM_V + vst1) = sr_[i].vs1; const int kc = sc * 2; \
    *(bf16x8*)(K_lds + (b) * SHM_K + KSWZ(sr, kc)) = sr_[i].ks0; *(bf16x8*)(K_lds + (b) * SHM_K + KSWZ(32 + sr, kc)) = sr_[i].ks1; \
    if constexpr (DKX > 0) *(bf16x8*)(K_lds + (b) * SHM_K + KSWZ(xr, 256 + xc * 2)) = sr_[i].kx; } while (0)
#define SWAIT() do { if constexpr (SDEPTH == 1) asm volatile("s_waitcnt vmcnt(0)" ::: "memory"); else if constexpr (DKX > 0) asm volatile("s_waitcnt vmcnt(5)" ::: "memory"); else asm volatile("s_waitcnt vmcnt(4)" ::: "memory"); } while (0)
#define RESC(a) do { if (__any((a) < 1.f)) { if (hi == 0) al_l[r32] = (a); asm volatile("s_waitcnt lgkmcnt(0)" ::: "memory"); \
    for (int d = 0; d < 4; ++d) for (int r = 0; r < 16; ++r) o[d][r] *= al_l[crow(r, hi)]; } } while (0)
#define QKT(p0, p1, Ks) do { p0 = f32x16{}; p1 = f32x16{}; _Pragma("unroll") for (int d0 = 0; d0 < ND0; ++d0) { const int cb = (d0 * 16 + hi * 8) * 2; \
    const bf16x8 b0 = *reinterpret_cast<const bf16x8*>((Ks) + KSWZ(r32, cb)); const bf16x8 b1 = *reinterpret_cast<const bf16x8*>((Ks) + KSWZ(32 + r32, cb)); \
    const bf16x8 qf = d0 < 8 ? qr[d0 < 8 ? d0 : 0] : *reinterpret_cast<const bf16x8*>(QX + (d0 - 8) * 1024); \
    p0 = __builtin_amdgcn_mfma_f32_32x32x16_bf16(b0, qf, p0, 0, 0, 0); p1 = __builtin_amdgcn_mfma_f32_32x32x16_bf16(b1, qf, p1, 0, 0, 0); if (DKX > 0 && (d0 & 1) == 1) SBAR(); } } while (0)
#define PARTIAL_SM(p0, p1, mn, alpha) do { float pmax = p0[0]; for (int r = 1; r < 16; ++r) pmax = fmaxf(pmax, p0[r]); for (int r = 0; r < 16; ++r) pmax = fmaxf(pmax, p1[r]); \
    { auto rr = __builtin_amdgcn_permlane32_swap(__float_as_uint(pmax), __float_as_uint(pmax), false, false); pmax = fmaxf(__uint_as_float(rr[0]), __uint_as_float(rr[1])); } \
    if (__builtin_expect(__all((pmax - m_reg) * scale <= THR), 1)) { mn = m_reg; alpha = 1.f; } \
    else { mn = fmaxf(m_reg, pmax); alpha = __builtin_amdgcn_exp2f((m_reg - mn) * C); m_reg = mn; } \
    const float mnC = -mn * C; for (int r = 0; r < 16; ++r) p0[r] = fmaf(p0[r], C, mnC); for (int r = 0; r < 16; ++r) p1[r] = fmaf(p1[r], C, mnC); \
    for (int r = 0; r < 16; ++r) p0[r] = __builtin_amdgcn_exp2f(p0[r]); } while (0)
#define PK4(P, BASE, OUT) do { unsigned a0 = pk2(P[BASE + 0], P[BASE + 1]), a1 = pk2(P[BASE + 2], P[BASE + 3]); \
    unsigned b0 = pk2(P[BASE + 4], P[BASE + 5]), b1 = pk2(P[BASE + 6], P[BASE + 7]); \
    auto r0 = __builtin_amdgcn_permlane32_swap(a0, b0, false, false); auto r1 = __builtin_amdgcn_permlane32_swap(a1, b1, false, false); \
    u32x4 w = {r0[0], r1[0], r0[1], r1[1]}; OUT = *reinterpret_cast<bf16x8*>(&w); } while (0)
#define FINISH_SM(p0, p1, alpha) do { for (int r = 0; r < 16; ++r) p1[r] = __builtin_amdgcn_exp2f(p1[r]); \
    float ps = 0; for (int r = 0; r < 16; ++r) ps += p0[r]; for (int r = 0; r < 16; ++r) ps += p1[r]; \
    { auto rr = __builtin_amdgcn_permlane32_swap(__float_as_uint(ps), __float_as_uint(ps), false, false); ps = __uint_as_float(rr[0]) + __uint_as_float(rr[1]); } \
    l_reg = l_reg * alpha + ps; PK4(p0, 0, pa0); PK4(p0, 8, pa1); PK4(p1, 0, pa2); PK4(p1, 8, pa3); } while (0)
  f32x16 pA0, pA1, pB0, pB1; float mnA, mnB, alA, alB; bf16x8 pa0, pa1, pa2, pa3;
  constexpr int SE = 0, SO = SDEPTH - 1;
  SLOAD(SE, 0); asm volatile("s_waitcnt vmcnt(0)" ::: "memory"); SWRITE(0, SE); __syncthreads();
  QKT(pA0, pA1, K_lds); PARTIAL_SM(pA0, pA1, mnA, alA);
  SLOAD(SO, 1); if constexpr (SDEPTH == 2) { if (2 < NT) SLOAD(SE, 2); }
  SWAIT(); SWRITE(1, SO); __syncthreads();
  for (int j = 1; j + 1 < NT; j += 2) {
    SBAR(); QKT(pB0, pB1, K_lds + SHM_K);
    FINISH_SM(pA0, pA1, alA); SBAR();
    SLOAD(SO, j + SDEPTH); SBAR();
    pv_d0(o, vb0, pa0, pa1, pa2, pa3); PARTIAL_SM(pB0, pB1, mnB, alB);
    __syncthreads(); SWAIT(); SWRITE(0, SE);
    RESC(alB); __syncthreads();
    SBAR(); QKT(pA0, pA1, K_lds);
    FINISH_SM(pB0, pB1, alB); SBAR();
    if (SDEPTH == 1 || j + 3 < NT) SLOAD(SE, j + 1 + SDEPTH); SBAR();
    pv_d0(o, vb0 + (int)SHM_V, pa0, pa1, pa2, pa3); PARTIAL_SM(pA0, pA1, mnA, alA);
    __syncthreads(); SWAIT(); SWRITE(1, SO);
    RESC(alA); __syncthreads();
  }
  SBAR(); QKT(pB0, pB1, K_lds + SHM_K);
  FINISH_SM(pA0, pA1, alA); SBAR();
  pv_d0(o, vb0, pa0, pa1, pa2, pa3); PARTIAL_SM(pB0, pB1, mnB, alB);
  __syncthreads(); RESC(alB);
  FINISH_SM(pB0, pB1, alB); SBAR();
  pv_d0(o, vb0 + (int)SHM_V, pa0, pa1, pa2, pa3);
  if (hi == 0) li_l[r32] = l_reg; asm volatile("s_waitcnt lgkmcnt(0)" ::: "memory");
  float rli[16];
#pragma unroll
  for (int r = 0; r < 16; ++r) rli[r] = __builtin_amdgcn_rcpf(li_l[crow(r, hi)]);
  bf16_t* Ow = Ob + (long)(wid * QBLK) * LDO;
#pragma unroll
  for (int r = 0; r < 16; ++r) { const int orow = crow(r, hi);
#pragma unroll
    for (int d0 = 0; d0 < 4; ++d0) Ow[(long)orow * LDO + d0 * 32 + r32] = (bf16_t)f2bf(o[d0][r] * rli[r]); }
  __syncthreads();
#undef KSWZ
#undef TROW
#undef SLOAD
#undef SWRITE
#undef SWAIT
#undef RESC
#undef QKT
#undef PARTIAL_SM
#undef PK4
#undef FINISH_SM
}
}

namespace ml {
constexpr int LD = 264, ROWB = LD * 2, QS_OFF = 0, KS_OFF = 64 * ROWB, VS_OFF = 2 * 64 * ROWB, NV_OFF = 3 * 64 * ROWB, SC_OFF = NV_OFF + 1024, ML_END = SC_OFF + 2048;
static_assert(ML_END <= LDS_BYTES - 1024, "mlstm lds");
#define MFMA32(a, b, c) __builtin_amdgcn_mfma_f32_32x32x16_bf16((a), (b), (c), 0, 0, 0)
DI bf16x8 pack_step(const f32x16& x, int s) {
    u32x4 p;
    asm volatile("v_cvt_pk_bf16_f32 %0, %4, %5\n\tv_cvt_pk_bf16_f32 %1, %6, %7\n\tv_cvt_pk_bf16_f32 %2, %8, %9\n\tv_cvt_pk_bf16_f32 %3, %10, %11\n\ts_nop 1"
                 : "=&v"(p[0]), "=&v"(p[1]), "=&v"(p[2]), "=&v"(p[3])
                 : "v"(x[8 * s]), "v"(x[8 * s + 1]), "v"(x[8 * s + 2]), "v"(x[8 * s + 3]), "v"(x[8 * s + 4]), "v"(x[8 * s + 5]), "v"(x[8 * s + 6]), "v"(x[8 * s + 7]));
    return __builtin_bit_cast(bf16x8, p);
}
DI bf16x8 ld_perm(const LAS unsigned char* p) {
    const s16x4 lo = *(const LAS s16x4*)p, hi = *(const LAS s16x4*)(p + 16);
    return (bf16x8){lo[0], lo[1], lo[2], lo[3], hi[0], hi[1], hi[2], hi[3]};
}
DI int crow(int r, int hi) { return (r & 3) + 8 * (r >> 2) + 4 * hi; }
template <int OFF> DI s16x4 tr_rd(unsigned addr) { s16x4 r; asm volatile("ds_read_b64_tr_b16 %0, %1 offset:%2" : "=&v"(r) : "v"(addr), "i"(OFF) : "memory"); return r; }
#define TR_WAIT() do { asm volatile("s_waitcnt lgkmcnt(0)" ::: "memory"); __builtin_amdgcn_sched_barrier(0); } while (0)
#define CAT8(L, H) (bf16x8){L[0], L[1], L[2], L[3], H[0], H[1], H[2], H[3]}

DI void mlstm_stream(const Frame& F, const Args& a, int l, int stream, bool ctx_out) {
    const int b = stream >> 3, hd = (stream >> 1) & 3, dir = stream & 1;
    const int tid = F.tid, w = F.wave;
    LAS unsigned char* lds = F.lds;
    const unsigned ldsb = (unsigned)(uintptr_t)lds;
    const bf16_t* P = (const bf16_t*)(F.ws + WS_P); const float* X80 = (const float*)(F.ws + WS_X80);
    float* MLH = (float*)(F.ws + WS_MLH) + (size_t)dir * MTOT * 1024;
    const float* gb = a.in[I_GBIAS] + l * 16;
    const float gbi = gb[dir * 8 + hd], gbf = gb[dir * 8 + 4 + hd];
    LAS float* NV = (LAS float*)(lds + NV_OFF);
    LAS float* SC = (LAS float*)(lds + SC_OFF);
    f32x16 CT[8];
#pragma unroll
    for (int i = 0; i < 8; ++i) CT[i] = f32x16{};
    if (tid < 256) NV[tid] = 0.f;
    float m_prev = 0.f;
    const int sgn = dir ? -1 : 1;
#define CHUNK_ROW0(c) ((c) < 4 ? MLAT + b * CTXL + (dir ? 255 - (c) * 64 : (c) * 64) : b * SEQ + (dir ? 2047 - ((c) - 4) * 64 : ((c) - 4) * 64))
    bf16x8 pq[4], pk[4], pv[4]; float pgi, pgf;
#define PREFETCH(c) do { int ln_ = F.lane; asm volatile("" : "+v"(ln_)); const int r0_ = CHUNK_ROW0(c); \
        const bf16_t* pr_ = P + (size_t)(r0_ + sgn * ((w << 3) | (ln_ >> 3))) * NP + hd * 256 + 8 * (ln_ & 7); \
        _Pragma("unroll") for (int j = 0; j < 4; ++j) { pq[j] = *(const bf16x8*)(pr_ + C_MLQ + 64 * j); pk[j] = *(const bf16x8*)(pr_ + C_MLK + 64 * j); pv[j] = *(const bf16x8*)(pr_ + C_MLV + 64 * j); } \
        const float* xg_ = X80 + (size_t)(r0_ + sgn * ln_) * XW + 64 + dir * 8 + hd; pgi = xg_[0]; pgf = xg_[4]; } while (0)
    PREFETCH(0);
#ifndef MK_MLX
#define MK_MLX 1
#endif
    for (int cc = 0; cc < 36 * MK_MLX; ++cc) {
        const int c = cc % 36;
        if (MK_MLX > 1 && cc == 36) { __syncthreads();
#pragma unroll
            for (int i = 0; i < 8; ++i) CT[i] = f32x16{};
            if (tid < 256) NV[tid] = 0.f; m_prev = 0.f; }
        int lane = F.lane; asm volatile("" : "+v"(lane));
        const int r32 = lane & 31, hi = lane >> 5, ldi = (w << 3) | (lane >> 3), cg = lane & 7, g16 = lane >> 4, q4 = (lane & 15) >> 2, p4 = lane & 3;
        const int row0 = CHUNK_ROW0(c);
        const float ipre = pgi + gbi, fpre = pgf + gbf;
        const float lf = fminf(fpre, 0.f) - __logf(1.f + __expf(-fabsf(fpre)));
        float cum = lf;
#pragma unroll
        for (int o = 1; o < 64; o <<= 1) { const float t = shu(cum, o); if (lane >= o) cum += t; }
        const float bb = ipre - cum;
        float pmx = bb;
#pragma unroll
        for (int o = 1; o < 64; o <<= 1) { const float t = shu(pmx, o); if (lane >= o) pmx = fmaxf(pmx, t); }
        const float aa = fmaxf(m_prev, pmx);
        const float cum_end = shl_(cum, 63), a_end = shl_(aa, 63);
        const float decay = __expf(m_prev - a_end), m_new = cum_end + a_end;
        __syncthreads();
#pragma unroll
        for (int j = 0; j < 4; ++j) { const int ch = cg + 8 * j; const bf16x8 qv = pq[j];
            u32x4 qs;
            qs.x = pk2(bf2f((unsigned short)qv[0]) * 0.0625f, bf2f((unsigned short)qv[1]) * 0.0625f); qs.y = pk2(bf2f((unsigned short)qv[2]) * 0.0625f, bf2f((unsigned short)qv[3]) * 0.0625f);
            qs.z = pk2(bf2f((unsigned short)qv[4]) * 0.0625f, bf2f((unsigned short)qv[5]) * 0.0625f); qs.w = pk2(bf2f((unsigned short)qv[6]) * 0.0625f, bf2f((unsigned short)qv[7]) * 0.0625f);
            *(LAS u32x4*)(lds + QS_OFF + (ldi * LD + 8 * ch) * 2) = qs;
            *(LAS bf16x8*)(lds + KS_OFF + (ldi * LD + 8 * ch) * 2) = pk[j];
            *(LAS bf16x8*)(lds + VS_OFF + (ldi * LD + 8 * ch) * 2) = pv[j]; }
        {
            float part = 0.f;
#pragma unroll
            for (int j = 0; j < 4; ++j) { const int ch = cg + 8 * j; const bf16x8 qv = pq[j]; const f32x4 n0 = *(const LAS f32x4*)(NV + 8 * ch), n1 = *(const LAS f32x4*)(NV + 8 * ch + 4);
                part += bf2f((unsigned short)qv[0]) * n0.x + bf2f((unsigned short)qv[1]) * n0.y + bf2f((unsigned short)qv[2]) * n0.z + bf2f((unsigned short)qv[3]) * n0.w
                      + bf2f((unsigned short)qv[4]) * n1.x + bf2f((unsigned short)qv[5]) * n1.y + bf2f((unsigned short)qv[6]) * n1.z + bf2f((unsigned short)qv[7]) * n1.w; }
            part += shx(part, 1); part += shx(part, 2); part += shx(part, 4);
            if (cg == 0) SC[320 + ldi] = part * 0.0625f; }
        if (w == 0) { SC[lane] = bb; SC[64 + lane] = aa; SC[128 + lane] = __expf(m_prev - aa); SC[192 + lane] = __expf(-cum - aa); SC[256 + lane] = __expf(bb - a_end); }
        __syncthreads();
        const bool want_out = (c >= 4) || ctx_out;
        if (want_out) {
            const unsigned va0 = ldsb + VS_OFF + ((4 * (g16 >> 1) + q4) * LD + 32 * w + 16 * (g16 & 1) + 4 * p4) * 2;
#pragma unroll
            for (int lt = 0; lt < 2; ++lt) {
                const int lcol = 32 * lt + r32;
                const float a_l = SC[64 + lcol], wI_l = SC[128 + lcol], fl_l = SC[192 + lcol], nq_l = SC[320 + lcol];
                f32x16 N = f32x16{};
#pragma unroll
                for (int dt = 0; dt < 8; ++dt)
#pragma unroll
                    for (int ks = 0; ks < 2; ++ks) {
                        const bf16x8 qa = ld_perm(lds + QS_OFF + (lcol * LD + 32 * dt + 16 * ks + 4 * hi) * 2);
                        N = MFMA32(pack_step(CT[dt], ks), qa, N); if (ks == 1 && (dt & 1)) __builtin_amdgcn_sched_barrier(0); }
#pragma unroll
                for (int r = 0; r < 16; ++r) N[r] *= wI_l;
                float den = 0.f;
#pragma unroll
                for (int st = 0; st <= lt; ++st) {
                    f32x16 S = f32x16{};
#pragma unroll
                    for (int ks = 0; ks < 16; ++ks) {
                        const bf16x8 ka = *(const LAS bf16x8*)(lds + KS_OFF + ((32 * st + r32) * LD + 16 * ks + 8 * hi) * 2);
                        const bf16x8 qb = *(const LAS bf16x8*)(lds + QS_OFF + (lcol * LD + 16 * ks + 8 * hi) * 2);
                        S = MFMA32(ka, qb, S); }
                    const s16x4 v00 = st == 0 ? tr_rd<0>(va0) : tr_rd<32 * ROWB>(va0), v01 = st == 0 ? tr_rd<8 * ROWB>(va0) : tr_rd<40 * ROWB>(va0);
                    const s16x4 v10 = st == 0 ? tr_rd<16 * ROWB>(va0) : tr_rd<48 * ROWB>(va0), v11 = st == 0 ? tr_rd<24 * ROWB>(va0) : tr_rd<56 * ROWB>(va0);
#pragma unroll
                    for (int r = 0; r < 16; ++r) { const int srow = 32 * st + crow(r, hi); const float dd = __expf(SC[srow] - a_l);
                        const float v = (srow <= lcol) ? S[r] * dd : 0.f; S[r] = v; den += v; }
                    TR_WAIT();
                    N = MFMA32(CAT8(v00, v01), pack_step(S, 0), N);
                    N = MFMA32(CAT8(v10, v11), pack_step(S, 1), N);
                }
                den += shx(den, 32);
                den += wI_l * nq_l;
                const float inv = 1.f / fmaxf(fabsf(den), fl_l);
                float* orow = MLH + (size_t)(row0 + sgn * lcol) * 1024 + hd * 256 + 32 * w + 4 * hi;
#pragma unroll
                for (int g = 0; g < 4; ++g) *(f32x4*)(orow + 8 * g) = (f32x4){N[4 * g] * inv, N[4 * g + 1] * inv, N[4 * g + 2] * inv, N[4 * g + 3] * inv};
                __builtin_amdgcn_sched_barrier(0);
            }
        }
        __builtin_amdgcn_sched_barrier(0);
        { const int cn = (cc + 1 < 36 * MK_MLX) ? (cc + 1) % 36 : 35; PREFETCH(cn); }
        __builtin_amdgcn_sched_barrier(0);
        {
            const unsigned vb0 = ldsb + VS_OFF + ((8 * (g16 >> 1) + q4) * LD + 32 * w + 16 * (g16 & 1) + 4 * p4) * 2;
            const unsigned kb0 = ldsb + KS_OFF + ((8 * (g16 >> 1) + q4) * LD + 16 * (g16 & 1) + 4 * p4) * 2;
            const s16x4 b00 = tr_rd<0>(vb0), b01 = tr_rd<4 * ROWB>(vb0), b10 = tr_rd<16 * ROWB>(vb0), b11 = tr_rd<20 * ROWB>(vb0);
            const s16x4 b20 = tr_rd<32 * ROWB>(vb0), b21 = tr_rd<36 * ROWB>(vb0), b30 = tr_rd<48 * ROWB>(vb0), b31 = tr_rd<52 * ROWB>(vb0);
            TR_WAIT();
            bf16x8 vb[4];
#define SCALE8(dst, L, H, ks) do { const f32x4 w0 = *(const LAS f32x4*)(SC + 256 + 16 * (ks) + 8 * hi), w1 = *(const LAS f32x4*)(SC + 256 + 16 * (ks) + 8 * hi + 4); \
            u32x4 t_; t_.x = pk2(bf2f((unsigned short)L[0]) * w0.x, bf2f((unsigned short)L[1]) * w0.y); t_.y = pk2(bf2f((unsigned short)L[2]) * w0.z, bf2f((unsigned short)L[3]) * w0.w); \
            t_.z = pk2(bf2f((unsigned short)H[0]) * w1.x, bf2f((unsigned short)H[1]) * w1.y); t_.w = pk2(bf2f((unsigned short)H[2]) * w1.z, bf2f((unsigned short)H[3]) * w1.w); dst = __builtin_bit_cast(bf16x8, t_); } while (0)
            SCALE8(vb[0], b00, b01, 0); SCALE8(vb[1], b10, b11, 1); SCALE8(vb[2], b20, b21, 2); SCALE8(vb[3], b30, b31, 3);
#undef SCALE8
#define UPD(dt) do { const s16x4 k00 = tr_rd<(dt) * 64>(kb0), k01 = tr_rd<(dt) * 64 + 4 * ROWB>(kb0), k10 = tr_rd<(dt) * 64 + 16 * ROWB>(kb0), k11 = tr_rd<(dt) * 64 + 20 * ROWB>(kb0); \
            const s16x4 k20 = tr_rd<(dt) * 64 + 32 * ROWB>(kb0), k21 = tr_rd<(dt) * 64 + 36 * ROWB>(kb0), k30 = tr_rd<(dt) * 64 + 48 * ROWB>(kb0), k31 = tr_rd<(dt) * 64 + 52 * ROWB>(kb0); \
            _Pragma("unroll") for (int r = 0; r < 16; ++r) CT[dt][r] *= decay; \
            TR_WAIT(); \
            CT[dt] = MFMA32(CAT8(k00, k01), vb[0], CT[dt]); CT[dt] = MFMA32(CAT8(k10, k11), vb[1], CT[dt]); CT[dt] = MFMA32(CAT8(k20, k21), vb[2], CT[dt]); CT[dt] = MFMA32(CAT8(k30, k31), vb[3], CT[dt]); } while (0)
            UPD(0); UPD(1); UPD(2); UPD(3); UPD(4); UPD(5); UPD(6); UPD(7);
#undef UPD
        }
        __syncthreads();
        if (tid < 256) { float sacc = 0.f;
#pragma unroll 8
            for (int q = 0; q < 64; ++q) sacc += bf2f(*(const LAS unsigned short*)(lds + KS_OFF + (q * LD + tid) * 2)) * SC[256 + q];
            NV[tid] = decay * NV[tid] + sacc; }
        m_prev = m_new;
    }
    __syncthreads();
#undef CHUNK_ROW0
#undef PREFETCH
}

namespace u2 {
constexpr int LDQ = 264, ROWQ = LDQ * 2, LDV = 136, ROWV = LDV * 2, LDW = 72, ROWW = LDW * 2;
constexpr int QS = 0, KS = 64 * ROWQ, VS = 2 * 64 * ROWQ, SW = VS + 64 * ROWV, NV_O = SW + 64 * ROWW, SC_O = NV_O + 1024, SCN = 448, END = SC_O + 2 * SCN * 4;
static_assert(END <= LDS_BYTES - 1024, "mlstm2 lds");
}
DI void mlstm_unit2(const Frame& F, const Args& a, int l, int unit, bool ctx_out) {
    using namespace u2;
    const int stream = unit >> 1, half = unit & 1, b = stream >> 3, hd = (stream >> 1) & 3, dir = stream & 1;
    const int tid = F.tid, w = F.wave;
    LAS unsigned char* lds = F.lds;
    const unsigned ldsb = (unsigned)(uintptr_t)lds;
    const bf16_t* P = (const bf16_t*)(F.ws + WS_P); const float* X80 = (const float*)(F.ws + WS_X80);
    bf16_t* MLH = (bf16_t*)(F.ws + WS_MLH) + (size_t)dir * MTOT * 1024;
    const float* gb = a.in[I_GBIAS] + l * 16;
    const float gbi = gb[dir * 8 + hd], gbf = gb[dir * 8 + 4 + hd];
    LAS float* NV = (LAS float*)(lds + NV_O);
    const int sgn = dir ? -1 : 1;
#define CHUNK_ROW0(c) ((c) < 4 ? MLAT + b * CTXL + (dir ? 255 - (c) * 64 : (c) * 64) : b * SEQ + (dir ? 2047 - ((c) - 4) * 64 : ((c) - 4) * 64))
    const bool helper = w >= 4;
    bf16x8 pq[8], pk[8], pv[4]; float pgi = 0.f, pgf = 0.f; float m_prev = 0.f;
#define PREFETCH(c) do { int ht_ = tid - 256; asm volatile("" : "+v"(ht_)); const int r0_ = CHUNK_ROW0(c); \
        const bf16_t* pr_ = P + (size_t)(r0_ + sgn * (ht_ >> 2)) * NP + hd * 256 + 8 * (ht_ & 3); \
        _Pragma("unroll") for (int j = 0; j < 8; ++j) { pq[j] = *(const bf16x8*)(pr_ + C_MLQ + 32 * j); pk[j] = *(const bf16x8*)(pr_ + C_MLK + 32 * j); } \
        _Pragma("unroll") for (int j = 0; j < 4; ++j) pv[j] = *(const bf16x8*)(pr_ + C_MLV + 128 * half + 32 * j); \
        const float* xg_ = X80 + (size_t)(r0_ + sgn * (ht_ & 63)) * XW + 64 + dir * 8 + hd; pgi = xg_[0]; pgf = xg_[4]; } while (0)
#define SCALARS(sb) do { if (w == 4) { int ln_ = F.lane; asm volatile("" : "+v"(ln_)); LAS float* SCw = (LAS float*)(lds + SC_O) + (sb) * SCN; \
        const float ipre = pgi + gbi, fpre = pgf + gbf; const float lf = fminf(fpre, 0.f) - __logf(1.f + __expf(-fabsf(fpre))); \
        float cum = lf; _Pragma("unroll") for (int o = 1; o < 64; o <<= 1) { const float t = shu(cum, o); if (ln_ >= o) cum += t; } \
        const float bb = ipre - cum; float pmx = bb; _Pragma("unroll") for (int o = 1; o < 64; o <<= 1) { const float t = shu(pmx, o); if (ln_ >= o) pmx = fmaxf(pmx, t); } \
        const float aa = fmaxf(m_prev, pmx); const float cum_end = shl_(cum, 63), a_end = shl_(aa, 63); \
        { SCw[ln_] = bb; SCw[64 + ln_] = aa; SCw[128 + ln_] = __expf(m_prev - aa); SCw[192 + ln_] = __expf(-cum - aa); SCw[256 + ln_] = __expf(bb - a_end); if (ln_ == 0) SCw[384] = __expf(m_prev - a_end); } \
        m_prev = cum_end + a_end; } } while (0)
#define WRITE_Q() do { int ht_ = tid - 256; asm volatile("" : "+v"(ht_)); const int hp_ = ht_ >> 2, hg_ = ht_ & 3; \
        _Pragma("unroll") for (int j = 0; j < 8; ++j) { const bf16x8 qv = pq[j]; u32x4 qs; \
            qs.x = pk2(bf2f((unsigned short)qv[0]) * 0.0625f, bf2f((unsigned short)qv[1]) * 0.0625f); qs.y = pk2(bf2f((unsigned short)qv[2]) * 0.0625f, bf2f((unsigned short)qv[3]) * 0.0625f); \
            qs.z = pk2(bf2f((unsigned short)qv[4]) * 0.0625f, bf2f((unsigned short)qv[5]) * 0.0625f); qs.w = pk2(bf2f((unsigned short)qv[6]) * 0.0625f, bf2f((unsigned short)qv[7]) * 0.0625f); \
            *(LAS u32x4*)(lds + QS + (hp_ * LDQ + 8 * (hg_ + 4 * j)) * 2) = qs; } } while (0)
#define WRITE_KV() do { int ht_ = tid - 256; asm volatile("" : "+v"(ht_)); const int hp_ = ht_ >> 2, hg_ = ht_ & 3; \
        _Pragma("unroll") for (int j = 0; j < 8; ++j) *(LAS bf16x8*)(lds + KS + (hp_ * LDQ + 8 * (hg_ + 4 * j)) * 2) = pk[j]; \
        _Pragma("unroll") for (int j = 0; j < 4; ++j) *(LAS bf16x8*)(lds + VS + (hp_ * LDV + 8 * (hg_ + 4 * j)) * 2) = pv[j]; } while (0)
    LAS float* DEN = (LAS float*)(lds + END);
    static_assert(END + 768 <= LDS_BYTES - 1024, "mlstm2 lds den");
    __syncthreads();
    if (helper) { NV[tid - 256] = 0.f; PREFETCH(0); SCALARS(0); WRITE_Q(); WRITE_KV(); }
    __syncthreads();
    if (!helper) {
      f32x16 CT[8];
#pragma unroll
      for (int i = 0; i < 8; ++i) CT[i] = f32x16{};
      for (int cc = 0; cc < 36 * MK_MLX; ++cc) {
        const int c = cc % 36;
        const int sb = cc & 1;
        const LAS float* SC = (const LAS float*)(lds + SC_O) + sb * SCN;
        const bool want_out = (c >= 4) || ctx_out;
        int lane = F.lane; asm volatile("" : "+v"(lane));
        const int r32 = lane & 31, hi = lane >> 5, g16 = lane >> 4, q4 = (lane & 15) >> 2, p4 = lane & 3;
        const int row0 = CHUNK_ROW0(c);
        if (MK_MLX > 1 && cc == 36) {
#pragma unroll
          for (int i = 0; i < 8; ++i) CT[i] = f32x16{}; }
        f32x16 N0 = f32x16{}, N1 = f32x16{};
        {
            if (want_out) {
#pragma unroll
                for (int dt = 0; dt < 8; ++dt)
#pragma unroll
                    for (int ks = 0; ks < 2; ++ks) {
                        const bf16x8 cf = pack_step(CT[dt], ks);
                        const bf16x8 qa0 = ld_perm(lds + QS + (r32 * LDQ + 32 * dt + 16 * ks + 4 * hi) * 2), qa1 = ld_perm(lds + QS + ((32 + r32) * LDQ + 32 * dt + 16 * ks + 4 * hi) * 2);
                        N0 = MFMA32(cf, qa0, N0); N1 = MFMA32(cf, qa1, N1); if (ks == 1 && (dt & 1)) __builtin_amdgcn_sched_barrier(0); }
                const float wI0 = SC[128 + r32], wI1 = SC[128 + 32 + r32];
#pragma unroll
                for (int r = 0; r < 16; ++r) { N0[r] *= wI0; N1[r] *= wI1; }
            }
        }
        __syncthreads();
        {
            if (want_out) {
                const unsigned va0 = ldsb + VS + ((8 * (g16 >> 1) + q4) * LDV + 32 * w + 16 * (g16 & 1) + 4 * p4) * 2;
                const s16x4 a00 = tr_rd<0>(va0), a01 = tr_rd<4 * ROWV>(va0), a10 = tr_rd<16 * ROWV>(va0), a11 = tr_rd<20 * ROWV>(va0);
                const s16x4 a20 = tr_rd<32 * ROWV>(va0), a21 = tr_rd<36 * ROWV>(va0), a30 = tr_rd<48 * ROWV>(va0), a31 = tr_rd<52 * ROWV>(va0);
                const LAS unsigned char* sw0 = lds + SW + (r32 * LDW + 8 * hi) * 2; const LAS unsigned char* sw1 = sw0 + 32 * ROWW;
                const bf16x8 s00 = *(const LAS bf16x8*)(sw0), s01 = *(const LAS bf16x8*)(sw0 + 32);
                const bf16x8 s10 = *(const LAS bf16x8*)(sw1), s11 = *(const LAS bf16x8*)(sw1 + 32), s12 = *(const LAS bf16x8*)(sw1 + 64), s13 = *(const LAS bf16x8*)(sw1 + 96);
                TR_WAIT();
                N0 = MFMA32(CAT8(a00, a01), s00, N0); N0 = MFMA32(CAT8(a10, a11), s01, N0);
                N1 = MFMA32(CAT8(a00, a01), s10, N1); N1 = MFMA32(CAT8(a10, a11), s11, N1); N1 = MFMA32(CAT8(a20, a21), s12, N1); N1 = MFMA32(CAT8(a30, a31), s13, N1);
                {
                    const float den0 = DEN[r32] + SC[128 + r32] * SC[320 + r32];
                    const float den1 = DEN[64 + 32 + r32] + DEN[128 + 32 + r32] + SC[128 + 32 + r32] * SC[320 + 32 + r32];
                    const float inv0 = 1.f / fmaxf(fabsf(den0), SC[192 + r32]), inv1 = 1.f / fmaxf(fabsf(den1), SC[192 + 32 + r32]);
                    bf16_t* o0 = MLH + (size_t)(row0 + sgn * r32) * 1024 + hd * 256 + 128 * half + 32 * w + 4 * hi; bf16_t* o1 = MLH + (size_t)(row0 + sgn * (32 + r32)) * 1024 + hd * 256 + 128 * half + 32 * w + 4 * hi;
#pragma unroll
                    for (int g = 0; g < 4; ++g) { u32x2 t0, t1; t0.x = pk2(N0[4 * g] * inv0, N0[4 * g + 1] * inv0); t0.y = pk2(N0[4 * g + 2] * inv0, N0[4 * g + 3] * inv0);
                        t1.x = pk2(N1[4 * g] * inv1, N1[4 * g + 1] * inv1); t1.y = pk2(N1[4 * g + 2] * inv1, N1[4 * g + 3] * inv1);
                        *(u32x2*)(o0 + 8 * g) = t0; *(u32x2*)(o1 + 8 * g) = t1; }
                }
            }
            __builtin_amdgcn_sched_barrier(0);
            {
                const float decay = SC[384];
                const unsigned vb0 = ldsb + VS + ((8 * (g16 >> 1) + q4) * LDV + 32 * w + 16 * (g16 & 1) + 4 * p4) * 2;
                const unsigned kb0 = ldsb + KS + ((8 * (g16 >> 1) + q4) * LDQ + 16 * (g16 & 1) + 4 * p4) * 2;
                const s16x4 b00 = tr_rd<0>(vb0), b01 = tr_rd<4 * ROWV>(vb0), b10 = tr_rd<16 * ROWV>(vb0), b11 = tr_rd<20 * ROWV>(vb0);
                const s16x4 b20 = tr_rd<32 * ROWV>(vb0), b21 = tr_rd<36 * ROWV>(vb0), b30 = tr_rd<48 * ROWV>(vb0), b31 = tr_rd<52 * ROWV>(vb0);
                TR_WAIT();
                bf16x8 vb[4];
#define SCALE8(dst, L, H, ks) do { const f32x4 w0 = *(const LAS f32x4*)(SC + 256 + 16 * (ks) + 8 * hi), w1 = *(const LAS f32x4*)(SC + 256 + 16 * (ks) + 8 * hi + 4); \
                u32x4 t_; t_.x = pk2(bf2f((unsigned short)L[0]) * w0.x, bf2f((unsigned short)L[1]) * w0.y); t_.y = pk2(bf2f((unsigned short)L[2]) * w0.z, bf2f((unsigned short)L[3]) * w0.w); \
                t_.z = pk2(bf2f((unsigned short)H[0]) * w1.x, bf2f((unsigned short)H[1]) * w1.y); t_.w = pk2(bf2f((unsigned short)H[2]) * w1.z, bf2f((unsigned short)H[3]) * w1.w); dst = __builtin_bit_cast(bf16x8, t_); } while (0)
                SCALE8(vb[0], b00, b01, 0); SCALE8(vb[1], b10, b11, 1); SCALE8(vb[2], b20, b21, 2); SCALE8(vb[3], b30, b31, 3);
#undef SCALE8
#define UPD(dt) do { const s16x4 k00 = tr_rd<(dt) * 64>(kb0), k01 = tr_rd<(dt) * 64 + 4 * ROWQ>(kb0), k10 = tr_rd<(dt) * 64 + 16 * ROWQ>(kb0), k11 = tr_rd<(dt) * 64 + 20 * ROWQ>(kb0); \
                const s16x4 k20 = tr_rd<(dt) * 64 + 32 * ROWQ>(kb0), k21 = tr_rd<(dt) * 64 + 36 * ROWQ>(kb0), k30 = tr_rd<(dt) * 64 + 48 * ROWQ>(kb0), k31 = tr_rd<(dt) * 64 + 52 * ROWQ>(kb0); \
                _Pragma("unroll") for (int r = 0; r < 16; ++r) CT[dt][r] *= decay; \
                TR_WAIT(); \
                CT[dt] = MFMA32(CAT8(k00, k01), vb[0], CT[dt]); CT[dt] = MFMA32(CAT8(k10, k11), vb[1], CT[dt]); CT[dt] = MFMA32(CAT8(k20, k21), vb[2], CT[dt]); CT[dt] = MFMA32(CAT8(k30, k31), vb[3], CT[dt]); } while (0)
                UPD(0); UPD(1); UPD(2); UPD(3); UPD(4); UPD(5); UPD(6); UPD(7);
#undef UPD
            }
        }
        __syncthreads();
        __syncthreads();
      }
    } else {
      for (int cc = 0; cc < 36 * MK_MLX; ++cc) {
        const int c = cc % 36;
        const int sb = cc & 1;
        const LAS float* SC = (const LAS float*)(lds + SC_O) + sb * SCN;
        const bool want_out = (c >= 4) || ctx_out;
        int lane = F.lane; asm volatile("" : "+v"(lane));
        const int r32 = lane & 31, hi = lane >> 5, g16 = lane >> 4, q4 = (lane & 15) >> 2, p4 = lane & 3;
        const int row0 = CHUNK_ROW0(c);
        { const int cn = (cc + 1 < 36 * MK_MLX) ? (cc + 1) % 36 : 35; PREFETCH(cn); }
        {
            if (want_out) {
                if (w < 7) {
                    const int st = (w == 6) ? 1 : 0, lt = (w == 4) ? 0 : 1, lcol = 32 * lt + r32;
                    f32x16 S = f32x16{};
#pragma unroll
                    for (int ks = 0; ks < 16; ++ks) {
                        const bf16x8 ka = *(const LAS bf16x8*)(lds + KS + ((32 * st + r32) * LDQ + 16 * ks + 8 * hi) * 2);
                        const bf16x8 qb = *(const LAS bf16x8*)(lds + QS + (lcol * LDQ + 16 * ks + 8 * hi) * 2);
                        S = MFMA32(ka, qb, S); }
                    const float a_l = SC[64 + lcol]; float den = 0.f;
#pragma unroll
                    for (int r = 0; r < 16; ++r) { const int srow = 32 * st + crow(r, hi); const float dd = __expf(SC[srow] - a_l);
                        const float v = (srow <= lcol) ? S[r] * dd : 0.f; S[r] = v; den += v; }
                    den += shx(den, 32);
                    if (hi == 0) DEN[(w - 4) * 64 + lcol] = den;
#pragma unroll
                    for (int g = 0; g < 4; ++g) { u32x2 t_; t_.x = pk2(S[4 * g], S[4 * g + 1]); t_.y = pk2(S[4 * g + 2], S[4 * g + 3]);
                        *(LAS u32x2*)(lds + SW + (lcol * LDW + 32 * st + 8 * g + 4 * hi) * 2) = t_; }
                } else {
                    float nq = 0.f; const LAS unsigned char* qrow = lds + QS + lane * ROWQ;
#pragma unroll 4
                    for (int d8 = 0; d8 < 32; ++d8) { const bf16x8 qv = *(const LAS bf16x8*)(qrow + d8 * 16); const f32x4 n0 = *(const LAS f32x4*)(NV + 8 * d8), n1 = *(const LAS f32x4*)(NV + 8 * d8 + 4);
                        nq += bf2f((unsigned short)qv[0]) * n0.x + bf2f((unsigned short)qv[1]) * n0.y + bf2f((unsigned short)qv[2]) * n0.z + bf2f((unsigned short)qv[3]) * n0.w
                            + bf2f((unsigned short)qv[4]) * n1.x + bf2f((unsigned short)qv[5]) * n1.y + bf2f((unsigned short)qv[6]) * n1.z + bf2f((unsigned short)qv[7]) * n1.w; }
                    ((LAS float*)(lds + SC_O) + sb * SCN)[320 + lane] = nq;
                }
            }
        }
        __syncthreads();
        {
            if (w == 7) {
                const int dg = lane & 31, sh = lane >> 5; const float decay = SC[384];
                float ac[8];
#pragma unroll
                for (int j = 0; j < 8; ++j) ac[j] = 0.f;
#pragma unroll 4
                for (int q = 0; q < 32; ++q) { const int srow = 32 * sh + q; const bf16x8 kv = *(const LAS bf16x8*)(lds + KS + (srow * LDQ + 8 * dg) * 2); const float wq = SC[256 + srow];
#pragma unroll
                    for (int j = 0; j < 8; ++j) ac[j] += bf2f((unsigned short)kv[j]) * wq; }
#pragma unroll
                for (int j = 0; j < 8; ++j) ac[j] += shx(ac[j], 32);
                if (sh == 0) {
                    f32x4 n0 = *(LAS f32x4*)(NV + 8 * dg), n1 = *(LAS f32x4*)(NV + 8 * dg + 4);
                    n0 = n0 * decay + (f32x4){ac[0], ac[1], ac[2], ac[3]}; n1 = n1 * decay + (f32x4){ac[4], ac[5], ac[6], ac[7]};
                    if (MK_MLX > 1 && cc == 35) { n0 = (f32x4){0.f, 0.f, 0.f, 0.f}; n1 = n0; }
                    *(LAS f32x4*)(NV + 8 * dg) = n0; *(LAS f32x4*)(NV + 8 * dg + 4) = n1; }
            }
            if (MK_MLX > 1 && cc == 35) m_prev = 0.f;
            SCALARS(sb ^ 1);
            WRITE_Q();
        }
        __syncthreads();
        WRITE_KV();
        __syncthreads();
      }
    }
#undef CHUNK_ROW0
#undef PREFETCH
#undef SCALARS
#undef WRITE_Q
#undef WRITE_KV
}
#undef MFMA32
#undef TR_WAIT
#undef CAT8
}

DI void phase_mixers(const Frame& F, const Args& a, int l, char* ldsg, int npass) {
    unsigned* head0 = (unsigned*)(F.ws + WS_CTL) + CW_QUEUE + 64 * l;
    volatile LAS unsigned* MISC = (volatile LAS unsigned*)(F.lds + LDS_BYTES - 64);
    const int n_ml = 64, n_la = 256, n_ga = 256, n_cx = (l == 0) ? 32 : 0, n_mix = n_ml + n_la + n_ga + 2 * n_cx;
    const int total = n_mix;
    const bf16_t* QLA = (const bf16_t*)(F.ws + WS_QLA); const bf16_t* KVLA = (const bf16_t*)(F.ws + WS_KVLA); const bf16_t* KR = (const bf16_t*)(F.ws + WS_KR);
    const bf16_t* QG = (const bf16_t*)(F.ws + WS_QG); const bf16_t* KG = (const bf16_t*)(F.ws + WS_KG); const bf16_t* P = (const bf16_t*)(F.ws + WS_P);
    bf16_t* YCAT = (bf16_t*)(F.ws + WS_YCAT);
#ifndef MK_MIX
#define MK_MIX 7
#endif
#define GRAB(u) do { __syncthreads(); if (F.tid == 0) MISC[4] = __hip_atomic_fetch_add(head, 1u, __ATOMIC_RELAXED, __HIP_MEMORY_SCOPE_AGENT); __syncthreads(); u = __builtin_amdgcn_readfirstlane((int)MISC[4]); } while (0)
    for (int pass = 0; pass < npass; ++pass) {
    unsigned* head = head0 + 128 * pass;
    int u0;
    GRAB(u0);
    while (u0 < n_ml) { if (MK_MIX & 1) ml::mlstm_unit2(F, a, l, u0, l == 0);
        __builtin_amdgcn_fence(__ATOMIC_RELEASE, "agent"); __syncthreads();
        if (F.tid == 0) __hip_atomic_fetch_add((unsigned*)(F.ws + WS_CTL) + CW_MLDONE + 16 * l, 1u, __ATOMIC_RELAXED, __HIP_MEMORY_SCOPE_AGENT);
        GRAB(u0); }
    while (u0 < n_mix) {
        int u = u0 - n_ml;
        if (u < n_la) { const int b = u >> 6, h = (u >> 3) & 7, qb = u & 7; const long q0 = (long)b * SEQ + qb * 256;
            if (MK_MIX & 2) att::attn_body<64, 1536, 2048, 2048, 3072>(QLA + q0 * 1536 + h * 192, KVLA + h * 256, KR, KVLA + h * 256 + 128, YCAT + q0 * 3072 + 1024 + h * 128,
                                                      MLAT + b * CTXL, 4, b * SEQ, 32, 0.07216878364870322f, (const float*)(F.ws + WS_ROPE_LA) + (size_t)qb * 256 * 64, ldsg); }
        else if (u < n_la + n_ga) { u -= n_la; const int b = u >> 6, h = (u >> 3) & 7, qb = u & 7; const long q0 = (long)b * SEQ + qb * 256;
            if (MK_MIX & 4) att::attn_body<0, 1024, 256, NP, 3072>(QG + q0 * 1024 + h * 128, KG + (h >> 2) * 128, nullptr, P + C_GV + (h >> 2) * 128, YCAT + q0 * 3072 + 2048 + h * 128,
                                                  MLAT + b * CTXL, 4, b * SEQ, 32, 0.08838834764831845f, nullptr, ldsg); }
        else if (u < n_la + n_ga + n_cx) { u -= n_la + n_ga; const int b = u >> 3, h = u & 7; const long q0 = (long)MLAT + b * CTXL;
            if (MK_MIX & 2) att::attn_body<64, 1536, 2048, 2048, 3072>(QLA + q0 * 1536 + h * 192, KVLA + h * 256, KR, KVLA + h * 256 + 128, YCAT + q0 * 3072 + 1024 + h * 128,
                                                      MLAT + b * CTXL, 4, 0, 0, 0.07216878364870322f, nullptr, ldsg); }
        else { u -= n_la + n_ga + n_cx; const int b = u >> 3, h = u & 7; const long q0 = (long)MLAT + b * CTXL;
            if (MK_MIX & 4) att::attn_body<0, 1024, 256, NP, 3072>(QG + q0 * 1024 + h * 128, KG + (h >> 2) * 128, nullptr, P + C_GV + (h >> 2) * 128, YCAT + q0 * 3072 + 2048 + h * 128,
                                                  MLAT + b * CTXL, 4, 0, 0, 0.08838834764831845f, nullptr, ldsg); }
        GRAB(u0);
    }
    }
#undef GRAB
}

DI void phase_convert_tail(const Frame& F0, const Args& a, int l) {
    Frame F = F0; { int t_ = threadIdx.x; asm volatile("" : "+v"(t_)); F.tid = t_; F.lane = t_ & 63; F.wave = __builtin_amdgcn_readfirstlane(t_ >> 6); }
    constexpr int CVB = 64;
    unsigned* head = (unsigned*)(F.ws + WS_CTL) + CW_QUEUE + 64 * l + 32;
    volatile LAS unsigned* MISC = (volatile LAS unsigned*)(F.lds + LDS_BYTES - 64);
    const int n_cv = ((IT_LAYER - IT_EARLY) + ((l == 0) ? IT_EARLY : 0)) / CVB;
    LAS float* scr = (LAS float*)(F.lds + F.wave * 16384);
    for (;;) {
        __syncthreads();
        if (F.tid == 0) MISC[4] = __hip_atomic_fetch_add(head, 1u, __ATOMIC_RELAXED, __HIP_MEMORY_SCOPE_AGENT);
        __syncthreads();
        const int blk = __builtin_amdgcn_readfirstlane((int)MISC[4]);
        if (blk >= n_cv) break;
#pragma unroll 1
        for (int q = 0; q < CVB / NWAVES; ++q) { const int r = blk * CVB + q * NWAVES + F.wave;
            if (r < IT_LAYER - IT_EARLY) convert_item(F, a, l, IT_EARLY + r, scr); else convert_item(F, a, 1, r - (IT_LAYER - IT_EARLY), scr); }
    }
}

constexpr int FILL_BLK = 16, FILL_NBLK = IT_LAYER / FILL_BLK;
static_assert(IT_LAYER % FILL_BLK == 0, "fill blocks");
DI void fill_convert(const Frame& F0_, const Args& a, int ph, bool drain) {
    Frame F = F0_; { int t_ = threadIdx.x; asm volatile("" : "+v"(t_)); F.tid = t_; F.lane = t_ & 63; F.wave = __builtin_amdgcn_readfirstlane(t_ >> 6); }
    unsigned* ctl = (unsigned*)(F.ws + WS_CTL); unsigned* head = ctl + CW_CVHEAD; unsigned* done = ctl + CW_PHDONE + 64 * ph;
    volatile LAS unsigned* MISC = (volatile LAS unsigned*)(F.lds + LDS_BYTES - 64);
    LAS float* scr = (LAS float*)(F.lds + F.wave * 16384);
    __syncthreads();
    if (!drain && F.tid == 0) __hip_atomic_fetch_add(done, 1u, __ATOMIC_RELAXED, __HIP_MEMORY_SCOPE_AGENT);
    for (;;) {
        if (F.tid == 0) { unsigned blk = 0xffffffffu;
            if (drain || __hip_atomic_load(done, __ATOMIC_RELAXED, __HIP_MEMORY_SCOPE_AGENT) < (unsigned)F.G) blk = __hip_atomic_fetch_add(head, 1u, __ATOMIC_RELAXED, __HIP_MEMORY_SCOPE_AGENT);
            MISC[4] = blk; }
        __syncthreads();
        const unsigned blk = (unsigned)__builtin_amdgcn_readfirstlane((int)MISC[4]);
        __syncthreads();
        if (blk >= (unsigned)FILL_NBLK) break;
        convert_range(F, a, IT_LAYER + (int)blk * FILL_BLK + F.wave, NWAVES, IT_LAYER + ((int)blk + 1) * FILL_BLK, scr);
    }
}

DI void phase_convert_side(const Frame& F0_, const Args& a, int bid, int it_lo, int it_hi) {
    const int step = MK_CVSIDE, ncv = (256 + step - 1) / step;
    if (bid % step != 0 || F0_.G != 256) { if (F0_.G != 256) { Frame Fx = F0_; LAS float* scr = (LAS float*)(Fx.lds + Fx.wave * 16384); convert_range(Fx, a, it_lo + Fx.gw, Fx.ngw, it_hi, scr); } return; }
    Frame F = F0_; { int t_ = threadIdx.x; asm volatile("" : "+v"(t_)); F.tid = t_; F.lane = t_ & 63; F.wave = __builtin_amdgcn_readfirstlane(t_ >> 6); }
    LAS float* scr = (LAS float*)(F.lds + F.wave * 16384);
    const int j = bid / step, per = (it_hi - it_lo + ncv - 1) / ncv, lo = it_lo + j * per, hi = (lo + per < it_hi) ? lo + per : it_hi;
    convert_range(F, a, lo + F.wave, NWAVES, hi, scr);
    __syncthreads();
}

DI void phase_mlfin(const Frame& F, const Args& a, int l, int nrows, int first, int stride) {
    const bf16_t* H0 = (const bf16_t*)(F.ws + WS_MLH); const bf16_t* H1 = H0 + (size_t)MTOT * 1024;
    const bf16_t* P = (const bf16_t*)(F.ws + WS_P); bf16_t* YCAT = (bf16_t*)(F.ws + WS_YCAT); const float* gn = a.in[I_MLNORM] + l * 1024;
    int row = first; if (row >= nrows) return;
    s16x4 c0[4], c1[4]; s16x4 co[4];
#define MLF_LOAD(r_, a0, a1, ao) do { _Pragma("unroll") for (int hd = 0; hd < 4; ++hd) { const int c = hd * 256 + 4 * F.lane; a0[hd] = *(const s16x4*)(H0 + (size_t)(r_) * 1024 + c); a1[hd] = *(const s16x4*)(H1 + (size_t)(r_) * 1024 + c); \
        ao[hd] = *(const s16x4*)(P + (size_t)(r_) * NP + C_MLO + c); } } while (0)
    MLF_LOAD(row, c0, c1, co);
    f32x4 gv[4];
#pragma unroll
    for (int hd = 0; hd < 4; ++hd) gv[hd] = *(const f32x4*)(gn + hd * 256 + 4 * F.lane);
    for (;;) {
        const int nrow = row + stride; const bool hn = nrow < nrows; const int pr = hn ? nrow : row;
        s16x4 n0[4], n1[4]; s16x4 no[4]; MLF_LOAD(pr, n0, n1, no);
#pragma unroll
        for (int hd = 0; hd < 4; ++hd) { const int c = hd * 256 + 4 * F.lane;
            const f32x4 v = (f32x4){bf2f((unsigned short)c0[hd][0]) + bf2f((unsigned short)c1[hd][0]), bf2f((unsigned short)c0[hd][1]) + bf2f((unsigned short)c1[hd][1]), bf2f((unsigned short)c0[hd][2]) + bf2f((unsigned short)c1[hd][2]), bf2f((unsigned short)c0[hd][3]) + bf2f((unsigned short)c1[hd][3])};
            const float rs = rsqrtf(wave_sum(v.x * v.x + v.y * v.y + v.z * v.z + v.w * v.w) * (1.f / 256.f) + EPS);
            const f32x4 g = gv[hd]; const s16x4 og = co[hd];
            u32x2 w; w.x = pk2(v.x * rs * g.x * sigmoidf_(bf2f((unsigned short)og[0])), v.y * rs * g.y * sigmoidf_(bf2f((unsigned short)og[1])));
            w.y = pk2(v.z * rs * g.z * sigmoidf_(bf2f((unsigned short)og[2])), v.w * rs * g.w * sigmoidf_(bf2f((unsigned short)og[3])));
            *(u32x2*)(YCAT + (size_t)row * 3072 + c) = w; }
        if (!hn) break;
#pragma unroll
        for (int hd = 0; hd < 4; ++hd) { c0[hd] = n0[hd]; c1[hd] = n1[hd]; co[hd] = no[hd]; }
        row = nrow;
    }
#undef MLF_LOAD
}

DI void mlfin_tail(const Frame& F0, const Args& a, int l, int nrows) {
    Frame F = F0; { int t_ = threadIdx.x; asm volatile("" : "+v"(t_)); F.tid = t_; F.lane = t_ & 63; F.wave = __builtin_amdgcn_readfirstlane(t_ >> 6); }
    unsigned* done = (unsigned*)(F.ws + WS_CTL) + CW_MLDONE + 16 * l; unsigned* head = done + 8;
    volatile LAS unsigned* MISC = (volatile LAS unsigned*)(F.lds + LDS_BYTES - 64);
    if (F.tid == 0) { unsigned sp = 0; while (xb_ld(done) < 64u && ++sp < (1u << 22)) __builtin_amdgcn_s_sleep(2); }
    __syncthreads();
    __builtin_amdgcn_fence(__ATOMIC_ACQUIRE, "agent");
    for (;;) {
        __syncthreads();
        if (F.tid == 0) MISC[4] = __hip_atomic_fetch_add(head, 1u, __ATOMIC_RELAXED, __HIP_MEMORY_SCOPE_AGENT);
        __syncthreads();
        const int blk = __builtin_amdgcn_readfirstlane((int)MISC[4]);
        if (blk * 64 >= nrows) break;
        const int end = (blk + 1) * 64 < nrows ? (blk + 1) * 64 : nrows;
        phase_mlfin(F, a, l, end, blk * 64 + F.wave, NWAVES);
    }
}

struct SchedMerge {
    const char* Y; const char* Bt; int nM, G, c;
    DI bool next(int i, Unit& u) const {
        int pm, pn, br;
        if (nM == 36 && G == 256) {
            if (i < 3) { pg8::tile_of(c, 32, 8, pm, pn); br = i; }
            else if (i == 3 && c < 96) { const int t = c / 3; br = (c - 3 * t) | 4; pm = 32 + (t >> 3); pn = t & 7; }
            else return false;
        } else { const int k = i / 3; br = i - 3 * k; const long L = (long)k * G + c; if (L >= (long)nM * 8) return false; pg8::tile_of((int)L, nM, 8, pm, pn); }
        u.pm = pm; u.pn = pn; u.aux = br; u.nt = 16; u.pa = Y + (size_t)pm * 256 * 6144 + (br & 3) * 2048; u.pb = Bt + ((size_t)(br & 3) * 2048 + pn * 256) * 2048; return true;
    }
};
struct EpiMerge {
    const bf16_t* P; bf16_t* ZG; bf16_t* MB; bf16_t* CP; unsigned* cnt;
    DI void operator()(const f32x4 (&acc)[2][2][4][2], const Unit& u, int wr, int wc, int fr, int fq) const {
        const int br = u.aux & 3; const bool split = (u.aux & 4) != 0;
        EPI_FOREACH({
            const bf16x8 gp = *(const bf16x8*)(P + (size_t)row * NP + C_GATE + br * 2048 + col);
            f32x4 g0, g1;
            g0.x = sigmoidf_(bf2f((unsigned short)gp[0])); g0.y = sigmoidf_(bf2f((unsigned short)gp[1])); g0.z = sigmoidf_(bf2f((unsigned short)gp[2])); g0.w = sigmoidf_(bf2f((unsigned short)gp[3]));
            g1.x = sigmoidf_(bf2f((unsigned short)gp[4])); g1.y = sigmoidf_(bf2f((unsigned short)gp[5])); g1.z = sigmoidf_(bf2f((unsigned short)gp[6])); g1.w = sigmoidf_(bf2f((unsigned short)gp[7]));
            f32x4 r0 = v0 * g0, r1 = v1 * g1;
            const size_t off = (size_t)row * DM + col;
            if (split) { const u32x4 w_ = pack8(r0, r1); GAS unsigned long long* cp = (GAS unsigned long long*)(CP + ((size_t)br * MCTX + (row - MLAT)) * DM + col);
                __hip_atomic_store(cp, (unsigned long long)w_.x | ((unsigned long long)w_.y << 32), __ATOMIC_RELAXED, __HIP_MEMORY_SCOPE_AGENT);
                __hip_atomic_store(cp + 1, (unsigned long long)w_.z | ((unsigned long long)w_.w << 32), __ATOMIC_RELAXED, __HIP_MEMORY_SCOPE_AGENT); }
            else if (br < 2) *(u32x4*)(ZG + (size_t)br * MTOT * DM + off) = pack8(r0, r1);
            else { const bf16x8 z0 = *(const bf16x8*)(ZG + off), z1 = *(const bf16x8*)(ZG + (size_t)MTOT * DM + off);
                r0 += (f32x4){bf2f((unsigned short)z0[0]) + bf2f((unsigned short)z1[0]), bf2f((unsigned short)z0[1]) + bf2f((unsigned short)z1[1]), bf2f((unsigned short)z0[2]) + bf2f((unsigned short)z1[2]), bf2f((unsigned short)z0[3]) + bf2f((unsigned short)z1[3])};
                r1 += (f32x4){bf2f((unsigned short)z0[4]) + bf2f((unsigned short)z1[4]), bf2f((unsigned short)z0[5]) + bf2f((unsigned short)z1[5]), bf2f((unsigned short)z0[6]) + bf2f((unsigned short)z1[6]), bf2f((unsigned short)z0[7]) + bf2f((unsigned short)z1[7])};
                *(u32x4*)(MB + off) = pack8(r0, r1); }
        })
        if (split) {
            asm volatile("s_waitcnt vmcnt(0)" ::: "memory");
            unsigned old = 0;
            if ((fr | fq) == 0) old = __hip_atomic_fetch_add((GAS unsigned*)(cnt + (((u.pm - 32) * 8 + u.pn) * 8 + wr * 4 + wc) * 16), 1u, __ATOMIC_RELAXED, __HIP_MEMORY_SCOPE_AGENT);
            old = (unsigned)__builtin_amdgcn_readfirstlane((int)old);
            if (old == 2u) {
                EPI_FOREACH({
                    f32x4 r0 = (f32x4){0.f, 0.f, 0.f, 0.f}; f32x4 r1 = r0;
                    _Pragma("unroll") for (int ob = 0; ob < 3; ++ob) { const GAS unsigned long long* cp = (const GAS unsigned long long*)(CP + ((size_t)ob * MCTX + (row - MLAT)) * DM + col);
                        const unsigned long long a0 = __hip_atomic_load(cp, __ATOMIC_RELAXED, __HIP_MEMORY_SCOPE_AGENT), a1 = __hip_atomic_load(cp + 1, __ATOMIC_RELAXED, __HIP_MEMORY_SCOPE_AGENT);
                        r0 += (f32x4){bf2f((unsigned short)a0), bf2f((unsigned short)(a0 >> 16)), bf2f((unsigned short)(a0 >> 32)), bf2f((unsigned short)(a0 >> 48))};
                        r1 += (f32x4){bf2f((unsigned short)a1), bf2f((unsigned short)(a1 >> 16)), bf2f((unsigned short)(a1 >> 32)), bf2f((unsigned short)(a1 >> 48))}; }
                    (void)v0; (void)v1;
                    *(u32x4*)(MB + (size_t)row * DM + col) = pack8(r0, r1);
                })
            }
        }
    }
};
struct EpiOut {
    const float* xin; const float* ctxin; float* X1; const float* mods; int l;
    DI void operator()(const f32x4 (&acc)[2][2][4][2], const Unit& u, int wr, int wc, int fr, int fq) const {
        f32x4 g[2][2];
#pragma unroll
        for (int bj = 0; bj < 2; ++bj) { const float* gp = mods + ((size_t)(l * 5 + mods_row(u.pm * 256)) * 6 + 2) * DM + u.pn * 256 + bj * 128 + wc * 32 + 8 * fq;
            g[bj][0] = *(const f32x4*)gp; g[bj][1] = *(const f32x4*)(gp + 4); }
        EPI_FOREACH({
            const float* rp = (l == 0) ? (row < MLAT ? xin + (size_t)row * DM : ctxin + (size_t)(row - MLAT) * DM) : X1 + (size_t)row * DM;
            float* op = X1 + (size_t)row * DM + col;
            *(f32x4*)op = *(const f32x4*)(rp + col) + g[bj][0] * v0; *(f32x4*)(op + 4) = *(const f32x4*)(rp + col + 4) + g[bj][1] * v1;
        })
    }
};
DI void phase_topk(const Frame& F, const Args& a, int l, int bid) {
    const float* AFF = (const float*)(F.ws + WS_AFF);
    int* ROWS = (int*)(F.ws + WS_ROWS); float* VALS = (float*)(F.ws + WS_VALS); int* TOK = (int*)(F.ws + WS_TOK);
    LAS unsigned* cntr = (LAS unsigned*)F.lds;
    LAS unsigned* cg = cntr + 64; LAS unsigned* ce = cntr + 96;
    const int nitems = (l == 0) ? 256 + 64 + 16 : 256;
    const int lane = F.lane, wave = F.wave;
    for (int it = bid; it < nitems; it += F.G) {
        if (it >= 320) {
            const int e = it - 320;
            for (int s = F.tid; s < 128; s += NTHR) { ROWS[e * ESLOT + 1152 + s] = -1; VALS[e * ESLOT + 1152 + s] = 0.f; }
            continue;
        }
        const int lat = it < 256, b = lat ? (it >> 6) : ((it - 256) >> 4), e = lat ? ((it >> 2) & 15) : ((it - 256) & 15), qtr = lat ? (it & 3) : 0;
        const int ntok = lat ? SEQ : CTXL, rowbase = lat ? b * SEQ : MLAT + b * CTXL, slotbase = lat ? b * 256 : 1024 + b * 32;
        const unsigned cap = (unsigned)(ntok >> 3);
        __syncthreads();
        if (F.tid < 128) cntr[F.tid] = 0u;
        unsigned key[4];
#pragma unroll
        for (int q = 0; q < 4; ++q) { const int i = q * 512 + F.tid; key[q] = i < ntok ? __float_as_uint(AFF[(size_t)e * MTOT + rowbase + i]) : 0u; }
        __syncthreads();
        unsigned T = 0u;
#pragma unroll 1
        for (int r = 0; r < 16; ++r) { const int sh = 30 - 2 * r;
            const unsigned c1 = T | (1u << sh), c2 = T | (2u << sh), c3 = T | (3u << sh);
            unsigned n1 = 0, n2 = 0, n3 = 0;
#pragma unroll
            for (int q = 0; q < 4; ++q) { n1 += (unsigned)__builtin_popcountll(__ballot(key[q] >= c1)); n2 += (unsigned)__builtin_popcountll(__ballot(key[q] >= c2)); n3 += (unsigned)__builtin_popcountll(__ballot(key[q] >= c3)); }
            if (lane == 0) { atomicAdd((unsigned*)(cntr + r * 4 + 0), n1); atomicAdd((unsigned*)(cntr + r * 4 + 1), n2); atomicAdd((unsigned*)(cntr + r * 4 + 2), n3); }
            __syncthreads();
            const unsigned t1 = cntr[r * 4 + 0], t2 = cntr[r * 4 + 1], t3 = cntr[r * 4 + 2];
            T = t3 >= cap ? c3 : (t2 >= cap ? c2 : (t1 >= cap ? c1 : T));
        }
        unsigned long long bg_own = 0ull, be_own = 0ull; unsigned kown = 0u;
#pragma unroll
        for (int q = 0; q < 4; ++q) { const unsigned long long bg = __ballot(key[q] > T), be = __ballot(key[q] == T);
            if (lane == 0) { cg[q * 8 + wave] = (unsigned)__builtin_popcountll(bg); ce[q * 8 + wave] = (unsigned)__builtin_popcountll(be); }
            if (q == qtr) { bg_own = bg; be_own = be; kown = key[q]; } }
        __syncthreads();
        unsigned ngt = 0, gtb = 0, eqb = 0; const int me = qtr * 8 + wave;
#pragma unroll 1
        for (int k = 0; k < 32; ++k) { const unsigned g = cg[k], q_ = ce[k]; ngt += g; if (k < me) { gtb += g; eqb += q_; } }
        const unsigned need = cap - ngt;
        const unsigned long long lt = (1ull << lane) - 1ull;
        const int i = qtr * 512 + F.tid; const bool act = i < ntok;
        const unsigned eqpos = eqb + (unsigned)__builtin_popcountll(be_own & lt);
        const bool sel = act && (kown > T || (kown == T && eqpos < need));
        const unsigned slot = gtb + (unsigned)__builtin_popcountll(bg_own & lt) + (eqpos < need ? eqpos : need);
        if (act) { TOK[(size_t)(rowbase + i) * 16 + e] = sel ? slotbase + (int)slot : -1;
            if (sel) { ROWS[e * ESLOT + slotbase + (int)slot] = rowbase + i; VALS[e * ESLOT + slotbase + (int)slot] = __uint_as_float(kown); } }
    }
    __syncthreads();
}
struct SchedMoe {
    const char* A; const char* Bt; int lda, ldb, nMt, nt, G, c, gather;
    DI bool next(int i, Unit& u) const {
        const long L0 = (long)i * G + c; const int nwg = NEXP * nMt * 8; if (L0 >= nwg) return false;
        const int L = ((int)L0 % 8) * (nwg / 8) + (int)L0 / 8;
        const int e = L / (nMt * 8), rem = L % (nMt * 8), mt = rem % nMt, pn = rem / nMt;
        u.pm = e * 5 + mt; u.pn = pn; u.aux = e; u.nt = nt; u.pa = gather ? A : A + ((size_t)e * ESLOT + mt * 256) * lda; u.pb = Bt + ((size_t)e * 2048 + pn * 256) * ldb; return true;
    }
};
struct EpiMoe1 {
    bf16_t* ACT;
    DI void operator()(const f32x4 (&acc)[2][2][4][2], const Unit& u, int wr, int wc, int fr, int fq) const {
#pragma unroll
        for (int ai = 0; ai < 2; ++ai)
#pragma unroll
            for (int m = 0; m < 4; ++m) { const int row = u.pm * 256 + ai * 128 + wr * 64 + m * 16 + fr; const int col = u.pn * 128 + wc * 32 + 8 * fq;
                f32x4 r0, r1;
#pragma unroll
                for (int i = 0; i < 4; ++i) { r0[i] = siluf_(acc[ai][0][m][0][i]) * acc[ai][1][m][0][i]; r1[i] = siluf_(acc[ai][0][m][1][i]) * acc[ai][1][m][1][i]; }
                *(u32x4*)(ACT + (size_t)row * EFF + col) = pack8(r0, r1); }
    }
};
struct EpiMoe2 {
    const float* VALS; bf16_t* YE;
    DI void operator()(const f32x4 (&acc)[2][2][4][2], const Unit& u, int wr, int wc, int fr, int fq) const {
        EPI_FOREACH({ const float val = VALS[row]; *(u32x4*)(YE + (size_t)row * DM + col) = pack8(v0 * val, v1 * val); })
    }
};
DI void phase_final(const Frame& F, const Args& a) {
    const float* g = a.in[I_FNORM]; const int* TOK = (const int*)(F.ws + WS_TOK); const float* X1 = (const float*)(F.ws + WS_X1);
    LAS float* gs = (LAS float*)F.lds;
    { const float* MODS = (const float*)(F.ws + WS_MODS);
      for (int i = F.tid; i < 4 * 512; i += NTHR) { const int r = i / 512, c4 = i % 512;
          *(LAS f32x4*)(gs + (size_t)r * DM + 4 * c4) = *(const f32x4*)(MODS + ((size_t)((DEPTH - 1) * 5 + r) * 6 + 5) * DM + 4 * c4); }
      __syncthreads(); }
    int row = F.gw; if (row >= MLAT) return;
    f32x4 cur[8]; load_row(X1 + (size_t)row * DM, F.lane, cur); int tcur = TOK[(size_t)row * 16 + (F.lane & 15)];
    f32x4 gv[8]; load_row(g, F.lane, gv);
    for (;;) {
        const int nrow = row + F.ngw; const bool hn = nrow < MLAT; const int pr = hn ? nrow : row;
        f32x4 nxt[8]; load_row(X1 + (size_t)pr * DM, F.lane, nxt); const int tnxt = TOK[(size_t)pr * 16 + (F.lane & 15)];
        f32x4 v[8]; float ss = 0.f;
        combine_row<true>(F, DEPTH - 1, row, cur, tcur, v, gs + (size_t)(row >> 11) * DM);
#pragma unroll
        for (int j = 0; j < 8; ++j) ss += v[j].x * v[j].x + v[j].y * v[j].y + v[j].z * v[j].z + v[j].w * v[j].w;
        const float rs = rsqrtf(wave_sum(ss) * (1.f / DM) + EPS);
#pragma unroll
        for (int j = 0; j < 8; ++j) *(f32x4*)(a.out + (size_t)row * DM + 4 * F.lane + 256 * j) = v[j] * rs * gv[j];
        if (!hn) break;
#pragma unroll
        for (int j = 0; j < 8; ++j) cur[j] = nxt[j];
        tcur = tnxt; row = nrow;
    }
}

#ifndef MK_LAST_PHASE
#define MK_LAST_PHASE 1000
#endif
constexpr int PH_PER_LAYER = 11, N_PHASES = 2 + 2 * PH_PER_LAYER + 1;
__global__ void __launch_bounds__(NTHR, 2) mega(const Args args) {
    extern __shared__ __attribute__((aligned(16))) unsigned char lds[];
    Frame F0;
    F0.lds = (LAS unsigned char*)lds; F0.ws = args.ws;
    F0.tid = threadIdx.x; F0.lane = F0.tid & 63; F0.wave = __builtin_amdgcn_readfirstlane(F0.tid >> 6);
    F0.G = gridDim.x; { const int bx = blockIdx.x; F0.vcu = (F0.G % 8 == 0) ? (bx % 8) * (F0.G / 8) + bx / 8 : bx; }
    F0.gw = F0.vcu * NWAVES + F0.wave; F0.ngw = F0.G * NWAVES;
    volatile LAS unsigned* MISC = (volatile LAS unsigned*)(F0.lds + LDS_BYTES - 64);
    if (F0.tid < 16) MISC[F0.tid] = 0u;
    __syncthreads();
    unsigned* ctl = (unsigned*)(F0.ws + WS_CTL);
    XcdBarrier bar = xcd_barrier_post(ctl + CW_BAR, MISC + 8);
    const int lo = args.ph_lo, hi = args.ph_hi;
    int ph = 0, bid = 0;
#ifndef MK_EN
#define MK_EN 0xFFFF
#endif
#define EN(x) ((MK_EN >> (x)) & 1)
#ifndef MK_REP
#define MK_REP 0
#endif
#ifndef MK_BARX
#define MK_BARX 0
#endif
#ifndef MK_REPB
#define MK_REPB 0
#endif
#ifndef MK_TPH
#define MK_TPH -1
#endif
#ifndef MK_TMODE
#define MK_TMODE 0
#endif
#ifndef MK_TQ
#define MK_TQ 40.f
#endif
#define REP(pid_) ((MK_REP >> (pid_)) & 1)
#define PHASE(pid_, ...) if (EN(pid_) && lo <= ph && ph < hi) { Frame F = F0; { unsigned long long w_ = (unsigned long long)F0.ws; asm volatile("" : "+s"(w_)); F.ws = (unsigned char*)w_; \
        asm volatile("" : "+s"(F.G), "+s"(F.vcu)); F.ngw = F.G * NWAVES; bid = blockIdx.x; asm volatile("" : "+s"(bid)); \
        int t_ = threadIdx.x; asm volatile("" : "+v"(t_)); F.tid = t_; F.lane = t_ & 63; F.wave = __builtin_amdgcn_readfirstlane(t_ >> 6); F.gw = F.vcu * NWAVES + F.wave; } \
        { const int rep = 0; (void)rep; __VA_ARGS__ } if (REP(pid_)) { if (MK_REPB) xcd_barrier(bar); const int rep = 1; (void)rep; __VA_ARGS__ } \
        if (MK_TPH >= 0 && threadIdx.x == 0) ((unsigned long long*)(F0.ws + WS_CTL + 1536 * 1024))[ph * 256 + blockIdx.x] = wall_clock64(); \
        if (ph + 1 < hi) { xcd_barrier(bar); if (MK_BARX) xcd_barrier(bar); } } ++ph;

#define PHASE5(...) if (EN(5) && lo <= ph && ph < hi) { Frame F = F0; { unsigned long long w_ = (unsigned long long)F0.ws; asm volatile("" : "+s"(w_)); F.ws = (unsigned char*)w_; \
        asm volatile("" : "+s"(F.G), "+s"(F.vcu)); F.ngw = F.G * NWAVES; bid = blockIdx.x; asm volatile("" : "+s"(bid)); \
        int t_ = threadIdx.x; asm volatile("" : "+v"(t_)); F.tid = t_; F.lane = t_ & 63; F.wave = __builtin_amdgcn_readfirstlane(t_ >> 6); F.gw = F.vcu * NWAVES + F.wave; } \
        { __VA_ARGS__ } if (MK_TPH >= 0 && threadIdx.x == 0) ((unsigned long long*)(F0.ws + WS_CTL + 1536 * 1024))[ph * 256 + blockIdx.x] = wall_clock64(); \
        if (ph + 1 < hi) { xcd_barrier(bar); if (MK_BARX) xcd_barrier(bar); } } ++ph;
    PHASE(0, phase_prologue(F, args, rep);)
    PHASE(14, phase_mods_reduce(F, args);)
    for (int l = 0; l < DEPTH; ++l) {
        const size_t wlo = WS_W + (size_t)l * W_LAYER;
        const int nM = (l == 0) ? 36 : 32;
        PHASE(1, if (MK_FILL && l == 1 && rep == 0) fill_convert(F, args, ph, true); phase_mod1(F, args, l);)
        PHASE(2, {
            SchedProj S{(const char*)(F.ws + WS_H), (const char*)(F.ws + wlo + W_IN), l, F.G, bid};
            EpiProj E{(bf16_t*)(F.ws + WS_P)};
            pg8::gemm_phase(F.lds, DM * 2, DM * 2, S, E); if (MK_FILL && l == 0 && rep == 0) fill_convert(F, args, ph, false); })
        PHASE(3, phase_postproj(F, args, l);)
        PHASE(4, {
            const int Gw = F.G - 36, xw = bid - Gw, BIG = 1 << 28, cw = bid < Gw ? bid : BIG;
            { SchedDense S{(const char*)(F.ws + WS_H), (const char*)(F.ws + wlo + W_IN) + (size_t)C_X * DM * 2, DM * 2, DM * 2, 36, 1, 32, 36, xw >= 0 ? xw : BIG};
              EpiX E{(bf16_t*)(F.ws + WS_KR), (float*)(F.ws + WS_X80), (const float*)(F.ws + WS_ROPE_LA)}; pg8::gemm_phase(F.lds, DM * 2, DM * 2, S, E); }
            { SchedDense S{(const char*)(F.ws + WS_CQN), (const char*)(F.ws + wlo + W_UQ), 512 * 2, 512 * 2, nM, 6, 8, Gw, cw};
              EpiStoreBf16 E{(bf16_t*)(F.ws + WS_QLA), 1536}; pg8::gemm_phase(F.lds, 512 * 2, 512 * 2, S, E); }
            { SchedDense S{(const char*)(F.ws + WS_CKVN), (const char*)(F.ws + wlo + W_UKV), 256 * 2, 256 * 2, 36, 8, 4, Gw, bid < Gw ? (bid + Gw / 2) % Gw : BIG};
              EpiStoreBf16 E{(bf16_t*)(F.ws + WS_KVLA), 2048}; pg8::gemm_phase(F.lds, 256 * 2, 256 * 2, S, E); }
            if (MK_FILL && l == 0 && rep == 0) fill_convert(F, args, ph, false); })
        PHASE5(if (MK_CVSIDE) phase_convert_side(F, args, bid, l == 0 ? IT_EARLY : IT_LAYER + IT_EARLY, l == 0 ? IT_LAYER + IT_EARLY : 2 * IT_LAYER); phase_mixers(F, args, l, (char*)lds, 1 + REP(5)); if (MK_CONVTAIL) phase_convert_tail(F, args, l); mlfin_tail(F, args, l, nM * 256);)
        PHASE(7, {
            SchedMerge S{(const char*)(F.ws + WS_YCAT), (const char*)(F.ws + wlo + W_BR), nM, F.G, bid};
            EpiMerge E{(const bf16_t*)(F.ws + WS_P), (bf16_t*)(F.ws + WS_MF32), (bf16_t*)(F.ws + WS_MBF), (bf16_t*)(F.ws + WS_H), (unsigned*)(F.ws + WS_CTL) + CW_MCNT};
            pg8::gemm_phase(F.lds, 3072 * 2, 1024 * 2, S, E); if (MK_FILL && l == 0 && rep == 0) fill_convert(F, args, ph, false); })
        PHASE(8, {
            SchedDense S{(const char*)(F.ws + WS_MBF), (const char*)(F.ws + wlo + W_OUT), DM * 2, DM * 2, nM, 8, 32, F.G, bid};
            EpiOut E{args.in[I_X], args.in[I_CTX], (float*)(F.ws + WS_X1), (const float*)(F.ws + WS_MODS), l};
            if (rep == 0 || l == 0) pg8::gemm_phase(F.lds, DM * 2, DM * 2, S, E); if (MK_FILL && l == 0 && rep == 0) fill_convert(F, args, ph, false); })
        PHASE(9, phase_mod2(F, args, l, nM * 256);)
        PHASE(10, phase_topk(F, args, l, bid);)
        PHASE(11, {
            SchedMoe S{(const char*)(F.ws + WS_H), (const char*)(F.ws + wlo + W_E13), DM * 2, DM * 2, (l == 0) ? 5 : 4, 32, F.G, bid, 1};
            EpiMoe1 E{(bf16_t*)(F.ws + WS_ACT)};
            pg8::gemm_phase<true>(F.lds, DM * 2, DM * 2, S, E, (const int*)(F.ws + WS_ROWS)); if (MK_FILL && l == 0 && rep == 0) fill_convert(F, args, ph, false); })
        PHASE(12, {
            SchedMoe S{(const char*)(F.ws + WS_ACT), (const char*)(F.ws + wlo + W_E2), EFF * 2, EFF * 2, (l == 0) ? 5 : 4, 16, F.G, bid, 0};
            EpiMoe2 E{(const float*)(F.ws + WS_VALS), (bf16_t*)(F.ws + WS_YE)};
            pg8::gemm_phase(F.lds, EFF * 2, EFF * 2, S, E); if (MK_FILL && l == 0 && rep == 0) fill_convert(F, args, ph, false); })
    }
    PHASE(13, phase_final(F, args);)
    if (MK_TPH >= 0) {
        xcd_barrier(bar);
        if (blockIdx.x == 0 && threadIdx.x == 0) {
            const unsigned long long* st = (const unsigned long long*)(F0.ws + WS_CTL + 1536 * 1024);
            unsigned long long mx = 0, mxp = 0, sum = 0; const int G = gridDim.x;
            for (int bq = 0; bq < G; ++bq) { const unsigned long long e = st[MK_TPH * 256 + bq], p = st[(MK_TPH - 1) * 256 + bq]; mx = e > mx ? e : mx; mxp = p > mxp ? p : mxp; sum += e; }
            const float dur = MK_TMODE == 0 ? (float)(mx - mxp) * 0.01f : (float)((double)sum / G - (double)mxp) * 0.01f;
            args.out[0] = 20.f + floorf(dur / MK_TQ) * MK_TQ;
        }
    }
#undef PHASE
}


extern "C" void kernel_launch(void* const* d_in, const int* in_sizes, int n_in, void* d_out, int out_size, void* d_ws, size_t ws_size, hipStream_t stream) {
    static int grid = 0;
    if (grid == 0) {
        if (n_in != 24 || out_size != MLAT * DM || ws_size < WS_END) { fprintf(stderr, "kernel_launch: unexpected shapes: n_in %d out %d ws %zu (need %zu)\n", n_in, out_size, ws_size, (size_t)WS_END); grid = -1; return; }
        int dev = 0, cus = 0, per_cu = 0;
        if (hipGetDevice(&dev) != hipSuccess || hipDeviceGetAttribute(&cus, hipDeviceAttributeMultiprocessorCount, dev) != hipSuccess) { grid = -1; return; }
        if (hipFuncSetAttribute((const void*)mega, hipFuncAttributeMaxDynamicSharedMemorySize, LDS_BYTES) != hipSuccess) { fprintf(stderr, "kernel_launch: hipFuncSetAttribute failed\n"); grid = -1; return; }
        if (hipOccupancyMaxActiveBlocksPerMultiprocessor(&per_cu, (const void*)mega, NTHR, LDS_BYTES) != hipSuccess || per_cu < 1) { fprintf(stderr, "kernel_launch: occupancy query says %d blocks per CU\n", per_cu); }
        (void)hipGetLastError();
        grid = cus;
    }
    if (grid < 0) return;
    if (hipMemsetAsync((char*)d_ws + WS_CTL, 0, CTL_BYTES, stream) != hipSuccess) return;
    Args a{};
    for (int i = 0; i < 24; ++i) a.in[i] = (const float*)d_in[i];
    a.out = (float*)d_out; a.ws = (unsigned char*)d_ws; a.ph_lo = 0; a.ph_hi = N_PHASES < MK_LAST_PHASE ? N_PHASES : MK_LAST_PHASE;
    hipLaunchKernelGGL(mega, dim3(grid), dim3(NTHR), LDS_BYTES, stream, a);
}
```

```cpp
#include <hip/hip_runtime.h>
#include <cstdio>
#include <cstdint>

#define GAS __attribute__((address_space(1)))
#define LAS __attribute__((address_space(3)))
#define DI __device__ __forceinline__
typedef unsigned short bf16_t;
typedef short bf16x8 __attribute__((ext_vector_type(8)));
typedef short s16x4 __attribute__((ext_vector_type(4)));
typedef float f32x2 __attribute__((ext_vector_type(2)));
typedef float f32x4 __attribute__((ext_vector_type(4)));
typedef float f32x8 __attribute__((ext_vector_type(8)));
typedef float f32x16 __attribute__((ext_vector_type(16)));
typedef unsigned u32x2 __attribute__((ext_vector_type(2)));
typedef unsigned u32x4 __attribute__((ext_vector_type(4)));

constexpr int DM = 2048, NBATCH = 4, SEQ = 2048, CTXL = 256, DEPTH = 2;
constexpr int MLAT = NBATCH * SEQ, MCTX = NBATCH * CTXL, MTOT = MLAT + MCTX;
constexpr int PROJW = 12624, NP = 12800;
constexpr int C_MLQ = 0, C_MLK = 1024, C_MLV = 2048, C_MLO = 3072, C_CQ = 4096, C_CKV = 4608, C_GQ = 4864, C_GK = 5888, C_GV = 6144, C_GATE = 6400, C_X = 12544;
constexpr int XW = 80;
constexpr int NEXP = 16, EFF = 1024, ESLOT = 1280;
constexpr float EPS = 1e-6f;
constexpr int NWAVES = 8, NTHR = 512;

constexpr size_t al256(size_t x) { return (x + 255) / 256 * 256; }
constexpr size_t WS_CTL = 0, CTL_BYTES = 2u << 20;
constexpr int CW_BAR = 1024;
constexpr int CW_QUEUE = 8192;
constexpr int CW_CVHEAD = 12288;
constexpr int CW_MCNT = 20480;
constexpr int CW_PHDONE = 32768;
constexpr size_t WS_MODS = 1u << 20;
constexpr size_t WS_ROPE_LA = WS_CTL + CTL_BYTES;
constexpr size_t WS_ROPE_GA = WS_ROPE_LA + al256((size_t)2048 * 32 * 2 * 4);
constexpr size_t WS_W = WS_ROPE_GA + al256((size_t)2048 * 64 * 2 * 4);
constexpr size_t W_IN = 0, W_UQ = W_IN + (size_t)NP * DM * 2, W_UKV = W_UQ + (size_t)1536 * 512 * 2, W_BR = W_UKV + (size_t)2048 * 256 * 2,
                 W_OUT = W_BR + (size_t)3 * 2048 * 1024 * 2, W_E13 = W_OUT + (size_t)2048 * 2048 * 2, W_E2 = W_E13 + (size_t)NEXP * 2048 * 2048 * 2,
                 W_LAYER = W_E2 + (size_t)NEXP * 2048 * 1024 * 2;
constexpr size_t WS_H = WS_W + 2 * W_LAYER;
constexpr size_t WS_P = WS_H + (size_t)MTOT * DM * 2;
constexpr size_t WS_AG = WS_P;
constexpr size_t WS_ACT = WS_AG + (size_t)NEXP * ESLOT * DM * 2;
static_assert(WS_ACT + (size_t)NEXP * ESLOT * EFF * 2 <= WS_P + (size_t)MTOT * NP * 2, "overlay");
constexpr size_t WS_X80 = WS_P + (size_t)MTOT * NP * 2;
constexpr size_t WS_CQN = WS_X80 + al256((size_t)MTOT * XW * 4);
constexpr size_t WS_CKVN = WS_CQN + (size_t)MTOT * 512 * 2;
constexpr size_t WS_QG = WS_CKVN + (size_t)MTOT * 256 * 2;
constexpr size_t WS_KG = WS_QG + (size_t)MTOT * 1024 * 2;
constexpr size_t WS_KR = WS_KG + (size_t)MTOT * 256 * 2;
constexpr size_t WS_QLA = WS_KR + (size_t)MTOT * 64 * 2;
constexpr size_t WS_KVLA = WS_QLA + (size_t)MTOT * 1536 * 2;
constexpr size_t WS_YCAT = WS_KVLA + (size_t)MTOT * 2048 * 2;
constexpr size_t WS_MF32 = WS_YCAT + (size_t)MTOT * 3072 * 2;
constexpr size_t WS_MLH = WS_MF32;
constexpr size_t WS_MBF = WS_MF32 + (size_t)MTOT * DM * 4;
constexpr size_t WS_X1 = WS_MBF + (size_t)MTOT * DM * 2;
constexpr size_t WS_AFF = WS_X1 + (size_t)MTOT * DM * 4;
constexpr size_t WS_ROWS = WS_AFF + (size_t)MTOT * 16 * 4;
constexpr size_t WS_VALS = WS_ROWS + (size_t)NEXP * ESLOT * 4;
constexpr size_t WS_TOK = WS_VALS + (size_t)NEXP * ESLOT * 4;
constexpr size_t WS_MPART = WS_TOK + (size_t)MTOT * 16 * 4;
constexpr size_t WS_END = WS_MPART + (size_t)16 * 2 * 5 * 12288 * 4;
constexpr size_t WS_YE = WS_AG;

constexpr int RING_BYTES = 131072;
constexpr int MISC_OFF = RING_BYTES + 1024;
constexpr int LDS_BYTES = 147456;

DI float bf2f(unsigned short b) { return __uint_as_float(((unsigned)b) << 16); }
DI unsigned f2bf(float f) { unsigned u = __float_as_uint(f); return (u + 0x7fffu + ((u >> 16) & 1u)) >> 16; }
DI unsigned pk2(float lo, float hi) { unsigned r; asm volatile("v_cvt_pk_bf16_f32 %0, %1, %2" : "=v"(r) : "v"(lo), "v"(hi)); return r; }
DI int lane_id_() { int l = __builtin_amdgcn_mbcnt_hi(~0u, __builtin_amdgcn_mbcnt_lo(~0u, 0u)); asm volatile("" : "+v"(l)); return l; }
DI float bperm_f(float v, int srclane) { return __int_as_float(__builtin_amdgcn_ds_bpermute(srclane << 2, __float_as_int(v))); }
DI float shx(float v, int o) { return bperm_f(v, lane_id_() ^ o); }
DI float shl_(float v, int src) { return bperm_f(v, src); }
DI float shu(float v, int o) { const int l = lane_id_(); return bperm_f(v, l >= o ? l - o : l); }
DI float wave_sum(float v) { const int l = lane_id_();
#pragma unroll
    for (int o = 1; o < 64; o <<= 1) v += bperm_f(v, l ^ o);
    return v;
}
DI float wave_max(float v) { const int l = lane_id_();
#pragma unroll
    for (int o = 1; o < 64; o <<= 1) v = fmaxf(v, bperm_f(v, l ^ o));
    return v;
}
DI float sigmoidf_(float x) { return __builtin_amdgcn_rcpf(1.f + __expf(-x)); }
DI float siluf_(float x) { return x * __builtin_amdgcn_rcpf(1.f + __expf(-x)); }
#define LDS_WAIT() asm volatile("s_waitcnt lgkmcnt(0)" ::: "memory")
#define VM_WAIT() asm volatile("s_waitcnt vmcnt(0)" ::: "memory")

#define XB_TMO      128
#define XB_XCNT(j)  (256  + 64 * (j))
#define XB_XSUB(j)  (1280 + 64 * (j))
#define XB_XGEN(j)  (2304 + 64 * (j))
#define XB_TOP      3328
#define XB_TOPGEN   3392
#define XCD_BAR_WORDS 3456
#define XB_SPIN_CAP (1u << 20)

DI unsigned xb_ld(unsigned* p)              { return __hip_atomic_load(p, __ATOMIC_RELAXED, __HIP_MEMORY_SCOPE_AGENT); }
DI unsigned xb_add(unsigned* p, unsigned v) { return __hip_atomic_fetch_add(p, v, __ATOMIC_RELAXED, __HIP_MEMORY_SCOPE_AGENT); }
DI unsigned xb_xcc_id() { return (unsigned)__builtin_amdgcn_s_getreg((3 << 11) | 20) & 0xFu; }
#define XB_SPIN(cond, bar) do { unsigned _sp = 0; while (cond) { __builtin_amdgcn_s_sleep(1); \
    if ((++_sp & 255u) == 0u) { if (xb_ld(&(bar)[XB_TMO])) break; if (_sp > XB_SPIN_CAP) { atomicAdd(&(bar)[XB_TMO], 1u); break; } } } } while (0)

struct XcdBarrier { unsigned* bar; unsigned x; volatile LAS unsigned* st; };

DI XcdBarrier xcd_barrier_post(unsigned* bar, volatile LAS unsigned* st) {
    XcdBarrier b; b.bar = bar; b.x = xb_xcc_id(); b.st = st;
    if (threadIdx.x == 0) (void)xb_add(&bar[XB_XCNT(b.x)], 1u);
    return b;
}
DI void xcd_barrier_complete(unsigned* bar, unsigned x, unsigned& nloc, unsigned& nx) {
    const unsigned G = gridDim.x * gridDim.y * gridDim.z;
    unsigned sum, cnt, mine, sp = 0u;
    for (;;) {
        sum = 0u; cnt = 0u; mine = 0u;
#pragma unroll
        for (unsigned j = 0; j < 16; ++j) { const unsigned c = xb_ld(&bar[XB_XCNT(j)]); sum += c; cnt += (c > 0u) ? 1u : 0u; mine = (j == x) ? c : mine; }
        if (sum == G) break;
        __builtin_amdgcn_s_sleep(1);
        if ((++sp & 255u) == 0u) { if (xb_ld(&bar[XB_TMO])) break; if (sp > XB_SPIN_CAP) { atomicAdd(&bar[XB_TMO], 1u); break; } }
    }
    nloc = mine > 0u ? mine : 1u; nx = cnt > 0u ? cnt : 1u;
}
DI void xcd_barrier(const XcdBarrier& b) {
    asm volatile("s_waitcnt vmcnt(0)" ::: "memory");
    __syncthreads();
    if (threadIdx.x == 0) {
        unsigned* bar = b.bar; asm volatile("" : "+s"(bar));
        __builtin_amdgcn_s_waitcnt(0);
        unsigned nloc = b.st[0], nx = b.st[1];
        unsigned bx = b.x; asm volatile("" : "+s"(bx));
        if (nloc == 0u) { xcd_barrier_complete(bar, bx, nloc, nx); b.st[0] = nloc; b.st[1] = nx; }
        const unsigned old = xb_add(&bar[XB_XSUB(bx)], 1u);
        const unsigned gen = old / nloc;
        if (old + 1u == (gen + 1u) * nloc) {
            __builtin_amdgcn_fence(__ATOMIC_RELEASE, "agent");
            asm volatile("s_waitcnt vmcnt(0)" ::: "memory");
            const unsigned og = xb_add(&bar[XB_TOP], 1u);
            const unsigned tg = og / nx;
            if (og + 1u == (tg + 1u) * nx) xb_add(&bar[XB_TOPGEN], 1u);
            else XB_SPIN(xb_ld(&bar[XB_TOPGEN]) == tg, bar);
            __builtin_amdgcn_fence(__ATOMIC_ACQUIRE, "agent");
            xb_add(&bar[XB_XGEN(bx)], 1u);
            asm volatile("s_waitcnt vmcnt(0)" ::: "memory");
        } else {
            XB_SPIN(xb_ld(&bar[XB_XGEN(bx)]) == gen, bar);
            __builtin_amdgcn_fence(__ATOMIC_ACQUIRE, "agent");
            asm volatile("s_waitcnt vmcnt(0)" ::: "memory");
        }
    }
    __syncthreads();
}

struct Args { const float* in[24]; float* out; unsigned char* ws; int ph_lo, ph_hi; };
enum { I_X = 0, I_C, I_CTX, I_CCTX, I_WMOD, I_BMOD, I_WIN, I_GBIAS, I_MLNORM, I_LAQN, I_LAKVN, I_UQ, I_UKV, I_GAQN, I_GAKN, I_BRML, I_BRLA, I_BRGA, I_WOUT, I_WROUTER, I_WE1, I_WE3, I_WE2, I_FNORM };

struct Frame {
    LAS unsigned char* lds;
    unsigned char* ws;
    int tid, lane, wave, G, vcu, gw, ngw;
};

DI int mods_row(int row) { return row < MLAT ? (row >> 11) : 4; }
DI const float* mods_ptr(const Frame& F, int l, int row, int which  ) {
    return (const float*)(F.ws + WS_MODS) + ((size_t)(l * 5 + mods_row(row)) * 6 + which) * DM;
}

namespace pg8 {
constexpr int BM = 256, BK = 64, HALF = 128, HTB = HALF * BK * 2, STAGE_BYTES = 8 * HTB, NXCD = 8, WGM = 8;
__host__ __device__ __forceinline__ int lds_byte(int r, int c) { const int st = (r >> 4) * 2 + (c >> 5), rr = r & 15, cc = c & 31, ob = rr * 64 + cc * 2; return st * 1024 + (ob ^ (((ob >> 9) & 1) << 5)); }
__host__ __device__ __forceinline__ void stage_rc(int b, int& R, int& C) { const int st = b / 1024, sb = b % 1024, swz = sb ^ (((sb >> 9) & 1) << 5); R = (st >> 1) * 16 + swz / 64; C = (st & 1) * 32 + (swz % 64) / 2; }
__host__ __device__ __forceinline__ int perm32(int rho) { const int n = rho >> 4, i = rho & 15; return 8 * (i >> 2) + 4 * n + (i & 3); }

struct Unit { const char* pa; const char* pb; int pm, pn, aux, nt; };

DI void tile_of(int L, int nM, int nN, int& pm, int& pn) {
    const int nwg = nM * nN; int wgid = L;
    { const int q = nwg / NXCD, r = nwg % NXCD, xcd = wgid % NXCD, off = wgid / NXCD; wgid = (xcd < r ? xcd * (q + 1) : r * (q + 1) + (xcd - r) * q) + off; }
    const int nig = WGM * nN, gid = wgid / nig, fm = gid * WGM, gsz = (nM - fm) < WGM ? (nM - fm) : WGM;
    pm = fm + ((wgid % nig) % gsz); pn = (wgid % nig) / gsz;
}

template <bool GATHER = false, class Epi, class Sched>
DI void gemm_phase(LAS unsigned char* lds, const int lda  , const int ldb  , const Sched& S, const Epi& E, const int* rows = nullptr) {
    int tid = threadIdx.x; asm volatile("" : "+v"(tid));
    const int wid = __builtin_amdgcn_readfirstlane(tid >> 6), lane = tid & 63, wr = wid >> 2, wc = wid & 3, fr = lane & 15, fq = lane >> 4;
    unsigned vA0[2], vA1[2], nA0[2], nA1[2], voffB[2]; int sR[2], sC[2];
#pragma unroll
    for (int i = 0; i < 2; ++i) { int R, C; stage_rc(tid * 16 + i * 8192, R, C); const int Rb = (R & ~31) + perm32(R & 31); sR[i] = R; sC[i] = C;
        vA0[i] = (unsigned)(R * lda + C * 2); vA1[i] = (unsigned)((R + HALF) * lda + C * 2); nA0[i] = vA0[i]; nA1[i] = vA1[i]; voffB[i] = (unsigned)(Rb * ldb + C * 2); }
#define PG8_GATHER_OFFS(u_, d0, d1) do { if (GATHER) { _Pragma("unroll") for (int i = 0; i < 2; ++i) { const int r0_ = rows[(u_).pm * 256 + sR[i]], r1_ = rows[(u_).pm * 256 + HALF + sR[i]]; \
        d0[i] = (unsigned)((r0_ < 0 ? 0 : r0_) * lda + sC[i] * 2); d1[i] = (unsigned)((r1_ < 0 ? 0 : r1_) * lda + sC[i] * 2); } } } while (0)
    const size_t kstep = (size_t)(BK * 2);
    const size_t hstepB = (size_t)HALF * ldb;
    const unsigned ldsw = (unsigned)wid * 1024u;
    const int aoff = lds_byte(wr * 64 + fr, fq * 8), boff = lds_byte(wc * 32 + fr, fq * 8);
#define PG8_SA(b, h) (((b) * 2 + (h)) * HTB)
#define PG8_SB(b, h) ((4 + (b) * 2 + (h)) * HTB)
#define PG8_STAGE(bufoff, gbase, voff) do { _Pragma("unroll") for (int _i = 0; _i < 2; ++_i) \
        __builtin_amdgcn_global_load_lds((const unsigned*)((const char*)(gbase) + (voff)[_i]), (LAS unsigned*)(lds + (bufoff) + ldsw + _i * 8192), 16, 0, 0); } while (0)
#define PG8_LDA(dst, b, h) do { _Pragma("unroll") for (int m = 0; m < 4; ++m) _Pragma("unroll") for (int k = 0; k < 2; ++k) dst[m][k] = *(const LAS bf16x8*)(lds + PG8_SA(b, h) + aoff + m * 2048 + k * 1024); } while (0)
#define PG8_LDB(dst, b, h) do { _Pragma("unroll") for (int n = 0; n < 2; ++n) _Pragma("unroll") for (int k = 0; k < 2; ++k) dst[n][k] = *(const LAS bf16x8*)(lds + PG8_SB(b, h) + boff + n * 2048 + k * 1024); } while (0)
#define PG8_MMA(ai, bj, At, Bt) do { __builtin_amdgcn_s_setprio(1); _Pragma("unroll") for (int m = 0; m < 4; ++m) _Pragma("unroll") for (int n = 0; n < 2; ++n) _Pragma("unroll") for (int k = 0; k < 2; ++k) \
        acc[ai][bj][m][n] = __builtin_amdgcn_mfma_f32_16x16x32_bf16(Bt[n][k], At[m][k], acc[ai][bj][m][n], 0, 0, 0); __builtin_amdgcn_s_setprio(0); } while (0)
#define PG8_WAIT_V(n) asm volatile("s_waitcnt vmcnt(" #n ")" ::: "memory")
#define PG8_WAIT_L(n) asm volatile("s_waitcnt lgkmcnt(" #n ")" ::: "memory")
#define PG8_BAR __builtin_amdgcn_s_barrier()
#define PG8_SCHED __builtin_amdgcn_sched_barrier(0)
    Unit cur, nxt; int ui = 0;
    if (!S.next(0, cur)) return;
    f32x4 acc[2][2][4][2];
#pragma unroll
    for (int a = 0; a < 2; ++a)
#pragma unroll
        for (int b = 0; b < 2; ++b)
#pragma unroll
            for (int m = 0; m < 4; ++m)
#pragma unroll
                for (int n = 0; n < 2; ++n) acc[a][b][m][n] = (f32x4){0.f, 0.f, 0.f, 0.f};
    bf16x8 At[4][2], B0[2][2], B1[2][2];
    const char* cA = cur.pa; const char* cB = cur.pb;
    PG8_GATHER_OFFS(cur, vA0, vA1);
    PG8_STAGE(PG8_SB(0, 0), cB, voffB); PG8_STAGE(PG8_SA(0, 0), cA, vA0); PG8_STAGE(PG8_SB(0, 1), cB + hstepB, voffB); PG8_STAGE(PG8_SA(0, 1), cA, vA1);
    if (wr == 1) PG8_BAR;
    PG8_WAIT_V(4); PG8_BAR;
    PG8_STAGE(PG8_SB(1, 0), cB + kstep, voffB); PG8_STAGE(PG8_SA(1, 0), cA + kstep, vA0); PG8_STAGE(PG8_SB(1, 1), cB + hstepB + kstep, voffB);
    PG8_WAIT_V(6); PG8_BAR;
    for (;;) {
        const bool has_next = S.next(ui + 1, nxt);
        const char* nA = has_next ? nxt.pa : cA; const char* nB = has_next ? nxt.pb : cB;
        if (GATHER) { if (has_next) PG8_GATHER_OFFS(nxt, nA0, nA1); else { _Pragma("unroll") for (int i = 0; i < 2; ++i) { nA0[i] = vA0[i]; nA1[i] = vA1[i]; } } }
        const int nt = cur.nt;
        for (int t = 0; t < nt; t += 2) {
            const bool last = (t == nt - 2);
            const char* a1 = cA + (size_t)(t + 1) * kstep;
            const char* a2 = last ? nA : cA + (size_t)(t + 2) * kstep; const char* b2 = last ? nB : cB + (size_t)(t + 2) * kstep;
            const char* a3 = a2 + kstep; const char* b3 = b2 + kstep;
            unsigned wA0[2], wA1[2];
            _Pragma("unroll") for (int i = 0; i < 2; ++i) { wA0[i] = last ? nA0[i] : vA0[i]; wA1[i] = last ? nA1[i] : vA1[i]; }
            PG8_LDB(B0, 0, 0); PG8_SCHED; PG8_LDA(At, 0, 0); PG8_STAGE(PG8_SA(1, 1), a1, vA1);
            PG8_WAIT_L(8); PG8_BAR; PG8_WAIT_L(0); PG8_MMA(0, 0, At, B0); PG8_BAR; PG8_SCHED;
            PG8_LDB(B1, 0, 1); PG8_STAGE(PG8_SB(0, 0), b2, voffB);
            PG8_BAR; PG8_WAIT_L(0); PG8_MMA(0, 1, At, B1); PG8_BAR;
            PG8_LDA(At, 0, 1); PG8_STAGE(PG8_SA(0, 0), a2, wA0);
            PG8_BAR; PG8_WAIT_L(0); PG8_MMA(1, 0, At, B0); PG8_BAR; PG8_SCHED;
            PG8_STAGE(PG8_SB(0, 1), b2 + hstepB, voffB);
            PG8_WAIT_V(6); PG8_BAR; PG8_MMA(1, 1, At, B1); PG8_BAR;
            PG8_LDB(B0, 1, 0); PG8_SCHED; PG8_LDA(At, 1, 0); PG8_STAGE(PG8_SA(0, 1), a2, wA1);
            PG8_WAIT_L(8); PG8_BAR; PG8_WAIT_L(0); PG8_MMA(0, 0, At, B0); PG8_BAR; PG8_SCHED;
            PG8_LDB(B1, 1, 1); PG8_STAGE(PG8_SB(1, 0), b3, voffB);
            PG8_BAR; PG8_WAIT_L(0); PG8_MMA(0, 1, At, B1); PG8_BAR;
            PG8_LDA(At, 1, 1); PG8_STAGE(PG8_SA(1, 0), a3, wA0);
            PG8_BAR; PG8_WAIT_L(0); PG8_MMA(1, 0, At, B0); PG8_BAR; PG8_SCHED;
            PG8_STAGE(PG8_SB(1, 1), b3 + hstepB, voffB);
            PG8_WAIT_V(6); PG8_BAR; PG8_MMA(1, 1, At, B1); PG8_BAR;
        }
        E(acc, cur, wr, wc, fr, fq);
        if (!has_next) break;
#pragma unroll
        for (int a = 0; a < 2; ++a)
#pragma unroll
            for (int b = 0; b < 2; ++b)
#pragma unroll
                for (int m = 0; m < 4; ++m)
#pragma unroll
                    for (int n = 0; n < 2; ++n) acc[a][b][m][n] = (f32x4){0.f, 0.f, 0.f, 0.f};
        cur = nxt; cA = nA; cB = nB; ++ui;
        if (GATHER) { _Pragma("unroll") for (int i = 0; i < 2; ++i) { vA0[i] = nA0[i]; vA1[i] = nA1[i]; } }
    }
    PG8_WAIT_V(0);
    if (wr == 0) PG8_BAR;
    PG8_BAR;
#undef PG8_GATHER_OFFS
#undef PG8_SA
#undef PG8_SB
#undef PG8_STAGE
#undef PG8_LDA
#undef PG8_LDB
#undef PG8_MMA
#undef PG8_WAIT_V
#undef PG8_WAIT_L
#undef PG8_BAR
#undef PG8_SCHED
}
}
using pg8::Unit;

struct SchedDense {
    const char* A; const char* Bt; int lda, ldb, nM, nN, nt, G, c;
    DI bool next(int i, Unit& u) const {
        const long L = (long)i * G + c; if (L >= (long)nM * nN) return false;
        int pm, pn; pg8::tile_of((int)L, nM, nN, pm, pn);
        u.pm = pm; u.pn = pn; u.aux = 0; u.nt = nt; u.pa = A + (size_t)pm * 256 * lda; u.pb = Bt + (size_t)pn * 256 * ldb; return true;
    }
};

struct SchedProj {
    const char* A; const char* Bt; int l, G, c;
    DI bool next(int i, Unit& u) const {
        const long L = (long)i * G + c; int pm, pn;
        if (l == 0) { if (L >= 36 * 49) return false; pg8::tile_of((int)L, 36, 49, pm, pn); }
        else if (G == 256) {
            if (L >= 32 * 47 + 8) return false;
            if (L < 32 * 47) pg8::tile_of((int)L, 32, 47, pm, pn);
            else { const int r = (int)L - 32 * 47; pm = 32 + (r >> 1); pn = (r & 1) ? 23 : 18; } }
        else { if (L >= 32 * 49 + 44) return false;
            if (L < 32 * 49) pg8::tile_of((int)L, 32, 49, pm, pn);
            else { const int r = (int)L - 32 * 49, j = r % 11; pm = 32 + r / 11; pn = j < 8 ? 4 + j : (j == 8 ? 18 : (j == 9 ? 23 : 24)); } }
        u.pm = pm; u.pn = pn; u.aux = 0; u.nt = 32; u.pa = A + (size_t)pm * 256 * (DM * 2); u.pb = Bt + (size_t)pn * 256 * (DM * 2); return true;
    }
};

struct SchedDefer {
    const char* A; const char* Bt; int c;
    DI bool next(int i, Unit& u) const {
        if (i != 0 || c < 0 || c >= 100) return false;
        int pm, pn;
        if (c < 64) { pm = c >> 1; pn = 47 + (c & 1); }
        else { const int r = c - 64, j = r % 9; pm = 32 + r / 9; pn = j < 8 ? 4 + j : 24; }
        u.pm = pm; u.pn = pn; u.aux = 0; u.nt = 32; u.pa = A + (size_t)pm * 256 * (DM * 2); u.pb = Bt + (size_t)pn * 256 * (DM * 2); return true;
    }
};

#define EPI_FOREACH(...) \
    _Pragma("unroll") for (int ai = 0; ai < 2; ++ai) _Pragma("unroll") for (int m = 0; m < 4; ++m) { const int row = u.pm * 256 + ai * 128 + wr * 64 + m * 16 + fr; \
    _Pragma("unroll") for (int bj = 0; bj < 2; ++bj) { const int col = u.pn * 256 + bj * 128 + wc * 32 + 8 * fq; const f32x4 v0 = acc[ai][bj][m][0], v1 = acc[ai][bj][m][1]; __VA_ARGS__ } }

DI u32x4 pack8(const f32x4 v0, const f32x4 v1) { u32x4 w; w.x = pk2(v0[0], v0[1]); w.y = pk2(v0[2], v0[3]); w.z = pk2(v1[0], v1[1]); w.w = pk2(v1[2], v1[3]); return w; }

struct EpiStoreBf16 {
    bf16_t* O; int ldc;
    DI void operator()(const f32x4 (&acc)[2][2][4][2], const Unit& u, int wr, int wc, int fr, int fq) const {
        EPI_FOREACH({ *(u32x4*)(O + (size_t)row * ldc + col) = pack8(v0, v1); })
    }
};
struct EpiProj {
    bf16_t* P;
    DI void operator()(const f32x4 (&acc)[2][2][4][2], const Unit& u, int wr, int wc, int fr, int fq) const {
        EPI_FOREACH({ *(u32x4*)(P + (size_t)row * NP + col) = pack8(v0, v1); })
    }
};
struct EpiX {
    bf16_t* KR; float* X80; const float* rla;
    DI void operator()(const f32x4 (&acc)[2][2][4][2], const Unit& u, int wr, int wc, int fr, int fq) const {
#pragma unroll
        for (int ai = 0; ai < 2; ++ai)
#pragma unroll
            for (int m = 0; m < 4; ++m) { const int row = u.pm * 256 + ai * 128 + wr * 64 + m * 16 + fr; const bool lat = row < MLAT; const int t = row & 2047;
#pragma unroll
                for (int n = 0; n < 2; ++n) { const f32x4 v = acc[ai][0][m][n];
                    f32x4 pr; pr.x = shx(v.x, 32); pr.y = shx(v.y, 32); pr.z = shx(v.z, 32); pr.w = shx(v.w, 32);
                    if (wc < 2) {
                        const int idx = 8 * (fq & 1) + 4 * n; f32x4 o = v;
                        if (lat) { const float* cs = rla + ((size_t)t * 32 + wc * 16 + idx) * 2; const f32x4 c0 = *(const f32x4*)cs, c1 = *(const f32x4*)(cs + 4);
                            if (fq < 2) { o.x = v.x * c0.x - pr.x * c0.y; o.y = v.y * c0.z - pr.y * c0.w; o.z = v.z * c1.x - pr.z * c1.y; o.w = v.w * c1.z - pr.w * c1.w; }
                            else        { o.x = pr.x * c0.y + v.x * c0.x; o.y = pr.y * c0.w + v.y * c0.z; o.z = pr.z * c1.y + v.z * c1.x; o.w = pr.w * c1.w + v.w * c1.z; } }
                        u32x2 w2; w2.x = pk2(o.x, o.y); w2.y = pk2(o.z, o.w);
                        *(u32x2*)(KR + (size_t)row * 64 + 32 * wc + 8 * fq + 4 * n) = w2;
                    } else if (wc == 2 && fq < 2) *(f32x4*)(X80 + (size_t)row * XW + 64 + 8 * fq + 4 * n) = v;
                } }
    }
};

DI int win_src_col(int n) {
    if (n < 4096) return n;
    if (n < 4608) return n - 4096 + 4112;
    if (n < 4864) return n - 4608 + 4624;
    if (n < 5888) return n - 4864 + 4944;
    if (n < 6144) return n - 5888 + 5968;
    if (n < 6400) return n - 6144 + 6224;
    if (n < 12544) return n - 6400 + 6480;
    if (n < 12608) return n - 12544 + 4880;
    if (n < 12624) return n - 12608 + 4096;
    return -1;
}
DI void transpose_item(const float* W, int ldw, int K, bf16_t* WT, int k0, int n0, int srcc, LAS float* scr, int lane) {
#pragma unroll 8
    for (int i = 0; i < 32; ++i) { const int kk = 2 * i + (lane >> 5); scr[kk * 33 + (lane & 31)] = srcc >= 0 ? W[(size_t)(k0 + kk) * ldw + srcc] : 0.f; }
    LDS_WAIT(); asm volatile("" ::: "memory");
    const int c = lane & 7;
#pragma unroll
    for (int j = 0; j < 4; ++j) { const int n = (lane >> 3) + 8 * j; const LAS float* s = scr + (8 * c) * 33 + n;
        u32x4 o; o.x = pk2(s[0 * 33], s[1 * 33]); o.y = pk2(s[2 * 33], s[3 * 33]); o.z = pk2(s[4 * 33], s[5 * 33]); o.w = pk2(s[6 * 33], s[7 * 33]);
        *(u32x4*)(WT + (size_t)(n0 + n) * K + k0 + 8 * c) = o; }
    LDS_WAIT(); asm volatile("" ::: "memory");
}

constexpr int IT_IN = 32 * 400, IT_UQ = 8 * 48, IT_UKV = 4 * 64, IT_BR = 16 * 64, IT_OUT = 32 * 64, IT_E13 = 32 * 64, IT_E2 = 16 * 64;
constexpr int IT_EARLY = IT_IN + IT_UQ + IT_UKV, IT_LAYER = IT_EARLY + 3 * IT_BR + IT_OUT + NEXP * IT_E13 + NEXP * IT_E2;
struct CvDesc { const float* src; size_t ld2; bf16_t* dst; int K; };
DI CvDesc cv_make(const float* W, int ldw, int K, bf16_t* WT, int k0, int n0, int srcc, int lane) {
    CvDesc d; d.src = srcc >= 0 ? W + (size_t)(k0 + (lane >> 5)) * ldw + srcc : nullptr; d.ld2 = 2 * (size_t)ldw; d.dst = WT + (size_t)n0 * K + k0; d.K = K; return d; }
DI CvDesc cv_desc(const Frame& F, const Args& a, int l, int r) {
    unsigned char* wl = F.ws + WS_W + (size_t)l * W_LAYER;
    const int lane = F.lane, ln = lane & 31;
    if (r < IT_IN) { const int kb = r / 400, nb = r % 400; return cv_make(a.in[I_WIN] + (size_t)l * DM * PROJW, PROJW, DM, (bf16_t*)(wl + W_IN), 64 * kb, 32 * nb, win_src_col(32 * nb + ln), lane); } r -= IT_IN;
    if (r < IT_UQ) { const int kb = r / 48, nb = r % 48; return cv_make(a.in[I_UQ] + (size_t)l * 512 * 1536, 1536, 512, (bf16_t*)(wl + W_UQ), 64 * kb, 32 * nb, 32 * nb + ln, lane); } r -= IT_UQ;
    if (r < IT_UKV) { const int kb = r / 64, nb = r % 64; return cv_make(a.in[I_UKV] + (size_t)l * 256 * 2048, 2048, 256, (bf16_t*)(wl + W_UKV), 64 * kb, 32 * nb, 32 * nb + ln, lane); } r -= IT_UKV;
    if (r < 3 * IT_BR) { const int br = r / IT_BR, q = r % IT_BR, kb = q / 64, nb = q % 64;
        return cv_make(a.in[I_BRML + br] + (size_t)l * 1024 * 2048, 2048, 1024, (bf16_t*)(wl + W_BR) + (size_t)br * 2048 * 1024, 64 * kb, 32 * nb, 32 * nb + ln, lane); } r -= 3 * IT_BR;
    if (r < IT_OUT) { const int kb = r / 64, nb = r % 64; return cv_make(a.in[I_WOUT] + (size_t)l * 2048 * 2048, 2048, 2048, (bf16_t*)(wl + W_OUT), 64 * kb, 32 * nb, 32 * nb + ln, lane); } r -= IT_OUT;
    if (r < NEXP * IT_E13) { const int e = r / IT_E13, q = r % IT_E13, kb = q / 64, nb = q % 64;
        const int n0 = 32 * nb, j = n0 >> 8, half = (n0 >> 7) & 1, cc = n0 & 127;
        return cv_make(a.in[half ? I_WE3 : I_WE1] + ((size_t)l * NEXP + e) * 2048 * 1024, 1024, 2048, (bf16_t*)(wl + W_E13) + (size_t)e * 2048 * 2048, 64 * kb, n0, j * 128 + cc + ln, lane); } r -= NEXP * IT_E13;
    { const int e = r / IT_E2, q = r % IT_E2, kb = q / 64, nb = q % 64;
        return cv_make(a.in[I_WE2] + ((size_t)l * NEXP + e) * 1024 * 2048, 2048, 1024, (bf16_t*)(wl + W_E2) + (size_t)e * 2048 * 1024, 64 * kb, 32 * nb, 32 * nb + ln, lane); }
}
DI void cv_load(const CvDesc& d, float (&v)[32]) {
#pragma unroll
    for (int i = 0; i < 32; ++i) v[i] = d.src ? __builtin_nontemporal_load(d.src + (size_t)i * d.ld2) : 0.f;
}
DI void cv_store(const CvDesc& d, const float (&v)[32], LAS float* scr, int lane) {
#pragma unroll
    for (int i = 0; i < 32; ++i) scr[(2 * i + (lane >> 5)) * 33 + (lane & 31)] = v[i];
    LDS_WAIT(); asm volatile("" ::: "memory");
    const int c = lane & 7;
#pragma unroll
    for (int j = 0; j < 4; ++j) { const int n = (lane >> 3) + 8 * j; const LAS float* s = scr + (8 * c) * 33 + n;
        u32x4 o; o.x = pk2(s[0 * 33], s[1 * 33]); o.y = pk2(s[2 * 33], s[3 * 33]); o.z = pk2(s[4 * 33], s[5 * 33]); o.w = pk2(s[6 * 33], s[7 * 33]);
        *(u32x4*)(d.dst + (size_t)n * d.K + 8 * c) = o; }
    LDS_WAIT(); asm volatile("" ::: "memory");
}
DI void convert_range(const Frame& F, const Args& a, int first, int stride, int n_items, LAS float* scr) {
    int it = first; if (it >= n_items) return;
    CvDesc cur = cv_desc(F, a, it / IT_LAYER, it % IT_LAYER); float v[32]; cv_load(cur, v);
    for (;;) {
        const int nx = it + stride; const bool hn = nx < n_items; const int pn = hn ? nx : it;
        const CvDesc nd = cv_desc(F, a, pn / IT_LAYER, pn % IT_LAYER); float wv[32]; cv_load(nd, wv);
        cv_store(cur, v, scr, F.lane);
        if (!hn) break;
        cur = nd; it = nx;
#pragma unroll
        for (int i = 0; i < 32; ++i) v[i] = wv[i];
    }
}
DI void convert_item(const Frame& F, const Args& a, int l, int r, LAS float* scr) {
    const CvDesc d = cv_desc(F, a, l, r); float v[32]; cv_load(d, v); cv_store(d, v, scr, F.lane);
}

DI void phase_prologue(const Frame& F, const Args& a, int rep) {
    LAS float* scr = (LAS float*)(F.lds + F.wave * 16384);
    if (rep == 0) {
        const float* c = a.in[I_C]; const float* cctx = a.in[I_CCTX]; const float* wmod = a.in[I_WMOD];
        constexpr int NIT = 2 * 48 * 16;
        for (int it = F.gw; it < NIT; it += F.ngw) {
            const int l = it / 768, rem = it % 768, cb = rem / 16, kp = rem % 16, k0 = kp * 128, j0 = cb * 256 + F.lane * 4;
#pragma unroll
            for (int i = 0; i < 10; ++i) { const int idx = F.lane + 64 * i, r = idx >> 7, kk = idx & 127; const float v = r < 4 ? c[r * DM + k0 + kk] : cctx[k0 + kk]; scr[idx] = siluf_(v); }
            LDS_WAIT(); asm volatile("" ::: "memory");
            f32x4 acc[5];
#pragma unroll
            for (int r = 0; r < 5; ++r) acc[r] = (f32x4){0.f, 0.f, 0.f, 0.f};
            const float* wp = wmod + ((size_t)l * DM + k0) * (6 * DM) + j0;
#pragma unroll 8
            for (int kk = 0; kk < 128; ++kk) { const f32x4 w = __builtin_nontemporal_load((const f32x4*)(wp + (size_t)kk * (6 * DM)));
#pragma unroll
                for (int r = 0; r < 5; ++r) acc[r] += w * scr[r * 128 + kk]; }
#pragma unroll
            for (int r = 0; r < 5; ++r) *(f32x4*)((float*)(F.ws + WS_MPART) + ((size_t)(kp * 2 + l) * 5 + r) * (6 * DM) + j0) = acc[r];
            LDS_WAIT(); asm volatile("" ::: "memory");
        }
    }
    {
        float* rla = (float*)(F.ws + WS_ROPE_LA); float* rga = (float*)(F.ws + WS_ROPE_GA);
        const int gt = F.gw * 64 + F.lane, ngt = F.ngw * 64;
        for (int i = gt; i < 2048 * 32; i += ngt) { const int t = i >> 5, aidx = i & 31, ax = aidx >> 4, fi = aidx & 15;
            const float inv = exp2f(-(float)fi * (13.287712379549449f / 16.f)); const float ang = (float)(ax ? (t & 63) : (t >> 6)) * inv;
            rla[2 * i] = cosf(ang); rla[2 * i + 1] = sinf(ang); }
        for (int i = gt; i < 2048 * 64; i += ngt) { const int t = i >> 6, aidx = i & 63, ax = aidx >> 5, fi = aidx & 31;
            const float inv = exp2f(-(float)fi * (13.287712379549449f / 32.f)); const float ang = (float)(ax ? (t & 63) : (t >> 6)) * inv;
            rga[2 * i] = cosf(ang); rga[2 * i + 1] = sinf(ang); }
    }
#ifndef MK_CONVTAIL
#define MK_CONVTAIL 0
#endif
#ifndef MK_FILL
#define MK_FILL 0
#endif
#ifndef MK_CVSIDE
#define MK_CVSIDE 2
#endif
#ifndef MK_CVFROM
#define MK_CVFROM IT_EARLY
#endif
    if (MK_CONVTAIL) { for (int it = F.gw; it < IT_EARLY; it += F.ngw) convert_item(F, a, 0, it, scr); }
    else convert_range(F, a, F.gw, F.ngw, MK_CVSIDE ? MK_CVFROM : (MK_FILL ? IT_LAYER : 2 * IT_LAYER), scr);
}

DI void phase_mods_reduce(const Frame& F, const Args& a) {
    float* mods = (float*)(F.ws + WS_MODS); const float* part = (const float*)(F.ws + WS_MPART); const float* bmod = a.in[I_BMOD];
    const int gt = F.gw * 64 + F.lane, ngt = F.ngw * 64;
    for (int i = gt; i < 2 * 5 * 12288 / 4; i += ngt) { const int l = i / (5 * 3072), j4 = i % 3072;
        f32x4 s = *(const f32x4*)(bmod + (size_t)l * 12288 + 4 * j4);
#pragma unroll
        for (int kp = 0; kp < 16; ++kp) s += *(const f32x4*)(part + (size_t)kp * (2 * 5 * 12288) + 4 * (size_t)i);
        *(f32x4*)(mods + 4 * (size_t)i) = s; }
}

DI const float* resid_row(const Frame& F, const Args& a, int l, int row) {
    if (l == 0) return row < MLAT ? a.in[I_X] + (size_t)row * DM : a.in[I_CTX] + (size_t)(row - MLAT) * DM;
    return (const float*)(F.ws + WS_X1) + (size_t)row * DM;
}
DI void load_row(const float* p, int lane, f32x4 (&v)[8]) {
#pragma unroll
    for (int j = 0; j < 8; ++j) v[j] = *(const f32x4*)(p + 4 * lane + 256 * j);
}
template <bool G2LDS = false>
DI void combine_row(const Frame& F, int lp, int row, const f32x4 (&x)[8], int tokv, f32x4 (&v)[8], const LAS float* g2l = nullptr) {
    const bf16_t* YE = (const bf16_t*)(F.ws + WS_YE);
    f32x4 s[8];
#pragma unroll
    for (int j = 0; j < 8; ++j) s[j] = (f32x4){0.f, 0.f, 0.f, 0.f};
    unsigned mask = (unsigned)__ballot(tokv >= 0) & 0xffffu;
    while (mask) {
        const int e0 = __builtin_ctz(mask); mask &= mask - 1u; const bool two = mask != 0u; const int e1 = two ? __builtin_ctz(mask) : e0; mask &= mask - 1u;
        const int slot0 = __builtin_amdgcn_readlane(tokv, e0), slot1 = __builtin_amdgcn_readlane(tokv, e1);
        const bf16_t* y0r = YE + ((size_t)e0 * ESLOT + slot0) * DM; const bf16_t* y1r = YE + ((size_t)e1 * ESLOT + slot1) * DM;
        s16x4 y0[8], y1[8];
#pragma unroll
        for (int j = 0; j < 8; ++j) { y0[j] = *(const s16x4*)(y0r + 4 * F.lane + 256 * j); y1[j] = *(const s16x4*)(y1r + 4 * F.lane + 256 * j); }
#pragma unroll
        for (int j = 0; j < 8; ++j) s[j] += (f32x4){bf2f((unsigned short)y0[j][0]), bf2f((unsigned short)y0[j][1]), bf2f((unsigned short)y0[j][2]), bf2f((unsigned short)y0[j][3])};
        if (two) {
#pragma unroll
            for (int j = 0; j < 8; ++j) s[j] += (f32x4){bf2f((unsigned short)y1[j][0]), bf2f((unsigned short)y1[j][1]), bf2f((unsigned short)y1[j][2]), bf2f((unsigned short)y1[j][3])}; }
    }
    if (G2LDS) {
#pragma unroll
        for (int j = 0; j < 8; ++j) v[j] = x[j] + s[j] * *(const LAS f32x4*)(g2l + 4 * F.lane + 256 * j); }
    else { const float* g2 = mods_ptr(F, lp, row, 5);
#pragma unroll
        for (int j = 0; j < 8; ++j) v[j] = x[j] + s[j] * *(const f32x4*)(g2 + 4 * F.lane + 256 * j); }
}
DI void modulate_vals(const Frame& F, const f32x4 (&v)[8], const float* sh, const float* sc, bf16_t* hrow, f32x4 (&hv)[8]) {
    float ss = 0.f;
#pragma unroll
    for (int j = 0; j < 8; ++j) ss += v[j].x * v[j].x + v[j].y * v[j].y + v[j].z * v[j].z + v[j].w * v[j].w;
    const float rs = rsqrtf(wave_sum(ss) * (1.f / DM) + EPS);
#pragma unroll
    for (int j = 0; j < 8; ++j) { const f32x4 s1 = *(const f32x4*)(sc + 4 * F.lane + 256 * j), s0 = *(const f32x4*)(sh + 4 * F.lane + 256 * j);
        const f32x4 h = v[j] * rs * (s1 + 1.f) + s0; hv[j] = h;
        u32x2 w; w.x = pk2(h.x, h.y); w.y = pk2(h.z, h.w); *(u32x2*)(hrow + 4 * F.lane + 256 * j) = w; }
}
DI void phase_mod1(const Frame& F, const Args& a, int l) {
    bf16_t* H = (bf16_t*)(F.ws + WS_H); const int* TOK = (const int*)(F.ws + WS_TOK);
    LAS float* ms = (LAS float*)F.lds;
    { const float* MODS = (const float*)(F.ws + WS_MODS);
      for (int i = F.tid; i < 5 * 3 * 512; i += NTHR) { const int r = i / 1536, w = (i / 512) % 3, c4 = i % 512;
          if (w == 2 && l == 0) continue;
          const int ll = w == 2 ? l - 1 : l, which = w == 2 ? 5 : w;
          f32x4 val = *(const f32x4*)(MODS + ((size_t)(ll * 5 + r) * 6 + which) * DM + 4 * c4); if (w == 1) val += 1.f;
          *(LAS f32x4*)(ms + (size_t)(r * 3 + w) * DM + 4 * c4) = val; }
      __syncthreads(); }
    int row = F.gw; if (row >= MTOT) return;
    f32x4 cur[8]; int tcur = 0;
    load_row(resid_row(F, a, l, row), F.lane, cur); if (l > 0) tcur = TOK[(size_t)row * 16 + (F.lane & 15)];
    for (;;) {
        const int nrow = row + F.ngw; const bool hn = nrow < MTOT; const int pr = hn ? nrow : row;
        f32x4 nxt[8]; int tnxt = 0;
        load_row(resid_row(F, a, l, pr), F.lane, nxt); if (l > 0) tnxt = TOK[(size_t)pr * 16 + (F.lane & 15)];
        f32x4 v[8];
        if (l == 0) {
#pragma unroll
            for (int j = 0; j < 8; ++j) v[j] = cur[j]; }
        const LAS float* mr = ms + (size_t)mods_row(row) * 3 * DM;
        if (l != 0) { combine_row<true>(F, l - 1, row, cur, tcur, v, mr + 2 * DM); float* xw = (float*)(F.ws + WS_X1) + (size_t)row * DM;
#pragma unroll
            for (int j = 0; j < 8; ++j) *(f32x4*)(xw + 4 * F.lane + 256 * j) = v[j]; }
        { float ss = 0.f;
#pragma unroll
          for (int j = 0; j < 8; ++j) ss += v[j].x * v[j].x + v[j].y * v[j].y + v[j].z * v[j].z + v[j].w * v[j].w;
          const float rs = rsqrtf(wave_sum(ss) * (1.f / DM) + EPS);
          bf16_t* hrow = H + (size_t)row * DM;
#pragma unroll
          for (int j = 0; j < 8; ++j) { const f32x4 h = v[j] * rs * *(const LAS f32x4*)(mr + DM + 4 * F.lane + 256 * j) + *(const LAS f32x4*)(mr + 4 * F.lane + 256 * j);
              u32x2 w; w.x = pk2(h.x, h.y); w.y = pk2(h.z, h.w); *(u32x2*)(hrow + 4 * F.lane + 256 * j) = w; } }
        if (!hn) break;
#pragma unroll
        for (int j = 0; j < 8; ++j) cur[j] = nxt[j];
        tcur = tnxt; row = nrow;
    }
}
DI void phase_mod2(const Frame& F, const Args& a, int l, int nrows) {
    bf16_t* H = (bf16_t*)(F.ws + WS_H); float* AFF = (float*)(F.ws + WS_AFF);
    LAS float* wr = (LAS float*)F.lds;
    const float* wsrc = a.in[I_WROUTER] + (size_t)l * DM * NEXP;
    for (int i = F.tid; i < DM * NEXP / 4; i += NTHR) { const f32x4 w4 = ((const f32x4*)wsrc)[i]; const int c = i >> 2, e0 = (i & 3) * 4;
        wr[(e0 + 0) * DM + c] = w4.x; wr[(e0 + 1) * DM + c] = w4.y; wr[(e0 + 2) * DM + c] = w4.z; wr[(e0 + 3) * DM + c] = w4.w; }
    __syncthreads();
    const float* X1 = (const float*)(F.ws + WS_X1);
    auto router = [&](const f32x4 (&hv)[8], int row) {
        float lg[16];
#pragma unroll
        for (int e = 0; e < 16; ++e) lg[e] = 0.f;
#pragma unroll
        for (int j = 0; j < 8; ++j)
#pragma unroll
            for (int e = 0; e < 16; ++e) { const f32x4 w = *(const LAS f32x4*)(wr + e * DM + 4 * F.lane + 256 * j); lg[e] += hv[j].x * w.x + hv[j].y * w.y + hv[j].z * w.z + hv[j].w * w.w; }
        float mx = -1e30f;
#pragma unroll
        for (int e = 0; e < 16; ++e) { lg[e] = wave_sum(lg[e]); mx = fmaxf(mx, lg[e]); }
        float den = 0.f;
#pragma unroll
        for (int e = 0; e < 16; ++e) { lg[e] = __expf(lg[e] - mx); den += lg[e]; }
        const float inv = 1.f / den;
        float mine = 0.f;
#pragma unroll
        for (int e = 0; e < 16; ++e) mine = (F.lane == e) ? lg[e] * inv : mine;
        if (F.lane < 16) AFF[(size_t)F.lane * MTOT + row] = mine;
    };
    const int crow = MLAT + F.gw; const bool hasc = crow < nrows;
    f32x4 cur[8];
    for (int base = 4 * F.gw; base < MLAT; base += 4 * F.ngw) {
        load_row(X1 + (size_t)base * DM, F.lane, cur);
        f32x4 s1[8], s0[8];
        { const float* sh = mods_ptr(F, l, base, 3); const float* sc = mods_ptr(F, l, base, 4);
#pragma unroll
          for (int j = 0; j < 8; ++j) { s1[j] = *(const f32x4*)(sc + 4 * F.lane + 256 * j) + 1.f; s0[j] = *(const f32x4*)(sh + 4 * F.lane + 256 * j); } }
#pragma unroll 1
        for (int k = 0; k < 4; ++k) { const int row = base + k; f32x4 hv[8];
            { const int pr = k < 3 ? row + 1 : (hasc ? crow : row); f32x4 nxt[8]; load_row(X1 + (size_t)pr * DM, F.lane, nxt);
              float ss = 0.f;
#pragma unroll
              for (int j = 0; j < 8; ++j) ss += cur[j].x * cur[j].x + cur[j].y * cur[j].y + cur[j].z * cur[j].z + cur[j].w * cur[j].w;
              const float rs = rsqrtf(wave_sum(ss) * (1.f / DM) + EPS);
              bf16_t* hrow = H + (size_t)row * DM;
#pragma unroll
              for (int j = 0; j < 8; ++j) { const f32x4 h = cur[j] * rs * s1[j] + s0[j]; hv[j] = h;
                  u32x2 w; w.x = pk2(h.x, h.y); w.y = pk2(h.z, h.w); *(u32x2*)(hrow + 4 * F.lane + 256 * j) = w; }
#pragma unroll
              for (int j = 0; j < 8; ++j) cur[j] = nxt[j]; }
            router(hv, row);
        }
    }
    if (hasc) {
        if (4 * F.gw >= MLAT) load_row(X1 + (size_t)crow * DM, F.lane, cur);
        for (int row = crow; row < nrows; row += F.ngw) { f32x4 hv[8];
            modulate_vals(F, cur, mods_ptr(F, l, row, 3), mods_ptr(F, l, row, 4), H + (size_t)row * DM, hv);
            router(hv, row);
            if (row + F.ngw < nrows) load_row(X1 + (size_t)(row + F.ngw) * DM, F.lane, cur); }
    }
    __syncthreads();
}

DI void phase_postproj(const Frame& F, const Args& a, int l) {
    const bf16_t* P = (const bf16_t*)(F.ws + WS_P);
    bf16_t* CQN = (bf16_t*)(F.ws + WS_CQN); bf16_t* CKVN = (bf16_t*)(F.ws + WS_CKVN); bf16_t* QG = (bf16_t*)(F.ws + WS_QG); bf16_t* KG = (bf16_t*)(F.ws + WS_KG);
    const float* qn = a.in[I_LAQN] + l * 512; const float* kvn = a.in[I_LAKVN] + l * 256; const float* gqn = a.in[I_GAQN] + l * 128; const float* gkn = a.in[I_GAKN] + l * 128;
    const float* rga = (const float*)(F.ws + WS_ROPE_GA);
    const int lane = F.lane;
    const f32x4 qg0 = *(const f32x4*)(qn + 8 * lane), qg1 = *(const f32x4*)(qn + 8 * lane + 4), kg0 = *(const f32x4*)(kvn + 4 * lane);
    const int hq = lane >> 4, ax = (lane >> 3) & 1, seg = lane & 7, eo = ax * 64 + 4 * seg;
    const f32x4 gqa = *(const f32x4*)(gqn + eo), gqb = *(const f32x4*)(gqn + eo + 32), gka = *(const f32x4*)(gkn + eo), gkb = *(const f32x4*)(gkn + eo + 32);
    struct Raw { bf16x8 xq; s16x4 xkv; s16x4 ha[3], hb[3]; f32x4 r0, r1; };
    auto load = [&](int row, Raw& R) { const bf16_t* pr = P + (size_t)row * NP; const int t = row & 2047;
        R.xq = *(const bf16x8*)(pr + C_CQ + 8 * lane); R.xkv = *(const s16x4*)(pr + C_CKV + 4 * lane);
#pragma unroll
        for (int p = 0; p < 3; ++p) { const int hh = p < 2 ? 4 * p + hq : 8 + (hq & 1); const bf16_t* src = pr + C_GQ + hh * 128;
            R.ha[p] = *(const s16x4*)(src + eo); R.hb[p] = *(const s16x4*)(src + eo + 32); }
        const float* rp = rga + ((size_t)t * 64 + ax * 32 + 4 * seg) * 2; R.r0 = *(const f32x4*)rp; R.r1 = *(const f32x4*)(rp + 4); };
    static_assert(C_GK == C_GQ + 8 * 128, "q and k heads contiguous");
    int row = F.gw; if (row >= MTOT) return;
    Raw cur; load(row, cur);
    for (;;) {
        const int nrow = row + F.ngw; const bool hn = nrow < MTOT; Raw nxt; load(hn ? nrow : row, nxt);
        const bool lat = row < MLAT; const bool needq = lat || l == 0;
        if (needq) {
            float f[8]; float ss = 0.f;
#pragma unroll
            for (int i = 0; i < 8; ++i) { f[i] = bf2f((unsigned short)cur.xq[i]); ss += f[i] * f[i]; }
            const float rs = rsqrtf(wave_sum(ss) * (1.f / 512.f) + EPS);
            u32x4 w; w.x = pk2(f[0] * rs * qg0.x, f[1] * rs * qg0.y); w.y = pk2(f[2] * rs * qg0.z, f[3] * rs * qg0.w); w.z = pk2(f[4] * rs * qg1.x, f[5] * rs * qg1.y); w.w = pk2(f[6] * rs * qg1.z, f[7] * rs * qg1.w);
            *(u32x4*)(CQN + (size_t)row * 512 + 8 * lane) = w;
        }
        {
            float f[4]; float ss = 0.f;
#pragma unroll
            for (int i = 0; i < 4; ++i) { f[i] = bf2f((unsigned short)cur.xkv[i]); ss += f[i] * f[i]; }
            const float rs = rsqrtf(wave_sum(ss) * (1.f / 256.f) + EPS);
            u32x2 w; w.x = pk2(f[0] * rs * kg0.x, f[1] * rs * kg0.y); w.y = pk2(f[2] * rs * kg0.z, f[3] * rs * kg0.w);
            *(u32x2*)(CKVN + (size_t)row * 256 + 4 * lane) = w;
        }
        const float cs[4] = {cur.r0.x, cur.r0.z, cur.r1.x, cur.r1.z}, sn[4] = {cur.r0.y, cur.r0.w, cur.r1.y, cur.r1.w};
        const int ln = lane_id_();
#pragma unroll
        for (int p = 0; p < 3; ++p) {
            if (p < 2 && !needq) continue;
            float xa[4], xb[4]; float ss = 0.f;
#pragma unroll
            for (int i = 0; i < 4; ++i) { xa[i] = bf2f((unsigned short)cur.ha[p][i]); xb[i] = bf2f((unsigned short)cur.hb[p][i]); ss += xa[i] * xa[i] + xb[i] * xb[i]; }
#pragma unroll
            for (int o = 1; o < 16; o <<= 1) ss += bperm_f(ss, ln ^ o);
            const float rs = rsqrtf(ss * (1.f / 128.f) + EPS);
            const f32x4 ga = p < 2 ? gqa : gka, gb = p < 2 ? gqb : gkb;
            float oa[4], ob[4];
#pragma unroll
            for (int i = 0; i < 4; ++i) { const float ya = xa[i] * rs * ga[i], yb = xb[i] * rs * gb[i]; oa[i] = lat ? ya * cs[i] - yb * sn[i] : ya; ob[i] = lat ? ya * sn[i] + yb * cs[i] : yb; }
            bf16_t* dst = p < 2 ? QG + (size_t)row * 1024 + (4 * p + hq) * 128 : KG + (size_t)row * 256 + (hq & 1) * 128;
            if (p < 2 || hq < 2) { u32x2 wa, wb; wa.x = pk2(oa[0], oa[1]); wa.y = pk2(oa[2], oa[3]); wb.x = pk2(ob[0], ob[1]); wb.y = pk2(ob[2], ob[3]);
                *(u32x2*)(dst + eo) = wa; *(u32x2*)(dst + eo + 32) = wb; }
        }
        if (!hn) break;
        cur = nxt; row = nrow;
    }
}

namespace att {
constexpr int QBLK = 32, KVBLK = 64;
#define SBAR() __builtin_amdgcn_sched_barrier(0)
DI int crow(int r, int hi) { return (r & 3) + 8 * (r >> 2) + 4 * hi; }
DI int v_st(int k, int c) { const int kk = (k & ~0xC) | ((k & 4) << 1) | ((k & 8) >> 1); return ((kk >> 3) * 4 + (c >> 5)) * 512 + ((kk & 7) * 32 + (c & 31)) * 2; }
DI int v_rd_base(int lane) { return ((lane & 3) << 3) | (((lane >> 2) & 3) << 6) | (((lane >> 4) & 1) << 5) | (((lane >> 5) & 1) << 8); }
constexpr int v_rd_off(int d0, int ks, int half) { return d0 * 512 + ks * 4096 + half * 2048; }
template <int OFF> DI s16x4 tr_read(int vb) { s16x4 r; asm volatile("ds_read_b64_tr_b16 %0, %1 offset:%2" : "=&v"(r) : "v"(vb), "i"(OFF) : "memory"); return r; }
template <int D0> DI void pv_one(f32x16& od, int vb, bf16x8 pa0, bf16x8 pa1, bf16x8 pa2, bf16x8 pa3) {
  const s16x4 l0 = tr_read<v_rd_off(D0, 0, 0)>(vb), h0 = tr_read<v_rd_off(D0, 0, 1)>(vb), l1 = tr_read<v_rd_off(D0, 1, 0)>(vb), h1 = tr_read<v_rd_off(D0, 1, 1)>(vb);
  const s16x4 l2 = tr_read<v_rd_off(D0, 2, 0)>(vb), h2 = tr_read<v_rd_off(D0, 2, 1)>(vb), l3 = tr_read<v_rd_off(D0, 3, 0)>(vb), h3 = tr_read<v_rd_off(D0, 3, 1)>(vb);
  asm volatile("s_waitcnt lgkmcnt(0)" ::: "memory"); SBAR();
#define PK(L, H) (bf16x8){L[0], L[1], L[2], L[3], H[0], H[1], H[2], H[3]}
  od = __builtin_amdgcn_mfma_f32_32x32x16_bf16(pa0, PK(l0, h0), od, 0, 0, 0);
  od = __builtin_amdgcn_mfma_f32_32x32x16_bf16(pa1, PK(l1, h1), od, 0, 0, 0);
  od = __builtin_amdgcn_mfma_f32_32x32x16_bf16(pa2, PK(l2, h2), od, 0, 0, 0);
  od = __builtin_amdgcn_mfma_f32_32x32x16_bf16(pa3, PK(l3, h3), od, 0, 0, 0);
#undef PK
}
DI void pv_d0(f32x16* o, int vb, bf16x8 pa0, bf16x8 pa1, bf16x8 pa2, bf16x8 pa3) {
  pv_one<0>(o[0], vb, pa0, pa1, pa2, pa3); pv_one<1>(o[1], vb, pa0, pa1, pa2, pa3); pv_one<2>(o[2], vb, pa0, pa1, pa2, pa3); pv_one<3>(o[3], vb, pa0, pa1, pa2, pa3);
}
template <int DKX, int LDQ, int LDK, int LDV, int LDO, int SDEPTH = 1>
DI void attn_body(const bf16_t* __restrict__ Qb, const bf16_t* __restrict__ Km, const bf16_t* __restrict__ Kx, const bf16_t* __restrict__ Vm, bf16_t* __restrict__ Ob,
                  int kr0, int nt0, int kr1, int nt1, float scale, const float* __restrict__ ropeq  , char* lds) {
  constexpr int ND0 = 8 + DKX / 16, KROWB = (128 + DKX) * 2, SHM_V = KVBLK * 128 * 2, SHM_K = KVBLK * KROWB;
  constexpr float THR = 8.f;
#define KSWZ(row, colB) ((row) * KROWB + ((colB) ^ (((row) & 7) << 4)))
  int tid = threadIdx.x; asm volatile("" : "+v"(tid));
  const int wid = __builtin_amdgcn_readfirstlane(tid >> 6), lane = tid & 63, r32 = lane & 31, hi = lane >> 5;
  char* V_lds = lds; char* K_lds = lds + 2 * SHM_V;
  float* ws = (float*)(lds + 2 * SHM_V + 2 * SHM_K) + wid * 64; float* li_l = ws; float* al_l = ws + 32;
  const float C = scale * 1.4426950408889634f;
  float m_reg = -1e30f, l_reg = 0; f32x16 o[4] = {}; bf16x8 qr[8];
  const bf16_t* Qw = Qb + (long)(wid * QBLK + r32) * LDQ + hi * 8;
#pragma unroll
  for (int d0 = 0; d0 < 8; ++d0) qr[d0] = *reinterpret_cast<const bf16x8*>(Qw + d0 * 16);
  char* QX = lds + 2 * SHM_V + 2 * SHM_K + 2048 + (wid * 4 * 64 + lane) * 16;
  if constexpr (DKX > 0) {
#pragma unroll
    for (int ax = 0; ax < 2; ++ax) {
      const bf16x8 xa = *reinterpret_cast<const bf16x8*>(Qw + 128 + ax * 32), xb = *reinterpret_cast<const bf16x8*>(Qw + 128 + ax * 32 + 16);
      if (ropeq) {
        const float* cs = ropeq + ((size_t)(wid * QBLK + r32) * 32 + ax * 16 + hi * 8) * 2;
        float oa[8], ob[8];
#pragma unroll
        for (int j = 0; j < 8; ++j) { const float c = cs[2 * j], sn = cs[2 * j + 1], a = bf2f((unsigned short)xa[j]), b = bf2f((unsigned short)xb[j]); oa[j] = a * c - b * sn; ob[j] = a * sn + b * c; }
        u32x4 wa = {pk2(oa[0], oa[1]), pk2(oa[2], oa[3]), pk2(oa[4], oa[5]), pk2(oa[6], oa[7])}, wb = {pk2(ob[0], ob[1]), pk2(ob[2], ob[3]), pk2(ob[4], ob[5]), pk2(ob[6], ob[7])};
        *reinterpret_cast<u32x4*>(QX + (2 * ax) * 1024) = wa; *reinterpret_cast<u32x4*>(QX + (2 * ax + 1) * 1024) = wb;
      } else { *reinterpret_cast<bf16x8*>(QX + (2 * ax) * 1024) = xa; *reinterpret_cast<bf16x8*>(QX + (2 * ax + 1) * 1024) = xb; }
    }
  }
  const int sr = tid >> 4, sc = (tid & 15) * 8, vst0 = v_st(sr, sc), vst1 = v_st(32 + sr, sc);
  const int xr = tid >> 3, xc = (tid & 7) * 8;
  const int vb0 = (int)(uintptr_t)V_lds + v_rd_base(lane);
  const int offV = sr * LDV + sc, offK = sr * LDK + sc, offX = xr * 64 + xc;
  struct { bf16x8 vs0, vs1, ks0, ks1, kx; } sr_[SDEPTH];
  const int NT = nt0 + nt1;
#define TROW(j) ((j) < nt0 ? kr0 + (j) * KVBLK : kr1 + ((j) - nt0) * KVBLK)
#define SLOAD(i, j) do { const long _r = TROW(j); const bf16_t* _vt = Vm + _r * LDV; const bf16_t* _kt = Km + _r * LDK; \
    sr_[i].vs0 = *(const bf16x8*)(_vt + offV); sr_[i].vs1 = *(const bf16x8*)(_vt + offV + 32 * LDV); \
    sr_[i].ks0 = *(const bf16x8*)(_kt + offK); sr_[i].ks1 = *(const bf16x8*)(_kt + offK + 32 * LDK); \
    if constexpr (DKX > 0) sr_[i].kx = *(const bf16x8*)(Kx + _r * 64 + offX); } while (0)
#define SWRITE(b, i) do { *(bf16x8*)(V_lds + (b) * SHM_V + vst0) = sr_[i].vs0; *(bf16x8*)(V_lds + (b) * SHM_V + vst1) = sr_[i].vs1; const int kc = sc * 2; \
    *(bf16x8*)(K_lds + (b) * SHM_K + KSWZ(sr, kc)) = sr_[i].ks0; *(bf16x8*)(K_lds + (b) * SHM_K + KSWZ(32 + sr, kc)) = sr_[i].ks1; \
    if constexpr (DKX > 0) *(bf16x8*)(K_lds + (b) * SHM_K + KSWZ(xr, 256 + xc * 2)) = sr_[i].kx; } while (0)
#define SWAIT() do { if constexpr (SDEPTH == 1) asm volatile("s_waitcnt vmcnt(0)" ::: "memory"); else if constexpr (DKX > 0) asm volatile("s_waitcnt vmcnt(5)" ::: "memory"); else asm volatile("s_waitcnt vmcnt(4)" ::: "memory"); } while (0)
#define RESC(a) do { if (__any((a) < 1.f)) { if (hi == 0) al_l[r32] = (a); asm volatile("s_waitcnt lgkmcnt(0)" ::: "memory"); \
    for (int d = 0; d < 4; ++d) for (int r = 0; r < 16; ++r) o[d][r] *= al_l[crow(r, hi)]; } } while (0)
#define QKT(p0, p1, Ks) do { p0 = f32x16{}; p1 = f32x16{}; _Pragma("unroll") for (int d0 = 0; d0 < ND0; ++d0) { const int cb = (d0 * 16 + hi * 8) * 2; \
    const bf16x8 b0 = *reinterpret_cast<const bf16x8*>((Ks) + KSWZ(r32, cb)); const bf16x8 b1 = *reinterpret_cast<const bf16x8*>((Ks) + KSWZ(32 + r32, cb)); \
    const bf16x8 qf = d0 < 8 ? qr[d0 < 8 ? d0 : 0] : *reinterpret_cast<const bf16x8*>(QX + (d0 - 8) * 1024); \
    p0 = __builtin_amdgcn_mfma_f32_32x32x16_bf16(b0, qf, p0, 0, 0, 0); p1 = __builtin_amdgcn_mfma_f32_32x32x16_bf16(b1, qf, p1, 0, 0, 0); if (DKX > 0 && (d0 & 1) == 1) SBAR(); } } while (0)
#define PARTIAL_SM(p0, p1, mn, alpha) do { float pmax = p0[0]; for (int r = 1; r < 16; ++r) pmax = fmaxf(pmax, p0[r]); for (int r = 0; r < 16; ++r) pmax = fmaxf(pmax, p1[r]); \
    { auto rr = __builtin_amdgcn_permlane32_swap(__float_as_uint(pmax), __float_as_uint(pmax), false, false); pmax = fmaxf(__uint_as_float(rr[0]), __uint_as_float(rr[1])); } \
    if (__builtin_expect(__all((pmax - m_reg) * scale <= THR), 1)) { mn = m_reg; alpha = 1.f; } \
    else { mn = fmaxf(m_reg, pmax); alpha = __builtin_amdgcn_exp2f((m_reg - mn) * C); m_reg = mn; } \
    const float mnC = -mn * C; for (int r = 0; r < 16; ++r) p0[r] = fmaf(p0[r], C, mnC); for (int r = 0; r < 16; ++r) p1[r] = fmaf(p1[r], C, mnC); \
    for (int r = 0; r < 16; ++r) p0[r] = __builtin_amdgcn_exp2f(p0[r]); } while (0)
#define PK4(P, BASE, OUT) do { unsigned a0 = pk2(P[BASE + 0], P[BASE + 1]), a1 = pk2(P[BASE + 2], P[BASE + 3]); \
    unsigned b0 = pk2(P[BASE + 4], P[BASE + 5]), b1 = pk2(P[BASE + 6], P[BASE + 7]); \
    auto r0 = __builtin_amdgcn_permlane32_swap(a0, b0, false, false); auto r1 = __builtin_amdgcn_permlane32_swap(a1, b1, false, false); \
    u32x4 w = {r0[0], r1[0], r0[1], r1[1]}; OUT = *reinterpret_cast<bf16x8*>(&w); } while (0)
#define FINISH_SM(p0, p1, alpha) do { for (int r = 0; r < 16; ++r) p1[r] = __builtin_amdgcn_exp2f(p1[r]); \
    float ps = 0; for (int r = 0; r < 16; ++r) ps += p0[r]; for (int r = 0; r < 16; ++r) ps += p1[r]; \
    { auto rr = __builtin_amdgcn_permlane32_swap(__float_as_uint(ps), __float_as_uint(ps), false, false); ps = __uint_as_float(rr[0]) + __uint_as_float(rr[1]); } \
    l_reg = l_reg * alpha + ps; PK4(p0, 0, pa0); PK4(p0, 8, pa1); PK4(p1, 0, pa2); PK4(p1, 8, pa3); } while (0)
  f32x16 pA0, pA1, pB0, pB1; float mnA, mnB, alA, alB; bf16x8 pa0, pa1, pa2, pa3;
  constexpr int SE = 0, SO = SDEPTH - 1;
  SLOAD(SE, 0); asm volatile("s_waitcnt vmcnt(0)" ::: "memory"); SWRITE(0, SE); __syncthreads();
  QKT(pA0, pA1, K_lds); PARTIAL_SM(pA0, pA1, mnA, alA);
  SLOAD(SO, 1); if constexpr (SDEPTH == 2) { if (2 < NT) SLOAD(SE, 2); }
  SWAIT(); SWRITE(1, SO); __syncthreads();
  for (int j = 1; j + 1 < NT; j += 2) {
    SBAR(); QKT(pB0, pB1, K_lds + SHM_K);
    FINISH_SM(pA0, pA1, alA); SBAR();
    SLOAD(SO, j + SDEPTH); SBAR();
    pv_d0(o, vb0, pa0, pa1, pa2, pa3); PARTIAL_SM(pB0, pB1, mnB, alB);
    __syncthreads(); SWAIT(); SWRITE(0, SE);
    RESC(alB); __syncthreads();
    SBAR(); QKT(pA0, pA1, K_lds);
    FINISH_SM(pB0, pB1, alB); SBAR();
    if (SDEPTH == 1 || j + 3 < NT) SLOAD(SE, j + 1 + SDEPTH); SBAR();
    pv_d0(o, vb0 + (int)SHM_V, pa0, pa1, pa2, pa3); PARTIAL_SM(pA0, pA1, mnA, alA);
    __syncthreads(); SWAIT(); SWRITE(1, SO);
    RESC(alA); __syncthreads();
  }
  SBAR(); QKT(pB0, pB1, K_lds + SHM_K);
  FINISH_SM(pA0, pA1, alA); SBAR();
  pv_d0(o, vb0, pa0, pa1, pa2, pa3); PARTIAL_SM(pB0, pB1, mnB, alB);
  __syncthreads(); RESC(alB);
  FINISH_SM(pB0, pB1, alB); SBAR();
  pv_d0(o, vb0 + (int)SHM_V, pa0, pa1, pa2, pa3);
  if (hi == 0) li_l[r32] = l_reg; asm volatile("s_waitcnt lgkmcnt(0)" ::: "memory");
  float rli[16];
#pragma unroll
  for (int r = 0; r < 16; ++r) rli[r] = __builtin_amdgcn_rcpf(li_l[crow(r, hi)]);
  bf16_t* Ow = Ob + (long)(wid * QBLK) * LDO;
#pragma unroll
  for (int r = 0; r < 16; ++r) { const int orow = crow(r, hi);
#pragma unroll
    for (int d0 = 0; d0 < 4; ++d0) Ow[(long)orow * LDO + d0 * 32 + r32] = (bf16_t)f2bf(o[d0][r] * rli[r]); }
  __syncthreads();
#undef KSWZ
#undef TROW
#undef SLOAD
#undef SWRITE
#undef SWAIT
#undef RESC
#undef QKT
#undef PARTIAL_SM
#undef PK4
#undef FINISH_SM
}
}

namespace ml {
constexpr int LD = 264, ROWB = LD * 2, QS_OFF = 0, KS_OFF = 64 * ROWB, VS_OFF = 2 * 64 * ROWB, NV_OFF = 3 * 64 * ROWB, SC_OFF = NV_OFF + 1024, ML_END = SC_OFF + 2048;
static_assert(ML_END <= LDS_BYTES - 1024, "mlstm lds");
#define MFMA32(a, b, c) __builtin_amdgcn_mfma_f32_32x32x16_bf16((a), (b), (c), 0, 0, 0)
DI bf16x8 pack_step(const f32x16& x, int s) {
    u32x4 p;
    asm volatile("v_cvt_pk_bf16_f32 %0, %4, %5\n\tv_cvt_pk_bf16_f32 %1, %6, %7\n\tv_cvt_pk_bf16_f32 %2, %8, %9\n\tv_cvt_pk_bf16_f32 %3, %10, %11\n\ts_nop 1"
                 : "=&v"(p[0]), "=&v"(p[1]), "=&v"(p[2]), "=&v"(p[3])
                 : "v"(x[8 * s]), "v"(x[8 * s + 1]), "v"(x[8 * s + 2]), "v"(x[8 * s + 3]), "v"(x[8 * s + 4]), "v"(x[8 * s + 5]), "v"(x[8 * s + 6]), "v"(x[8 * s + 7]));
    return __builtin_bit_cast(bf16x8, p);
}
DI bf16x8 ld_perm(const LAS unsigned char* p) {
    const s16x4 lo = *(const LAS s16x4*)p, hi = *(const LAS s16x4*)(p + 16);
    return (bf16x8){lo[0], lo[1], lo[2], lo[3], hi[0], hi[1], hi[2], hi[3]};
}
DI int crow(int r, int hi) { return (r & 3) + 8 * (r >> 2) + 4 * hi; }
template <int OFF> DI s16x4 tr_rd(unsigned addr) { s16x4 r; asm volatile("ds_read_b64_tr_b16 %0, %1 offset:%2" : "=&v"(r) : "v"(addr), "i"(OFF) : "memory"); return r; }
#define TR_WAIT() do { asm volatile("s_waitcnt lgkmcnt(0)" ::: "memory"); __builtin_amdgcn_sched_barrier(0); } while (0)
#define CAT8(L, H) (bf16x8){L[0], L[1], L[2], L[3], H[0], H[1], H[2], H[3]}

DI void mlstm_stream(const Frame& F, const Args& a, int l, int stream, bool ctx_out) {
    const int b = stream >> 3, hd = (stream >> 1) & 3, dir = stream & 1;
    const int tid = F.tid, w = F.wave;
    LAS unsigned char* lds = F.lds;
    const unsigned ldsb = (unsigned)(uintptr_t)lds;
    const bf16_t* P = (const bf16_t*)(F.ws + WS_P); const float* X80 = (const float*)(F.ws + WS_X80);
    float* MLH = (float*)(F.ws + WS_MLH) + (size_t)dir * MTOT * 1024;
    const float* gb = a.in[I_GBIAS] + l * 16;
    const float gbi = gb[dir * 8 + hd], gbf = gb[dir * 8 + 4 + hd];
    LAS float* NV = (LAS float*)(lds + NV_OFF);
    LAS float* SC = (LAS float*)(lds + SC_OFF);
    f32x16 CT[8];
#pragma unroll
    for (int i = 0; i < 8; ++i) CT[i] = f32x16{};
    if (tid < 256) NV[tid] = 0.f;
    float m_prev = 0.f;
    const int sgn = dir ? -1 : 1;
#define CHUNK_ROW0(c) ((c) < 4 ? MLAT + b * CTXL + (dir ? 255 - (c) * 64 : (c) * 64) : b * SEQ + (dir ? 2047 - ((c) - 4) * 64 : ((c) - 4) * 64))
    bf16x8 pq[4], pk[4], pv[4]; float pgi, pgf;
#define PREFETCH(c) do { int ln_ = F.lane; asm volatile("" : "+v"(ln_)); const int r0_ = CHUNK_ROW0(c); \
        const bf16_t* pr_ = P + (size_t)(r0_ + sgn * ((w << 3) | (ln_ >> 3))) * NP + hd * 256 + 8 * (ln_ & 7); \
        _Pragma("unroll") for (int j = 0; j < 4; ++j) { pq[j] = *(const bf16x8*)(pr_ + C_MLQ + 64 * j); pk[j] = *(const bf16x8*)(pr_ + C_MLK + 64 * j); pv[j] = *(const bf16x8*)(pr_ + C_MLV + 64 * j); } \
        const float* xg_ = X80 + (size_t)(r0_ + sgn * ln_) * XW + 64 + dir * 8 + hd; pgi = xg_[0]; pgf = xg_[4]; } while (0)
    PREFETCH(0);
#ifndef MK_MLX
#define MK_MLX 1
#endif
    for (int cc = 0; cc < 36 * MK_MLX; ++cc) {
        const int c = cc % 36;
        if (MK_MLX > 1 && cc == 36) { __syncthreads();
#pragma unroll
            for (int i = 0; i < 8; ++i) CT[i] = f32x16{};
            if (tid < 256) NV[tid] = 0.f; m_prev = 0.f; }
        int lane = F.lane; asm volatile("" : "+v"(lane));
        const int r32 = lane & 31, hi = lane >> 5, ldi = (w << 3) | (lane >> 3), cg = lane & 7, g16 = lane >> 4, q4 = (lane & 15) >> 2, p4 = lane & 3;
        const int row0 = CHUNK_ROW0(c);
        const float ipre = pgi + gbi, fpre = pgf + gbf;
        const float lf = fminf(fpre, 0.f) - __logf(1.f + __expf(-fabsf(fpre)));
        float cum = lf;
#pragma unroll
        for (int o = 1; o < 64; o <<= 1) { const float t = shu(cum, o); if (lane >= o) cum += t; }
        const float bb = ipre - cum;
        float pmx = bb;
#pragma unroll
        for (int o = 1; o < 64; o <<= 1) { const float t = shu(pmx, o); if (lane >= o) pmx = fmaxf(pmx, t); }
        const float aa = fmaxf(m_prev, pmx);
        const float cum_end = shl_(cum, 63), a_end = shl_(aa, 63);
        const float decay = __expf(m_prev - a_end), m_new = cum_end + a_end;
        __syncthreads();
#pragma unroll
        for (int j = 0; j < 4; ++j) { const int ch = cg + 8 * j; const bf16x8 qv = pq[j];
            u32x4 qs;
            qs.x = pk2(bf2f((unsigned short)qv[0]) * 0.0625f, bf2f((unsigned short)qv[1]) * 0.0625f); qs.y = pk2(bf2f((unsigned short)qv[2]) * 0.0625f, bf2f((unsigned short)qv[3]) * 0.0625f);
            qs.z = pk2(bf2f((unsigned short)qv[4]) * 0.0625f, bf2f((unsigned short)qv[5]) * 0.0625f); qs.w = pk2(bf2f((unsigned short)qv[6]) * 0.0625f, bf2f((unsigned short)qv[7]) * 0.0625f);
            *(LAS u32x4*)(lds + QS_OFF + (ldi * LD + 8 * ch) * 2) = qs;
            *(LAS bf16x8*)(lds + KS_OFF + (ldi * LD + 8 * ch) * 2) = pk[j];
            *(LAS bf16x8*)(lds + VS_OFF + (ldi * LD + 8 * ch) * 2) = pv[j]; }
        {
            float part = 0.f;
#pragma unroll
            for (int j = 0; j < 4; ++j) { const int ch = cg + 8 * j; const bf16x8 qv = pq[j]; const f32x4 n0 = *(const LAS f32x4*)(NV + 8 * ch), n1 = *(const LAS f32x4*)(NV + 8 * ch + 4);
                part += bf2f((unsigned short)qv[0]) * n0.x + bf2f((unsigned short)qv[1]) * n0.y + bf2f((unsigned short)qv[2]) * n0.z + bf2f((unsigned short)qv[3]) * n0.w
                      + bf2f((unsigned short)qv[4]) * n1.x + bf2f((unsigned short)qv[5]) * n1.y + bf2f((unsigned short)qv[6]) * n1.z + bf2f((unsigned short)qv[7]) * n1.w; }
            part += shx(part, 1); part += shx(part, 2); part += shx(part, 4);
            if (cg == 0) SC[320 + ldi] = part * 0.0625f; }
        if (w == 0) { SC[lane] = bb; SC[64 + lane] = aa; SC[128 + lane] = __expf(m_prev - aa); SC[192 + lane] = __expf(-cum - aa); SC[256 + lane] = __expf(bb - a_end); }
        __syncthreads();
        const bool want_out = (c >= 4) || ctx_out;
        if (want_out) {
            const unsigned va0 = ldsb + VS_OFF + ((4 * (g16 >> 1) + q4) * LD + 32 * w + 16 * (g16 & 1) + 4 * p4) * 2;
#pragma unroll
            for (int lt = 0; lt < 2; ++lt) {
                const int lcol = 32 * lt + r32;
                const float a_l = SC[64 + lcol], wI_l = SC[128 + lcol], fl_l = SC[192 + lcol], nq_l = SC[320 + lcol];
                f32x16 N = f32x16{};
#pragma unroll
                for (int dt = 0; dt < 8; ++dt)
#pragma unroll
                    for (int ks = 0; ks < 2; ++ks) {
                        const bf16x8 qa = ld_perm(lds + QS_OFF + (lcol * LD + 32 * dt + 16 * ks + 4 * hi) * 2);
                        N = MFMA32(pack_step(CT[dt], ks), qa, N); if (ks == 1 && (dt & 1)) __builtin_amdgcn_sched_barrier(0); }
#pragma unroll
                for (int r = 0; r < 16; ++r) N[r] *= wI_l;
                float den = 0.f;
#pragma unroll
                for (int st = 0; st <= lt; ++st) {
                    f32x16 S = f32x16{};
#pragma unroll
                    for (int ks = 0; ks < 16; ++ks) {
                        const bf16x8 ka = *(const LAS bf16x8*)(lds + KS_OFF + ((32 * st + r32) * LD + 16 * ks + 8 * hi) * 2);
                        const bf16x8 qb = *(const LAS bf16x8*)(lds + QS_OFF + (lcol * LD + 16 * ks + 8 * hi) * 2);
                        S = MFMA32(ka, qb, S); }
                    const s16x4 v00 = st == 0 ? tr_rd<0>(va0) : tr_rd<32 * ROWB>(va0), v01 = st == 0 ? tr_rd<8 * ROWB>(va0) : tr_rd<40 * ROWB>(va0);
                    const s16x4 v10 = st == 0 ? tr_rd<16 * ROWB>(va0) : tr_rd<48 * ROWB>(va0), v11 = st == 0 ? tr_rd<24 * ROWB>(va0) : tr_rd<56 * ROWB>(va0);
#pragma unroll
                    for (int r = 0; r < 16; ++r) { const int srow = 32 * st + crow(r, hi); const float dd = __expf(SC[srow] - a_l);
                        const float v = (srow <= lcol) ? S[r] * dd : 0.f; S[r] = v; den += v; }
                    TR_WAIT();
                    N = MFMA32(CAT8(v00, v01), pack_step(S, 0), N);
                    N = MFMA32(CAT8(v10, v11), pack_step(S, 1), N);
                }
                den += shx(den, 32);
                den += wI_l * nq_l;
                const float inv = 1.f / fmaxf(fabsf(den), fl_l);
                float* orow = MLH + (size_t)(row0 + sgn * lcol) * 1024 + hd * 256 + 32 * w + 4 * hi;
#pragma unroll
                for (int g = 0; g < 4; ++g) *(f32x4*)(orow + 8 * g) = (f32x4){N[4 * g] * inv, N[4 * g + 1] * inv, N[4 * g + 2] * inv, N[4 * g + 3] * inv};
                __builtin_amdgcn_sched_barrier(0);
            }
        }
        __builtin_amdgcn_sched_barrier(0);
        { const int cn = (cc + 1 < 36 * MK_MLX) ? (cc + 1) % 36 : 35; PREFETCH(cn); }
        __builtin_amdgcn_sched_barrier(0);
        {
            const unsigned vb0 = ldsb + VS_OFF + ((8 * (g16 >> 1) + q4) * LD + 32 * w + 16 * (g16 & 1) + 4 * p4) * 2;
            const unsigned kb0 = ldsb + KS_OFF + ((8 * (g16 >> 1) + q4) * LD + 16 * (g16 & 1) + 4 * p4) * 2;
            const s16x4 b00 = tr_rd<0>(vb0), b01 = tr_rd<4 * ROWB>(vb0), b10 = tr_rd<16 * ROWB>(vb0), b11 = tr_rd<20 * ROWB>(vb0);
            const s16x4 b20 = tr_rd<32 * ROWB>(vb0), b21 = tr_rd<36 * ROWB>(vb0), b30 = tr_rd<48 * ROWB>(vb0), b31 = tr_rd<52 * ROWB>(vb0);
            TR_WAIT();
            bf16x8 vb[4];
#define SCALE8(dst, L, H, ks) do { const f32x4 w0 = *(const LAS f32x4*)(SC + 256 + 16 * (ks) + 8 * hi), w1 = *(const LAS f32x4*)(SC + 256 + 16 * (ks) + 8 * hi + 4); \
            u32x4 t_; t_.x = pk2(bf2f((unsigned short)L[0]) * w0.x, bf2f((unsigned short)L[1]) * w0.y); t_.y = pk2(bf2f((unsigned short)L[2]) * w0.z, bf2f((unsigned short)L[3]) * w0.w); \
            t_.z = pk2(bf2f((unsigned short)H[0]) * w1.x, bf2f((unsigned short)H[1]) * w1.y); t_.w = pk2(bf2f((unsigned short)H[2]) * w1.z, bf2f((unsigned short)H[3]) * w1.w); dst = __builtin_bit_cast(bf16x8, t_); } while (0)
            SCALE8(vb[0], b00, b01, 0); SCALE8(vb[1], b10, b11, 1); SCALE8(vb[2], b20, b21, 2); SCALE8(vb[3], b30, b31, 3);
#undef SCALE8
#define UPD(dt) do { const s16x4 k00 = tr_rd<(dt) * 64>(kb0), k01 = tr_rd<(dt) * 64 + 4 * ROWB>(kb0), k10 = tr_rd<(dt) * 64 + 16 * ROWB>(kb0), k11 = tr_rd<(dt) * 64 + 20 * ROWB>(kb0); \
            const s16x4 k20 = tr_rd<(dt) * 64 + 32 * ROWB>(kb0), k21 = tr_rd<(dt) * 64 + 36 * ROWB>(kb0), k30 = tr_rd<(dt) * 64 + 48 * ROWB>(kb0), k31 = tr_rd<(dt) * 64 + 52 * ROWB>(kb0); \
            _Pragma("unroll") for (int r = 0; r < 16; ++r) CT[dt][r] *= decay; \
            TR_WAIT(); \
            CT[dt] = MFMA32(CAT8(k00, k01), vb[0], CT[dt]); CT[dt] = MFMA32(CAT8(k10, k11), vb[1], CT[dt]); CT[dt] = MFMA32(CAT8(k20, k21), vb[2], CT[dt]); CT[dt] = MFMA32(CAT8(k30, k31), vb[3], CT[dt]); } while (0)
            UPD(0); UPD(1); UPD(2); UPD(3); UPD(4); UPD(5); UPD(6); UPD(7);
#undef UPD
        }
        __syncthreads();
        if (tid < 256) { float sacc = 0.f;
#pragma unroll 8
            for (int q = 0; q < 64; ++q) sacc += bf2f(*(const LAS unsigned short*)(lds + KS_OFF + (q * LD + tid) * 2)) * SC[256 + q];
            NV[tid] = decay * NV[tid] + sacc; }
        m_prev = m_new;
    }
    __syncthreads();
#undef CHUNK_ROW0
#undef PREFETCH
}

namespace u2 {
constexpr int LDQ = 264, ROWQ = LDQ * 2, LDV = 136, ROWV = LDV * 2, LDW = 72, ROWW = LDW * 2;
constexpr int QS = 0, KS = 64 * ROWQ, VS = 2 * 64 * ROWQ, SW = VS + 64 * ROWV, NV_O = SW + 64 * ROWW, SC_O = NV_O + 1024, SCN = 448, END = SC_O + 2 * SCN * 4;
static_assert(END <= LDS_BYTES - 1024, "mlstm2 lds");
}
DI void mlstm_unit2(const Frame& F, const Args& a, int l, int unit, bool ctx_out) {
    using namespace u2;
    const int stream = unit >> 1, half = unit & 1, b = stream >> 3, hd = (stream >> 1) & 3, dir = stream & 1;
    const int tid = F.tid, w = F.wave;
    LAS unsigned char* lds = F.lds;
    const unsigned ldsb = (unsigned)(uintptr_t)lds;
    const bf16_t* P = (const bf16_t*)(F.ws + WS_P); const float* X80 = (const float*)(F.ws + WS_X80);
    bf16_t* MLH = (bf16_t*)(F.ws + WS_MLH) + (size_t)dir * MTOT * 1024;
    const float* gb = a.in[I_GBIAS] + l * 16;
    const float gbi = gb[dir * 8 + hd], gbf = gb[dir * 8 + 4 + hd];
    LAS float* NV = (LAS float*)(lds + NV_O);
    const int sgn = dir ? -1 : 1;
#define CHUNK_ROW0(c) ((c) < 4 ? MLAT + b * CTXL + (dir ? 255 - (c) * 64 : (c) * 64) : b * SEQ + (dir ? 2047 - ((c) - 4) * 64 : ((c) - 4) * 64))
    const bool helper = w >= 4;
    bf16x8 pq[8], pk[8], pv[4]; float pgi = 0.f, pgf = 0.f; float m_prev = 0.f;
#define PREFETCH(c) do { int ht_ = tid - 256; asm volatile("" : "+v"(ht_)); const int r0_ = CHUNK_ROW0(c); \
        const bf16_t* pr_ = P + (size_t)(r0_ + sgn * (ht_ >> 2)) * NP + hd * 256 + 8 * (ht_ & 3); \
        _Pragma("unroll") for (int j = 0; j < 8; ++j) { pq[j] = *(const bf16x8*)(pr_ + C_MLQ + 32 * j); pk[j] = *(const bf16x8*)(pr_ + C_MLK + 32 * j); } \
        _Pragma("unroll") for (int j = 0; j < 4; ++j) pv[j] = *(const bf16x8*)(pr_ + C_MLV + 128 * half + 32 * j); \
        const float* xg_ = X80 + (size_t)(r0_ + sgn * (ht_ & 63)) * XW + 64 + dir * 8 + hd; pgi = xg_[0]; pgf = xg_[4]; } while (0)
#define SCALARS(sb) do { if (w == 4) { int ln_ = F.lane; asm volatile("" : "+v"(ln_)); LAS float* SCw = (LAS float*)(lds + SC_O) + (sb) * SCN; \
        const float ipre = pgi + gbi, fpre = pgf + gbf; const float lf = fminf(fpre, 0.f) - __logf(1.f + __expf(-fabsf(fpre))); \
        float cum = lf; _Pragma("unroll") for (int o = 1; o < 64; o <<= 1) { const float t = shu(cum, o); if (ln_ >= o) cum += t; } \
        const float bb = ipre - cum; float pmx = bb; _Pragma("unroll") for (int o = 1; o < 64; o <<= 1) { const float t = shu(pmx, o); if (ln_ >= o) pmx = fmaxf(pmx, t); } \
        const float aa = fmaxf(m_prev, pmx); const float cum_end = shl_(cum, 63), a_end = shl_(aa, 63); \
        { SCw[ln_] = bb; SCw[64 + ln_] = aa; SCw[128 + ln_] = __expf(m_prev - aa); SCw[192 + ln_] = __expf(-cum - aa); SCw[256 + ln_] = __expf(bb - a_end); if (ln_ == 0) SCw[384] = __expf(m_prev - a_end); } \
        m_prev = cum_end + a_end; } } while (0)
#define WRITE_Q() do { int ht_ = tid - 256; asm volatile("" : "+v"(ht_)); const int hp_ = ht_ >> 2, hg_ = ht_ & 3; \
        _Pragma("unroll") for (int j = 0; j < 8; ++j) { const bf16x8 qv = pq[j]; u32x4 qs; \
            qs.x = pk2(bf2f((unsigned short)qv[0]) * 0.0625f, bf2f((unsigned short)qv[1]) * 0.0625f); qs.y = pk2(bf2f((unsigned short)qv[2]) * 0.0625f, bf2f((unsigned short)qv[3]) * 0.0625f); \
            qs.z = pk2(bf2f((unsigned short)qv[4]) * 0.0625f, bf2f((unsigned short)qv[5]) * 0.0625f); qs.w = pk2(bf2f((unsigned short)qv[6]) * 0.0625f, bf2f((unsigned short)qv[7]) * 0.0625f); \
            *(LAS u32x4*)(lds + QS + (hp_ * LDQ + 8 * (hg_ + 4 * j)) * 2) = qs; } } while (0)
#define WRITE_KV() do { int ht_ = tid - 256; asm volatile("" : "+v"(ht_)); const int hp_ = ht_ >> 2, hg_ = ht_ & 3; \
        _Pragma("unroll") for (int j = 0; j < 8; ++j) *(LAS bf16x8*)(lds + KS + (hp_ * LDQ + 8 * (hg_ + 4 * j)) * 2) = pk[j]; \
        _Pragma("unroll") for (int j = 0; j < 4; ++j) *(LAS bf16x8*)(lds + VS + (hp_ * LDV + 8 * (hg_ + 4 * j)) * 2) = pv[j]; } while (0)
    LAS float* DEN = (LAS float*)(lds + END);
    static_assert(END + 768 <= LDS_BYTES - 1024, "mlstm2 lds den");
    __syncthreads();
    if (helper) { NV[tid - 256] = 0.f; PREFETCH(0); SCALARS(0); WRITE_Q(); WRITE_KV(); }
    __syncthreads();
    if (!helper) {
      f32x16 CT[8];
#pragma unroll
      for (int i = 0; i < 8; ++i) CT[i] = f32x16{};
      for (int cc = 0; cc < 36 * MK_MLX; ++cc) {
        const int c = cc % 36;
        const int sb = cc & 1;
        const LAS float* SC = (const LAS float*)(lds + SC_O) + sb * SCN;
        const bool want_out = (c >= 4) || ctx_out;
        int lane = F.lane; asm volatile("" : "+v"(lane));
        const int r32 = lane & 31, hi = lane >> 5, g16 = lane >> 4, q4 = (lane & 15) >> 2, p4 = lane & 3;
        const int row0 = CHUNK_ROW0(c);
        if (MK_MLX > 1 && cc == 36) {
#pragma unroll
          for (int i = 0; i < 8; ++i) CT[i] = f32x16{}; }
        f32x16 N0 = f32x16{}, N1 = f32x16{};
        {
            if (want_out) {
#pragma unroll
                for (int dt = 0; dt < 8; ++dt)
#pragma unroll
                    for (int ks = 0; ks < 2; ++ks) {
                        const bf16x8 cf = pack_step(CT[dt], ks);
                        const bf16x8 qa0 = ld_perm(lds + QS + (r32 * LDQ + 32 * dt + 16 * ks + 4 * hi) * 2), qa1 = ld_perm(lds + QS + ((32 + r32) * LDQ + 32 * dt + 16 * ks + 4 * hi) * 2);
                        N0 = MFMA32(cf, qa0, N0); N1 = MFMA32(cf, qa1, N1); if (ks == 1 && (dt & 1)) __builtin_amdgcn_sched_barrier(0); }
                const float wI0 = SC[128 + r32], wI1 = SC[128 + 32 + r32];
#pragma unroll
                for (int r = 0; r < 16; ++r) { N0[r] *= wI0; N1[r] *= wI1; }
            }
        }
        __syncthreads();
        {
            if (want_out) {
                const unsigned va0 = ldsb + VS + ((8 * (g16 >> 1) + q4) * LDV + 32 * w + 16 * (g16 & 1) + 4 * p4) * 2;
                const s16x4 a00 = tr_rd<0>(va0), a01 = tr_rd<4 * ROWV>(va0), a10 = tr_rd<16 * ROWV>(va0), a11 = tr_rd<20 * ROWV>(va0);
                const s16x4 a20 = tr_rd<32 * ROWV>(va0), a21 = tr_rd<36 * ROWV>(va0), a30 = tr_rd<48 * ROWV>(va0), a31 = tr_rd<52 * ROWV>(va0);
                const LAS unsigned char* sw0 = lds + SW + (r32 * LDW + 8 * hi) * 2; const LAS unsigned char* sw1 = sw0 + 32 * ROWW;
                const bf16x8 s00 = *(const LAS bf16x8*)(sw0), s01 = *(const LAS bf16x8*)(sw0 + 32);
                const bf16x8 s10 = *(const LAS bf16x8*)(sw1), s11 = *(const LAS bf16x8*)(sw1 + 32), s12 = *(const LAS bf16x8*)(sw1 + 64), s13 = *(const LAS bf16x8*)(sw1 + 96);
                TR_WAIT();
                N0 = MFMA32(CAT8(a00, a01), s00, N0); N0 = MFMA32(CAT8(a10, a11), s01, N0);
                N1 = MFMA32(CAT8(a00, a01), s10, N1); N1 = MFMA32(CAT8(a10, a11), s11, N1); N1 = MFMA32(CAT8(a20, a21), s12, N1); N1 = MFMA32(CAT8(a30, a31), s13, N1);
                {
                    const float den0 = DEN[r32] + SC[128 + r32] * SC[320 + r32];
                    const float den1 = DEN[64 + 32 + r32] + DEN[128 + 32 + r32] + SC[128 + 32 + r32] * SC[320 + 32 + r32];
                    const float inv0 = 1.f / fmaxf(fabsf(den0), SC[192 + r32]), inv1 = 1.f / fmaxf(fabsf(den1), SC[192 + 32 + r32]);
                    bf16_t* o0 = MLH + (size_t)(row0 + sgn * r32) * 1024 + hd * 256 + 128 * half + 32 * w + 4 * hi; bf16_t* o1 = MLH + (size_t)(row0 + sgn * (32 + r32)) * 1024 + hd * 256 + 128 * half + 32 * w + 4 * hi;
#pragma unroll
                    for (int g = 0; g < 4; ++g) { u32x2 t0, t1; t0.x = pk2(N0[4 * g] * inv0, N0[4 * g + 1] * inv0); t0.y = pk2(N0[4 * g + 2] * inv0, N0[4 * g + 3] * inv0);
                        t1.x = pk2(N1[4 * g] * inv1, N1[4 * g + 1] * inv1); t1.y = pk2(N1[4 * g + 2] * inv1, N1[4 * g + 3] * inv1);
                        *(u32x2*)(o0 + 8 * g) = t0; *(u32x2*)(o1 + 8 * g) = t1; }
                }
            }
            __builtin_amdgcn_sched_barrier(0);
            {
                const float decay = SC[384];
                const unsigned vb0 = ldsb + VS + ((8 * (g16 >> 1) + q4) * LDV + 32 * w + 16 * (g16 & 1) + 4 * p4) * 2;
                const unsigned kb0 = ldsb + KS + ((8 * (g16 >> 1) + q4) * LDQ + 16 * (g16 & 1) + 4 * p4) * 2;
                const s16x4 b00 = tr_rd<0>(vb0), b01 = tr_rd<4 * ROWV>(vb0), b10 = tr_rd<16 * ROWV>(vb0), b11 = tr_rd<20 * ROWV>(vb0);
                const s16x4 b20 = tr_rd<32 * ROWV>(vb0), b21 = tr_rd<36 * ROWV>(vb0), b30 = tr_rd<48 * ROWV>(vb0), b31 = tr_rd<52 * ROWV>(vb0);
                TR_WAIT();
                bf16x8 vb[4];
#define SCALE8(dst, L, H, ks) do { const f32x4 w0 = *(const LAS f32x4*)(SC + 256 + 16 * (ks) + 8 * hi), w1 = *(const LAS f32x4*)(SC + 256 + 16 * (ks) + 8 * hi + 4); \
                u32x4 t_; t_.x = pk2(bf2f((unsigned short)L[0]) * w0.x, bf2f((unsigned short)L[1]) * w0.y); t_.y = pk2(bf2f((unsigned short)L[2]) * w0.z, bf2f((unsigned short)L[3]) * w0.w); \
                t_.z = pk2(bf2f((unsigned short)H[0]) * w1.x, bf2f((unsigned short)H[1]) * w1.y); t_.w = pk2(bf2f((unsigned short)H[2]) * w1.z, bf2f((unsigned short)H[3]) * w1.w); dst = __builtin_bit_cast(bf16x8, t_); } while (0)
                SCALE8(vb[0], b00, b01, 0); SCALE8(vb[1], b10, b11, 1); SCALE8(vb[2], b20, b21, 2); SCALE8(vb[3], b30, b31, 3);
#undef SCALE8
#define UPD(dt) do { const s16x4 k00 = tr_rd<(dt) * 64>(kb0), k01 = tr_rd<(dt) * 64 + 4 * ROWQ>(kb0), k10 = tr_rd<(dt) * 64 + 16 * ROWQ>(kb0), k11 = tr_rd<(dt) * 64 + 20 * ROWQ>(kb0); \
                const s16x4 k20 = tr_rd<(dt) * 64 + 32 * ROWQ>(kb0), k21 = tr_rd<(dt) * 64 + 36 * ROWQ>(kb0), k30 = tr_rd<(dt) * 64 + 48 * ROWQ>(kb0), k31 = tr_rd<(dt) * 64 + 52 * ROWQ>(kb0); \
                _Pragma("unroll") for (int r = 0; r < 16; ++r) CT[dt][r] *= decay; \
                TR_WAIT(); \
                CT[dt] = MFMA32(CAT8(k00, k01), vb[0], CT[dt]); CT[dt] = MFMA32(CAT8(k10, k11), vb[1], CT[dt]); CT[dt] = MFMA32(CAT8(k20, k21), vb[2], CT[dt]); CT[dt] = MFMA32(CAT8(k30, k31), vb[3], CT[dt]); } while (0)
                UPD(0); UPD(1); UPD(2); UPD(3); UPD(4); UPD(5); UPD(6); UPD(7);
#undef UPD
            }
        }
        __syncthreads();
        __syncthreads();
      }
    } else {
      for (int cc = 0; cc < 36 * MK_MLX; ++cc) {
        const int c = cc % 36;
        const int sb = cc & 1;
        const LAS float* SC = (const LAS float*)(lds + SC_O) + sb * SCN;
        const bool want_out = (c >= 4) || ctx_out;
        int lane = F.lane; asm volatile("" : "+v"(lane));
        const int r32 = lane & 31, hi = lane >> 5, g16 = lane >> 4, q4 = (lane & 15) >> 2, p4 = lane & 3;
        const int row0 = CHUNK_ROW0(c);
        { const int cn = (cc + 1 < 36 * MK_MLX) ? (cc + 1) % 36 : 35; PREFETCH(cn); }
        {
            if (want_out) {
                if (w < 7) {
                    const int st = (w == 6) ? 1 : 0, lt = (w == 4) ? 0 : 1, lcol = 32 * lt + r32;
                    f32x16 S = f32x16{};
#pragma unroll
                    for (int ks = 0; ks < 16; ++ks) {
                        const bf16x8 ka = *(const LAS bf16x8*)(lds + KS + ((32 * st + r32) * LDQ + 16 * ks + 8 * hi) * 2);
                        const bf16x8 qb = *(const LAS bf16x8*)(lds + QS + (lcol * LDQ + 16 * ks + 8 * hi) * 2);
                        S = MFMA32(ka, qb, S); }
                    const float a_l = SC[64 + lcol]; float den = 0.f;
#pragma unroll
                    for (int r = 0; r < 16; ++r) { const int srow = 32 * st + crow(r, hi); const float dd = __expf(SC[srow] - a_l);
                        const float v = (srow <= lcol) ? S[r] * dd : 0.f; S[r] = v; den += v; }
                    den += shx(den, 32);
                    if (hi == 0) DEN[(w - 4) * 64 + lcol] = den;
#pragma unroll
                    for (int g = 0; g < 4; ++g) { u32x2 t_; t_.x = pk2(S[4 * g], S[4 * g + 1]); t_.y = pk2(S[4 * g + 2], S[4 * g + 3]);
                        *(LAS u32x2*)(lds + SW + (lcol * LDW + 32 * st + 8 * g + 4 * hi) * 2) = t_; }
                } else {
                    float nq = 0.f; const LAS unsigned char* qrow = lds + QS + lane * ROWQ;
#pragma unroll 4
                    for (int d8 = 0; d8 < 32; ++d8) { const bf16x8 qv = *(const LAS bf16x8*)(qrow + d8 * 16); const f32x4 n0 = *(const LAS f32x4*)(NV + 8 * d8), n1 = *(const LAS f32x4*)(NV + 8 * d8 + 4);
                        nq += bf2f((unsigned short)qv[0]) * n0.x + bf2f((unsigned short)qv[1]) * n0.y + bf2f((unsigned short)qv[2]) * n0.z + bf2f((unsigned short)qv[3]) * n0.w
                            + bf2f((unsigned short)qv[4]) * n1.x + bf2f((unsigned short)qv[5]) * n1.y + bf2f((unsigned short)qv[6]) * n1.z + bf2f((unsigned short)qv[7]) * n1.w; }
                    ((LAS float*)(lds + SC_O) + sb * SCN)[320 + lane] = nq;
                }
            }
        }
        __syncthreads();
        {
            if (w == 7) {
                const int dg = lane & 31, sh = lane >> 5; const float decay = SC[384];
                float ac[8];
#pragma unroll
                for (int j = 0; j < 8; ++j) ac[j] = 0.f;
#pragma unroll 4
                for (int q = 0; q < 32; ++q) { const int srow = 32 * sh + q; const bf16x8 kv = *(const LAS bf16x8*)(lds + KS + (srow * LDQ + 8 * dg) * 2); const float wq = SC[256 + srow];
#pragma unroll
                    for (int j = 0; j < 8; ++j) ac[j] += bf2f((unsigned short)kv[j]) * wq; }
#pragma unroll
                for (int j = 0; j < 8; ++j) ac[j] += shx(ac[j], 32);
                if (sh == 0) {
                    f32x4 n0 = *(LAS f32x4*)(NV + 8 * dg), n1 = *(LAS f32x4*)(NV + 8 * dg + 4);
                    n0 = n0 * decay + (f32x4){ac[0], ac[1], ac[2], ac[3]}; n1 = n1 * decay + (f32x4){ac[4], ac[5], ac[6], ac[7]};
                    if (MK_MLX > 1 && cc == 35) { n0 = (f32x4){0.f, 0.f, 0.f, 0.f}; n1 = n0; }
                    *(LAS f32x4*)(NV + 8 * dg) = n0; *(LAS f32x4*)(NV + 8 * dg + 4) = n1; }
            }
            if (MK_MLX > 1 && cc == 35) m_prev = 0.f;
            SCALARS(sb ^ 1);
            WRITE_Q();
        }
        __syncthreads();
        WRITE_KV();
        __syncthreads();
      }
    }
#undef CHUNK_ROW0
#undef PREFETCH
#undef SCALARS
#undef WRITE_Q
#undef WRITE_KV
}
#undef MFMA32
#undef TR_WAIT
#undef CAT8
}

DI void phase_mixers(const Frame& F, const Args& a, int l, char* ldsg, int npass) {
    unsigned* head0 = (unsigned*)(F.ws + WS_CTL) + CW_QUEUE + 64 * l;
    volatile LAS unsigned* MISC = (volatile LAS unsigned*)(F.lds + LDS_BYTES - 64);
    const int n_ml = 64, n_la = 256, n_ga = 256, n_cx = (l == 0) ? 32 : 0, n_mix = n_ml + n_la + n_ga + 2 * n_cx;
    const int total = n_mix;
    const bf16_t* QLA = (const bf16_t*)(F.ws + WS_QLA); const bf16_t* KVLA = (const bf16_t*)(F.ws + WS_KVLA); const bf16_t* KR = (const bf16_t*)(F.ws + WS_KR);
    const bf16_t* QG = (const bf16_t*)(F.ws + WS_QG); const bf16_t* KG = (const bf16_t*)(F.ws + WS_KG); const bf16_t* P = (const bf16_t*)(F.ws + WS_P);
    bf16_t* YCAT = (bf16_t*)(F.ws + WS_YCAT);
#ifndef MK_MIX
#define MK_MIX 7
#endif
#define GRAB(u) do { __syncthreads(); if (F.tid == 0) MISC[4] = __hip_atomic_fetch_add(head, 1u, __ATOMIC_RELAXED, __HIP_MEMORY_SCOPE_AGENT); __syncthreads(); u = __builtin_amdgcn_readfirstlane((int)MISC[4]); } while (0)
    for (int pass = 0; pass < npass; ++pass) {
    unsigned* head = head0 + 128 * pass;
    int u0;
    GRAB(u0);
    while (u0 < n_ml) { if (MK_MIX & 1) ml::mlstm_unit2(F, a, l, u0, l == 0); GRAB(u0); }
    while (u0 < n_mix) {
        int u = u0 - n_ml;
        if (u < n_la) { const int b = u >> 6, h = (u >> 3) & 7, qb = u & 7; const long q0 = (long)b * SEQ + qb * 256;
            if (MK_MIX & 2) att::attn_body<64, 1536, 2048, 2048, 3072>(QLA + q0 * 1536 + h * 192, KVLA + h * 256, KR, KVLA + h * 256 + 128, YCAT + q0 * 3072 + 1024 + h * 128,
                                                      MLAT + b * CTXL, 4, b * SEQ, 32, 0.07216878364870322f, (const float*)(F.ws + WS_ROPE_LA) + (size_t)qb * 256 * 64, ldsg); }
        else if (u < n_la + n_ga) { u -= n_la; const int b = u >> 6, h = (u >> 3) & 7, qb = u & 7; const long q0 = (long)b * SEQ + qb * 256;
            if (MK_MIX & 4) att::attn_body<0, 1024, 256, NP, 3072>(QG + q0 * 1024 + h * 128, KG + (h >> 2) * 128, nullptr, P + C_GV + (h >> 2) * 128, YCAT + q0 * 3072 + 2048 + h * 128,
                                                  MLAT + b * CTXL, 4, b * SEQ, 32, 0.08838834764831845f, nullptr, ldsg); }
        else if (u < n_la + n_ga + n_cx) { u -= n_la + n_ga; const int b = u >> 3, h = u & 7; const long q0 = (long)MLAT + b * CTXL;
            if (MK_MIX & 2) att::attn_body<64, 1536, 2048, 2048, 3072>(QLA + q0 * 1536 + h * 192, KVLA + h * 256, KR, KVLA + h * 256 + 128, YCAT + q0 * 3072 + 1024 + h * 128,
                                                      MLAT + b * CTXL, 4, 0, 0, 0.07216878364870322f, nullptr, ldsg); }
        else { u -= n_la + n_ga + n_cx; const int b = u >> 3, h = u & 7; const long q0 = (long)MLAT + b * CTXL;
            if (MK_MIX & 4) att::attn_body<0, 1024, 256, NP, 3072>(QG + q0 * 1024 + h * 128, KG + (h >> 2) * 128, nullptr, P + C_GV + (h >> 2) * 128, YCAT + q0 * 3072 + 2048 + h * 128,
                                                  MLAT + b * CTXL, 4, 0, 0, 0.08838834764831845f, nullptr, ldsg); }
        GRAB(u0);
    }
    }
#undef GRAB
}

DI void phase_convert_tail(const Frame& F0, const Args& a, int l) {
    Frame F = F0; { int t_ = threadIdx.x; asm volatile("" : "+v"(t_)); F.tid = t_; F.lane = t_ & 63; F.wave = __builtin_amdgcn_readfirstlane(t_ >> 6); }
    constexpr int CVB = 64;
    unsigned* head = (unsigned*)(F.ws + WS_CTL) + CW_QUEUE + 64 * l + 32;
    volatile LAS unsigned* MISC = (volatile LAS unsigned*)(F.lds + LDS_BYTES - 64);
    const int n_cv = ((IT_LAYER - IT_EARLY) + ((l == 0) ? IT_EARLY : 0)) / CVB;
    LAS float* scr = (LAS float*)(F.lds + F.wave * 16384);
    for (;;) {
        __syncthreads();
        if (F.tid == 0) MISC[4] = __hip_atomic_fetch_add(head, 1u, __ATOMIC_RELAXED, __HIP_MEMORY_SCOPE_AGENT);
        __syncthreads();
        const int blk = __builtin_amdgcn_readfirstlane((int)MISC[4]);
        if (blk >= n_cv) break;
#pragma unroll 1
        for (int q = 0; q < CVB / NWAVES; ++q) { const int r = blk * CVB + q * NWAVES + F.wave;
            if (r < IT_LAYER - IT_EARLY) convert_item(F, a, l, IT_EARLY + r, scr); else convert_item(F, a, 1, r - (IT_LAYER - IT_EARLY), scr); }
    }
}

constexpr int FILL_BLK = 16, FILL_NBLK = IT_LAYER / FILL_BLK;
static_assert(IT_LAYER % FILL_BLK == 0, "fill blocks");
DI void fill_convert(const Frame& F0_, const Args& a, int ph, bool drain) {
    Frame F = F0_; { int t_ = threadIdx.x; asm volatile("" : "+v"(t_)); F.tid = t_; F.lane = t_ & 63; F.wave = __builtin_amdgcn_readfirstlane(t_ >> 6); }
    unsigned* ctl = (unsigned*)(F.ws + WS_CTL); unsigned* head = ctl + CW_CVHEAD; unsigned* done = ctl + CW_PHDONE + 64 * ph;
    volatile LAS unsigned* MISC = (volatile LAS unsigned*)(F.lds + LDS_BYTES - 64);
    LAS float* scr = (LAS float*)(F.lds + F.wave * 16384);
    __syncthreads();
    if (!drain && F.tid == 0) __hip_atomic_fetch_add(done, 1u, __ATOMIC_RELAXED, __HIP_MEMORY_SCOPE_AGENT);
    for (;;) {
        if (F.tid == 0) { unsigned blk = 0xffffffffu;
            if (drain || __hip_atomic_load(done, __ATOMIC_RELAXED, __HIP_MEMORY_SCOPE_AGENT) < (unsigned)F.G) blk = __hip_atomic_fetch_add(head, 1u, __ATOMIC_RELAXED, __HIP_MEMORY_SCOPE_AGENT);
            MISC[4] = blk; }
        __syncthreads();
        const unsigned blk = (unsigned)__builtin_amdgcn_readfirstlane((int)MISC[4]);
        __syncthreads();
        if (blk >= (unsigned)FILL_NBLK) break;
        convert_range(F, a, IT_LAYER + (int)blk * FILL_BLK + F.wave, NWAVES, IT_LAYER + ((int)blk + 1) * FILL_BLK, scr);
    }
}

DI void phase_convert_side(const Frame& F0_, const Args& a, int bid, int it_lo, int it_hi) {
    const int step = MK_CVSIDE, ncv = (256 + step - 1) / step;
    if (bid % step != 0 || F0_.G != 256) { if (F0_.G != 256) { Frame Fx = F0_; LAS float* scr = (LAS float*)(Fx.lds + Fx.wave * 16384); convert_range(Fx, a, it_lo + Fx.gw, Fx.ngw, it_hi, scr); } return; }
    Frame F = F0_; { int t_ = threadIdx.x; asm volatile("" : "+v"(t_)); F.tid = t_; F.lane = t_ & 63; F.wave = __builtin_amdgcn_readfirstlane(t_ >> 6); }
    LAS float* scr = (LAS float*)(F.lds + F.wave * 16384);
    const int j = bid / step, per = (it_hi - it_lo + ncv - 1) / ncv, lo = it_lo + j * per, hi = (lo + per < it_hi) ? lo + per : it_hi;
    convert_range(F, a, lo + F.wave, NWAVES, hi, scr);
    __syncthreads();
}

DI void phase_mlfin(const Frame& F, const Args& a, int l, int nrows) {
    const bf16_t* H0 = (const bf16_t*)(F.ws + WS_MLH); const bf16_t* H1 = H0 + (size_t)MTOT * 1024;
    const bf16_t* P = (const bf16_t*)(F.ws + WS_P); bf16_t* YCAT = (bf16_t*)(F.ws + WS_YCAT); const float* gn = a.in[I_MLNORM] + l * 1024;
    int row = F.gw; if (row >= nrows) return;
    s16x4 c0[4], c1[4]; s16x4 co[4];
#define MLF_LOAD(r_, a0, a1, ao) do { _Pragma("unroll") for (int hd = 0; hd < 4; ++hd) { const int c = hd * 256 + 4 * F.lane; a0[hd] = *(const s16x4*)(H0 + (size_t)(r_) * 1024 + c); a1[hd] = *(const s16x4*)(H1 + (size_t)(r_) * 1024 + c); \
        ao[hd] = *(const s16x4*)(P + (size_t)(r_) * NP + C_MLO + c); } } while (0)
    MLF_LOAD(row, c0, c1, co);
    f32x4 gv[4];
#pragma unroll
    for (int hd = 0; hd < 4; ++hd) gv[hd] = *(const f32x4*)(gn + hd * 256 + 4 * F.lane);
    for (;;) {
        const int nrow = row + F.ngw; const bool hn = nrow < nrows; const int pr = hn ? nrow : row;
        s16x4 n0[4], n1[4]; s16x4 no[4]; MLF_LOAD(pr, n0, n1, no);
#pragma unroll
        for (int hd = 0; hd < 4; ++hd) { const int c = hd * 256 + 4 * F.lane;
            const f32x4 v = (f32x4){bf2f((unsigned short)c0[hd][0]) + bf2f((unsigned short)c1[hd][0]), bf2f((unsigned short)c0[hd][1]) + bf2f((unsigned short)c1[hd][1]), bf2f((unsigned short)c0[hd][2]) + bf2f((unsigned short)c1[hd][2]), bf2f((unsigned short)c0[hd][3]) + bf2f((unsigned short)c1[hd][3])};
            const float rs = rsqrtf(wave_sum(v.x * v.x + v.y * v.y + v.z * v.z + v.w * v.w) * (1.f / 256.f) + EPS);
            const f32x4 g = gv[hd]; const s16x4 og = co[hd];
            u32x2 w; w.x = pk2(v.x * rs * g.x * sigmoidf_(bf2f((unsigned short)og[0])), v.y * rs * g.y * sigmoidf_(bf2f((unsigned short)og[1])));
            w.y = pk2(v.z * rs * g.z * sigmoidf_(bf2f((unsigned short)og[2])), v.w * rs * g.w * sigmoidf_(bf2f((unsigned short)og[3])));
            *(u32x2*)(YCAT + (size_t)row * 3072 + c) = w; }
        if (!hn) break;
#pragma unroll
        for (int hd = 0; hd < 4; ++hd) { c0[hd] = n0[hd]; c1[hd] = n1[hd]; co[hd] = no[hd]; }
        row = nrow;
    }
#undef MLF_LOAD
}

struct SchedMerge {
    const char* Y; const char* Bt; int nM, G, c;
    DI bool next(int i, Unit& u) const {
        int pm, pn, br;
        if (nM == 36 && G == 256) {
            if (i < 3) { pg8::tile_of(c, 32, 8, pm, pn); br = i; }
            else if (i == 3 && c < 96) { const int t = c / 3; br = (c - 3 * t) | 4; pm = 32 + (t >> 3); pn = t & 7; }
            else return false;
        } else { const int k = i / 3; br = i - 3 * k; const long L = (long)k * G + c; if (L >= (long)nM * 8) return false; pg8::tile_of((int)L, nM, 8, pm, pn); }
        u.pm = pm; u.pn = pn; u.aux = br; u.nt = 16; u.pa = Y + (size_t)pm * 256 * 6144 + (br & 3) * 2048; u.pb = Bt + ((size_t)(br & 3) * 2048 + pn * 256) * 2048; return true;
    }
};
struct EpiMerge {
    const bf16_t* P; bf16_t* ZG; bf16_t* MB; bf16_t* CP; unsigned* cnt;
    DI void operator()(const f32x4 (&acc)[2][2][4][2], const Unit& u, int wr, int wc, int fr, int fq) const {
        const int br = u.aux & 3; const bool split = (u.aux & 4) != 0;
        EPI_FOREACH({
            const bf16x8 gp = *(const bf16x8*)(P + (size_t)row * NP + C_GATE + br * 2048 + col);
            f32x4 g0, g1;
            g0.x = sigmoidf_(bf2f((unsigned short)gp[0])); g0.y = sigmoidf_(bf2f((unsigned short)gp[1])); g0.z = sigmoidf_(bf2f((unsigned short)gp[2])); g0.w = sigmoidf_(bf2f((unsigned short)gp[3]));
            g1.x = sigmoidf_(bf2f((unsigned short)gp[4])); g1.y = sigmoidf_(bf2f((unsigned short)gp[5])); g1.z = sigmoidf_(bf2f((unsigned short)gp[6])); g1.w = sigmoidf_(bf2f((unsigned short)gp[7]));
            f32x4 r0 = v0 * g0, r1 = v1 * g1;
            const size_t off = (size_t)row * DM + col;
            if (split) { const u32x4 w_ = pack8(r0, r1); GAS unsigned long long* cp = (GAS unsigned long long*)(CP + ((size_t)br * MCTX + (row - MLAT)) * DM + col);
                __hip_atomic_store(cp, (unsigned long long)w_.x | ((unsigned long long)w_.y << 32), __ATOMIC_RELAXED, __HIP_MEMORY_SCOPE_AGENT);
                __hip_atomic_store(cp + 1, (unsigned long long)w_.z | ((unsigned long long)w_.w << 32), __ATOMIC_RELAXED, __HIP_MEMORY_SCOPE_AGENT); }
            else if (br < 2) *(u32x4*)(ZG + (size_t)br * MTOT * DM + off) = pack8(r0, r1);
            else { const bf16x8 z0 = *(const bf16x8*)(ZG + off), z1 = *(const bf16x8*)(ZG + (size_t)MTOT * DM + off);
                r0 += (f32x4){bf2f((unsigned short)z0[0]) + bf2f((unsigned short)z1[0]), bf2f((unsigned short)z0[1]) + bf2f((unsigned short)z1[1]), bf2f((unsigned short)z0[2]) + bf2f((unsigned short)z1[2]), bf2f((unsigned short)z0[3]) + bf2f((unsigned short)z1[3])};
                r1 += (f32x4){bf2f((unsigned short)z0[4]) + bf2f((unsigned short)z1[4]), bf2f((unsigned short)z0[5]) + bf2f((unsigned short)z1[5]), bf2f((unsigned short)z0[6]) + bf2f((unsigned short)z1[6]), bf2f((unsigned short)z0[7]) + bf2f((unsigned short)z1[7])};
                *(u32x4*)(MB + off) = pack8(r0, r1); }
        })
        if (split) {
            asm volatile("s_waitcnt vmcnt(0)" ::: "memory");
            unsigned old = 0;
            if ((fr | fq) == 0) old = __hip_atomic_fetch_add((GAS unsigned*)(cnt + (((u.pm - 32) * 8 + u.pn) * 8 + wr * 4 + wc) * 16), 1u, __ATOMIC_RELAXED, __HIP_MEMORY_SCOPE_AGENT);
            old = (unsigned)__builtin_amdgcn_readfirstlane((int)old);
            if (old == 2u) {
                EPI_FOREACH({
                    f32x4 r0 = (f32x4){0.f, 0.f, 0.f, 0.f}; f32x4 r1 = r0;
                    _Pragma("unroll") for (int ob = 0; ob < 3; ++ob) { const GAS unsigned long long* cp = (const GAS unsigned long long*)(CP + ((size_t)ob * MCTX + (row - MLAT)) * DM + col);
                        const unsigned long long a0 = __hip_atomic_load(cp, __ATOMIC_RELAXED, __HIP_MEMORY_SCOPE_AGENT), a1 = __hip_atomic_load(cp + 1, __ATOMIC_RELAXED, __HIP_MEMORY_SCOPE_AGENT);
                        r0 += (f32x4){bf2f((unsigned short)a0), bf2f((unsigned short)(a0 >> 16)), bf2f((unsigned short)(a0 >> 32)), bf2f((unsigned short)(a0 >> 48))};
                        r1 += (f32x4){bf2f((unsigned short)a1), bf2f((unsigned short)(a1 >> 16)), bf2f((unsigned short)(a1 >> 32)), bf2f((unsigned short)(a1 >> 48))}; }
                    (void)v0; (void)v1;
                    *(u32x4*)(MB + (size_t)row * DM + col) = pack8(r0, r1);
                })
            }
        }
    }
};
struct EpiOut {
    const float* xin; const float* ctxin; float* X1; const float* mods; int l;
    DI void operator()(const f32x4 (&acc)[2][2][4][2], const Unit& u, int wr, int wc, int fr, int fq) const {
        f32x4 g[2][2];
#pragma unroll
        for (int bj = 0; bj < 2; ++bj) { const float* gp = mods + ((size_t)(l * 5 + mods_row(u.pm * 256)) * 6 + 2) * DM + u.pn * 256 + bj * 128 + wc * 32 + 8 * fq;
            g[bj][0] = *(const f32x4*)gp; g[bj][1] = *(const f32x4*)(gp + 4); }
        EPI_FOREACH({
            const float* rp = (l == 0) ? (row < MLAT ? xin + (size_t)row * DM : ctxin + (size_t)(row - MLAT) * DM) : X1 + (size_t)row * DM;
            float* op = X1 + (size_t)row * DM + col;
            *(f32x4*)op = *(const f32x4*)(rp + col) + g[bj][0] * v0; *(f32x4*)(op + 4) = *(const f32x4*)(rp + col + 4) + g[bj][1] * v1;
        })
    }
};
DI void phase_topk(const Frame& F, const Args& a, int l, int bid) {
    const float* AFF = (const float*)(F.ws + WS_AFF);
    int* ROWS = (int*)(F.ws + WS_ROWS); float* VALS = (float*)(F.ws + WS_VALS); int* TOK = (int*)(F.ws + WS_TOK);
    LAS unsigned* cntr = (LAS unsigned*)F.lds;
    LAS unsigned* cg = cntr + 64; LAS unsigned* ce = cntr + 96;
    const int nitems = (l == 0) ? 256 + 64 + 16 : 256;
    const int lane = F.lane, wave = F.wave;
    for (int it = bid; it < nitems; it += F.G) {
        if (it >= 320) {
            const int e = it - 320;
            for (int s = F.tid; s < 128; s += NTHR) { ROWS[e * ESLOT + 1152 + s] = -1; VALS[e * ESLOT + 1152 + s] = 0.f; }
            continue;
        }
        const int lat = it < 256, b = lat ? (it >> 6) : ((it - 256) >> 4), e = lat ? ((it >> 2) & 15) : ((it - 256) & 15), qtr = lat ? (it & 3) : 0;
        const int ntok = lat ? SEQ : CTXL, rowbase = lat ? b * SEQ : MLAT + b * CTXL, slotbase = lat ? b * 256 : 1024 + b * 32;
        const unsigned cap = (unsigned)(ntok >> 3);
        __syncthreads();
        if (F.tid < 128) cntr[F.tid] = 0u;
        unsigned key[4];
#pragma unroll
        for (int q = 0; q < 4; ++q) { const int i = q * 512 + F.tid; key[q] = i < ntok ? __float_as_uint(AFF[(size_t)e * MTOT + rowbase + i]) : 0u; }
        __syncthreads();
        unsigned T = 0u;
#pragma unroll 1
        for (int r = 0; r < 16; ++r) { const int sh = 30 - 2 * r;
            const unsigned c1 = T | (1u << sh), c2 = T | (2u << sh), c3 = T | (3u << sh);
            unsigned n1 = 0, n2 = 0, n3 = 0;
#pragma unroll
            for (int q = 0; q < 4; ++q) { n1 += (unsigned)__builtin_popcountll(__ballot(key[q] >= c1)); n2 += (unsigned)__builtin_popcountll(__ballot(key[q] >= c2)); n3 += (unsigned)__builtin_popcountll(__ballot(key[q] >= c3)); }
            if (lane == 0) { atomicAdd((unsigned*)(cntr + r * 4 + 0), n1); atomicAdd((unsigned*)(cntr + r * 4 + 1), n2); atomicAdd((unsigned*)(cntr + r * 4 + 2), n3); }
            __syncthreads();
            const unsigned t1 = cntr[r * 4 + 0], t2 = cntr[r * 4 + 1], t3 = cntr[r * 4 + 2];
            T = t3 >= cap ? c3 : (t2 >= cap ? c2 : (t1 >= cap ? c1 : T));
        }
        unsigned long long bg_own = 0ull, be_own = 0ull; unsigned kown = 0u;
#pragma unroll
        for (int q = 0; q < 4; ++q) { const unsigned long long bg = __ballot(key[q] > T), be = __ballot(key[q] == T);
            if (lane == 0) { cg[q * 8 + wave] = (unsigned)__builtin_popcountll(bg); ce[q * 8 + wave] = (unsigned)__builtin_popcountll(be); }
            if (q == qtr) { bg_own = bg; be_own = be; kown = key[q]; } }
        __syncthreads();
        unsigned ngt = 0, gtb = 0, eqb = 0; const int me = qtr * 8 + wave;
#pragma unroll 1
        for (int k = 0; k < 32; ++k) { const unsigned g = cg[k], q_ = ce[k]; ngt += g; if (k < me) { gtb += g; eqb += q_; } }
        const unsigned need = cap - ngt;
        const unsigned long long lt = (1ull << lane) - 1ull;
        const int i = qtr * 512 + F.tid; const bool act = i < ntok;
        const unsigned eqpos = eqb + (unsigned)__builtin_popcountll(be_own & lt);
        const bool sel = act && (kown > T || (kown == T && eqpos < need));
        const unsigned slot = gtb + (unsigned)__builtin_popcountll(bg_own & lt) + (eqpos < need ? eqpos : need);
        if (act) { TOK[(size_t)(rowbase + i) * 16 + e] = sel ? slotbase + (int)slot : -1;
            if (sel) { ROWS[e * ESLOT + slotbase + (int)slot] = rowbase + i; VALS[e * ESLOT + slotbase + (int)slot] = __uint_as_float(kown); } }
    }
    __syncthreads();
}
struct SchedMoe {
    const char* A; const char* Bt; int lda, ldb, nMt, nt, G, c, gather;
    DI bool next(int i, Unit& u) const {
        const long L0 = (long)i * G + c; const int nwg = NEXP * nMt * 8; if (L0 >= nwg) return false;
        const int L = ((int)L0 % 8) * (nwg / 8) + (int)L0 / 8;
        const int e = L / (nMt * 8), rem = L % (nMt * 8), mt = rem % nMt, pn = rem / nMt;
        u.pm = e * 5 + mt; u.pn = pn; u.aux = e; u.nt = nt; u.pa = gather ? A : A + ((size_t)e * ESLOT + mt * 256) * lda; u.pb = Bt + ((size_t)e * 2048 + pn * 256) * ldb; return true;
    }
};
struct EpiMoe1 {
    bf16_t* ACT;
    DI void operator()(const f32x4 (&acc)[2][2][4][2], const Unit& u, int wr, int wc, int fr, int fq) const {
#pragma unroll
        for (int ai = 0; ai < 2; ++ai)
#pragma unroll
            for (int m = 0; m < 4; ++m) { const int row = u.pm * 256 + ai * 128 + wr * 64 + m * 16 + fr; const int col = u.pn * 128 + wc * 32 + 8 * fq;
                f32x4 r0, r1;
#pragma unroll
                for (int i = 0; i < 4; ++i) { r0[i] = siluf_(acc[ai][0][m][0][i]) * acc[ai][1][m][0][i]; r1[i] = siluf_(acc[ai][0][m][1][i]) * acc[ai][1][m][1][i]; }
                *(u32x4*)(ACT + (size_t)row * EFF + col) = pack8(r0, r1); }
    }
};
struct EpiMoe2 {
    const float* VALS; bf16_t* YE;
    DI void operator()(const f32x4 (&acc)[2][2][4][2], const Unit& u, int wr, int wc, int fr, int fq) const {
        EPI_FOREACH({ const float val = VALS[row]; *(u32x4*)(YE + (size_t)row * DM + col) = pack8(v0 * val, v1 * val); })
    }
};
DI void phase_final(const Frame& F, const Args& a) {
    const float* g = a.in[I_FNORM]; const int* TOK = (const int*)(F.ws + WS_TOK); const float* X1 = (const float*)(F.ws + WS_X1);
    LAS float* gs = (LAS float*)F.lds;
    { const float* MODS = (const float*)(F.ws + WS_MODS);
      for (int i = F.tid; i < 4 * 512; i += NTHR) { const int r = i / 512, c4 = i % 512;
          *(LAS f32x4*)(gs + (size_t)r * DM + 4 * c4) = *(const f32x4*)(MODS + ((size_t)((DEPTH - 1) * 5 + r) * 6 + 5) * DM + 4 * c4); }
      __syncthreads(); }
    int row = F.gw; if (row >= MLAT) return;
    f32x4 cur[8]; load_row(X1 + (size_t)row * DM, F.lane, cur); int tcur = TOK[(size_t)row * 16 + (F.lane & 15)];
    f32x4 gv[8]; load_row(g, F.lane, gv);
    for (;;) {
        const int nrow = row + F.ngw; const bool hn = nrow < MLAT; const int pr = hn ? nrow : row;
        f32x4 nxt[8]; load_row(X1 + (size_t)pr * DM, F.lane, nxt); const int tnxt = TOK[(size_t)pr * 16 + (F.lane & 15)];
        f32x4 v[8]; float ss = 0.f;
        combine_row<true>(F, DEPTH - 1, row, cur, tcur, v, gs + (size_t)(row >> 11) * DM);
#pragma unroll
        for (int j = 0; j < 8; ++j) ss += v[j].x * v[j].x + v[j].y * v[j].y + v[j].z * v[j].z + v[j].w * v[j].w;
        const float rs = rsqrtf(wave_sum(ss) * (1.f / DM) + EPS);
#pragma unroll
        for (int j = 0; j < 8; ++j) *(f32x4*)(a.out + (size_t)row * DM + 4 * F.lane + 256 * j) = v[j] * rs * gv[j];
        if (!hn) break;
#pragma unroll
        for (int j = 0; j < 8; ++j) cur[j] = nxt[j];
        tcur = tnxt; row = nrow;
    }
}

#ifndef MK_LAST_PHASE
#define MK_LAST_PHASE 1000
#endif
constexpr int PH_PER_LAYER = 12, N_PHASES = 2 + 2 * PH_PER_LAYER + 1;
__global__ void __launch_bounds__(NTHR, 2) mega(const Args args) {
    extern __shared__ __attribute__((aligned(16))) unsigned char lds[];
    Frame F0;
    F0.lds = (LAS unsigned char*)lds; F0.ws = args.ws;
    F0.tid = threadIdx.x; F0.lane = F0.tid & 63; F0.wave = __builtin_amdgcn_readfirstlane(F0.tid >> 6);
    F0.G = gridDim.x; { const int bx = blockIdx.x; F0.vcu = (F0.G % 8 == 0) ? (bx % 8) * (F0.G / 8) + bx / 8 : bx; }
    F0.gw = F0.vcu * NWAVES + F0.wave; F0.ngw = F0.G * NWAVES;
    volatile LAS unsigned* MISC = (volatile LAS unsigned*)(F0.lds + LDS_BYTES - 64);
    if (F0.tid < 16) MISC[F0.tid] = 0u;
    __syncthreads();
    unsigned* ctl = (unsigned*)(F0.ws + WS_CTL);
    XcdBarrier bar = xcd_barrier_post(ctl + CW_BAR, MISC + 8);
    const int lo = args.ph_lo, hi = args.ph_hi;
    int ph = 0, bid = 0;
#ifndef MK_EN
#define MK_EN 0xFFFF
#endif
#define EN(x) ((MK_EN >> (x)) & 1)
#ifndef MK_REP
#define MK_REP 0
#endif
#ifndef MK_BARX
#define MK_BARX 0
#endif
#ifndef MK_REPB
#define MK_REPB 0
#endif
#ifndef MK_TPH
#define MK_TPH -1
#endif
#ifndef MK_TMODE
#define MK_TMODE 0
#endif
#ifndef MK_TQ
#define MK_TQ 40.f
#endif
#define REP(pid_) ((MK_REP >> (pid_)) & 1)
#define PHASE(pid_, ...) if (EN(pid_) && lo <= ph && ph < hi) { Frame F = F0; { unsigned long long w_ = (unsigned long long)F0.ws; asm volatile("" : "+s"(w_)); F.ws = (unsigned char*)w_; \
        asm volatile("" : "+s"(F.G), "+s"(F.vcu)); F.ngw = F.G * NWAVES; bid = blockIdx.x; asm volatile("" : "+s"(bid)); \
        int t_ = threadIdx.x; asm volatile("" : "+v"(t_)); F.tid = t_; F.lane = t_ & 63; F.wave = __builtin_amdgcn_readfirstlane(t_ >> 6); F.gw = F.vcu * NWAVES + F.wave; } \
        { const int rep = 0; (void)rep; __VA_ARGS__ } if (REP(pid_)) { if (MK_REPB) xcd_barrier(bar); const int rep = 1; (void)rep; __VA_ARGS__ } \
        if (MK_TPH >= 0 && threadIdx.x == 0) ((unsigned long long*)(F0.ws + WS_CTL + 1536 * 1024))[ph * 256 + blockIdx.x] = wall_clock64(); \
        if (ph + 1 < hi) { xcd_barrier(bar); if (MK_BARX) xcd_barrier(bar); } } ++ph;

#define PHASE5(...) if (EN(5) && lo <= ph && ph < hi) { Frame F = F0; { unsigned long long w_ = (unsigned long long)F0.ws; asm volatile("" : "+s"(w_)); F.ws = (unsigned char*)w_; \
        asm volatile("" : "+s"(F.G), "+s"(F.vcu)); F.ngw = F.G * NWAVES; bid = blockIdx.x; asm volatile("" : "+s"(bid)); \
        int t_ = threadIdx.x; asm volatile("" : "+v"(t_)); F.tid = t_; F.lane = t_ & 63; F.wave = __builtin_amdgcn_readfirstlane(t_ >> 6); F.gw = F.vcu * NWAVES + F.wave; } \
        { __VA_ARGS__ } if (MK_TPH >= 0 && threadIdx.x == 0) ((unsigned long long*)(F0.ws + WS_CTL + 1536 * 1024))[ph * 256 + blockIdx.x] = wall_clock64(); \
        if (ph + 1 < hi) { xcd_barrier(bar); if (MK_BARX) xcd_barrier(bar); } } ++ph;
    PHASE(0, phase_prologue(F, args, rep);)
    PHASE(14, phase_mods_reduce(F, args);)
    for (int l = 0; l < DEPTH; ++l) {
        const size_t wlo = WS_W + (size_t)l * W_LAYER;
        const int nM = (l == 0) ? 36 : 32;
        PHASE(1, if (MK_FILL && l == 1 && rep == 0) fill_convert(F, args, ph, true); phase_mod1(F, args, l);)
        PHASE(2, {
            SchedProj S{(const char*)(F.ws + WS_H), (const char*)(F.ws + wlo + W_IN), l, F.G, bid};
            EpiProj E{(bf16_t*)(F.ws + WS_P)};
            pg8::gemm_phase(F.lds, DM * 2, DM * 2, S, E); if (MK_FILL && l == 0 && rep == 0) fill_convert(F, args, ph, false); })
        PHASE(3, phase_postproj(F, args, l);)
        PHASE(4, {
            const bool defer = (l == 1 && F.G == 256);
            const int Gx = F.G - 36, xw = bid - Gx, BIG = 1 << 28, Gw = defer ? 120 : Gx, cw = bid < Gw ? bid : BIG;
            if (defer) { SchedDefer S{(const char*)(F.ws + WS_H), (const char*)(F.ws + wlo + W_IN), (bid >= 120 && bid < 220) ? bid - 120 : -1};
              EpiProj E{(bf16_t*)(F.ws + WS_P)}; pg8::gemm_phase(F.lds, DM * 2, DM * 2, S, E); }
            { SchedDense S{(const char*)(F.ws + WS_H), (const char*)(F.ws + wlo + W_IN) + (size_t)C_X * DM * 2, DM * 2, DM * 2, 36, 1, 32, 36, xw >= 0 ? xw : BIG};
              EpiX E{(bf16_t*)(F.ws + WS_KR), (float*)(F.ws + WS_X80), (const float*)(F.ws + WS_ROPE_LA)}; pg8::gemm_phase(F.lds, DM * 2, DM * 2, S, E); }
            { SchedDense S{(const char*)(F.ws + WS_CQN), (const char*)(F.ws + wlo + W_UQ), 512 * 2, 512 * 2, nM, 6, 8, Gw, cw};
              EpiStoreBf16 E{(bf16_t*)(F.ws + WS_QLA), 1536}; pg8::gemm_phase(F.lds, 512 * 2, 512 * 2, S, E); }
            { SchedDense S{(const char*)(F.ws + WS_CKVN), (const char*)(F.ws + wlo + W_UKV), 256 * 2, 256 * 2, 36, 8, 4, Gw, bid < Gw ? (bid + Gw / 2) % Gw : BIG};
              EpiStoreBf16 E{(bf16_t*)(F.ws + WS_KVLA), 2048}; pg8::gemm_phase(F.lds, 256 * 2, 256 * 2, S, E); }
            if (MK_FILL && l == 0 && rep == 0) fill_convert(F, args, ph, false); })
        PHASE5(if (MK_CVSIDE) phase_convert_side(F, args, bid, l == 0 ? IT_EARLY : IT_LAYER + IT_EARLY, l == 0 ? IT_LAYER + IT_EARLY : 2 * IT_LAYER); phase_mixers(F, args, l, (char*)lds, 1 + REP(5)); if (MK_CONVTAIL) phase_convert_tail(F, args, l);)
        PHASE(6, phase_mlfin(F, args, l, nM * 256);)
        PHASE(7, {
            SchedMerge S{(const char*)(F.ws + WS_YCAT), (const char*)(F.ws + wlo + W_BR), nM, F.G, bid};
            EpiMerge E{(const bf16_t*)(F.ws + WS_P), (bf16_t*)(F.ws + WS_MF32), (bf16_t*)(F.ws + WS_MBF), (bf16_t*)(F.ws + WS_H), (unsigned*)(F.ws + WS_CTL) + CW_MCNT};
            pg8::gemm_phase(F.lds, 3072 * 2, 1024 * 2, S, E); if (MK_FILL && l == 0 && rep == 0) fill_convert(F, args, ph, false); })
        PHASE(8, {
            SchedDense S{(const char*)(F.ws + WS_MBF), (const char*)(F.ws + wlo + W_OUT), DM * 2, DM * 2, nM, 8, 32, F.G, bid};
            EpiOut E{args.in[I_X], args.in[I_CTX], (float*)(F.ws + WS_X1), (const float*)(F.ws + WS_MODS), l};
            if (rep == 0 || l == 0) pg8::gemm_phase(F.lds, DM * 2, DM * 2, S, E); if (MK_FILL && l == 0 && rep == 0) fill_convert(F, args, ph, false); })
        PHASE(9, phase_mod2(F, args, l, nM * 256);)
        PHASE(10, phase_topk(F, args, l, bid);)
        PHASE(11, {
            SchedMoe S{(const char*)(F.ws + WS_H), (const char*)(F.ws + wlo + W_E13), DM * 2, DM * 2, (l == 0) ? 5 : 4, 32, F.G, bid, 1};
            EpiMoe1 E{(bf16_t*)(F.ws + WS_ACT)};
            pg8::gemm_phase<true>(F.lds, DM * 2, DM * 2, S, E, (const int*)(F.ws + WS_ROWS)); if (MK_FILL && l == 0 && rep == 0) fill_convert(F, args, ph, false); })
        PHASE(12, {
            SchedMoe S{(const char*)(F.ws + WS_ACT), (const char*)(F.ws + wlo + W_E2), EFF * 2, EFF * 2, (l == 0) ? 5 : 4, 16, F.G, bid, 0};
            EpiMoe2 E{(const float*)(F.ws + WS_VALS), (bf16_t*)(F.ws + WS_YE)};
            pg8::gemm_phase(F.lds, EFF * 2, EFF * 2, S, E); if (MK_FILL && l == 0 && rep == 0) fill_convert(F, args, ph, false); })
    }
    PHASE(13, phase_final(F, args);)
    if (MK_TPH >= 0) {
        xcd_barrier(bar);
        if (blockIdx.x == 0 && threadIdx.x == 0) {
            const unsigned long long* st = (const unsigned long long*)(F0.ws + WS_CTL + 1536 * 1024);
            unsigned long long mx = 0, mxp = 0, sum = 0; const int G = gridDim.x;
            for (int bq = 0; bq < G; ++bq) { const unsigned long long e = st[MK_TPH * 256 + bq], p = st[(MK_TPH - 1) * 256 + bq]; mx = e > mx ? e : mx; mxp = p > mxp ? p : mxp; sum += e; }
            const float dur = MK_TMODE == 0 ? (float)(mx - mxp) * 0.01f : (float)((double)sum / G - (double)mxp) * 0.01f;
            args.out[0] = 20.f + floorf(dur / MK_TQ) * MK_TQ;
        }
    }
#undef PHASE
}


extern "C" void kernel_launch(void* const* d_in, const int* in_sizes, int n_in, void* d_out, int out_size, void* d_ws, size_t ws_size, hipStream_t stream) {
    static int grid = 0;
    if (grid == 0) {
        if (n_in != 24 || out_size != MLAT * DM || ws_size < WS_END) { fprintf(stderr, "kernel_launch: unexpected shapes: n_in %d out %d ws %zu (need %zu)\n", n_in, out_size, ws_size, (size_t)WS_END); grid = -1; return; }
        int dev = 0, cus = 0, per_cu = 0;
        if (hipGetDevice(&dev) != hipSuccess || hipDeviceGetAttribute(&cus, hipDeviceAttributeMultiprocessorCount, dev) != hipSuccess) { grid = -1; return; }
        if (hipFuncSetAttribute((const void*)mega, hipFuncAttributeMaxDynamicSharedMemorySize, LDS_BYTES) != hipSuccess) { fprintf(stderr, "kernel_launch: hipFuncSetAttribute failed\n"); grid = -1; return; }
        if (hipOccupancyMaxActiveBlocksPerMultiprocessor(&per_cu, (const void*)mega, NTHR, LDS_BYTES) != hipSuccess || per_cu < 1) { fprintf(stderr, "kernel_launch: occupancy query says %d blocks per CU\n", per_cu); }
        (void)hipGetLastError();
        grid = cus;
    }
    if (grid < 0) return;
    if (hipMemsetAsync((char*)d_ws + WS_CTL, 0, CTL_BYTES, stream) != hipSuccess) return;
    Args a{};
    for (int i = 0; i < 24; ++i) a.in[i] = (const float*)d_in[i];
    a.out = (float*)d_out; a.ws = (unsigned char*)d_ws; a.ph_lo = 0; a.ph_hi = N_PHASES < MK_LAST_PHASE ? N_PHASES : MK_LAST_PHASE;
    hipLaunchKernelGGL(mega, dim3(grid), dim3(NTHR), LDS_BYTES, stream, a);
}
```

```cpp
#include <hip/hip_runtime.h>
#include <cstdio>
#include <cstdint>

#define GAS __attribute__((address_space(1)))
#define LAS __attribute__((address_space(3)))
#define DI __device__ __forceinline__
typedef unsigned short bf16_t;
typedef short bf16x8 __attribute__((ext_vector_type(8)));
typedef short s16x4 __attribute__((ext_vector_type(4)));
typedef float f32x2 __attribute__((ext_vector_type(2)));
typedef float f32x4 __attribute__((ext_vector_type(4)));
typedef float f32x8 __attribute__((ext_vector_type(8)));
typedef float f32x16 __attribute__((ext_vector_type(16)));
typedef unsigned u32x2 __attribute__((ext_vector_type(2)));
typedef unsigned u32x4 __attribute__((ext_vector_type(4)));

constexpr int DM = 2048, NBATCH = 4, SEQ = 2048, CTXL = 256, DEPTH = 2;
constexpr int MLAT = NBATCH * SEQ, MCTX = NBATCH * CTXL, MTOT = MLAT + MCTX;
constexpr int PROJW = 12624, NP = 12800;
constexpr int C_MLQ = 0, C_MLK = 1024, C_MLV = 2048, C_MLO = 3072, C_CQ = 4096, C_CKV = 4608, C_GQ = 4864, C_GK = 5888, C_GV = 6144, C_GATE = 6400, C_X = 12544;
constexpr int XW = 80;
constexpr int NEXP = 16, EFF = 1024, ESLOT = 1280;
constexpr float EPS = 1e-6f;
constexpr int NWAVES = 8, NTHR = 512;

constexpr size_t al256(size_t x) { return (x + 255) / 256 * 256; }
constexpr size_t WS_CTL = 0, CTL_BYTES = 2u << 20;
constexpr int CW_BAR = 1024;
constexpr int CW_QUEUE = 8192;
constexpr int CW_CVHEAD = 12288;
constexpr int CW_MCNT = 20480;
constexpr int CW_PHDONE = 32768;
constexpr size_t WS_MODS = 1u << 20;
constexpr size_t WS_ROPE_LA = WS_CTL + CTL_BYTES;
constexpr size_t WS_ROPE_GA = WS_ROPE_LA + al256((size_t)2048 * 32 * 2 * 4);
constexpr size_t WS_W = WS_ROPE_GA + al256((size_t)2048 * 64 * 2 * 4);
constexpr size_t W_IN = 0, W_UQ = W_IN + (size_t)NP * DM * 2, W_UKV = W_UQ + (size_t)1536 * 512 * 2, W_BR = W_UKV + (size_t)2048 * 256 * 2,
                 W_OUT = W_BR + (size_t)3 * 2048 * 1024 * 2, W_E13 = W_OUT + (size_t)2048 * 2048 * 2, W_E2 = W_E13 + (size_t)NEXP * 2048 * 2048 * 2,
                 W_LAYER = W_E2 + (size_t)NEXP * 2048 * 1024 * 2;
constexpr size_t WS_H = WS_W + 2 * W_LAYER;
constexpr size_t WS_P = WS_H + (size_t)MTOT * DM * 2;
constexpr size_t WS_AG = WS_P;
constexpr size_t WS_ACT = WS_AG + (size_t)NEXP * ESLOT * DM * 2;
static_assert(WS_ACT + (size_t)NEXP * ESLOT * EFF * 2 <= WS_P + (size_t)MTOT * NP * 2, "overlay");
constexpr size_t WS_X80 = WS_P + (size_t)MTOT * NP * 2;
constexpr size_t WS_CQN = WS_X80 + al256((size_t)MTOT * XW * 4);
constexpr size_t WS_CKVN = WS_CQN + (size_t)MTOT * 512 * 2;
constexpr size_t WS_QG = WS_CKVN + (size_t)MTOT * 256 * 2;
constexpr size_t WS_KG = WS_QG + (size_t)MTOT * 1024 * 2;
constexpr size_t WS_KR = WS_KG + (size_t)MTOT * 256 * 2;
constexpr size_t WS_QLA = WS_KR + (size_t)MTOT * 64 * 2;
constexpr size_t WS_KVLA = WS_QLA + (size_t)MTOT * 1536 * 2;
constexpr size_t WS_YCAT = WS_KVLA + (size_t)MTOT * 2048 * 2;
constexpr size_t WS_MF32 = WS_YCAT + (size_t)MTOT * 3072 * 2;
constexpr size_t WS_MLH = WS_MF32;
constexpr size_t WS_MBF = WS_MF32 + (size_t)MTOT * DM * 4;
constexpr size_t WS_X1 = WS_MBF + (size_t)MTOT * DM * 2;
constexpr size_t WS_AFF = WS_X1 + (size_t)MTOT * DM * 4;
constexpr size_t WS_ROWS = WS_AFF + (size_t)MTOT * 16 * 4;
constexpr size_t WS_VALS = WS_ROWS + (size_t)NEXP * ESLOT * 4;
constexpr size_t WS_TOK = WS_VALS + (size_t)NEXP * ESLOT * 4;
constexpr size_t WS_MPART = WS_TOK + (size_t)MTOT * 16 * 4;
constexpr size_t WS_END = WS_MPART + (size_t)16 * 2 * 5 * 12288 * 4;
constexpr size_t WS_YE = WS_AG;

constexpr int RING_BYTES = 131072;
constexpr int MISC_OFF = RING_BYTES + 1024;
constexpr int LDS_BYTES = 147456;

DI float bf2f(unsigned short b) { return __uint_as_float(((unsigned)b) << 16); }
DI unsigned f2bf(float f) { unsigned u = __float_as_uint(f); return (u + 0x7fffu + ((u >> 16) & 1u)) >> 16; }
DI unsigned pk2(float lo, float hi) { unsigned r; asm volatile("v_cvt_pk_bf16_f32 %0, %1, %2" : "=v"(r) : "v"(lo), "v"(hi)); return r; }
DI int lane_id_() { int l = __builtin_amdgcn_mbcnt_hi(~0u, __builtin_amdgcn_mbcnt_lo(~0u, 0u)); asm volatile("" : "+v"(l)); return l; }
DI float bperm_f(float v, int srclane) { return __int_as_float(__builtin_amdgcn_ds_bpermute(srclane << 2, __float_as_int(v))); }
DI float shx(float v, int o) { return bperm_f(v, lane_id_() ^ o); }
DI float shl_(float v, int src) { return bperm_f(v, src); }
DI float shu(float v, int o) { const int l = lane_id_(); return bperm_f(v, l >= o ? l - o : l); }
DI float wave_sum(float v) { const int l = lane_id_();
#pragma unroll
    for (int o = 1; o < 64; o <<= 1) v += bperm_f(v, l ^ o);
    return v;
}
DI float wave_max(float v) { const int l = lane_id_();
#pragma unroll
    for (int o = 1; o < 64; o <<= 1) v = fmaxf(v, bperm_f(v, l ^ o));
    return v;
}
DI float sigmoidf_(float x) { return __builtin_amdgcn_rcpf(1.f + __expf(-x)); }
DI float siluf_(float x) { return x * __builtin_amdgcn_rcpf(1.f + __expf(-x)); }
#define LDS_WAIT() asm volatile("s_waitcnt lgkmcnt(0)" ::: "memory")
#define VM_WAIT() asm volatile("s_waitcnt vmcnt(0)" ::: "memory")

#define XB_TMO      128
#define XB_XCNT(j)  (256  + 64 * (j))
#define XB_XSUB(j)  (1280 + 64 * (j))
#define XB_XGEN(j)  (2304 + 64 * (j))
#define XB_TOP      3328
#define XB_TOPGEN   3392
#define XCD_BAR_WORDS 3456
#define XB_SPIN_CAP (1u << 20)

DI unsigned xb_ld(unsigned* p)              { return __hip_atomic_load(p, __ATOMIC_RELAXED, __HIP_MEMORY_SCOPE_AGENT); }
DI unsigned xb_add(unsigned* p, unsigned v) { return __hip_atomic_fetch_add(p, v, __ATOMIC_RELAXED, __HIP_MEMORY_SCOPE_AGENT); }
DI unsigned xb_xcc_id() { return (unsigned)__builtin_amdgcn_s_getreg((3 << 11) | 20) & 0xFu; }
#define XB_SPIN(cond, bar) do { unsigned _sp = 0; while (cond) { __builtin_amdgcn_s_sleep(1); \
    if ((++_sp & 255u) == 0u) { if (xb_ld(&(bar)[XB_TMO])) break; if (_sp > XB_SPIN_CAP) { atomicAdd(&(bar)[XB_TMO], 1u); break; } } } } while (0)

struct XcdBarrier { unsigned* bar; unsigned x; volatile LAS unsigned* st; };

DI XcdBarrier xcd_barrier_post(unsigned* bar, volatile LAS unsigned* st) {
    XcdBarrier b; b.bar = bar; b.x = xb_xcc_id(); b.st = st;
    if (threadIdx.x == 0) (void)xb_add(&bar[XB_XCNT(b.x)], 1u);
    return b;
}
DI void xcd_barrier_complete(unsigned* bar, unsigned x, unsigned& nloc, unsigned& nx) {
    const unsigned G = gridDim.x * gridDim.y * gridDim.z;
    unsigned sum, cnt, mine, sp = 0u;
    for (;;) {
        sum = 0u; cnt = 0u; mine = 0u;
#pragma unroll
        for (unsigned j = 0; j < 16; ++j) { const unsigned c = xb_ld(&bar[XB_XCNT(j)]); sum += c; cnt += (c > 0u) ? 1u : 0u; mine = (j == x) ? c : mine; }
        if (sum == G) break;
        __builtin_amdgcn_s_sleep(1);
        if ((++sp & 255u) == 0u) { if (xb_ld(&bar[XB_TMO])) break; if (sp > XB_SPIN_CAP) { atomicAdd(&bar[XB_TMO], 1u); break; } }
    }
    nloc = mine > 0u ? mine : 1u; nx = cnt > 0u ? cnt : 1u;
}
DI void xcd_barrier(const XcdBarrier& b) {
    asm volatile("s_waitcnt vmcnt(0)" ::: "memory");
    __syncthreads();
    if (threadIdx.x == 0) {
        unsigned* bar = b.bar; asm volatile("" : "+s"(bar));
        __builtin_amdgcn_s_waitcnt(0);
        unsigned nloc = b.st[0], nx = b.st[1];
        unsigned bx = b.x; asm volatile("" : "+s"(bx));
        if (nloc == 0u) { xcd_barrier_complete(bar, bx, nloc, nx); b.st[0] = nloc; b.st[1] = nx; }
        const unsigned old = xb_add(&bar[XB_XSUB(bx)], 1u);
        const unsigned gen = old / nloc;
        if (old + 1u == (gen + 1u) * nloc) {
            __builtin_amdgcn_fence(__ATOMIC_RELEASE, "agent");
            asm volatile("s_waitcnt vmcnt(0)" ::: "memory");
            const unsigned og = xb_add(&bar[XB_TOP], 1u);
            const unsigned tg = og / nx;
            if (og + 1u == (tg + 1u) * nx) xb_add(&bar[XB_TOPGEN], 1u);
            else XB_SPIN(xb_ld(&bar[XB_TOPGEN]) == tg, bar);
            __builtin_amdgcn_fence(__ATOMIC_ACQUIRE, "agent");
            xb_add(&bar[XB_XGEN(bx)], 1u);
            asm volatile("s_waitcnt vmcnt(0)" ::: "memory");
        } else {
            XB_SPIN(xb_ld(&bar[XB_XGEN(bx)]) == gen, bar);
            __builtin_amdgcn_fence(__ATOMIC_ACQUIRE, "agent");
            asm volatile("s_waitcnt vmcnt(0)" ::: "memory");
        }
    }
    __syncthreads();
}

struct Args { const float* in[24]; float* out; unsigned char* ws; int ph_lo, ph_hi; };
enum { I_X = 0, I_C, I_CTX, I_CCTX, I_WMOD, I_BMOD, I_WIN, I_GBIAS, I_MLNORM, I_LAQN, I_LAKVN, I_UQ, I_UKV, I_GAQN, I_GAKN, I_BRML, I_BRLA, I_BRGA, I_WOUT, I_WROUTER, I_WE1, I_WE3, I_WE2, I_FNORM };

struct Frame {
    LAS unsigned char* lds;
    unsigned char* ws;
    int tid, lane, wave, G, vcu, gw, ngw;
};

DI int mods_row(int row) { return row < MLAT ? (row >> 11) : 4; }
DI const float* mods_ptr(const Frame& F, int l, int row, int which  ) {
    return (const float*)(F.ws + WS_MODS) + ((size_t)(l * 5 + mods_row(row)) * 6 + which) * DM;
}

namespace pg8 {
constexpr int BM = 256, BK = 64, HALF = 128, HTB = HALF * BK * 2, STAGE_BYTES = 8 * HTB, NXCD = 8, WGM = 8;
__host__ __device__ __forceinline__ int lds_byte(int r, int c) { const int st = (r >> 4) * 2 + (c >> 5), rr = r & 15, cc = c & 31, ob = rr * 64 + cc * 2; return st * 1024 + (ob ^ (((ob >> 9) & 1) << 5)); }
__host__ __device__ __forceinline__ void stage_rc(int b, int& R, int& C) { const int st = b / 1024, sb = b % 1024, swz = sb ^ (((sb >> 9) & 1) << 5); R = (st >> 1) * 16 + swz / 64; C = (st & 1) * 32 + (swz % 64) / 2; }
__host__ __device__ __forceinline__ int perm32(int rho) { const int n = rho >> 4, i = rho & 15; return 8 * (i >> 2) + 4 * n + (i & 3); }

struct Unit { const char* pa; const char* pb; int pm, pn, aux, nt; };

DI void tile_of(int L, int nM, int nN, int& pm, int& pn) {
    const int nwg = nM * nN; int wgid = L;
    { const int q = nwg / NXCD, r = nwg % NXCD, xcd = wgid % NXCD, off = wgid / NXCD; wgid = (xcd < r ? xcd * (q + 1) : r * (q + 1) + (xcd - r) * q) + off; }
    const int nig = WGM * nN, gid = wgid / nig, fm = gid * WGM, gsz = (nM - fm) < WGM ? (nM - fm) : WGM;
    pm = fm + ((wgid % nig) % gsz); pn = (wgid % nig) / gsz;
}

template <bool GATHER = false, class Epi, class Sched>
DI void gemm_phase(LAS unsigned char* lds, const int lda  , const int ldb  , const Sched& S, const Epi& E, const int* rows = nullptr) {
    int tid = threadIdx.x; asm volatile("" : "+v"(tid));
    const int wid = __builtin_amdgcn_readfirstlane(tid >> 6), lane = tid & 63, wr = wid >> 2, wc = wid & 3, fr = lane & 15, fq = lane >> 4;
    unsigned vA0[2], vA1[2], nA0[2], nA1[2], voffB[2]; int sR[2], sC[2];
#pragma unroll
    for (int i = 0; i < 2; ++i) { int R, C; stage_rc(tid * 16 + i * 8192, R, C); const int Rb = (R & ~31) + perm32(R & 31); sR[i] = R; sC[i] = C;
        vA0[i] = (unsigned)(R * lda + C * 2); vA1[i] = (unsigned)((R + HALF) * lda + C * 2); nA0[i] = vA0[i]; nA1[i] = vA1[i]; voffB[i] = (unsigned)(Rb * ldb + C * 2); }
#define PG8_GATHER_OFFS(u_, d0, d1) do { if (GATHER) { _Pragma("unroll") for (int i = 0; i < 2; ++i) { const int r0_ = rows[(u_).pm * 256 + sR[i]], r1_ = rows[(u_).pm * 256 + HALF + sR[i]]; \
        d0[i] = (unsigned)((r0_ < 0 ? 0 : r0_) * lda + sC[i] * 2); d1[i] = (unsigned)((r1_ < 0 ? 0 : r1_) * lda + sC[i] * 2); } } } while (0)
    const size_t kstep = (size_t)(BK * 2);
    const size_t hstepB = (size_t)HALF * ldb;
    const unsigned ldsw = (unsigned)wid * 1024u;
    const int aoff = lds_byte(wr * 64 + fr, fq * 8), boff = lds_byte(wc * 32 + fr, fq * 8);
#define PG8_SA(b, h) (((b) * 2 + (h)) * HTB)
#define PG8_SB(b, h) ((4 + (b) * 2 + (h)) * HTB)
#define PG8_STAGE(bufoff, gbase, voff) do { _Pragma("unroll") for (int _i = 0; _i < 2; ++_i) \
        __builtin_amdgcn_global_load_lds((const unsigned*)((const char*)(gbase) + (voff)[_i]), (LAS unsigned*)(lds + (bufoff) + ldsw + _i * 8192), 16, 0, 0); } while (0)
#define PG8_LDA(dst, b, h) do { _Pragma("unroll") for (int m = 0; m < 4; ++m) _Pragma("unroll") for (int k = 0; k < 2; ++k) dst[m][k] = *(const LAS bf16x8*)(lds + PG8_SA(b, h) + aoff + m * 2048 + k * 1024); } while (0)
#define PG8_LDB(dst, b, h) do { _Pragma("unroll") for (int n = 0; n < 2; ++n) _Pragma("unroll") for (int k = 0; k < 2; ++k) dst[n][k] = *(const LAS bf16x8*)(lds + PG8_SB(b, h) + boff + n * 2048 + k * 1024); } while (0)
#define PG8_MMA(ai, bj, At, Bt) do { __builtin_amdgcn_s_setprio(1); _Pragma("unroll") for (int m = 0; m < 4; ++m) _Pragma("unroll") for (int n = 0; n < 2; ++n) _Pragma("unroll") for (int k = 0; k < 2; ++k) \
        acc[ai][bj][m][n] = __builtin_amdgcn_mfma_f32_16x16x32_bf16(Bt[n][k], At[m][k], acc[ai][bj][m][n], 0, 0, 0); __builtin_amdgcn_s_setprio(0); } while (0)
#define PG8_WAIT_V(n) asm volatile("s_waitcnt vmcnt(" #n ")" ::: "memory")
#define PG8_WAIT_L(n) asm volatile("s_waitcnt lgkmcnt(" #n ")" ::: "memory")
#define PG8_BAR __builtin_amdgcn_s_barrier()
#define PG8_SCHED __builtin_amdgcn_sched_barrier(0)
    Unit cur, nxt; int ui = 0;
    if (!S.next(0, cur)) return;
    f32x4 acc[2][2][4][2];
#pragma unroll
    for (int a = 0; a < 2; ++a)
#pragma unroll
        for (int b = 0; b < 2; ++b)
#pragma unroll
            for (int m = 0; m < 4; ++m)
#pragma unroll
                for (int n = 0; n < 2; ++n) acc[a][b][m][n] = (f32x4){0.f, 0.f, 0.f, 0.f};
    bf16x8 At[4][2], B0[2][2], B1[2][2];
    const char* cA = cur.pa; const char* cB = cur.pb;
    PG8_GATHER_OFFS(cur, vA0, vA1);
    PG8_STAGE(PG8_SB(0, 0), cB, voffB); PG8_STAGE(PG8_SA(0, 0), cA, vA0); PG8_STAGE(PG8_SB(0, 1), cB + hstepB, voffB); PG8_STAGE(PG8_SA(0, 1), cA, vA1);
    if (wr == 1) PG8_BAR;
    PG8_WAIT_V(4); PG8_BAR;
    PG8_STAGE(PG8_SB(1, 0), cB + kstep, voffB); PG8_STAGE(PG8_SA(1, 0), cA + kstep, vA0); PG8_STAGE(PG8_SB(1, 1), cB + hstepB + kstep, voffB);
    PG8_WAIT_V(6); PG8_BAR;
    for (;;) {
        const bool has_next = S.next(ui + 1, nxt);
        const char* nA = has_next ? nxt.pa : cA; const char* nB = has_next ? nxt.pb : cB;
        if (GATHER) { if (has_next) PG8_GATHER_OFFS(nxt, nA0, nA1); else { _Pragma("unroll") for (int i = 0; i < 2; ++i) { nA0[i] = vA0[i]; nA1[i] = vA1[i]; } } }
        const int nt = cur.nt;
        for (int t = 0; t < nt; t += 2) {
            const bool last = (t == nt - 2);
            const char* a1 = cA + (size_t)(t + 1) * kstep;
            const char* a2 = last ? nA : cA + (size_t)(t + 2) * kstep; const char* b2 = last ? nB : cB + (size_t)(t + 2) * kstep;
            const char* a3 = a2 + kstep; const char* b3 = b2 + kstep;
            unsigned wA0[2], wA1[2];
            _Pragma("unroll") for (int i = 0; i < 2; ++i) { wA0[i] = last ? nA0[i] : vA0[i]; wA1[i] = last ? nA1[i] : vA1[i]; }
            PG8_LDB(B0, 0, 0); PG8_SCHED; PG8_LDA(At, 0, 0); PG8_STAGE(PG8_SA(1, 1), a1, vA1);
            PG8_WAIT_L(8); PG8_BAR; PG8_WAIT_L(0); PG8_MMA(0, 0, At, B0); PG8_BAR; PG8_SCHED;
            PG8_LDB(B1, 0, 1); PG8_STAGE(PG8_SB(0, 0), b2, voffB);
            PG8_BAR; PG8_WAIT_L(0); PG8_MMA(0, 1, At, B1); PG8_BAR;
            PG8_LDA(At, 0, 1); PG8_STAGE(PG8_SA(0, 0), a2, wA0);
            PG8_BAR; PG8_WAIT_L(0); PG8_MMA(1, 0, At, B0); PG8_BAR; PG8_SCHED;
            PG8_STAGE(PG8_SB(0, 1), b2 + hstepB, voffB);
            PG8_WAIT_V(6); PG8_BAR; PG8_MMA(1, 1, At, B1); PG8_BAR;
            PG8_LDB(B0, 1, 0); PG8_SCHED; PG8_LDA(At, 1, 0); PG8_STAGE(PG8_SA(0, 1), a2, wA1);
            PG8_WAIT_L(8); PG8_BAR; PG8_WAIT_L(0); PG8_MMA(0, 0, At, B0); PG8_BAR; PG8_SCHED;
            PG8_LDB(B1, 1, 1); PG8_STAGE(PG8_SB(1, 0), b3, voffB);
            PG8_BAR; PG8_WAIT_L(0); PG8_MMA(0, 1, At, B1); PG8_BAR;
            PG8_LDA(At, 1, 1); PG8_STAGE(PG8_SA(1, 0), a3, wA0);
            PG8_BAR; PG8_WAIT_L(0); PG8_MMA(1, 0, At, B0); PG8_BAR; PG8_SCHED;
            PG8_STAGE(PG8_SB(1, 1), b3 + hstepB, voffB);
            PG8_WAIT_V(6); PG8_BAR; PG8_MMA(1, 1, At, B1); PG8_BAR;
        }
        E(acc, cur, wr, wc, fr, fq);
        if (!has_next) break;
#pragma unroll
        for (int a = 0; a < 2; ++a)
#pragma unroll
            for (int b = 0; b < 2; ++b)
#pragma unroll
                for (int m = 0; m < 4; ++m)
#pragma unroll
                    for (int n = 0; n < 2; ++n) acc[a][b][m][n] = (f32x4){0.f, 0.f, 0.f, 0.f};
        cur = nxt; cA = nA; cB = nB; ++ui;
        if (GATHER) { _Pragma("unroll") for (int i = 0; i < 2; ++i) { vA0[i] = nA0[i]; vA1[i] = nA1[i]; } }
    }
    PG8_WAIT_V(0);
    if (wr == 0) PG8_BAR;
    PG8_BAR;
#undef PG8_GATHER_OFFS
#undef PG8_SA
#undef PG8_SB
#undef PG8_STAGE
#undef PG8_LDA
#undef PG8_LDB
#undef PG8_MMA
#undef PG8_WAIT_V
#undef PG8_WAIT_L
#undef PG8_BAR
#undef PG8_SCHED
}
}
using pg8::Unit;

struct SchedDense {
    const char* A; const char* Bt; int lda, ldb, nM, nN, nt, G, c;
    DI bool next(int i, Unit& u) const {
        const long L = (long)i * G + c; if (L >= (long)nM * nN) return false;
        int pm, pn; pg8::tile_of((int)L, nM, nN, pm, pn);
        u.pm = pm; u.pn = pn; u.aux = 0; u.nt = nt; u.pa = A + (size_t)pm * 256 * lda; u.pb = Bt + (size_t)pn * 256 * ldb; return true;
    }
};

struct SchedProj {
    const char* A; const char* Bt; int l, G, c;
    DI bool next(int i, Unit& u) const {
        const long L = (long)i * G + c; int pm, pn;
        if (l == 0) { if (L >= 36 * 49) return false; pg8::tile_of((int)L, 36, 49, pm, pn); }
        else if (G == 256) {
            if (L >= 32 * 47 + 8 + 24) return false;
            if (L < 32 * 47) pg8::tile_of((int)L, 32, 47, pm, pn);
            else if (L < 32 * 47 + 8) { const int r = (int)L - 32 * 47; pm = 32 + (r >> 1); pn = (r & 1) ? 23 : 18; }
            else { pm = (int)L - (32 * 47 + 8); pn = 47; } }
        else { if (L >= 32 * 49 + 44) return false;
            if (L < 32 * 49) pg8::tile_of((int)L, 32, 49, pm, pn);
            else { const int r = (int)L - 32 * 49, j = r % 11; pm = 32 + r / 11; pn = j < 8 ? 4 + j : (j == 8 ? 18 : (j == 9 ? 23 : 24)); } }
        u.pm = pm; u.pn = pn; u.aux = 0; u.nt = 32; u.pa = A + (size_t)pm * 256 * (DM * 2); u.pb = Bt + (size_t)pn * 256 * (DM * 2); return true;
    }
};

struct SchedDefer {
    const char* A; const char* Bt; int c;
    DI bool next(int i, Unit& u) const {
        if (i != 0 || c < 0 || c >= 76) return false;
        int pm, pn;
        if (c < 8) { pm = 24 + c; pn = 47; }
        else if (c < 40) { pm = c - 8; pn = 48; }
        else { const int r = c - 40, j = r % 9; pm = 32 + r / 9; pn = j < 8 ? 4 + j : 24; }
        u.pm = pm; u.pn = pn; u.aux = 0; u.nt = 32; u.pa = A + (size_t)pm * 256 * (DM * 2); u.pb = Bt + (size_t)pn * 256 * (DM * 2); return true;
    }
};

#define EPI_FOREACH(...) \
    _Pragma("unroll") for (int ai = 0; ai < 2; ++ai) _Pragma("unroll") for (int m = 0; m < 4; ++m) { const int row = u.pm * 256 + ai * 128 + wr * 64 + m * 16 + fr; \
    _Pragma("unroll") for (int bj = 0; bj < 2; ++bj) { const int col = u.pn * 256 + bj * 128 + wc * 32 + 8 * fq; const f32x4 v0 = acc[ai][bj][m][0], v1 = acc[ai][bj][m][1]; __VA_ARGS__ } }

DI u32x4 pack8(const f32x4 v0, const f32x4 v1) { u32x4 w; w.x = pk2(v0[0], v0[1]); w.y = pk2(v0[2], v0[3]); w.z = pk2(v1[0], v1[1]); w.w = pk2(v1[2], v1[3]); return w; }

struct EpiStoreBf16 {
    bf16_t* O; int ldc;
    DI void operator()(const f32x4 (&acc)[2][2][4][2], const Unit& u, int wr, int wc, int fr, int fq) const {
        EPI_FOREACH({ *(u32x4*)(O + (size_t)row * ldc + col) = pack8(v0, v1); })
    }
};
struct EpiProj {
    bf16_t* P;
    DI void operator()(const f32x4 (&acc)[2][2][4][2], const Unit& u, int wr, int wc, int fr, int fq) const {
        EPI_FOREACH({ *(u32x4*)(P + (size_t)row * NP + col) = pack8(v0, v1); })
    }
};
struct EpiX {
    bf16_t* KR; float* X80; const float* rla;
    DI void operator()(const f32x4 (&acc)[2][2][4][2], const Unit& u, int wr, int wc, int fr, int fq) const {
#pragma unroll
        for (int ai = 0; ai < 2; ++ai)
#pragma unroll
            for (int m = 0; m < 4; ++m) { const int row = u.pm * 256 + ai * 128 + wr * 64 + m * 16 + fr; const bool lat = row < MLAT; const int t = row & 2047;
#pragma unroll
                for (int n = 0; n < 2; ++n) { const f32x4 v = acc[ai][0][m][n];
                    f32x4 pr; pr.x = shx(v.x, 32); pr.y = shx(v.y, 32); pr.z = shx(v.z, 32); pr.w = shx(v.w, 32);
                    if (wc < 2) {
                        const int idx = 8 * (fq & 1) + 4 * n; f32x4 o = v;
                        if (lat) { const float* cs = rla + ((size_t)t * 32 + wc * 16 + idx) * 2; const f32x4 c0 = *(const f32x4*)cs, c1 = *(const f32x4*)(cs + 4);
                            if (fq < 2) { o.x = v.x * c0.x - pr.x * c0.y; o.y = v.y * c0.z - pr.y * c0.w; o.z = v.z * c1.x - pr.z * c1.y; o.w = v.w * c1.z - pr.w * c1.w; }
                            else        { o.x = pr.x * c0.y + v.x * c0.x; o.y = pr.y * c0.w + v.y * c0.z; o.z = pr.z * c1.y + v.z * c1.x; o.w = pr.w * c1.w + v.w * c1.z; } }
                        u32x2 w2; w2.x = pk2(o.x, o.y); w2.y = pk2(o.z, o.w);
                        *(u32x2*)(KR + (size_t)row * 64 + 32 * wc + 8 * fq + 4 * n) = w2;
                    } else if (wc == 2 && fq < 2) *(f32x4*)(X80 + (size_t)row * XW + 64 + 8 * fq + 4 * n) = v;
                } }
    }
};

DI int win_src_col(int n) {
    if (n < 4096) return n;
    if (n < 4608) return n - 4096 + 4112;
    if (n < 4864) return n - 4608 + 4624;
    if (n < 5888) return n - 4864 + 4944;
    if (n < 6144) return n - 5888 + 5968;
    if (n < 6400) return n - 6144 + 6224;
    if (n < 12544) return n - 6400 + 6480;
    if (n < 12608) return n - 12544 + 4880;
    if (n < 12624) return n - 12608 + 4096;
    return -1;
}
DI void transpose_item(const float* W, int ldw, int K, bf16_t* WT, int k0, int n0, int srcc, LAS float* scr, int lane) {
#pragma unroll 8
    for (int i = 0; i < 32; ++i) { const int kk = 2 * i + (lane >> 5); scr[kk * 33 + (lane & 31)] = srcc >= 0 ? W[(size_t)(k0 + kk) * ldw + srcc] : 0.f; }
    LDS_WAIT(); asm volatile("" ::: "memory");
    const int c = lane & 7;
#pragma unroll
    for (int j = 0; j < 4; ++j) { const int n = (lane >> 3) + 8 * j; const LAS float* s = scr + (8 * c) * 33 + n;
        u32x4 o; o.x = pk2(s[0 * 33], s[1 * 33]); o.y = pk2(s[2 * 33], s[3 * 33]); o.z = pk2(s[4 * 33], s[5 * 33]); o.w = pk2(s[6 * 33], s[7 * 33]);
        *(u32x4*)(WT + (size_t)(n0 + n) * K + k0 + 8 * c) = o; }
    LDS_WAIT(); asm volatile("" ::: "memory");
}

constexpr int IT_IN = 32 * 400, IT_UQ = 8 * 48, IT_UKV = 4 * 64, IT_BR = 16 * 64, IT_OUT = 32 * 64, IT_E13 = 32 * 64, IT_E2 = 16 * 64;
constexpr int IT_EARLY = IT_IN + IT_UQ + IT_UKV, IT_LAYER = IT_EARLY + 3 * IT_BR + IT_OUT + NEXP * IT_E13 + NEXP * IT_E2;
struct CvDesc { const float* src; size_t ld2; bf16_t* dst; int K; };
DI CvDesc cv_make(const float* W, int ldw, int K, bf16_t* WT, int k0, int n0, int srcc, int lane) {
    CvDesc d; d.src = srcc >= 0 ? W + (size_t)(k0 + (lane >> 5)) * ldw + srcc : nullptr; d.ld2 = 2 * (size_t)ldw; d.dst = WT + (size_t)n0 * K + k0; d.K = K; return d; }
DI CvDesc cv_desc(const Frame& F, const Args& a, int l, int r) {
    unsigned char* wl = F.ws + WS_W + (size_t)l * W_LAYER;
    const int lane = F.lane, ln = lane & 31;
    if (r < IT_IN) { const int kb = r / 400, nb = r % 400; return cv_make(a.in[I_WIN] + (size_t)l * DM * PROJW, PROJW, DM, (bf16_t*)(wl + W_IN), 64 * kb, 32 * nb, win_src_col(32 * nb + ln), lane); } r -= IT_IN;
    if (r < IT_UQ) { const int kb = r / 48, nb = r % 48; return cv_make(a.in[I_UQ] + (size_t)l * 512 * 1536, 1536, 512, (bf16_t*)(wl + W_UQ), 64 * kb, 32 * nb, 32 * nb + ln, lane); } r -= IT_UQ;
    if (r < IT_UKV) { const int kb = r / 64, nb = r % 64; return cv_make(a.in[I_UKV] + (size_t)l * 256 * 2048, 2048, 256, (bf16_t*)(wl + W_UKV), 64 * kb, 32 * nb, 32 * nb + ln, lane); } r -= IT_UKV;
    if (r < 3 * IT_BR) { const int br = r / IT_BR, q = r % IT_BR, kb = q / 64, nb = q % 64;
        return cv_make(a.in[I_BRML + br] + (size_t)l * 1024 * 2048, 2048, 1024, (bf16_t*)(wl + W_BR) + (size_t)br * 2048 * 1024, 64 * kb, 32 * nb, 32 * nb + ln, lane); } r -= 3 * IT_BR;
    if (r < IT_OUT) { const int kb = r / 64, nb = r % 64; return cv_make(a.in[I_WOUT] + (size_t)l * 2048 * 2048, 2048, 2048, (bf16_t*)(wl + W_OUT), 64 * kb, 32 * nb, 32 * nb + ln, lane); } r -= IT_OUT;
    if (r < NEXP * IT_E13) { const int e = r / IT_E13, q = r % IT_E13, kb = q / 64, nb = q % 64;
        const int n0 = 32 * nb, j = n0 >> 8, half = (n0 >> 7) & 1, cc = n0 & 127;
        return cv_make(a.in[half ? I_WE3 : I_WE1] + ((size_t)l * NEXP + e) * 2048 * 1024, 1024, 2048, (bf16_t*)(wl + W_E13) + (size_t)e * 2048 * 2048, 64 * kb, n0, j * 128 + cc + ln, lane); } r -= NEXP * IT_E13;
    { const int e = r / IT_E2, q = r % IT_E2, kb = q / 64, nb = q % 64;
        return cv_make(a.in[I_WE2] + ((size_t)l * NEXP + e) * 1024 * 2048, 2048, 1024, (bf16_t*)(wl + W_E2) + (size_t)e * 2048 * 1024, 64 * kb, 32 * nb, 32 * nb + ln, lane); }
}
DI void cv_load(const CvDesc& d, float (&v)[32]) {
#pragma unroll
    for (int i = 0; i < 32; ++i) v[i] = d.src ? __builtin_nontemporal_load(d.src + (size_t)i * d.ld2) : 0.f;
}
DI void cv_store(const CvDesc& d, const float (&v)[32], LAS float* scr, int lane) {
#pragma unroll
    for (int i = 0; i < 32; ++i) scr[(2 * i + (lane >> 5)) * 33 + (lane & 31)] = v[i];
    LDS_WAIT(); asm volatile("" ::: "memory");
    const int c = lane & 7;
#pragma unroll
    for (int j = 0; j < 4; ++j) { const int n = (lane >> 3) + 8 * j; const LAS float* s = scr + (8 * c) * 33 + n;
        u32x4 o; o.x = pk2(s[0 * 33], s[1 * 33]); o.y = pk2(s[2 * 33], s[3 * 33]); o.z = pk2(s[4 * 33], s[5 * 33]); o.w = pk2(s[6 * 33], s[7 * 33]);
        *(u32x4*)(d.dst + (size_t)n * d.K + 8 * c) = o; }
    LDS_WAIT(); asm volatile("" ::: "memory");
}
DI void convert_range(const Frame& F, const Args& a, int first, int stride, int n_items, LAS float* scr) {
    int it = first; if (it >= n_items) return;
    CvDesc cur = cv_desc(F, a, it / IT_LAYER, it % IT_LAYER); float v[32]; cv_load(cur, v);
    for (;;) {
        const int nx = it + stride; const bool hn = nx < n_items; const int pn = hn ? nx : it;
        const CvDesc nd = cv_desc(F, a, pn / IT_LAYER, pn % IT_LAYER); float wv[32]; cv_load(nd, wv);
        cv_store(cur, v, scr, F.lane);
        if (!hn) break;
        cur = nd; it = nx;
#pragma unroll
        for (int i = 0; i < 32; ++i) v[i] = wv[i];
    }
}
DI void convert_item(const Frame& F, const Args& a, int l, int r, LAS float* scr) {
    const CvDesc d = cv_desc(F, a, l, r); float v[32]; cv_load(d, v); cv_store(d, v, scr, F.lane);
}

DI void phase_prologue(const Frame& F, const Args& a, int rep) {
    LAS float* scr = (LAS float*)(F.lds + F.wave * 16384);
    if (rep == 0) {
        const float* c = a.in[I_C]; const float* cctx = a.in[I_CCTX]; const float* wmod = a.in[I_WMOD];
        constexpr int NIT = 2 * 48 * 16;
        for (int it = F.gw; it < NIT; it += F.ngw) {
            const int l = it / 768, rem = it % 768, cb = rem / 16, kp = rem % 16, k0 = kp * 128, j0 = cb * 256 + F.lane * 4;
#pragma unroll
            for (int i = 0; i < 10; ++i) { const int idx = F.lane + 64 * i, r = idx >> 7, kk = idx & 127; const float v = r < 4 ? c[r * DM + k0 + kk] : cctx[k0 + kk]; scr[idx] = siluf_(v); }
            LDS_WAIT(); asm volatile("" ::: "memory");
            f32x4 acc[5];
#pragma unroll
            for (int r = 0; r < 5; ++r) acc[r] = (f32x4){0.f, 0.f, 0.f, 0.f};
            const float* wp = wmod + ((size_t)l * DM + k0) * (6 * DM) + j0;
#pragma unroll 8
            for (int kk = 0; kk < 128; ++kk) { const f32x4 w = __builtin_nontemporal_load((const f32x4*)(wp + (size_t)kk * (6 * DM)));
#pragma unroll
                for (int r = 0; r < 5; ++r) acc[r] += w * scr[r * 128 + kk]; }
#pragma unroll
            for (int r = 0; r < 5; ++r) *(f32x4*)((float*)(F.ws + WS_MPART) + ((size_t)(kp * 2 + l) * 5 + r) * (6 * DM) + j0) = acc[r];
            LDS_WAIT(); asm volatile("" ::: "memory");
        }
    }
    {
        float* rla = (float*)(F.ws + WS_ROPE_LA); float* rga = (float*)(F.ws + WS_ROPE_GA);
        const int gt = F.gw * 64 + F.lane, ngt = F.ngw * 64;
        for (int i = gt; i < 2048 * 32; i += ngt) { const int t = i >> 5, aidx = i & 31, ax = aidx >> 4, fi = aidx & 15;
            const float inv = exp2f(-(float)fi * (13.287712379549449f / 16.f)); const float ang = (float)(ax ? (t & 63) : (t >> 6)) * inv;
            rla[2 * i] = cosf(ang); rla[2 * i + 1] = sinf(ang); }
        for (int i = gt; i < 2048 * 64; i += ngt) { const int t = i >> 6, aidx = i & 63, ax = aidx >> 5, fi = aidx & 31;
            const float inv = exp2f(-(float)fi * (13.287712379549449f / 32.f)); const float ang = (float)(ax ? (t & 63) : (t >> 6)) * inv;
            rga[2 * i] = cosf(ang); rga[2 * i + 1] = sinf(ang); }
    }
#ifndef MK_CONVTAIL
#define MK_CONVTAIL 0
#endif
#ifndef MK_FILL
#define MK_FILL 0
#endif
#ifndef MK_CVSIDE
#define MK_CVSIDE 2
#endif
#ifndef MK_CVFROM
#define MK_CVFROM IT_EARLY
#endif
    if (MK_CONVTAIL) { for (int it = F.gw; it < IT_EARLY; it += F.ngw) convert_item(F, a, 0, it, scr); }
    else convert_range(F, a, F.gw, F.ngw, MK_CVSIDE ? MK_CVFROM : (MK_FILL ? IT_LAYER : 2 * IT_LAYER), scr);
}

DI void phase_mods_reduce(const Frame& F, const Args& a) {
    float* mods = (float*)(F.ws + WS_MODS); const float* part = (const float*)(F.ws + WS_MPART); const float* bmod = a.in[I_BMOD];
    const int gt = F.gw * 64 + F.lane, ngt = F.ngw * 64;
    for (int i = gt; i < 2 * 5 * 12288 / 4; i += ngt) { const int l = i / (5 * 3072), j4 = i % 3072;
        f32x4 s = *(const f32x4*)(bmod + (size_t)l * 12288 + 4 * j4);
#pragma unroll
        for (int kp = 0; kp < 16; ++kp) s += *(const f32x4*)(part + (size_t)kp * (2 * 5 * 12288) + 4 * (size_t)i);
        *(f32x4*)(mods + 4 * (size_t)i) = s; }
}

DI const float* resid_row(const Frame& F, const Args& a, int l, int row) {
    if (l == 0) return row < MLAT ? a.in[I_X] + (size_t)row * DM : a.in[I_CTX] + (size_t)(row - MLAT) * DM;
    return (const float*)(F.ws + WS_X1) + (size_t)row * DM;
}
DI void load_row(const float* p, int lane, f32x4 (&v)[8]) {
#pragma unroll
    for (int j = 0; j < 8; ++j) v[j] = *(const f32x4*)(p + 4 * lane + 256 * j);
}
template <bool G2LDS = false>
DI void combine_row(const Frame& F, int lp, int row, const f32x4 (&x)[8], int tokv, f32x4 (&v)[8], const LAS float* g2l = nullptr) {
    const bf16_t* YE = (const bf16_t*)(F.ws + WS_YE);
    f32x4 s[8];
#pragma unroll
    for (int j = 0; j < 8; ++j) s[j] = (f32x4){0.f, 0.f, 0.f, 0.f};
    unsigned mask = (unsigned)__ballot(tokv >= 0) & 0xffffu;
    while (mask) {
        const int e0 = __builtin_ctz(mask); mask &= mask - 1u; const bool two = mask != 0u; const int e1 = two ? __builtin_ctz(mask) : e0; mask &= mask - 1u;
        const int slot0 = __builtin_amdgcn_readlane(tokv, e0), slot1 = __builtin_amdgcn_readlane(tokv, e1);
        const bf16_t* y0r = YE + ((size_t)e0 * ESLOT + slot0) * DM; const bf16_t* y1r = YE + ((size_t)e1 * ESLOT + slot1) * DM;
        s16x4 y0[8], y1[8];
#pragma unroll
        for (int j = 0; j < 8; ++j) { y0[j] = *(const s16x4*)(y0r + 4 * F.lane + 256 * j); y1[j] = *(const s16x4*)(y1r + 4 * F.lane + 256 * j); }
#pragma unroll
        for (int j = 0; j < 8; ++j) s[j] += (f32x4){bf2f((unsigned short)y0[j][0]), bf2f((unsigned short)y0[j][1]), bf2f((unsigned short)y0[j][2]), bf2f((unsigned short)y0[j][3])};
        if (two) {
#pragma unroll
            for (int j = 0; j < 8; ++j) s[j] += (f32x4){bf2f((unsigned short)y1[j][0]), bf2f((unsigned short)y1[j][1]), bf2f((unsigned short)y1[j][2]), bf2f((unsigned short)y1[j][3])}; }
    }
    if (G2LDS) {
#pragma unroll
        for (int j = 0; j < 8; ++j) v[j] = x[j] + s[j] * *(const LAS f32x4*)(g2l + 4 * F.lane + 256 * j); }
    else { const float* g2 = mods_ptr(F, lp, row, 5);
#pragma unroll
        for (int j = 0; j < 8; ++j) v[j] = x[j] + s[j] * *(const f32x4*)(g2 + 4 * F.lane + 256 * j); }
}
DI void modulate_vals(const Frame& F, const f32x4 (&v)[8], const float* sh, const float* sc, bf16_t* hrow, f32x4 (&hv)[8]) {
    float ss = 0.f;
#pragma unroll
    for (int j = 0; j < 8; ++j) ss += v[j].x * v[j].x + v[j].y * v[j].y + v[j].z * v[j].z + v[j].w * v[j].w;
    const float rs = rsqrtf(wave_sum(ss) * (1.f / DM) + EPS);
#pragma unroll
    for (int j = 0; j < 8; ++j) { const f32x4 s1 = *(const f32x4*)(sc + 4 * F.lane + 256 * j), s0 = *(const f32x4*)(sh + 4 * F.lane + 256 * j);
        const f32x4 h = v[j] * rs * (s1 + 1.f) + s0; hv[j] = h;
        u32x2 w; w.x = pk2(h.x, h.y); w.y = pk2(h.z, h.w); *(u32x2*)(hrow + 4 * F.lane + 256 * j) = w; }
}
DI void phase_mod1(const Frame& F, const Args& a, int l) {
    bf16_t* H = (bf16_t*)(F.ws + WS_H); const int* TOK = (const int*)(F.ws + WS_TOK);
    LAS float* ms = (LAS float*)F.lds;
    { const float* MODS = (const float*)(F.ws + WS_MODS);
      for (int i = F.tid; i < 5 * 3 * 512; i += NTHR) { const int r = i / 1536, w = (i / 512) % 3, c4 = i % 512;
          if (w == 2 && l == 0) continue;
          const int ll = w == 2 ? l - 1 : l, which = w == 2 ? 5 : w;
          f32x4 val = *(const f32x4*)(MODS + ((size_t)(ll * 5 + r) * 6 + which) * DM + 4 * c4); if (w == 1) val += 1.f;
          *(LAS f32x4*)(ms + (size_t)(r * 3 + w) * DM + 4 * c4) = val; }
      __syncthreads(); }
    int row = F.gw; if (row >= MTOT) return;
    f32x4 cur[8]; int tcur = 0;
    load_row(resid_row(F, a, l, row), F.lane, cur); if (l > 0) tcur = TOK[(size_t)row * 16 + (F.lane & 15)];
    for (;;) {
        const int nrow = row + F.ngw; const bool hn = nrow < MTOT; const int pr = hn ? nrow : row;
        f32x4 nxt[8]; int tnxt = 0;
        load_row(resid_row(F, a, l, pr), F.lane, nxt); if (l > 0) tnxt = TOK[(size_t)pr * 16 + (F.lane & 15)];
        f32x4 v[8];
        if (l == 0) {
#pragma unroll
            for (int j = 0; j < 8; ++j) v[j] = cur[j]; }
        const LAS float* mr = ms + (size_t)mods_row(row) * 3 * DM;
        if (l != 0) { combine_row<true>(F, l - 1, row, cur, tcur, v, mr + 2 * DM); float* xw = (float*)(F.ws + WS_X1) + (size_t)row * DM;
#pragma unroll
            for (int j = 0; j < 8; ++j) *(f32x4*)(xw + 4 * F.lane + 256 * j) = v[j]; }
        { float ss = 0.f;
#pragma unroll
          for (int j = 0; j < 8; ++j) ss += v[j].x * v[j].x + v[j].y * v[j].y + v[j].z * v[j].z + v[j].w * v[j].w;
          const float rs = rsqrtf(wave_sum(ss) * (1.f / DM) + EPS);
          bf16_t* hrow = H + (size_t)row * DM;
#pragma unroll
          for (int j = 0; j < 8; ++j) { const f32x4 h = v[j] * rs * *(const LAS f32x4*)(mr + DM + 4 * F.lane + 256 * j) + *(const LAS f32x4*)(mr + 4 * F.lane + 256 * j);
              u32x2 w; w.x = pk2(h.x, h.y); w.y = pk2(h.z, h.w); *(u32x2*)(hrow + 4 * F.lane + 256 * j) = w; } }
        if (!hn) break;
#pragma unroll
        for (int j = 0; j < 8; ++j) cur[j] = nxt[j];
        tcur = tnxt; row = nrow;
    }
}
DI void phase_mod2(const Frame& F, const Args& a, int l, int nrows) {
    bf16_t* H = (bf16_t*)(F.ws + WS_H); float* AFF = (float*)(F.ws + WS_AFF);
    LAS float* wr = (LAS float*)F.lds;
    const float* wsrc = a.in[I_WROUTER] + (size_t)l * DM * NEXP;
    for (int i = F.tid; i < DM * NEXP / 4; i += NTHR) { const f32x4 w4 = ((const f32x4*)wsrc)[i]; const int c = i >> 2, e0 = (i & 3) * 4;
        wr[(e0 + 0) * DM + c] = w4.x; wr[(e0 + 1) * DM + c] = w4.y; wr[(e0 + 2) * DM + c] = w4.z; wr[(e0 + 3) * DM + c] = w4.w; }
    __syncthreads();
    const float* X1 = (const float*)(F.ws + WS_X1);
    auto router = [&](const f32x4 (&hv)[8], int row) {
        float lg[16];
#pragma unroll
        for (int e = 0; e < 16; ++e) lg[e] = 0.f;
#pragma unroll
        for (int j = 0; j < 8; ++j)
#pragma unroll
            for (int e = 0; e < 16; ++e) { const f32x4 w = *(const LAS f32x4*)(wr + e * DM + 4 * F.lane + 256 * j); lg[e] += hv[j].x * w.x + hv[j].y * w.y + hv[j].z * w.z + hv[j].w * w.w; }
        float mx = -1e30f;
#pragma unroll
        for (int e = 0; e < 16; ++e) { lg[e] = wave_sum(lg[e]); mx = fmaxf(mx, lg[e]); }
        float den = 0.f;
#pragma unroll
        for (int e = 0; e < 16; ++e) { lg[e] = __expf(lg[e] - mx); den += lg[e]; }
        const float inv = 1.f / den;
        float mine = 0.f;
#pragma unroll
        for (int e = 0; e < 16; ++e) mine = (F.lane == e) ? lg[e] * inv : mine;
        if (F.lane < 16) AFF[(size_t)F.lane * MTOT + row] = mine;
    };
    const int crow = MLAT + F.gw; const bool hasc = crow < nrows;
    f32x4 cur[8];
    for (int base = 4 * F.gw; base < MLAT; base += 4 * F.ngw) {
        load_row(X1 + (size_t)base * DM, F.lane, cur);
        f32x4 s1[8], s0[8];
        { const float* sh = mods_ptr(F, l, base, 3); const float* sc = mods_ptr(F, l, base, 4);
#pragma unroll
          for (int j = 0; j < 8; ++j) { s1[j] = *(const f32x4*)(sc + 4 * F.lane + 256 * j) + 1.f; s0[j] = *(const f32x4*)(sh + 4 * F.lane + 256 * j); } }
#pragma unroll 1
        for (int k = 0; k < 4; ++k) { const int row = base + k; f32x4 hv[8];
            { const int pr = k < 3 ? row + 1 : (hasc ? crow : row); f32x4 nxt[8]; load_row(X1 + (size_t)pr * DM, F.lane, nxt);
              float ss = 0.f;
#pragma unroll
              for (int j = 0; j < 8; ++j) ss += cur[j].x * cur[j].x + cur[j].y * cur[j].y + cur[j].z * cur[j].z + cur[j].w * cur[j].w;
              const float rs = rsqrtf(wave_sum(ss) * (1.f / DM) + EPS);
              bf16_t* hrow = H + (size_t)row * DM;
#pragma unroll
              for (int j = 0; j < 8; ++j) { const f32x4 h = cur[j] * rs * s1[j] + s0[j]; hv[j] = h;
                  u32x2 w; w.x = pk2(h.x, h.y); w.y = pk2(h.z, h.w); *(u32x2*)(hrow + 4 * F.lane + 256 * j) = w; }
#pragma unroll
              for (int j = 0; j < 8; ++j) cur[j] = nxt[j]; }
            router(hv, row);
        }
    }
    if (hasc) {
        if (4 * F.gw >= MLAT) load_row(X1 + (size_t)crow * DM, F.lane, cur);
        for (int row = crow; row < nrows; row += F.ngw) { f32x4 hv[8];
            modulate_vals(F, cur, mods_ptr(F, l, row, 3), mods_ptr(F, l, row, 4), H + (size_t)row * DM, hv);
            router(hv, row);
            if (row + F.ngw < nrows) load_row(X1 + (size_t)(row + F.ngw) * DM, F.lane, cur); }
    }
    __syncthreads();
}

DI void phase_postproj(const Frame& F, const Args& a, int l) {
    const bf16_t* P = (const bf16_t*)(F.ws + WS_P);
    bf16_t* CQN = (bf16_t*)(F.ws + WS_CQN); bf16_t* CKVN = (bf16_t*)(F.ws + WS_CKVN); bf16_t* QG = (bf16_t*)(F.ws + WS_QG); bf16_t* KG = (bf16_t*)(F.ws + WS_KG);
    const float* qn = a.in[I_LAQN] + l * 512; const float* kvn = a.in[I_LAKVN] + l * 256; const float* gqn = a.in[I_GAQN] + l * 128; const float* gkn = a.in[I_GAKN] + l * 128;
    const float* rga = (const float*)(F.ws + WS_ROPE_GA);
    const int lane = F.lane;
    const f32x4 qg0 = *(const f32x4*)(qn + 8 * lane), qg1 = *(const f32x4*)(qn + 8 * lane + 4), kg0 = *(const f32x4*)(kvn + 4 * lane);
    const int hq = lane >> 4, ax = (lane >> 3) & 1, seg = lane & 7, eo = ax * 64 + 4 * seg;
    const f32x4 gqa = *(const f32x4*)(gqn + eo), gqb = *(const f32x4*)(gqn + eo + 32), gka = *(const f32x4*)(gkn + eo), gkb = *(const f32x4*)(gkn + eo + 32);
    struct Raw { bf16x8 xq; s16x4 xkv; s16x4 ha[3], hb[3]; f32x4 r0, r1; };
    auto load = [&](int row, Raw& R) { const bf16_t* pr = P + (size_t)row * NP; const int t = row & 2047;
        R.xq = *(const bf16x8*)(pr + C_CQ + 8 * lane); R.xkv = *(const s16x4*)(pr + C_CKV + 4 * lane);
#pragma unroll
        for (int p = 0; p < 3; ++p) { const int hh = p < 2 ? 4 * p + hq : 8 + (hq & 1); const bf16_t* src = pr + C_GQ + hh * 128;
            R.ha[p] = *(const s16x4*)(src + eo); R.hb[p] = *(const s16x4*)(src + eo + 32); }
        const float* rp = rga + ((size_t)t * 64 + ax * 32 + 4 * seg) * 2; R.r0 = *(const f32x4*)rp; R.r1 = *(const f32x4*)(rp + 4); };
    static_assert(C_GK == C_GQ + 8 * 128, "q and k heads contiguous");
    int row = F.gw; if (row >= MTOT) return;
    Raw cur; load(row, cur);
    for (;;) {
        const int nrow = row + F.ngw; const bool hn = nrow < MTOT; Raw nxt; load(hn ? nrow : row, nxt);
        const bool lat = row < MLAT; const bool needq = lat || l == 0;
        if (needq) {
            float f[8]; float ss = 0.f;
#pragma unroll
            for (int i = 0; i < 8; ++i) { f[i] = bf2f((unsigned short)cur.xq[i]); ss += f[i] * f[i]; }
            const float rs = rsqrtf(wave_sum(ss) * (1.f / 512.f) + EPS);
            u32x4 w; w.x = pk2(f[0] * rs * qg0.x, f[1] * rs * qg0.y); w.y = pk2(f[2] * rs * qg0.z, f[3] * rs * qg0.w); w.z = pk2(f[4] * rs * qg1.x, f[5] * rs * qg1.y); w.w = pk2(f[6] * rs * qg1.z, f[7] * rs * qg1.w);
            *(u32x4*)(CQN + (size_t)row * 512 + 8 * lane) = w;
        }
        {
            float f[4]; float ss = 0.f;
#pragma unroll
            for (int i = 0; i < 4; ++i) { f[i] = bf2f((unsigned short)cur.xkv[i]); ss += f[i] * f[i]; }
            const float rs = rsqrtf(wave_sum(ss) * (1.f / 256.f) + EPS);
            u32x2 w; w.x = pk2(f[0] * rs * kg0.x, f[1] * rs * kg0.y); w.y = pk2(f[2] * rs * kg0.z, f[3] * rs * kg0.w);
            *(u32x2*)(CKVN + (size_t)row * 256 + 4 * lane) = w;
        }
        const float cs[4] = {cur.r0.x, cur.r0.z, cur.r1.x, cur.r1.z}, sn[4] = {cur.r0.y, cur.r0.w, cur.r1.y, cur.r1.w};
        const int ln = lane_id_();
#pragma unroll
        for (int p = 0; p < 3; ++p) {
            if (p < 2 && !needq) continue;
            float xa[4], xb[4]; float ss = 0.f;
#pragma unroll
            for (int i = 0; i < 4; ++i) { xa[i] = bf2f((unsigned short)cur.ha[p][i]); xb[i] = bf2f((unsigned short)cur.hb[p][i]); ss += xa[i] * xa[i] + xb[i] * xb[i]; }
#pragma unroll
            for (int o = 1; o < 16; o <<= 1) ss += bperm_f(ss, ln ^ o);
            const float rs = rsqrtf(ss * (1.f / 128.f) + EPS);
            const f32x4 ga = p < 2 ? gqa : gka, gb = p < 2 ? gqb : gkb;
            float oa[4], ob[4];
#pragma unroll
            for (int i = 0; i < 4; ++i) { const float ya = xa[i] * rs * ga[i], yb = xb[i] * rs * gb[i]; oa[i] = lat ? ya * cs[i] - yb * sn[i] : ya; ob[i] = lat ? ya * sn[i] + yb * cs[i] : yb; }
            bf16_t* dst = p < 2 ? QG + (size_t)row * 1024 + (4 * p + hq) * 128 : KG + (size_t)row * 256 + (hq & 1) * 128;
            if (p < 2 || hq < 2) { u32x2 wa, wb; wa.x = pk2(oa[0], oa[1]); wa.y = pk2(oa[2], oa[3]); wb.x = pk2(ob[0], ob[1]); wb.y = pk2(ob[2], ob[3]);
                *(u32x2*)(dst + eo) = wa; *(u32x2*)(dst + eo + 32) = wb; }
        }
        if (!hn) break;
        cur = nxt; row = nrow;
    }
}

namespace att {
constexpr int QBLK = 32, KVBLK = 64;
#define SBAR() __builtin_amdgcn_sched_barrier(0)
DI int crow(int r, int hi) { return (r & 3) + 8 * (r >> 2) + 4 * hi; }
DI int v_st(int k, int c) { const int kk = (k & ~0xC) | ((k & 4) << 1) | ((k & 8) >> 1); return ((kk >> 3) * 4 + (c >> 5)) * 512 + ((kk & 7) * 32 + (c & 31)) * 2; }
DI int v_rd_base(int lane) { return ((lane & 3) << 3) | (((lane >> 2) & 3) << 6) | (((lane >> 4) & 1) << 5) | (((lane >> 5) & 1) << 8); }
constexpr int v_rd_off(int d0, int ks, int half) { return d0 * 512 + ks * 4096 + half * 2048; }
template <int OFF> DI s16x4 tr_read(int vb) { s16x4 r; asm volatile("ds_read_b64_tr_b16 %0, %1 offset:%2" : "=&v"(r) : "v"(vb), "i"(OFF) : "memory"); return r; }
template <int D0> DI void pv_one(f32x16& od, int vb, bf16x8 pa0, bf16x8 pa1, bf16x8 pa2, bf16x8 pa3) {
  const s16x4 l0 = tr_read<v_rd_off(D0, 0, 0)>(vb), h0 = tr_read<v_rd_off(D0, 0, 1)>(vb), l1 = tr_read<v_rd_off(D0, 1, 0)>(vb), h1 = tr_read<v_rd_off(D0, 1, 1)>(vb);
  const s16x4 l2 = tr_read<v_rd_off(D0, 2, 0)>(vb), h2 = tr_read<v_rd_off(D0, 2, 1)>(vb), l3 = tr_read<v_rd_off(D0, 3, 0)>(vb), h3 = tr_read<v_rd_off(D0, 3, 1)>(vb);
  asm volatile("s_waitcnt lgkmcnt(0)" ::: "memory"); SBAR();
#define PK(L, H) (bf16x8){L[0], L[1], L[2], L[3], H[0], H[1], H[2], H[3]}
  od = __builtin_amdgcn_mfma_f32_32x32x16_bf16(pa0, PK(l0, h0), od, 0, 0, 0);
  od = __builtin_amdgcn_mfma_f32_32x32x16_bf16(pa1, PK(l1, h1), od, 0, 0, 0);
  od = __builtin_amdgcn_mfma_f32_32x32x16_bf16(pa2, PK(l2, h2), od, 0, 0, 0);
  od = __builtin_amdgcn_mfma_f32_32x32x16_bf16(pa3, PK(l3, h3), od, 0, 0, 0);
#undef PK
}
DI void pv_d0(f32x16* o, int vb, bf16x8 pa0, bf16x8 pa1, bf16x8 pa2, bf16x8 pa3) {
  pv_one<0>(o[0], vb, pa0, pa1, pa2, pa3); pv_one<1>(o[1], vb, pa0, pa1, pa2, pa3); pv_one<2>(o[2], vb, pa0, pa1, pa2, pa3); pv_one<3>(o[3], vb, pa0, pa1, pa2, pa3);
}
template <int DKX, int LDQ, int LDK, int LDV, int LDO, int SDEPTH = 1>
DI void attn_body(const bf16_t* __restrict__ Qb, const bf16_t* __restrict__ Km, const bf16_t* __restrict__ Kx, const bf16_t* __restrict__ Vm, bf16_t* __restrict__ Ob,
                  int kr0, int nt0, int kr1, int nt1, float scale, const float* __restrict__ ropeq  , char* lds) {
  constexpr int ND0 = 8 + DKX / 16, KROWB = (128 + DKX) * 2, SHM_V = KVBLK * 128 * 2, SHM_K = KVBLK * KROWB;
  constexpr float THR = 8.f;
#define KSWZ(row, colB) ((row) * KROWB + ((colB) ^ (((row) & 7) << 4)))
  int tid = threadIdx.x; asm volatile("" : "+v"(tid));
  const int wid = __builtin_amdgcn_readfirstlane(tid >> 6), lane = tid & 63, r32 = lane & 31, hi = lane >> 5;
  char* V_lds = lds; char* K_lds = lds + 2 * SHM_V;
  float* ws = (float*)(lds + 2 * SHM_V + 2 * SHM_K) + wid * 64; float* li_l = ws; float* al_l = ws + 32;
  const float C = scale * 1.4426950408889634f;
  float m_reg = -1e30f, l_reg = 0; f32x16 o[4] = {}; bf16x8 qr[8];
  const bf16_t* Qw = Qb + (long)(wid * QBLK + r32) * LDQ + hi * 8;
#pragma unroll
  for (int d0 = 0; d0 < 8; ++d0) qr[d0] = *reinterpret_cast<const bf16x8*>(Qw + d0 * 16);
  char* QX = lds + 2 * SHM_V + 2 * SHM_K + 2048 + (wid * 4 * 64 + lane) * 16;
  if constexpr (DKX > 0) {
#pragma unroll
    for (int ax = 0; ax < 2; ++ax) {
      const bf16x8 xa = *reinterpret_cast<const bf16x8*>(Qw + 128 + ax * 32), xb = *reinterpret_cast<const bf16x8*>(Qw + 128 + ax * 32 + 16);
      if (ropeq) {
        const float* cs = ropeq + ((size_t)(wid * QBLK + r32) * 32 + ax * 16 + hi * 8) * 2;
        float oa[8], ob[8];
#pragma unroll
        for (int j = 0; j < 8; ++j) { const float c = cs[2 * j], sn = cs[2 * j + 1], a = bf2f((unsigned short)xa[j]), b = bf2f((unsigned short)xb[j]); oa[j] = a * c - b * sn; ob[j] = a * sn + b * c; }
        u32x4 wa = {pk2(oa[0], oa[1]), pk2(oa[2], oa[3]), pk2(oa[4], oa[5]), pk2(oa[6], oa[7])}, wb = {pk2(ob[0], ob[1]), pk2(ob[2], ob[3]), pk2(ob[4], ob[5]), pk2(ob[6], ob[7])};
        *reinterpret_cast<u32x4*>(QX + (2 * ax) * 1024) = wa; *reinterpret_cast<u32x4*>(QX + (2 * ax + 1) * 1024) = wb;
      } else { *reinterpret_cast<bf16x8*>(QX + (2 * ax) * 1024) = xa; *reinterpret_cast<bf16x8*>(QX + (2 * ax + 1) * 1024) = xb; }
    }
  }
  const int sr = tid >> 4, sc = (tid & 15) * 8, vst0 = v_st(sr, sc), vst1 = v_st(32 + sr, sc);
  const int xr = tid >> 3, xc = (tid & 7) * 8;
  const int vb0 = (int)(uintptr_t)V_lds + v_rd_base(lane);
  const int offV = sr * LDV + sc, offK = sr * LDK + sc, offX = xr * 64 + xc;
  struct { bf16x8 vs0, vs1, ks0, ks1, kx; } sr_[SDEPTH];
  const int NT = nt0 + nt1;
#define TROW(j) ((j) < nt0 ? kr0 + (j) * KVBLK : kr1 + ((j) - nt0) * KVBLK)
#define SLOAD(i, j) do { const long _r = TROW(j); const bf16_t* _vt = Vm + _r * LDV; const bf16_t* _kt = Km + _r * LDK; \
    sr_[i].vs0 = *(const bf16x8*)(_vt + offV); sr_[i].vs1 = *(const bf16x8*)(_vt + offV + 32 * LDV); \
    sr_[i].ks0 = *(const bf16x8*)(_kt + offK); sr_[i].ks1 = *(const bf16x8*)(_kt + offK + 32 * LDK); \
    if constexpr (DKX > 0) sr_[i].kx = *(const bf16x8*)(Kx + _r * 64 + offX); } while (0)
#define SWRITE(b, i) do { *(bf16x8*)(V_lds + (b) * SHM_V + vst0) = sr_[i].vs0; *(bf16x8*)(V_lds + (b) * SHM_V + vst1) = sr_[i].vs1; const int kc = sc * 2; \
    *(bf16x8*)(K_lds + (b) * SHM_K + KSWZ(sr, kc)) = sr_[i].ks0; *(bf16x8*)(K_lds + (b) * SHM_K + KSWZ(32 + sr, kc)) = sr_[i].ks1; \
    if constexpr (DKX > 0) *(bf16x8*)(K_lds + (b) * SHM_K + KSWZ(xr, 256 + xc * 2)) = sr_[i].kx; } while (0)
#define SWAIT() do { if constexpr (SDEPTH == 1) asm volatile("s_waitcnt vmcnt(0)" ::: "memory"); else if constexpr (DKX > 0) asm volatile("s_waitcnt vmcnt(5)" ::: "memory"); else asm volatile("s_waitcnt vmcnt(4)" ::: "memory"); } while (0)
#define RESC(a) do { if (__any((a) < 1.f)) { if (hi == 0) al_l[r32] = (a); asm volatile("s_waitcnt lgkmcnt(0)" ::: "memory"); \
    for (int d = 0; d < 4; ++d) for (int r = 0; r < 16; ++r) o[d][r] *= al_l[crow(r, hi)]; } } while (0)
#define QKT(p0, p1, Ks) do { p0 = f32x16{}; p1 = f32x16{}; _Pragma("unroll") for (int d0 = 0; d0 < ND0; ++d0) { const int cb = (d0 * 16 + hi * 8) * 2; \
    const bf16x8 b0 = *reinterpret_cast<const bf16x8*>((Ks) + KSWZ(r32, cb)); const bf16x8 b1 = *reinterpret_cast<const bf16x8*>((Ks) + KSWZ(32 + r32, cb)); \
    const bf16x8 qf = d0 < 8 ? qr[d0 < 8 ? d0 : 0] : *reinterpret_cast<const bf16x8*>(QX + (d0 - 8) * 1024); \
    p0 = __builtin_amdgcn_mfma_f32_32x32x16_bf16(b0, qf, p0, 0, 0, 0); p1 = __builtin_amdgcn_mfma_f32_32x32x16_bf16(b1, qf, p1, 0, 0, 0); if (DKX > 0 && (d0 & 1) == 1) SBAR(); } } while (0)
#define PARTIAL_SM(p0, p1, mn, alpha) do { float pmax = p0[0]; for (int r = 1; r < 16; ++r) pmax = fmaxf(pmax, p0[r]); for (int r = 0; r < 16; ++r) pmax = fmaxf(pmax, p1[r]); \
    { auto rr = __builtin_amdgcn_permlane32_swap(__float_as_uint(pmax), __float_as_uint(pmax), false, false); pmax = fmaxf(__uint_as_float(rr[0]), __uint_as_float(rr[1])); } \
    if (__builtin_expect(__all((pmax - m_reg) * scale <= THR), 1)) { mn = m_reg; alpha = 1.f; } \
    else { mn = fmaxf(m_reg, pmax); alpha = __builtin_amdgcn_exp2f((m_reg - mn) * C); m_reg = mn; } \
    const float mnC = -mn * C; for (int r = 0; r < 16; ++r) p0[r] = fmaf(p0[r], C, mnC); for (int r = 0; r < 16; ++r) p1[r] = fmaf(p1[r], C, mnC); \
    for (int r = 0; r < 16; ++r) p0[r] = __builtin_amdgcn_exp2f(p0[r]); } while (0)
#define PK4(P, BASE, OUT) do { unsigned a0 = pk2(P[BASE + 0], P[BASE + 1]), a1 = pk2(P[BASE + 2], P[BASE + 3]); \
    unsigned b0 = pk2(P[BASE + 4], P[BASE + 5]), b1 = pk2(P[BASE + 6], P[BASE + 7]); \
    auto r0 = __builtin_amdgcn_permlane32_swap(a0, b0, false, false); auto r1 = __builtin_amdgcn_permlane32_swap(a1, b1, false, false); \
    u32x4 w = {r0[0], r1[0], r0[1], r1[1]}; OUT = *reinterpret_cast<bf16x8*>(&w); } while (0)
#define FINISH_SM(p0, p1, alpha) do { for (int r = 0; r < 16; ++r) p1[r] = __builtin_amdgcn_exp2f(p1[r]); \
    float ps = 0; for (int r = 0; r < 16; ++r) ps += p0[r]; for (int r = 0; r < 16; ++r) ps += p1[r]; \
    { auto rr = __builtin_amdgcn_permlane32_swap(__float_as_uint(ps), __float_as_uint(ps), false, false); ps = __uint_as_float(rr[0]) + __uint_as_float(rr[1]); } \
    l_reg = l_reg * alpha + ps; PK4(p0, 0, pa0); PK4(p0, 8, pa1); PK4(p1, 0, pa2); PK4(p1, 8, pa3); } while (0)
  f32x16 pA0, pA1, pB0, pB1; float mnA, mnB, alA, alB; bf16x8 pa0, pa1, pa2, pa3;
  constexpr int SE = 0, SO = SDEPTH - 1;
  SLOAD(SE, 0); asm volatile("s_waitcnt vmcnt(0)" ::: "memory"); SWRITE(0, SE); __syncthreads();
  QKT(pA0, pA1, K_lds); PARTIAL_SM(pA0, pA1, mnA, alA);
  SLOAD(SO, 1); if constexpr (SDEPTH == 2) { if (2 < NT) SLOAD(SE, 2); }
  SWAIT(); SWRITE(1, SO); __syncthreads();
  for (int j = 1; j + 1 < NT; j += 2) {
    SBAR(); QKT(pB0, pB1, K_lds + SHM_K);
    FINISH_SM(pA0, pA1, alA); SBAR();
    SLOAD(SO, j + SDEPTH); SBAR();
    pv_d0(o, vb0, pa0, pa1, pa2, pa3); PARTIAL_SM(pB0, pB1, mnB, alB);
    __syncthreads(); SWAIT(); SWRITE(0, SE);
    RESC(alB); __syncthreads();
    SBAR(); QKT(pA0, pA1, K_lds);
    FINISH_SM(pB0, pB1, alB); SBAR();
    if (SDEPTH == 1 || j + 3 < NT) SLOAD(SE, j + 1 + SDEPTH); SBAR();
    pv_d0(o, vb0 + (int)SHM_V, pa0, pa1, pa2, pa3); PARTIAL_SM(pA0, pA1, mnA, alA);
    __syncthreads(); SWAIT(); SWRITE(1, SO);
    RESC(alA); __syncthreads();
  }
  SBAR(); QKT(pB0, pB1, K_lds + SHM_K);
  FINISH_SM(pA0, pA1, alA); SBAR();
  pv_d0(o, vb0, pa0, pa1, pa2, pa3); PARTIAL_SM(pB0, pB1, mnB, alB);
  __syncthreads(); RESC(alB);
  FINISH_SM(pB0, pB1, alB); SBAR();
  pv_d0(o, vb0 + (int)SHM_V, pa0, pa1, pa2, pa3);
  if (hi == 0) li_l[r32] = l_reg; asm volatile("s_waitcnt lgkmcnt(0)" ::: "memory");
  float rli[16];
#pragma unroll
  for (int r = 0; r < 16; ++r) rli[r] = __builtin_amdgcn_rcpf(li_l[crow(r, hi)]);
  bf16_t* Ow = Ob + (long)(wid * QBLK) * LDO;
#pragma unroll
  for (int r = 0; r < 16; ++r) { const int orow = crow(r, hi);
#pragma unroll
    for (int d0 = 0; d0 < 4; ++d0) Ow[(long)orow * LDO + d0 * 32 + r32] = (bf16_t)f2bf(o[d0][r] * rli[r]); }
  __syncthreads();
#undef KSWZ
#undef TROW
#undef SLOAD
#undef SWRITE
#undef SWAIT
#undef RESC
#undef QKT
#undef PARTIAL_SM
#undef PK4
#undef FINISH_SM
}
}

namespace ml {
constexpr int LD = 264, ROWB = LD * 2, QS_OFF = 0, KS_OFF = 64 * ROWB, VS_OFF = 2 * 64 * ROWB, NV_OFF = 3 * 64 * ROWB, SC_OFF = NV_OFF + 1024, ML_END = SC_OFF + 2048;
static_assert(ML_END <= LDS_BYTES - 1024, "mlstm lds");
#define MFMA32(a, b, c) __builtin_amdgcn_mfma_f32_32x32x16_bf16((a), (b), (c), 0, 0, 0)
DI bf16x8 pack_step(const f32x16& x, int s) {
    u32x4 p;
    asm volatile("v_cvt_pk_bf16_f32 %0, %4, %5\n\tv_cvt_pk_bf16_f32 %1, %6, %7\n\tv_cvt_pk_bf16_f32 %2, %8, %9\n\tv_cvt_pk_bf16_f32 %3, %10, %11\n\ts_nop 1"
                 : "=&v"(p[0]), "=&v"(p[1]), "=&v"(p[2]), "=&v"(p[3])
                 : "v"(x[8 * s]), "v"(x[8 * s + 1]), "v"(x[8 * s + 2]), "v"(x[8 * s + 3]), "v"(x[8 * s + 4]), "v"(x[8 * s + 5]), "v"(x[8 * s + 6]), "v"(x[8 * s + 7]));
    return __builtin_bit_cast(bf16x8, p);
}
DI bf16x8 ld_perm(const LAS unsigned char* p) {
    const s16x4 lo = *(const LAS s16x4*)p, hi = *(const LAS s16x4*)(p + 16);
    return (bf16x8){lo[0], lo[1], lo[2], lo[3], hi[0], hi[1], hi[2], hi[3]};
}
DI int crow(int r, int hi) { return (r & 3) + 8 * (r >> 2) + 4 * hi; }
template <int OFF> DI s16x4 tr_rd(unsigned addr) { s16x4 r; asm volatile("ds_read_b64_tr_b16 %0, %1 offset:%2" : "=&v"(r) : "v"(addr), "i"(OFF) : "memory"); return r; }
#define TR_WAIT() do { asm volatile("s_waitcnt lgkmcnt(0)" ::: "memory"); __builtin_amdgcn_sched_barrier(0); } while (0)
#define CAT8(L, H) (bf16x8){L[0], L[1], L[2], L[3], H[0], H[1], H[2], H[3]}

DI void mlstm_stream(const Frame& F, const Args& a, int l, int stream, bool ctx_out) {
    const int b = stream >> 3, hd = (stream >> 1) & 3, dir = stream & 1;
    const int tid = F.tid, w = F.wave;
    LAS unsigned char* lds = F.lds;
    const unsigned ldsb = (unsigned)(uintptr_t)lds;
    const bf16_t* P = (const bf16_t*)(F.ws + WS_P); const float* X80 = (const float*)(F.ws + WS_X80);
    float* MLH = (float*)(F.ws + WS_MLH) + (size_t)dir * MTOT * 1024;
    const float* gb = a.in[I_GBIAS] + l * 16;
    const float gbi = gb[dir * 8 + hd], gbf = gb[dir * 8 + 4 + hd];
    LAS float* NV = (LAS float*)(lds + NV_OFF);
    LAS float* SC = (LAS float*)(lds + SC_OFF);
    f32x16 CT[8];
#pragma unroll
    for (int i = 0; i < 8; ++i) CT[i] = f32x16{};
    if (tid < 256) NV[tid] = 0.f;
    float m_prev = 0.f;
    const int sgn = dir ? -1 : 1;
#define CHUNK_ROW0(c) ((c) < 4 ? MLAT + b * CTXL + (dir ? 255 - (c) * 64 : (c) * 64) : b * SEQ + (dir ? 2047 - ((c) - 4) * 64 : ((c) - 4) * 64))
    bf16x8 pq[4], pk[4], pv[4]; float pgi, pgf;
#define PREFETCH(c) do { int ln_ = F.lane; asm volatile("" : "+v"(ln_)); const int r0_ = CHUNK_ROW0(c); \
        const bf16_t* pr_ = P + (size_t)(r0_ + sgn * ((w << 3) | (ln_ >> 3))) * NP + hd * 256 + 8 * (ln_ & 7); \
        _Pragma("unroll") for (int j = 0; j < 4; ++j) { pq[j] = *(const bf16x8*)(pr_ + C_MLQ + 64 * j); pk[j] = *(const bf16x8*)(pr_ + C_MLK + 64 * j); pv[j] = *(const bf16x8*)(pr_ + C_MLV + 64 * j); } \
        const float* xg_ = X80 + (size_t)(r0_ + sgn * ln_) * XW + 64 + dir * 8 + hd; pgi = xg_[0]; pgf = xg_[4]; } while (0)
    PREFETCH(0);
#ifndef MK_MLX
#define MK_MLX 1
#endif
    for (int cc = 0; cc < 36 * MK_MLX; ++cc) {
        const int c = cc % 36;
        if (MK_MLX > 1 && cc == 36) { __syncthreads();
#pragma unroll
            for (int i = 0; i < 8; ++i) CT[i] = f32x16{};
            if (tid < 256) NV[tid] = 0.f; m_prev = 0.f; }
        int lane = F.lane; asm volatile("" : "+v"(lane));
        const int r32 = lane & 31, hi = lane >> 5, ldi = (w << 3) | (lane >> 3), cg = lane & 7, g16 = lane >> 4, q4 = (lane & 15) >> 2, p4 = lane & 3;
        const int row0 = CHUNK_ROW0(c);
        const float ipre = pgi + gbi, fpre = pgf + gbf;
        const float lf = fminf(fpre, 0.f) - __logf(1.f + __expf(-fabsf(fpre)));
        float cum = lf;
#pragma unroll
        for (int o = 1; o < 64; o <<= 1) { const float t = shu(cum, o); if (lane >= o) cum += t; }
        const float bb = ipre - cum;
        float pmx = bb;
#pragma unroll
        for (int o = 1; o < 64; o <<= 1) { const float t = shu(pmx, o); if (lane >= o) pmx = fmaxf(pmx, t); }
        const float aa = fmaxf(m_prev, pmx);
        const float cum_end = shl_(cum, 63), a_end = shl_(aa, 63);
        const float decay = __expf(m_prev - a_end), m_new = cum_end + a_end;
        __syncthreads();
#pragma unroll
        for (int j = 0; j < 4; ++j) { const int ch = cg + 8 * j; const bf16x8 qv = pq[j];
            u32x4 qs;
            qs.x = pk2(bf2f((unsigned short)qv[0]) * 0.0625f, bf2f((unsigned short)qv[1]) * 0.0625f); qs.y = pk2(bf2f((unsigned short)qv[2]) * 0.0625f, bf2f((unsigned short)qv[3]) * 0.0625f);
            qs.z = pk2(bf2f((unsigned short)qv[4]) * 0.0625f, bf2f((unsigned short)qv[5]) * 0.0625f); qs.w = pk2(bf2f((unsigned short)qv[6]) * 0.0625f, bf2f((unsigned short)qv[7]) * 0.0625f);
            *(LAS u32x4*)(lds + QS_OFF + (ldi * LD + 8 * ch) * 2) = qs;
            *(LAS bf16x8*)(lds + KS_OFF + (ldi * LD + 8 * ch) * 2) = pk[j];
            *(LAS bf16x8*)(lds + VS_OFF + (ldi * LD + 8 * ch) * 2) = pv[j]; }
        {
            float part = 0.f;
#pragma unroll
            for (int j = 0; j < 4; ++j) { const int ch = cg + 8 * j; const bf16x8 qv = pq[j]; const f32x4 n0 = *(const LAS f32x4*)(NV + 8 * ch), n1 = *(const LAS f32x4*)(NV + 8 * ch + 4);
                part += bf2f((unsigned short)qv[0]) * n0.x + bf2f((unsigned short)qv[1]) * n0.y + bf2f((unsigned short)qv[2]) * n0.z + bf2f((unsigned short)qv[3]) * n0.w
                      + bf2f((unsigned short)qv[4]) * n1.x + bf2f((unsigned short)qv[5]) * n1.y + bf2f((unsigned short)qv[6]) * n1.z + bf2f((unsigned short)qv[7]) * n1.w; }
            part += shx(part, 1); part += shx(part, 2); part += shx(part, 4);
            if (cg == 0) SC[320 + ldi] = part * 0.0625f; }
        if (w == 0) { SC[lane] = bb; SC[64 + lane] = aa; SC[128 + lane] = __expf(m_prev - aa); SC[192 + lane] = __expf(-cum - aa); SC[256 + lane] = __expf(bb - a_end); }
        __syncthreads();
        const bool want_out = (c >= 4) || ctx_out;
        if (want_out) {
            const unsigned va0 = ldsb + VS_OFF + ((4 * (g16 >> 1) + q4) * LD + 32 * w + 16 * (g16 & 1) + 4 * p4) * 2;
#pragma unroll
            for (int lt = 0; lt < 2; ++lt) {
                const int lcol = 32 * lt + r32;
                const float a_l = SC[64 + lcol], wI_l = SC[128 + lcol], fl_l = SC[192 + lcol], nq_l = SC[320 + lcol];
                f32x16 N = f32x16{};
#pragma unroll
                for (int dt = 0; dt < 8; ++dt)
#pragma unroll
                    for (int ks = 0; ks < 2; ++ks) {
                        const bf16x8 qa = ld_perm(lds + QS_OFF + (lcol * LD + 32 * dt + 16 * ks + 4 * hi) * 2);
                        N = MFMA32(pack_step(CT[dt], ks), qa, N); if (ks == 1 && (dt & 1)) __builtin_amdgcn_sched_barrier(0); }
#pragma unroll
                for (int r = 0; r < 16; ++r) N[r] *= wI_l;
                float den = 0.f;
#pragma unroll
                for (int st = 0; st <= lt; ++st) {
                    f32x16 S = f32x16{};
#pragma unroll
                    for (int ks = 0; ks < 16; ++ks) {
                        const bf16x8 ka = *(const LAS bf16x8*)(lds + KS_OFF + ((32 * st + r32) * LD + 16 * ks + 8 * hi) * 2);
                        const bf16x8 qb = *(const LAS bf16x8*)(lds + QS_OFF + (lcol * LD + 16 * ks + 8 * hi) * 2);
                        S = MFMA32(ka, qb, S); }
                    const s16x4 v00 = st == 0 ? tr_rd<0>(va0) : tr_rd<32 * ROWB>(va0), v01 = st == 0 ? tr_rd<8 * ROWB>(va0) : tr_rd<40 * ROWB>(va0);
                    const s16x4 v10 = st == 0 ? tr_rd<16 * ROWB>(va0) : tr_rd<48 * ROWB>(va0), v11 = st == 0 ? tr_rd<24 * ROWB>(va0) : tr_rd<56 * ROWB>(va0);
#pragma unroll
                    for (int r = 0; r < 16; ++r) { const int srow = 32 * st + crow(r, hi); const float dd = __expf(SC[srow] - a_l);
                        const float v = (srow <= lcol) ? S[r] * dd : 0.f; S[r] = v; den += v; }
                    TR_WAIT();
                    N = MFMA32(CAT8(v00, v01), pack_step(S, 0), N);
                    N = MFMA32(CAT8(v10, v11), pack_step(S, 1), N);
                }
                den += shx(den, 32);
                den += wI_l * nq_l;
                const float inv = 1.f / fmaxf(fabsf(den), fl_l);
                float* orow = MLH + (size_t)(row0 + sgn * lcol) * 1024 + hd * 256 + 32 * w + 4 * hi;
#pragma unroll
                for (int g = 0; g < 4; ++g) *(f32x4*)(orow + 8 * g) = (f32x4){N[4 * g] * inv, N[4 * g + 1] * inv, N[4 * g + 2] * inv, N[4 * g + 3] * inv};
                __builtin_amdgcn_sched_barrier(0);
            }
        }
        __builtin_amdgcn_sched_barrier(0);
        { const int cn = (cc + 1 < 36 * MK_MLX) ? (cc + 1) % 36 : 35; PREFETCH(cn); }
        __builtin_amdgcn_sched_barrier(0);
        {
            const unsigned vb0 = ldsb + VS_OFF + ((8 * (g16 >> 1) + q4) * LD + 32 * w + 16 * (g16 & 1) + 4 * p4) * 2;
            const unsigned kb0 = ldsb + KS_OFF + ((8 * (g16 >> 1) + q4) * LD + 16 * (g16 & 1) + 4 * p4) * 2;
            const s16x4 b00 = tr_rd<0>(vb0), b01 = tr_rd<4 * ROWB>(vb0), b10 = tr_rd<16 * ROWB>(vb0), b11 = tr_rd<20 * ROWB>(vb0);
            const s16x4 b20 = tr_rd<32 * ROWB>(vb0), b21 = tr_rd<36 * ROWB>(vb0), b30 = tr_rd<48 * ROWB>(vb0), b31 = tr_rd<52 * ROWB>(vb0);
            TR_WAIT();
            bf16x8 vb[4];
#define SCALE8(dst, L, H, ks) do { const f32x4 w0 = *(const LAS f32x4*)(SC + 256 + 16 * (ks) + 8 * hi), w1 = *(const LAS f32x4*)(SC + 256 + 16 * (ks) + 8 * hi + 4); \
            u32x4 t_; t_.x = pk2(bf2f((unsigned short)L[0]) * w0.x, bf2f((unsigned short)L[1]) * w0.y); t_.y = pk2(bf2f((unsigned short)L[2]) * w0.z, bf2f((unsigned short)L[3]) * w0.w); \
            t_.z = pk2(bf2f((unsigned short)H[0]) * w1.x, bf2f((unsigned short)H[1]) * w1.y); t_.w = pk2(bf2f((unsigned short)H[2]) * w1.z, bf2f((unsigned short)H[3]) * w1.w); dst = __builtin_bit_cast(bf16x8, t_); } while (0)
            SCALE8(vb[0], b00, b01, 0); SCALE8(vb[1], b10, b11, 1); SCALE8(vb[2], b20, b21, 2); SCALE8(vb[3], b30, b31, 3);
#undef SCALE8
#define UPD(dt) do { const s16x4 k00 = tr_rd<(dt) * 64>(kb0), k01 = tr_rd<(dt) * 64 + 4 * ROWB>(kb0), k10 = tr_rd<(dt) * 64 + 16 * ROWB>(kb0), k11 = tr_rd<(dt) * 64 + 20 * ROWB>(kb0); \
            const s16x4 k20 = tr_rd<(dt) * 64 + 32 * ROWB>(kb0), k21 = tr_rd<(dt) * 64 + 36 * ROWB>(kb0), k30 = tr_rd<(dt) * 64 + 48 * ROWB>(kb0), k31 = tr_rd<(dt) * 64 + 52 * ROWB>(kb0); \
            _Pragma("unroll") for (int r = 0; r < 16; ++r) CT[dt][r] *= decay; \
            TR_WAIT(); \
            CT[dt] = MFMA32(CAT8(k00, k01), vb[0], CT[dt]); CT[dt] = MFMA32(CAT8(k10, k11), vb[1], CT[dt]); CT[dt] = MFMA32(CAT8(k20, k21), vb[2], CT[dt]); CT[dt] = MFMA32(CAT8(k30, k31), vb[3], CT[dt]); } while (0)
            UPD(0); UPD(1); UPD(2); UPD(3); UPD(4); UPD(5); UPD(6); UPD(7);
#undef UPD
        }
        __syncthreads();
        if (tid < 256) { float sacc = 0.f;
#pragma unroll 8
            for (int q = 0; q < 64; ++q) sacc += bf2f(*(const LAS unsigned short*)(lds + KS_OFF + (q * LD + tid) * 2)) * SC[256 + q];
            NV[tid] = decay * NV[tid] + sacc; }
        m_prev = m_new;
    }
    __syncthreads();
#undef CHUNK_ROW0
#undef PREFETCH
}

namespace u2 {
constexpr int LDQ = 264, ROWQ = LDQ * 2, LDV = 136, ROWV = LDV * 2, LDW = 72, ROWW = LDW * 2;
constexpr int QS = 0, KS = 64 * ROWQ, VS = 2 * 64 * ROWQ, SW = VS + 64 * ROWV, NV_O = SW + 64 * ROWW, SC_O = NV_O + 1024, SCN = 448, END = SC_O + 2 * SCN * 4;
static_assert(END <= LDS_BYTES - 1024, "mlstm2 lds");
}
DI void mlstm_unit2(const Frame& F, const Args& a, int l, int unit, bool ctx_out) {
    using namespace u2;
    const int stream = unit >> 1, half = unit & 1, b = stream >> 3, hd = (stream >> 1) & 3, dir = stream & 1;
    const int tid = F.tid, w = F.wave;
    LAS unsigned char* lds = F.lds;
    const unsigned ldsb = (unsigned)(uintptr_t)lds;
    const bf16_t* P = (const bf16_t*)(F.ws + WS_P); const float* X80 = (const float*)(F.ws + WS_X80);
    bf16_t* MLH = (bf16_t*)(F.ws + WS_MLH) + (size_t)dir * MTOT * 1024;
    const float* gb = a.in[I_GBIAS] + l * 16;
    const float gbi = gb[dir * 8 + hd], gbf = gb[dir * 8 + 4 + hd];
    LAS float* NV = (LAS float*)(lds + NV_O);
    const int sgn = dir ? -1 : 1;
#define CHUNK_ROW0(c) ((c) < 4 ? MLAT + b * CTXL + (dir ? 255 - (c) * 64 : (c) * 64) : b * SEQ + (dir ? 2047 - ((c) - 4) * 64 : ((c) - 4) * 64))
    const bool helper = w >= 4;
    bf16x8 pq[8], pk[8], pv[4]; float pgi = 0.f, pgf = 0.f; float m_prev = 0.f;
#define PREFETCH(c) do { int ht_ = tid - 256; asm volatile("" : "+v"(ht_)); const int r0_ = CHUNK_ROW0(c); \
        const bf16_t* pr_ = P + (size_t)(r0_ + sgn * (ht_ >> 2)) * NP + hd * 256 + 8 * (ht_ & 3); \
        _Pragma("unroll") for (int j = 0; j < 8; ++j) { pq[j] = *(const bf16x8*)(pr_ + C_MLQ + 32 * j); pk[j] = *(const bf16x8*)(pr_ + C_MLK + 32 * j); } \
        _Pragma("unroll") for (int j = 0; j < 4; ++j) pv[j] = *(const bf16x8*)(pr_ + C_MLV + 128 * half + 32 * j); \
        const float* xg_ = X80 + (size_t)(r0_ + sgn * (ht_ & 63)) * XW + 64 + dir * 8 + hd; pgi = xg_[0]; pgf = xg_[4]; } while (0)
#define SCALARS(sb) do { if (w == 4) { int ln_ = F.lane; asm volatile("" : "+v"(ln_)); LAS float* SCw = (LAS float*)(lds + SC_O) + (sb) * SCN; \
        const float ipre = pgi + gbi, fpre = pgf + gbf; const float lf = fminf(fpre, 0.f) - __logf(1.f + __expf(-fabsf(fpre))); \
        float cum = lf; _Pragma("unroll") for (int o = 1; o < 64; o <<= 1) { const float t = shu(cum, o); if (ln_ >= o) cum += t; } \
        const float bb = ipre - cum; float pmx = bb; _Pragma("unroll") for (int o = 1; o < 64; o <<= 1) { const float t = shu(pmx, o); if (ln_ >= o) pmx = fmaxf(pmx, t); } \
        const float aa = fmaxf(m_prev, pmx); const float cum_end = shl_(cum, 63), a_end = shl_(aa, 63); \
        { SCw[ln_] = bb; SCw[64 + ln_] = aa; SCw[128 + ln_] = __expf(m_prev - aa); SCw[192 + ln_] = __expf(-cum - aa); SCw[256 + ln_] = __expf(bb - a_end); if (ln_ == 0) SCw[384] = __expf(m_prev - a_end); } \
        m_prev = cum_end + a_end; } } while (0)
#define WRITE_Q() do { int ht_ = tid - 256; asm volatile("" : "+v"(ht_)); const int hp_ = ht_ >> 2, hg_ = ht_ & 3; \
        _Pragma("unroll") for (int j = 0; j < 8; ++j) { const bf16x8 qv = pq[j]; u32x4 qs; \
            qs.x = pk2(bf2f((unsigned short)qv[0]) * 0.0625f, bf2f((unsigned short)qv[1]) * 0.0625f); qs.y = pk2(bf2f((unsigned short)qv[2]) * 0.0625f, bf2f((unsigned short)qv[3]) * 0.0625f); \
            qs.z = pk2(bf2f((unsigned short)qv[4]) * 0.0625f, bf2f((unsigned short)qv[5]) * 0.0625f); qs.w = pk2(bf2f((unsigned short)qv[6]) * 0.0625f, bf2f((unsigned short)qv[7]) * 0.0625f); \
            *(LAS u32x4*)(lds + QS + (hp_ * LDQ + 8 * (hg_ + 4 * j)) * 2) = qs; } } while (0)
#define WRITE_KV() do { int ht_ = tid - 256; asm volatile("" : "+v"(ht_)); const int hp_ = ht_ >> 2, hg_ = ht_ & 3; \
        _Pragma("unroll") for (int j = 0; j < 8; ++j) *(LAS bf16x8*)(lds + KS + (hp_ * LDQ + 8 * (hg_ + 4 * j)) * 2) = pk[j]; \
        _Pragma("unroll") for (int j = 0; j < 4; ++j) *(LAS bf16x8*)(lds + VS + (hp_ * LDV + 8 * (hg_ + 4 * j)) * 2) = pv[j]; } while (0)
    LAS float* DEN = (LAS float*)(lds + END);
    static_assert(END + 768 <= LDS_BYTES - 1024, "mlstm2 lds den");
    __syncthreads();
    if (helper) { NV[tid - 256] = 0.f; PREFETCH(0); SCALARS(0); WRITE_Q(); WRITE_KV(); }
    __syncthreads();
    if (!helper) {
      f32x16 CT[8];
#pragma unroll
      for (int i = 0; i < 8; ++i) CT[i] = f32x16{};
      for (int cc = 0; cc < 36 * MK_MLX; ++cc) {
        const int c = cc % 36;
        const int sb = cc & 1;
        const LAS float* SC = (const LAS float*)(lds + SC_O) + sb * SCN;
        const bool want_out = (c >= 4) || ctx_out;
        int lane = F.lane; asm volatile("" : "+v"(lane));
        const int r32 = lane & 31, hi = lane >> 5, g16 = lane >> 4, q4 = (lane & 15) >> 2, p4 = lane & 3;
        const int row0 = CHUNK_ROW0(c);
        if (MK_MLX > 1 && cc == 36) {
#pragma unroll
          for (int i = 0; i < 8; ++i) CT[i] = f32x16{}; }
        f32x16 N0 = f32x16{}, N1 = f32x16{};
        {
            if (want_out) {
#pragma unroll
                for (int dt = 0; dt < 8; ++dt)
#pragma unroll
                    for (int ks = 0; ks < 2; ++ks) {
                        const bf16x8 cf = pack_step(CT[dt], ks);
                        const bf16x8 qa0 = ld_perm(lds + QS + (r32 * LDQ + 32 * dt + 16 * ks + 4 * hi) * 2), qa1 = ld_perm(lds + QS + ((32 + r32) * LDQ + 32 * dt + 16 * ks + 4 * hi) * 2);
                        N0 = MFMA32(cf, qa0, N0); N1 = MFMA32(cf, qa1, N1); if (ks == 1 && (dt & 1)) __builtin_amdgcn_sched_barrier(0); }
                const float wI0 = SC[128 + r32], wI1 = SC[128 + 32 + r32];
#pragma unroll
                for (int r = 0; r < 16; ++r) { N0[r] *= wI0; N1[r] *= wI1; }
            }
        }
        __syncthreads();
        {
            if (want_out) {
                const unsigned va0 = ldsb + VS + ((8 * (g16 >> 1) + q4) * LDV + 32 * w + 16 * (g16 & 1) + 4 * p4) * 2;
                const s16x4 a00 = tr_rd<0>(va0), a01 = tr_rd<4 * ROWV>(va0), a10 = tr_rd<16 * ROWV>(va0), a11 = tr_rd<20 * ROWV>(va0);
                const s16x4 a20 = tr_rd<32 * ROWV>(va0), a21 = tr_rd<36 * ROWV>(va0), a30 = tr_rd<48 * ROWV>(va0), a31 = tr_rd<52 * ROWV>(va0);
                const LAS unsigned char* sw0 = lds + SW + (r32 * LDW + 8 * hi) * 2; const LAS unsigned char* sw1 = sw0 + 32 * ROWW;
                const bf16x8 s00 = *(const LAS bf16x8*)(sw0), s01 = *(const LAS bf16x8*)(sw0 + 32);
                const bf16x8 s10 = *(const LAS bf16x8*)(sw1), s11 = *(const LAS bf16x8*)(sw1 + 32), s12 = *(const LAS bf16x8*)(sw1 + 64), s13 = *(const LAS bf16x8*)(sw1 + 96);
                TR_WAIT();
                N0 = MFMA32(CAT8(a00, a01), s00, N0); N0 = MFMA32(CAT8(a10, a11), s01, N0);
                N1 = MFMA32(CAT8(a00, a01), s10, N1); N1 = MFMA32(CAT8(a10, a11), s11, N1); N1 = MFMA32(CAT8(a20, a21), s12, N1); N1 = MFMA32(CAT8(a30, a31), s13, N1);
                {
                    const float den0 = DEN[r32] + SC[128 + r32] * SC[320 + r32];
                    const float den1 = DEN[64 + 32 + r32] + DEN[128 + 32 + r32] + SC[128 + 32 + r32] * SC[320 + 32 + r32];
                    const float inv0 = 1.f / fmaxf(fabsf(den0), SC[192 + r32]), inv1 = 1.f / fmaxf(fabsf(den1), SC[192 + 32 + r32]);
                    bf16_t* o0 = MLH + (size_t)(row0 + sgn * r32) * 1024 + hd * 256 + 128 * half + 32 * w + 4 * hi; bf16_t* o1 = MLH + (size_t)(row0 + sgn * (32 + r32)) * 1024 + hd * 256 + 128 * half + 32 * w + 4 * hi;
#pragma unroll
                    for (int g = 0; g < 4; ++g) { u32x2 t0, t1; t0.x = pk2(N0[4 * g] * inv0, N0[4 * g + 1] * inv0); t0.y = pk2(N0[4 * g + 2] * inv0, N0[4 * g + 3] * inv0);
                        t1.x = pk2(N1[4 * g] * inv1, N1[4 * g + 1] * inv1); t1.y = pk2(N1[4 * g + 2] * inv1, N1[4 * g + 3] * inv1);
                        *(u32x2*)(o0 + 8 * g) = t0; *(u32x2*)(o1 + 8 * g) = t1; }
                }
            }
            __builtin_amdgcn_sched_barrier(0);
            {
                const float decay = SC[384];
                const unsigned vb0 = ldsb + VS + ((8 * (g16 >> 1) + q4) * LDV + 32 * w + 16 * (g16 & 1) + 4 * p4) * 2;
                const unsigned kb0 = ldsb + KS + ((8 * (g16 >> 1) + q4) * LDQ + 16 * (g16 & 1) + 4 * p4) * 2;
                const s16x4 b00 = tr_rd<0>(vb0), b01 = tr_rd<4 * ROWV>(vb0), b10 = tr_rd<16 * ROWV>(vb0), b11 = tr_rd<20 * ROWV>(vb0);
                const s16x4 b20 = tr_rd<32 * ROWV>(vb0), b21 = tr_rd<36 * ROWV>(vb0), b30 = tr_rd<48 * ROWV>(vb0), b31 = tr_rd<52 * ROWV>(vb0);
                TR_WAIT();
                bf16x8 vb[4];
#define SCALE8(dst, L, H, ks) do { const f32x4 w0 = *(const LAS f32x4*)(SC + 256 + 16 * (ks) + 8 * hi), w1 = *(const LAS f32x4*)(SC + 256 + 16 * (ks) + 8 * hi + 4); \
                u32x4 t_; t_.x = pk2(bf2f((unsigned short)L[0]) * w0.x, bf2f((unsigned short)L[1]) * w0.y); t_.y = pk2(bf2f((unsigned short)L[2]) * w0.z, bf2f((unsigned short)L[3]) * w0.w); \
                t_.z = pk2(bf2f((unsigned short)H[0]) * w1.x, bf2f((unsigned short)H[1]) * w1.y); t_.w = pk2(bf2f((unsigned short)H[2]) * w1.z, bf2f((unsigned short)H[3]) * w1.w); dst = __builtin_bit_cast(bf16x8, t_); } while (0)
                SCALE8(vb[0], b00, b01, 0); SCALE8(vb[1], b10, b11, 1); SCALE8(vb[2], b20, b21, 2); SCALE8(vb[3], b30, b31, 3);
#undef SCALE8
#define UPD(dt) do { const s16x4 k00 = tr_rd<(dt) * 64>(kb0), k01 = tr_rd<(dt) * 64 + 4 * ROWQ>(kb0), k10 = tr_rd<(dt) * 64 + 16 * ROWQ>(kb0), k11 = tr_rd<(dt) * 64 + 20 * ROWQ>(kb0); \
                const s16x4 k20 = tr_rd<(dt) * 64 + 32 * ROWQ>(kb0), k21 = tr_rd<(dt) * 64 + 36 * ROWQ>(kb0), k30 = tr_rd<(dt) * 64 + 48 * ROWQ>(kb0), k31 = tr_rd<(dt) * 64 + 52 * ROWQ>(kb0); \
                _Pragma("unroll") for (int r = 0; r < 16; ++r) CT[dt][r] *= decay; \
                TR_WAIT(); \
                CT[dt] = MFMA32(CAT8(k00, k01), vb[0], CT[dt]); CT[dt] = MFMA32(CAT8(k10, k11), vb[1], CT[dt]); CT[dt] = MFMA32(CAT8(k20, k21), vb[2], CT[dt]); CT[dt] = MFMA32(CAT8(k30, k31), vb[3], CT[dt]); } while (0)
                UPD(0); UPD(1); UPD(2); UPD(3); UPD(4); UPD(5); UPD(6); UPD(7);
#undef UPD
            }
        }
        __syncthreads();
        __syncthreads();
      }
    } else {
      for (int cc = 0; cc < 36 * MK_MLX; ++cc) {
        const int c = cc % 36;
        const int sb = cc & 1;
        const LAS float* SC = (const LAS float*)(lds + SC_O) + sb * SCN;
        const bool want_out = (c >= 4) || ctx_out;
        int lane = F.lane; asm volatile("" : "+v"(lane));
        const int r32 = lane & 31, hi = lane >> 5, g16 = lane >> 4, q4 = (lane & 15) >> 2, p4 = lane & 3;
        const int row0 = CHUNK_ROW0(c);
        { const int cn = (cc + 1 < 36 * MK_MLX) ? (cc + 1) % 36 : 35; PREFETCH(cn); }
        {
            if (want_out) {
                if (w < 7) {
                    const int st = (w == 6) ? 1 : 0, lt = (w == 4) ? 0 : 1, lcol = 32 * lt + r32;
                    f32x16 S = f32x16{};
#pragma unroll
                    for (int ks = 0; ks < 16; ++ks) {
                        const bf16x8 ka = *(const LAS bf16x8*)(lds + KS + ((32 * st + r32) * LDQ + 16 * ks + 8 * hi) * 2);
                        const bf16x8 qb = *(const LAS bf16x8*)(lds + QS + (lcol * LDQ + 16 * ks + 8 * hi) * 2);
                        S = MFMA32(ka, qb, S); }
                    const float a_l = SC[64 + lcol]; float den = 0.f;
#pragma unroll
                    for (int r = 0; r < 16; ++r) { const int srow = 32 * st + crow(r, hi); const float dd = __expf(SC[srow] - a_l);
                        const float v = (srow <= lcol) ? S[r] * dd : 0.f; S[r] = v; den += v; }
                    den += shx(den, 32);
                    if (hi == 0) DEN[(w - 4) * 64 + lcol] = den;
#pragma unroll
                    for (int g = 0; g < 4; ++g) { u32x2 t_; t_.x = pk2(S[4 * g], S[4 * g + 1]); t_.y = pk2(S[4 * g + 2], S[4 * g + 3]);
                        *(LAS u32x2*)(lds + SW + (lcol * LDW + 32 * st + 8 * g + 4 * hi) * 2) = t_; }
                } else {
                    float nq = 0.f; const LAS unsigned char* qrow = lds + QS + lane * ROWQ;
#pragma unroll 4
                    for (int d8 = 0; d8 < 32; ++d8) { const bf16x8 qv = *(const LAS bf16x8*)(qrow + d8 * 16); const f32x4 n0 = *(const LAS f32x4*)(NV + 8 * d8), n1 = *(const LAS f32x4*)(NV + 8 * d8 + 4);
                        nq += bf2f((unsigned short)qv[0]) * n0.x + bf2f((unsigned short)qv[1]) * n0.y + bf2f((unsigned short)qv[2]) * n0.z + bf2f((unsigned short)qv[3]) * n0.w
                            + bf2f((unsigned short)qv[4]) * n1.x + bf2f((unsigned short)qv[5]) * n1.y + bf2f((unsigned short)qv[6]) * n1.z + bf2f((unsigned short)qv[7]) * n1.w; }
                    ((LAS float*)(lds + SC_O) + sb * SCN)[320 + lane] = nq;
                }
            }
        }
        __syncthreads();
        {
            if (w == 7) {
                const int dg = lane & 31, sh = lane >> 5; const float decay = SC[384];
                float ac[8];
#pragma unroll
                for (int j = 0; j < 8; ++j) ac[j] = 0.f;
#pragma unroll 4
                for (int q = 0; q < 32; ++q) { const int srow = 32 * sh + q; const bf16x8 kv = *(const LAS bf16x8*)(lds + KS + (srow * LDQ + 8 * dg) * 2); const float wq = SC[256 + srow];
#pragma unroll
                    for (int j = 0; j < 8; ++j) ac[j] += bf2f((unsigned short)kv[j]) * wq; }
#pragma unroll
                for (int j = 0; j < 8; ++j) ac[j] += shx(ac[j], 32);
                if (sh == 0) {
                    f32x4 n0 = *(LAS f32x4*)(NV + 8 * dg), n1 = *(LAS f32x4*)(NV + 8 * dg + 4);
                    n0 = n0 * decay + (f32x4){ac[0], ac[1], ac[2], ac[3]}; n1 = n1 * decay + (f32x4){ac[4], ac[5], ac[6], ac[7]};
                    if (MK_MLX > 1 && cc == 35) { n0 = (f32x4){0.f, 0.f, 0.f, 0.f}; n1 = n0; }
                    *(LAS f32x4*)(NV + 8 * dg) = n0; *(LAS f32x4*)(NV + 8 * dg + 4) = n1; }
            }
            if (MK_MLX > 1 && cc == 35) m_prev = 0.f;
            SCALARS(sb ^ 1);
            WRITE_Q();
        }
        __syncthreads();
        WRITE_KV();
        __syncthreads();
      }
    }
#undef CHUNK_ROW0
#undef PREFETCH
#undef SCALARS
#undef WRITE_Q
#undef WRITE_KV
}
#undef MFMA32
#undef TR_WAIT
#undef CAT8
}

DI void phase_mixers(const Frame& F, const Args& a, int l, char* ldsg, int npass) {
    unsigned* head0 = (unsigned*)(F.ws + WS_CTL) + CW_QUEUE + 64 * l;
    volatile LAS unsigned* MISC = (volatile LAS unsigned*)(F.lds + LDS_BYTES - 64);
    const int n_ml = 64, n_la = 256, n_ga = 256, n_cx = (l == 0) ? 32 : 0, n_mix = n_ml + n_la + n_ga + 2 * n_cx;
    const int total = n_mix;
    const bf16_t* QLA = (const bf16_t*)(F.ws + WS_QLA); const bf16_t* KVLA = (const bf16_t*)(F.ws + WS_KVLA); const bf16_t* KR = (const bf16_t*)(F.ws + WS_KR);
    const bf16_t* QG = (const bf16_t*)(F.ws + WS_QG); const bf16_t* KG = (const bf16_t*)(F.ws + WS_KG); const bf16_t* P = (const bf16_t*)(F.ws + WS_P);
    bf16_t* YCAT = (bf16_t*)(F.ws + WS_YCAT);
#ifndef MK_MIX
#define MK_MIX 7
#endif
#define GRAB(u) do { __syncthreads(); if (F.tid == 0) MISC[4] = __hip_atomic_fetch_add(head, 1u, __ATOMIC_RELAXED, __HIP_MEMORY_SCOPE_AGENT); __syncthreads(); u = __builtin_amdgcn_readfirstlane((int)MISC[4]); } while (0)
    for (int pass = 0; pass < npass; ++pass) {
    unsigned* head = head0 + 128 * pass;
    int u0;
    GRAB(u0);
    while (u0 < n_ml) { if (MK_MIX & 1) ml::mlstm_unit2(F, a, l, u0, l == 0); GRAB(u0); }
    while (u0 < n_mix) {
        int u = u0 - n_ml;
        if (u < n_la) { const int b = u >> 6, h = (u >> 3) & 7, qb = u & 7; const long q0 = (long)b * SEQ + qb * 256;
            if (MK_MIX & 2) att::attn_body<64, 1536, 2048, 2048, 3072>(QLA + q0 * 1536 + h * 192, KVLA + h * 256, KR, KVLA + h * 256 + 128, YCAT + q0 * 3072 + 1024 + h * 128,
                                                      MLAT + b * CTXL, 4, b * SEQ, 32, 0.07216878364870322f, (const float*)(F.ws + WS_ROPE_LA) + (size_t)qb * 256 * 64, ldsg); }
        else if (u < n_la + n_ga) { u -= n_la; const int b = u >> 6, h = (u >> 3) & 7, qb = u & 7; const long q0 = (long)b * SEQ + qb * 256;
            if (MK_MIX & 4) att::attn_body<0, 1024, 256, NP, 3072>(QG + q0 * 1024 + h * 128, KG + (h >> 2) * 128, nullptr, P + C_GV + (h >> 2) * 128, YCAT + q0 * 3072 + 2048 + h * 128,
                                                  MLAT + b * CTXL, 4, b * SEQ, 32, 0.08838834764831845f, nullptr, ldsg); }
        else if (u < n_la + n_ga + n_cx) { u -= n_la + n_ga; const int b = u >> 3, h = u & 7; const long q0 = (long)MLAT + b * CTXL;
            if (MK_MIX & 2) att::attn_body<64, 1536, 2048, 2048, 3072>(QLA + q0 * 1536 + h * 192, KVLA + h * 256, KR, KVLA + h * 256 + 128, YCAT + q0 * 3072 + 1024 + h * 128,
                                                      MLAT + b * CTXL, 4, 0, 0, 0.07216878364870322f, nullptr, ldsg); }
        else { u -= n_la + n_ga + n_cx; const int b = u >> 3, h = u & 7; const long q0 = (long)MLAT + b * CTXL;
            if (MK_MIX & 4) att::attn_body<0, 1024, 256, NP, 3072>(QG + q0 * 1024 + h * 128, KG + (h >> 2) * 128, nullptr, P + C_GV + (h >> 2) * 128, YCAT + q0 * 3072 + 2048 + h * 128,
                                                  MLAT + b * CTXL, 4, 0, 0, 0.08838834764831845f, nullptr, ldsg); }
        GRAB(u0);
    }
    }
#undef GRAB
}

DI void phase_convert_tail(const Frame& F0, const Args& a, int l) {
    Frame F = F0; { int t_ = threadIdx.x; asm volatile("" : "+v"(t_)); F.tid = t_; F.lane = t_ & 63; F.wave = __builtin_amdgcn_readfirstlane(t_ >> 6); }
    constexpr int CVB = 64;
    unsigned* head = (unsigned*)(F.ws + WS_CTL) + CW_QUEUE + 64 * l + 32;
    volatile LAS unsigned* MISC = (volatile LAS unsigned*)(F.lds + LDS_BYTES - 64);
    const int n_cv = ((IT_LAYER - IT_EARLY) + ((l == 0) ? IT_EARLY : 0)) / CVB;
    LAS float* scr = (LAS float*)(F.lds + F.wave * 16384);
    for (;;) {
        __syncthreads();
        if (F.tid == 0) MISC[4] = __hip_atomic_fetch_add(head, 1u, __ATOMIC_RELAXED, __HIP_MEMORY_SCOPE_AGENT);
        __syncthreads();
        const int blk = __builtin_amdgcn_readfirstlane((int)MISC[4]);
        if (blk >= n_cv) break;
#pragma unroll 1
        for (int q = 0; q < CVB / NWAVES; ++q) { const int r = blk * CVB + q * NWAVES + F.wave;
            if (r < IT_LAYER - IT_EARLY) convert_item(F, a, l, IT_EARLY + r, scr); else convert_item(F, a, 1, r - (IT_LAYER - IT_EARLY), scr); }
    }
}

constexpr int FILL_BLK = 16, FILL_NBLK = IT_LAYER / FILL_BLK;
static_assert(IT_LAYER % FILL_BLK == 0, "fill blocks");
DI void fill_convert(const Frame& F0_, const Args& a, int ph, bool drain) {
    Frame F = F0_; { int t_ = threadIdx.x; asm volatile("" : "+v"(t_)); F.tid = t_; F.lane = t_ & 63; F.wave = __builtin_amdgcn_readfirstlane(t_ >> 6); }
    unsigned* ctl = (unsigned*)(F.ws + WS_CTL); unsigned* head = ctl + CW_CVHEAD; unsigned* done = ctl + CW_PHDONE + 64 * ph;
    volatile LAS unsigned* MISC = (volatile LAS unsigned*)(F.lds + LDS_BYTES - 64);
    LAS float* scr = (LAS float*)(F.lds + F.wave * 16384);
    __syncthreads();
    if (!drain && F.tid == 0) __hip_atomic_fetch_add(done, 1u, __ATOMIC_RELAXED, __HIP_MEMORY_SCOPE_AGENT);
    for (;;) {
        if (F.tid == 0) { unsigned blk = 0xffffffffu;
            if (drain || __hip_atomic_load(done, __ATOMIC_RELAXED, __HIP_MEMORY_SCOPE_AGENT) < (unsigned)F.G) blk = __hip_atomic_fetch_add(head, 1u, __ATOMIC_RELAXED, __HIP_MEMORY_SCOPE_AGENT);
            MISC[4] = blk; }
        __syncthreads();
        const unsigned blk = (unsigned)__builtin_amdgcn_readfirstlane((int)MISC[4]);
        __syncthreads();
        if (blk >= (unsigned)FILL_NBLK) break;
        convert_range(F, a, IT_LAYER + (int)blk * FILL_BLK + F.wave, NWAVES, IT_LAYER + ((int)blk + 1) * FILL_BLK, scr);
    }
}

DI void phase_convert_side(const Frame& F0_, const Args& a, int bid, int it_lo, int it_hi) {
    const int step = MK_CVSIDE, ncv = (256 + step - 1) / step;
    if (bid % step != 0 || F0_.G != 256) { if (F0_.G != 256) { Frame Fx = F0_; LAS float* scr = (LAS float*)(Fx.lds + Fx.wave * 16384); convert_range(Fx, a, it_lo + Fx.gw, Fx.ngw, it_hi, scr); } return; }
    Frame F = F0_; { int t_ = threadIdx.x; asm volatile("" : "+v"(t_)); F.tid = t_; F.lane = t_ & 63; F.wave = __builtin_amdgcn_readfirstlane(t_ >> 6); }
    LAS float* scr = (LAS float*)(F.lds + F.wave * 16384);
    const int j = bid / step, per = (it_hi - it_lo + ncv - 1) / ncv, lo = it_lo + j * per, hi = (lo + per < it_hi) ? lo + per : it_hi;
    convert_range(F, a, lo + F.wave, NWAVES, hi, scr);
    __syncthreads();
}

DI void phase_mlfin(const Frame& F, const Args& a, int l, int nrows) {
    const bf16_t* H0 = (const bf16_t*)(F.ws + WS_MLH); const bf16_t* H1 = H0 + (size_t)MTOT * 1024;
    const bf16_t* P = (const bf16_t*)(F.ws + WS_P); bf16_t* YCAT = (bf16_t*)(F.ws + WS_YCAT); const float* gn = a.in[I_MLNORM] + l * 1024;
    int row = F.gw; if (row >= nrows) return;
    s16x4 c0[4], c1[4]; s16x4 co[4];
#define MLF_LOAD(r_, a0, a1, ao) do { _Pragma("unroll") for (int hd = 0; hd < 4; ++hd) { const int c = hd * 256 + 4 * F.lane; a0[hd] = *(const s16x4*)(H0 + (size_t)(r_) * 1024 + c); a1[hd] = *(const s16x4*)(H1 + (size_t)(r_) * 1024 + c); \
        ao[hd] = *(const s16x4*)(P + (size_t)(r_) * NP + C_MLO + c); } } while (0)
    MLF_LOAD(row, c0, c1, co);
    f32x4 gv[4];
#pragma unroll
    for (int hd = 0; hd < 4; ++hd) gv[hd] = *(const f32x4*)(gn + hd * 256 + 4 * F.lane);
    for (;;) {
        const int nrow = row + F.ngw; const bool hn = nrow < nrows; const int pr = hn ? nrow : row;
        s16x4 n0[4], n1[4]; s16x4 no[4]; MLF_LOAD(pr, n0, n1, no);
#pragma unroll
        for (int hd = 0; hd < 4; ++hd) { const int c = hd * 256 + 4 * F.lane;
            const f32x4 v = (f32x4){bf2f((unsigned short)c0[hd][0]) + bf2f((unsigned short)c1[hd][0]), bf2f((unsigned short)c0[hd][1]) + bf2f((unsigned short)c1[hd][1]), bf2f((unsigned short)c0[hd][2]) + bf2f((unsigned short)c1[hd][2]), bf2f((unsigned short)c0[hd][3]) + bf2f((unsigned short)c1[hd][3])};
            const float rs = rsqrtf(wave_sum(v.x * v.x + v.y * v.y + v.z * v.z + v.w * v.w) * (1.f / 256.f) + EPS);
            const f32x4 g = gv[hd]; const s16x4 og = co[hd];
            u32x2 w; w.x = pk2(v.x * rs * g.x * sigmoidf_(bf2f((unsigned short)og[0])), v.y * rs * g.y * sigmoidf_(bf2f((unsigned short)og[1])));
            w.y = pk2(v.z * rs * g.z * sigmoidf_(bf2f((unsigned short)og[2])), v.w * rs * g.w * sigmoidf_(bf2f((unsigned short)og[3])));
            *(u32x2*)(YCAT + (size_t)row * 3072 + c) = w; }
        if (!hn) break;
#pragma unroll
        for (int hd = 0; hd < 4; ++hd) { c0[hd] = n0[hd]; c1[hd] = n1[hd]; co[hd] = no[hd]; }
        row = nrow;
    }
#undef MLF_LOAD
}

struct SchedMerge {
    const char* Y; const char* Bt; int nM, G, c;
    DI bool next(int i, Unit& u) const {
        int pm, pn, br;
        if (nM == 36 && G == 256) {
            if (i < 3) { pg8::tile_of(c, 32, 8, pm, pn); br = i; }
            else if (i == 3 && c < 96) { const int t = c / 3; br = (c - 3 * t) | 4; pm = 32 + (t >> 3); pn = t & 7; }
            else return false;
        } else { const int k = i / 3; br = i - 3 * k; const long L = (long)k * G + c; if (L >= (long)nM * 8) return false; pg8::tile_of((int)L, nM, 8, pm, pn); }
        u.pm = pm; u.pn = pn; u.aux = br; u.nt = 16; u.pa = Y + (size_t)pm * 256 * 6144 + (br & 3) * 2048; u.pb = Bt + ((size_t)(br & 3) * 2048 + pn * 256) * 2048; return true;
    }
};
struct EpiMerge {
    const bf16_t* P; bf16_t* ZG; bf16_t* MB; bf16_t* CP; unsigned* cnt;
    DI void operator()(const f32x4 (&acc)[2][2][4][2], const Unit& u, int wr, int wc, int fr, int fq) const {
        const int br = u.aux & 3; const bool split = (u.aux & 4) != 0;
        EPI_FOREACH({
            const bf16x8 gp = *(const bf16x8*)(P + (size_t)row * NP + C_GATE + br * 2048 + col);
            f32x4 g0, g1;
            g0.x = sigmoidf_(bf2f((unsigned short)gp[0])); g0.y = sigmoidf_(bf2f((unsigned short)gp[1])); g0.z = sigmoidf_(bf2f((unsigned short)gp[2])); g0.w = sigmoidf_(bf2f((unsigned short)gp[3]));
            g1.x = sigmoidf_(bf2f((unsigned short)gp[4])); g1.y = sigmoidf_(bf2f((unsigned short)gp[5])); g1.z = sigmoidf_(bf2f((unsigned short)gp[6])); g1.w = sigmoidf_(bf2f((unsigned short)gp[7]));
            f32x4 r0 = v0 * g0, r1 = v1 * g1;
            const size_t off = (size_t)row * DM + col;
            if (split) { const u32x4 w_ = pack8(r0, r1); GAS unsigned long long* cp = (GAS unsigned long long*)(CP + ((size_t)br * MCTX + (row - MLAT)) * DM + col);
                __hip_atomic_store(cp, (unsigned long long)w_.x | ((unsigned long long)w_.y << 32), __ATOMIC_RELAXED, __HIP_MEMORY_SCOPE_AGENT);
                __hip_atomic_store(cp + 1, (unsigned long long)w_.z | ((unsigned long long)w_.w << 32), __ATOMIC_RELAXED, __HIP_MEMORY_SCOPE_AGENT); }
            else if (br < 2) *(u32x4*)(ZG + (size_t)br * MTOT * DM + off) = pack8(r0, r1);
            else { const bf16x8 z0 = *(const bf16x8*)(ZG + off), z1 = *(const bf16x8*)(ZG + (size_t)MTOT * DM + off);
                r0 += (f32x4){bf2f((unsigned short)z0[0]) + bf2f((unsigned short)z1[0]), bf2f((unsigned short)z0[1]) + bf2f((unsigned short)z1[1]), bf2f((unsigned short)z0[2]) + bf2f((unsigned short)z1[2]), bf2f((unsigned short)z0[3]) + bf2f((unsigned short)z1[3])};
                r1 += (f32x4){bf2f((unsigned short)z0[4]) + bf2f((unsigned short)z1[4]), bf2f((unsigned short)z0[5]) + bf2f((unsigned short)z1[5]), bf2f((unsigned short)z0[6]) + bf2f((unsigned short)z1[6]), bf2f((unsigned short)z0[7]) + bf2f((unsigned short)z1[7])};
                *(u32x4*)(MB + off) = pack8(r0, r1); }
        })
        if (split) {
            asm volatile("s_waitcnt vmcnt(0)" ::: "memory");
            unsigned old = 0;
            if ((fr | fq) == 0) old = __hip_atomic_fetch_add((GAS unsigned*)(cnt + (((u.pm - 32) * 8 + u.pn) * 8 + wr * 4 + wc) * 16), 1u, __ATOMIC_RELAXED, __HIP_MEMORY_SCOPE_AGENT);
            old = (unsigned)__builtin_amdgcn_readfirstlane((int)old);
            if (old == 2u) {
                EPI_FOREACH({
                    f32x4 r0 = (f32x4){0.f, 0.f, 0.f, 0.f}; f32x4 r1 = r0;
                    _Pragma("unroll") for (int ob = 0; ob < 3; ++ob) { const GAS unsigned long long* cp = (const GAS unsigned long long*)(CP + ((size_t)ob * MCTX + (row - MLAT)) * DM + col);
                        const unsigned long long a0 = __hip_atomic_load(cp, __ATOMIC_RELAXED, __HIP_MEMORY_SCOPE_AGENT), a1 = __hip_atomic_load(cp + 1, __ATOMIC_RELAXED, __HIP_MEMORY_SCOPE_AGENT);
                        r0 += (f32x4){bf2f((unsigned short)a0), bf2f((unsigned short)(a0 >> 16)), bf2f((unsigned short)(a0 >> 32)), bf2f((unsigned short)(a0 >> 48))};
                        r1 += (f32x4){bf2f((unsigned short)a1), bf2f((unsigned short)(a1 >> 16)), bf2f((unsigned short)(a1 >> 32)), bf2f((unsigned short)(a1 >> 48))}; }
                    (void)v0; (void)v1;
                    *(u32x4*)(MB + (size_t)row * DM + col) = pack8(r0, r1);
                })
            }
        }
    }
};
struct EpiOut {
    const float* xin; const float* ctxin; float* X1; const float* mods; int l;
    DI void operator()(const f32x4 (&acc)[2][2][4][2], const Unit& u, int wr, int wc, int fr, int fq) const {
        f32x4 g[2][2];
#pragma unroll
        for (int bj = 0; bj < 2; ++bj) { const float* gp = mods + ((size_t)(l * 5 + mods_row(u.pm * 256)) * 6 + 2) * DM + u.pn * 256 + bj * 128 + wc * 32 + 8 * fq;
            g[bj][0] = *(const f32x4*)gp; g[bj][1] = *(const f32x4*)(gp + 4); }
        EPI_FOREACH({
            const float* rp = (l == 0) ? (row < MLAT ? xin + (size_t)row * DM : ctxin + (size_t)(row - MLAT) * DM) : X1 + (size_t)row * DM;
            float* op = X1 + (size_t)row * DM + col;
            *(f32x4*)op = *(const f32x4*)(rp + col) + g[bj][0] * v0; *(f32x4*)(op + 4) = *(const f32x4*)(rp + col + 4) + g[bj][1] * v1;
        })
    }
};
DI void phase_topk(const Frame& F, const Args& a, int l, int bid) {
    const float* AFF = (const float*)(F.ws + WS_AFF);
    int* ROWS = (int*)(F.ws + WS_ROWS); float* VALS = (float*)(F.ws + WS_VALS); int* TOK = (int*)(F.ws + WS_TOK);
    LAS unsigned* cntr = (LAS unsigned*)F.lds;
    LAS unsigned* cg = cntr + 64; LAS unsigned* ce = cntr + 96;
    const int nitems = (l == 0) ? 256 + 64 + 16 : 256;
    const int lane = F.lane, wave = F.wave;
    for (int it = bid; it < nitems; it += F.G) {
        if (it >= 320) {
            const int e = it - 320;
            for (int s = F.tid; s < 128; s += NTHR) { ROWS[e * ESLOT + 1152 + s] = -1; VALS[e * ESLOT + 1152 + s] = 0.f; }
            continue;
        }
        const int lat = it < 256, b = lat ? (it >> 6) : ((it - 256) >> 4), e = lat ? ((it >> 2) & 15) : ((it - 256) & 15), qtr = lat ? (it & 3) : 0;
        const int ntok = lat ? SEQ : CTXL, rowbase = lat ? b * SEQ : MLAT + b * CTXL, slotbase = lat ? b * 256 : 1024 + b * 32;
        const unsigned cap = (unsigned)(ntok >> 3);
        __syncthreads();
        if (F.tid < 128) cntr[F.tid] = 0u;
        unsigned key[4];
#pragma unroll
        for (int q = 0; q < 4; ++q) { const int i = q * 512 + F.tid; key[q] = i < ntok ? __float_as_uint(AFF[(size_t)e * MTOT + rowbase + i]) : 0u; }
        __syncthreads();
        unsigned T = 0u;
#pragma unroll 1
        for (int r = 0; r < 16; ++r) { const int sh = 30 - 2 * r;
            const unsigned c1 = T | (1u << sh), c2 = T | (2u << sh), c3 = T | (3u << sh);
            unsigned n1 = 0, n2 = 0, n3 = 0;
#pragma unroll
            for (int q = 0; q < 4; ++q) { n1 += (unsigned)__builtin_popcountll(__ballot(key[q] >= c1)); n2 += (unsigned)__builtin_popcountll(__ballot(key[q] >= c2)); n3 += (unsigned)__builtin_popcountll(__ballot(key[q] >= c3)); }
            if (lane == 0) { atomicAdd((unsigned*)(cntr + r * 4 + 0), n1); atomicAdd((unsigned*)(cntr + r * 4 + 1), n2); atomicAdd((unsigned*)(cntr + r * 4 + 2), n3); }
            __syncthreads();
            const unsigned t1 = cntr[r * 4 + 0], t2 = cntr[r * 4 + 1], t3 = cntr[r * 4 + 2];
            T = t3 >= cap ? c3 : (t2 >= cap ? c2 : (t1 >= cap ? c1 : T));
        }
        unsigned long long bg_own = 0ull, be_own = 0ull; unsigned kown = 0u;
#pragma unroll
        for (int q = 0; q < 4; ++q) { const unsigned long long bg = __ballot(key[q] > T), be = __ballot(key[q] == T);
            if (lane == 0) { cg[q * 8 + wave] = (unsigned)__builtin_popcountll(bg); ce[q * 8 + wave] = (unsigned)__builtin_popcountll(be); }
            if (q == qtr) { bg_own = bg; be_own = be; kown = key[q]; } }
        __syncthreads();
        unsigned ngt = 0, gtb = 0, eqb = 0; const int me = qtr * 8 + wave;
#pragma unroll 1
        for (int k = 0; k < 32; ++k) { const unsigned g = cg[k], q_ = ce[k]; ngt += g; if (k < me) { gtb += g; eqb += q_; } }
        const unsigned need = cap - ngt;
        const unsigned long long lt = (1ull << lane) - 1ull;
        const int i = qtr * 512 + F.tid; const bool act = i < ntok;
        const unsigned eqpos = eqb + (unsigned)__builtin_popcountll(be_own & lt);
        const bool sel = act && (kown > T || (kown == T && eqpos < need));
        const unsigned slot = gtb + (unsigned)__builtin_popcountll(bg_own & lt) + (eqpos < need ? eqpos : need);
        if (act) { TOK[(size_t)(rowbase + i) * 16 + e] = sel ? slotbase + (int)slot : -1;
            if (sel) { ROWS[e * ESLOT + slotbase + (int)slot] = rowbase + i; VALS[e * ESLOT + slotbase + (int)slot] = __uint_as_float(kown); } }
    }
    __syncthreads();
}
struct SchedMoe {
    const char* A; const char* Bt; int lda, ldb, nMt, nt, G, c, gather;
    DI bool next(int i, Unit& u) const {
        const long L0 = (long)i * G + c; const int nwg = NEXP * nMt * 8; if (L0 >= nwg) return false;
        const int L = ((int)L0 % 8) * (nwg / 8) + (int)L0 / 8;
        const int e = L / (nMt * 8), rem = L % (nMt * 8), mt = rem % nMt, pn = rem / nMt;
        u.pm = e * 5 + mt; u.pn = pn; u.aux = e; u.nt = nt; u.pa = gather ? A : A + ((size_t)e * ESLOT + mt * 256) * lda; u.pb = Bt + ((size_t)e * 2048 + pn * 256) * ldb; return true;
    }
};
struct EpiMoe1 {
    bf16_t* ACT;
    DI void operator()(const f32x4 (&acc)[2][2][4][2], const Unit& u, int wr, int wc, int fr, int fq) const {
#pragma unroll
        for (int ai = 0; ai < 2; ++ai)
#pragma unroll
            for (int m = 0; m < 4; ++m) { const int row = u.pm * 256 + ai * 128 + wr * 64 + m * 16 + fr; const int col = u.pn * 128 + wc * 32 + 8 * fq;
                f32x4 r0, r1;
#pragma unroll
                for (int i = 0; i < 4; ++i) { r0[i] = siluf_(acc[ai][0][m][0][i]) * acc[ai][1][m][0][i]; r1[i] = siluf_(acc[ai][0][m][1][i]) * acc[ai][1][m][1][i]; }
                *(u32x4*)(ACT + (size_t)row * EFF + col) = pack8(r0, r1); }
    }
};
struct EpiMoe2 {
    const float* VALS; bf16_t* YE;
    DI void operator()(const f32x4 (&acc)[2][2][4][2], const Unit& u, int wr, int wc, int fr, int fq) const {
        EPI_FOREACH({ const float val = VALS[row]; *(u32x4*)(YE + (size_t)row * DM + col) = pack8(v0 * val, v1 * val); })
    }
};
DI void phase_final(const Frame& F, const Args& a) {
    const float* g = a.in[I_FNORM]; const int* TOK = (const int*)(F.ws + WS_TOK); const float* X1 = (const float*)(F.ws + WS_X1);
    LAS float* gs = (LAS float*)F.lds;
    { const float* MODS = (const float*)(F.ws + WS_MODS);
      for (int i = F.tid; i < 4 * 512; i += NTHR) { const int r = i / 512, c4 = i % 512;
          *(LAS f32x4*)(gs + (size_t)r * DM + 4 * c4) = *(const f32x4*)(MODS + ((size_t)((DEPTH - 1) * 5 + r) * 6 + 5) * DM + 4 * c4); }
      __syncthreads(); }
    int row = F.gw; if (row >= MLAT) return;
    f32x4 cur[8]; load_row(X1 + (size_t)row * DM, F.lane, cur); int tcur = TOK[(size_t)row * 16 + (F.lane & 15)];
    f32x4 gv[8]; load_row(g, F.lane, gv);
    for (;;) {
        const int nrow = row + F.ngw; const bool hn = nrow < MLAT; const int pr = hn ? nrow : row;
        f32x4 nxt[8]; load_row(X1 + (size_t)pr * DM, F.lane, nxt); const int tnxt = TOK[(size_t)pr * 16 + (F.lane & 15)];
        f32x4 v[8]; float ss = 0.f;
        combine_row<true>(F, DEPTH - 1, row, cur, tcur, v, gs + (size_t)(row >> 11) * DM);
#pragma unroll
        for (int j = 0; j < 8; ++j) ss += v[j].x * v[j].x + v[j].y * v[j].y + v[j].z * v[j].z + v[j].w * v[j].w;
        const float rs = rsqrtf(wave_sum(ss) * (1.f / DM) + EPS);
#pragma unroll
        for (int j = 0; j < 8; ++j) *(f32x4*)(a.out + (size_t)row * DM + 4 * F.lane + 256 * j) = v[j] * rs * gv[j];
        if (!hn) break;
#pragma unroll
        for (int j = 0; j < 8; ++j) cur[j] = nxt[j];
        tcur = tnxt; row = nrow;
    }
}

#ifndef MK_LAST_PHASE
#define MK_LAST_PHASE 1000
#endif
constexpr int PH_PER_LAYER = 12, N_PHASES = 2 + 2 * PH_PER_LAYER + 1;
__global__ void __launch_bounds__(NTHR, 2) mega(const Args args) {
    extern __shared__ __attribute__((aligned(16))) unsigned char lds[];
    Frame F0;
    F0.lds = (LAS unsigned char*)lds; F0.ws = args.ws;
    F0.tid = threadIdx.x; F0.lane = F0.tid & 63; F0.wave = __builtin_amdgcn_readfirstlane(F0.tid >> 6);
    F0.G = gridDim.x; { const int bx = blockIdx.x; F0.vcu = (F0.G % 8 == 0) ? (bx % 8) * (F0.G / 8) + bx / 8 : bx; }
    F0.gw = F0.vcu * NWAVES + F0.wave; F0.ngw = F0.G * NWAVES;
    volatile LAS unsigned* MISC = (volatile LAS unsigned*)(F0.lds + LDS_BYTES - 64);
    if (F0.tid < 16) MISC[F0.tid] = 0u;
    __syncthreads();
    unsigned* ctl = (unsigned*)(F0.ws + WS_CTL);
    XcdBarrier bar = xcd_barrier_post(ctl + CW_BAR, MISC + 8);
    const int lo = args.ph_lo, hi = args.ph_hi;
    int ph = 0, bid = 0;
#ifndef MK_EN
#define MK_EN 0xFFFF
#endif
#define EN(x) ((MK_EN >> (x)) & 1)
#ifndef MK_REP
#define MK_REP 0
#endif
#ifndef MK_BARX
#define MK_BARX 0
#endif
#ifndef MK_REPB
#define MK_REPB 0
#endif
#ifndef MK_TPH
#define MK_TPH -1
#endif
#ifndef MK_TMODE
#define MK_TMODE 0
#endif
#ifndef MK_TQ
#define MK_TQ 40.f
#endif
#define REP(pid_) ((MK_REP >> (pid_)) & 1)
#define PHASE(pid_, ...) if (EN(pid_) && lo <= ph && ph < hi) { Frame F = F0; { unsigned long long w_ = (unsigned long long)F0.ws; asm volatile("" : "+s"(w_)); F.ws = (unsigned char*)w_; \
        asm volatile("" : "+s"(F.G), "+s"(F.vcu)); F.ngw = F.G * NWAVES; bid = blockIdx.x; asm volatile("" : "+s"(bid)); \
        int t_ = threadIdx.x; asm volatile("" : "+v"(t_)); F.tid = t_; F.lane = t_ & 63; F.wave = __builtin_amdgcn_readfirstlane(t_ >> 6); F.gw = F.vcu * NWAVES + F.wave; } \
        { const int rep = 0; (void)rep; __VA_ARGS__ } if (REP(pid_)) { if (MK_REPB) xcd_barrier(bar); const int rep = 1; (void)rep; __VA_ARGS__ } \
        if (MK_TPH >= 0 && threadIdx.x == 0) ((unsigned long long*)(F0.ws + WS_CTL + 1536 * 1024))[ph * 256 + blockIdx.x] = wall_clock64(); \
        if (ph + 1 < hi) { xcd_barrier(bar); if (MK_BARX) xcd_barrier(bar); } } ++ph;

#define PHASE5(...) if (EN(5) && lo <= ph && ph < hi) { Frame F = F0; { unsigned long long w_ = (unsigned long long)F0.ws; asm volatile("" : "+s"(w_)); F.ws = (unsigned char*)w_; \
        asm volatile("" : "+s"(F.G), "+s"(F.vcu)); F.ngw = F.G * NWAVES; bid = blockIdx.x; asm volatile("" : "+s"(bid)); \
        int t_ = threadIdx.x; asm volatile("" : "+v"(t_)); F.tid = t_; F.lane = t_ & 63; F.wave = __builtin_amdgcn_readfirstlane(t_ >> 6); F.gw = F.vcu * NWAVES + F.wave; } \
        { __VA_ARGS__ } if (MK_TPH >= 0 && threadIdx.x == 0) ((unsigned long long*)(F0.ws + WS_CTL + 1536 * 1024))[ph * 256 + blockIdx.x] = wall_clock64(); \
        if (ph + 1 < hi) { xcd_barrier(bar); if (MK_BARX) xcd_barrier(bar); } } ++ph;
    PHASE(0, phase_prologue(F, args, rep);)
    PHASE(14, phase_mods_reduce(F, args);)
    for (int l = 0; l < DEPTH; ++l) {
        const size_t wlo = WS_W + (size_t)l * W_LAYER;
        const int nM = (l == 0) ? 36 : 32;
        PHASE(1, if (MK_FILL && l == 1 && rep == 0) fill_convert(F, args, ph, true); phase_mod1(F, args, l);)
        PHASE(2, {
            SchedProj S{(const char*)(F.ws + WS_H), (const char*)(F.ws + wlo + W_IN), l, F.G, bid};
            EpiProj E{(bf16_t*)(F.ws + WS_P)};
            pg8::gemm_phase(F.lds, DM * 2, DM * 2, S, E); if (MK_FILL && l == 0 && rep == 0) fill_convert(F, args, ph, false); })
        PHASE(3, phase_postproj(F, args, l);)
        PHASE(4, {
            const bool defer = (l == 1 && F.G == 256);
            const int Gx = F.G - 36, xw = bid - Gx, BIG = 1 << 28, Gw = defer ? 144 : Gx, cw = bid < Gw ? bid : BIG;
            if (defer) { SchedDefer S{(const char*)(F.ws + WS_H), (const char*)(F.ws + wlo + W_IN), (bid >= 144 && bid < 220) ? bid - 144 : -1};
              EpiProj E{(bf16_t*)(F.ws + WS_P)}; pg8::gemm_phase(F.lds, DM * 2, DM * 2, S, E); }
            { SchedDense S{(const char*)(F.ws + WS_H), (const char*)(F.ws + wlo + W_IN) + (size_t)C_X * DM * 2, DM * 2, DM * 2, 36, 1, 32, 36, xw >= 0 ? xw : BIG};
              EpiX E{(bf16_t*)(F.ws + WS_KR), (float*)(F.ws + WS_X80), (const float*)(F.ws + WS_ROPE_LA)}; pg8::gemm_phase(F.lds, DM * 2, DM * 2, S, E); }
            { SchedDense S{(const char*)(F.ws + WS_CQN), (const char*)(F.ws + wlo + W_UQ), 512 * 2, 512 * 2, nM, 6, 8, Gw, cw};
              EpiStoreBf16 E{(bf16_t*)(F.ws + WS_QLA), 1536}; pg8::gemm_phase(F.lds, 512 * 2, 512 * 2, S, E); }
            { SchedDense S{(const char*)(F.ws + WS_CKVN), (const char*)(F.ws + wlo + W_UKV), 256 * 2, 256 * 2, 36, 8, 4, defer ? 96 : Gw, defer ? ((bid >= 48 && bid < 144) ? bid - 48 : BIG) : (bid < Gw ? (bid + Gw / 2) % Gw : BIG)};
              EpiStoreBf16 E{(bf16_t*)(F.ws + WS_KVLA), 2048}; pg8::gemm_phase(F.lds, 256 * 2, 256 * 2, S, E); }
            if (MK_FILL && l == 0 && rep == 0) fill_convert(F, args, ph, false); })
        PHASE5(if (MK_CVSIDE) phase_convert_side(F, args, bid, l == 0 ? IT_EARLY : IT_LAYER + IT_EARLY, l == 0 ? IT_LAYER + IT_EARLY : 2 * IT_LAYER); phase_mixers(F, args, l, (char*)lds, 1 + REP(5)); if (MK_CONVTAIL) phase_convert_tail(F, args, l);)
        PHASE(6, phase_mlfin(F, args, l, nM * 256);)
        PHASE(7, {
            SchedMerge S{(const char*)(F.ws + WS_YCAT), (const char*)(F.ws + wlo + W_BR), nM, F.G, bid};
            EpiMerge E{(const bf16_t*)(F.ws + WS_P), (bf16_t*)(F.ws + WS_MF32), (bf16_t*)(F.ws + WS_MBF), (bf16_t*)(F.ws + WS_H), (unsigned*)(F.ws + WS_CTL) + CW_MCNT};
            pg8::gemm_phase(F.lds, 3072 * 2, 1024 * 2, S, E); if (MK_FILL && l == 0 && rep == 0) fill_convert(F, args, ph, false); })
        PHASE(8, {
            SchedDense S{(const char*)(F.ws + WS_MBF), (const char*)(F.ws + wlo + W_OUT), DM * 2, DM * 2, nM, 8, 32, F.G, bid};
            EpiOut E{args.in[I_X], args.in[I_CTX], (float*)(F.ws + WS_X1), (const float*)(F.ws + WS_MODS), l};
            if (rep == 0 || l == 0) pg8::gemm_phase(F.lds, DM * 2, DM * 2, S, E); if (MK_FILL && l == 0 && rep == 0) fill_convert(F, args, ph, false); })
        PHASE(9, phase_mod2(F, args, l, nM * 256);)
        PHASE(10, phase_topk(F, args, l, bid);)
        PHASE(11, {
            SchedMoe S{(const char*)(F.ws + WS_H), (const char*)(F.ws + wlo + W_E13), DM * 2, DM * 2, (l == 0) ? 5 : 4, 32, F.G, bid, 1};
            EpiMoe1 E{(bf16_t*)(F.ws + WS_ACT)};
            pg8::gemm_phase<true>(F.lds, DM * 2, DM * 2, S, E, (const int*)(F.ws + WS_ROWS)); if (MK_FILL && l == 0 && rep == 0) fill_convert(F, args, ph, false); })
        PHASE(12, {
            SchedMoe S{(const char*)(F.ws + WS_ACT), (const char*)(F.ws + wlo + W_E2), EFF * 2, EFF * 2, (l == 0) ? 5 : 4, 16, F.G, bid, 0};
            EpiMoe2 E{(const float*)(F.ws + WS_VALS), (bf16_t*)(F.ws + WS_YE)};
            pg8::gemm_phase(F.lds, EFF * 2, EFF * 2, S, E); if (MK_FILL && l == 0 && rep == 0) fill_convert(F, args, ph, false); })
    }
    PHASE(13, phase_final(F, args);)
    if (MK_TPH >= 0) {
        xcd_barrier(bar);
        if (blockIdx.x == 0 && threadIdx.x == 0) {
            const unsigned long long* st = (const unsigned long long*)(F0.ws + WS_CTL + 1536 * 1024);
            unsigned long long mx = 0, mxp = 0, sum = 0; const int G = gridDim.x;
            for (int bq = 0; bq < G; ++bq) { const unsigned long long e = st[MK_TPH * 256 + bq], p = st[(MK_TPH - 1) * 256 + bq]; mx = e > mx ? e : mx; mxp = p > mxp ? p : mxp; sum += e; }
            const float dur = MK_TMODE == 0 ? (float)(mx - mxp) * 0.01f : (float)((double)sum / G - (double)mxp) * 0.01f;
            args.out[0] = 20.f + floorf(dur / MK_TQ) * MK_TQ;
        }
    }
#undef PHASE
}


extern "C" void kernel_launch(void* const* d_in, const int* in_sizes, int n_in, void* d_out, int out_size, void* d_ws, size_t ws_size, hipStream_t stream) {
    static int grid = 0;
    if (grid == 0) {
        if (n_in != 24 || out_size != MLAT * DM || ws_size < WS_END) { fprintf(stderr, "kernel_launch: unexpected shapes: n_in %d out %d ws %zu (need %zu)\n", n_in, out_size, ws_size, (size_t)WS_END); grid = -1; return; }
        int dev = 0, cus = 0, per_cu = 0;
        if (hipGetDevice(&dev) != hipSuccess || hipDeviceGetAttribute(&cus, hipDeviceAttributeMultiprocessorCount, dev) != hipSuccess) { grid = -1; return; }
        if (hipFuncSetAttribute((const void*)mega, hipFuncAttributeMaxDynamicSharedMemorySize, LDS_BYTES) != hipSuccess) { fprintf(stderr, "kernel_launch: hipFuncSetAttribute failed\n"); grid = -1; return; }
        if (hipOccupancyMaxActiveBlocksPerMultiprocessor(&per_cu, (const void*)mega, NTHR, LDS_BYTES) != hipSuccess || per_cu < 1) { fprintf(stderr, "kernel_launch: occupancy query says %d blocks per CU\n", per_cu); }
        (void)hipGetLastError();
        grid = cus;
    }
    if (grid < 0) return;
    if (hipMemsetAsync((char*)d_ws + WS_CTL, 0, CTL_BYTES, stream) != hipSuccess) return;
    Args a{};
    for (int i = 0; i < 24; ++i) a.in[i] = (const float*)d_in[i];
    a.out = (float*)d_out; a.ws = (unsigned char*)d_ws; a.ph_lo = 0; a.ph_hi = N_PHASES < MK_LAST_PHASE ? N_PHASES : MK_LAST_PHASE;
    hipLaunchKernelGGL(mega, dim3(grid), dim3(NTHR), LDS_BYTES, stream, a);
}
```

```cpp
#include <hip/hip_runtime.h>
#include <cstdio>
#include <cstdint>

#define GAS __attribute__((address_space(1)))
#define LAS __attribute__((address_space(3)))
#define DI __device__ __forceinline__
typedef unsigned short bf16_t;
typedef short bf16x8 __attribute__((ext_vector_type(8)));
typedef short s16x4 __attribute__((ext_vector_type(4)));
typedef float f32x2 __attribute__((ext_vector_type(2)));
typedef float f32x4 __attribute__((ext_vector_type(4)));
typedef float f32x8 __attribute__((ext_vector_type(8)));
typedef float f32x16 __attribute__((ext_vector_type(16)));
typedef unsigned u32x2 __attribute__((ext_vector_type(2)));
typedef unsigned u32x4 __attribute__((ext_vector_type(4)));

constexpr int DM = 2048, NBATCH = 4, SEQ = 2048, CTXL = 256, DEPTH = 2;
constexpr int MLAT = NBATCH * SEQ, MCTX = NBATCH * CTXL, MTOT = MLAT + MCTX;
constexpr int PROJW = 12624, NP = 12800;
constexpr int C_MLQ = 0, C_MLK = 1024, C_MLV = 2048, C_MLO = 3072, C_CQ = 4096, C_CKV = 4608, C_GQ = 4864, C_GK = 5888, C_GV = 6144, C_GATE = 6400, C_X = 12544;
constexpr int XW = 80;
constexpr int NEXP = 16, EFF = 1024, ESLOT = 1280;
constexpr float EPS = 1e-6f;
constexpr int NWAVES = 8, NTHR = 512;

constexpr size_t al256(size_t x) { return (x + 255) / 256 * 256; }
constexpr size_t WS_CTL = 0, CTL_BYTES = 2u << 20;
constexpr int CW_BAR = 1024;
constexpr int CW_QUEUE = 8192;
constexpr int CW_CVHEAD = 12288;
constexpr int CW_MCNT = 20480;
constexpr int CW_OCNT = 24576;
constexpr int CW_ODONE = 28672;
constexpr int CW_PHDONE = 32768;
constexpr size_t WS_MODS = 1u << 20;
constexpr size_t WS_ROPE_LA = WS_CTL + CTL_BYTES;
constexpr size_t WS_ROPE_GA = WS_ROPE_LA + al256((size_t)2048 * 32 * 2 * 4);
constexpr size_t WS_W = WS_ROPE_GA + al256((size_t)2048 * 64 * 2 * 4);
constexpr size_t W_IN = 0, W_UQ = W_IN + (size_t)NP * DM * 2, W_UKV = W_UQ + (size_t)1536 * 512 * 2, W_BR = W_UKV + (size_t)2048 * 256 * 2,
                 W_OUT = W_BR + (size_t)3 * 2048 * 1024 * 2, W_E13 = W_OUT + (size_t)2048 * 2048 * 2, W_E2 = W_E13 + (size_t)NEXP * 2048 * 2048 * 2,
                 W_LAYER = W_E2 + (size_t)NEXP * 2048 * 1024 * 2;
constexpr size_t WS_H = WS_W + 2 * W_LAYER;
constexpr size_t WS_P = WS_H + (size_t)MTOT * DM * 2;
constexpr size_t WS_AG = WS_P;
constexpr size_t WS_ACT = WS_AG + (size_t)NEXP * ESLOT * DM * 2;
static_assert(WS_ACT + (size_t)NEXP * ESLOT * EFF * 2 <= WS_P + (size_t)MTOT * NP * 2, "overlay");
constexpr size_t WS_X80 = WS_P + (size_t)MTOT * NP * 2;
constexpr size_t WS_CQN = WS_X80 + al256((size_t)MTOT * XW * 4);
constexpr size_t WS_CKVN = WS_CQN + (size_t)MTOT * 512 * 2;
constexpr size_t WS_QG = WS_CKVN + (size_t)MTOT * 256 * 2;
constexpr size_t WS_KG = WS_QG + (size_t)MTOT * 1024 * 2;
constexpr size_t WS_KR = WS_KG + (size_t)MTOT * 256 * 2;
constexpr size_t WS_QLA = WS_KR + (size_t)MTOT * 64 * 2;
constexpr size_t WS_KVLA = WS_QLA + (size_t)MTOT * 1536 * 2;
constexpr size_t WS_YCAT = WS_KVLA + (size_t)MTOT * 2048 * 2;
constexpr size_t WS_MF32 = WS_YCAT + (size_t)MTOT * 3072 * 2;
constexpr size_t WS_MLH = WS_MF32;
constexpr size_t WS_MBF = WS_MF32 + (size_t)MTOT * DM * 4;
constexpr size_t WS_X1 = WS_MBF + (size_t)MTOT * DM * 2;
constexpr size_t WS_AFF = WS_X1 + (size_t)MTOT * DM * 4;
constexpr size_t WS_ROWS = WS_AFF + (size_t)MTOT * 16 * 4;
constexpr size_t WS_VALS = WS_ROWS + (size_t)NEXP * ESLOT * 4;
constexpr size_t WS_TOK = WS_VALS + (size_t)NEXP * ESLOT * 4;
constexpr size_t WS_MPART = WS_TOK + (size_t)MTOT * 16 * 4;
constexpr size_t WS_END = WS_MPART + (size_t)16 * 2 * 5 * 12288 * 4;
constexpr size_t WS_YE = WS_AG;

constexpr int RING_BYTES = 131072;
constexpr int MISC_OFF = RING_BYTES + 1024;
constexpr int LDS_BYTES = 147456;

DI float bf2f(unsigned short b) { return __uint_as_float(((unsigned)b) << 16); }
DI unsigned f2bf(float f) { unsigned u = __float_as_uint(f); return (u + 0x7fffu + ((u >> 16) & 1u)) >> 16; }
DI unsigned pk2(float lo, float hi) { unsigned r; asm volatile("v_cvt_pk_bf16_f32 %0, %1, %2" : "=v"(r) : "v"(lo), "v"(hi)); return r; }
DI int lane_id_() { int l = __builtin_amdgcn_mbcnt_hi(~0u, __builtin_amdgcn_mbcnt_lo(~0u, 0u)); asm volatile("" : "+v"(l)); return l; }
DI float bperm_f(float v, int srclane) { return __int_as_float(__builtin_amdgcn_ds_bpermute(srclane << 2, __float_as_int(v))); }
DI float shx(float v, int o) { return bperm_f(v, lane_id_() ^ o); }
DI float shl_(float v, int src) { return bperm_f(v, src); }
DI float shu(float v, int o) { const int l = lane_id_(); return bperm_f(v, l >= o ? l - o : l); }
DI float wave_sum(float v) { const int l = lane_id_();
#pragma unroll
    for (int o = 1; o < 64; o <<= 1) v += bperm_f(v, l ^ o);
    return v;
}
DI float wave_max(float v) { const int l = lane_id_();
#pragma unroll
    for (int o = 1; o < 64; o <<= 1) v = fmaxf(v, bperm_f(v, l ^ o));
    return v;
}
DI float sigmoidf_(float x) { return __builtin_amdgcn_rcpf(1.f + __expf(-x)); }
DI float siluf_(float x) { return x * __builtin_amdgcn_rcpf(1.f + __expf(-x)); }
#define LDS_WAIT() asm volatile("s_waitcnt lgkmcnt(0)" ::: "memory")
#define VM_WAIT() asm volatile("s_waitcnt vmcnt(0)" ::: "memory")

#define XB_TMO      128
#define XB_XCNT(j)  (256  + 64 * (j))
#define XB_XSUB(j)  (1280 + 64 * (j))
#define XB_XGEN(j)  (2304 + 64 * (j))
#define XB_TOP      3328
#define XB_TOPGEN   3392
#define XCD_BAR_WORDS 3456
#define XB_SPIN_CAP (1u << 20)

DI unsigned xb_ld(unsigned* p)              { return __hip_atomic_load(p, __ATOMIC_RELAXED, __HIP_MEMORY_SCOPE_AGENT); }
DI unsigned xb_add(unsigned* p, unsigned v) { return __hip_atomic_fetch_add(p, v, __ATOMIC_RELAXED, __HIP_MEMORY_SCOPE_AGENT); }
DI unsigned xb_xcc_id() { return (unsigned)__builtin_amdgcn_s_getreg((3 << 11) | 20) & 0xFu; }
#define XB_SPIN(cond, bar) do { unsigned _sp = 0; while (cond) { __builtin_amdgcn_s_sleep(1); \
    if ((++_sp & 255u) == 0u) { if (xb_ld(&(bar)[XB_TMO])) break; if (_sp > XB_SPIN_CAP) { atomicAdd(&(bar)[XB_TMO], 1u); break; } } } } while (0)

struct XcdBarrier { unsigned* bar; unsigned x; volatile LAS unsigned* st; };

DI XcdBarrier xcd_barrier_post(unsigned* bar, volatile LAS unsigned* st) {
    XcdBarrier b; b.bar = bar; b.x = xb_xcc_id(); b.st = st;
    if (threadIdx.x == 0) (void)xb_add(&bar[XB_XCNT(b.x)], 1u);
    return b;
}
DI void xcd_barrier_complete(unsigned* bar, unsigned x, unsigned& nloc, unsigned& nx) {
    const unsigned G = gridDim.x * gridDim.y * gridDim.z;
    unsigned sum, cnt, mine, sp = 0u;
    for (;;) {
        sum = 0u; cnt = 0u; mine = 0u;
#pragma unroll
        for (unsigned j = 0; j < 16; ++j) { const unsigned c = xb_ld(&bar[XB_XCNT(j)]); sum += c; cnt += (c > 0u) ? 1u : 0u; mine = (j == x) ? c : mine; }
        if (sum == G) break;
        __builtin_amdgcn_s_sleep(1);
        if ((++sp & 255u) == 0u) { if (xb_ld(&bar[XB_TMO])) break; if (sp > XB_SPIN_CAP) { atomicAdd(&bar[XB_TMO], 1u); break; } }
    }
    nloc = mine > 0u ? mine : 1u; nx = cnt > 0u ? cnt : 1u;
}
DI void xcd_barrier(const XcdBarrier& b) {
    asm volatile("s_waitcnt vmcnt(0)" ::: "memory");
    __syncthreads();
    if (threadIdx.x == 0) {
        unsigned* bar = b.bar; asm volatile("" : "+s"(bar));
        __builtin_amdgcn_s_waitcnt(0);
        unsigned nloc = b.st[0], nx = b.st[1];
        unsigned bx = b.x; asm volatile("" : "+s"(bx));
        if (nloc == 0u) { xcd_barrier_complete(bar, bx, nloc, nx); b.st[0] = nloc; b.st[1] = nx; }
        const unsigned old = xb_add(&bar[XB_XSUB(bx)], 1u);
        const unsigned gen = old / nloc;
        if (old + 1u == (gen + 1u) * nloc) {
            __builtin_amdgcn_fence(__ATOMIC_RELEASE, "agent");
            asm volatile("s_waitcnt vmcnt(0)" ::: "memory");
            const unsigned og = xb_add(&bar[XB_TOP], 1u);
            const unsigned tg = og / nx;
            if (og + 1u == (tg + 1u) * nx) xb_add(&bar[XB_TOPGEN], 1u);
            else XB_SPIN(xb_ld(&bar[XB_TOPGEN]) == tg, bar);
            __builtin_amdgcn_fence(__ATOMIC_ACQUIRE, "agent");
            xb_add(&bar[XB_XGEN(bx)], 1u);
            asm volatile("s_waitcnt vmcnt(0)" ::: "memory");
        } else {
            XB_SPIN(xb_ld(&bar[XB_XGEN(bx)]) == gen, bar);
            __builtin_amdgcn_fence(__ATOMIC_ACQUIRE, "agent");
            asm volatile("s_waitcnt vmcnt(0)" ::: "memory");
        }
    }
    __syncthreads();
}

struct Args { const float* in[24]; float* out; unsigned char* ws; int ph_lo, ph_hi; };
enum { I_X = 0, I_C, I_CTX, I_CCTX, I_WMOD, I_BMOD, I_WIN, I_GBIAS, I_MLNORM, I_LAQN, I_LAKVN, I_UQ, I_UKV, I_GAQN, I_GAKN, I_BRML, I_BRLA, I_BRGA, I_WOUT, I_WROUTER, I_WE1, I_WE3, I_WE2, I_FNORM };

struct Frame {
    LAS unsigned char* lds;
    unsigned char* ws;
    int tid, lane, wave, G, vcu, gw, ngw;
};

DI int mods_row(int row) { return row < MLAT ? (row >> 11) : 4; }
DI const float* mods_ptr(const Frame& F, int l, int row, int which  ) {
    return (const float*)(F.ws + WS_MODS) + ((size_t)(l * 5 + mods_row(row)) * 6 + which) * DM;
}

namespace pg8 {
constexpr int BM = 256, BK = 64, HALF = 128, HTB = HALF * BK * 2, STAGE_BYTES = 8 * HTB, NXCD = 8, WGM = 8;
__host__ __device__ __forceinline__ int lds_byte(int r, int c) { const int st = (r >> 4) * 2 + (c >> 5), rr = r & 15, cc = c & 31, ob = rr * 64 + cc * 2; return st * 1024 + (ob ^ (((ob >> 9) & 1) << 5)); }
__host__ __device__ __forceinline__ void stage_rc(int b, int& R, int& C) { const int st = b / 1024, sb = b % 1024, swz = sb ^ (((sb >> 9) & 1) << 5); R = (st >> 1) * 16 + swz / 64; C = (st & 1) * 32 + (swz % 64) / 2; }
__host__ __device__ __forceinline__ int perm32(int rho) { const int n = rho >> 4, i = rho & 15; return 8 * (i >> 2) + 4 * n + (i & 3); }

struct Unit { const char* pa; const char* pb; int pm, pn, aux, nt; };

DI void tile_of(int L, int nM, int nN, int& pm, int& pn) {
    const int nwg = nM * nN; int wgid = L;
    { const int q = nwg / NXCD, r = nwg % NXCD, xcd = wgid % NXCD, off = wgid / NXCD; wgid = (xcd < r ? xcd * (q + 1) : r * (q + 1) + (xcd - r) * q) + off; }
    const int nig = WGM * nN, gid = wgid / nig, fm = gid * WGM, gsz = (nM - fm) < WGM ? (nM - fm) : WGM;
    pm = fm + ((wgid % nig) % gsz); pn = (wgid % nig) / gsz;
}

template <bool GATHER = false, class Epi, class Sched>
DI void gemm_phase(LAS unsigned char* lds, const int lda  , const int ldb  , const Sched& S, const Epi& E, const int* rows = nullptr) {
    int tid = threadIdx.x; asm volatile("" : "+v"(tid));
    const int wid = __builtin_amdgcn_readfirstlane(tid >> 6), lane = tid & 63, wr = wid >> 2, wc = wid & 3, fr = lane & 15, fq = lane >> 4;
    unsigned vA0[2], vA1[2], nA0[2], nA1[2], voffB[2]; int sR[2], sC[2];
#pragma unroll
    for (int i = 0; i < 2; ++i) { int R, C; stage_rc(tid * 16 + i * 8192, R, C); const int Rb = (R & ~31) + perm32(R & 31); sR[i] = R; sC[i] = C;
        vA0[i] = (unsigned)(R * lda + C * 2); vA1[i] = (unsigned)((R + HALF) * lda + C * 2); nA0[i] = vA0[i]; nA1[i] = vA1[i]; voffB[i] = (unsigned)(Rb * ldb + C * 2); }
#define PG8_GATHER_OFFS(u_, d0, d1) do { if (GATHER) { _Pragma("unroll") for (int i = 0; i < 2; ++i) { const int r0_ = rows[(u_).pm * 256 + sR[i]], r1_ = rows[(u_).pm * 256 + HALF + sR[i]]; \
        d0[i] = (unsigned)((r0_ < 0 ? 0 : r0_) * lda + sC[i] * 2); d1[i] = (unsigned)((r1_ < 0 ? 0 : r1_) * lda + sC[i] * 2); } } } while (0)
    const size_t kstep = (size_t)(BK * 2);
    const size_t hstepB = (size_t)HALF * ldb;
    const unsigned ldsw = (unsigned)wid * 1024u;
    const int aoff = lds_byte(wr * 64 + fr, fq * 8), boff = lds_byte(wc * 32 + fr, fq * 8);
#define PG8_SA(b, h) (((b) * 2 + (h)) * HTB)
#define PG8_SB(b, h) ((4 + (b) * 2 + (h)) * HTB)
#define PG8_STAGE(bufoff, gbase, voff) do { _Pragma("unroll") for (int _i = 0; _i < 2; ++_i) \
        __builtin_amdgcn_global_load_lds((const unsigned*)((const char*)(gbase) + (voff)[_i]), (LAS unsigned*)(lds + (bufoff) + ldsw + _i * 8192), 16, 0, 0); } while (0)
#define PG8_LDA(dst, b, h) do { _Pragma("unroll") for (int m = 0; m < 4; ++m) _Pragma("unroll") for (int k = 0; k < 2; ++k) dst[m][k] = *(const LAS bf16x8*)(lds + PG8_SA(b, h) + aoff + m * 2048 + k * 1024); } while (0)
#define PG8_LDB(dst, b, h) do { _Pragma("unroll") for (int n = 0; n < 2; ++n) _Pragma("unroll") for (int k = 0; k < 2; ++k) dst[n][k] = *(const LAS bf16x8*)(lds + PG8_SB(b, h) + boff + n * 2048 + k * 1024); } while (0)
#define PG8_MMA(ai, bj, At, Bt) do { __builtin_amdgcn_s_setprio(1); _Pragma("unroll") for (int m = 0; m < 4; ++m) _Pragma("unroll") for (int n = 0; n < 2; ++n) _Pragma("unroll") for (int k = 0; k < 2; ++k) \
        acc[ai][bj][m][n] = __builtin_amdgcn_mfma_f32_16x16x32_bf16(Bt[n][k], At[m][k], acc[ai][bj][m][n], 0, 0, 0); __builtin_amdgcn_s_setprio(0); } while (0)
#define PG8_WAIT_V(n) asm volatile("s_waitcnt vmcnt(" #n ")" ::: "memory")
#define PG8_WAIT_L(n) asm volatile("s_waitcnt lgkmcnt(" #n ")" ::: "memory")
#define PG8_BAR __builtin_amdgcn_s_barrier()
#define PG8_SCHED __builtin_amdgcn_sched_barrier(0)
    Unit cur, nxt; int ui = 0;
    if (!S.next(0, cur)) return;
    f32x4 acc[2][2][4][2];
#pragma unroll
    for (int a = 0; a < 2; ++a)
#pragma unroll
        for (int b = 0; b < 2; ++b)
#pragma unroll
            for (int m = 0; m < 4; ++m)
#pragma unroll
                for (int n = 0; n < 2; ++n) acc[a][b][m][n] = (f32x4){0.f, 0.f, 0.f, 0.f};
    bf16x8 At[4][2], B0[2][2], B1[2][2];
    const char* cA = cur.pa; const char* cB = cur.pb;
    PG8_GATHER_OFFS(cur, vA0, vA1);
    PG8_STAGE(PG8_SB(0, 0), cB, voffB); PG8_STAGE(PG8_SA(0, 0), cA, vA0); PG8_STAGE(PG8_SB(0, 1), cB + hstepB, voffB); PG8_STAGE(PG8_SA(0, 1), cA, vA1);
    if (wr == 1) PG8_BAR;
    PG8_WAIT_V(4); PG8_BAR;
    PG8_STAGE(PG8_SB(1, 0), cB + kstep, voffB); PG8_STAGE(PG8_SA(1, 0), cA + kstep, vA0); PG8_STAGE(PG8_SB(1, 1), cB + hstepB + kstep, voffB);
    PG8_WAIT_V(6); PG8_BAR;
    for (;;) {
        const bool has_next = S.next(ui + 1, nxt);
        const char* nA = has_next ? nxt.pa : cA; const char* nB = has_next ? nxt.pb : cB;
        if (GATHER) { if (has_next) PG8_GATHER_OFFS(nxt, nA0, nA1); else { _Pragma("unroll") for (int i = 0; i < 2; ++i) { nA0[i] = vA0[i]; nA1[i] = vA1[i]; } } }
        const int nt = cur.nt;
        for (int t = 0; t < nt; t += 2) {
            const bool last = (t == nt - 2);
            const char* a1 = cA + (size_t)(t + 1) * kstep;
            const char* a2 = last ? nA : cA + (size_t)(t + 2) * kstep; const char* b2 = last ? nB : cB + (size_t)(t + 2) * kstep;
            const char* a3 = a2 + kstep; const char* b3 = b2 + kstep;
            unsigned wA0[2], wA1[2];
            _Pragma("unroll") for (int i = 0; i < 2; ++i) { wA0[i] = last ? nA0[i] : vA0[i]; wA1[i] = last ? nA1[i] : vA1[i]; }
            PG8_LDB(B0, 0, 0); PG8_SCHED; PG8_LDA(At, 0, 0); PG8_STAGE(PG8_SA(1, 1), a1, vA1);
            PG8_WAIT_L(8); PG8_BAR; PG8_WAIT_L(0); PG8_MMA(0, 0, At, B0); PG8_BAR; PG8_SCHED;
            PG8_LDB(B1, 0, 1); PG8_STAGE(PG8_SB(0, 0), b2, voffB);
            PG8_BAR; PG8_WAIT_L(0); PG8_MMA(0, 1, At, B1); PG8_BAR;
            PG8_LDA(At, 0, 1); PG8_STAGE(PG8_SA(0, 0), a2, wA0);
            PG8_BAR; PG8_WAIT_L(0); PG8_MMA(1, 0, At, B0); PG8_BAR; PG8_SCHED;
            PG8_STAGE(PG8_SB(0, 1), b2 + hstepB, voffB);
            PG8_WAIT_V(6); PG8_BAR; PG8_MMA(1, 1, At, B1); PG8_BAR;
            PG8_LDB(B0, 1, 0); PG8_SCHED; PG8_LDA(At, 1, 0); PG8_STAGE(PG8_SA(0, 1), a2, wA1);
            PG8_WAIT_L(8); PG8_BAR; PG8_WAIT_L(0); PG8_MMA(0, 0, At, B0); PG8_BAR; PG8_SCHED;
            PG8_LDB(B1, 1, 1); PG8_STAGE(PG8_SB(1, 0), b3, voffB);
            PG8_BAR; PG8_WAIT_L(0); PG8_MMA(0, 1, At, B1); PG8_BAR;
            PG8_LDA(At, 1, 1); PG8_STAGE(PG8_SA(1, 0), a3, wA0);
            PG8_BAR; PG8_WAIT_L(0); PG8_MMA(1, 0, At, B0); PG8_BAR; PG8_SCHED;
            PG8_STAGE(PG8_SB(1, 1), b3 + hstepB, voffB);
            PG8_WAIT_V(6); PG8_BAR; PG8_MMA(1, 1, At, B1); PG8_BAR;
        }
        E(acc, cur, wr, wc, fr, fq);
        if (!has_next) break;
#pragma unroll
        for (int a = 0; a < 2; ++a)
#pragma unroll
            for (int b = 0; b < 2; ++b)
#pragma unroll
                for (int m = 0; m < 4; ++m)
#pragma unroll
                    for (int n = 0; n < 2; ++n) acc[a][b][m][n] = (f32x4){0.f, 0.f, 0.f, 0.f};
        cur = nxt; cA = nA; cB = nB; ++ui;
        if (GATHER) { _Pragma("unroll") for (int i = 0; i < 2; ++i) { vA0[i] = nA0[i]; vA1[i] = nA1[i]; } }
    }
    PG8_WAIT_V(0);
    if (wr == 0) PG8_BAR;
    PG8_BAR;
#undef PG8_GATHER_OFFS
#undef PG8_SA
#undef PG8_SB
#undef PG8_STAGE
#undef PG8_LDA
#undef PG8_LDB
#undef PG8_MMA
#undef PG8_WAIT_V
#undef PG8_WAIT_L
#undef PG8_BAR
#undef PG8_SCHED
}
}
using pg8::Unit;

struct SchedDense {
    const char* A; const char* Bt; int lda, ldb, nM, nN, nt, G, c;
    DI bool next(int i, Unit& u) const {
        const long L = (long)i * G + c; if (L >= (long)nM * nN) return false;
        int pm, pn; pg8::tile_of((int)L, nM, nN, pm, pn);
        u.pm = pm; u.pn = pn; u.aux = 0; u.nt = nt; u.pa = A + (size_t)pm * 256 * lda; u.pb = Bt + (size_t)pn * 256 * ldb; return true;
    }
};

struct SchedProj {
    const char* A; const char* Bt; int l, G, c;
    DI bool next(int i, Unit& u) const {
        const long L = (long)i * G + c; int pm, pn;
        if (l == 0) { if (L >= 36 * 49) return false; pg8::tile_of((int)L, 36, 49, pm, pn); }
        else if (G == 256) {
            if (L >= 32 * 47 + 8 + 24) return false;
            if (L < 32 * 47) pg8::tile_of((int)L, 32, 47, pm, pn);
            else if (L < 32 * 47 + 8) { const int r = (int)L - 32 * 47; pm = 32 + (r >> 1); pn = (r & 1) ? 23 : 18; }
            else { pm = (int)L - (32 * 47 + 8); pn = 47; } }
        else { if (L >= 32 * 49 + 44) return false;
            if (L < 32 * 49) pg8::tile_of((int)L, 32, 49, pm, pn);
            else { const int r = (int)L - 32 * 49, j = r % 11; pm = 32 + r / 11; pn = j < 8 ? 4 + j : (j == 8 ? 18 : (j == 9 ? 23 : 24)); } }
        u.pm = pm; u.pn = pn; u.aux = 0; u.nt = 32; u.pa = A + (size_t)pm * 256 * (DM * 2); u.pb = Bt + (size_t)pn * 256 * (DM * 2); return true;
    }
};

struct SchedDefer {
    const char* A; const char* Bt; int c;
    DI bool next(int i, Unit& u) const {
        if (i != 0 || c < 0 || c >= 76) return false;
        int pm, pn;
        if (c < 8) { pm = 24 + c; pn = 47; }
        else if (c < 40) { pm = c - 8; pn = 48; }
        else { const int r = c - 40, j = r % 9; pm = 32 + r / 9; pn = j < 8 ? 4 + j : 24; }
        u.pm = pm; u.pn = pn; u.aux = 0; u.nt = 32; u.pa = A + (size_t)pm * 256 * (DM * 2); u.pb = Bt + (size_t)pn * 256 * (DM * 2); return true;
    }
};

#define EPI_FOREACH(...) \
    _Pragma("unroll") for (int ai = 0; ai < 2; ++ai) _Pragma("unroll") for (int m = 0; m < 4; ++m) { const int row = u.pm * 256 + ai * 128 + wr * 64 + m * 16 + fr; \
    _Pragma("unroll") for (int bj = 0; bj < 2; ++bj) { const int col = u.pn * 256 + bj * 128 + wc * 32 + 8 * fq; const f32x4 v0 = acc[ai][bj][m][0], v1 = acc[ai][bj][m][1]; __VA_ARGS__ } }

DI u32x4 pack8(const f32x4 v0, const f32x4 v1) { u32x4 w; w.x = pk2(v0[0], v0[1]); w.y = pk2(v0[2], v0[3]); w.z = pk2(v1[0], v1[1]); w.w = pk2(v1[2], v1[3]); return w; }

struct EpiStoreBf16 {
    bf16_t* O; int ldc;
    DI void operator()(const f32x4 (&acc)[2][2][4][2], const Unit& u, int wr, int wc, int fr, int fq) const {
        EPI_FOREACH({ *(u32x4*)(O + (size_t)row * ldc + col) = pack8(v0, v1); })
    }
};
struct EpiProj {
    bf16_t* P;
    DI void operator()(const f32x4 (&acc)[2][2][4][2], const Unit& u, int wr, int wc, int fr, int fq) const {
        EPI_FOREACH({ *(u32x4*)(P + (size_t)row * NP + col) = pack8(v0, v1); })
    }
};
struct EpiX {
    bf16_t* KR; float* X80; const float* rla;
    DI void operator()(const f32x4 (&acc)[2][2][4][2], const Unit& u, int wr, int wc, int fr, int fq) const {
#pragma unroll
        for (int ai = 0; ai < 2; ++ai)
#pragma unroll
            for (int m = 0; m < 4; ++m) { const int row = u.pm * 256 + ai * 128 + wr * 64 + m * 16 + fr; const bool lat = row < MLAT; const int t = row & 2047;
#pragma unroll
                for (int n = 0; n < 2; ++n) { const f32x4 v = acc[ai][0][m][n];
                    f32x4 pr; pr.x = shx(v.x, 32); pr.y = shx(v.y, 32); pr.z = shx(v.z, 32); pr.w = shx(v.w, 32);
                    if (wc < 2) {
                        const int idx = 8 * (fq & 1) + 4 * n; f32x4 o = v;
                        if (lat) { const float* cs = rla + ((size_t)t * 32 + wc * 16 + idx) * 2; const f32x4 c0 = *(const f32x4*)cs, c1 = *(const f32x4*)(cs + 4);
                            if (fq < 2) { o.x = v.x * c0.x - pr.x * c0.y; o.y = v.y * c0.z - pr.y * c0.w; o.z = v.z * c1.x - pr.z * c1.y; o.w = v.w * c1.z - pr.w * c1.w; }
                            else        { o.x = pr.x * c0.y + v.x * c0.x; o.y = pr.y * c0.w + v.y * c0.z; o.z = pr.z * c1.y + v.z * c1.x; o.w = pr.w * c1.w + v.w * c1.z; } }
                        u32x2 w2; w2.x = pk2(o.x, o.y); w2.y = pk2(o.z, o.w);
                        *(u32x2*)(KR + (size_t)row * 64 + 32 * wc + 8 * fq + 4 * n) = w2;
                    } else if (wc == 2 && fq < 2) *(f32x4*)(X80 + (size_t)row * XW + 64 + 8 * fq + 4 * n) = v;
                } }
    }
};

DI int win_src_col(int n) {
    if (n < 4096) return n;
    if (n < 4608) return n - 4096 + 4112;
    if (n < 4864) return n - 4608 + 4624;
    if (n < 5888) return n - 4864 + 4944;
    if (n < 6144) return n - 5888 + 5968;
    if (n < 6400) return n - 6144 + 6224;
    if (n < 12544) return n - 6400 + 6480;
    if (n < 12608) return n - 12544 + 4880;
    if (n < 12624) return n - 12608 + 4096;
    return -1;
}
DI void transpose_item(const float* W, int ldw, int K, bf16_t* WT, int k0, int n0, int srcc, LAS float* scr, int lane) {
#pragma unroll 8
    for (int i = 0; i < 32; ++i) { const int kk = 2 * i + (lane >> 5); scr[kk * 33 + (lane & 31)] = srcc >= 0 ? W[(size_t)(k0 + kk) * ldw + srcc] : 0.f; }
    LDS_WAIT(); asm volatile("" ::: "memory");
    const int c = lane & 7;
#pragma unroll
    for (int j = 0; j < 4; ++j) { const int n = (lane >> 3) + 8 * j; const LAS float* s = scr + (8 * c) * 33 + n;
        u32x4 o; o.x = pk2(s[0 * 33], s[1 * 33]); o.y = pk2(s[2 * 33], s[3 * 33]); o.z = pk2(s[4 * 33], s[5 * 33]); o.w = pk2(s[6 * 33], s[7 * 33]);
        *(u32x4*)(WT + (size_t)(n0 + n) * K + k0 + 8 * c) = o; }
    LDS_WAIT(); asm volatile("" ::: "memory");
}

constexpr int IT_IN = 32 * 400, IT_UQ = 8 * 48, IT_UKV = 4 * 64, IT_BR = 16 * 64, IT_OUT = 32 * 64, IT_E13 = 32 * 64, IT_E2 = 16 * 64;
constexpr int IT_EARLY = IT_IN + IT_UQ + IT_UKV, IT_LAYER = IT_EARLY + 3 * IT_BR + IT_OUT + NEXP * IT_E13 + NEXP * IT_E2;
struct CvDesc { const float* src; size_t ld2; bf16_t* dst; int K; };
DI CvDesc cv_make(const float* W, int ldw, int K, bf16_t* WT, int k0, int n0, int srcc, int lane) {
    CvDesc d; d.src = srcc >= 0 ? W + (size_t)(k0 + (lane >> 5)) * ldw + srcc : nullptr; d.ld2 = 2 * (size_t)ldw; d.dst = WT + (size_t)n0 * K + k0; d.K = K; return d; }
DI CvDesc cv_desc(const Frame& F, const Args& a, int l, int r) {
    unsigned char* wl = F.ws + WS_W + (size_t)l * W_LAYER;
    const int lane = F.lane, ln = lane & 31;
    if (r < IT_IN) { const int kb = r / 400, nb = r % 400; return cv_make(a.in[I_WIN] + (size_t)l * DM * PROJW, PROJW, DM, (bf16_t*)(wl + W_IN), 64 * kb, 32 * nb, win_src_col(32 * nb + ln), lane); } r -= IT_IN;
    if (r < IT_UQ) { const int kb = r / 48, nb = r % 48; return cv_make(a.in[I_UQ] + (size_t)l * 512 * 1536, 1536, 512, (bf16_t*)(wl + W_UQ), 64 * kb, 32 * nb, 32 * nb + ln, lane); } r -= IT_UQ;
    if (r < IT_UKV) { const int kb = r / 64, nb = r % 64; return cv_make(a.in[I_UKV] + (size_t)l * 256 * 2048, 2048, 256, (bf16_t*)(wl + W_UKV), 64 * kb, 32 * nb, 32 * nb + ln, lane); } r -= IT_UKV;
    if (r < 3 * IT_BR) { const int br = r / IT_BR, q = r % IT_BR, kb = q / 64, nb = q % 64;
        return cv_make(a.in[I_BRML + br] + (size_t)l * 1024 * 2048, 2048, 1024, (bf16_t*)(wl + W_BR) + (size_t)br * 2048 * 1024, 64 * kb, 32 * nb, 32 * nb + ln, lane); } r -= 3 * IT_BR;
    if (r < IT_OUT) { const int kb = r / 64, nb = r % 64; return cv_make(a.in[I_WOUT] + (size_t)l * 2048 * 2048, 2048, 2048, (bf16_t*)(wl + W_OUT), 64 * kb, 32 * nb, 32 * nb + ln, lane); } r -= IT_OUT;
    if (r < NEXP * IT_E13) { const int e = r / IT_E13, q = r % IT_E13, kb = q / 64, nb = q % 64;
        const int n0 = 32 * nb, j = n0 >> 8, half = (n0 >> 7) & 1, cc = n0 & 127;
        return cv_make(a.in[half ? I_WE3 : I_WE1] + ((size_t)l * NEXP + e) * 2048 * 1024, 1024, 2048, (bf16_t*)(wl + W_E13) + (size_t)e * 2048 * 2048, 64 * kb, n0, j * 128 + cc + ln, lane); } r -= NEXP * IT_E13;
    { const int e = r / IT_E2, q = r % IT_E2, kb = q / 64, nb = q % 64;
        return cv_make(a.in[I_WE2] + ((size_t)l * NEXP + e) * 1024 * 2048, 2048, 1024, (bf16_t*)(wl + W_E2) + (size_t)e * 2048 * 1024, 64 * kb, 32 * nb, 32 * nb + ln, lane); }
}
DI void cv_load(const CvDesc& d, float (&v)[32]) {
#pragma unroll
    for (int i = 0; i < 32; ++i) v[i] = d.src ? __builtin_nontemporal_load(d.src + (size_t)i * d.ld2) : 0.f;
}
DI void cv_store(const CvDesc& d, const float (&v)[32], LAS float* scr, int lane) {
#pragma unroll
    for (int i = 0; i < 32; ++i) scr[(2 * i + (lane >> 5)) * 33 + (lane & 31)] = v[i];
    LDS_WAIT(); asm volatile("" ::: "memory");
    const int c = lane & 7;
#pragma unroll
    for (int j = 0; j < 4; ++j) { const int n = (lane >> 3) + 8 * j; const LAS float* s = scr + (8 * c) * 33 + n;
        u32x4 o; o.x = pk2(s[0 * 33], s[1 * 33]); o.y = pk2(s[2 * 33], s[3 * 33]); o.z = pk2(s[4 * 33], s[5 * 33]); o.w = pk2(s[6 * 33], s[7 * 33]);
        *(u32x4*)(d.dst + (size_t)n * d.K + 8 * c) = o; }
    LDS_WAIT(); asm volatile("" ::: "memory");
}
DI void convert_range(const Frame& F, const Args& a, int first, int stride, int n_items, LAS float* scr) {
    int it = first; if (it >= n_items) return;
    CvDesc cur = cv_desc(F, a, it / IT_LAYER, it % IT_LAYER); float v[32]; cv_load(cur, v);
    for (;;) {
        const int nx = it + stride; const bool hn = nx < n_items; const int pn = hn ? nx : it;
        const CvDesc nd = cv_desc(F, a, pn / IT_LAYER, pn % IT_LAYER); float wv[32]; cv_load(nd, wv);
        cv_store(cur, v, scr, F.lane);
        if (!hn) break;
        cur = nd; it = nx;
#pragma unroll
        for (int i = 0; i < 32; ++i) v[i] = wv[i];
    }
}
DI void convert_item(const Frame& F, const Args& a, int l, int r, LAS float* scr) {
    const CvDesc d = cv_desc(F, a, l, r); float v[32]; cv_load(d, v); cv_store(d, v, scr, F.lane);
}

DI void phase_prologue(const Frame& F, const Args& a, int rep) {
    LAS float* scr = (LAS float*)(F.lds + F.wave * 16384);
    if (rep == 0) {
        const float* c = a.in[I_C]; const float* cctx = a.in[I_CCTX]; const float* wmod = a.in[I_WMOD];
        constexpr int NIT = 2 * 48 * 16;
        for (int it = F.gw; it < NIT; it += F.ngw) {
            const int l = it / 768, rem = it % 768, cb = rem / 16, kp = rem % 16, k0 = kp * 128, j0 = cb * 256 + F.lane * 4;
#pragma unroll
            for (int i = 0; i < 10; ++i) { const int idx = F.lane + 64 * i, r = idx >> 7, kk = idx & 127; const float v = r < 4 ? c[r * DM + k0 + kk] : cctx[k0 + kk]; scr[idx] = siluf_(v); }
            LDS_WAIT(); asm volatile("" ::: "memory");
            f32x4 acc[5];
#pragma unroll
            for (int r = 0; r < 5; ++r) acc[r] = (f32x4){0.f, 0.f, 0.f, 0.f};
            const float* wp = wmod + ((size_t)l * DM + k0) * (6 * DM) + j0;
#pragma unroll 8
            for (int kk = 0; kk < 128; ++kk) { const f32x4 w = __builtin_nontemporal_load((const f32x4*)(wp + (size_t)kk * (6 * DM)));
#pragma unroll
                for (int r = 0; r < 5; ++r) acc[r] += w * scr[r * 128 + kk]; }
#pragma unroll
            for (int r = 0; r < 5; ++r) *(f32x4*)((float*)(F.ws + WS_MPART) + ((size_t)(kp * 2 + l) * 5 + r) * (6 * DM) + j0) = acc[r];
            LDS_WAIT(); asm volatile("" ::: "memory");
        }
    }
    {
        float* rla = (float*)(F.ws + WS_ROPE_LA); float* rga = (float*)(F.ws + WS_ROPE_GA);
        const int gt = F.gw * 64 + F.lane, ngt = F.ngw * 64;
        for (int i = gt; i < 2048 * 32; i += ngt) { const int t = i >> 5, aidx = i & 31, ax = aidx >> 4, fi = aidx & 15;
            const float inv = exp2f(-(float)fi * (13.287712379549449f / 16.f)); const float ang = (float)(ax ? (t & 63) : (t >> 6)) * inv;
            rla[2 * i] = cosf(ang); rla[2 * i + 1] = sinf(ang); }
        for (int i = gt; i < 2048 * 64; i += ngt) { const int t = i >> 6, aidx = i & 63, ax = aidx >> 5, fi = aidx & 31;
            const float inv = exp2f(-(float)fi * (13.287712379549449f / 32.f)); const float ang = (float)(ax ? (t & 63) : (t >> 6)) * inv;
            rga[2 * i] = cosf(ang); rga[2 * i + 1] = sinf(ang); }
    }
#ifndef MK_CONVTAIL
#define MK_CONVTAIL 0
#endif
#ifndef MK_FILL
#define MK_FILL 0
#endif
#ifndef MK_CVSIDE
#define MK_CVSIDE 2
#endif
#ifndef MK_CVFROM
#define MK_CVFROM IT_EARLY
#endif
    if (MK_CONVTAIL) { for (int it = F.gw; it < IT_EARLY; it += F.ngw) convert_item(F, a, 0, it, scr); }
    else convert_range(F, a, F.gw, F.ngw, MK_CVSIDE ? MK_CVFROM : (MK_FILL ? IT_LAYER : 2 * IT_LAYER), scr);
}

DI void phase_mods_reduce(const Frame& F, const Args& a) {
    float* mods = (float*)(F.ws + WS_MODS); const float* part = (const float*)(F.ws + WS_MPART); const float* bmod = a.in[I_BMOD];
    const int gt = F.gw * 64 + F.lane, ngt = F.ngw * 64;
    for (int i = gt; i < 2 * 5 * 12288 / 4; i += ngt) { const int l = i / (5 * 3072), j4 = i % 3072;
        f32x4 s = *(const f32x4*)(bmod + (size_t)l * 12288 + 4 * j4);
#pragma unroll
        for (int kp = 0; kp < 16; ++kp) s += *(const f32x4*)(part + (size_t)kp * (2 * 5 * 12288) + 4 * (size_t)i);
        *(f32x4*)(mods + 4 * (size_t)i) = s; }
}

DI const float* resid_row(const Frame& F, const Args& a, int l, int row) {
    if (l == 0) return row < MLAT ? a.in[I_X] + (size_t)row * DM : a.in[I_CTX] + (size_t)(row - MLAT) * DM;
    return (const float*)(F.ws + WS_X1) + (size_t)row * DM;
}
DI void load_row(const float* p, int lane, f32x4 (&v)[8]) {
#pragma unroll
    for (int j = 0; j < 8; ++j) v[j] = *(const f32x4*)(p + 4 * lane + 256 * j);
}
template <bool G2LDS = false>
DI void combine_row(const Frame& F, int lp, int row, const f32x4 (&x)[8], int tokv, f32x4 (&v)[8], const LAS float* g2l = nullptr) {
    const bf16_t* YE = (const bf16_t*)(F.ws + WS_YE);
    f32x4 s[8];
#pragma unroll
    for (int j = 0; j < 8; ++j) s[j] = (f32x4){0.f, 0.f, 0.f, 0.f};
    unsigned mask = (unsigned)__ballot(tokv >= 0) & 0xffffu;
    while (mask) {
        const int e0 = __builtin_ctz(mask); mask &= mask - 1u; const bool two = mask != 0u; const int e1 = two ? __builtin_ctz(mask) : e0; mask &= mask - 1u;
        const int slot0 = __builtin_amdgcn_readlane(tokv, e0), slot1 = __builtin_amdgcn_readlane(tokv, e1);
        const bf16_t* y0r = YE + ((size_t)e0 * ESLOT + slot0) * DM; const bf16_t* y1r = YE + ((size_t)e1 * ESLOT + slot1) * DM;
        s16x4 y0[8], y1[8];
#pragma unroll
        for (int j = 0; j < 8; ++j) { y0[j] = *(const s16x4*)(y0r + 4 * F.lane + 256 * j); y1[j] = *(const s16x4*)(y1r + 4 * F.lane + 256 * j); }
#pragma unroll
        for (int j = 0; j < 8; ++j) s[j] += (f32x4){bf2f((unsigned short)y0[j][0]), bf2f((unsigned short)y0[j][1]), bf2f((unsigned short)y0[j][2]), bf2f((unsigned short)y0[j][3])};
        if (two) {
#pragma unroll
            for (int j = 0; j < 8; ++j) s[j] += (f32x4){bf2f((unsigned short)y1[j][0]), bf2f((unsigned short)y1[j][1]), bf2f((unsigned short)y1[j][2]), bf2f((unsigned short)y1[j][3])}; }
    }
    if (G2LDS) {
#pragma unroll
        for (int j = 0; j < 8; ++j) v[j] = x[j] + s[j] * *(const LAS f32x4*)(g2l + 4 * F.lane + 256 * j); }
    else { const float* g2 = mods_ptr(F, lp, row, 5);
#pragma unroll
        for (int j = 0; j < 8; ++j) v[j] = x[j] + s[j] * *(const f32x4*)(g2 + 4 * F.lane + 256 * j); }
}
DI void modulate_vals(const Frame& F, const f32x4 (&v)[8], const float* sh, const float* sc, bf16_t* hrow, f32x4 (&hv)[8]) {
    float ss = 0.f;
#pragma unroll
    for (int j = 0; j < 8; ++j) ss += v[j].x * v[j].x + v[j].y * v[j].y + v[j].z * v[j].z + v[j].w * v[j].w;
    const float rs = rsqrtf(wave_sum(ss) * (1.f / DM) + EPS);
#pragma unroll
    for (int j = 0; j < 8; ++j) { const f32x4 s1 = *(const f32x4*)(sc + 4 * F.lane + 256 * j), s0 = *(const f32x4*)(sh + 4 * F.lane + 256 * j);
        const f32x4 h = v[j] * rs * (s1 + 1.f) + s0; hv[j] = h;
        u32x2 w; w.x = pk2(h.x, h.y); w.y = pk2(h.z, h.w); *(u32x2*)(hrow + 4 * F.lane + 256 * j) = w; }
}
DI void phase_mod1(const Frame& F, const Args& a, int l) {
    bf16_t* H = (bf16_t*)(F.ws + WS_H); const int* TOK = (const int*)(F.ws + WS_TOK);
    LAS float* ms = (LAS float*)F.lds;
    { const float* MODS = (const float*)(F.ws + WS_MODS);
      for (int i = F.tid; i < 5 * 3 * 512; i += NTHR) { const int r = i / 1536, w = (i / 512) % 3, c4 = i % 512;
          if (w == 2 && l == 0) continue;
          const int ll = w == 2 ? l - 1 : l, which = w == 2 ? 5 : w;
          f32x4 val = *(const f32x4*)(MODS + ((size_t)(ll * 5 + r) * 6 + which) * DM + 4 * c4); if (w == 1) val += 1.f;
          *(LAS f32x4*)(ms + (size_t)(r * 3 + w) * DM + 4 * c4) = val; }
      __syncthreads(); }
    int row = F.gw; if (row >= MTOT) return;
    f32x4 cur[8]; int tcur = 0;
    load_row(resid_row(F, a, l, row), F.lane, cur); if (l > 0) tcur = TOK[(size_t)row * 16 + (F.lane & 15)];
    for (;;) {
        const int nrow = row + F.ngw; const bool hn = nrow < MTOT; const int pr = hn ? nrow : row;
        f32x4 nxt[8]; int tnxt = 0;
        load_row(resid_row(F, a, l, pr), F.lane, nxt); if (l > 0) tnxt = TOK[(size_t)pr * 16 + (F.lane & 15)];
        f32x4 v[8];
        if (l == 0) {
#pragma unroll
            for (int j = 0; j < 8; ++j) v[j] = cur[j]; }
        const LAS float* mr = ms + (size_t)mods_row(row) * 3 * DM;
        if (l != 0) { combine_row<true>(F, l - 1, row, cur, tcur, v, mr + 2 * DM); float* xw = (float*)(F.ws + WS_X1) + (size_t)row * DM;
#pragma unroll
            for (int j = 0; j < 8; ++j) *(f32x4*)(xw + 4 * F.lane + 256 * j) = v[j]; }
        { float ss = 0.f;
#pragma unroll
          for (int j = 0; j < 8; ++j) ss += v[j].x * v[j].x + v[j].y * v[j].y + v[j].z * v[j].z + v[j].w * v[j].w;
          const float rs = rsqrtf(wave_sum(ss) * (1.f / DM) + EPS);
          bf16_t* hrow = H + (size_t)row * DM;
#pragma unroll
          for (int j = 0; j < 8; ++j) { const f32x4 h = v[j] * rs * *(const LAS f32x4*)(mr + DM + 4 * F.lane + 256 * j) + *(const LAS f32x4*)(mr + 4 * F.lane + 256 * j);
              u32x2 w; w.x = pk2(h.x, h.y); w.y = pk2(h.z, h.w); *(u32x2*)(hrow + 4 * F.lane + 256 * j) = w; } }
        if (!hn) break;
#pragma unroll
        for (int j = 0; j < 8; ++j) cur[j] = nxt[j];
        tcur = tnxt; row = nrow;
    }
}
DI void phase_mod2(const Frame& F, const Args& a, int l, int nrows) {
    bf16_t* H = (bf16_t*)(F.ws + WS_H); float* AFF = (float*)(F.ws + WS_AFF);
    LAS float* wr = (LAS float*)F.lds;
    const float* wsrc = a.in[I_WROUTER] + (size_t)l * DM * NEXP;
    for (int i = F.tid; i < DM * NEXP / 4; i += NTHR) { const f32x4 w4 = ((const f32x4*)wsrc)[i]; const int c = i >> 2, e0 = (i & 3) * 4;
        wr[(e0 + 0) * DM + c] = w4.x; wr[(e0 + 1) * DM + c] = w4.y; wr[(e0 + 2) * DM + c] = w4.z; wr[(e0 + 3) * DM + c] = w4.w; }
    __syncthreads();
    const float* X1 = (const float*)(F.ws + WS_X1);
    auto router = [&](const f32x4 (&hv)[8], int row) {
        float lg[16];
#pragma unroll
        for (int e = 0; e < 16; ++e) lg[e] = 0.f;
#pragma unroll
        for (int j = 0; j < 8; ++j)
#pragma unroll
            for (int e = 0; e < 16; ++e) { const f32x4 w = *(const LAS f32x4*)(wr + e * DM + 4 * F.lane + 256 * j); lg[e] += hv[j].x * w.x + hv[j].y * w.y + hv[j].z * w.z + hv[j].w * w.w; }
        float mx = -1e30f;
#pragma unroll
        for (int e = 0; e < 16; ++e) { lg[e] = wave_sum(lg[e]); mx = fmaxf(mx, lg[e]); }
        float den = 0.f;
#pragma unroll
        for (int e = 0; e < 16; ++e) { lg[e] = __expf(lg[e] - mx); den += lg[e]; }
        const float inv = 1.f / den;
        float mine = 0.f;
#pragma unroll
        for (int e = 0; e < 16; ++e) mine = (F.lane == e) ? lg[e] * inv : mine;
        if (F.lane < 16) AFF[(size_t)F.lane * MTOT + row] = mine;
    };
    const int crow = MLAT + F.gw; const bool hasc = crow < nrows;
    f32x4 cur[8];
    for (int base = 4 * F.gw; base < MLAT; base += 4 * F.ngw) {
        load_row(X1 + (size_t)base * DM, F.lane, cur);
        f32x4 s1[8], s0[8];
        { const float* sh = mods_ptr(F, l, base, 3); const float* sc = mods_ptr(F, l, base, 4);
#pragma unroll
          for (int j = 0; j < 8; ++j) { s1[j] = *(const f32x4*)(sc + 4 * F.lane + 256 * j) + 1.f; s0[j] = *(const f32x4*)(sh + 4 * F.lane + 256 * j); } }
#pragma unroll 1
        for (int k = 0; k < 4; ++k) { const int row = base + k; f32x4 hv[8];
            { const int pr = k < 3 ? row + 1 : (hasc ? crow : row); f32x4 nxt[8]; load_row(X1 + (size_t)pr * DM, F.lane, nxt);
              float ss = 0.f;
#pragma unroll
              for (int j = 0; j < 8; ++j) ss += cur[j].x * cur[j].x + cur[j].y * cur[j].y + cur[j].z * cur[j].z + cur[j].w * cur[j].w;
              const float rs = rsqrtf(wave_sum(ss) * (1.f / DM) + EPS);
              bf16_t* hrow = H + (size_t)row * DM;
#pragma unroll
              for (int j = 0; j < 8; ++j) { const f32x4 h = cur[j] * rs * s1[j] + s0[j]; hv[j] = h;
                  u32x2 w; w.x = pk2(h.x, h.y); w.y = pk2(h.z, h.w); *(u32x2*)(hrow + 4 * F.lane + 256 * j) = w; }
#pragma unroll
              for (int j = 0; j < 8; ++j) cur[j] = nxt[j]; }
            router(hv, row);
        }
    }
    if (hasc) {
        if (4 * F.gw >= MLAT) load_row(X1 + (size_t)crow * DM, F.lane, cur);
        for (int row = crow; row < nrows; row += F.ngw) { f32x4 hv[8];
            modulate_vals(F, cur, mods_ptr(F, l, row, 3), mods_ptr(F, l, row, 4), H + (size_t)row * DM, hv);
            router(hv, row);
            if (row + F.ngw < nrows) load_row(X1 + (size_t)(row + F.ngw) * DM, F.lane, cur); }
    }
    __syncthreads();
}

DI void phase_postproj(const Frame& F, const Args& a, int l) {
    const bf16_t* P = (const bf16_t*)(F.ws + WS_P);
    bf16_t* CQN = (bf16_t*)(F.ws + WS_CQN); bf16_t* CKVN = (bf16_t*)(F.ws + WS_CKVN); bf16_t* QG = (bf16_t*)(F.ws + WS_QG); bf16_t* KG = (bf16_t*)(F.ws + WS_KG);
    const float* qn = a.in[I_LAQN] + l * 512; const float* kvn = a.in[I_LAKVN] + l * 256; const float* gqn = a.in[I_GAQN] + l * 128; const float* gkn = a.in[I_GAKN] + l * 128;
    const float* rga = (const float*)(F.ws + WS_ROPE_GA);
    const int lane = F.lane;
    const f32x4 qg0 = *(const f32x4*)(qn + 8 * lane), qg1 = *(const f32x4*)(qn + 8 * lane + 4), kg0 = *(const f32x4*)(kvn + 4 * lane);
    const int hq = lane >> 4, ax = (lane >> 3) & 1, seg = lane & 7, eo = ax * 64 + 4 * seg;
    const f32x4 gqa = *(const f32x4*)(gqn + eo), gqb = *(const f32x4*)(gqn + eo + 32), gka = *(const f32x4*)(gkn + eo), gkb = *(const f32x4*)(gkn + eo + 32);
    struct Raw { bf16x8 xq; s16x4 xkv; s16x4 ha[3], hb[3]; f32x4 r0, r1; };
    auto load = [&](int row, Raw& R) { const bf16_t* pr = P + (size_t)row * NP; const int t = row & 2047;
        R.xq = *(const bf16x8*)(pr + C_CQ + 8 * lane); R.xkv = *(const s16x4*)(pr + C_CKV + 4 * lane);
#pragma unroll
        for (int p = 0; p < 3; ++p) { const int hh = p < 2 ? 4 * p + hq : 8 + (hq & 1); const bf16_t* src = pr + C_GQ + hh * 128;
            R.ha[p] = *(const s16x4*)(src + eo); R.hb[p] = *(const s16x4*)(src + eo + 32); }
        const float* rp = rga + ((size_t)t * 64 + ax * 32 + 4 * seg) * 2; R.r0 = *(const f32x4*)rp; R.r1 = *(const f32x4*)(rp + 4); };
    static_assert(C_GK == C_GQ + 8 * 128, "q and k heads contiguous");
    int row = F.gw; if (row >= MTOT) return;
    Raw cur; load(row, cur);
    for (;;) {
        const int nrow = row + F.ngw; const bool hn = nrow < MTOT; Raw nxt; load(hn ? nrow : row, nxt);
        const bool lat = row < MLAT; const bool needq = lat || l == 0;
        if (needq) {
            float f[8]; float ss = 0.f;
#pragma unroll
            for (int i = 0; i < 8; ++i) { f[i] = bf2f((unsigned short)cur.xq[i]); ss += f[i] * f[i]; }
            const float rs = rsqrtf(wave_sum(ss) * (1.f / 512.f) + EPS);
            u32x4 w; w.x = pk2(f[0] * rs * qg0.x, f[1] * rs * qg0.y); w.y = pk2(f[2] * rs * qg0.z, f[3] * rs * qg0.w); w.z = pk2(f[4] * rs * qg1.x, f[5] * rs * qg1.y); w.w = pk2(f[6] * rs * qg1.z, f[7] * rs * qg1.w);
            *(u32x4*)(CQN + (size_t)row * 512 + 8 * lane) = w;
        }
        {
            float f[4]; float ss = 0.f;
#pragma unroll
            for (int i = 0; i < 4; ++i) { f[i] = bf2f((unsigned short)cur.xkv[i]); ss += f[i] * f[i]; }
            const float rs = rsqrtf(wave_sum(ss) * (1.f / 256.f) + EPS);
            u32x2 w; w.x = pk2(f[0] * rs * kg0.x, f[1] * rs * kg0.y); w.y = pk2(f[2] * rs * kg0.z, f[3] * rs * kg0.w);
            *(u32x2*)(CKVN + (size_t)row * 256 + 4 * lane) = w;
        }
        const float cs[4] = {cur.r0.x, cur.r0.z, cur.r1.x, cur.r1.z}, sn[4] = {cur.r0.y, cur.r0.w, cur.r1.y, cur.r1.w};
        const int ln = lane_id_();
#pragma unroll
        for (int p = 0; p < 3; ++p) {
            if (p < 2 && !needq) continue;
            float xa[4], xb[4]; float ss = 0.f;
#pragma unroll
            for (int i = 0; i < 4; ++i) { xa[i] = bf2f((unsigned short)cur.ha[p][i]); xb[i] = bf2f((unsigned short)cur.hb[p][i]); ss += xa[i] * xa[i] + xb[i] * xb[i]; }
#pragma unroll
            for (int o = 1; o < 16; o <<= 1) ss += bperm_f(ss, ln ^ o);
            const float rs = rsqrtf(ss * (1.f / 128.f) + EPS);
            const f32x4 ga = p < 2 ? gqa : gka, gb = p < 2 ? gqb : gkb;
            float oa[4], ob[4];
#pragma unroll
            for (int i = 0; i < 4; ++i) { const float ya = xa[i] * rs * ga[i], yb = xb[i] * rs * gb[i]; oa[i] = lat ? ya * cs[i] - yb * sn[i] : ya; ob[i] = lat ? ya * sn[i] + yb * cs[i] : yb; }
            bf16_t* dst = p < 2 ? QG + (size_t)row * 1024 + (4 * p + hq) * 128 : KG + (size_t)row * 256 + (hq & 1) * 128;
            if (p < 2 || hq < 2) { u32x2 wa, wb; wa.x = pk2(oa[0], oa[1]); wa.y = pk2(oa[2], oa[3]); wb.x = pk2(ob[0], ob[1]); wb.y = pk2(ob[2], ob[3]);
                *(u32x2*)(dst + eo) = wa; *(u32x2*)(dst + eo + 32) = wb; }
        }
        if (!hn) break;
        cur = nxt; row = nrow;
    }
}

namespace att {
constexpr int QBLK = 32, KVBLK = 64;
#define SBAR() __builtin_amdgcn_sched_barrier(0)
DI int crow(int r, int hi) { return (r & 3) + 8 * (r >> 2) + 4 * hi; }
DI int v_st(int k, int c) { const int kk = (k & ~0xC) | ((k & 4) << 1) | ((k & 8) >> 1); return ((kk >> 3) * 4 + (c >> 5)) * 512 + ((kk & 7) * 32 + (c & 31)) * 2; }
DI int v_rd_base(int lane) { return ((lane & 3) << 3) | (((lane >> 2) & 3) << 6) | (((lane >> 4) & 1) << 5) | (((lane >> 5) & 1) << 8); }
constexpr int v_rd_off(int d0, int ks, int half) { return d0 * 512 + ks * 4096 + half * 2048; }
template <int OFF> DI s16x4 tr_read(int vb) { s16x4 r; asm volatile("ds_read_b64_tr_b16 %0, %1 offset:%2" : "=&v"(r) : "v"(vb), "i"(OFF) : "memory"); return r; }
template <int D0> DI void pv_one(f32x16& od, int vb, bf16x8 pa0, bf16x8 pa1, bf16x8 pa2, bf16x8 pa3) {
  const s16x4 l0 = tr_read<v_rd_off(D0, 0, 0)>(vb), h0 = tr_read<v_rd_off(D0, 0, 1)>(vb), l1 = tr_read<v_rd_off(D0, 1, 0)>(vb), h1 = tr_read<v_rd_off(D0, 1, 1)>(vb);
  const s16x4 l2 = tr_read<v_rd_off(D0, 2, 0)>(vb), h2 = tr_read<v_rd_off(D0, 2, 1)>(vb), l3 = tr_read<v_rd_off(D0, 3, 0)>(vb), h3 = tr_read<v_rd_off(D0, 3, 1)>(vb);
  asm volatile("s_waitcnt lgkmcnt(0)" ::: "memory"); SBAR();
#define PK(L, H) (bf16x8){L[0], L[1], L[2], L[3], H[0], H[1], H[2], H[3]}
  od = __builtin_amdgcn_mfma_f32_32x32x16_bf16(pa0, PK(l0, h0), od, 0, 0, 0);
  od = __builtin_amdgcn_mfma_f32_32x32x16_bf16(pa1, PK(l1, h1), od, 0, 0, 0);
  od = __builtin_amdgcn_mfma_f32_32x32x16_bf16(pa2, PK(l2, h2), od, 0, 0, 0);
  od = __builtin_amdgcn_mfma_f32_32x32x16_bf16(pa3, PK(l3, h3), od, 0, 0, 0);
#undef PK
}
DI void pv_d0(f32x16* o, int vb, bf16x8 pa0, bf16x8 pa1, bf16x8 pa2, bf16x8 pa3) {
  pv_one<0>(o[0], vb, pa0, pa1, pa2, pa3); pv_one<1>(o[1], vb, pa0, pa1, pa2, pa3); pv_one<2>(o[2], vb, pa0, pa1, pa2, pa3); pv_one<3>(o[3], vb, pa0, pa1, pa2, pa3);
}
template <int DKX, int LDQ, int LDK, int LDV, int LDO, int SDEPTH = 1>
DI void attn_body(const bf16_t* __restrict__ Qb, const bf16_t* __restrict__ Km, const bf16_t* __restrict__ Kx, const bf16_t* __restrict__ Vm, bf16_t* __restrict__ Ob,
                  int kr0, int nt0, int kr1, int nt1, float scale, const float* __restrict__ ropeq  , char* lds) {
  constexpr int ND0 = 8 + DKX / 16, KROWB = (128 + DKX) * 2, SHM_V = KVBLK * 128 * 2, SHM_K = KVBLK * KROWB;
  constexpr float THR = 8.f;
#define KSWZ(row, colB) ((row) * KROWB + ((colB) ^ (((row) & 7) << 4)))
  int tid = threadIdx.x; asm volatile("" : "+v"(tid));
  const int wid = __builtin_amdgcn_readfirstlane(tid >> 6), lane = tid & 63, r32 = lane & 31, hi = lane >> 5;
  char* V_lds = lds; char* K_lds = lds + 2 * SHM_V;
  float* ws = (float*)(lds + 2 * SHM_V + 2 * SHM_K) + wid * 64; float* li_l = ws; float* al_l = ws + 32;
  const float C = scale * 1.4426950408889634f;
  float m_reg = -1e30f, l_reg = 0; f32x16 o[4] = {}; bf16x8 qr[8];
  const bf16_t* Qw = Qb + (long)(wid * QBLK + r32) * LDQ + hi * 8;
#pragma unroll
  for (int d0 = 0; d0 < 8; ++d0) qr[d0] = *reinterpret_cast<const bf16x8*>(Qw + d0 * 16);
  char* QX = lds + 2 * SHM_V + 2 * SHM_K + 2048 + (wid * 4 * 64 + lane) * 16;
  if constexpr (DKX > 0) {
#pragma unroll
    for (int ax = 0; ax < 2; ++ax) {
      const bf16x8 xa = *reinterpret_cast<const bf16x8*>(Qw + 128 + ax * 32), xb = *reinterpret_cast<const bf16x8*>(Qw + 128 + ax * 32 + 16);
      if (ropeq) {
        const float* cs = ropeq + ((size_t)(wid * QBLK + r32) * 32 + ax * 16 + hi * 8) * 2;
        float oa[8], ob[8];
#pragma unroll
        for (int j = 0; j < 8; ++j) { const float c = cs[2 * j], sn = cs[2 * j + 1], a = bf2f((unsigned short)xa[j]), b = bf2f((unsigned short)xb[j]); oa[j] = a * c - b * sn; ob[j] = a * sn + b * c; }
        u32x4 wa = {pk2(oa[0], oa[1]), pk2(oa[2], oa[3]), pk2(oa[4], oa[5]), pk2(oa[6], oa[7])}, wb = {pk2(ob[0], ob[1]), pk2(ob[2], ob[3]), pk2(ob[4], ob[5]), pk2(ob[6], ob[7])};
        *reinterpret_cast<u32x4*>(QX + (2 * ax) * 1024) = wa; *reinterpret_cast<u32x4*>(QX + (2 * ax + 1) * 1024) = wb;
      } else { *reinterpret_cast<bf16x8*>(QX + (2 * ax) * 1024) = xa; *reinterpret_cast<bf16x8*>(QX + (2 * ax + 1) * 1024) = xb; }
    }
  }
  const int sr = tid >> 4, sc = (tid & 15) * 8, vst0 = v_st(sr, sc), vst1 = v_st(32 + sr, sc);
  const int xr = tid >> 3, xc = (tid & 7) * 8;
  const int vb0 = (int)(uintptr_t)V_lds + v_rd_base(lane);
  const int offV = sr * LDV + sc, offK = sr * LDK + sc, offX = xr * 64 + xc;
  struct { bf16x8 vs0, vs1, ks0, ks1, kx; } sr_[SDEPTH];
  const int NT = nt0 + nt1;
#define TROW(j) ((j) < nt0 ? kr0 + (j) * KVBLK : kr1 + ((j) - nt0) * KVBLK)
#define SLOAD(i, j) do { const long _r = TROW(j); const bf16_t* _vt = Vm + _r * LDV; const bf16_t* _kt = Km + _r * LDK; \
    sr_[i].vs0 = *(const bf16x8*)(_vt + offV); sr_[i].vs1 = *(const bf16x8*)(_vt + offV + 32 * LDV); \
    sr_[i].ks0 = *(const bf16x8*)(_kt + offK); sr_[i].ks1 = *(const bf16x8*)(_kt + offK + 32 * LDK); \
    if constexpr (DKX > 0) sr_[i].kx = *(const bf16x8*)(Kx + _r * 64 + offX); } while (0)
#define SWRITE(b, i) do { *(bf16x8*)(V_lds + (b) * SHM_V + vst0) = sr_[i].vs0; *(bf16x8*)(V_lds + (b) * SHM_V + vst1) = sr_[i].vs1; const int kc = sc * 2; \
    *(bf16x8*)(K_lds + (b) * SHM_K + KSWZ(sr, kc)) = sr_[i].ks0; *(bf16x8*)(K_lds + (b) * SHM_K + KSWZ(32 + sr, kc)) = sr_[i].ks1; \
    if constexpr (DKX > 0) *(bf16x8*)(K_lds + (b) * SHM_K + KSWZ(xr, 256 + xc * 2)) = sr_[i].kx; } while (0)
#define SWAIT() do { if constexpr (SDEPTH == 1) asm volatile("s_waitcnt vmcnt(0)" ::: "memory"); else if constexpr (DKX > 0) asm volatile("s_waitcnt vmcnt(5)" ::: "memory"); else asm volatile("s_waitcnt vmcnt(4)" ::: "memory"); } while (0)
#define RESC(a) do { if (__any((a) < 1.f)) { if (hi == 0) al_l[r32] = (a); asm volatile("s_waitcnt lgkmcnt(0)" ::: "memory"); \
    for (int d = 0; d < 4; ++d) for (int r = 0; r < 16; ++r) o[d][r] *= al_l[crow(r, hi)]; } } while (0)
#define QKT(p0, p1, Ks) do { p0 = f32x16{}; p1 = f32x16{}; _Pragma("unroll") for (int d0 = 0; d0 < ND0; ++d0) { const int cb = (d0 * 16 + hi * 8) * 2; \
    const bf16x8 b0 = *reinterpret_cast<const bf16x8*>((Ks) + KSWZ(r32, cb)); const bf16x8 b1 = *reinterpret_cast<const bf16x8*>((Ks) + KSWZ(32 + r32, cb)); \
    const bf16x8 qf = d0 < 8 ? qr[d0 < 8 ? d0 : 0] : *reinterpret_cast<const bf16x8*>(QX + (d0 - 8) * 1024); \
    p0 = __builtin_amdgcn_mfma_f32_32x32x16_bf16(b0, qf, p0, 0, 0, 0); p1 = __builtin_amdgcn_mfma_f32_32x32x16_bf16(b1, qf, p1, 0, 0, 0); if (DKX > 0 && (d0 & 1) == 1) SBAR(); } } while (0)
#define PARTIAL_SM(p0, p1, mn, alpha) do { float pmax = p0[0]; for (int r = 1; r < 16; ++r) pmax = fmaxf(pmax, p0[r]); for (int r = 0; r < 16; ++r) pmax = fmaxf(pmax, p1[r]); \
    { auto rr = __builtin_amdgcn_permlane32_swap(__float_as_uint(pmax), __float_as_uint(pmax), false, false); pmax = fmaxf(__uint_as_float(rr[0]), __uint_as_float(rr[1])); } \
    if (__builtin_expect(__all((pmax - m_reg) * scale <= THR), 1)) { mn = m_reg; alpha = 1.f; } \
    else { mn = fmaxf(m_reg, pmax); alpha = __builtin_amdgcn_exp2f((m_reg - mn) * C); m_reg = mn; } \
    const float mnC = -mn * C; for (int r = 0; r < 16; ++r) p0[r] = fmaf(p0[r], C, mnC); for (int r = 0; r < 16; ++r) p1[r] = fmaf(p1[r], C, mnC); \
    for (int r = 0; r < 16; ++r) p0[r] = __builtin_amdgcn_exp2f(p0[r]); } while (0)
#define PK4(P, BASE, OUT) do { unsigned a0 = pk2(P[BASE + 0], P[BASE + 1]), a1 = pk2(P[BASE + 2], P[BASE + 3]); \
    unsigned b0 = pk2(P[BASE + 4], P[BASE + 5]), b1 = pk2(P[BASE + 6], P[BASE + 7]); \
    auto r0 = __builtin_amdgcn_permlane32_swap(a0, b0, false, false); auto r1 = __builtin_amdgcn_permlane32_swap(a1, b1, false, false); \
    u32x4 w = {r0[0], r1[0], r0[1], r1[1]}; OUT = *reinterpret_cast<bf16x8*>(&w); } while (0)
#define FINISH_SM(p0, p1, alpha) do { for (int r = 0; r < 16; ++r) p1[r] = __builtin_amdgcn_exp2f(p1[r]); \
    float ps = 0; for (int r = 0; r < 16; ++r) ps += p0[r]; for (int r = 0; r < 16; ++r) ps += p1[r]; \
    { auto rr = __builtin_amdgcn_permlane32_swap(__float_as_uint(ps), __float_as_uint(ps), false, false); ps = __uint_as_float(rr[0]) + __uint_as_float(rr[1]); } \
    l_reg = l_reg * alpha + ps; PK4(p0, 0, pa0); PK4(p0, 8, pa1); PK4(p1, 0, pa2); PK4(p1, 8, pa3); } while (0)
  f32x16 pA0, pA1, pB0, pB1; float mnA, mnB, alA, alB; bf16x8 pa0, pa1, pa2, pa3;
  constexpr int SE = 0, SO = SDEPTH - 1;
  SLOAD(SE, 0); asm volatile("s_waitcnt vmcnt(0)" ::: "memory"); SWRITE(0, SE); __syncthreads();
  QKT(pA0, pA1, K_lds); PARTIAL_SM(pA0, pA1, mnA, alA);
  SLOAD(SO, 1); if constexpr (SDEPTH == 2) { if (2 < NT) SLOAD(SE, 2); }
  SWAIT(); SWRITE(1, SO); __syncthreads();
  for (int j = 1; j + 1 < NT; j += 2) {
    SBAR(); QKT(pB0, pB1, K_lds + SHM_K);
    FINISH_SM(pA0, pA1, alA); SBAR();
    SLOAD(SO, j + SDEPTH); SBAR();
    pv_d0(o, vb0, pa0, pa1, pa2, pa3); PARTIAL_SM(pB0, pB1, mnB, alB);
    __syncthreads(); SWAIT(); SWRITE(0, SE);
    RESC(alB); __syncthreads();
    SBAR(); QKT(pA0, pA1, K_lds);
    FINISH_SM(pB0, pB1, alB); SBAR();
    if (SDEPTH == 1 || j + 3 < NT) SLOAD(SE, j + 1 + SDEPTH); SBAR();
    pv_d0(o, vb0 + (int)SHM_V, pa0, pa1, pa2, pa3); PARTIAL_SM(pA0, pA1, mnA, alA);
    __syncthreads(); SWAIT(); SWRITE(1, SO);
    RESC(alA); __syncthreads();
  }
  SBAR(); QKT(pB0, pB1, K_lds + SHM_K);
  FINISH_SM(pA0, pA1, alA); SBAR();
  pv_d0(o, vb0, pa0, pa1, pa2, pa3); PARTIAL_SM(pB0, pB1, mnB, alB);
  __syncthreads(); RESC(alB);
  FINISH_SM(pB0, pB1, alB); SBAR();
  pv_d0(o, vb0 + (int)SHM_V, pa0, pa1, pa2, pa3);
  if (hi == 0) li_l[r32] = l_reg; asm volatile("s_waitcnt lgkmcnt(0)" ::: "memory");
  float rli[16];
#pragma unroll
  for (int r = 0; r < 16; ++r) rli[r] = __builtin_amdgcn_rcpf(li_l[crow(r, hi)]);
  bf16_t* Ow = Ob + (long)(wid * QBLK) * LDO;
#pragma unroll
  for (int r = 0; r < 16; ++r) { const int orow = crow(r, hi);
#pragma unroll
    for (int d0 = 0; d0 < 4; ++d0) Ow[(long)orow * LDO + d0 * 32 + r32] = (bf16_t)f2bf(o[d0][r] * rli[r]); }
  __syncthreads();
#undef KSWZ
#undef TROW
#undef SLOAD
#undef SWRITE
#undef SWAIT
#undef RESC
#undef QKT
#undef PARTIAL_SM
#undef PK4
#undef FINISH_SM
}
}

namespace ml {
constexpr int LD = 264, ROWB = LD * 2, QS_OFF = 0, KS_OFF = 64 * ROWB, VS_OFF = 2 * 64 * ROWB, NV_OFF = 3 * 64 * ROWB, SC_OFF = NV_OFF + 1024, ML_END = SC_OFF + 2048;
static_assert(ML_END <= LDS_BYTES - 1024, "mlstm lds");
#define MFMA32(a, b, c) __builtin_amdgcn_mfma_f32_32x32x16_bf16((a), (b), (c), 0, 0, 0)
DI bf16x8 pack_step(const f32x16& x, int s) {
    u32x4 p;
    asm volatile("v_cvt_pk_bf16_f32 %0, %4, %5\n\tv_cvt_pk_bf16_f32 %1, %6, %7\n\tv_cvt_pk_bf16_f32 %2, %8, %9\n\tv_cvt_pk_bf16_f32 %3, %10, %11\n\ts_nop 1"
                 : "=&v"(p[0]), "=&v"(p[1]), "=&v"(p[2]), "=&v"(p[3])
                 : "v"(x[8 * s]), "v"(x[8 * s + 1]), "v"(x[8 * s + 2]), "v"(x[8 * s + 3]), "v"(x[8 * s + 4]), "v"(x[8 * s + 5]), "v"(x[8 * s + 6]), "v"(x[8 * s + 7]));
    return __builtin_bit_cast(bf16x8, p);
}
DI bf16x8 ld_perm(const LAS unsigned char* p) {
    const s16x4 lo = *(const LAS s16x4*)p, hi = *(const LAS s16x4*)(p + 16);
    return (bf16x8){lo[0], lo[1], lo[2], lo[3], hi[0], hi[1], hi[2], hi[3]};
}
DI int crow(int r, int hi) { return (r & 3) + 8 * (r >> 2) + 4 * hi; }
template <int OFF> DI s16x4 tr_rd(unsigned addr) { s16x4 r; asm volatile("ds_read_b64_tr_b16 %0, %1 offset:%2" : "=&v"(r) : "v"(addr), "i"(OFF) : "memory"); return r; }
#define TR_WAIT() do { asm volatile("s_waitcnt lgkmcnt(0)" ::: "memory"); __builtin_amdgcn_sched_barrier(0); } while (0)
#define CAT8(L, H) (bf16x8){L[0], L[1], L[2], L[3], H[0], H[1], H[2], H[3]}

DI void mlstm_stream(const Frame& F, const Args& a, int l, int stream, bool ctx_out) {
    const int b = stream >> 3, hd = (stream >> 1) & 3, dir = stream & 1;
    const int tid = F.tid, w = F.wave;
    LAS unsigned char* lds = F.lds;
    const unsigned ldsb = (unsigned)(uintptr_t)lds;
    const bf16_t* P = (const bf16_t*)(F.ws + WS_P); const float* X80 = (const float*)(F.ws + WS_X80);
    float* MLH = (float*)(F.ws + WS_MLH) + (size_t)dir * MTOT * 1024;
    const float* gb = a.in[I_GBIAS] + l * 16;
    const float gbi = gb[dir * 8 + hd], gbf = gb[dir * 8 + 4 + hd];
    LAS float* NV = (LAS float*)(lds + NV_OFF);
    LAS float* SC = (LAS float*)(lds + SC_OFF);
    f32x16 CT[8];
#pragma unroll
    for (int i = 0; i < 8; ++i) CT[i] = f32x16{};
    if (tid < 256) NV[tid] = 0.f;
    float m_prev = 0.f;
    const int sgn = dir ? -1 : 1;
#define CHUNK_ROW0(c) ((c) < 4 ? MLAT + b * CTXL + (dir ? 255 - (c) * 64 : (c) * 64) : b * SEQ + (dir ? 2047 - ((c) - 4) * 64 : ((c) - 4) * 64))
    bf16x8 pq[4], pk[4], pv[4]; float pgi, pgf;
#define PREFETCH(c) do { int ln_ = F.lane; asm volatile("" : "+v"(ln_)); const int r0_ = CHUNK_ROW0(c); \
        const bf16_t* pr_ = P + (size_t)(r0_ + sgn * ((w << 3) | (ln_ >> 3))) * NP + hd * 256 + 8 * (ln_ & 7); \
        _Pragma("unroll") for (int j = 0; j < 4; ++j) { pq[j] = *(const bf16x8*)(pr_ + C_MLQ + 64 * j); pk[j] = *(const bf16x8*)(pr_ + C_MLK + 64 * j); pv[j] = *(const bf16x8*)(pr_ + C_MLV + 64 * j); } \
        const float* xg_ = X80 + (size_t)(r0_ + sgn * ln_) * XW + 64 + dir * 8 + hd; pgi = xg_[0]; pgf = xg_[4]; } while (0)
    PREFETCH(0);
#ifndef MK_MLX
#define MK_MLX 1
#endif
    for (int cc = 0; cc < 36 * MK_MLX; ++cc) {
        const int c = cc % 36;
        if (MK_MLX > 1 && cc == 36) { __syncthreads();
#pragma unroll
            for (int i = 0; i < 8; ++i) CT[i] = f32x16{};
            if (tid < 256) NV[tid] = 0.f; m_prev = 0.f; }
        int lane = F.lane; asm volatile("" : "+v"(lane));
        const int r32 = lane & 31, hi = lane >> 5, ldi = (w << 3) | (lane >> 3), cg = lane & 7, g16 = lane >> 4, q4 = (lane & 15) >> 2, p4 = lane & 3;
        const int row0 = CHUNK_ROW0(c);
        const float ipre = pgi + gbi, fpre = pgf + gbf;
        const float lf = fminf(fpre, 0.f) - __logf(1.f + __expf(-fabsf(fpre)));
        float cum = lf;
#pragma unroll
        for (int o = 1; o < 64; o <<= 1) { const float t = shu(cum, o); if (lane >= o) cum += t; }
        const float bb = ipre - cum;
        float pmx = bb;
#pragma unroll
        for (int o = 1; o < 64; o <<= 1) { const float t = shu(pmx, o); if (lane >= o) pmx = fmaxf(pmx, t); }
        const float aa = fmaxf(m_prev, pmx);
        const float cum_end = shl_(cum, 63), a_end = shl_(aa, 63);
        const float decay = __expf(m_prev - a_end), m_new = cum_end + a_end;
        __syncthreads();
#pragma unroll
        for (int j = 0; j < 4; ++j) { const int ch = cg + 8 * j; const bf16x8 qv = pq[j];
            u32x4 qs;
            qs.x = pk2(bf2f((unsigned short)qv[0]) * 0.0625f, bf2f((unsigned short)qv[1]) * 0.0625f); qs.y = pk2(bf2f((unsigned short)qv[2]) * 0.0625f, bf2f((unsigned short)qv[3]) * 0.0625f);
            qs.z = pk2(bf2f((unsigned short)qv[4]) * 0.0625f, bf2f((unsigned short)qv[5]) * 0.0625f); qs.w = pk2(bf2f((unsigned short)qv[6]) * 0.0625f, bf2f((unsigned short)qv[7]) * 0.0625f);
            *(LAS u32x4*)(lds + QS_OFF + (ldi * LD + 8 * ch) * 2) = qs;
            *(LAS bf16x8*)(lds + KS_OFF + (ldi * LD + 8 * ch) * 2) = pk[j];
            *(LAS bf16x8*)(lds + VS_OFF + (ldi * LD + 8 * ch) * 2) = pv[j]; }
        {
            float part = 0.f;
#pragma unroll
            for (int j = 0; j < 4; ++j) { const int ch = cg + 8 * j; const bf16x8 qv = pq[j]; const f32x4 n0 = *(const LAS f32x4*)(NV + 8 * ch), n1 = *(const LAS f32x4*)(NV + 8 * ch + 4);
                part += bf2f((unsigned short)qv[0]) * n0.x + bf2f((unsigned short)qv[1]) * n0.y + bf2f((unsigned short)qv[2]) * n0.z + bf2f((unsigned short)qv[3]) * n0.w
                      + bf2f((unsigned short)qv[4]) * n1.x + bf2f((unsigned short)qv[5]) * n1.y + bf2f((unsigned short)qv[6]) * n1.z + bf2f((unsigned short)qv[7]) * n1.w; }
            part += shx(part, 1); part += shx(part, 2); part += shx(part, 4);
            if (cg == 0) SC[320 + ldi] = part * 0.0625f; }
        if (w == 0) { SC[lane] = bb; SC[64 + lane] = aa; SC[128 + lane] = __expf(m_prev - aa); SC[192 + lane] = __expf(-cum - aa); SC[256 + lane] = __expf(bb - a_end); }
        __syncthreads();
        const bool want_out = (c >= 4) || ctx_out;
        if (want_out) {
            const unsigned va0 = ldsb + VS_OFF + ((4 * (g16 >> 1) + q4) * LD + 32 * w + 16 * (g16 & 1) + 4 * p4) * 2;
#pragma unroll
            for (int lt = 0; lt < 2; ++lt) {
                const int lcol = 32 * lt + r32;
                const float a_l = SC[64 + lcol], wI_l = SC[128 + lcol], fl_l = SC[192 + lcol], nq_l = SC[320 + lcol];
                f32x16 N = f32x16{};
#pragma unroll
                for (int dt = 0; dt < 8; ++dt)
#pragma unroll
                    for (int ks = 0; ks < 2; ++ks) {
                        const bf16x8 qa = ld_perm(lds + QS_OFF + (lcol * LD + 32 * dt + 16 * ks + 4 * hi) * 2);
                        N = MFMA32(pack_step(CT[dt], ks), qa, N); if (ks == 1 && (dt & 1)) __builtin_amdgcn_sched_barrier(0); }
#pragma unroll
                for (int r = 0; r < 16; ++r) N[r] *= wI_l;
                float den = 0.f;
#pragma unroll
                for (int st = 0; st <= lt; ++st) {
                    f32x16 S = f32x16{};
#pragma unroll
                    for (int ks = 0; ks < 16; ++ks) {
                        const bf16x8 ka = *(const LAS bf16x8*)(lds + KS_OFF + ((32 * st + r32) * LD + 16 * ks + 8 * hi) * 2);
                        const bf16x8 qb = *(const LAS bf16x8*)(lds + QS_OFF + (lcol * LD + 16 * ks + 8 * hi) * 2);
                        S = MFMA32(ka, qb, S); }
                    const s16x4 v00 = st == 0 ? tr_rd<0>(va0) : tr_rd<32 * ROWB>(va0), v01 = st == 0 ? tr_rd<8 * ROWB>(va0) : tr_rd<40 * ROWB>(va0);
                    const s16x4 v10 = st == 0 ? tr_rd<16 * ROWB>(va0) : tr_rd<48 * ROWB>(va0), v11 = st == 0 ? tr_rd<24 * ROWB>(va0) : tr_rd<56 * ROWB>(va0);
#pragma unroll
                    for (int r = 0; r < 16; ++r) { const int srow = 32 * st + crow(r, hi); const float dd = __expf(SC[srow] - a_l);
                        const float v = (srow <= lcol) ? S[r] * dd : 0.f; S[r] = v; den += v; }
                    TR_WAIT();
                    N = MFMA32(CAT8(v00, v01), pack_step(S, 0), N);
                    N = MFMA32(CAT8(v10, v11), pack_step(S, 1), N);
                }
                den += shx(den, 32);
                den += wI_l * nq_l;
                const float inv = 1.f / fmaxf(fabsf(den), fl_l);
                float* orow = MLH + (size_t)(row0 + sgn * lcol) * 1024 + hd * 256 + 32 * w + 4 * hi;
#pragma unroll
                for (int g = 0; g < 4; ++g) *(f32x4*)(orow + 8 * g) = (f32x4){N[4 * g] * inv, N[4 * g + 1] * inv, N[4 * g + 2] * inv, N[4 * g + 3] * inv};
                __builtin_amdgcn_sched_barrier(0);
            }
        }
        __builtin_amdgcn_sched_barrier(0);
        { const int cn = (cc + 1 < 36 * MK_MLX) ? (cc + 1) % 36 : 35; PREFETCH(cn); }
        __builtin_amdgcn_sched_barrier(0);
        {
            const unsigned vb0 = ldsb + VS_OFF + ((8 * (g16 >> 1) + q4) * LD + 32 * w + 16 * (g16 & 1) + 4 * p4) * 2;
            const unsigned kb0 = ldsb + KS_OFF + ((8 * (g16 >> 1) + q4) * LD + 16 * (g16 & 1) + 4 * p4) * 2;
            const s16x4 b00 = tr_rd<0>(vb0), b01 = tr_rd<4 * ROWB>(vb0), b10 = tr_rd<16 * ROWB>(vb0), b11 = tr_rd<20 * ROWB>(vb0);
            const s16x4 b20 = tr_rd<32 * ROWB>(vb0), b21 = tr_rd<36 * ROWB>(vb0), b30 = tr_rd<48 * ROWB>(vb0), b31 = tr_rd<52 * ROWB>(vb0);
            TR_WAIT();
            bf16x8 vb[4];
#define SCALE8(dst, L, H, ks) do { const f32x4 w0 = *(const LAS f32x4*)(SC + 256 + 16 * (ks) + 8 * hi), w1 = *(const LAS f32x4*)(SC + 256 + 16 * (ks) + 8 * hi + 4); \
            u32x4 t_; t_.x = pk2(bf2f((unsigned short)L[0]) * w0.x, bf2f((unsigned short)L[1]) * w0.y); t_.y = pk2(bf2f((unsigned short)L[2]) * w0.z, bf2f((unsigned short)L[3]) * w0.w); \
            t_.z = pk2(bf2f((unsigned short)H[0]) * w1.x, bf2f((unsigned short)H[1]) * w1.y); t_.w = pk2(bf2f((unsigned short)H[2]) * w1.z, bf2f((unsigned short)H[3]) * w1.w); dst = __builtin_bit_cast(bf16x8, t_); } while (0)
            SCALE8(vb[0], b00, b01, 0); SCALE8(vb[1], b10, b11, 1); SCALE8(vb[2], b20, b21, 2); SCALE8(vb[3], b30, b31, 3);
#undef SCALE8
#define UPD(dt) do { const s16x4 k00 = tr_rd<(dt) * 64>(kb0), k01 = tr_rd<(dt) * 64 + 4 * ROWB>(kb0), k10 = tr_rd<(dt) * 64 + 16 * ROWB>(kb0), k11 = tr_rd<(dt) * 64 + 20 * ROWB>(kb0); \
            const s16x4 k20 = tr_rd<(dt) * 64 + 32 * ROWB>(kb0), k21 = tr_rd<(dt) * 64 + 36 * ROWB>(kb0), k30 = tr_rd<(dt) * 64 + 48 * ROWB>(kb0), k31 = tr_rd<(dt) * 64 + 52 * ROWB>(kb0); \
            _Pragma("unroll") for (int r = 0; r < 16; ++r) CT[dt][r] *= decay; \
            TR_WAIT(); \
            CT[dt] = MFMA32(CAT8(k00, k01), vb[0], CT[dt]); CT[dt] = MFMA32(CAT8(k10, k11), vb[1], CT[dt]); CT[dt] = MFMA32(CAT8(k20, k21), vb[2], CT[dt]); CT[dt] = MFMA32(CAT8(k30, k31), vb[3], CT[dt]); } while (0)
            UPD(0); UPD(1); UPD(2); UPD(3); UPD(4); UPD(5); UPD(6); UPD(7);
#undef UPD
        }
        __syncthreads();
        if (tid < 256) { float sacc = 0.f;
#pragma unroll 8
            for (int q = 0; q < 64; ++q) sacc += bf2f(*(const LAS unsigned short*)(lds + KS_OFF + (q * LD + tid) * 2)) * SC[256 + q];
            NV[tid] = decay * NV[tid] + sacc; }
        m_prev = m_new;
    }
    __syncthreads();
#undef CHUNK_ROW0
#undef PREFETCH
}

namespace u2 {
constexpr int LDQ = 264, ROWQ = LDQ * 2, LDV = 136, ROWV = LDV * 2, LDW = 72, ROWW = LDW * 2;
constexpr int QS = 0, KS = 64 * ROWQ, VS = 2 * 64 * ROWQ, SW = VS + 64 * ROWV, NV_O = SW + 64 * ROWW, SC_O = NV_O + 1024, SCN = 448, END = SC_O + 2 * SCN * 4;
static_assert(END <= LDS_BYTES - 1024, "mlstm2 lds");
}
DI void mlstm_unit2(const Frame& F, const Args& a, int l, int unit, bool ctx_out) {
    using namespace u2;
    const int stream = unit >> 1, half = unit & 1, b = stream >> 3, hd = (stream >> 1) & 3, dir = stream & 1;
    const int tid = F.tid, w = F.wave;
    LAS unsigned char* lds = F.lds;
    const unsigned ldsb = (unsigned)(uintptr_t)lds;
    const bf16_t* P = (const bf16_t*)(F.ws + WS_P); const float* X80 = (const float*)(F.ws + WS_X80);
    bf16_t* MLH = (bf16_t*)(F.ws + WS_MLH) + (size_t)dir * MTOT * 1024;
    const float* gb = a.in[I_GBIAS] + l * 16;
    const float gbi = gb[dir * 8 + hd], gbf = gb[dir * 8 + 4 + hd];
    LAS float* NV = (LAS float*)(lds + NV_O);
    const int sgn = dir ? -1 : 1;
#define CHUNK_ROW0(c) ((c) < 4 ? MLAT + b * CTXL + (dir ? 255 - (c) * 64 : (c) * 64) : b * SEQ + (dir ? 2047 - ((c) - 4) * 64 : ((c) - 4) * 64))
    const bool helper = w >= 4;
    bf16x8 pq[8], pk[8], pv[4]; float pgi = 0.f, pgf = 0.f; float m_prev = 0.f;
#define PREFETCH(c) do { int ht_ = tid - 256; asm volatile("" : "+v"(ht_)); const int r0_ = CHUNK_ROW0(c); \
        const bf16_t* pr_ = P + (size_t)(r0_ + sgn * (ht_ >> 2)) * NP + hd * 256 + 8 * (ht_ & 3); \
        _Pragma("unroll") for (int j = 0; j < 8; ++j) { pq[j] = *(const bf16x8*)(pr_ + C_MLQ + 32 * j); pk[j] = *(const bf16x8*)(pr_ + C_MLK + 32 * j); } \
        _Pragma("unroll") for (int j = 0; j < 4; ++j) pv[j] = *(const bf16x8*)(pr_ + C_MLV + 128 * half + 32 * j); \
        const float* xg_ = X80 + (size_t)(r0_ + sgn * (ht_ & 63)) * XW + 64 + dir * 8 + hd; pgi = xg_[0]; pgf = xg_[4]; } while (0)
#define SCALARS(sb) do { if (w == 4) { int ln_ = F.lane; asm volatile("" : "+v"(ln_)); LAS float* SCw = (LAS float*)(lds + SC_O) + (sb) * SCN; \
        const float ipre = pgi + gbi, fpre = pgf + gbf; const float lf = fminf(fpre, 0.f) - __logf(1.f + __expf(-fabsf(fpre))); \
        float cum = lf; _Pragma("unroll") for (int o = 1; o < 64; o <<= 1) { const float t = shu(cum, o); if (ln_ >= o) cum += t; } \
        const float bb = ipre - cum; float pmx = bb; _Pragma("unroll") for (int o = 1; o < 64; o <<= 1) { const float t = shu(pmx, o); if (ln_ >= o) pmx = fmaxf(pmx, t); } \
        const float aa = fmaxf(m_prev, pmx); const float cum_end = shl_(cum, 63), a_end = shl_(aa, 63); \
        { SCw[ln_] = bb; SCw[64 + ln_] = aa; SCw[128 + ln_] = __expf(m_prev - aa); SCw[192 + ln_] = __expf(-cum - aa); SCw[256 + ln_] = __expf(bb - a_end); if (ln_ == 0) SCw[384] = __expf(m_prev - a_end); } \
        m_prev = cum_end + a_end; } } while (0)
#define WRITE_Q() do { int ht_ = tid - 256; asm volatile("" : "+v"(ht_)); const int hp_ = ht_ >> 2, hg_ = ht_ & 3; \
        _Pragma("unroll") for (int j = 0; j < 8; ++j) { const bf16x8 qv = pq[j]; u32x4 qs; \
            qs.x = pk2(bf2f((unsigned short)qv[0]) * 0.0625f, bf2f((unsigned short)qv[1]) * 0.0625f); qs.y = pk2(bf2f((unsigned short)qv[2]) * 0.0625f, bf2f((unsigned short)qv[3]) * 0.0625f); \
            qs.z = pk2(bf2f((unsigned short)qv[4]) * 0.0625f, bf2f((unsigned short)qv[5]) * 0.0625f); qs.w = pk2(bf2f((unsigned short)qv[6]) * 0.0625f, bf2f((unsigned short)qv[7]) * 0.0625f); \
            *(LAS u32x4*)(lds + QS + (hp_ * LDQ + 8 * (hg_ + 4 * j)) * 2) = qs; } } while (0)
#define WRITE_KV() do { int ht_ = tid - 256; asm volatile("" : "+v"(ht_)); const int hp_ = ht_ >> 2, hg_ = ht_ & 3; \
        _Pragma("unroll") for (int j = 0; j < 8; ++j) *(LAS bf16x8*)(lds + KS + (hp_ * LDQ + 8 * (hg_ + 4 * j)) * 2) = pk[j]; \
        _Pragma("unroll") for (int j = 0; j < 4; ++j) *(LAS bf16x8*)(lds + VS + (hp_ * LDV + 8 * (hg_ + 4 * j)) * 2) = pv[j]; } while (0)
    LAS float* DEN = (LAS float*)(lds + END);
    static_assert(END + 768 <= LDS_BYTES - 1024, "mlstm2 lds den");
    __syncthreads();
    if (helper) { NV[tid - 256] = 0.f; PREFETCH(0); SCALARS(0); WRITE_Q(); WRITE_KV(); }
    __syncthreads();
    if (!helper) {
      f32x16 CT[8];
#pragma unroll
      for (int i = 0; i < 8; ++i) CT[i] = f32x16{};
      for (int cc = 0; cc < 36 * MK_MLX; ++cc) {
        const int c = cc % 36;
        const int sb = cc & 1;
        const LAS float* SC = (const LAS float*)(lds + SC_O) + sb * SCN;
        const bool want_out = (c >= 4) || ctx_out;
        int lane = F.lane; asm volatile("" : "+v"(lane));
        const int r32 = lane & 31, hi = lane >> 5, g16 = lane >> 4, q4 = (lane & 15) >> 2, p4 = lane & 3;
        const int row0 = CHUNK_ROW0(c);
        if (MK_MLX > 1 && cc == 36) {
#pragma unroll
          for (int i = 0; i < 8; ++i) CT[i] = f32x16{}; }
        f32x16 N0 = f32x16{}, N1 = f32x16{};
        {
            if (want_out) {
#pragma unroll
                for (int dt = 0; dt < 8; ++dt)
#pragma unroll
                    for (int ks = 0; ks < 2; ++ks) {
                        const bf16x8 cf = pack_step(CT[dt], ks);
                        const bf16x8 qa0 = ld_perm(lds + QS + (r32 * LDQ + 32 * dt + 16 * ks + 4 * hi) * 2), qa1 = ld_perm(lds + QS + ((32 + r32) * LDQ + 32 * dt + 16 * ks + 4 * hi) * 2);
                        N0 = MFMA32(cf, qa0, N0); N1 = MFMA32(cf, qa1, N1); if (ks == 1 && (dt & 1)) __builtin_amdgcn_sched_barrier(0); }
                const float wI0 = SC[128 + r32], wI1 = SC[128 + 32 + r32];
#pragma unroll
                for (int r = 0; r < 16; ++r) { N0[r] *= wI0; N1[r] *= wI1; }
            }
        }
        __syncthreads();
        {
            if (want_out) {
                const unsigned va0 = ldsb + VS + ((8 * (g16 >> 1) + q4) * LDV + 32 * w + 16 * (g16 & 1) + 4 * p4) * 2;
                const s16x4 a00 = tr_rd<0>(va0), a01 = tr_rd<4 * ROWV>(va0), a10 = tr_rd<16 * ROWV>(va0), a11 = tr_rd<20 * ROWV>(va0);
                const s16x4 a20 = tr_rd<32 * ROWV>(va0), a21 = tr_rd<36 * ROWV>(va0), a30 = tr_rd<48 * ROWV>(va0), a31 = tr_rd<52 * ROWV>(va0);
                const LAS unsigned char* sw0 = lds + SW + (r32 * LDW + 8 * hi) * 2; const LAS unsigned char* sw1 = sw0 + 32 * ROWW;
                const bf16x8 s00 = *(const LAS bf16x8*)(sw0), s01 = *(const LAS bf16x8*)(sw0 + 32);
                const bf16x8 s10 = *(const LAS bf16x8*)(sw1), s11 = *(const LAS bf16x8*)(sw1 + 32), s12 = *(const LAS bf16x8*)(sw1 + 64), s13 = *(const LAS bf16x8*)(sw1 + 96);
                TR_WAIT();
                N0 = MFMA32(CAT8(a00, a01), s00, N0); N0 = MFMA32(CAT8(a10, a11), s01, N0);
                N1 = MFMA32(CAT8(a00, a01), s10, N1); N1 = MFMA32(CAT8(a10, a11), s11, N1); N1 = MFMA32(CAT8(a20, a21), s12, N1); N1 = MFMA32(CAT8(a30, a31), s13, N1);
                {
                    const float den0 = DEN[r32] + SC[128 + r32] * SC[320 + r32];
                    const float den1 = DEN[64 + 32 + r32] + DEN[128 + 32 + r32] + SC[128 + 32 + r32] * SC[320 + 32 + r32];
                    const float inv0 = 1.f / fmaxf(fabsf(den0), SC[192 + r32]), inv1 = 1.f / fmaxf(fabsf(den1), SC[192 + 32 + r32]);
                    bf16_t* o0 = MLH + (size_t)(row0 + sgn * r32) * 1024 + hd * 256 + 128 * half + 32 * w + 4 * hi; bf16_t* o1 = MLH + (size_t)(row0 + sgn * (32 + r32)) * 1024 + hd * 256 + 128 * half + 32 * w + 4 * hi;
#pragma unroll
                    for (int g = 0; g < 4; ++g) { u32x2 t0, t1; t0.x = pk2(N0[4 * g] * inv0, N0[4 * g + 1] * inv0); t0.y = pk2(N0[4 * g + 2] * inv0, N0[4 * g + 3] * inv0);
                        t1.x = pk2(N1[4 * g] * inv1, N1[4 * g + 1] * inv1); t1.y = pk2(N1[4 * g + 2] * inv1, N1[4 * g + 3] * inv1);
                        *(u32x2*)(o0 + 8 * g) = t0; *(u32x2*)(o1 + 8 * g) = t1; }
                }
            }
            __builtin_amdgcn_sched_barrier(0);
            {
                const float decay = SC[384];
                const unsigned vb0 = ldsb + VS + ((8 * (g16 >> 1) + q4) * LDV + 32 * w + 16 * (g16 & 1) + 4 * p4) * 2;
                const unsigned kb0 = ldsb + KS + ((8 * (g16 >> 1) + q4) * LDQ + 16 * (g16 & 1) + 4 * p4) * 2;
                const s16x4 b00 = tr_rd<0>(vb0), b01 = tr_rd<4 * ROWV>(vb0), b10 = tr_rd<16 * ROWV>(vb0), b11 = tr_rd<20 * ROWV>(vb0);
                const s16x4 b20 = tr_rd<32 * ROWV>(vb0), b21 = tr_rd<36 * ROWV>(vb0), b30 = tr_rd<48 * ROWV>(vb0), b31 = tr_rd<52 * ROWV>(vb0);
                TR_WAIT();
                bf16x8 vb[4];
#define SCALE8(dst, L, H, ks) do { const f32x4 w0 = *(const LAS f32x4*)(SC + 256 + 16 * (ks) + 8 * hi), w1 = *(const LAS f32x4*)(SC + 256 + 16 * (ks) + 8 * hi + 4); \
                u32x4 t_; t_.x = pk2(bf2f((unsigned short)L[0]) * w0.x, bf2f((unsigned short)L[1]) * w0.y); t_.y = pk2(bf2f((unsigned short)L[2]) * w0.z, bf2f((unsigned short)L[3]) * w0.w); \
                t_.z = pk2(bf2f((unsigned short)H[0]) * w1.x, bf2f((unsigned short)H[1]) * w1.y); t_.w = pk2(bf2f((unsigned short)H[2]) * w1.z, bf2f((unsigned short)H[3]) * w1.w); dst = __builtin_bit_cast(bf16x8, t_); } while (0)
                SCALE8(vb[0], b00, b01, 0); SCALE8(vb[1], b10, b11, 1); SCALE8(vb[2], b20, b21, 2); SCALE8(vb[3], b30, b31, 3);
#undef SCALE8
#define UPD(dt) do { const s16x4 k00 = tr_rd<(dt) * 64>(kb0), k01 = tr_rd<(dt) * 64 + 4 * ROWQ>(kb0), k10 = tr_rd<(dt) * 64 + 16 * ROWQ>(kb0), k11 = tr_rd<(dt) * 64 + 20 * ROWQ>(kb0); \
                const s16x4 k20 = tr_rd<(dt) * 64 + 32 * ROWQ>(kb0), k21 = tr_rd<(dt) * 64 + 36 * ROWQ>(kb0), k30 = tr_rd<(dt) * 64 + 48 * ROWQ>(kb0), k31 = tr_rd<(dt) * 64 + 52 * ROWQ>(kb0); \
                _Pragma("unroll") for (int r = 0; r < 16; ++r) CT[dt][r] *= decay; \
                TR_WAIT(); \
                CT[dt] = MFMA32(CAT8(k00, k01), vb[0], CT[dt]); CT[dt] = MFMA32(CAT8(k10, k11), vb[1], CT[dt]); CT[dt] = MFMA32(CAT8(k20, k21), vb[2], CT[dt]); CT[dt] = MFMA32(CAT8(k30, k31), vb[3], CT[dt]); } while (0)
                UPD(0); UPD(1); UPD(2); UPD(3); UPD(4); UPD(5); UPD(6); UPD(7);
#undef UPD
            }
        }
        __syncthreads();
        __syncthreads();
      }
    } else {
      for (int cc = 0; cc < 36 * MK_MLX; ++cc) {
        const int c = cc % 36;
        const int sb = cc & 1;
        const LAS float* SC = (const LAS float*)(lds + SC_O) + sb * SCN;
        const bool want_out = (c >= 4) || ctx_out;
        int lane = F.lane; asm volatile("" : "+v"(lane));
        const int r32 = lane & 31, hi = lane >> 5, g16 = lane >> 4, q4 = (lane & 15) >> 2, p4 = lane & 3;
        const int row0 = CHUNK_ROW0(c);
        { const int cn = (cc + 1 < 36 * MK_MLX) ? (cc + 1) % 36 : 35; PREFETCH(cn); }
        {
            if (want_out) {
                if (w < 7) {
                    const int st = (w == 6) ? 1 : 0, lt = (w == 4) ? 0 : 1, lcol = 32 * lt + r32;
                    f32x16 S = f32x16{};
#pragma unroll
                    for (int ks = 0; ks < 16; ++ks) {
                        const bf16x8 ka = *(const LAS bf16x8*)(lds + KS + ((32 * st + r32) * LDQ + 16 * ks + 8 * hi) * 2);
                        const bf16x8 qb = *(const LAS bf16x8*)(lds + QS + (lcol * LDQ + 16 * ks + 8 * hi) * 2);
                        S = MFMA32(ka, qb, S); }
                    const float a_l = SC[64 + lcol]; float den = 0.f;
#pragma unroll
                    for (int r = 0; r < 16; ++r) { const int srow = 32 * st + crow(r, hi); const float dd = __expf(SC[srow] - a_l);
                        const float v = (srow <= lcol) ? S[r] * dd : 0.f; S[r] = v; den += v; }
                    den += shx(den, 32);
                    if (hi == 0) DEN[(w - 4) * 64 + lcol] = den;
#pragma unroll
                    for (int g = 0; g < 4; ++g) { u32x2 t_; t_.x = pk2(S[4 * g], S[4 * g + 1]); t_.y = pk2(S[4 * g + 2], S[4 * g + 3]);
                        *(LAS u32x2*)(lds + SW + (lcol * LDW + 32 * st + 8 * g + 4 * hi) * 2) = t_; }
                } else {
                    float nq = 0.f; const LAS unsigned char* qrow = lds + QS + lane * ROWQ;
#pragma unroll 4
                    for (int d8 = 0; d8 < 32; ++d8) { const bf16x8 qv = *(const LAS bf16x8*)(qrow + d8 * 16); const f32x4 n0 = *(const LAS f32x4*)(NV + 8 * d8), n1 = *(const LAS f32x4*)(NV + 8 * d8 + 4);
                        nq += bf2f((unsigned short)qv[0]) * n0.x + bf2f((unsigned short)qv[1]) * n0.y + bf2f((unsigned short)qv[2]) * n0.z + bf2f((unsigned short)qv[3]) * n0.w
                            + bf2f((unsigned short)qv[4]) * n1.x + bf2f((unsigned short)qv[5]) * n1.y + bf2f((unsigned short)qv[6]) * n1.z + bf2f((unsigned short)qv[7]) * n1.w; }
                    ((LAS float*)(lds + SC_O) + sb * SCN)[320 + lane] = nq;
                }
            }
        }
        __syncthreads();
        {
            if (w == 7) {
                const int dg = lane & 31, sh = lane >> 5; const float decay = SC[384];
                float ac[8];
#pragma unroll
                for (int j = 0; j < 8; ++j) ac[j] = 0.f;
#pragma unroll 4
                for (int q = 0; q < 32; ++q) { const int srow = 32 * sh + q; const bf16x8 kv = *(const LAS bf16x8*)(lds + KS + (srow * LDQ + 8 * dg) * 2); const float wq = SC[256 + srow];
#pragma unroll
                    for (int j = 0; j < 8; ++j) ac[j] += bf2f((unsigned short)kv[j]) * wq; }
#pragma unroll
                for (int j = 0; j < 8; ++j) ac[j] += shx(ac[j], 32);
                if (sh == 0) {
                    f32x4 n0 = *(LAS f32x4*)(NV + 8 * dg), n1 = *(LAS f32x4*)(NV + 8 * dg + 4);
                    n0 = n0 * decay + (f32x4){ac[0], ac[1], ac[2], ac[3]}; n1 = n1 * decay + (f32x4){ac[4], ac[5], ac[6], ac[7]};
                    if (MK_MLX > 1 && cc == 35) { n0 = (f32x4){0.f, 0.f, 0.f, 0.f}; n1 = n0; }
                    *(LAS f32x4*)(NV + 8 * dg) = n0; *(LAS f32x4*)(NV + 8 * dg + 4) = n1; }
            }
            if (MK_MLX > 1 && cc == 35) m_prev = 0.f;
            SCALARS(sb ^ 1);
            WRITE_Q();
        }
        __syncthreads();
        WRITE_KV();
        __syncthreads();
      }
    }
#undef CHUNK_ROW0
#undef PREFETCH
#undef SCALARS
#undef WRITE_Q
#undef WRITE_KV
}
#undef MFMA32
#undef TR_WAIT
#undef CAT8
}

DI void phase_mixers(const Frame& F, const Args& a, int l, char* ldsg, int npass) {
    unsigned* head0 = (unsigned*)(F.ws + WS_CTL) + CW_QUEUE + 64 * l;
    volatile LAS unsigned* MISC = (volatile LAS unsigned*)(F.lds + LDS_BYTES - 64);
    const int n_ml = 64, n_la = 256, n_ga = 256, n_cx = (l == 0) ? 32 : 0, n_mix = n_ml + n_la + n_ga + 2 * n_cx;
    const int total = n_mix;
    const bf16_t* QLA = (const bf16_t*)(F.ws + WS_QLA); const bf16_t* KVLA = (const bf16_t*)(F.ws + WS_KVLA); const bf16_t* KR = (const bf16_t*)(F.ws + WS_KR);
    const bf16_t* QG = (const bf16_t*)(F.ws + WS_QG); const bf16_t* KG = (const bf16_t*)(F.ws + WS_KG); const bf16_t* P = (const bf16_t*)(F.ws + WS_P);
    bf16_t* YCAT = (bf16_t*)(F.ws + WS_YCAT);
#ifndef MK_MIX
#define MK_MIX 7
#endif
#define GRAB(u) do { __syncthreads(); if (F.tid == 0) MISC[4] = __hip_atomic_fetch_add(head, 1u, __ATOMIC_RELAXED, __HIP_MEMORY_SCOPE_AGENT); __syncthreads(); u = __builtin_amdgcn_readfirstlane((int)MISC[4]); } while (0)
    for (int pass = 0; pass < npass; ++pass) {
    unsigned* head = head0 + 128 * pass;
    int u0;
    GRAB(u0);
    while (u0 < n_ml) { if (MK_MIX & 1) ml::mlstm_unit2(F, a, l, u0, l == 0); GRAB(u0); }
    while (u0 < n_mix) {
        int u = u0 - n_ml;
        if (u < n_la) { const int b = u >> 6, h = (u >> 3) & 7, qb = u & 7; const long q0 = (long)b * SEQ + qb * 256;
            if (MK_MIX & 2) att::attn_body<64, 1536, 2048, 2048, 3072>(QLA + q0 * 1536 + h * 192, KVLA + h * 256, KR, KVLA + h * 256 + 128, YCAT + q0 * 3072 + 1024 + h * 128,
                                                      MLAT + b * CTXL, 4, b * SEQ, 32, 0.07216878364870322f, (const float*)(F.ws + WS_ROPE_LA) + (size_t)qb * 256 * 64, ldsg); }
        else if (u < n_la + n_ga) { u -= n_la; const int b = u >> 6, h = (u >> 3) & 7, qb = u & 7; const long q0 = (long)b * SEQ + qb * 256;
            if (MK_MIX & 4) att::attn_body<0, 1024, 256, NP, 3072>(QG + q0 * 1024 + h * 128, KG + (h >> 2) * 128, nullptr, P + C_GV + (h >> 2) * 128, YCAT + q0 * 3072 + 2048 + h * 128,
                                                  MLAT + b * CTXL, 4, b * SEQ, 32, 0.08838834764831845f, nullptr, ldsg); }
        else if (u < n_la + n_ga + n_cx) { u -= n_la + n_ga; const int b = u >> 3, h = u & 7; const long q0 = (long)MLAT + b * CTXL;
            if (MK_MIX & 2) att::attn_body<64, 1536, 2048, 2048, 3072>(QLA + q0 * 1536 + h * 192, KVLA + h * 256, KR, KVLA + h * 256 + 128, YCAT + q0 * 3072 + 1024 + h * 128,
                                                      MLAT + b * CTXL, 4, 0, 0, 0.07216878364870322f, nullptr, ldsg); }
        else { u -= n_la + n_ga + n_cx; const int b = u >> 3, h = u & 7; const long q0 = (long)MLAT + b * CTXL;
            if (MK_MIX & 4) att::attn_body<0, 1024, 256, NP, 3072>(QG + q0 * 1024 + h * 128, KG + (h >> 2) * 128, nullptr, P + C_GV + (h >> 2) * 128, YCAT + q0 * 3072 + 2048 + h * 128,
                                                  MLAT + b * CTXL, 4, 0, 0, 0.08838834764831845f, nullptr, ldsg); }
        GRAB(u0);
    }
    }
#undef GRAB
}

DI void phase_convert_tail(const Frame& F0, const Args& a, int l) {
    Frame F = F0; { int t_ = threadIdx.x; asm volatile("" : "+v"(t_)); F.tid = t_; F.lane = t_ & 63; F.wave = __builtin_amdgcn_readfirstlane(t_ >> 6); }
    constexpr int CVB = 64;
    unsigned* head = (unsigned*)(F.ws + WS_CTL) + CW_QUEUE + 64 * l + 32;
    volatile LAS unsigned* MISC = (volatile LAS unsigned*)(F.lds + LDS_BYTES - 64);
    const int n_cv = ((IT_LAYER - IT_EARLY) + ((l == 0) ? IT_EARLY : 0)) / CVB;
    LAS float* scr = (LAS float*)(F.lds + F.wave * 16384);
    for (;;) {
        __syncthreads();
        if (F.tid == 0) MISC[4] = __hip_atomic_fetch_add(head, 1u, __ATOMIC_RELAXED, __HIP_MEMORY_SCOPE_AGENT);
        __syncthreads();
        const int blk = __builtin_amdgcn_readfirstlane((int)MISC[4]);
        if (blk >= n_cv) break;
#pragma unroll 1
        for (int q = 0; q < CVB / NWAVES; ++q) { const int r = blk * CVB + q * NWAVES + F.wave;
            if (r < IT_LAYER - IT_EARLY) convert_item(F, a, l, IT_EARLY + r, scr); else convert_item(F, a, 1, r - (IT_LAYER - IT_EARLY), scr); }
    }
}

constexpr int FILL_BLK = 16, FILL_NBLK = IT_LAYER / FILL_BLK;
static_assert(IT_LAYER % FILL_BLK == 0, "fill blocks");
DI void fill_convert(const Frame& F0_, const Args& a, int ph, bool drain) {
    Frame F = F0_; { int t_ = threadIdx.x; asm volatile("" : "+v"(t_)); F.tid = t_; F.lane = t_ & 63; F.wave = __builtin_amdgcn_readfirstlane(t_ >> 6); }
    unsigned* ctl = (unsigned*)(F.ws + WS_CTL); unsigned* head = ctl + CW_CVHEAD; unsigned* done = ctl + CW_PHDONE + 64 * ph;
    volatile LAS unsigned* MISC = (volatile LAS unsigned*)(F.lds + LDS_BYTES - 64);
    LAS float* scr = (LAS float*)(F.lds + F.wave * 16384);
    __syncthreads();
    if (!drain && F.tid == 0) __hip_atomic_fetch_add(done, 1u, __ATOMIC_RELAXED, __HIP_MEMORY_SCOPE_AGENT);
    for (;;) {
        if (F.tid == 0) { unsigned blk = 0xffffffffu;
            if (drain || __hip_atomic_load(done, __ATOMIC_RELAXED, __HIP_MEMORY_SCOPE_AGENT) < (unsigned)F.G) blk = __hip_atomic_fetch_add(head, 1u, __ATOMIC_RELAXED, __HIP_MEMORY_SCOPE_AGENT);
            MISC[4] = blk; }
        __syncthreads();
        const unsigned blk = (unsigned)__builtin_amdgcn_readfirstlane((int)MISC[4]);
        __syncthreads();
        if (blk >= (unsigned)FILL_NBLK) break;
        convert_range(F, a, IT_LAYER + (int)blk * FILL_BLK + F.wave, NWAVES, IT_LAYER + ((int)blk + 1) * FILL_BLK, scr);
    }
}

DI void phase_convert_side(const Frame& F0_, const Args& a, int bid, int it_lo, int it_hi) {
    const int step = MK_CVSIDE, ncv = (256 + step - 1) / step;
    if (bid % step != 0 || F0_.G != 256) { if (F0_.G != 256) { Frame Fx = F0_; LAS float* scr = (LAS float*)(Fx.lds + Fx.wave * 16384); convert_range(Fx, a, it_lo + Fx.gw, Fx.ngw, it_hi, scr); } return; }
    Frame F = F0_; { int t_ = threadIdx.x; asm volatile("" : "+v"(t_)); F.tid = t_; F.lane = t_ & 63; F.wave = __builtin_amdgcn_readfirstlane(t_ >> 6); }
    LAS float* scr = (LAS float*)(F.lds + F.wave * 16384);
    const int j = bid / step, per = (it_hi - it_lo + ncv - 1) / ncv, lo = it_lo + j * per, hi = (lo + per < it_hi) ? lo + per : it_hi;
    convert_range(F, a, lo + F.wave, NWAVES, hi, scr);
    __syncthreads();
}

DI void phase_mlfin(const Frame& F, const Args& a, int l, int nrows) {
    const bf16_t* H0 = (const bf16_t*)(F.ws + WS_MLH); const bf16_t* H1 = H0 + (size_t)MTOT * 1024;
    const bf16_t* P = (const bf16_t*)(F.ws + WS_P); bf16_t* YCAT = (bf16_t*)(F.ws + WS_YCAT); const float* gn = a.in[I_MLNORM] + l * 1024;
    int row = F.gw; if (row >= nrows) return;
    s16x4 c0[4], c1[4]; s16x4 co[4];
#define MLF_LOAD(r_, a0, a1, ao) do { _Pragma("unroll") for (int hd = 0; hd < 4; ++hd) { const int c = hd * 256 + 4 * F.lane; a0[hd] = *(const s16x4*)(H0 + (size_t)(r_) * 1024 + c); a1[hd] = *(const s16x4*)(H1 + (size_t)(r_) * 1024 + c); \
        ao[hd] = *(const s16x4*)(P + (size_t)(r_) * NP + C_MLO + c); } } while (0)
    MLF_LOAD(row, c0, c1, co);
    f32x4 gv[4];
#pragma unroll
    for (int hd = 0; hd < 4; ++hd) gv[hd] = *(const f32x4*)(gn + hd * 256 + 4 * F.lane);
    for (;;) {
        const int nrow = row + F.ngw; const bool hn = nrow < nrows; const int pr = hn ? nrow : row;
        s16x4 n0[4], n1[4]; s16x4 no[4]; MLF_LOAD(pr, n0, n1, no);
#pragma unroll
        for (int hd = 0; hd < 4; ++hd) { const int c = hd * 256 + 4 * F.lane;
            const f32x4 v = (f32x4){bf2f((unsigned short)c0[hd][0]) + bf2f((unsigned short)c1[hd][0]), bf2f((unsigned short)c0[hd][1]) + bf2f((unsigned short)c1[hd][1]), bf2f((unsigned short)c0[hd][2]) + bf2f((unsigned short)c1[hd][2]), bf2f((unsigned short)c0[hd][3]) + bf2f((unsigned short)c1[hd][3])};
            const float rs = rsqrtf(wave_sum(v.x * v.x + v.y * v.y + v.z * v.z + v.w * v.w) * (1.f / 256.f) + EPS);
            const f32x4 g = gv[hd]; const s16x4 og = co[hd];
            u32x2 w; w.x = pk2(v.x * rs * g.x * sigmoidf_(bf2f((unsigned short)og[0])), v.y * rs * g.y * sigmoidf_(bf2f((unsigned short)og[1])));
            w.y = pk2(v.z * rs * g.z * sigmoidf_(bf2f((unsigned short)og[2])), v.w * rs * g.w * sigmoidf_(bf2f((unsigned short)og[3])));
            *(u32x2*)(YCAT + (size_t)row * 3072 + c) = w; }
        if (!hn) break;
#pragma unroll
        for (int hd = 0; hd < 4; ++hd) { c0[hd] = n0[hd]; c1[hd] = n1[hd]; co[hd] = no[hd]; }
        row = nrow;
    }
#undef MLF_LOAD
}

struct SchedMerge {
    const char* Y; const char* Bt; int nM, G, c;
    DI bool next(int i, Unit& u) const {
        int pm, pn, br;
        if (nM == 36 && G == 256) {
            const int j = c < 96 ? i - 1 : i;
            if (j < 0) { const int t = c / 3; br = (c - 3 * t) | 4; pm = 32 + (t >> 3); pn = t & 7; }
            else if (j < 3) { pg8::tile_of(c, 32, 8, pm, pn); br = j; }
            else return false;
        } else { const int k = i / 3; br = i - 3 * k; const long L = (long)k * G + c; if (L >= (long)nM * 8) return false; pg8::tile_of((int)L, nM, 8, pm, pn); }
        u.pm = pm; u.pn = pn; u.aux = br; u.nt = 16; u.pa = Y + (size_t)pm * 256 * 6144 + (br & 3) * 2048; u.pb = Bt + ((size_t)(br & 3) * 2048 + pn * 256) * 2048; return true;
    }
};
struct EpiMerge {
    const bf16_t* P; bf16_t* ZG; bf16_t* MB; bf16_t* CP; unsigned* cnt; unsigned* odone;
    DI void operator()(const f32x4 (&acc)[2][2][4][2], const Unit& u, int wr, int wc, int fr, int fq) const {
        const int br = u.aux & 3; const bool split = (u.aux & 4) != 0;
        EPI_FOREACH({
            const bf16x8 gp = *(const bf16x8*)(P + (size_t)row * NP + C_GATE + br * 2048 + col);
            f32x4 g0, g1;
            g0.x = sigmoidf_(bf2f((unsigned short)gp[0])); g0.y = sigmoidf_(bf2f((unsigned short)gp[1])); g0.z = sigmoidf_(bf2f((unsigned short)gp[2])); g0.w = sigmoidf_(bf2f((unsigned short)gp[3]));
            g1.x = sigmoidf_(bf2f((unsigned short)gp[4])); g1.y = sigmoidf_(bf2f((unsigned short)gp[5])); g1.z = sigmoidf_(bf2f((unsigned short)gp[6])); g1.w = sigmoidf_(bf2f((unsigned short)gp[7]));
            f32x4 r0 = v0 * g0, r1 = v1 * g1;
            const size_t off = (size_t)row * DM + col;
            if (split) { const u32x4 w_ = pack8(r0, r1); GAS unsigned long long* cp = (GAS unsigned long long*)(CP + ((size_t)br * MCTX + (row - MLAT)) * DM + col);
                __hip_atomic_store(cp, (unsigned long long)w_.x | ((unsigned long long)w_.y << 32), __ATOMIC_RELAXED, __HIP_MEMORY_SCOPE_AGENT);
                __hip_atomic_store(cp + 1, (unsigned long long)w_.z | ((unsigned long long)w_.w << 32), __ATOMIC_RELAXED, __HIP_MEMORY_SCOPE_AGENT); }
            else if (br < 2) *(u32x4*)(ZG + (size_t)br * MTOT * DM + off) = pack8(r0, r1);
            else { const bf16x8 z0 = *(const bf16x8*)(ZG + off), z1 = *(const bf16x8*)(ZG + (size_t)MTOT * DM + off);
                r0 += (f32x4){bf2f((unsigned short)z0[0]) + bf2f((unsigned short)z1[0]), bf2f((unsigned short)z0[1]) + bf2f((unsigned short)z1[1]), bf2f((unsigned short)z0[2]) + bf2f((unsigned short)z1[2]), bf2f((unsigned short)z0[3]) + bf2f((unsigned short)z1[3])};
                r1 += (f32x4){bf2f((unsigned short)z0[4]) + bf2f((unsigned short)z1[4]), bf2f((unsigned short)z0[5]) + bf2f((unsigned short)z1[5]), bf2f((unsigned short)z0[6]) + bf2f((unsigned short)z1[6]), bf2f((unsigned short)z0[7]) + bf2f((unsigned short)z1[7])};
                *(u32x4*)(MB + off) = pack8(r0, r1); }
        })
        if (split) {
            asm volatile("s_waitcnt vmcnt(0)" ::: "memory");
            unsigned old = 0;
            if ((fr | fq) == 0) old = __hip_atomic_fetch_add((GAS unsigned*)(cnt + (((u.pm - 32) * 8 + u.pn) * 8 + wr * 4 + wc) * 16), 1u, __ATOMIC_RELAXED, __HIP_MEMORY_SCOPE_AGENT);
            old = (unsigned)__builtin_amdgcn_readfirstlane((int)old);
            if (old == 2u) {
                EPI_FOREACH({
                    f32x4 r0 = (f32x4){0.f, 0.f, 0.f, 0.f}; f32x4 r1 = r0;
                    _Pragma("unroll") for (int ob = 0; ob < 3; ++ob) { const GAS unsigned long long* cp = (const GAS unsigned long long*)(CP + ((size_t)ob * MCTX + (row - MLAT)) * DM + col);
                        const unsigned long long a0 = __hip_atomic_load(cp, __ATOMIC_RELAXED, __HIP_MEMORY_SCOPE_AGENT), a1 = __hip_atomic_load(cp + 1, __ATOMIC_RELAXED, __HIP_MEMORY_SCOPE_AGENT);
                        r0 += (f32x4){bf2f((unsigned short)a0), bf2f((unsigned short)(a0 >> 16)), bf2f((unsigned short)(a0 >> 32)), bf2f((unsigned short)(a0 >> 48))};
                        r1 += (f32x4){bf2f((unsigned short)a1), bf2f((unsigned short)(a1 >> 16)), bf2f((unsigned short)(a1 >> 32)), bf2f((unsigned short)(a1 >> 48))}; }
                    (void)v0; (void)v1;
                    { const u32x4 w_ = pack8(r0, r1); GAS unsigned long long* mp = (GAS unsigned long long*)(MB + (size_t)row * DM + col);
                      __hip_atomic_store(mp, (unsigned long long)w_.x | ((unsigned long long)w_.y << 32), __ATOMIC_RELAXED, __HIP_MEMORY_SCOPE_AGENT);
                      __hip_atomic_store(mp + 1, (unsigned long long)w_.z | ((unsigned long long)w_.w << 32), __ATOMIC_RELAXED, __HIP_MEMORY_SCOPE_AGENT); }
                })
                asm volatile("s_waitcnt vmcnt(0)" ::: "memory");
                if ((fr | fq) == 0) __hip_atomic_fetch_add((GAS unsigned*)(odone + (u.pm - 32) * 16), 1u, __ATOMIC_RELAXED, __HIP_MEMORY_SCOPE_AGENT);
            }
        }
    }
};
struct SchedOutCtx {
    const char* A; const char* Bt; int c;
    DI bool next(int i, Unit& u) const {
        if (i != 0 || c < 96 || c >= 160) return false;
        const int t = (c - 96) >> 1, kh = (c - 96) & 1; const size_t ko = (size_t)kh * 2048;
        u.pm = 32 + (t >> 3); u.pn = t & 7; u.aux = 4 | kh; u.nt = 16; u.pa = A + (size_t)u.pm * 256 * (DM * 2) + ko; u.pb = Bt + (size_t)u.pn * 256 * (DM * 2) + ko; return true;
    }
};
struct EpiOut {
    const float* xin; const float* ctxin; float* X1; const float* mods; int l; bf16_t* CP; unsigned* cnt;
    DI void operator()(const f32x4 (&acc)[2][2][4][2], const Unit& u, int wr, int wc, int fr, int fq) const {
        if (u.aux & 4) {
            const int kh = u.aux & 1;
            EPI_FOREACH({ const u32x4 w_ = pack8(v0, v1); GAS unsigned long long* cp = (GAS unsigned long long*)(CP + ((size_t)kh * MCTX + (row - MLAT)) * DM + col);
                __hip_atomic_store(cp, (unsigned long long)w_.x | ((unsigned long long)w_.y << 32), __ATOMIC_RELAXED, __HIP_MEMORY_SCOPE_AGENT);
                __hip_atomic_store(cp + 1, (unsigned long long)w_.z | ((unsigned long long)w_.w << 32), __ATOMIC_RELAXED, __HIP_MEMORY_SCOPE_AGENT); })
            asm volatile("s_waitcnt vmcnt(0)" ::: "memory");
            unsigned old = 0;
            if ((fr | fq) == 0) old = __hip_atomic_fetch_add((GAS unsigned*)(cnt + (((u.pm - 32) * 8 + u.pn) * 8 + wr * 4 + wc) * 16), 1u, __ATOMIC_RELAXED, __HIP_MEMORY_SCOPE_AGENT);
            old = (unsigned)__builtin_amdgcn_readfirstlane((int)old);
            if (old == 1u) {
                EPI_FOREACH({
                    f32x4 r0 = (f32x4){0.f, 0.f, 0.f, 0.f}; f32x4 r1 = r0; (void)v0; (void)v1;
                    _Pragma("unroll") for (int ob = 0; ob < 2; ++ob) { const GAS unsigned long long* cp = (const GAS unsigned long long*)(CP + ((size_t)ob * MCTX + (row - MLAT)) * DM + col);
                        const unsigned long long a0 = __hip_atomic_load(cp, __ATOMIC_RELAXED, __HIP_MEMORY_SCOPE_AGENT), a1 = __hip_atomic_load(cp + 1, __ATOMIC_RELAXED, __HIP_MEMORY_SCOPE_AGENT);
                        r0 += (f32x4){bf2f((unsigned short)a0), bf2f((unsigned short)(a0 >> 16)), bf2f((unsigned short)(a0 >> 32)), bf2f((unsigned short)(a0 >> 48))};
                        r1 += (f32x4){bf2f((unsigned short)a1), bf2f((unsigned short)(a1 >> 16)), bf2f((unsigned short)(a1 >> 32)), bf2f((unsigned short)(a1 >> 48))}; }
                    const float* rp = ctxin + (size_t)(row - MLAT) * DM; const float* gp = mods + ((size_t)(l * 5 + 4) * 6 + 2) * DM + col; float* op = X1 + (size_t)row * DM + col;
                    *(f32x4*)op = *(const f32x4*)(rp + col) + *(const f32x4*)gp * r0; *(f32x4*)(op + 4) = *(const f32x4*)(rp + col + 4) + *(const f32x4*)(gp + 4) * r1;
                })
            }
            return;
        }
        f32x4 g[2][2];
#pragma unroll
        for (int bj = 0; bj < 2; ++bj) { const float* gp = mods + ((size_t)(l * 5 + mods_row(u.pm * 256)) * 6 + 2) * DM + u.pn * 256 + bj * 128 + wc * 32 + 8 * fq;
            g[bj][0] = *(const f32x4*)gp; g[bj][1] = *(const f32x4*)(gp + 4); }
        EPI_FOREACH({
            const float* rp = (l == 0) ? (row < MLAT ? xin + (size_t)row * DM : ctxin + (size_t)(row - MLAT) * DM) : X1 + (size_t)row * DM;
            float* op = X1 + (size_t)row * DM + col;
            *(f32x4*)op = *(const f32x4*)(rp + col) + g[bj][0] * v0; *(f32x4*)(op + 4) = *(const f32x4*)(rp + col + 4) + g[bj][1] * v1;
        })
    }
};
DI void phase_topk(const Frame& F, const Args& a, int l, int bid) {
    const float* AFF = (const float*)(F.ws + WS_AFF);
    int* ROWS = (int*)(F.ws + WS_ROWS); float* VALS = (float*)(F.ws + WS_VALS); int* TOK = (int*)(F.ws + WS_TOK);
    LAS unsigned* cntr = (LAS unsigned*)F.lds;
    LAS unsigned* cg = cntr + 64; LAS unsigned* ce = cntr + 96;
    const int nitems = (l == 0) ? 256 + 64 + 16 : 256;
    const int lane = F.lane, wave = F.wave;
    for (int it = bid; it < nitems; it += F.G) {
        if (it >= 320) {
            const int e = it - 320;
            for (int s = F.tid; s < 128; s += NTHR) { ROWS[e * ESLOT + 1152 + s] = -1; VALS[e * ESLOT + 1152 + s] = 0.f; }
            continue;
        }
        const int lat = it < 256, b = lat ? (it >> 6) : ((it - 256) >> 4), e = lat ? ((it >> 2) & 15) : ((it - 256) & 15), qtr = lat ? (it & 3) : 0;
        const int ntok = lat ? SEQ : CTXL, rowbase = lat ? b * SEQ : MLAT + b * CTXL, slotbase = lat ? b * 256 : 1024 + b * 32;
        const unsigned cap = (unsigned)(ntok >> 3);
        __syncthreads();
        if (F.tid < 128) cntr[F.tid] = 0u;
        unsigned key[4];
#pragma unroll
        for (int q = 0; q < 4; ++q) { const int i = q * 512 + F.tid; key[q] = i < ntok ? __float_as_uint(AFF[(size_t)e * MTOT + rowbase + i]) : 0u; }
        __syncthreads();
        unsigned T = 0u;
#pragma unroll 1
        for (int r = 0; r < 16; ++r) { const int sh = 30 - 2 * r;
            const unsigned c1 = T | (1u << sh), c2 = T | (2u << sh), c3 = T | (3u << sh);
            unsigned n1 = 0, n2 = 0, n3 = 0;
#pragma unroll
            for (int q = 0; q < 4; ++q) { n1 += (unsigned)__builtin_popcountll(__ballot(key[q] >= c1)); n2 += (unsigned)__builtin_popcountll(__ballot(key[q] >= c2)); n3 += (unsigned)__builtin_popcountll(__ballot(key[q] >= c3)); }
            if (lane == 0) { atomicAdd((unsigned*)(cntr + r * 4 + 0), n1); atomicAdd((unsigned*)(cntr + r * 4 + 1), n2); atomicAdd((unsigned*)(cntr + r * 4 + 2), n3); }
            __syncthreads();
            const unsigned t1 = cntr[r * 4 + 0], t2 = cntr[r * 4 + 1], t3 = cntr[r * 4 + 2];
            T = t3 >= cap ? c3 : (t2 >= cap ? c2 : (t1 >= cap ? c1 : T));
        }
        unsigned long long bg_own = 0ull, be_own = 0ull; unsigned kown = 0u;
#pragma unroll
        for (int q = 0; q < 4; ++q) { const unsigned long long bg = __ballot(key[q] > T), be = __ballot(key[q] == T);
            if (lane == 0) { cg[q * 8 + wave] = (unsigned)__builtin_popcountll(bg); ce[q * 8 + wave] = (unsigned)__builtin_popcountll(be); }
            if (q == qtr) { bg_own = bg; be_own = be; kown = key[q]; } }
        __syncthreads();
        unsigned ngt = 0, gtb = 0, eqb = 0; const int me = qtr * 8 + wave;
#pragma unroll 1
        for (int k = 0; k < 32; ++k) { const unsigned g = cg[k], q_ = ce[k]; ngt += g; if (k < me) { gtb += g; eqb += q_; } }
        const unsigned need = cap - ngt;
        const unsigned long long lt = (1ull << lane) - 1ull;
        const int i = qtr * 512 + F.tid; const bool act = i < ntok;
        const unsigned eqpos = eqb + (unsigned)__builtin_popcountll(be_own & lt);
        const bool sel = act && (kown > T || (kown == T && eqpos < need));
        const unsigned slot = gtb + (unsigned)__builtin_popcountll(bg_own & lt) + (eqpos < need ? eqpos : need);
        if (act) { TOK[(size_t)(rowbase + i) * 16 + e] = sel ? slotbase + (int)slot : -1;
            if (sel) { ROWS[e * ESLOT + slotbase + (int)slot] = rowbase + i; VALS[e * ESLOT + slotbase + (int)slot] = __uint_as_float(kown); } }
    }
    __syncthreads();
}
struct SchedMoe {
    const char* A; const char* Bt; int lda, ldb, nMt, nt, G, c, gather;
    DI bool next(int i, Unit& u) const {
        const long L0 = (long)i * G + c; const int nwg = NEXP * nMt * 8; if (L0 >= nwg) return false;
        const int L = ((int)L0 % 8) * (nwg / 8) + (int)L0 / 8;
        const int e = L / (nMt * 8), rem = L % (nMt * 8), mt = rem % nMt, pn = rem / nMt;
        u.pm = e * 5 + mt; u.pn = pn; u.aux = e; u.nt = nt; u.pa = gather ? A : A + ((size_t)e * ESLOT + mt * 256) * lda; u.pb = Bt + ((size_t)e * 2048 + pn * 256) * ldb; return true;
    }
};
struct EpiMoe1 {
    bf16_t* ACT;
    DI void operator()(const f32x4 (&acc)[2][2][4][2], const Unit& u, int wr, int wc, int fr, int fq) const {
#pragma unroll
        for (int ai = 0; ai < 2; ++ai)
#pragma unroll
            for (int m = 0; m < 4; ++m) { const int row = u.pm * 256 + ai * 128 + wr * 64 + m * 16 + fr; const int col = u.pn * 128 + wc * 32 + 8 * fq;
                f32x4 r0, r1;
#pragma unroll
                for (int i = 0; i < 4; ++i) { r0[i] = siluf_(acc[ai][0][m][0][i]) * acc[ai][1][m][0][i]; r1[i] = siluf_(acc[ai][0][m][1][i]) * acc[ai][1][m][1][i]; }
                *(u32x4*)(ACT + (size_t)row * EFF + col) = pack8(r0, r1); }
    }
};
struct EpiMoe2 {
    const float* VALS; bf16_t* YE;
    DI void operator()(const f32x4 (&acc)[2][2][4][2], const Unit& u, int wr, int wc, int fr, int fq) const {
        EPI_FOREACH({ const float val = VALS[row]; *(u32x4*)(YE + (size_t)row * DM + col) = pack8(v0 * val, v1 * val); })
    }
};
DI void phase_final(const Frame& F, const Args& a) {
    const float* g = a.in[I_FNORM]; const int* TOK = (const int*)(F.ws + WS_TOK); const float* X1 = (const float*)(F.ws + WS_X1);
    LAS float* gs = (LAS float*)F.lds;
    { const float* MODS = (const float*)(F.ws + WS_MODS);
      for (int i = F.tid; i < 4 * 512; i += NTHR) { const int r = i / 512, c4 = i % 512;
          *(LAS f32x4*)(gs + (size_t)r * DM + 4 * c4) = *(const f32x4*)(MODS + ((size_t)((DEPTH - 1) * 5 + r) * 6 + 5) * DM + 4 * c4); }
      __syncthreads(); }
    int row = F.gw; if (row >= MLAT) return;
    f32x4 cur[8]; load_row(X1 + (size_t)row * DM, F.lane, cur); int tcur = TOK[(size_t)row * 16 + (F.lane & 15)];
    f32x4 gv[8]; load_row(g, F.lane, gv);
    for (;;) {
        const int nrow = row + F.ngw; const bool hn = nrow < MLAT; const int pr = hn ? nrow : row;
        f32x4 nxt[8]; load_row(X1 + (size_t)pr * DM, F.lane, nxt); const int tnxt = TOK[(size_t)pr * 16 + (F.lane & 15)];
        f32x4 v[8]; float ss = 0.f;
        combine_row<true>(F, DEPTH - 1, row, cur, tcur, v, gs + (size_t)(row >> 11) * DM);
#pragma unroll
        for (int j = 0; j < 8; ++j) ss += v[j].x * v[j].x + v[j].y * v[j].y + v[j].z * v[j].z + v[j].w * v[j].w;
        const float rs = rsqrtf(wave_sum(ss) * (1.f / DM) + EPS);
#pragma unroll
        for (int j = 0; j < 8; ++j) *(f32x4*)(a.out + (size_t)row * DM + 4 * F.lane + 256 * j) = v[j] * rs * gv[j];
        if (!hn) break;
#pragma unroll
        for (int j = 0; j < 8; ++j) cur[j] = nxt[j];
        tcur = tnxt; row = nrow;
    }
}

#ifndef MK_LAST_PHASE
#define MK_LAST_PHASE 1000
#endif
constexpr int PH_PER_LAYER = 12, N_PHASES = 2 + 2 * PH_PER_LAYER + 1;
__global__ void __launch_bounds__(NTHR, 2) mega(const Args args) {
    extern __shared__ __attribute__((aligned(16))) unsigned char lds[];
    Frame F0;
    F0.lds = (LAS unsigned char*)lds; F0.ws = args.ws;
    F0.tid = threadIdx.x; F0.lane = F0.tid & 63; F0.wave = __builtin_amdgcn_readfirstlane(F0.tid >> 6);
    F0.G = gridDim.x; { const int bx = blockIdx.x; F0.vcu = (F0.G % 8 == 0) ? (bx % 8) * (F0.G / 8) + bx / 8 : bx; }
    F0.gw = F0.vcu * NWAVES + F0.wave; F0.ngw = F0.G * NWAVES;
    volatile LAS unsigned* MISC = (volatile LAS unsigned*)(F0.lds + LDS_BYTES - 64);
    if (F0.tid < 16) MISC[F0.tid] = 0u;
    __syncthreads();
    unsigned* ctl = (unsigned*)(F0.ws + WS_CTL);
    XcdBarrier bar = xcd_barrier_post(ctl + CW_BAR, MISC + 8);
    const int lo = args.ph_lo, hi = args.ph_hi;
    int ph = 0, bid = 0;
#ifndef MK_EN
#define MK_EN 0xFFFF
#endif
#define EN(x) ((MK_EN >> (x)) & 1)
#ifndef MK_REP
#define MK_REP 0
#endif
#ifndef MK_BARX
#define MK_BARX 0
#endif
#ifndef MK_REPB
#define MK_REPB 0
#endif
#ifndef MK_TPH
#define MK_TPH -1
#endif
#ifndef MK_TMODE
#define MK_TMODE 0
#endif
#ifndef MK_TQ
#define MK_TQ 40.f
#endif
#define REP(pid_) ((MK_REP >> (pid_)) & 1)
#define PHASE(pid_, ...) if (EN(pid_) && lo <= ph && ph < hi) { Frame F = F0; { unsigned long long w_ = (unsigned long long)F0.ws; asm volatile("" : "+s"(w_)); F.ws = (unsigned char*)w_; \
        asm volatile("" : "+s"(F.G), "+s"(F.vcu)); F.ngw = F.G * NWAVES; bid = blockIdx.x; asm volatile("" : "+s"(bid)); \
        int t_ = threadIdx.x; asm volatile("" : "+v"(t_)); F.tid = t_; F.lane = t_ & 63; F.wave = __builtin_amdgcn_readfirstlane(t_ >> 6); F.gw = F.vcu * NWAVES + F.wave; } \
        { const int rep = 0; (void)rep; __VA_ARGS__ } if (REP(pid_)) { if (MK_REPB) xcd_barrier(bar); const int rep = 1; (void)rep; __VA_ARGS__ } \
        if (MK_TPH >= 0 && threadIdx.x == 0) ((unsigned long long*)(F0.ws + WS_CTL + 1536 * 1024))[ph * 256 + blockIdx.x] = wall_clock64(); \
        if (ph + 1 < hi) { xcd_barrier(bar); if (MK_BARX) xcd_barrier(bar); } } ++ph;

#define PHASE5(...) if (EN(5) && lo <= ph && ph < hi) { Frame F = F0; { unsigned long long w_ = (unsigned long long)F0.ws; asm volatile("" : "+s"(w_)); F.ws = (unsigned char*)w_; \
        asm volatile("" : "+s"(F.G), "+s"(F.vcu)); F.ngw = F.G * NWAVES; bid = blockIdx.x; asm volatile("" : "+s"(bid)); \
        int t_ = threadIdx.x; asm volatile("" : "+v"(t_)); F.tid = t_; F.lane = t_ & 63; F.wave = __builtin_amdgcn_readfirstlane(t_ >> 6); F.gw = F.vcu * NWAVES + F.wave; } \
        { __VA_ARGS__ } if (MK_TPH >= 0 && threadIdx.x == 0) ((unsigned long long*)(F0.ws + WS_CTL + 1536 * 1024))[ph * 256 + blockIdx.x] = wall_clock64(); \
        if (ph + 1 < hi) { xcd_barrier(bar); if (MK_BARX) xcd_barrier(bar); } } ++ph;
    PHASE(0, phase_prologue(F, args, rep);)
    PHASE(14, phase_mods_reduce(F, args);)
    for (int l = 0; l < DEPTH; ++l) {
        const size_t wlo = WS_W + (size_t)l * W_LAYER;
        const int nM = (l == 0) ? 36 : 32;
        PHASE(1, if (MK_FILL && l == 1 && rep == 0) fill_convert(F, args, ph, true); phase_mod1(F, args, l);)
        PHASE(2, {
            SchedProj S{(const char*)(F.ws + WS_H), (const char*)(F.ws + wlo + W_IN), l, F.G, bid};
            EpiProj E{(bf16_t*)(F.ws + WS_P)};
            pg8::gemm_phase(F.lds, DM * 2, DM * 2, S, E); if (MK_FILL && l == 0 && rep == 0) fill_convert(F, args, ph, false); })
        PHASE(3, phase_postproj(F, args, l);)
        PHASE(4, {
            const bool defer = (l == 1 && F.G == 256);
            const int Gx = F.G - 36, xw = bid - Gx, BIG = 1 << 28, Gw = defer ? 144 : Gx, cw = bid < Gw ? bid : BIG;
            if (defer) { SchedDefer S{(const char*)(F.ws + WS_H), (const char*)(F.ws + wlo + W_IN), (bid >= 144 && bid < 220) ? bid - 144 : -1};
              EpiProj E{(bf16_t*)(F.ws + WS_P)}; pg8::gemm_phase(F.lds, DM * 2, DM * 2, S, E); }
            { SchedDense S{(const char*)(F.ws + WS_H), (const char*)(F.ws + wlo + W_IN) + (size_t)C_X * DM * 2, DM * 2, DM * 2, 36, 1, 32, 36, xw >= 0 ? xw : BIG};
              EpiX E{(bf16_t*)(F.ws + WS_KR), (float*)(F.ws + WS_X80), (const float*)(F.ws + WS_ROPE_LA)}; pg8::gemm_phase(F.lds, DM * 2, DM * 2, S, E); }
            { SchedDense S{(const char*)(F.ws + WS_CQN), (const char*)(F.ws + wlo + W_UQ), 512 * 2, 512 * 2, nM, 6, 8, Gw, cw};
              EpiStoreBf16 E{(bf16_t*)(F.ws + WS_QLA), 1536}; pg8::gemm_phase(F.lds, 512 * 2, 512 * 2, S, E); }
            { SchedDense S{(const char*)(F.ws + WS_CKVN), (const char*)(F.ws + wlo + W_UKV), 256 * 2, 256 * 2, 36, 8, 4, defer ? 96 : Gw, defer ? ((bid >= 48 && bid < 144) ? bid - 48 : BIG) : (bid < Gw ? (bid + Gw / 2) % Gw : BIG)};
              EpiStoreBf16 E{(bf16_t*)(F.ws + WS_KVLA), 2048}; pg8::gemm_phase(F.lds, 256 * 2, 256 * 2, S, E); }
            if (MK_FILL && l == 0 && rep == 0) fill_convert(F, args, ph, false); })
        PHASE5(if (MK_CVSIDE) phase_convert_side(F, args, bid, l == 0 ? IT_EARLY : IT_LAYER + IT_EARLY, l == 0 ? IT_LAYER + IT_EARLY : 2 * IT_LAYER); phase_mixers(F, args, l, (char*)lds, 1 + REP(5)); if (MK_CONVTAIL) phase_convert_tail(F, args, l);)
        PHASE(6, phase_mlfin(F, args, l, nM * 256);)
        PHASE(7, {
            SchedMerge S{(const char*)(F.ws + WS_YCAT), (const char*)(F.ws + wlo + W_BR), nM, F.G, bid};
            EpiMerge E{(const bf16_t*)(F.ws + WS_P), (bf16_t*)(F.ws + WS_MF32), (bf16_t*)(F.ws + WS_MBF), (bf16_t*)(F.ws + WS_H), (unsigned*)(F.ws + WS_CTL) + CW_MCNT, (unsigned*)(F.ws + WS_CTL) + CW_ODONE};
            pg8::gemm_phase(F.lds, 3072 * 2, 1024 * 2, S, E);
            if (l == 0 && F.G == 256 && bid >= 96 && bid < 160 && rep == 0) {
                unsigned* od = (unsigned*)(F.ws + WS_CTL) + CW_ODONE + (((bid - 96) >> 1) >> 3) * 16;
                if (F.tid == 0) { unsigned sp = 0; while (xb_ld(od) < 64u && ++sp < (1u << 22)) __builtin_amdgcn_s_sleep(2); }
                __syncthreads();
                __builtin_amdgcn_fence(__ATOMIC_ACQUIRE, "agent");
                SchedOutCtx S2{(const char*)(F.ws + WS_MBF), (const char*)(F.ws + wlo + W_OUT), bid};
                EpiOut E2{args.in[I_X], args.in[I_CTX], (float*)(F.ws + WS_X1), (const float*)(F.ws + WS_MODS), l, (bf16_t*)(F.ws + WS_H + (16u << 20)), (unsigned*)(F.ws + WS_CTL) + CW_OCNT};
                pg8::gemm_phase(F.lds, DM * 2, DM * 2, S2, E2); } })
        PHASE(8, {
            SchedDense S{(const char*)(F.ws + WS_MBF), (const char*)(F.ws + wlo + W_OUT), DM * 2, DM * 2, (l == 0 && F.G == 256) ? 32 : nM, 8, 32, F.G, bid};
            EpiOut E{args.in[I_X], args.in[I_CTX], (float*)(F.ws + WS_X1), (const float*)(F.ws + WS_MODS), l, nullptr, nullptr};
            if (rep == 0 || l == 0) pg8::gemm_phase(F.lds, DM * 2, DM * 2, S, E); if (MK_FILL && l == 0 && rep == 0) fill_convert(F, args, ph, false); })
        PHASE(9, phase_mod2(F, args, l, nM * 256);)
        PHASE(10, phase_topk(F, args, l, bid);)
        PHASE(11, {
            SchedMoe S{(const char*)(F.ws + WS_H), (const char*)(F.ws + wlo + W_E13), DM * 2, DM * 2, (l == 0) ? 5 : 4, 32, F.G, bid, 1};
            EpiMoe1 E{(bf16_t*)(F.ws + WS_ACT)};
            pg8::gemm_phase<true>(F.lds, DM * 2, DM * 2, S, E, (const int*)(F.ws + WS_ROWS)); if (MK_FILL && l == 0 && rep == 0) fill_convert(F, args, ph, false); })
        PHASE(12, {
            SchedMoe S{(const char*)(F.ws + WS_ACT), (const char*)(F.ws + wlo + W_E2), EFF * 2, EFF * 2, (l == 0) ? 5 : 4, 16, F.G, bid, 0};
            EpiMoe2 E{(const float*)(F.ws + WS_VALS), (bf16_t*)(F.ws + WS_YE)};
            pg8::gemm_phase(F.lds, EFF * 2, EFF * 2, S, E); if (MK_FILL && l == 0 && rep == 0) fill_convert(F, args, ph, false); })
    }
    PHASE(13, phase_final(F, args);)
    if (MK_TPH >= 0) {
        xcd_barrier(bar);
        if (blockIdx.x == 0 && threadIdx.x == 0) {
            const unsigned long long* st = (const unsigned long long*)(F0.ws + WS_CTL + 1536 * 1024);
            unsigned long long mx = 0, mxp = 0, sum = 0; const int G = gridDim.x;
            for (int bq = 0; bq < G; ++bq) { const unsigned long long e = st[MK_TPH * 256 + bq], p = st[(MK_TPH - 1) * 256 + bq]; mx = e > mx ? e : mx; mxp = p > mxp ? p : mxp; sum += e; }
            const float dur = MK_TMODE == 0 ? (float)(mx - mxp) * 0.01f : (float)((double)sum / G - (double)mxp) * 0.01f;
            args.out[0] = 20.f + floorf(dur / MK_TQ) * MK_TQ;
        }
    }
#undef PHASE
}


extern "C" void kernel_launch(void* const* d_in, const int* in_sizes, int n_in, void* d_out, int out_size, void* d_ws, size_t ws_size, hipStream_t stream) {
    static int grid = 0;
    if (grid == 0) {
        if (n_in != 24 || out_size != MLAT * DM || ws_size < WS_END) { fprintf(stderr, "kernel_launch: unexpected shapes: n_in %d out %d ws %zu (need %zu)\n", n_in, out_size, ws_size, (size_t)WS_END); grid = -1; return; }
        int dev = 0, cus = 0, per_cu = 0;
        if (hipGetDevice(&dev) != hipSuccess || hipDeviceGetAttribute(&cus, hipDeviceAttributeMultiprocessorCount, dev) != hipSuccess) { grid = -1; return; }
        if (hipFuncSetAttribute((const void*)mega, hipFuncAttributeMaxDynamicSharedMemorySize, LDS_BYTES) != hipSuccess) { fprintf(stderr, "kernel_launch: hipFuncSetAttribute failed\n"); grid = -1; return; }
        if (hipOccupancyMaxActiveBlocksPerMultiprocessor(&per_cu, (const void*)mega, NTHR, LDS_BYTES) != hipSuccess || per_cu < 1) { fprintf(stderr, "kernel_launch: occupancy query says %d blocks per CU\n", per_cu); }
        (void)hipGetLastError();
        grid = cus;
    }
    if (grid < 0) return;
    if (hipMemsetAsync((char*)d_ws + WS_CTL, 0, CTL_BYTES, stream) != hipSuccess) return;
    Args a{};
    for (int i = 0; i < 24; ++i) a.in[i] = (const float*)d_in[i];
    a.out = (float*)d_out; a.ws = (unsigned char*)d_ws; a.ph_lo = 0; a.ph_hi = N_PHASES < MK_LAST_PHASE ? N_PHASES : MK_LAST_PHASE;
    hipLaunchKernelGGL(mega, dim3(grid), dim3(NTHR), LDS_BYTES, stream, a);
}
```

```cpp
#include <hip/hip_runtime.h>
#include <cstdio>
#include <cstdint>

#define GAS __attribute__((address_space(1)))
#define LAS __attribute__((address_space(3)))
#define DI __device__ __forceinline__
typedef unsigned short bf16_t;
typedef short bf16x8 __attribute__((ext_vector_type(8)));
typedef short s16x4 __attribute__((ext_vector_type(4)));
typedef float f32x2 __attribute__((ext_vector_type(2)));
typedef float f32x4 __attribute__((ext_vector_type(4)));
typedef float f32x8 __attribute__((ext_vector_type(8)));
typedef float f32x16 __attribute__((ext_vector_type(16)));
typedef unsigned u32x2 __attribute__((ext_vector_type(2)));
typedef unsigned u32x4 __attribute__((ext_vector_type(4)));

constexpr int DM = 2048, NBATCH = 4, SEQ = 2048, CTXL = 256, DEPTH = 2;
constexpr int MLAT = NBATCH * SEQ, MCTX = NBATCH * CTXL, MTOT = MLAT + MCTX;
constexpr int PROJW = 12624, NP = 12800;
constexpr int C_MLQ = 0, C_MLK = 1024, C_MLV = 2048, C_MLO = 3072, C_CQ = 4096, C_CKV = 4608, C_GQ = 4864, C_GK = 5888, C_GV = 6144, C_GATE = 6400, C_X = 12544;
constexpr int XW = 80;
constexpr int NEXP = 16, EFF = 1024, ESLOT = 1280;
constexpr float EPS = 1e-6f;
constexpr int NWAVES = 8, NTHR = 512;

constexpr size_t al256(size_t x) { return (x + 255) / 256 * 256; }
constexpr size_t WS_CTL = 0, CTL_BYTES = 2u << 20;
constexpr int CW_BAR = 1024;
constexpr int CW_QUEUE = 8192;
constexpr int CW_CVHEAD = 12288;
constexpr int CW_MCNT = 20480;
constexpr int CW_OCNT = 24576;
constexpr int CW_ODONE = 28672;
constexpr int CW_E1CNT = 29696;
constexpr int CW_PHDONE = 32768;
constexpr size_t WS_MODS = 1u << 20;
constexpr size_t WS_ROPE_LA = WS_CTL + CTL_BYTES;
constexpr size_t WS_ROPE_GA = WS_ROPE_LA + al256((size_t)2048 * 32 * 2 * 4);
constexpr size_t WS_W = WS_ROPE_GA + al256((size_t)2048 * 64 * 2 * 4);
constexpr size_t W_IN = 0, W_UQ = W_IN + (size_t)NP * DM * 2, W_UKV = W_UQ + (size_t)1536 * 512 * 2, W_BR = W_UKV + (size_t)2048 * 256 * 2,
                 W_OUT = W_BR + (size_t)3 * 2048 * 1024 * 2, W_E13 = W_OUT + (size_t)2048 * 2048 * 2, W_E2 = W_E13 + (size_t)NEXP * 2048 * 2048 * 2,
                 W_LAYER = W_E2 + (size_t)NEXP * 2048 * 1024 * 2;
constexpr size_t WS_H = WS_W + 2 * W_LAYER;
constexpr size_t WS_P = WS_H + (size_t)MTOT * DM * 2;
constexpr size_t WS_AG = WS_P;
constexpr size_t WS_ACT = WS_AG + (size_t)NEXP * ESLOT * DM * 2;
static_assert(WS_ACT + (size_t)NEXP * ESLOT * EFF * 2 <= WS_P + (size_t)MTOT * NP * 2, "overlay");
constexpr size_t WS_X80 = WS_P + (size_t)MTOT * NP * 2;
constexpr size_t WS_CQN = WS_X80 + al256((size_t)MTOT * XW * 4);
constexpr size_t WS_CKVN = WS_CQN + (size_t)MTOT * 512 * 2;
constexpr size_t WS_QG = WS_CKVN + (size_t)MTOT * 256 * 2;
constexpr size_t WS_KG = WS_QG + (size_t)MTOT * 1024 * 2;
constexpr size_t WS_KR = WS_KG + (size_t)MTOT * 256 * 2;
constexpr size_t WS_QLA = WS_KR + (size_t)MTOT * 64 * 2;
constexpr size_t WS_KVLA = WS_QLA + (size_t)MTOT * 1536 * 2;
constexpr size_t WS_YCAT = WS_KVLA + (size_t)MTOT * 2048 * 2;
constexpr size_t WS_MF32 = WS_YCAT + (size_t)MTOT * 3072 * 2;
constexpr size_t WS_MLH = WS_MF32;
constexpr size_t WS_MBF = WS_MF32 + (size_t)MTOT * DM * 4;
constexpr size_t WS_X1 = WS_MBF + (size_t)MTOT * DM * 2;
constexpr size_t WS_AFF = WS_X1 + (size_t)MTOT * DM * 4;
constexpr size_t WS_ROWS = WS_AFF + (size_t)MTOT * 16 * 4;
constexpr size_t WS_VALS = WS_ROWS + (size_t)NEXP * ESLOT * 4;
constexpr size_t WS_TOK = WS_VALS + (size_t)NEXP * ESLOT * 4;
constexpr size_t WS_MPART = WS_TOK + (size_t)MTOT * 16 * 4;
constexpr size_t WS_END = WS_MPART + (size_t)16 * 2 * 5 * 12288 * 4;
constexpr size_t WS_YE = WS_AG;

constexpr int RING_BYTES = 131072;
constexpr int MISC_OFF = RING_BYTES + 1024;
constexpr int LDS_BYTES = 147456;

DI float bf2f(unsigned short b) { return __uint_as_float(((unsigned)b) << 16); }
DI unsigned f2bf(float f) { unsigned u = __float_as_uint(f); return (u + 0x7fffu + ((u >> 16) & 1u)) >> 16; }
DI unsigned pk2(float lo, float hi) { unsigned r; asm volatile("v_cvt_pk_bf16_f32 %0, %1, %2" : "=v"(r) : "v"(lo), "v"(hi)); return r; }
DI int lane_id_() { int l = __builtin_amdgcn_mbcnt_hi(~0u, __builtin_amdgcn_mbcnt_lo(~0u, 0u)); asm volatile("" : "+v"(l)); return l; }
DI float bperm_f(float v, int srclane) { return __int_as_float(__builtin_amdgcn_ds_bpermute(srclane << 2, __float_as_int(v))); }
DI float shx(float v, int o) { return bperm_f(v, lane_id_() ^ o); }
DI float shl_(float v, int src) { return bperm_f(v, src); }
DI float shu(float v, int o) { const int l = lane_id_(); return bperm_f(v, l >= o ? l - o : l); }
DI float wave_sum(float v) { const int l = lane_id_();
#pragma unroll
    for (int o = 1; o < 64; o <<= 1) v += bperm_f(v, l ^ o);
    return v;
}
DI float wave_max(float v) { const int l = lane_id_();
#pragma unroll
    for (int o = 1; o < 64; o <<= 1) v = fmaxf(v, bperm_f(v, l ^ o));
    return v;
}
DI float sigmoidf_(float x) { return __builtin_amdgcn_rcpf(1.f + __expf(-x)); }
DI float siluf_(float x) { return x * __builtin_amdgcn_rcpf(1.f + __expf(-x)); }
#define LDS_WAIT() asm volatile("s_waitcnt lgkmcnt(0)" ::: "memory")
#define VM_WAIT() asm volatile("s_waitcnt vmcnt(0)" ::: "memory")

#define XB_TMO      128
#define XB_XCNT(j)  (256  + 64 * (j))
#define XB_XSUB(j)  (1280 + 64 * (j))
#define XB_XGEN(j)  (2304 + 64 * (j))
#define XB_TOP      3328
#define XB_TOPGEN   3392
#define XCD_BAR_WORDS 3456
#define XB_SPIN_CAP (1u << 20)

DI unsigned xb_ld(unsigned* p)              { return __hip_atomic_load(p, __ATOMIC_RELAXED, __HIP_MEMORY_SCOPE_AGENT); }
DI unsigned xb_add(unsigned* p, unsigned v) { return __hip_atomic_fetch_add(p, v, __ATOMIC_RELAXED, __HIP_MEMORY_SCOPE_AGENT); }
DI unsigned xb_xcc_id() { return (unsigned)__builtin_amdgcn_s_getreg((3 << 11) | 20) & 0xFu; }
#define XB_SPIN(cond, bar) do { unsigned _sp = 0; while (cond) { __builtin_amdgcn_s_sleep(1); \
    if ((++_sp & 255u) == 0u) { if (xb_ld(&(bar)[XB_TMO])) break; if (_sp > XB_SPIN_CAP) { atomicAdd(&(bar)[XB_TMO], 1u); break; } } } } while (0)

struct XcdBarrier { unsigned* bar; unsigned x; volatile LAS unsigned* st; };

DI XcdBarrier xcd_barrier_post(unsigned* bar, volatile LAS unsigned* st) {
    XcdBarrier b; b.bar = bar; b.x = xb_xcc_id(); b.st = st;
    if (threadIdx.x == 0) (void)xb_add(&bar[XB_XCNT(b.x)], 1u);
    return b;
}
DI void xcd_barrier_complete(unsigned* bar, unsigned x, unsigned& nloc, unsigned& nx) {
    const unsigned G = gridDim.x * gridDim.y * gridDim.z;
    unsigned sum, cnt, mine, sp = 0u;
    for (;;) {
        sum = 0u; cnt = 0u; mine = 0u;
#pragma unroll
        for (unsigned j = 0; j < 16; ++j) { const unsigned c = xb_ld(&bar[XB_XCNT(j)]); sum += c; cnt += (c > 0u) ? 1u : 0u; mine = (j == x) ? c : mine; }
        if (sum == G) break;
        __builtin_amdgcn_s_sleep(1);
        if ((++sp & 255u) == 0u) { if (xb_ld(&bar[XB_TMO])) break; if (sp > XB_SPIN_CAP) { atomicAdd(&bar[XB_TMO], 1u); break; } }
    }
    nloc = mine > 0u ? mine : 1u; nx = cnt > 0u ? cnt : 1u;
}
DI void xcd_barrier(const XcdBarrier& b) {
    asm volatile("s_waitcnt vmcnt(0)" ::: "memory");
    __syncthreads();
    if (threadIdx.x == 0) {
        unsigned* bar = b.bar; asm volatile("" : "+s"(bar));
        __builtin_amdgcn_s_waitcnt(0);
        unsigned nloc = b.st[0], nx = b.st[1];
        unsigned bx = b.x; asm volatile("" : "+s"(bx));
        if (nloc == 0u) { xcd_barrier_complete(bar, bx, nloc, nx); b.st[0] = nloc; b.st[1] = nx; }
        const unsigned old = xb_add(&bar[XB_XSUB(bx)], 1u);
        const unsigned gen = old / nloc;
        if (old + 1u == (gen + 1u) * nloc) {
            __builtin_amdgcn_fence(__ATOMIC_RELEASE, "agent");
            asm volatile("s_waitcnt vmcnt(0)" ::: "memory");
            const unsigned og = xb_add(&bar[XB_TOP], 1u);
            const unsigned tg = og / nx;
            if (og + 1u == (tg + 1u) * nx) xb_add(&bar[XB_TOPGEN], 1u);
            else XB_SPIN(xb_ld(&bar[XB_TOPGEN]) == tg, bar);
            __builtin_amdgcn_fence(__ATOMIC_ACQUIRE, "agent");
            xb_add(&bar[XB_XGEN(bx)], 1u);
            asm volatile("s_waitcnt vmcnt(0)" ::: "memory");
        } else {
            XB_SPIN(xb_ld(&bar[XB_XGEN(bx)]) == gen, bar);
            __builtin_amdgcn_fence(__ATOMIC_ACQUIRE, "agent");
            asm volatile("s_waitcnt vmcnt(0)" ::: "memory");
        }
    }
    __syncthreads();
}

struct Args { const float* in[24]; float* out; unsigned char* ws; int ph_lo, ph_hi; };
enum { I_X = 0, I_C, I_CTX, I_CCTX, I_WMOD, I_BMOD, I_WIN, I_GBIAS, I_MLNORM, I_LAQN, I_LAKVN, I_UQ, I_UKV, I_GAQN, I_GAKN, I_BRML, I_BRLA, I_BRGA, I_WOUT, I_WROUTER, I_WE1, I_WE3, I_WE2, I_FNORM };

struct Frame {
    LAS unsigned char* lds;
    unsigned char* ws;
    int tid, lane, wave, G, vcu, gw, ngw;
};

DI int mods_row(int row) { return row < MLAT ? (row >> 11) : 4; }
DI const float* mods_ptr(const Frame& F, int l, int row, int which  ) {
    return (const float*)(F.ws + WS_MODS) + ((size_t)(l * 5 + mods_row(row)) * 6 + which) * DM;
}

namespace pg8 {
constexpr int BM = 256, BK = 64, HALF = 128, HTB = HALF * BK * 2, STAGE_BYTES = 8 * HTB, NXCD = 8, WGM = 8;
__host__ __device__ __forceinline__ int lds_byte(int r, int c) { const int st = (r >> 4) * 2 + (c >> 5), rr = r & 15, cc = c & 31, ob = rr * 64 + cc * 2; return st * 1024 + (ob ^ (((ob >> 9) & 1) << 5)); }
__host__ __device__ __forceinline__ void stage_rc(int b, int& R, int& C) { const int st = b / 1024, sb = b % 1024, swz = sb ^ (((sb >> 9) & 1) << 5); R = (st >> 1) * 16 + swz / 64; C = (st & 1) * 32 + (swz % 64) / 2; }
__host__ __device__ __forceinline__ int perm32(int rho) { const int n = rho >> 4, i = rho & 15; return 8 * (i >> 2) + 4 * n + (i & 3); }

struct Unit { const char* pa; const char* pb; int pm, pn, aux, nt; };

DI void tile_of(int L, int nM, int nN, int& pm, int& pn) {
    const int nwg = nM * nN; int wgid = L;
    { const int q = nwg / NXCD, r = nwg % NXCD, xcd = wgid % NXCD, off = wgid / NXCD; wgid = (xcd < r ? xcd * (q + 1) : r * (q + 1) + (xcd - r) * q) + off; }
    const int nig = WGM * nN, gid = wgid / nig, fm = gid * WGM, gsz = (nM - fm) < WGM ? (nM - fm) : WGM;
    pm = fm + ((wgid % nig) % gsz); pn = (wgid % nig) / gsz;
}

template <bool GATHER = false, class Epi, class Sched>
DI void gemm_phase(LAS unsigned char* lds, const int lda  , const int ldb  , const Sched& S, const Epi& E, const int* rows = nullptr) {
    int tid = threadIdx.x; asm volatile("" : "+v"(tid));
    const int wid = __builtin_amdgcn_readfirstlane(tid >> 6), lane = tid & 63, wr = wid >> 2, wc = wid & 3, fr = lane & 15, fq = lane >> 4;
    unsigned vA0[2], vA1[2], nA0[2], nA1[2], voffB[2]; int sR[2], sC[2];
#pragma unroll
    for (int i = 0; i < 2; ++i) { int R, C; stage_rc(tid * 16 + i * 8192, R, C); const int Rb = (R & ~31) + perm32(R & 31); sR[i] = R; sC[i] = C;
        vA0[i] = (unsigned)(R * lda + C * 2); vA1[i] = (unsigned)((R + HALF) * lda + C * 2); nA0[i] = vA0[i]; nA1[i] = vA1[i]; voffB[i] = (unsigned)(Rb * ldb + C * 2); }
#define PG8_GATHER_OFFS(u_, d0, d1) do { if (GATHER) { _Pragma("unroll") for (int i = 0; i < 2; ++i) { const int r0_ = rows[(u_).pm * 256 + sR[i]], r1_ = rows[(u_).pm * 256 + HALF + sR[i]]; \
        d0[i] = (unsigned)((r0_ < 0 ? 0 : r0_) * lda + sC[i] * 2); d1[i] = (unsigned)((r1_ < 0 ? 0 : r1_) * lda + sC[i] * 2); } } } while (0)
    const size_t kstep = (size_t)(BK * 2);
    const size_t hstepB = (size_t)HALF * ldb;
    const unsigned ldsw = (unsigned)wid * 1024u;
    const int aoff = lds_byte(wr * 64 + fr, fq * 8), boff = lds_byte(wc * 32 + fr, fq * 8);
#define PG8_SA(b, h) (((b) * 2 + (h)) * HTB)
#define PG8_SB(b, h) ((4 + (b) * 2 + (h)) * HTB)
#define PG8_STAGE(bufoff, gbase, voff) do { _Pragma("unroll") for (int _i = 0; _i < 2; ++_i) \
        __builtin_amdgcn_global_load_lds((const unsigned*)((const char*)(gbase) + (voff)[_i]), (LAS unsigned*)(lds + (bufoff) + ldsw + _i * 8192), 16, 0, 0); } while (0)
#define PG8_LDA(dst, b, h) do { _Pragma("unroll") for (int m = 0; m < 4; ++m) _Pragma("unroll") for (int k = 0; k < 2; ++k) dst[m][k] = *(const LAS bf16x8*)(lds + PG8_SA(b, h) + aoff + m * 2048 + k * 1024); } while (0)
#define PG8_LDB(dst, b, h) do { _Pragma("unroll") for (int n = 0; n < 2; ++n) _Pragma("unroll") for (int k = 0; k < 2; ++k) dst[n][k] = *(const LAS bf16x8*)(lds + PG8_SB(b, h) + boff + n * 2048 + k * 1024); } while (0)
#define PG8_MMA(ai, bj, At, Bt) do { __builtin_amdgcn_s_setprio(1); _Pragma("unroll") for (int m = 0; m < 4; ++m) _Pragma("unroll") for (int n = 0; n < 2; ++n) _Pragma("unroll") for (int k = 0; k < 2; ++k) \
        acc[ai][bj][m][n] = __builtin_amdgcn_mfma_f32_16x16x32_bf16(Bt[n][k], At[m][k], acc[ai][bj][m][n], 0, 0, 0); __builtin_amdgcn_s_setprio(0); } while (0)
#define PG8_WAIT_V(n) asm volatile("s_waitcnt vmcnt(" #n ")" ::: "memory")
#define PG8_WAIT_L(n) asm volatile("s_waitcnt lgkmcnt(" #n ")" ::: "memory")
#define PG8_BAR __builtin_amdgcn_s_barrier()
#define PG8_SCHED __builtin_amdgcn_sched_barrier(0)
    Unit cur, nxt; int ui = 0;
    if (!S.next(0, cur)) return;
    f32x4 acc[2][2][4][2];
#pragma unroll
    for (int a = 0; a < 2; ++a)
#pragma unroll
        for (int b = 0; b < 2; ++b)
#pragma unroll
            for (int m = 0; m < 4; ++m)
#pragma unroll
                for (int n = 0; n < 2; ++n) acc[a][b][m][n] = (f32x4){0.f, 0.f, 0.f, 0.f};
    bf16x8 At[4][2], B0[2][2], B1[2][2];
    const char* cA = cur.pa; const char* cB = cur.pb;
    PG8_GATHER_OFFS(cur, vA0, vA1);
    PG8_STAGE(PG8_SB(0, 0), cB, voffB); PG8_STAGE(PG8_SA(0, 0), cA, vA0); PG8_STAGE(PG8_SB(0, 1), cB + hstepB, voffB); PG8_STAGE(PG8_SA(0, 1), cA, vA1);
    if (wr == 1) PG8_BAR;
    PG8_WAIT_V(4); PG8_BAR;
    PG8_STAGE(PG8_SB(1, 0), cB + kstep, voffB); PG8_STAGE(PG8_SA(1, 0), cA + kstep, vA0); PG8_STAGE(PG8_SB(1, 1), cB + hstepB + kstep, voffB);
    PG8_WAIT_V(6); PG8_BAR;
    for (;;) {
        const bool has_next = S.next(ui + 1, nxt);
        const char* nA = has_next ? nxt.pa : cA; const char* nB = has_next ? nxt.pb : cB;
        if (GATHER) { if (has_next) PG8_GATHER_OFFS(nxt, nA0, nA1); else { _Pragma("unroll") for (int i = 0; i < 2; ++i) { nA0[i] = vA0[i]; nA1[i] = vA1[i]; } } }
        const int nt = cur.nt;
        for (int t = 0; t < nt; t += 2) {
            const bool last = (t == nt - 2);
            const char* a1 = cA + (size_t)(t + 1) * kstep;
            const char* a2 = last ? nA : cA + (size_t)(t + 2) * kstep; const char* b2 = last ? nB : cB + (size_t)(t + 2) * kstep;
            const char* a3 = a2 + kstep; const char* b3 = b2 + kstep;
            unsigned wA0[2], wA1[2];
            _Pragma("unroll") for (int i = 0; i < 2; ++i) { wA0[i] = last ? nA0[i] : vA0[i]; wA1[i] = last ? nA1[i] : vA1[i]; }
            PG8_LDB(B0, 0, 0); PG8_SCHED; PG8_LDA(At, 0, 0); PG8_STAGE(PG8_SA(1, 1), a1, vA1);
            PG8_WAIT_L(8); PG8_BAR; PG8_WAIT_L(0); PG8_MMA(0, 0, At, B0); PG8_BAR; PG8_SCHED;
            PG8_LDB(B1, 0, 1); PG8_STAGE(PG8_SB(0, 0), b2, voffB);
            PG8_BAR; PG8_WAIT_L(0); PG8_MMA(0, 1, At, B1); PG8_BAR;
            PG8_LDA(At, 0, 1); PG8_STAGE(PG8_SA(0, 0), a2, wA0);
            PG8_BAR; PG8_WAIT_L(0); PG8_MMA(1, 0, At, B0); PG8_BAR; PG8_SCHED;
            PG8_STAGE(PG8_SB(0, 1), b2 + hstepB, voffB);
            PG8_WAIT_V(6); PG8_BAR; PG8_MMA(1, 1, At, B1); PG8_BAR;
            PG8_LDB(B0, 1, 0); PG8_SCHED; PG8_LDA(At, 1, 0); PG8_STAGE(PG8_SA(0, 1), a2, wA1);
            PG8_WAIT_L(8); PG8_BAR; PG8_WAIT_L(0); PG8_MMA(0, 0, At, B0); PG8_BAR; PG8_SCHED;
            PG8_LDB(B1, 1, 1); PG8_STAGE(PG8_SB(1, 0), b3, voffB);
            PG8_BAR; PG8_WAIT_L(0); PG8_MMA(0, 1, At, B1); PG8_BAR;
            PG8_LDA(At, 1, 1); PG8_STAGE(PG8_SA(1, 0), a3, wA0);
            PG8_BAR; PG8_WAIT_L(0); PG8_MMA(1, 0, At, B0); PG8_BAR; PG8_SCHED;
            PG8_STAGE(PG8_SB(1, 1), b3 + hstepB, voffB);
            PG8_WAIT_V(6); PG8_BAR; PG8_MMA(1, 1, At, B1); PG8_BAR;
        }
        E(acc, cur, wr, wc, fr, fq);
        if (!has_next) break;
#pragma unroll
        for (int a = 0; a < 2; ++a)
#pragma unroll
            for (int b = 0; b < 2; ++b)
#pragma unroll
                for (int m = 0; m < 4; ++m)
#pragma unroll
                    for (int n = 0; n < 2; ++n) acc[a][b][m][n] = (f32x4){0.f, 0.f, 0.f, 0.f};
        cur = nxt; cA = nA; cB = nB; ++ui;
        if (GATHER) { _Pragma("unroll") for (int i = 0; i < 2; ++i) { vA0[i] = nA0[i]; vA1[i] = nA1[i]; } }
    }
    PG8_WAIT_V(0);
    if (wr == 0) PG8_BAR;
    PG8_BAR;
#undef PG8_GATHER_OFFS
#undef PG8_SA
#undef PG8_SB
#undef PG8_STAGE
#undef PG8_LDA
#undef PG8_LDB
#undef PG8_MMA
#undef PG8_WAIT_V
#undef PG8_WAIT_L
#undef PG8_BAR
#undef PG8_SCHED
}
}
using pg8::Unit;

struct SchedDense {
    const char* A; const char* Bt; int lda, ldb, nM, nN, nt, G, c;
    DI bool next(int i, Unit& u) const {
        const long L = (long)i * G + c; if (L >= (long)nM * nN) return false;
        int pm, pn; pg8::tile_of((int)L, nM, nN, pm, pn);
        u.pm = pm; u.pn = pn; u.aux = 0; u.nt = nt; u.pa = A + (size_t)pm * 256 * lda; u.pb = Bt + (size_t)pn * 256 * ldb; return true;
    }
};

struct SchedProj {
    const char* A; const char* Bt; int l, G, c;
    DI bool next(int i, Unit& u) const {
        const long L = (long)i * G + c; int pm, pn;
        if (l == 0) { if (L >= 36 * 49) return false; pg8::tile_of((int)L, 36, 49, pm, pn); }
        else if (G == 256) {
            if (L >= 32 * 47 + 8 + 24) return false;
            if (L < 32 * 47) pg8::tile_of((int)L, 32, 47, pm, pn);
            else if (L < 32 * 47 + 8) { const int r = (int)L - 32 * 47; pm = 32 + (r >> 1); pn = (r & 1) ? 23 : 18; }
            else { pm = (int)L - (32 * 47 + 8); pn = 47; } }
        else { if (L >= 32 * 49 + 44) return false;
            if (L < 32 * 49) pg8::tile_of((int)L, 32, 49, pm, pn);
            else { const int r = (int)L - 32 * 49, j = r % 11; pm = 32 + r / 11; pn = j < 8 ? 4 + j : (j == 8 ? 18 : (j == 9 ? 23 : 24)); } }
        u.pm = pm; u.pn = pn; u.aux = 0; u.nt = 32; u.pa = A + (size_t)pm * 256 * (DM * 2); u.pb = Bt + (size_t)pn * 256 * (DM * 2); return true;
    }
};

struct SchedDefer {
    const char* A; const char* Bt; int c;
    DI bool next(int i, Unit& u) const {
        if (i != 0 || c < 0 || c >= 76) return false;
        int pm, pn;
        if (c < 8) { pm = 24 + c; pn = 47; }
        else if (c < 40) { pm = c - 8; pn = 48; }
        else { const int r = c - 40, j = r % 9; pm = 32 + r / 9; pn = j < 8 ? 4 + j : 24; }
        u.pm = pm; u.pn = pn; u.aux = 0; u.nt = 32; u.pa = A + (size_t)pm * 256 * (DM * 2); u.pb = Bt + (size_t)pn * 256 * (DM * 2); return true;
    }
};

#define EPI_FOREACH(...) \
    _Pragma("unroll") for (int ai = 0; ai < 2; ++ai) _Pragma("unroll") for (int m = 0; m < 4; ++m) { const int row = u.pm * 256 + ai * 128 + wr * 64 + m * 16 + fr; \
    _Pragma("unroll") for (int bj = 0; bj < 2; ++bj) { const int col = u.pn * 256 + bj * 128 + wc * 32 + 8 * fq; const f32x4 v0 = acc[ai][bj][m][0], v1 = acc[ai][bj][m][1]; __VA_ARGS__ } }

DI u32x4 pack8(const f32x4 v0, const f32x4 v1) { u32x4 w; w.x = pk2(v0[0], v0[1]); w.y = pk2(v0[2], v0[3]); w.z = pk2(v1[0], v1[1]); w.w = pk2(v1[2], v1[3]); return w; }

struct EpiStoreBf16 {
    bf16_t* O; int ldc;
    DI void operator()(const f32x4 (&acc)[2][2][4][2], const Unit& u, int wr, int wc, int fr, int fq) const {
        EPI_FOREACH({ *(u32x4*)(O + (size_t)row * ldc + col) = pack8(v0, v1); })
    }
};
struct EpiProj {
    bf16_t* P;
    DI void operator()(const f32x4 (&acc)[2][2][4][2], const Unit& u, int wr, int wc, int fr, int fq) const {
        EPI_FOREACH({ *(u32x4*)(P + (size_t)row * NP + col) = pack8(v0, v1); })
    }
};
struct EpiX {
    bf16_t* KR; float* X80; const float* rla;
    DI void operator()(const f32x4 (&acc)[2][2][4][2], const Unit& u, int wr, int wc, int fr, int fq) const {
#pragma unroll
        for (int ai = 0; ai < 2; ++ai)
#pragma unroll
            for (int m = 0; m < 4; ++m) { const int row = u.pm * 256 + ai * 128 + wr * 64 + m * 16 + fr; const bool lat = row < MLAT; const int t = row & 2047;
#pragma unroll
                for (int n = 0; n < 2; ++n) { const f32x4 v = acc[ai][0][m][n];
                    f32x4 pr; pr.x = shx(v.x, 32); pr.y = shx(v.y, 32); pr.z = shx(v.z, 32); pr.w = shx(v.w, 32);
                    if (wc < 2) {
                        const int idx = 8 * (fq & 1) + 4 * n; f32x4 o = v;
                        if (lat) { const float* cs = rla + ((size_t)t * 32 + wc * 16 + idx) * 2; const f32x4 c0 = *(const f32x4*)cs, c1 = *(const f32x4*)(cs + 4);
                            if (fq < 2) { o.x = v.x * c0.x - pr.x * c0.y; o.y = v.y * c0.z - pr.y * c0.w; o.z = v.z * c1.x - pr.z * c1.y; o.w = v.w * c1.z - pr.w * c1.w; }
                            else        { o.x = pr.x * c0.y + v.x * c0.x; o.y = pr.y * c0.w + v.y * c0.z; o.z = pr.z * c1.y + v.z * c1.x; o.w = pr.w * c1.w + v.w * c1.z; } }
                        u32x2 w2; w2.x = pk2(o.x, o.y); w2.y = pk2(o.z, o.w);
                        *(u32x2*)(KR + (size_t)row * 64 + 32 * wc + 8 * fq + 4 * n) = w2;
                    } else if (wc == 2 && fq < 2) *(f32x4*)(X80 + (size_t)row * XW + 64 + 8 * fq + 4 * n) = v;
                } }
    }
};

DI int win_src_col(int n) {
    if (n < 4096) return n;
    if (n < 4608) return n - 4096 + 4112;
    if (n < 4864) return n - 4608 + 4624;
    if (n < 5888) return n - 4864 + 4944;
    if (n < 6144) return n - 5888 + 5968;
    if (n < 6400) return n - 6144 + 6224;
    if (n < 12544) return n - 6400 + 6480;
    if (n < 12608) return n - 12544 + 4880;
    if (n < 12624) return n - 12608 + 4096;
    return -1;
}
DI void transpose_item(const float* W, int ldw, int K, bf16_t* WT, int k0, int n0, int srcc, LAS float* scr, int lane) {
#pragma unroll 8
    for (int i = 0; i < 32; ++i) { const int kk = 2 * i + (lane >> 5); scr[kk * 33 + (lane & 31)] = srcc >= 0 ? W[(size_t)(k0 + kk) * ldw + srcc] : 0.f; }
    LDS_WAIT(); asm volatile("" ::: "memory");
    const int c = lane & 7;
#pragma unroll
    for (int j = 0; j < 4; ++j) { const int n = (lane >> 3) + 8 * j; const LAS float* s = scr + (8 * c) * 33 + n;
        u32x4 o; o.x = pk2(s[0 * 33], s[1 * 33]); o.y = pk2(s[2 * 33], s[3 * 33]); o.z = pk2(s[4 * 33], s[5 * 33]); o.w = pk2(s[6 * 33], s[7 * 33]);
        *(u32x4*)(WT + (size_t)(n0 + n) * K + k0 + 8 * c) = o; }
    LDS_WAIT(); asm volatile("" ::: "memory");
}

constexpr int IT_IN = 32 * 400, IT_UQ = 8 * 48, IT_UKV = 4 * 64, IT_BR = 16 * 64, IT_OUT = 32 * 64, IT_E13 = 32 * 64, IT_E2 = 16 * 64;
constexpr int IT_EARLY = IT_IN + IT_UQ + IT_UKV, IT_LAYER = IT_EARLY + 3 * IT_BR + IT_OUT + NEXP * IT_E13 + NEXP * IT_E2;
struct CvDesc { const float* src; size_t ld2; bf16_t* dst; int K; };
DI CvDesc cv_make(const float* W, int ldw, int K, bf16_t* WT, int k0, int n0, int srcc, int lane) {
    CvDesc d; d.src = srcc >= 0 ? W + (size_t)(k0 + (lane >> 5)) * ldw + srcc : nullptr; d.ld2 = 2 * (size_t)ldw; d.dst = WT + (size_t)n0 * K + k0; d.K = K; return d; }
DI CvDesc cv_desc(const Frame& F, const Args& a, int l, int r) {
    unsigned char* wl = F.ws + WS_W + (size_t)l * W_LAYER;
    const int lane = F.lane, ln = lane & 31;
    if (r < IT_IN) { const int kb = r / 400, nb = r % 400; return cv_make(a.in[I_WIN] + (size_t)l * DM * PROJW, PROJW, DM, (bf16_t*)(wl + W_IN), 64 * kb, 32 * nb, win_src_col(32 * nb + ln), lane); } r -= IT_IN;
    if (r < IT_UQ) { const int kb = r / 48, nb = r % 48; return cv_make(a.in[I_UQ] + (size_t)l * 512 * 1536, 1536, 512, (bf16_t*)(wl + W_UQ), 64 * kb, 32 * nb, 32 * nb + ln, lane); } r -= IT_UQ;
    if (r < IT_UKV) { const int kb = r / 64, nb = r % 64; return cv_make(a.in[I_UKV] + (size_t)l * 256 * 2048, 2048, 256, (bf16_t*)(wl + W_UKV), 64 * kb, 32 * nb, 32 * nb + ln, lane); } r -= IT_UKV;
    if (r < 3 * IT_BR) { const int br = r / IT_BR, q = r % IT_BR, kb = q / 64, nb = q % 64;
        return cv_make(a.in[I_BRML + br] + (size_t)l * 1024 * 2048, 2048, 1024, (bf16_t*)(wl + W_BR) + (size_t)br * 2048 * 1024, 64 * kb, 32 * nb, 32 * nb + ln, lane); } r -= 3 * IT_BR;
    if (r < IT_OUT) { const int kb = r / 64, nb = r % 64; return cv_make(a.in[I_WOUT] + (size_t)l * 2048 * 2048, 2048, 2048, (bf16_t*)(wl + W_OUT), 64 * kb, 32 * nb, 32 * nb + ln, lane); } r -= IT_OUT;
    if (r < NEXP * IT_E13) { const int e = r / IT_E13, q = r % IT_E13, kb = q / 64, nb = q % 64;
        const int n0 = 32 * nb, j = n0 >> 8, half = (n0 >> 7) & 1, cc = n0 & 127;
        return cv_make(a.in[half ? I_WE3 : I_WE1] + ((size_t)l * NEXP + e) * 2048 * 1024, 1024, 2048, (bf16_t*)(wl + W_E13) + (size_t)e * 2048 * 2048, 64 * kb, n0, j * 128 + cc + ln, lane); } r -= NEXP * IT_E13;
    { const int e = r / IT_E2, q = r % IT_E2, kb = q / 64, nb = q % 64;
        return cv_make(a.in[I_WE2] + ((size_t)l * NEXP + e) * 1024 * 2048, 2048, 1024, (bf16_t*)(wl + W_E2) + (size_t)e * 2048 * 1024, 64 * kb, 32 * nb, 32 * nb + ln, lane); }
}
DI void cv_load(const CvDesc& d, float (&v)[32]) {
#pragma unroll
    for (int i = 0; i < 32; ++i) v[i] = d.src ? __builtin_nontemporal_load(d.src + (size_t)i * d.ld2) : 0.f;
}
DI void cv_store(const CvDesc& d, const float (&v)[32], LAS float* scr, int lane) {
#pragma unroll
    for (int i = 0; i < 32; ++i) scr[(2 * i + (lane >> 5)) * 33 + (lane & 31)] = v[i];
    LDS_WAIT(); asm volatile("" ::: "memory");
    const int c = lane & 7;
#pragma unroll
    for (int j = 0; j < 4; ++j) { const int n = (lane >> 3) + 8 * j; const LAS float* s = scr + (8 * c) * 33 + n;
        u32x4 o; o.x = pk2(s[0 * 33], s[1 * 33]); o.y = pk2(s[2 * 33], s[3 * 33]); o.z = pk2(s[4 * 33], s[5 * 33]); o.w = pk2(s[6 * 33], s[7 * 33]);
        *(u32x4*)(d.dst + (size_t)n * d.K + 8 * c) = o; }
    LDS_WAIT(); asm volatile("" ::: "memory");
}
DI void convert_range(const Frame& F, const Args& a, int first, int stride, int n_items, LAS float* scr) {
    int it = first; if (it >= n_items) return;
    CvDesc cur = cv_desc(F, a, it / IT_LAYER, it % IT_LAYER); float v[32]; cv_load(cur, v);
    for (;;) {
        const int nx = it + stride; const bool hn = nx < n_items; const int pn = hn ? nx : it;
        const CvDesc nd = cv_desc(F, a, pn / IT_LAYER, pn % IT_LAYER); float wv[32]; cv_load(nd, wv);
        cv_store(cur, v, scr, F.lane);
        if (!hn) break;
        cur = nd; it = nx;
#pragma unroll
        for (int i = 0; i < 32; ++i) v[i] = wv[i];
    }
}
DI void convert_item(const Frame& F, const Args& a, int l, int r, LAS float* scr) {
    const CvDesc d = cv_desc(F, a, l, r); float v[32]; cv_load(d, v); cv_store(d, v, scr, F.lane);
}

DI void phase_prologue(const Frame& F, const Args& a, int rep) {
    LAS float* scr = (LAS float*)(F.lds + F.wave * 16384);
    if (rep == 0) {
        const float* c = a.in[I_C]; const float* cctx = a.in[I_CCTX]; const float* wmod = a.in[I_WMOD];
        constexpr int NIT = 2 * 48 * 16;
        for (int it = F.gw; it < NIT; it += F.ngw) {
            const int l = it / 768, rem = it % 768, cb = rem / 16, kp = rem % 16, k0 = kp * 128, j0 = cb * 256 + F.lane * 4;
#pragma unroll
            for (int i = 0; i < 10; ++i) { const int idx = F.lane + 64 * i, r = idx >> 7, kk = idx & 127; const float v = r < 4 ? c[r * DM + k0 + kk] : cctx[k0 + kk]; scr[idx] = siluf_(v); }
            LDS_WAIT(); asm volatile("" ::: "memory");
            f32x4 acc[5];
#pragma unroll
            for (int r = 0; r < 5; ++r) acc[r] = (f32x4){0.f, 0.f, 0.f, 0.f};
            const float* wp = wmod + ((size_t)l * DM + k0) * (6 * DM) + j0;
#pragma unroll 8
            for (int kk = 0; kk < 128; ++kk) { const f32x4 w = __builtin_nontemporal_load((const f32x4*)(wp + (size_t)kk * (6 * DM)));
#pragma unroll
                for (int r = 0; r < 5; ++r) acc[r] += w * scr[r * 128 + kk]; }
#pragma unroll
            for (int r = 0; r < 5; ++r) *(f32x4*)((float*)(F.ws + WS_MPART) + ((size_t)(kp * 2 + l) * 5 + r) * (6 * DM) + j0) = acc[r];
            LDS_WAIT(); asm volatile("" ::: "memory");
        }
    }
    {
        float* rla = (float*)(F.ws + WS_ROPE_LA); float* rga = (float*)(F.ws + WS_ROPE_GA);
        const int gt = F.gw * 64 + F.lane, ngt = F.ngw * 64;
        for (int i = gt; i < 2048 * 32; i += ngt) { const int t = i >> 5, aidx = i & 31, ax = aidx >> 4, fi = aidx & 15;
            const float inv = exp2f(-(float)fi * (13.287712379549449f / 16.f)); const float ang = (float)(ax ? (t & 63) : (t >> 6)) * inv;
            rla[2 * i] = cosf(ang); rla[2 * i + 1] = sinf(ang); }
        for (int i = gt; i < 2048 * 64; i += ngt) { const int t = i >> 6, aidx = i & 63, ax = aidx >> 5, fi = aidx & 31;
            const float inv = exp2f(-(float)fi * (13.287712379549449f / 32.f)); const float ang = (float)(ax ? (t & 63) : (t >> 6)) * inv;
            rga[2 * i] = cosf(ang); rga[2 * i + 1] = sinf(ang); }
    }
#ifndef MK_CONVTAIL
#define MK_CONVTAIL 0
#endif
#ifndef MK_FILL
#define MK_FILL 0
#endif
#ifndef MK_CVSIDE
#define MK_CVSIDE 2
#endif
#ifndef MK_CVFROM
#define MK_CVFROM IT_EARLY
#endif
    if (MK_CONVTAIL) { for (int it = F.gw; it < IT_EARLY; it += F.ngw) convert_item(F, a, 0, it, scr); }
    else convert_range(F, a, F.gw, F.ngw, MK_CVSIDE ? MK_CVFROM : (MK_FILL ? IT_LAYER : 2 * IT_LAYER), scr);
}

DI void phase_mods_reduce(const Frame& F, const Args& a) {
    float* mods = (float*)(F.ws + WS_MODS); const float* part = (const float*)(F.ws + WS_MPART); const float* bmod = a.in[I_BMOD];
    const int gt = F.gw * 64 + F.lane, ngt = F.ngw * 64;
    for (int i = gt; i < 2 * 5 * 12288 / 4; i += ngt) { const int l = i / (5 * 3072), j4 = i % 3072;
        f32x4 s = *(const f32x4*)(bmod + (size_t)l * 12288 + 4 * j4);
#pragma unroll
        for (int kp = 0; kp < 16; ++kp) s += *(const f32x4*)(part + (size_t)kp * (2 * 5 * 12288) + 4 * (size_t)i);
        *(f32x4*)(mods + 4 * (size_t)i) = s; }
}

DI const float* resid_row(const Frame& F, const Args& a, int l, int row) {
    if (l == 0) return row < MLAT ? a.in[I_X] + (size_t)row * DM : a.in[I_CTX] + (size_t)(row - MLAT) * DM;
    return (const float*)(F.ws + WS_X1) + (size_t)row * DM;
}
DI void load_row(const float* p, int lane, f32x4 (&v)[8]) {
#pragma unroll
    for (int j = 0; j < 8; ++j) v[j] = *(const f32x4*)(p + 4 * lane + 256 * j);
}
template <bool G2LDS = false>
DI void combine_row(const Frame& F, int lp, int row, const f32x4 (&x)[8], int tokv, f32x4 (&v)[8], const LAS float* g2l = nullptr) {
    const bf16_t* YE = (const bf16_t*)(F.ws + WS_YE);
    f32x4 s[8];
#pragma unroll
    for (int j = 0; j < 8; ++j) s[j] = (f32x4){0.f, 0.f, 0.f, 0.f};
    unsigned mask = (unsigned)__ballot(tokv >= 0) & 0xffffu;
    while (mask) {
        const int e0 = __builtin_ctz(mask); mask &= mask - 1u; const bool two = mask != 0u; const int e1 = two ? __builtin_ctz(mask) : e0; mask &= mask - 1u;
        const int slot0 = __builtin_amdgcn_readlane(tokv, e0), slot1 = __builtin_amdgcn_readlane(tokv, e1);
        const bf16_t* y0r = YE + ((size_t)e0 * ESLOT + slot0) * DM; const bf16_t* y1r = YE + ((size_t)e1 * ESLOT + slot1) * DM;
        s16x4 y0[8], y1[8];
#pragma unroll
        for (int j = 0; j < 8; ++j) { y0[j] = *(const s16x4*)(y0r + 4 * F.lane + 256 * j); y1[j] = *(const s16x4*)(y1r + 4 * F.lane + 256 * j); }
#pragma unroll
        for (int j = 0; j < 8; ++j) s[j] += (f32x4){bf2f((unsigned short)y0[j][0]), bf2f((unsigned short)y0[j][1]), bf2f((unsigned short)y0[j][2]), bf2f((unsigned short)y0[j][3])};
        if (two) {
#pragma unroll
            for (int j = 0; j < 8; ++j) s[j] += (f32x4){bf2f((unsigned short)y1[j][0]), bf2f((unsigned short)y1[j][1]), bf2f((unsigned short)y1[j][2]), bf2f((unsigned short)y1[j][3])}; }
    }
    if (G2LDS) {
#pragma unroll
        for (int j = 0; j < 8; ++j) v[j] = x[j] + s[j] * *(const LAS f32x4*)(g2l + 4 * F.lane + 256 * j); }
    else { const float* g2 = mods_ptr(F, lp, row, 5);
#pragma unroll
        for (int j = 0; j < 8; ++j) v[j] = x[j] + s[j] * *(const f32x4*)(g2 + 4 * F.lane + 256 * j); }
}
DI void modulate_vals(const Frame& F, const f32x4 (&v)[8], const float* sh, const float* sc, bf16_t* hrow, f32x4 (&hv)[8]) {
    float ss = 0.f;
#pragma unroll
    for (int j = 0; j < 8; ++j) ss += v[j].x * v[j].x + v[j].y * v[j].y + v[j].z * v[j].z + v[j].w * v[j].w;
    const float rs = rsqrtf(wave_sum(ss) * (1.f / DM) + EPS);
#pragma unroll
    for (int j = 0; j < 8; ++j) { const f32x4 s1 = *(const f32x4*)(sc + 4 * F.lane + 256 * j), s0 = *(const f32x4*)(sh + 4 * F.lane + 256 * j);
        const f32x4 h = v[j] * rs * (s1 + 1.f) + s0; hv[j] = h;
        u32x2 w; w.x = pk2(h.x, h.y); w.y = pk2(h.z, h.w); *(u32x2*)(hrow + 4 * F.lane + 256 * j) = w; }
}
DI void phase_mod1(const Frame& F, const Args& a, int l) {
    bf16_t* H = (bf16_t*)(F.ws + WS_H); const int* TOK = (const int*)(F.ws + WS_TOK);
    LAS float* ms = (LAS float*)F.lds;
    { const float* MODS = (const float*)(F.ws + WS_MODS);
      for (int i = F.tid; i < 5 * 3 * 512; i += NTHR) { const int r = i / 1536, w = (i / 512) % 3, c4 = i % 512;
          if (w == 2 && l == 0) continue;
          const int ll = w == 2 ? l - 1 : l, which = w == 2 ? 5 : w;
          f32x4 val = *(const f32x4*)(MODS + ((size_t)(ll * 5 + r) * 6 + which) * DM + 4 * c4); if (w == 1) val += 1.f;
          *(LAS f32x4*)(ms + (size_t)(r * 3 + w) * DM + 4 * c4) = val; }
      __syncthreads(); }
    int row = F.gw; if (row >= MTOT) return;
    f32x4 cur[8]; int tcur = 0;
    load_row(resid_row(F, a, l, row), F.lane, cur); if (l > 0) tcur = TOK[(size_t)row * 16 + (F.lane & 15)];
    for (;;) {
        const int nrow = row + F.ngw; const bool hn = nrow < MTOT; const int pr = hn ? nrow : row;
        f32x4 nxt[8]; int tnxt = 0;
        load_row(resid_row(F, a, l, pr), F.lane, nxt); if (l > 0) tnxt = TOK[(size_t)pr * 16 + (F.lane & 15)];
        f32x4 v[8];
        if (l == 0) {
#pragma unroll
            for (int j = 0; j < 8; ++j) v[j] = cur[j]; }
        const LAS float* mr = ms + (size_t)mods_row(row) * 3 * DM;
        if (l != 0) { combine_row<true>(F, l - 1, row, cur, tcur, v, mr + 2 * DM); float* xw = (float*)(F.ws + WS_X1) + (size_t)row * DM;
#pragma unroll
            for (int j = 0; j < 8; ++j) *(f32x4*)(xw + 4 * F.lane + 256 * j) = v[j]; }
        { float ss = 0.f;
#pragma unroll
          for (int j = 0; j < 8; ++j) ss += v[j].x * v[j].x + v[j].y * v[j].y + v[j].z * v[j].z + v[j].w * v[j].w;
          const float rs = rsqrtf(wave_sum(ss) * (1.f / DM) + EPS);
          bf16_t* hrow = H + (size_t)row * DM;
#pragma unroll
          for (int j = 0; j < 8; ++j) { const f32x4 h = v[j] * rs * *(const LAS f32x4*)(mr + DM + 4 * F.lane + 256 * j) + *(const LAS f32x4*)(mr + 4 * F.lane + 256 * j);
              u32x2 w; w.x = pk2(h.x, h.y); w.y = pk2(h.z, h.w); *(u32x2*)(hrow + 4 * F.lane + 256 * j) = w; } }
        if (!hn) break;
#pragma unroll
        for (int j = 0; j < 8; ++j) cur[j] = nxt[j];
        tcur = tnxt; row = nrow;
    }
}
DI void phase_mod2(const Frame& F, const Args& a, int l, int nrows) {
    bf16_t* H = (bf16_t*)(F.ws + WS_H); float* AFF = (float*)(F.ws + WS_AFF);
    LAS float* wr = (LAS float*)F.lds;
    const float* wsrc = a.in[I_WROUTER] + (size_t)l * DM * NEXP;
    for (int i = F.tid; i < DM * NEXP / 4; i += NTHR) { const f32x4 w4 = ((const f32x4*)wsrc)[i]; const int c = i >> 2, e0 = (i & 3) * 4;
        wr[(e0 + 0) * DM + c] = w4.x; wr[(e0 + 1) * DM + c] = w4.y; wr[(e0 + 2) * DM + c] = w4.z; wr[(e0 + 3) * DM + c] = w4.w; }
    __syncthreads();
    const float* X1 = (const float*)(F.ws + WS_X1);
    auto router = [&](const f32x4 (&hv)[8], int row) {
        float lg[16];
#pragma unroll
        for (int e = 0; e < 16; ++e) lg[e] = 0.f;
#pragma unroll
        for (int j = 0; j < 8; ++j)
#pragma unroll
            for (int e = 0; e < 16; ++e) { const f32x4 w = *(const LAS f32x4*)(wr + e * DM + 4 * F.lane + 256 * j); lg[e] += hv[j].x * w.x + hv[j].y * w.y + hv[j].z * w.z + hv[j].w * w.w; }
        float mx = -1e30f;
#pragma unroll
        for (int e = 0; e < 16; ++e) { lg[e] = wave_sum(lg[e]); mx = fmaxf(mx, lg[e]); }
        float den = 0.f;
#pragma unroll
        for (int e = 0; e < 16; ++e) { lg[e] = __expf(lg[e] - mx); den += lg[e]; }
        const float inv = 1.f / den;
        float mine = 0.f;
#pragma unroll
        for (int e = 0; e < 16; ++e) mine = (F.lane == e) ? lg[e] * inv : mine;
        if (F.lane < 16) AFF[(size_t)F.lane * MTOT + row] = mine;
    };
    const int crow = MLAT + F.gw; const bool hasc = crow < nrows;
    f32x4 cur[8];
    for (int base = 4 * F.gw; base < MLAT; base += 4 * F.ngw) {
        load_row(X1 + (size_t)base * DM, F.lane, cur);
        f32x4 s1[8], s0[8];
        { const float* sh = mods_ptr(F, l, base, 3); const float* sc = mods_ptr(F, l, base, 4);
#pragma unroll
          for (int j = 0; j < 8; ++j) { s1[j] = *(const f32x4*)(sc + 4 * F.lane + 256 * j) + 1.f; s0[j] = *(const f32x4*)(sh + 4 * F.lane + 256 * j); } }
#pragma unroll 1
        for (int k = 0; k < 4; ++k) { const int row = base + k; f32x4 hv[8];
            { const int pr = k < 3 ? row + 1 : (hasc ? crow : row); f32x4 nxt[8]; load_row(X1 + (size_t)pr * DM, F.lane, nxt);
              float ss = 0.f;
#pragma unroll
              for (int j = 0; j < 8; ++j) ss += cur[j].x * cur[j].x + cur[j].y * cur[j].y + cur[j].z * cur[j].z + cur[j].w * cur[j].w;
              const float rs = rsqrtf(wave_sum(ss) * (1.f / DM) + EPS);
              bf16_t* hrow = H + (size_t)row * DM;
#pragma unroll
              for (int j = 0; j < 8; ++j) { const f32x4 h = cur[j] * rs * s1[j] + s0[j]; hv[j] = h;
                  u32x2 w; w.x = pk2(h.x, h.y); w.y = pk2(h.z, h.w); *(u32x2*)(hrow + 4 * F.lane + 256 * j) = w; }
#pragma unroll
              for (int j = 0; j < 8; ++j) cur[j] = nxt[j]; }
            router(hv, row);
        }
    }
    if (hasc) {
        if (4 * F.gw >= MLAT) load_row(X1 + (size_t)crow * DM, F.lane, cur);
        for (int row = crow; row < nrows; row += F.ngw) { f32x4 hv[8];
            modulate_vals(F, cur, mods_ptr(F, l, row, 3), mods_ptr(F, l, row, 4), H + (size_t)row * DM, hv);
            router(hv, row);
            if (row + F.ngw < nrows) load_row(X1 + (size_t)(row + F.ngw) * DM, F.lane, cur); }
    }
    __syncthreads();
}

DI void phase_postproj(const Frame& F, const Args& a, int l) {
    const bf16_t* P = (const bf16_t*)(F.ws + WS_P);
    bf16_t* CQN = (bf16_t*)(F.ws + WS_CQN); bf16_t* CKVN = (bf16_t*)(F.ws + WS_CKVN); bf16_t* QG = (bf16_t*)(F.ws + WS_QG); bf16_t* KG = (bf16_t*)(F.ws + WS_KG);
    const float* qn = a.in[I_LAQN] + l * 512; const float* kvn = a.in[I_LAKVN] + l * 256; const float* gqn = a.in[I_GAQN] + l * 128; const float* gkn = a.in[I_GAKN] + l * 128;
    const float* rga = (const float*)(F.ws + WS_ROPE_GA);
    const int lane = F.lane;
    const f32x4 qg0 = *(const f32x4*)(qn + 8 * lane), qg1 = *(const f32x4*)(qn + 8 * lane + 4), kg0 = *(const f32x4*)(kvn + 4 * lane);
    const int hq = lane >> 4, ax = (lane >> 3) & 1, seg = lane & 7, eo = ax * 64 + 4 * seg;
    const f32x4 gqa = *(const f32x4*)(gqn + eo), gqb = *(const f32x4*)(gqn + eo + 32), gka = *(const f32x4*)(gkn + eo), gkb = *(const f32x4*)(gkn + eo + 32);
    struct Raw { bf16x8 xq; s16x4 xkv; s16x4 ha[3], hb[3]; f32x4 r0, r1; };
    auto load = [&](int row, Raw& R) { const bf16_t* pr = P + (size_t)row * NP; const int t = row & 2047;
        R.xq = *(const bf16x8*)(pr + C_CQ + 8 * lane); R.xkv = *(const s16x4*)(pr + C_CKV + 4 * lane);
#pragma unroll
        for (int p = 0; p < 3; ++p) { const int hh = p < 2 ? 4 * p + hq : 8 + (hq & 1); const bf16_t* src = pr + C_GQ + hh * 128;
            R.ha[p] = *(const s16x4*)(src + eo); R.hb[p] = *(const s16x4*)(src + eo + 32); }
        const float* rp = rga + ((size_t)t * 64 + ax * 32 + 4 * seg) * 2; R.r0 = *(const f32x4*)rp; R.r1 = *(const f32x4*)(rp + 4); };
    static_assert(C_GK == C_GQ + 8 * 128, "q and k heads contiguous");
    int row = F.gw; if (row >= MTOT) return;
    Raw cur; load(row, cur);
    for (;;) {
        const int nrow = row + F.ngw; const bool hn = nrow < MTOT; Raw nxt; load(hn ? nrow : row, nxt);
        const bool lat = row < MLAT; const bool needq = lat || l == 0;
        if (needq) {
            float f[8]; float ss = 0.f;
#pragma unroll
            for (int i = 0; i < 8; ++i) { f[i] = bf2f((unsigned short)cur.xq[i]); ss += f[i] * f[i]; }
            const float rs = rsqrtf(wave_sum(ss) * (1.f / 512.f) + EPS);
            u32x4 w; w.x = pk2(f[0] * rs * qg0.x, f[1] * rs * qg0.y); w.y = pk2(f[2] * rs * qg0.z, f[3] * rs * qg0.w); w.z = pk2(f[4] * rs * qg1.x, f[5] * rs * qg1.y); w.w = pk2(f[6] * rs * qg1.z, f[7] * rs * qg1.w);
            *(u32x4*)(CQN + (size_t)row * 512 + 8 * lane) = w;
        }
        {
            float f[4]; float ss = 0.f;
#pragma unroll
            for (int i = 0; i < 4; ++i) { f[i] = bf2f((unsigned short)cur.xkv[i]); ss += f[i] * f[i]; }
            const float rs = rsqrtf(wave_sum(ss) * (1.f / 256.f) + EPS);
            u32x2 w; w.x = pk2(f[0] * rs * kg0.x, f[1] * rs * kg0.y); w.y = pk2(f[2] * rs * kg0.z, f[3] * rs * kg0.w);
            *(u32x2*)(CKVN + (size_t)row * 256 + 4 * lane) = w;
        }
        const float cs[4] = {cur.r0.x, cur.r0.z, cur.r1.x, cur.r1.z}, sn[4] = {cur.r0.y, cur.r0.w, cur.r1.y, cur.r1.w};
        const int ln = lane_id_();
#pragma unroll
        for (int p = 0; p < 3; ++p) {
            if (p < 2 && !needq) continue;
            float xa[4], xb[4]; float ss = 0.f;
#pragma unroll
            for (int i = 0; i < 4; ++i) { xa[i] = bf2f((unsigned short)cur.ha[p][i]); xb[i] = bf2f((unsigned short)cur.hb[p][i]); ss += xa[i] * xa[i] + xb[i] * xb[i]; }
#pragma unroll
            for (int o = 1; o < 16; o <<= 1) ss += bperm_f(ss, ln ^ o);
            const float rs = rsqrtf(ss * (1.f / 128.f) + EPS);
            const f32x4 ga = p < 2 ? gqa : gka, gb = p < 2 ? gqb : gkb;
            float oa[4], ob[4];
#pragma unroll
            for (int i = 0; i < 4; ++i) { const float ya = xa[i] * rs * ga[i], yb = xb[i] * rs * gb[i]; oa[i] = lat ? ya * cs[i] - yb * sn[i] : ya; ob[i] = lat ? ya * sn[i] + yb * cs[i] : yb; }
            bf16_t* dst = p < 2 ? QG + (size_t)row * 1024 + (4 * p + hq) * 128 : KG + (size_t)row * 256 + (hq & 1) * 128;
            if (p < 2 || hq < 2) { u32x2 wa, wb; wa.x = pk2(oa[0], oa[1]); wa.y = pk2(oa[2], oa[3]); wb.x = pk2(ob[0], ob[1]); wb.y = pk2(ob[2], ob[3]);
                *(u32x2*)(dst + eo) = wa; *(u32x2*)(dst + eo + 32) = wb; }
        }
        if (!hn) break;
        cur = nxt; row = nrow;
    }
}

namespace att {
constexpr int QBLK = 32, KVBLK = 64;
#define SBAR() __builtin_amdgcn_sched_barrier(0)
DI int crow(int r, int hi) { return (r & 3) + 8 * (r >> 2) + 4 * hi; }
DI int v_st(int k, int c) { const int kk = (k & ~0xC) | ((k & 4) << 1) | ((k & 8) >> 1); return ((kk >> 3) * 4 + (c >> 5)) * 512 + ((kk & 7) * 32 + (c & 31)) * 2; }
DI int v_rd_base(int lane) { return ((lane & 3) << 3) | (((lane >> 2) & 3) << 6) | (((lane >> 4) & 1) << 5) | (((lane >> 5) & 1) << 8); }
constexpr int v_rd_off(int d0, int ks, int half) { return d0 * 512 + ks * 4096 + half * 2048; }
template <int OFF> DI s16x4 tr_read(int vb) { s16x4 r; asm volatile("ds_read_b64_tr_b16 %0, %1 offset:%2" : "=&v"(r) : "v"(vb), "i"(OFF) : "memory"); return r; }
template <int D0> DI void pv_one(f32x16& od, int vb, bf16x8 pa0, bf16x8 pa1, bf16x8 pa2, bf16x8 pa3) {
  const s16x4 l0 = tr_read<v_rd_off(D0, 0, 0)>(vb), h0 = tr_read<v_rd_off(D0, 0, 1)>(vb), l1 = tr_read<v_rd_off(D0, 1, 0)>(vb), h1 = tr_read<v_rd_off(D0, 1, 1)>(vb);
  const s16x4 l2 = tr_read<v_rd_off(D0, 2, 0)>(vb), h2 = tr_read<v_rd_off(D0, 2, 1)>(vb), l3 = tr_read<v_rd_off(D0, 3, 0)>(vb), h3 = tr_read<v_rd_off(D0, 3, 1)>(vb);
  asm volatile("s_waitcnt lgkmcnt(0)" ::: "memory"); SBAR();
#define PK(L, H) (bf16x8){L[0], L[1], L[2], L[3], H[0], H[1], H[2], H[3]}
  od = __builtin_amdgcn_mfma_f32_32x32x16_bf16(pa0, PK(l0, h0), od, 0, 0, 0);
  od = __builtin_amdgcn_mfma_f32_32x32x16_bf16(pa1, PK(l1, h1), od, 0, 0, 0);
  od = __builtin_amdgcn_mfma_f32_32x32x16_bf16(pa2, PK(l2, h2), od, 0, 0, 0);
  od = __builtin_amdgcn_mfma_f32_32x32x16_bf16(pa3, PK(l3, h3), od, 0, 0, 0);
#undef PK
}
DI void pv_d0(f32x16* o, int vb, bf16x8 pa0, bf16x8 pa1, bf16x8 pa2, bf16x8 pa3) {
  pv_one<0>(o[0], vb, pa0, pa1, pa2, pa3); pv_one<1>(o[1], vb, pa0, pa1, pa2, pa3); pv_one<2>(o[2], vb, pa0, pa1, pa2, pa3); pv_one<3>(o[3], vb, pa0, pa1, pa2, pa3);
}
template <int DKX, int LDQ, int LDK, int LDV, int LDO, int SDEPTH = 1>
DI void attn_body(const bf16_t* __restrict__ Qb, const bf16_t* __restrict__ Km, const bf16_t* __restrict__ Kx, const bf16_t* __restrict__ Vm, bf16_t* __restrict__ Ob,
                  int kr0, int nt0, int kr1, int nt1, float scale, const float* __restrict__ ropeq  , char* lds) {
  constexpr int ND0 = 8 + DKX / 16, KROWB = (128 + DKX) * 2, SHM_V = KVBLK * 128 * 2, SHM_K = KVBLK * KROWB;
  constexpr float THR = 8.f;
#define KSWZ(row, colB) ((row) * KROWB + ((colB) ^ (((row) & 7) << 4)))
  int tid = threadIdx.x; asm volatile("" : "+v"(tid));
  const int wid = __builtin_amdgcn_readfirstlane(tid >> 6), lane = tid & 63, r32 = lane & 31, hi = lane >> 5;
  char* V_lds = lds; char* K_lds = lds + 2 * SHM_V;
  float* ws = (float*)(lds + 2 * SHM_V + 2 * SHM_K) + wid * 64; float* li_l = ws; float* al_l = ws + 32;
  const float C = scale * 1.4426950408889634f;
  float m_reg = -1e30f, l_reg = 0; f32x16 o[4] = {}; bf16x8 qr[8];
  const bf16_t* Qw = Qb + (long)(wid * QBLK + r32) * LDQ + hi * 8;
#pragma unroll
  for (int d0 = 0; d0 < 8; ++d0) qr[d0] = *reinterpret_cast<const bf16x8*>(Qw + d0 * 16);
  char* QX = lds + 2 * SHM_V + 2 * SHM_K + 2048 + (wid * 4 * 64 + lane) * 16;
  if constexpr (DKX > 0) {
#pragma unroll
    for (int ax = 0; ax < 2; ++ax) {
      const bf16x8 xa = *reinterpret_cast<const bf16x8*>(Qw + 128 + ax * 32), xb = *reinterpret_cast<const bf16x8*>(Qw + 128 + ax * 32 + 16);
      if (ropeq) {
        const float* cs = ropeq + ((size_t)(wid * QBLK + r32) * 32 + ax * 16 + hi * 8) * 2;
        float oa[8], ob[8];
#pragma unroll
        for (int j = 0; j < 8; ++j) { const float c = cs[2 * j], sn = cs[2 * j + 1], a = bf2f((unsigned short)xa[j]), b = bf2f((unsigned short)xb[j]); oa[j] = a * c - b * sn; ob[j] = a * sn + b * c; }
        u32x4 wa = {pk2(oa[0], oa[1]), pk2(oa[2], oa[3]), pk2(oa[4], oa[5]), pk2(oa[6], oa[7])}, wb = {pk2(ob[0], ob[1]), pk2(ob[2], ob[3]), pk2(ob[4], ob[5]), pk2(ob[6], ob[7])};
        *reinterpret_cast<u32x4*>(QX + (2 * ax) * 1024) = wa; *reinterpret_cast<u32x4*>(QX + (2 * ax + 1) * 1024) = wb;
      } else { *reinterpret_cast<bf16x8*>(QX + (2 * ax) * 1024) = xa; *reinterpret_cast<bf16x8*>(QX + (2 * ax + 1) * 1024) = xb; }
    }
  }
  const int sr = tid >> 4, sc = (tid & 15) * 8, vst0 = v_st(sr, sc), vst1 = v_st(32 + sr, sc);
  const int xr = tid >> 3, xc = (tid & 7) * 8;
  const int vb0 = (int)(uintptr_t)V_lds + v_rd_base(lane);
  const int offV = sr * LDV + sc, offK = sr * LDK + sc, offX = xr * 64 + xc;
  struct { bf16x8 vs0, vs1, ks0, ks1, kx; } sr_[SDEPTH];
  const int NT = nt0 + nt1;
#define TROW(j) ((j) < nt0 ? kr0 + (j) * KVBLK : kr1 + ((j) - nt0) * KVBLK)
#define SLOAD(i, j) do { const long _r = TROW(j); const bf16_t* _vt = Vm + _r * LDV; const bf16_t* _kt = Km + _r * LDK; \
    sr_[i].vs0 = *(const bf16x8*)(_vt + offV); sr_[i].vs1 = *(const bf16x8*)(_vt + offV + 32 * LDV); \
    sr_[i].ks0 = *(const bf16x8*)(_kt + offK); sr_[i].ks1 = *(const bf16x8*)(_kt + offK + 32 * LDK); \
    if constexpr (DKX > 0) sr_[i].kx = *(const bf16x8*)(Kx + _r * 64 + offX); } while (0)
#define SWRITE(b, i) do { *(bf16x8*)(V_lds + (b) * SHM_V + vst0) = sr_[i].vs0; *(bf16x8*)(V_lds + (b) * SHM_V + vst1) = sr_[i].vs1; const int kc = sc * 2; \
    *(bf16x8*)(K_lds + (b) * SHM_K + KSWZ(sr, kc)) = sr_[i].ks0; *(bf16x8*)(K_lds + (b) * SHM_K + KSWZ(32 + sr, kc)) = sr_[i].ks1; \
    if constexpr (DKX > 0) *(bf16x8*)(K_lds + (b) * SHM_K + KSWZ(xr, 256 + xc * 2)) = sr_[i].kx; } while (0)
#define SWAIT() do { if constexpr (SDEPTH == 1) asm volatile("s_waitcnt vmcnt(0)" ::: "memory"); else if constexpr (DKX > 0) asm volatile("s_waitcnt vmcnt(5)" ::: "memory"); else asm volatile("s_waitcnt vmcnt(4)" ::: "memory"); } while (0)
#define RESC(a) do { if (__any((a) < 1.f)) { if (hi == 0) al_l[r32] = (a); asm volatile("s_waitcnt lgkmcnt(0)" ::: "memory"); \
    for (int d = 0; d < 4; ++d) for (int r = 0; r < 16; ++r) o[d][r] *= al_l[crow(r, hi)]; } } while (0)
#define QKT(p0, p1, Ks) do { p0 = f32x16{}; p1 = f32x16{}; _Pragma("unroll") for (int d0 = 0; d0 < ND0; ++d0) { const int cb = (d0 * 16 + hi * 8) * 2; \
    const bf16x8 b0 = *reinterpret_cast<const bf16x8*>((Ks) + KSWZ(r32, cb)); const bf16x8 b1 = *reinterpret_cast<const bf16x8*>((Ks) + KSWZ(32 + r32, cb)); \
    const bf16x8 qf = d0 < 8 ? qr[d0 < 8 ? d0 : 0] : *reinterpret_cast<const bf16x8*>(QX + (d0 - 8) * 1024); \
    p0 = __builtin_amdgcn_mfma_f32_32x32x16_bf16(b0, qf, p0, 0, 0, 0); p1 = __builtin_amdgcn_mfma_f32_32x32x16_bf16(b1, qf, p1, 0, 0, 0); if (DKX > 0 && (d0 & 1) == 1) SBAR(); } } while (0)
#define PARTIAL_SM(p0, p1, mn, alpha) do { float pmax = p0[0]; for (int r = 1; r < 16; ++r) pmax = fmaxf(pmax, p0[r]); for (int r = 0; r < 16; ++r) pmax = fmaxf(pmax, p1[r]); \
    { auto rr = __builtin_amdgcn_permlane32_swap(__float_as_uint(pmax), __float_as_uint(pmax), false, false); pmax = fmaxf(__uint_as_float(rr[0]), __uint_as_float(rr[1])); } \
    if (__builtin_expect(__all((pmax - m_reg) * scale <= THR), 1)) { mn = m_reg; alpha = 1.f; } \
    else { mn = fmaxf(m_reg, pmax); alpha = __builtin_amdgcn_exp2f((m_reg - mn) * C); m_reg = mn; } \
    const float mnC = -mn * C; for (int r = 0; r < 16; ++r) p0[r] = fmaf(p0[r], C, mnC); for (int r = 0; r < 16; ++r) p1[r] = fmaf(p1[r], C, mnC); \
    for (int r = 0; r < 16; ++r) p0[r] = __builtin_amdgcn_exp2f(p0[r]); } while (0)
#define PK4(P, BASE, OUT) do { unsigned a0 = pk2(P[BASE + 0], P[BASE + 1]), a1 = pk2(P[BASE + 2], P[BASE + 3]); \
    unsigned b0 = pk2(P[BASE + 4], P[BASE + 5]), b1 = pk2(P[BASE + 6], P[BASE + 7]); \
    auto r0 = __builtin_amdgcn_permlane32_swap(a0, b0, false, false); auto r1 = __builtin_amdgcn_permlane32_swap(a1, b1, false, false); \
    u32x4 w = {r0[0], r1[0], r0[1], r1[1]}; OUT = *reinterpret_cast<bf16x8*>(&w); } while (0)
#define FINISH_SM(p0, p1, alpha) do { for (int r = 0; r < 16; ++r) p1[r] = __builtin_amdgcn_exp2f(p1[r]); \
    float ps = 0; for (int r = 0; r < 16; ++r) ps += p0[r]; for (int r = 0; r < 16; ++r) ps += p1[r]; \
    { auto rr = __builtin_amdgcn_permlane32_swap(__float_as_uint(ps), __float_as_uint(ps), false, false); ps = __uint_as_float(rr[0]) + __uint_as_float(rr[1]); } \
    l_reg = l_reg * alpha + ps; PK4(p0, 0, pa0); PK4(p0, 8, pa1); PK4(p1, 0, pa2); PK4(p1, 8, pa3); } while (0)
  f32x16 pA0, pA1, pB0, pB1; float mnA, mnB, alA, alB; bf16x8 pa0, pa1, pa2, pa3;
  constexpr int SE = 0, SO = SDEPTH - 1;
  SLOAD(SE, 0); asm volatile("s_waitcnt vmcnt(0)" ::: "memory"); SWRITE(0, SE); __syncthreads();
  QKT(pA0, pA1, K_lds); PARTIAL_SM(pA0, pA1, mnA, alA);
  SLOAD(SO, 1); if constexpr (SDEPTH == 2) { if (2 < NT) SLOAD(SE, 2); }
  SWAIT(); SWRITE(1, SO); __syncthreads();
  for (int j = 1; j + 1 < NT; j += 2) {
    SBAR(); QKT(pB0, pB1, K_lds + SHM_K);
    FINISH_SM(pA0, pA1, alA); SBAR();
    SLOAD(SO, j + SDEPTH); SBAR();
    pv_d0(o, vb0, pa0, pa1, pa2, pa3); PARTIAL_SM(pB0, pB1, mnB, alB);
    __syncthreads(); SWAIT(); SWRITE(0, SE);
    RESC(alB); __syncthreads();
    SBAR(); QKT(pA0, pA1, K_lds);
    FINISH_SM(pB0, pB1, alB); SBAR();
    if (SDEPTH == 1 || j + 3 < NT) SLOAD(SE, j + 1 + SDEPTH); SBAR();
    pv_d0(o, vb0 + (int)SHM_V, pa0, pa1, pa2, pa3); PARTIAL_SM(pA0, pA1, mnA, alA);
    __syncthreads(); SWAIT(); SWRITE(1, SO);
    RESC(alA); __syncthreads();
  }
  SBAR(); QKT(pB0, pB1, K_lds + SHM_K);
  FINISH_SM(pA0, pA1, alA); SBAR();
  pv_d0(o, vb0, pa0, pa1, pa2, pa3); PARTIAL_SM(pB0, pB1, mnB, alB);
  __syncthreads(); RESC(alB);
  FINISH_SM(pB0, pB1, alB); SBAR();
  pv_d0(o, vb0 + (int)SHM_V, pa0, pa1, pa2, pa3);
  if (hi == 0) li_l[r32] = l_reg; asm volatile("s_waitcnt lgkmcnt(0)" ::: "memory");
  float rli[16];
#pragma unroll
  for (int r = 0; r < 16; ++r) rli[r] = __builtin_amdgcn_rcpf(li_l[crow(r, hi)]);
  bf16_t* Ow = Ob + (long)(wid * QBLK) * LDO;
#pragma unroll
  for (int r = 0; r < 16; ++r) { const int orow = crow(r, hi);
#pragma unroll
    for (int d0 = 0; d0 < 4; ++d0) Ow[(long)orow * LDO + d0 * 32 + r32] = (bf16_t)f2bf(o[d0][r] * rli[r]); }
  __syncthreads();
#undef KSWZ
#undef TROW
#undef SLOAD
#undef SWRITE
#undef SWAIT
#undef RESC
#undef QKT
#undef PARTIAL_SM
#undef PK4
#undef FINISH_SM
}
}

namespace ml {
constexpr int LD = 264, ROWB = LD * 2, QS_OFF = 0, KS_OFF = 64 * ROWB, VS_OFF = 2 * 64 * ROWB, NV_OFF = 3 * 64 * ROWB, SC_OFF = NV_OFF + 1024, ML_END = SC_OFF + 2048;
static_assert(ML_END <= LDS_BYTES - 1024, "mlstm lds");
#define MFMA32(a, b, c) __builtin_amdgcn_mfma_f32_32x32x16_bf16((a), (b), (c), 0, 0, 0)
DI bf16x8 pack_step(const f32x16& x, int s) {
    u32x4 p;
    asm volatile("v_cvt_pk_bf16_f32 %0, %4, %5\n\tv_cvt_pk_bf16_f32 %1, %6, %7\n\tv_cvt_pk_bf16_f32 %2, %8, %9\n\tv_cvt_pk_bf16_f32 %3, %10, %11\n\ts_nop 1"
                 : "=&v"(p[0]), "=&v"(p[1]), "=&v"(p[2]), "=&v"(p[3])
                 : "v"(x[8 * s]), "v"(x[8 * s + 1]), "v"(x[8 * s + 2]), "v"(x[8 * s + 3]), "v"(x[8 * s + 4]), "v"(x[8 * s + 5]), "v"(x[8 * s + 6]), "v"(x[8 * s + 7]));
    return __builtin_bit_cast(bf16x8, p);
}
DI bf16x8 ld_perm(const LAS unsigned char* p) {
    const s16x4 lo = *(const LAS s16x4*)p, hi = *(const LAS s16x4*)(p + 16);
    return (bf16x8){lo[0], lo[1], lo[2], lo[3], hi[0], hi[1], hi[2], hi[3]};
}
DI int crow(int r, int hi) { return (r & 3) + 8 * (r >> 2) + 4 * hi; }
template <int OFF> DI s16x4 tr_rd(unsigned addr) { s16x4 r; asm volatile("ds_read_b64_tr_b16 %0, %1 offset:%2" : "=&v"(r) : "v"(addr), "i"(OFF) : "memory"); return r; }
#define TR_WAIT() do { asm volatile("s_waitcnt lgkmcnt(0)" ::: "memory"); __builtin_amdgcn_sched_barrier(0); } while (0)
#define CAT8(L, H) (bf16x8){L[0], L[1], L[2], L[3], H[0], H[1], H[2], H[3]}

DI void mlstm_stream(const Frame& F, const Args& a, int l, int stream, bool ctx_out) {
    const int b = stream >> 3, hd = (stream >> 1) & 3, dir = stream & 1;
    const int tid = F.tid, w = F.wave;
    LAS unsigned char* lds = F.lds;
    const unsigned ldsb = (unsigned)(uintptr_t)lds;
    const bf16_t* P = (const bf16_t*)(F.ws + WS_P); const float* X80 = (const float*)(F.ws + WS_X80);
    float* MLH = (float*)(F.ws + WS_MLH) + (size_t)dir * MTOT * 1024;
    const float* gb = a.in[I_GBIAS] + l * 16;
    const float gbi = gb[dir * 8 + hd], gbf = gb[dir * 8 + 4 + hd];
    LAS float* NV = (LAS float*)(lds + NV_OFF);
    LAS float* SC = (LAS float*)(lds + SC_OFF);
    f32x16 CT[8];
#pragma unroll
    for (int i = 0; i < 8; ++i) CT[i] = f32x16{};
    if (tid < 256) NV[tid] = 0.f;
    float m_prev = 0.f;
    const int sgn = dir ? -1 : 1;
#define CHUNK_ROW0(c) ((c) < 4 ? MLAT + b * CTXL + (dir ? 255 - (c) * 64 : (c) * 64) : b * SEQ + (dir ? 2047 - ((c) - 4) * 64 : ((c) - 4) * 64))
    bf16x8 pq[4], pk[4], pv[4]; float pgi, pgf;
#define PREFETCH(c) do { int ln_ = F.lane; asm volatile("" : "+v"(ln_)); const int r0_ = CHUNK_ROW0(c); \
        const bf16_t* pr_ = P + (size_t)(r0_ + sgn * ((w << 3) | (ln_ >> 3))) * NP + hd * 256 + 8 * (ln_ & 7); \
        _Pragma("unroll") for (int j = 0; j < 4; ++j) { pq[j] = *(const bf16x8*)(pr_ + C_MLQ + 64 * j); pk[j] = *(const bf16x8*)(pr_ + C_MLK + 64 * j); pv[j] = *(const bf16x8*)(pr_ + C_MLV + 64 * j); } \
        const float* xg_ = X80 + (size_t)(r0_ + sgn * ln_) * XW + 64 + dir * 8 + hd; pgi = xg_[0]; pgf = xg_[4]; } while (0)
    PREFETCH(0);
#ifndef MK_MLX
#define MK_MLX 1
#endif
    for (int cc = 0; cc < 36 * MK_MLX; ++cc) {
        const int c = cc % 36;
        if (MK_MLX > 1 && cc == 36) { __syncthreads();
#pragma unroll
            for (int i = 0; i < 8; ++i) CT[i] = f32x16{};
            if (tid < 256) NV[tid] = 0.f; m_prev = 0.f; }
        int lane = F.lane; asm volatile("" : "+v"(lane));
        const int r32 = lane & 31, hi = lane >> 5, ldi = (w << 3) | (lane >> 3), cg = lane & 7, g16 = lane >> 4, q4 = (lane & 15) >> 2, p4 = lane & 3;
        const int row0 = CHUNK_ROW0(c);
        const float ipre = pgi + gbi, fpre = pgf + gbf;
        const float lf = fminf(fpre, 0.f) - __logf(1.f + __expf(-fabsf(fpre)));
        float cum = lf;
#pragma unroll
        for (int o = 1; o < 64; o <<= 1) { const float t = shu(cum, o); if (lane >= o) cum += t; }
        const float bb = ipre - cum;
        float pmx = bb;
#pragma unroll
        for (int o = 1; o < 64; o <<= 1) { const float t = shu(pmx, o); if (lane >= o) pmx = fmaxf(pmx, t); }
        const float aa = fmaxf(m_prev, pmx);
        const float cum_end = shl_(cum, 63), a_end = shl_(aa, 63);
        const float decay = __expf(m_prev - a_end), m_new = cum_end + a_end;
        __syncthreads();
#pragma unroll
        for (int j = 0; j < 4; ++j) { const int ch = cg + 8 * j; const bf16x8 qv = pq[j];
            u32x4 qs;
            qs.x = pk2(bf2f((unsigned short)qv[0]) * 0.0625f, bf2f((unsigned short)qv[1]) * 0.0625f); qs.y = pk2(bf2f((unsigned short)qv[2]) * 0.0625f, bf2f((unsigned short)qv[3]) * 0.0625f);
            qs.z = pk2(bf2f((unsigned short)qv[4]) * 0.0625f, bf2f((unsigned short)qv[5]) * 0.0625f); qs.w = pk2(bf2f((unsigned short)qv[6]) * 0.0625f, bf2f((unsigned short)qv[7]) * 0.0625f);
            *(LAS u32x4*)(lds + QS_OFF + (ldi * LD + 8 * ch) * 2) = qs;
            *(LAS bf16x8*)(lds + KS_OFF + (ldi * LD + 8 * ch) * 2) = pk[j];
            *(LAS bf16x8*)(lds + VS_OFF + (ldi * LD + 8 * ch) * 2) = pv[j]; }
        {
            float part = 0.f;
#pragma unroll
            for (int j = 0; j < 4; ++j) { const int ch = cg + 8 * j; const bf16x8 qv = pq[j]; const f32x4 n0 = *(const LAS f32x4*)(NV + 8 * ch), n1 = *(const LAS f32x4*)(NV + 8 * ch + 4);
                part += bf2f((unsigned short)qv[0]) * n0.x + bf2f((unsigned short)qv[1]) * n0.y + bf2f((unsigned short)qv[2]) * n0.z + bf2f((unsigned short)qv[3]) * n0.w
                      + bf2f((unsigned short)qv[4]) * n1.x + bf2f((unsigned short)qv[5]) * n1.y + bf2f((unsigned short)qv[6]) * n1.z + bf2f((unsigned short)qv[7]) * n1.w; }
            part += shx(part, 1); part += shx(part, 2); part += shx(part, 4);
            if (cg == 0) SC[320 + ldi] = part * 0.0625f; }
        if (w == 0) { SC[lane] = bb; SC[64 + lane] = aa; SC[128 + lane] = __expf(m_prev - aa); SC[192 + lane] = __expf(-cum - aa); SC[256 + lane] = __expf(bb - a_end); }
        __syncthreads();
        const bool want_out = (c >= 4) || ctx_out;
        if (want_out) {
            const unsigned va0 = ldsb + VS_OFF + ((4 * (g16 >> 1) + q4) * LD + 32 * w + 16 * (g16 & 1) + 4 * p4) * 2;
#pragma unroll
            for (int lt = 0; lt < 2; ++lt) {
                const int lcol = 32 * lt + r32;
                const float a_l = SC[64 + lcol], wI_l = SC[128 + lcol], fl_l = SC[192 + lcol], nq_l = SC[320 + lcol];
                f32x16 N = f32x16{};
#pragma unroll
                for (int dt = 0; dt < 8; ++dt)
#pragma unroll
                    for (int ks = 0; ks < 2; ++ks) {
                        const bf16x8 qa = ld_perm(lds + QS_OFF + (lcol * LD + 32 * dt + 16 * ks + 4 * hi) * 2);
                        N = MFMA32(pack_step(CT[dt], ks), qa, N); if (ks == 1 && (dt & 1)) __builtin_amdgcn_sched_barrier(0); }
#pragma unroll
                for (int r = 0; r < 16; ++r) N[r] *= wI_l;
                float den = 0.f;
#pragma unroll
                for (int st = 0; st <= lt; ++st) {
                    f32x16 S = f32x16{};
#pragma unroll
                    for (int ks = 0; ks < 16; ++ks) {
                        const bf16x8 ka = *(const LAS bf16x8*)(lds + KS_OFF + ((32 * st + r32) * LD + 16 * ks + 8 * hi) * 2);
                        const bf16x8 qb = *(const LAS bf16x8*)(lds + QS_OFF + (lcol * LD + 16 * ks + 8 * hi) * 2);
                        S = MFMA32(ka, qb, S); }
                    const s16x4 v00 = st == 0 ? tr_rd<0>(va0) : tr_rd<32 * ROWB>(va0), v01 = st == 0 ? tr_rd<8 * ROWB>(va0) : tr_rd<40 * ROWB>(va0);
                    const s16x4 v10 = st == 0 ? tr_rd<16 * ROWB>(va0) : tr_rd<48 * ROWB>(va0), v11 = st == 0 ? tr_rd<24 * ROWB>(va0) : tr_rd<56 * ROWB>(va0);
#pragma unroll
                    for (int r = 0; r < 16; ++r) { const int srow = 32 * st + crow(r, hi); const float dd = __expf(SC[srow] - a_l);
                        const float v = (srow <= lcol) ? S[r] * dd : 0.f; S[r] = v; den += v; }
                    TR_WAIT();
                    N = MFMA32(CAT8(v00, v01), pack_step(S, 0), N);
                    N = MFMA32(CAT8(v10, v11), pack_step(S, 1), N);
                }
                den += shx(den, 32);
                den += wI_l * nq_l;
                const float inv = 1.f / fmaxf(fabsf(den), fl_l);
                float* orow = MLH + (size_t)(row0 + sgn * lcol) * 1024 + hd * 256 + 32 * w + 4 * hi;
#pragma unroll
                for (int g = 0; g < 4; ++g) *(f32x4*)(orow + 8 * g) = (f32x4){N[4 * g] * inv, N[4 * g + 1] * inv, N[4 * g + 2] * inv, N[4 * g + 3] * inv};
                __builtin_amdgcn_sched_barrier(0);
            }
        }
        __builtin_amdgcn_sched_barrier(0);
        { const int cn = (cc + 1 < 36 * MK_MLX) ? (cc + 1) % 36 : 35; PREFETCH(cn); }
        __builtin_amdgcn_sched_barrier(0);
        {
            const unsigned vb0 = ldsb + VS_OFF + ((8 * (g16 >> 1) + q4) * LD + 32 * w + 16 * (g16 & 1) + 4 * p4) * 2;
            const unsigned kb0 = ldsb + KS_OFF + ((8 * (g16 >> 1) + q4) * LD + 16 * (g16 & 1) + 4 * p4) * 2;
            const s16x4 b00 = tr_rd<0>(vb0), b01 = tr_rd<4 * ROWB>(vb0), b10 = tr_rd<16 * ROWB>(vb0), b11 = tr_rd<20 * ROWB>(vb0);
            const s16x4 b20 = tr_rd<32 * ROWB>(vb0), b21 = tr_rd<36 * ROWB>(vb0), b30 = tr_rd<48 * ROWB>(vb0), b31 = tr_rd<52 * ROWB>(vb0);
            TR_WAIT();
            bf16x8 vb[4];
#define SCALE8(dst, L, H, ks) do { const f32x4 w0 = *(const LAS f32x4*)(SC + 256 + 16 * (ks) + 8 * hi), w1 = *(const LAS f32x4*)(SC + 256 + 16 * (ks) + 8 * hi + 4); \
            u32x4 t_; t_.x = pk2(bf2f((unsigned short)L[0]) * w0.x, bf2f((unsigned short)L[1]) * w0.y); t_.y = pk2(bf2f((unsigned short)L[2]) * w0.z, bf2f((unsigned short)L[3]) * w0.w); \
            t_.z = pk2(bf2f((unsigned short)H[0]) * w1.x, bf2f((unsigned short)H[1]) * w1.y); t_.w = pk2(bf2f((unsigned short)H[2]) * w1.z, bf2f((unsigned short)H[3]) * w1.w); dst = __builtin_bit_cast(bf16x8, t_); } while (0)
            SCALE8(vb[0], b00, b01, 0); SCALE8(vb[1], b10, b11, 1); SCALE8(vb[2], b20, b21, 2); SCALE8(vb[3], b30, b31, 3);
#undef SCALE8
#define UPD(dt) do { const s16x4 k00 = tr_rd<(dt) * 64>(kb0), k01 = tr_rd<(dt) * 64 + 4 * ROWB>(kb0), k10 = tr_rd<(dt) * 64 + 16 * ROWB>(kb0), k11 = tr_rd<(dt) * 64 + 20 * ROWB>(kb0); \
            const s16x4 k20 = tr_rd<(dt) * 64 + 32 * ROWB>(kb0), k21 = tr_rd<(dt) * 64 + 36 * ROWB>(kb0), k30 = tr_rd<(dt) * 64 + 48 * ROWB>(kb0), k31 = tr_rd<(dt) * 64 + 52 * ROWB>(kb0); \
            _Pragma("unroll") for (int r = 0; r < 16; ++r) CT[dt][r] *= decay; \
            TR_WAIT(); \
            CT[dt] = MFMA32(CAT8(k00, k01), vb[0], CT[dt]); CT[dt] = MFMA32(CAT8(k10, k11), vb[1], CT[dt]); CT[dt] = MFMA32(CAT8(k20, k21), vb[2], CT[dt]); CT[dt] = MFMA32(CAT8(k30, k31), vb[3], CT[dt]); } while (0)
            UPD(0); UPD(1); UPD(2); UPD(3); UPD(4); UPD(5); UPD(6); UPD(7);
#undef UPD
        }
        __syncthreads();
        if (tid < 256) { float sacc = 0.f;
#pragma unroll 8
            for (int q = 0; q < 64; ++q) sacc += bf2f(*(const LAS unsigned short*)(lds + KS_OFF + (q * LD + tid) * 2)) * SC[256 + q];
            NV[tid] = decay * NV[tid] + sacc; }
        m_prev = m_new;
    }
    __syncthreads();
#undef CHUNK_ROW0
#undef PREFETCH
}

namespace u2 {
constexpr int LDQ = 264, ROWQ = LDQ * 2, LDV = 136, ROWV = LDV * 2, LDW = 72, ROWW = LDW * 2;
constexpr int QS = 0, KS = 64 * ROWQ, VS = 2 * 64 * ROWQ, SW = VS + 64 * ROWV, NV_O = SW + 64 * ROWW, SC_O = NV_O + 1024, SCN = 448, END = SC_O + 2 * SCN * 4;
static_assert(END <= LDS_BYTES - 1024, "mlstm2 lds");
}
DI void mlstm_unit2(const Frame& F, const Args& a, int l, int unit, bool ctx_out) {
    using namespace u2;
    const int stream = unit >> 1, half = unit & 1, b = stream >> 3, hd = (stream >> 1) & 3, dir = stream & 1;
    const int tid = F.tid, w = F.wave;
    LAS unsigned char* lds = F.lds;
    const unsigned ldsb = (unsigned)(uintptr_t)lds;
    const bf16_t* P = (const bf16_t*)(F.ws + WS_P); const float* X80 = (const float*)(F.ws + WS_X80);
    bf16_t* MLH = (bf16_t*)(F.ws + WS_MLH) + (size_t)dir * MTOT * 1024;
    const float* gb = a.in[I_GBIAS] + l * 16;
    const float gbi = gb[dir * 8 + hd], gbf = gb[dir * 8 + 4 + hd];
    LAS float* NV = (LAS float*)(lds + NV_O);
    const int sgn = dir ? -1 : 1;
#define CHUNK_ROW0(c) ((c) < 4 ? MLAT + b * CTXL + (dir ? 255 - (c) * 64 : (c) * 64) : b * SEQ + (dir ? 2047 - ((c) - 4) * 64 : ((c) - 4) * 64))
    const bool helper = w >= 4;
    bf16x8 pq[8], pk[8], pv[4]; float pgi = 0.f, pgf = 0.f; float m_prev = 0.f;
#define PREFETCH(c) do { int ht_ = tid - 256; asm volatile("" : "+v"(ht_)); const int r0_ = CHUNK_ROW0(c); \
        const bf16_t* pr_ = P + (size_t)(r0_ + sgn * (ht_ >> 2)) * NP + hd * 256 + 8 * (ht_ & 3); \
        _Pragma("unroll") for (int j = 0; j < 8; ++j) { pq[j] = *(const bf16x8*)(pr_ + C_MLQ + 32 * j); pk[j] = *(const bf16x8*)(pr_ + C_MLK + 32 * j); } \
        _Pragma("unroll") for (int j = 0; j < 4; ++j) pv[j] = *(const bf16x8*)(pr_ + C_MLV + 128 * half + 32 * j); \
        const float* xg_ = X80 + (size_t)(r0_ + sgn * (ht_ & 63)) * XW + 64 + dir * 8 + hd; pgi = xg_[0]; pgf = xg_[4]; } while (0)
#define SCALARS(sb) do { if (w == 4) { int ln_ = F.lane; asm volatile("" : "+v"(ln_)); LAS float* SCw = (LAS float*)(lds + SC_O) + (sb) * SCN; \
        const float ipre = pgi + gbi, fpre = pgf + gbf; const float lf = fminf(fpre, 0.f) - __logf(1.f + __expf(-fabsf(fpre))); \
        float cum = lf; _Pragma("unroll") for (int o = 1; o < 64; o <<= 1) { const float t = shu(cum, o); if (ln_ >= o) cum += t; } \
        const float bb = ipre - cum; float pmx = bb; _Pragma("unroll") for (int o = 1; o < 64; o <<= 1) { const float t = shu(pmx, o); if (ln_ >= o) pmx = fmaxf(pmx, t); } \
        const float aa = fmaxf(m_prev, pmx); const float cum_end = shl_(cum, 63), a_end = shl_(aa, 63); \
        { SCw[ln_] = bb; SCw[64 + ln_] = aa; SCw[128 + ln_] = __expf(m_prev - aa); SCw[192 + ln_] = __expf(-cum - aa); SCw[256 + ln_] = __expf(bb - a_end); if (ln_ == 0) SCw[384] = __expf(m_prev - a_end); } \
        m_prev = cum_end + a_end; } } while (0)
#define WRITE_Q() do { int ht_ = tid - 256; asm volatile("" : "+v"(ht_)); const int hp_ = ht_ >> 2, hg_ = ht_ & 3; \
        _Pragma("unroll") for (int j = 0; j < 8; ++j) { const bf16x8 qv = pq[j]; u32x4 qs; \
            qs.x = pk2(bf2f((unsigned short)qv[0]) * 0.0625f, bf2f((unsigned short)qv[1]) * 0.0625f); qs.y = pk2(bf2f((unsigned short)qv[2]) * 0.0625f, bf2f((unsigned short)qv[3]) * 0.0625f); \
            qs.z = pk2(bf2f((unsigned short)qv[4]) * 0.0625f, bf2f((unsigned short)qv[5]) * 0.0625f); qs.w = pk2(bf2f((unsigned short)qv[6]) * 0.0625f, bf2f((unsigned short)qv[7]) * 0.0625f); \
            *(LAS u32x4*)(lds + QS + (hp_ * LDQ + 8 * (hg_ + 4 * j)) * 2) = qs; } } while (0)
#define WRITE_KV() do { int ht_ = tid - 256; asm volatile("" : "+v"(ht_)); const int hp_ = ht_ >> 2, hg_ = ht_ & 3; \
        _Pragma("unroll") for (int j = 0; j < 8; ++j) *(LAS bf16x8*)(lds + KS + (hp_ * LDQ + 8 * (hg_ + 4 * j)) * 2) = pk[j]; \
        _Pragma("unroll") for (int j = 0; j < 4; ++j) *(LAS bf16x8*)(lds + VS + (hp_ * LDV + 8 * (hg_ + 4 * j)) * 2) = pv[j]; } while (0)
    LAS float* DEN = (LAS float*)(lds + END);
    static_assert(END + 768 <= LDS_BYTES - 1024, "mlstm2 lds den");
    __syncthreads();
    if (helper) { NV[tid - 256] = 0.f; PREFETCH(0); SCALARS(0); WRITE_Q(); WRITE_KV(); }
    __syncthreads();
    if (!helper) {
      f32x16 CT[8];
#pragma unroll
      for (int i = 0; i < 8; ++i) CT[i] = f32x16{};
      for (int cc = 0; cc < 36 * MK_MLX; ++cc) {
        const int c = cc % 36;
        const int sb = cc & 1;
        const LAS float* SC = (const LAS float*)(lds + SC_O) + sb * SCN;
        const bool want_out = (c >= 4) || ctx_out;
        int lane = F.lane; asm volatile("" : "+v"(lane));
        const int r32 = lane & 31, hi = lane >> 5, g16 = lane >> 4, q4 = (lane & 15) >> 2, p4 = lane & 3;
        const int row0 = CHUNK_ROW0(c);
        if (MK_MLX > 1 && cc == 36) {
#pragma unroll
          for (int i = 0; i < 8; ++i) CT[i] = f32x16{}; }
        f32x16 N0 = f32x16{}, N1 = f32x16{};
        {
            if (want_out) {
#pragma unroll
                for (int dt = 0; dt < 8; ++dt)
#pragma unroll
                    for (int ks = 0; ks < 2; ++ks) {
                        const bf16x8 cf = pack_step(CT[dt], ks);
                        const bf16x8 qa0 = ld_perm(lds + QS + (r32 * LDQ + 32 * dt + 16 * ks + 4 * hi) * 2), qa1 = ld_perm(lds + QS + ((32 + r32) * LDQ + 32 * dt + 16 * ks + 4 * hi) * 2);
                        N0 = MFMA32(cf, qa0, N0); N1 = MFMA32(cf, qa1, N1); if (ks == 1 && (dt & 1)) __builtin_amdgcn_sched_barrier(0); }
                const float wI0 = SC[128 + r32], wI1 = SC[128 + 32 + r32];
#pragma unroll
                for (int r = 0; r < 16; ++r) { N0[r] *= wI0; N1[r] *= wI1; }
            }
        }
        __syncthreads();
        {
            if (want_out) {
                const unsigned va0 = ldsb + VS + ((8 * (g16 >> 1) + q4) * LDV + 32 * w + 16 * (g16 & 1) + 4 * p4) * 2;
                const s16x4 a00 = tr_rd<0>(va0), a01 = tr_rd<4 * ROWV>(va0), a10 = tr_rd<16 * ROWV>(va0), a11 = tr_rd<20 * ROWV>(va0);
                const s16x4 a20 = tr_rd<32 * ROWV>(va0), a21 = tr_rd<36 * ROWV>(va0), a30 = tr_rd<48 * ROWV>(va0), a31 = tr_rd<52 * ROWV>(va0);
                const LAS unsigned char* sw0 = lds + SW + (r32 * LDW + 8 * hi) * 2; const LAS unsigned char* sw1 = sw0 + 32 * ROWW;
                const bf16x8 s00 = *(const LAS bf16x8*)(sw0), s01 = *(const LAS bf16x8*)(sw0 + 32);
                const bf16x8 s10 = *(const LAS bf16x8*)(sw1), s11 = *(const LAS bf16x8*)(sw1 + 32), s12 = *(const LAS bf16x8*)(sw1 + 64), s13 = *(const LAS bf16x8*)(sw1 + 96);
                TR_WAIT();
                N0 = MFMA32(CAT8(a00, a01), s00, N0); N0 = MFMA32(CAT8(a10, a11), s01, N0);
                N1 = MFMA32(CAT8(a00, a01), s10, N1); N1 = MFMA32(CAT8(a10, a11), s11, N1); N1 = MFMA32(CAT8(a20, a21), s12, N1); N1 = MFMA32(CAT8(a30, a31), s13, N1);
                {
                    const float den0 = DEN[r32] + SC[128 + r32] * SC[320 + r32];
                    const float den1 = DEN[64 + 32 + r32] + DEN[128 + 32 + r32] + SC[128 + 32 + r32] * SC[320 + 32 + r32];
                    const float inv0 = 1.f / fmaxf(fabsf(den0), SC[192 + r32]), inv1 = 1.f / fmaxf(fabsf(den1), SC[192 + 32 + r32]);
                    bf16_t* o0 = MLH + (size_t)(row0 + sgn * r32) * 1024 + hd * 256 + 128 * half + 32 * w + 4 * hi; bf16_t* o1 = MLH + (size_t)(row0 + sgn * (32 + r32)) * 1024 + hd * 256 + 128 * half + 32 * w + 4 * hi;
#pragma unroll
                    for (int g = 0; g < 4; ++g) { u32x2 t0, t1; t0.x = pk2(N0[4 * g] * inv0, N0[4 * g + 1] * inv0); t0.y = pk2(N0[4 * g + 2] * inv0, N0[4 * g + 3] * inv0);
                        t1.x = pk2(N1[4 * g] * inv1, N1[4 * g + 1] * inv1); t1.y = pk2(N1[4 * g + 2] * inv1, N1[4 * g + 3] * inv1);
                        *(u32x2*)(o0 + 8 * g) = t0; *(u32x2*)(o1 + 8 * g) = t1; }
                }
            }
            __builtin_amdgcn_sched_barrier(0);
            {
                const float decay = SC[384];
                const unsigned vb0 = ldsb + VS + ((8 * (g16 >> 1) + q4) * LDV + 32 * w + 16 * (g16 & 1) + 4 * p4) * 2;
                const unsigned kb0 = ldsb + KS + ((8 * (g16 >> 1) + q4) * LDQ + 16 * (g16 & 1) + 4 * p4) * 2;
                const s16x4 b00 = tr_rd<0>(vb0), b01 = tr_rd<4 * ROWV>(vb0), b10 = tr_rd<16 * ROWV>(vb0), b11 = tr_rd<20 * ROWV>(vb0);
                const s16x4 b20 = tr_rd<32 * ROWV>(vb0), b21 = tr_rd<36 * ROWV>(vb0), b30 = tr_rd<48 * ROWV>(vb0), b31 = tr_rd<52 * ROWV>(vb0);
                TR_WAIT();
                bf16x8 vb[4];
#define SCALE8(dst, L, H, ks) do { const f32x4 w0 = *(const LAS f32x4*)(SC + 256 + 16 * (ks) + 8 * hi), w1 = *(const LAS f32x4*)(SC + 256 + 16 * (ks) + 8 * hi + 4); \
                u32x4 t_; t_.x = pk2(bf2f((unsigned short)L[0]) * w0.x, bf2f((unsigned short)L[1]) * w0.y); t_.y = pk2(bf2f((unsigned short)L[2]) * w0.z, bf2f((unsigned short)L[3]) * w0.w); \
                t_.z = pk2(bf2f((unsigned short)H[0]) * w1.x, bf2f((unsigned short)H[1]) * w1.y); t_.w = pk2(bf2f((unsigned short)H[2]) * w1.z, bf2f((unsigned short)H[3]) * w1.w); dst = __builtin_bit_cast(bf16x8, t_); } while (0)
                SCALE8(vb[0], b00, b01, 0); SCALE8(vb[1], b10, b11, 1); SCALE8(vb[2], b20, b21, 2); SCALE8(vb[3], b30, b31, 3);
#undef SCALE8
#define UPD(dt) do { const s16x4 k00 = tr_rd<(dt) * 64>(kb0), k01 = tr_rd<(dt) * 64 + 4 * ROWQ>(kb0), k10 = tr_rd<(dt) * 64 + 16 * ROWQ>(kb0), k11 = tr_rd<(dt) * 64 + 20 * ROWQ>(kb0); \
                const s16x4 k20 = tr_rd<(dt) * 64 + 32 * ROWQ>(kb0), k21 = tr_rd<(dt) * 64 + 36 * ROWQ>(kb0), k30 = tr_rd<(dt) * 64 + 48 * ROWQ>(kb0), k31 = tr_rd<(dt) * 64 + 52 * ROWQ>(kb0); \
                _Pragma("unroll") for (int r = 0; r < 16; ++r) CT[dt][r] *= decay; \
                TR_WAIT(); \
                CT[dt] = MFMA32(CAT8(k00, k01), vb[0], CT[dt]); CT[dt] = MFMA32(CAT8(k10, k11), vb[1], CT[dt]); CT[dt] = MFMA32(CAT8(k20, k21), vb[2], CT[dt]); CT[dt] = MFMA32(CAT8(k30, k31), vb[3], CT[dt]); } while (0)
                UPD(0); UPD(1); UPD(2); UPD(3); UPD(4); UPD(5); UPD(6); UPD(7);
#undef UPD
            }
        }
        __syncthreads();
        __syncthreads();
      }
    } else {
      for (int cc = 0; cc < 36 * MK_MLX; ++cc) {
        const int c = cc % 36;
        const int sb = cc & 1;
        const LAS float* SC = (const LAS float*)(lds + SC_O) + sb * SCN;
        const bool want_out = (c >= 4) || ctx_out;
        int lane = F.lane; asm volatile("" : "+v"(lane));
        const int r32 = lane & 31, hi = lane >> 5, g16 = lane >> 4, q4 = (lane & 15) >> 2, p4 = lane & 3;
        const int row0 = CHUNK_ROW0(c);
        { const int cn = (cc + 1 < 36 * MK_MLX) ? (cc + 1) % 36 : 35; PREFETCH(cn); }
        {
            if (want_out) {
                if (w < 7) {
                    const int st = (w == 6) ? 1 : 0, lt = (w == 4) ? 0 : 1, lcol = 32 * lt + r32;
                    f32x16 S = f32x16{};
#pragma unroll
                    for (int ks = 0; ks < 16; ++ks) {
                        const bf16x8 ka = *(const LAS bf16x8*)(lds + KS + ((32 * st + r32) * LDQ + 16 * ks + 8 * hi) * 2);
                        const bf16x8 qb = *(const LAS bf16x8*)(lds + QS + (lcol * LDQ + 16 * ks + 8 * hi) * 2);
                        S = MFMA32(ka, qb, S); }
                    const float a_l = SC[64 + lcol]; float den = 0.f;
#pragma unroll
                    for (int r = 0; r < 16; ++r) { const int srow = 32 * st + crow(r, hi); const float dd = __expf(SC[srow] - a_l);
                        const float v = (srow <= lcol) ? S[r] * dd : 0.f; S[r] = v; den += v; }
                    den += shx(den, 32);
                    if (hi == 0) DEN[(w - 4) * 64 + lcol] = den;
#pragma unroll
                    for (int g = 0; g < 4; ++g) { u32x2 t_; t_.x = pk2(S[4 * g], S[4 * g + 1]); t_.y = pk2(S[4 * g + 2], S[4 * g + 3]);
                        *(LAS u32x2*)(lds + SW + (lcol * LDW + 32 * st + 8 * g + 4 * hi) * 2) = t_; }
                } else {
                    float nq = 0.f; const LAS unsigned char* qrow = lds + QS + lane * ROWQ;
#pragma unroll 4
                    for (int d8 = 0; d8 < 32; ++d8) { const bf16x8 qv = *(const LAS bf16x8*)(qrow + d8 * 16); const f32x4 n0 = *(const LAS f32x4*)(NV + 8 * d8), n1 = *(const LAS f32x4*)(NV + 8 * d8 + 4);
                        nq += bf2f((unsigned short)qv[0]) * n0.x + bf2f((unsigned short)qv[1]) * n0.y + bf2f((unsigned short)qv[2]) * n0.z + bf2f((unsigned short)qv[3]) * n0.w
                            + bf2f((unsigned short)qv[4]) * n1.x + bf2f((unsigned short)qv[5]) * n1.y + bf2f((unsigned short)qv[6]) * n1.z + bf2f((unsigned short)qv[7]) * n1.w; }
                    ((LAS float*)(lds + SC_O) + sb * SCN)[320 + lane] = nq;
                }
            }
        }
        __syncthreads();
        {
            if (w == 7) {
                const int dg = lane & 31, sh = lane >> 5; const float decay = SC[384];
                float ac[8];
#pragma unroll
                for (int j = 0; j < 8; ++j) ac[j] = 0.f;
#pragma unroll 4
                for (int q = 0; q < 32; ++q) { const int srow = 32 * sh + q; const bf16x8 kv = *(const LAS bf16x8*)(lds + KS + (srow * LDQ + 8 * dg) * 2); const float wq = SC[256 + srow];
#pragma unroll
                    for (int j = 0; j < 8; ++j) ac[j] += bf2f((unsigned short)kv[j]) * wq; }
#pragma unroll
                for (int j = 0; j < 8; ++j) ac[j] += shx(ac[j], 32);
                if (sh == 0) {
                    f32x4 n0 = *(LAS f32x4*)(NV + 8 * dg), n1 = *(LAS f32x4*)(NV + 8 * dg + 4);
                    n0 = n0 * decay + (f32x4){ac[0], ac[1], ac[2], ac[3]}; n1 = n1 * decay + (f32x4){ac[4], ac[5], ac[6], ac[7]};
                    if (MK_MLX > 1 && cc == 35) { n0 = (f32x4){0.f, 0.f, 0.f, 0.f}; n1 = n0; }
                    *(LAS f32x4*)(NV + 8 * dg) = n0; *(LAS f32x4*)(NV + 8 * dg + 4) = n1; }
            }
            if (MK_MLX > 1 && cc == 35) m_prev = 0.f;
            SCALARS(sb ^ 1);
            WRITE_Q();
        }
        __syncthreads();
        WRITE_KV();
        __syncthreads();
      }
    }
#undef CHUNK_ROW0
#undef PREFETCH
#undef SCALARS
#undef WRITE_Q
#undef WRITE_KV
}
#undef MFMA32
#undef TR_WAIT
#undef CAT8
}

DI void phase_mixers(const Frame& F, const Args& a, int l, char* ldsg, int npass) {
    unsigned* head0 = (unsigned*)(F.ws + WS_CTL) + CW_QUEUE + 64 * l;
    volatile LAS unsigned* MISC = (volatile LAS unsigned*)(F.lds + LDS_BYTES - 64);
    const int n_ml = 64, n_la = 256, n_ga = 256, n_cx = (l == 0) ? 32 : 0, n_mix = n_ml + n_la + n_ga + 2 * n_cx;
    const int total = n_mix;
    const bf16_t* QLA = (const bf16_t*)(F.ws + WS_QLA); const bf16_t* KVLA = (const bf16_t*)(F.ws + WS_KVLA); const bf16_t* KR = (const bf16_t*)(F.ws + WS_KR);
    const bf16_t* QG = (const bf16_t*)(F.ws + WS_QG); const bf16_t* KG = (const bf16_t*)(F.ws + WS_KG); const bf16_t* P = (const bf16_t*)(F.ws + WS_P);
    bf16_t* YCAT = (bf16_t*)(F.ws + WS_YCAT);
#ifndef MK_MIX
#define MK_MIX 7
#endif
#define GRAB(u) do { __syncthreads(); if (F.tid == 0) MISC[4] = __hip_atomic_fetch_add(head, 1u, __ATOMIC_RELAXED, __HIP_MEMORY_SCOPE_AGENT); __syncthreads(); u = __builtin_amdgcn_readfirstlane((int)MISC[4]); } while (0)
    for (int pass = 0; pass < npass; ++pass) {
    unsigned* head = head0 + 128 * pass;
    int u0;
    GRAB(u0);
    while (u0 < n_ml) { if (MK_MIX & 1) ml::mlstm_unit2(F, a, l, u0, l == 0); GRAB(u0); }
    while (u0 < n_mix) {
        int u = u0 - n_ml;
        if (u < n_la) { const int b = u >> 6, h = (u >> 3) & 7, qb = u & 7; const long q0 = (long)b * SEQ + qb * 256;
            if (MK_MIX & 2) att::attn_body<64, 1536, 2048, 2048, 3072>(QLA + q0 * 1536 + h * 192, KVLA + h * 256, KR, KVLA + h * 256 + 128, YCAT + q0 * 3072 + 1024 + h * 128,
                                                      MLAT + b * CTXL, 4, b * SEQ, 32, 0.07216878364870322f, (const float*)(F.ws + WS_ROPE_LA) + (size_t)qb * 256 * 64, ldsg); }
        else if (u < n_la + n_ga) { u -= n_la; const int b = u >> 6, h = (u >> 3) & 7, qb = u & 7; const long q0 = (long)b * SEQ + qb * 256;
            if (MK_MIX & 4) att::attn_body<0, 1024, 256, NP, 3072>(QG + q0 * 1024 + h * 128, KG + (h >> 2) * 128, nullptr, P + C_GV + (h >> 2) * 128, YCAT + q0 * 3072 + 2048 + h * 128,
                                                  MLAT + b * CTXL, 4, b * SEQ, 32, 0.08838834764831845f, nullptr, ldsg); }
        else if (u < n_la + n_ga + n_cx) { u -= n_la + n_ga; const int b = u >> 3, h = u & 7; const long q0 = (long)MLAT + b * CTXL;
            if (MK_MIX & 2) att::attn_body<64, 1536, 2048, 2048, 3072>(QLA + q0 * 1536 + h * 192, KVLA + h * 256, KR, KVLA + h * 256 + 128, YCAT + q0 * 3072 + 1024 + h * 128,
                                                      MLAT + b * CTXL, 4, 0, 0, 0.07216878364870322f, nullptr, ldsg); }
        else { u -= n_la + n_ga + n_cx; const int b = u >> 3, h = u & 7; const long q0 = (long)MLAT + b * CTXL;
            if (MK_MIX & 4) att::attn_body<0, 1024, 256, NP, 3072>(QG + q0 * 1024 + h * 128, KG + (h >> 2) * 128, nullptr, P + C_GV + (h >> 2) * 128, YCAT + q0 * 3072 + 2048 + h * 128,
                                                  MLAT + b * CTXL, 4, 0, 0, 0.08838834764831845f, nullptr, ldsg); }
        GRAB(u0);
    }
    }
#undef GRAB
}

DI void phase_convert_tail(const Frame& F0, const Args& a, int l) {
    Frame F = F0; { int t_ = threadIdx.x; asm volatile("" : "+v"(t_)); F.tid = t_; F.lane = t_ & 63; F.wave = __builtin_amdgcn_readfirstlane(t_ >> 6); }
    constexpr int CVB = 64;
    unsigned* head = (unsigned*)(F.ws + WS_CTL) + CW_QUEUE + 64 * l + 32;
    volatile LAS unsigned* MISC = (volatile LAS unsigned*)(F.lds + LDS_BYTES - 64);
    const int n_cv = ((IT_LAYER - IT_EARLY) + ((l == 0) ? IT_EARLY : 0)) / CVB;
    LAS float* scr = (LAS float*)(F.lds + F.wave * 16384);
    for (;;) {
        __syncthreads();
        if (F.tid == 0) MISC[4] = __hip_atomic_fetch_add(head, 1u, __ATOMIC_RELAXED, __HIP_MEMORY_SCOPE_AGENT);
        __syncthreads();
        const int blk = __builtin_amdgcn_readfirstlane((int)MISC[4]);
        if (blk >= n_cv) break;
#pragma unroll 1
        for (int q = 0; q < CVB / NWAVES; ++q) { const int r = blk * CVB + q * NWAVES + F.wave;
            if (r < IT_LAYER - IT_EARLY) convert_item(F, a, l, IT_EARLY + r, scr); else convert_item(F, a, 1, r - (IT_LAYER - IT_EARLY), scr); }
    }
}

constexpr int FILL_BLK = 16, FILL_NBLK = IT_LAYER / FILL_BLK;
static_assert(IT_LAYER % FILL_BLK == 0, "fill blocks");
DI void fill_convert(const Frame& F0_, const Args& a, int ph, bool drain) {
    Frame F = F0_; { int t_ = threadIdx.x; asm volatile("" : "+v"(t_)); F.tid = t_; F.lane = t_ & 63; F.wave = __builtin_amdgcn_readfirstlane(t_ >> 6); }
    unsigned* ctl = (unsigned*)(F.ws + WS_CTL); unsigned* head = ctl + CW_CVHEAD; unsigned* done = ctl + CW_PHDONE + 64 * ph;
    volatile LAS unsigned* MISC = (volatile LAS unsigned*)(F.lds + LDS_BYTES - 64);
    LAS float* scr = (LAS float*)(F.lds + F.wave * 16384);
    __syncthreads();
    if (!drain && F.tid == 0) __hip_atomic_fetch_add(done, 1u, __ATOMIC_RELAXED, __HIP_MEMORY_SCOPE_AGENT);
    for (;;) {
        if (F.tid == 0) { unsigned blk = 0xffffffffu;
            if (drain || __hip_atomic_load(done, __ATOMIC_RELAXED, __HIP_MEMORY_SCOPE_AGENT) < (unsigned)F.G) blk = __hip_atomic_fetch_add(head, 1u, __ATOMIC_RELAXED, __HIP_MEMORY_SCOPE_AGENT);
            MISC[4] = blk; }
        __syncthreads();
        const unsigned blk = (unsigned)__builtin_amdgcn_readfirstlane((int)MISC[4]);
        __syncthreads();
        if (blk >= (unsigned)FILL_NBLK) break;
        convert_range(F, a, IT_LAYER + (int)blk * FILL_BLK + F.wave, NWAVES, IT_LAYER + ((int)blk + 1) * FILL_BLK, scr);
    }
}

DI void phase_convert_side(const Frame& F0_, const Args& a, int bid, int it_lo, int it_hi) {
    const int step = MK_CVSIDE, ncv = (256 + step - 1) / step;
    if (bid % step != 0 || F0_.G != 256) { if (F0_.G != 256) { Frame Fx = F0_; LAS float* scr = (LAS float*)(Fx.lds + Fx.wave * 16384); convert_range(Fx, a, it_lo + Fx.gw, Fx.ngw, it_hi, scr); } return; }
    Frame F = F0_; { int t_ = threadIdx.x; asm volatile("" : "+v"(t_)); F.tid = t_; F.lane = t_ & 63; F.wave = __builtin_amdgcn_readfirstlane(t_ >> 6); }
    LAS float* scr = (LAS float*)(F.lds + F.wave * 16384);
    const int j = bid / step, per = (it_hi - it_lo + ncv - 1) / ncv, lo = it_lo + j * per, hi = (lo + per < it_hi) ? lo + per : it_hi;
    convert_range(F, a, lo + F.wave, NWAVES, hi, scr);
    __syncthreads();
}

DI void phase_mlfin(const Frame& F, const Args& a, int l, int nrows) {
    const bf16_t* H0 = (const bf16_t*)(F.ws + WS_MLH); const bf16_t* H1 = H0 + (size_t)MTOT * 1024;
    const bf16_t* P = (const bf16_t*)(F.ws + WS_P); bf16_t* YCAT = (bf16_t*)(F.ws + WS_YCAT); const float* gn = a.in[I_MLNORM] + l * 1024;
    int row = F.gw; if (row >= nrows) return;
    s16x4 c0[4], c1[4]; s16x4 co[4];
#define MLF_LOAD(r_, a0, a1, ao) do { _Pragma("unroll") for (int hd = 0; hd < 4; ++hd) { const int c = hd * 256 + 4 * F.lane; a0[hd] = *(const s16x4*)(H0 + (size_t)(r_) * 1024 + c); a1[hd] = *(const s16x4*)(H1 + (size_t)(r_) * 1024 + c); \
        ao[hd] = *(const s16x4*)(P + (size_t)(r_) * NP + C_MLO + c); } } while (0)
    MLF_LOAD(row, c0, c1, co);
    f32x4 gv[4];
#pragma unroll
    for (int hd = 0; hd < 4; ++hd) gv[hd] = *(const f32x4*)(gn + hd * 256 + 4 * F.lane);
    for (;;) {
        const int nrow = row + F.ngw; const bool hn = nrow < nrows; const int pr = hn ? nrow : row;
        s16x4 n0[4], n1[4]; s16x4 no[4]; MLF_LOAD(pr, n0, n1, no);
#pragma unroll
        for (int hd = 0; hd < 4; ++hd) { const int c = hd * 256 + 4 * F.lane;
            const f32x4 v = (f32x4){bf2f((unsigned short)c0[hd][0]) + bf2f((unsigned short)c1[hd][0]), bf2f((unsigned short)c0[hd][1]) + bf2f((unsigned short)c1[hd][1]), bf2f((unsigned short)c0[hd][2]) + bf2f((unsigned short)c1[hd][2]), bf2f((unsigned short)c0[hd][3]) + bf2f((unsigned short)c1[hd][3])};
            const float rs = rsqrtf(wave_sum(v.x * v.x + v.y * v.y + v.z * v.z + v.w * v.w) * (1.f / 256.f) + EPS);
            const f32x4 g = gv[hd]; const s16x4 og = co[hd];
            u32x2 w; w.x = pk2(v.x * rs * g.x * sigmoidf_(bf2f((unsigned short)og[0])), v.y * rs * g.y * sigmoidf_(bf2f((unsigned short)og[1])));
            w.y = pk2(v.z * rs * g.z * sigmoidf_(bf2f((unsigned short)og[2])), v.w * rs * g.w * sigmoidf_(bf2f((unsigned short)og[3])));
            *(u32x2*)(YCAT + (size_t)row * 3072 + c) = w; }
        if (!hn) break;
#pragma unroll
        for (int hd = 0; hd < 4; ++hd) { c0[hd] = n0[hd]; c1[hd] = n1[hd]; co[hd] = no[hd]; }
        row = nrow;
    }
#undef MLF_LOAD
}

struct SchedMerge {
    const char* Y; const char* Bt; int nM, G, c;
    DI bool next(int i, Unit& u) const {
        int pm, pn, br;
        if (nM == 36 && G == 256) {
            const int j = c < 96 ? i - 1 : i;
            if (j < 0) { const int t = c / 3; br = (c - 3 * t) | 4; pm = 32 + (t >> 3); pn = t & 7; }
            else if (j < 3) { pg8::tile_of(c, 32, 8, pm, pn); br = j; }
            else return false;
        } else { const int k = i / 3; br = i - 3 * k; const long L = (long)k * G + c; if (L >= (long)nM * 8) return false; pg8::tile_of((int)L, nM, 8, pm, pn); }
        u.pm = pm; u.pn = pn; u.aux = br; u.nt = 16; u.pa = Y + (size_t)pm * 256 * 6144 + (br & 3) * 2048; u.pb = Bt + ((size_t)(br & 3) * 2048 + pn * 256) * 2048; return true;
    }
};
struct EpiMerge {
    const bf16_t* P; bf16_t* ZG; bf16_t* MB; bf16_t* CP; unsigned* cnt; unsigned* odone;
    DI void operator()(const f32x4 (&acc)[2][2][4][2], const Unit& u, int wr, int wc, int fr, int fq) const {
        const int br = u.aux & 3; const bool split = (u.aux & 4) != 0;
        EPI_FOREACH({
            const bf16x8 gp = *(const bf16x8*)(P + (size_t)row * NP + C_GATE + br * 2048 + col);
            f32x4 g0, g1;
            g0.x = sigmoidf_(bf2f((unsigned short)gp[0])); g0.y = sigmoidf_(bf2f((unsigned short)gp[1])); g0.z = sigmoidf_(bf2f((unsigned short)gp[2])); g0.w = sigmoidf_(bf2f((unsigned short)gp[3]));
            g1.x = sigmoidf_(bf2f((unsigned short)gp[4])); g1.y = sigmoidf_(bf2f((unsigned short)gp[5])); g1.z = sigmoidf_(bf2f((unsigned short)gp[6])); g1.w = sigmoidf_(bf2f((unsigned short)gp[7]));
            f32x4 r0 = v0 * g0, r1 = v1 * g1;
            const size_t off = (size_t)row * DM + col;
            if (split) { const u32x4 w_ = pack8(r0, r1); GAS unsigned long long* cp = (GAS unsigned long long*)(CP + ((size_t)br * MCTX + (row - MLAT)) * DM + col);
                __hip_atomic_store(cp, (unsigned long long)w_.x | ((unsigned long long)w_.y << 32), __ATOMIC_RELAXED, __HIP_MEMORY_SCOPE_AGENT);
                __hip_atomic_store(cp + 1, (unsigned long long)w_.z | ((unsigned long long)w_.w << 32), __ATOMIC_RELAXED, __HIP_MEMORY_SCOPE_AGENT); }
            else if (br < 2) *(u32x4*)(ZG + (size_t)br * MTOT * DM + off) = pack8(r0, r1);
            else { const bf16x8 z0 = *(const bf16x8*)(ZG + off), z1 = *(const bf16x8*)(ZG + (size_t)MTOT * DM + off);
                r0 += (f32x4){bf2f((unsigned short)z0[0]) + bf2f((unsigned short)z1[0]), bf2f((unsigned short)z0[1]) + bf2f((unsigned short)z1[1]), bf2f((unsigned short)z0[2]) + bf2f((unsigned short)z1[2]), bf2f((unsigned short)z0[3]) + bf2f((unsigned short)z1[3])};
                r1 += (f32x4){bf2f((unsigned short)z0[4]) + bf2f((unsigned short)z1[4]), bf2f((unsigned short)z0[5]) + bf2f((unsigned short)z1[5]), bf2f((unsigned short)z0[6]) + bf2f((unsigned short)z1[6]), bf2f((unsigned short)z0[7]) + bf2f((unsigned short)z1[7])};
                *(u32x4*)(MB + off) = pack8(r0, r1); }
        })
        if (split) {
            asm volatile("s_waitcnt vmcnt(0)" ::: "memory");
            unsigned old = 0;
            if ((fr | fq) == 0) old = __hip_atomic_fetch_add((GAS unsigned*)(cnt + (((u.pm - 32) * 8 + u.pn) * 8 + wr * 4 + wc) * 16), 1u, __ATOMIC_RELAXED, __HIP_MEMORY_SCOPE_AGENT);
            old = (unsigned)__builtin_amdgcn_readfirstlane((int)old);
            if (old == 2u) {
                EPI_FOREACH({
                    f32x4 r0 = (f32x4){0.f, 0.f, 0.f, 0.f}; f32x4 r1 = r0;
                    _Pragma("unroll") for (int ob = 0; ob < 3; ++ob) { const GAS unsigned long long* cp = (const GAS unsigned long long*)(CP + ((size_t)ob * MCTX + (row - MLAT)) * DM + col);
                        const unsigned long long a0 = __hip_atomic_load(cp, __ATOMIC_RELAXED, __HIP_MEMORY_SCOPE_AGENT), a1 = __hip_atomic_load(cp + 1, __ATOMIC_RELAXED, __HIP_MEMORY_SCOPE_AGENT);
                        r0 += (f32x4){bf2f((unsigned short)a0), bf2f((unsigned short)(a0 >> 16)), bf2f((unsigned short)(a0 >> 32)), bf2f((unsigned short)(a0 >> 48))};
                        r1 += (f32x4){bf2f((unsigned short)a1), bf2f((unsigned short)(a1 >> 16)), bf2f((unsigned short)(a1 >> 32)), bf2f((unsigned short)(a1 >> 48))}; }
                    (void)v0; (void)v1;
                    { const u32x4 w_ = pack8(r0, r1); GAS unsigned long long* mp = (GAS unsigned long long*)(MB + (size_t)row * DM + col);
                      __hip_atomic_store(mp, (unsigned long long)w_.x | ((unsigned long long)w_.y << 32), __ATOMIC_RELAXED, __HIP_MEMORY_SCOPE_AGENT);
                      __hip_atomic_store(mp + 1, (unsigned long long)w_.z | ((unsigned long long)w_.w << 32), __ATOMIC_RELAXED, __HIP_MEMORY_SCOPE_AGENT); }
                })
                asm volatile("s_waitcnt vmcnt(0)" ::: "memory");
                if ((fr | fq) == 0) __hip_atomic_fetch_add((GAS unsigned*)(odone + (u.pm - 32) * 16), 1u, __ATOMIC_RELAXED, __HIP_MEMORY_SCOPE_AGENT);
            }
        }
    }
};
struct SchedOutCtx {
    const char* A; const char* Bt; int c;
    DI bool next(int i, Unit& u) const {
        if (i != 0 || c < 96 || c >= 160) return false;
        const int t = (c - 96) >> 1, kh = (c - 96) & 1; const size_t ko = (size_t)kh * 2048;
        u.pm = 32 + (t >> 3); u.pn = t & 7; u.aux = 4 | kh; u.nt = 16; u.pa = A + (size_t)u.pm * 256 * (DM * 2) + ko; u.pb = Bt + (size_t)u.pn * 256 * (DM * 2) + ko; return true;
    }
};
struct EpiOut {
    const float* xin; const float* ctxin; float* X1; const float* mods; int l; bf16_t* CP; unsigned* cnt;
    DI void operator()(const f32x4 (&acc)[2][2][4][2], const Unit& u, int wr, int wc, int fr, int fq) const {
        if (u.aux & 4) {
            const int kh = u.aux & 1;
            EPI_FOREACH({ const u32x4 w_ = pack8(v0, v1); GAS unsigned long long* cp = (GAS unsigned long long*)(CP + ((size_t)kh * MCTX + (row - MLAT)) * DM + col);
                __hip_atomic_store(cp, (unsigned long long)w_.x | ((unsigned long long)w_.y << 32), __ATOMIC_RELAXED, __HIP_MEMORY_SCOPE_AGENT);
                __hip_atomic_store(cp + 1, (unsigned long long)w_.z | ((unsigned long long)w_.w << 32), __ATOMIC_RELAXED, __HIP_MEMORY_SCOPE_AGENT); })
            asm volatile("s_waitcnt vmcnt(0)" ::: "memory");
            unsigned old = 0;
            if ((fr | fq) == 0) old = __hip_atomic_fetch_add((GAS unsigned*)(cnt + (((u.pm - 32) * 8 + u.pn) * 8 + wr * 4 + wc) * 16), 1u, __ATOMIC_RELAXED, __HIP_MEMORY_SCOPE_AGENT);
            old = (unsigned)__builtin_amdgcn_readfirstlane((int)old);
            if (old == 1u) {
                EPI_FOREACH({
                    f32x4 r0 = (f32x4){0.f, 0.f, 0.f, 0.f}; f32x4 r1 = r0; (void)v0; (void)v1;
                    _Pragma("unroll") for (int ob = 0; ob < 2; ++ob) { const GAS unsigned long long* cp = (const GAS unsigned long long*)(CP + ((size_t)ob * MCTX + (row - MLAT)) * DM + col);
                        const unsigned long long a0 = __hip_atomic_load(cp, __ATOMIC_RELAXED, __HIP_MEMORY_SCOPE_AGENT), a1 = __hip_atomic_load(cp + 1, __ATOMIC_RELAXED, __HIP_MEMORY_SCOPE_AGENT);
                        r0 += (f32x4){bf2f((unsigned short)a0), bf2f((unsigned short)(a0 >> 16)), bf2f((unsigned short)(a0 >> 32)), bf2f((unsigned short)(a0 >> 48))};
                        r1 += (f32x4){bf2f((unsigned short)a1), bf2f((unsigned short)(a1 >> 16)), bf2f((unsigned short)(a1 >> 32)), bf2f((unsigned short)(a1 >> 48))}; }
                    const float* rp = ctxin + (size_t)(row - MLAT) * DM; const float* gp = mods + ((size_t)(l * 5 + 4) * 6 + 2) * DM + col; float* op = X1 + (size_t)row * DM + col;
                    *(f32x4*)op = *(const f32x4*)(rp + col) + *(const f32x4*)gp * r0; *(f32x4*)(op + 4) = *(const f32x4*)(rp + col + 4) + *(const f32x4*)(gp + 4) * r1;
                })
            }
            return;
        }
        f32x4 g[2][2];
#pragma unroll
        for (int bj = 0; bj < 2; ++bj) { const float* gp = mods + ((size_t)(l * 5 + mods_row(u.pm * 256)) * 6 + 2) * DM + u.pn * 256 + bj * 128 + wc * 32 + 8 * fq;
            g[bj][0] = *(const f32x4*)gp; g[bj][1] = *(const f32x4*)(gp + 4); }
        EPI_FOREACH({
            const float* rp = (l == 0) ? (row < MLAT ? xin + (size_t)row * DM : ctxin + (size_t)(row - MLAT) * DM) : X1 + (size_t)row * DM;
            float* op = X1 + (size_t)row * DM + col;
            *(f32x4*)op = *(const f32x4*)(rp + col) + g[bj][0] * v0; *(f32x4*)(op + 4) = *(const f32x4*)(rp + col + 4) + g[bj][1] * v1;
        })
    }
};
DI void phase_topk(const Frame& F, const Args& a, int l, int bid) {
    const float* AFF = (const float*)(F.ws + WS_AFF);
    int* ROWS = (int*)(F.ws + WS_ROWS); float* VALS = (float*)(F.ws + WS_VALS); int* TOK = (int*)(F.ws + WS_TOK);
    LAS unsigned* cntr = (LAS unsigned*)F.lds;
    LAS unsigned* cg = cntr + 64; LAS unsigned* ce = cntr + 96;
    const int nitems = (l == 0) ? 256 + 64 + 16 : 256;
    const int lane = F.lane, wave = F.wave;
    for (int it = bid; it < nitems; it += F.G) {
        if (it >= 320) {
            const int e = it - 320;
            for (int s = F.tid; s < 128; s += NTHR) { ROWS[e * ESLOT + 1152 + s] = -1; VALS[e * ESLOT + 1152 + s] = 0.f; }
            continue;
        }
        const int lat = it < 256, b = lat ? (it >> 6) : ((it - 256) >> 4), e = lat ? ((it >> 2) & 15) : ((it - 256) & 15), qtr = lat ? (it & 3) : 0;
        const int ntok = lat ? SEQ : CTXL, rowbase = lat ? b * SEQ : MLAT + b * CTXL, slotbase = lat ? b * 256 : 1024 + b * 32;
        const unsigned cap = (unsigned)(ntok >> 3);
        __syncthreads();
        if (F.tid < 128) cntr[F.tid] = 0u;
        unsigned key[4];
#pragma unroll
        for (int q = 0; q < 4; ++q) { const int i = q * 512 + F.tid; key[q] = i < ntok ? __float_as_uint(AFF[(size_t)e * MTOT + rowbase + i]) : 0u; }
        __syncthreads();
        unsigned T = 0u;
#pragma unroll 1
        for (int r = 0; r < 16; ++r) { const int sh = 30 - 2 * r;
            const unsigned c1 = T | (1u << sh), c2 = T | (2u << sh), c3 = T | (3u << sh);
            unsigned n1 = 0, n2 = 0, n3 = 0;
#pragma unroll
            for (int q = 0; q < 4; ++q) { n1 += (unsigned)__builtin_popcountll(__ballot(key[q] >= c1)); n2 += (unsigned)__builtin_popcountll(__ballot(key[q] >= c2)); n3 += (unsigned)__builtin_popcountll(__ballot(key[q] >= c3)); }
            if (lane == 0) { atomicAdd((unsigned*)(cntr + r * 4 + 0), n1); atomicAdd((unsigned*)(cntr + r * 4 + 1), n2); atomicAdd((unsigned*)(cntr + r * 4 + 2), n3); }
            __syncthreads();
            const unsigned t1 = cntr[r * 4 + 0], t2 = cntr[r * 4 + 1], t3 = cntr[r * 4 + 2];
            T = t3 >= cap ? c3 : (t2 >= cap ? c2 : (t1 >= cap ? c1 : T));
        }
        unsigned long long bg_own = 0ull, be_own = 0ull; unsigned kown = 0u;
#pragma unroll
        for (int q = 0; q < 4; ++q) { const unsigned long long bg = __ballot(key[q] > T), be = __ballot(key[q] == T);
            if (lane == 0) { cg[q * 8 + wave] = (unsigned)__builtin_popcountll(bg); ce[q * 8 + wave] = (unsigned)__builtin_popcountll(be); }
            if (q == qtr) { bg_own = bg; be_own = be; kown = key[q]; } }
        __syncthreads();
        unsigned ngt = 0, gtb = 0, eqb = 0; const int me = qtr * 8 + wave;
#pragma unroll 1
        for (int k = 0; k < 32; ++k) { const unsigned g = cg[k], q_ = ce[k]; ngt += g; if (k < me) { gtb += g; eqb += q_; } }
        const unsigned need = cap - ngt;
        const unsigned long long lt = (1ull << lane) - 1ull;
        const int i = qtr * 512 + F.tid; const bool act = i < ntok;
        const unsigned eqpos = eqb + (unsigned)__builtin_popcountll(be_own & lt);
        const bool sel = act && (kown > T || (kown == T && eqpos < need));
        const unsigned slot = gtb + (unsigned)__builtin_popcountll(bg_own & lt) + (eqpos < need ? eqpos : need);
        if (act) { TOK[(size_t)(rowbase + i) * 16 + e] = sel ? slotbase + (int)slot : -1;
            if (sel) { ROWS[e * ESLOT + slotbase + (int)slot] = rowbase + i; VALS[e * ESLOT + slotbase + (int)slot] = __uint_as_float(kown); } }
    }
    __syncthreads();
}
struct SchedMoe {
    const char* A; const char* Bt; int lda, ldb, nMt, nt, G, c, gather;
    DI bool next(int i, Unit& u) const {
        const long L0 = (long)i * G + c; const int nwg = NEXP * nMt * 8; if (L0 >= nwg) return false;
        const int L = ((int)L0 % 8) * (nwg / 8) + (int)L0 / 8;
        const int e = L / (nMt * 8), rem = L % (nMt * 8), mt = rem % nMt, pn = rem / nMt;
        u.pm = e * 5 + mt; u.pn = pn; u.aux = e; u.nt = nt; u.pa = gather ? A : A + ((size_t)e * ESLOT + mt * 256) * lda; u.pb = Bt + ((size_t)e * 2048 + pn * 256) * ldb; return true;
    }
};
struct SchedMoe2Early {
    const char* A; const char* Bt; int c;
    DI bool next(int i, Unit& u) const {
        if (i != 0 || c < 128 || c >= 256) return false;
        const int k = c - 128, x = k & 7, j = k >> 3, e = 2 * x, mt = j & 1, pn = j >> 1;
        u.pm = e * 5 + mt; u.pn = pn; u.aux = e; u.nt = 16; u.pa = A + ((size_t)e * ESLOT + mt * 256) * (EFF * 2); u.pb = Bt + ((size_t)e * 2048 + pn * 256) * (EFF * 2); return true;
    }
};
struct SchedMoe2Rest {
    const char* A; const char* Bt; int c;
    DI bool next(int i, Unit& u) const {
        if (i >= 2) return false;
        const int x = c & 7, j = i * 32 + (c >> 3); int e, mt, pn;
        if (j < 40) { e = 2 * x + 1; mt = j % 5; pn = j / 5; } else { const int r = j - 40; e = 2 * x; mt = 2 + r % 3; pn = r / 3; }
        u.pm = e * 5 + mt; u.pn = pn; u.aux = e; u.nt = 16; u.pa = A + ((size_t)e * ESLOT + mt * 256) * (EFF * 2); u.pb = Bt + ((size_t)e * 2048 + pn * 256) * (EFF * 2); return true;
    }
};
struct EpiMoe1 {
    bf16_t* ACT; unsigned* pub;
    DI void operator()(const f32x4 (&acc)[2][2][4][2], const Unit& u, int wr, int wc, int fr, int fq) const {
        const bool pubu = pub != nullptr && (u.aux & 1) == 0 && u.pm - u.aux * 5 < 2;
#pragma unroll
        for (int ai = 0; ai < 2; ++ai)
#pragma unroll
            for (int m = 0; m < 4; ++m) { const int row = u.pm * 256 + ai * 128 + wr * 64 + m * 16 + fr; const int col = u.pn * 128 + wc * 32 + 8 * fq;
                f32x4 r0, r1;
#pragma unroll
                for (int i = 0; i < 4; ++i) { r0[i] = siluf_(acc[ai][0][m][0][i]) * acc[ai][1][m][0][i]; r1[i] = siluf_(acc[ai][0][m][1][i]) * acc[ai][1][m][1][i]; }
                const u32x4 w_ = pack8(r0, r1);
                if (pubu) { GAS unsigned long long* ap = (GAS unsigned long long*)(ACT + (size_t)row * EFF + col);
                    __hip_atomic_store(ap, (unsigned long long)w_.x | ((unsigned long long)w_.y << 32), __ATOMIC_RELAXED, __HIP_MEMORY_SCOPE_AGENT);
                    __hip_atomic_store(ap + 1, (unsigned long long)w_.z | ((unsigned long long)w_.w << 32), __ATOMIC_RELAXED, __HIP_MEMORY_SCOPE_AGENT); }
                else *(u32x4*)(ACT + (size_t)row * EFF + col) = w_; }
        if (pubu) { asm volatile("s_waitcnt vmcnt(0)" ::: "memory");
            if ((fr | fq) == 0) __hip_atomic_fetch_add((GAS unsigned*)(pub + u.aux * 16), 1u, __ATOMIC_RELAXED, __HIP_MEMORY_SCOPE_AGENT); }
    }
};
struct EpiMoe2 {
    const float* VALS; bf16_t* YE;
    DI void operator()(const f32x4 (&acc)[2][2][4][2], const Unit& u, int wr, int wc, int fr, int fq) const {
        EPI_FOREACH({ const float val = VALS[row]; *(u32x4*)(YE + (size_t)row * DM + col) = pack8(v0 * val, v1 * val); })
    }
};
DI void phase_final(const Frame& F, const Args& a) {
    const float* g = a.in[I_FNORM]; const int* TOK = (const int*)(F.ws + WS_TOK); const float* X1 = (const float*)(F.ws + WS_X1);
    LAS float* gs = (LAS float*)F.lds;
    { const float* MODS = (const float*)(F.ws + WS_MODS);
      for (int i = F.tid; i < 4 * 512; i += NTHR) { const int r = i / 512, c4 = i % 512;
          *(LAS f32x4*)(gs + (size_t)r * DM + 4 * c4) = *(const f32x4*)(MODS + ((size_t)((DEPTH - 1) * 5 + r) * 6 + 5) * DM + 4 * c4); }
      __syncthreads(); }
    int row = F.gw; if (row >= MLAT) return;
    f32x4 cur[8]; load_row(X1 + (size_t)row * DM, F.lane, cur); int tcur = TOK[(size_t)row * 16 + (F.lane & 15)];
    f32x4 gv[8]; load_row(g, F.lane, gv);
    for (;;) {
        const int nrow = row + F.ngw; const bool hn = nrow < MLAT; const int pr = hn ? nrow : row;
        f32x4 nxt[8]; load_row(X1 + (size_t)pr * DM, F.lane, nxt); const int tnxt = TOK[(size_t)pr * 16 + (F.lane & 15)];
        f32x4 v[8]; float ss = 0.f;
        combine_row<true>(F, DEPTH - 1, row, cur, tcur, v, gs + (size_t)(row >> 11) * DM);
#pragma unroll
        for (int j = 0; j < 8; ++j) ss += v[j].x * v[j].x + v[j].y * v[j].y + v[j].z * v[j].z + v[j].w * v[j].w;
        const float rs = rsqrtf(wave_sum(ss) * (1.f / DM) + EPS);
#pragma unroll
        for (int j = 0; j < 8; ++j) *(f32x4*)(a.out + (size_t)row * DM + 4 * F.lane + 256 * j) = v[j] * rs * gv[j];
        if (!hn) break;
#pragma unroll
        for (int j = 0; j < 8; ++j) cur[j] = nxt[j];
        tcur = tnxt; row = nrow;
    }
}

#ifndef MK_LAST_PHASE
#define MK_LAST_PHASE 1000
#endif
constexpr int PH_PER_LAYER = 12, N_PHASES = 2 + 2 * PH_PER_LAYER + 1;
__global__ void __launch_bounds__(NTHR, 2) mega(const Args args) {
    extern __shared__ __attribute__((aligned(16))) unsigned char lds[];
    Frame F0;
    F0.lds = (LAS unsigned char*)lds; F0.ws = args.ws;
    F0.tid = threadIdx.x; F0.lane = F0.tid & 63; F0.wave = __builtin_amdgcn_readfirstlane(F0.tid >> 6);
    F0.G = gridDim.x; { const int bx = blockIdx.x; F0.vcu = (F0.G % 8 == 0) ? (bx % 8) * (F0.G / 8) + bx / 8 : bx; }
    F0.gw = F0.vcu * NWAVES + F0.wave; F0.ngw = F0.G * NWAVES;
    volatile LAS unsigned* MISC = (volatile LAS unsigned*)(F0.lds + LDS_BYTES - 64);
    if (F0.tid < 16) MISC[F0.tid] = 0u;
    __syncthreads();
    unsigned* ctl = (unsigned*)(F0.ws + WS_CTL);
    XcdBarrier bar = xcd_barrier_post(ctl + CW_BAR, MISC + 8);
    const int lo = args.ph_lo, hi = args.ph_hi;
    int ph = 0, bid = 0;
#ifndef MK_EN
#define MK_EN 0xFFFF
#endif
#define EN(x) ((MK_EN >> (x)) & 1)
#ifndef MK_REP
#define MK_REP 0
#endif
#ifndef MK_BARX
#define MK_BARX 0
#endif
#ifndef MK_REPB
#define MK_REPB 0
#endif
#ifndef MK_TPH
#define MK_TPH -1
#endif
#ifndef MK_TMODE
#define MK_TMODE 0
#endif
#ifndef MK_TQ
#define MK_TQ 40.f
#endif
#define REP(pid_) ((MK_REP >> (pid_)) & 1)
#define PHASE(pid_, ...) if (EN(pid_) && lo <= ph && ph < hi) { Frame F = F0; { unsigned long long w_ = (unsigned long long)F0.ws; asm volatile("" : "+s"(w_)); F.ws = (unsigned char*)w_; \
        asm volatile("" : "+s"(F.G), "+s"(F.vcu)); F.ngw = F.G * NWAVES; bid = blockIdx.x; asm volatile("" : "+s"(bid)); \
        int t_ = threadIdx.x; asm volatile("" : "+v"(t_)); F.tid = t_; F.lane = t_ & 63; F.wave = __builtin_amdgcn_readfirstlane(t_ >> 6); F.gw = F.vcu * NWAVES + F.wave; } \
        { const int rep = 0; (void)rep; __VA_ARGS__ } if (REP(pid_)) { if (MK_REPB) xcd_barrier(bar); const int rep = 1; (void)rep; __VA_ARGS__ } \
        if (MK_TPH >= 0 && threadIdx.x == 0) ((unsigned long long*)(F0.ws + WS_CTL + 1536 * 1024))[ph * 256 + blockIdx.x] = wall_clock64(); \
        if (ph + 1 < hi) { xcd_barrier(bar); if (MK_BARX) xcd_barrier(bar); } } ++ph;

#define PHASE5(...) if (EN(5) && lo <= ph && ph < hi) { Frame F = F0; { unsigned long long w_ = (unsigned long long)F0.ws; asm volatile("" : "+s"(w_)); F.ws = (unsigned char*)w_; \
        asm volatile("" : "+s"(F.G), "+s"(F.vcu)); F.ngw = F.G * NWAVES; bid = blockIdx.x; asm volatile("" : "+s"(bid)); \
        int t_ = threadIdx.x; asm volatile("" : "+v"(t_)); F.tid = t_; F.lane = t_ & 63; F.wave = __builtin_amdgcn_readfirstlane(t_ >> 6); F.gw = F.vcu * NWAVES + F.wave; } \
        { __VA_ARGS__ } if (MK_TPH >= 0 && threadIdx.x == 0) ((unsigned long long*)(F0.ws + WS_CTL + 1536 * 1024))[ph * 256 + blockIdx.x] = wall_clock64(); \
        if (ph + 1 < hi) { xcd_barrier(bar); if (MK_BARX) xcd_barrier(bar); } } ++ph;
    PHASE(0, phase_prologue(F, args, rep);)
    PHASE(14, phase_mods_reduce(F, args);)
    for (int l = 0; l < DEPTH; ++l) {
        const size_t wlo = WS_W + (size_t)l * W_LAYER;
        const int nM = (l == 0) ? 36 : 32;
        PHASE(1, if (MK_FILL && l == 1 && rep == 0) fill_convert(F, args, ph, true); phase_mod1(F, args, l);)
        PHASE(2, {
            SchedProj S{(const char*)(F.ws + WS_H), (const char*)(F.ws + wlo + W_IN), l, F.G, bid};
            EpiProj E{(bf16_t*)(F.ws + WS_P)};
            pg8::gemm_phase(F.lds, DM * 2, DM * 2, S, E); if (MK_FILL && l == 0 && rep == 0) fill_convert(F, args, ph, false); })
        PHASE(3, phase_postproj(F, args, l);)
        PHASE(4, {
            const bool defer = (l == 1 && F.G == 256);
            const int Gx = F.G - 36, xw = bid - Gx, BIG = 1 << 28, Gw = defer ? 144 : Gx, cw = bid < Gw ? bid : BIG;
            if (defer) { SchedDefer S{(const char*)(F.ws + WS_H), (const char*)(F.ws + wlo + W_IN), (bid >= 144 && bid < 220) ? bid - 144 : -1};
              EpiProj E{(bf16_t*)(F.ws + WS_P)}; pg8::gemm_phase(F.lds, DM * 2, DM * 2, S, E); }
            { SchedDense S{(const char*)(F.ws + WS_H), (const char*)(F.ws + wlo + W_IN) + (size_t)C_X * DM * 2, DM * 2, DM * 2, 36, 1, 32, 36, xw >= 0 ? xw : BIG};
              EpiX E{(bf16_t*)(F.ws + WS_KR), (float*)(F.ws + WS_X80), (const float*)(F.ws + WS_ROPE_LA)}; pg8::gemm_phase(F.lds, DM * 2, DM * 2, S, E); }
            { SchedDense S{(const char*)(F.ws + WS_CQN), (const char*)(F.ws + wlo + W_UQ), 512 * 2, 512 * 2, nM, 6, 8, Gw, cw};
              EpiStoreBf16 E{(bf16_t*)(F.ws + WS_QLA), 1536}; pg8::gemm_phase(F.lds, 512 * 2, 512 * 2, S, E); }
            { SchedDense S{(const char*)(F.ws + WS_CKVN), (const char*)(F.ws + wlo + W_UKV), 256 * 2, 256 * 2, 36, 8, 4, defer ? 96 : Gw, defer ? ((bid >= 48 && bid < 144) ? bid - 48 : BIG) : (bid < Gw ? (bid + Gw / 2) % Gw : BIG)};
              EpiStoreBf16 E{(bf16_t*)(F.ws + WS_KVLA), 2048}; pg8::gemm_phase(F.lds, 256 * 2, 256 * 2, S, E); }
            if (MK_FILL && l == 0 && rep == 0) fill_convert(F, args, ph, false); })
        PHASE5(if (MK_CVSIDE) phase_convert_side(F, args, bid, l == 0 ? IT_EARLY : IT_LAYER + IT_EARLY, l == 0 ? IT_LAYER + IT_EARLY : 2 * IT_LAYER); phase_mixers(F, args, l, (char*)lds, 1 + REP(5)); if (MK_CONVTAIL) phase_convert_tail(F, args, l);)
        PHASE(6, phase_mlfin(F, args, l, nM * 256);)
        PHASE(7, {
            SchedMerge S{(const char*)(F.ws + WS_YCAT), (const char*)(F.ws + wlo + W_BR), nM, F.G, bid};
            EpiMerge E{(const bf16_t*)(F.ws + WS_P), (bf16_t*)(F.ws + WS_MF32), (bf16_t*)(F.ws + WS_MBF), (bf16_t*)(F.ws + WS_H), (unsigned*)(F.ws + WS_CTL) + CW_MCNT, (unsigned*)(F.ws + WS_CTL) + CW_ODONE};
            pg8::gemm_phase(F.lds, 3072 * 2, 1024 * 2, S, E);
            if (l == 0 && F.G == 256 && bid >= 96 && bid < 160 && rep == 0) {
                unsigned* od = (unsigned*)(F.ws + WS_CTL) + CW_ODONE + (((bid - 96) >> 1) >> 3) * 16;
                if (F.tid == 0) { unsigned sp = 0; while (xb_ld(od) < 64u && ++sp < (1u << 22)) __builtin_amdgcn_s_sleep(2); }
                __syncthreads();
                __builtin_amdgcn_fence(__ATOMIC_ACQUIRE, "agent");
                SchedOutCtx S2{(const char*)(F.ws + WS_MBF), (const char*)(F.ws + wlo + W_OUT), bid};
                EpiOut E2{args.in[I_X], args.in[I_CTX], (float*)(F.ws + WS_X1), (const float*)(F.ws + WS_MODS), l, (bf16_t*)(F.ws + WS_H + (16u << 20)), (unsigned*)(F.ws + WS_CTL) + CW_OCNT};
                pg8::gemm_phase(F.lds, DM * 2, DM * 2, S2, E2); } })
        PHASE(8, {
            SchedDense S{(const char*)(F.ws + WS_MBF), (const char*)(F.ws + wlo + W_OUT), DM * 2, DM * 2, (l == 0 && F.G == 256) ? 32 : nM, 8, 32, F.G, bid};
            EpiOut E{args.in[I_X], args.in[I_CTX], (float*)(F.ws + WS_X1), (const float*)(F.ws + WS_MODS), l, nullptr, nullptr};
            if (rep == 0 || l == 0) pg8::gemm_phase(F.lds, DM * 2, DM * 2, S, E); if (MK_FILL && l == 0 && rep == 0) fill_convert(F, args, ph, false); })
        PHASE(9, phase_mod2(F, args, l, nM * 256);)
        PHASE(10, phase_topk(F, args, l, bid);)
        PHASE(11, {
            SchedMoe S{(const char*)(F.ws + WS_H), (const char*)(F.ws + wlo + W_E13), DM * 2, DM * 2, (l == 0) ? 5 : 4, 32, F.G, bid, 1};
            const bool early = (l == 0 && F.G == 256 && rep == 0);
            EpiMoe1 E{(bf16_t*)(F.ws + WS_ACT), early ? (unsigned*)(F.ws + WS_CTL) + CW_E1CNT : nullptr};
            pg8::gemm_phase<true>(F.lds, DM * 2, DM * 2, S, E, (const int*)(F.ws + WS_ROWS));
            if (early && bid >= 128) {
                unsigned* ec = (unsigned*)(F.ws + WS_CTL) + CW_E1CNT + (2 * ((bid - 128) & 7)) * 16;
                if (F.tid == 0) { unsigned sp = 0; while (xb_ld(ec) < 128u && ++sp < (1u << 22)) __builtin_amdgcn_s_sleep(2); }
                __syncthreads();
                __builtin_amdgcn_fence(__ATOMIC_ACQUIRE, "agent");
                SchedMoe2Early S2{(const char*)(F.ws + WS_ACT), (const char*)(F.ws + wlo + W_E2), bid};
                EpiMoe2 E2{(const float*)(F.ws + WS_VALS), (bf16_t*)(F.ws + WS_YE)};
                pg8::gemm_phase(F.lds, EFF * 2, EFF * 2, S2, E2); } })
        PHASE(12, {
            EpiMoe2 E{(const float*)(F.ws + WS_VALS), (bf16_t*)(F.ws + WS_YE)};
            if (l == 0 && F.G == 256) { SchedMoe2Rest S{(const char*)(F.ws + WS_ACT), (const char*)(F.ws + wlo + W_E2), bid}; pg8::gemm_phase(F.lds, EFF * 2, EFF * 2, S, E); }
            else { SchedMoe S{(const char*)(F.ws + WS_ACT), (const char*)(F.ws + wlo + W_E2), EFF * 2, EFF * 2, (l == 0) ? 5 : 4, 16, F.G, bid, 0}; pg8::gemm_phase(F.lds, EFF * 2, EFF * 2, S, E); } })
    }
    PHASE(13, phase_final(F, args);)
    if (MK_TPH >= 0) {
        xcd_barrier(bar);
        if (blockIdx.x == 0 && threadIdx.x == 0) {
            const unsigned long long* st = (const unsigned long long*)(F0.ws + WS_CTL + 1536 * 1024);
            unsigned long long mx = 0, mxp = 0, sum = 0; const int G = gridDim.x;
            for (int bq = 0; bq < G; ++bq) { const unsigned long long e = st[MK_TPH * 256 + bq], p = st[(MK_TPH - 1) * 256 + bq]; mx = e > mx ? e : mx; mxp = p > mxp ? p : mxp; sum += e; }
            const float dur = MK_TMODE == 0 ? (float)(mx - mxp) * 0.01f : (float)((double)sum / G - (double)mxp) * 0.01f;
            args.out[0] = 20.f + floorf(dur / MK_TQ) * MK_TQ;
        }
    }
#undef PHASE
}


extern "C" void kernel_launch(void* const* d_in, const int* in_sizes, int n_in, void* d_out, int out_size, void* d_ws, size_t ws_size, hipStream_t stream) {
    static int grid = 0;
    if (grid == 0) {
        if (n_in != 24 || out_size != MLAT * DM || ws_size < WS_END) { fprintf(stderr, "kernel_launch: unexpected shapes: n_in %d out %d ws %zu (need %zu)\n", n_in, out_size, ws_size, (size_t)WS_END); grid = -1; return; }
        int dev = 0, cus = 0, per_cu = 0;
        if (hipGetDevice(&dev) != hipSuccess || hipDeviceGetAttribute(&cus, hipDeviceAttributeMultiprocessorCount, dev) != hipSuccess) { grid = -1; return; }
        if (hipFuncSetAttribute((const void*)mega, hipFuncAttributeMaxDynamicSharedMemorySize, LDS_BYTES) != hipSuccess) { fprintf(stderr, "kernel_launch: hipFuncSetAttribute failed\n"); grid = -1; return; }
        if (hipOccupancyMaxActiveBlocksPerMultiprocessor(&per_cu, (const void*)mega, NTHR, LDS_BYTES) != hipSuccess || per_cu < 1) { fprintf(stderr, "kernel_launch: occupancy query says %d blocks per CU\n", per_cu); }
        (void)hipGetLastError();
        grid = cus;
    }
    if (grid < 0) return;
    if (hipMemsetAsync((char*)d_ws + WS_CTL, 0, CTL_BYTES, stream) != hipSuccess) return;
    Args a{};
    for (int i = 0; i < 24; ++i) a.in[i] = (const float*)d_in[i];
    a.out = (float*)d_out; a.ws = (unsigned char*)d_ws; a.ph_lo = 0; a.ph_hi = N_PHASES < MK_LAST_PHASE ? N_PHASES : MK_LAST_PHASE;
    hipLaunchKernelGGL(mega, dim3(grid), dim3(NTHR), LDS_BYTES, stream, a);
}
```

```cpp
#include <hip/hip_runtime.h>
#include <cstdio>
#include <cstdint>

#define GAS __attribute__((address_space(1)))
#define LAS __attribute__((address_space(3)))
#define DI __device__ __forceinline__
typedef unsigned short bf16_t;
typedef short bf16x8 __attribute__((ext_vector_type(8)));
typedef short s16x4 __attribute__((ext_vector_type(4)));
typedef float f32x2 __attribute__((ext_vector_type(2)));
typedef float f32x4 __attribute__((ext_vector_type(4)));
typedef float f32x8 __attribute__((ext_vector_type(8)));
typedef float f32x16 __attribute__((ext_vector_type(16)));
typedef unsigned u32x2 __attribute__((ext_vector_type(2)));
typedef unsigned u32x4 __attribute__((ext_vector_type(4)));

constexpr int DM = 2048, NBATCH = 4, SEQ = 2048, CTXL = 256, DEPTH = 2;
constexpr int MLAT = NBATCH * SEQ, MCTX = NBATCH * CTXL, MTOT = MLAT + MCTX;
constexpr int PROJW = 12624, NP = 12800;
constexpr int C_MLQ = 0, C_MLK = 1024, C_MLV = 2048, C_MLO = 3072, C_CQ = 4096, C_CKV = 4608, C_GQ = 4864, C_GK = 5888, C_GV = 6144, C_GATE = 6400, C_X = 12544;
constexpr int XW = 80;
constexpr int NEXP = 16, EFF = 1024, ESLOT = 1280;
constexpr float EPS = 1e-6f;
constexpr int NWAVES = 8, NTHR = 512;

constexpr size_t al256(size_t x) { return (x + 255) / 256 * 256; }
constexpr size_t WS_CTL = 0, CTL_BYTES = 2u << 20;
constexpr int CW_BAR = 1024;
constexpr int CW_QUEUE = 8192;
constexpr int CW_CVHEAD = 12288;
constexpr int CW_MCNT = 20480;
constexpr int CW_OCNT = 24576;
constexpr int CW_ODONE = 28672;
constexpr int CW_E1CNT = 29696;
constexpr int CW_PHDONE = 32768;
constexpr size_t WS_MODS = 1u << 20;
constexpr size_t WS_ROPE_LA = WS_CTL + CTL_BYTES;
constexpr size_t WS_ROPE_GA = WS_ROPE_LA + al256((size_t)2048 * 32 * 2 * 4);
constexpr size_t WS_W = WS_ROPE_GA + al256((size_t)2048 * 64 * 2 * 4);
constexpr size_t W_IN = 0, W_UQ = W_IN + (size_t)NP * DM * 2, W_UKV = W_UQ + (size_t)1536 * 512 * 2, W_BR = W_UKV + (size_t)2048 * 256 * 2,
                 W_OUT = W_BR + (size_t)3 * 2048 * 1024 * 2, W_E13 = W_OUT + (size_t)2048 * 2048 * 2, W_E2 = W_E13 + (size_t)NEXP * 2048 * 2048 * 2,
                 W_LAYER = W_E2 + (size_t)NEXP * 2048 * 1024 * 2;
constexpr size_t WS_H = WS_W + 2 * W_LAYER;
constexpr size_t WS_P = WS_H + (size_t)MTOT * DM * 2;
constexpr size_t WS_AG = WS_P;
constexpr size_t WS_ACT = WS_AG + (size_t)NEXP * ESLOT * DM * 2;
static_assert(WS_ACT + (size_t)NEXP * ESLOT * EFF * 2 <= WS_P + (size_t)MTOT * NP * 2, "overlay");
constexpr size_t WS_X80 = WS_P + (size_t)MTOT * NP * 2;
constexpr size_t WS_CQN = WS_X80 + al256((size_t)MTOT * XW * 4);
constexpr size_t WS_CKVN = WS_CQN + (size_t)MTOT * 512 * 2;
constexpr size_t WS_QG = WS_CKVN + (size_t)MTOT * 256 * 2;
constexpr size_t WS_KG = WS_QG + (size_t)MTOT * 1024 * 2;
constexpr size_t WS_KR = WS_KG + (size_t)MTOT * 256 * 2;
constexpr size_t WS_QLA = WS_KR + (size_t)MTOT * 64 * 2;
constexpr size_t WS_KVLA = WS_QLA + (size_t)MTOT * 1536 * 2;
constexpr size_t WS_YCAT = WS_KVLA + (size_t)MTOT * 2048 * 2;
constexpr size_t WS_MF32 = WS_YCAT + (size_t)MTOT * 3072 * 2;
constexpr size_t WS_MLH = WS_MF32;
constexpr size_t WS_MBF = WS_MF32 + (size_t)MTOT * DM * 4;
constexpr size_t WS_X1 = WS_MBF + (size_t)MTOT * DM * 2;
constexpr size_t WS_AFF = WS_X1 + (size_t)MTOT * DM * 4;
constexpr size_t WS_ROWS = WS_AFF + (size_t)MTOT * 16 * 4;
constexpr size_t WS_VALS = WS_ROWS + (size_t)NEXP * ESLOT * 4;
constexpr size_t WS_TOK = WS_VALS + (size_t)NEXP * ESLOT * 4;
constexpr size_t WS_MPART = WS_TOK + (size_t)MTOT * 16 * 4;
constexpr size_t WS_END = WS_MPART + (size_t)16 * 2 * 5 * 12288 * 4;
constexpr size_t WS_YE = WS_AG;

constexpr int RING_BYTES = 131072;
constexpr int MISC_OFF = RING_BYTES + 1024;
constexpr int LDS_BYTES = 147456;

DI float bf2f(unsigned short b) { return __uint_as_float(((unsigned)b) << 16); }
DI unsigned f2bf(float f) { unsigned u = __float_as_uint(f); return (u + 0x7fffu + ((u >> 16) & 1u)) >> 16; }
DI unsigned pk2(float lo, float hi) { unsigned r; asm volatile("v_cvt_pk_bf16_f32 %0, %1, %2" : "=v"(r) : "v"(lo), "v"(hi)); return r; }
DI int lane_id_() { int l = __builtin_amdgcn_mbcnt_hi(~0u, __builtin_amdgcn_mbcnt_lo(~0u, 0u)); asm volatile("" : "+v"(l)); return l; }
DI float bperm_f(float v, int srclane) { return __int_as_float(__builtin_amdgcn_ds_bpermute(srclane << 2, __float_as_int(v))); }
DI float shx(float v, int o) { return bperm_f(v, lane_id_() ^ o); }
DI float shl_(float v, int src) { return bperm_f(v, src); }
DI float shu(float v, int o) { const int l = lane_id_(); return bperm_f(v, l >= o ? l - o : l); }
DI float wave_sum(float v) { const int l = lane_id_();
#pragma unroll
    for (int o = 1; o < 64; o <<= 1) v += bperm_f(v, l ^ o);
    return v;
}
DI float wave_max(float v) { const int l = lane_id_();
#pragma unroll
    for (int o = 1; o < 64; o <<= 1) v = fmaxf(v, bperm_f(v, l ^ o));
    return v;
}
DI float sigmoidf_(float x) { return __builtin_amdgcn_rcpf(1.f + __expf(-x)); }
DI float siluf_(float x) { return x * __builtin_amdgcn_rcpf(1.f + __expf(-x)); }
#define LDS_WAIT() asm volatile("s_waitcnt lgkmcnt(0)" ::: "memory")
#define VM_WAIT() asm volatile("s_waitcnt vmcnt(0)" ::: "memory")

#define XB_TMO      128
#define XB_XCNT(j)  (256  + 64 * (j))
#define XB_XSUB(j)  (1280 + 64 * (j))
#define XB_XGEN(j)  (2304 + 64 * (j))
#define XB_TOP      3328
#define XB_TOPGEN   3392
#define XCD_BAR_WORDS 3456
#define XB_SPIN_CAP (1u << 20)

DI unsigned xb_ld(unsigned* p)              { return __hip_atomic_load(p, __ATOMIC_RELAXED, __HIP_MEMORY_SCOPE_AGENT); }
DI unsigned xb_add(unsigned* p, unsigned v) { return __hip_atomic_fetch_add(p, v, __ATOMIC_RELAXED, __HIP_MEMORY_SCOPE_AGENT); }
DI unsigned xb_xcc_id() { return (unsigned)__builtin_amdgcn_s_getreg((3 << 11) | 20) & 0xFu; }
#define XB_SPIN(cond, bar) do { unsigned _sp = 0; while (cond) { __builtin_amdgcn_s_sleep(1); \
    if ((++_sp & 255u) == 0u) { if (xb_ld(&(bar)[XB_TMO])) break; if (_sp > XB_SPIN_CAP) { atomicAdd(&(bar)[XB_TMO], 1u); break; } } } } while (0)

struct XcdBarrier { unsigned* bar; unsigned x; volatile LAS unsigned* st; };

DI XcdBarrier xcd_barrier_post(unsigned* bar, volatile LAS unsigned* st) {
    XcdBarrier b; b.bar = bar; b.x = xb_xcc_id(); b.st = st;
    if (threadIdx.x == 0) (void)xb_add(&bar[XB_XCNT(b.x)], 1u);
    return b;
}
DI void xcd_barrier_complete(unsigned* bar, unsigned x, unsigned& nloc, unsigned& nx) {
    const unsigned G = gridDim.x * gridDim.y * gridDim.z;
    unsigned sum, cnt, mine, sp = 0u;
    for (;;) {
        sum = 0u; cnt = 0u; mine = 0u;
#pragma unroll
        for (unsigned j = 0; j < 16; ++j) { const unsigned c = xb_ld(&bar[XB_XCNT(j)]); sum += c; cnt += (c > 0u) ? 1u : 0u; mine = (j == x) ? c : mine; }
        if (sum == G) break;
        __builtin_amdgcn_s_sleep(1);
        if ((++sp & 255u) == 0u) { if (xb_ld(&bar[XB_TMO])) break; if (sp > XB_SPIN_CAP) { atomicAdd(&bar[XB_TMO], 1u); break; } }
    }
    nloc = mine > 0u ? mine : 1u; nx = cnt > 0u ? cnt : 1u;
}
DI void xcd_barrier(const XcdBarrier& b) {
    asm volatile("s_waitcnt vmcnt(0)" ::: "memory");
    __syncthreads();
    if (threadIdx.x == 0) {
        unsigned* bar = b.bar; asm volatile("" : "+s"(bar));
        __builtin_amdgcn_s_waitcnt(0);
        unsigned nloc = b.st[0], nx = b.st[1];
        unsigned bx = b.x; asm volatile("" : "+s"(bx));
        if (nloc == 0u) { xcd_barrier_complete(bar, bx, nloc, nx); b.st[0] = nloc; b.st[1] = nx; }
        const unsigned old = xb_add(&bar[XB_XSUB(bx)], 1u);
        const unsigned gen = old / nloc;
        if (old + 1u == (gen + 1u) * nloc) {
            __builtin_amdgcn_fence(__ATOMIC_RELEASE, "agent");
            asm volatile("s_waitcnt vmcnt(0)" ::: "memory");
            const unsigned og = xb_add(&bar[XB_TOP], 1u);
            const unsigned tg = og / nx;
            if (og + 1u == (tg + 1u) * nx) xb_add(&bar[XB_TOPGEN], 1u);
            else XB_SPIN(xb_ld(&bar[XB_TOPGEN]) == tg, bar);
            __builtin_amdgcn_fence(__ATOMIC_ACQUIRE, "agent");
            xb_add(&bar[XB_XGEN(bx)], 1u);
            asm volatile("s_waitcnt vmcnt(0)" ::: "memory");
        } else {
            XB_SPIN(xb_ld(&bar[XB_XGEN(bx)]) == gen, bar);
            __builtin_amdgcn_fence(__ATOMIC_ACQUIRE, "agent");
            asm volatile("s_waitcnt vmcnt(0)" ::: "memory");
        }
    }
    __syncthreads();
}

struct Args { const float* in[24]; float* out; unsigned char* ws; int ph_lo, ph_hi; };
enum { I_X = 0, I_C, I_CTX, I_CCTX, I_WMOD, I_BMOD, I_WIN, I_GBIAS, I_MLNORM, I_LAQN, I_LAKVN, I_UQ, I_UKV, I_GAQN, I_GAKN, I_BRML, I_BRLA, I_BRGA, I_WOUT, I_WROUTER, I_WE1, I_WE3, I_WE2, I_FNORM };

struct Frame {
    LAS unsigned char* lds;
    unsigned char* ws;
    int tid, lane, wave, G, vcu, gw, ngw;
};

DI int mods_row(int row) { return row < MLAT ? (row >> 11) : 4; }
DI const float* mods_ptr(const Frame& F, int l, int row, int which  ) {
    return (const float*)(F.ws + WS_MODS) + ((size_t)(l * 5 + mods_row(row)) * 6 + which) * DM;
}

namespace pg8 {
constexpr int BM = 256, BK = 64, HALF = 128, HTB = HALF * BK * 2, STAGE_BYTES = 8 * HTB, NXCD = 8, WGM = 8;
__host__ __device__ __forceinline__ int lds_byte(int r, int c) { const int st = (r >> 4) * 2 + (c >> 5), rr = r & 15, cc = c & 31, ob = rr * 64 + cc * 2; return st * 1024 + (ob ^ (((ob >> 9) & 1) << 5)); }
__host__ __device__ __forceinline__ void stage_rc(int b, int& R, int& C) { const int st = b / 1024, sb = b % 1024, swz = sb ^ (((sb >> 9) & 1) << 5); R = (st >> 1) * 16 + swz / 64; C = (st & 1) * 32 + (swz % 64) / 2; }
__host__ __device__ __forceinline__ int perm32(int rho) { const int n = rho >> 4, i = rho & 15; return 8 * (i >> 2) + 4 * n + (i & 3); }

struct Unit { const char* pa; const char* pb; int pm, pn, aux, nt; };

DI void tile_of(int L, int nM, int nN, int& pm, int& pn) {
    const int nwg = nM * nN; int wgid = L;
    { const int q = nwg / NXCD, r = nwg % NXCD, xcd = wgid % NXCD, off = wgid / NXCD; wgid = (xcd < r ? xcd * (q + 1) : r * (q + 1) + (xcd - r) * q) + off; }
    const int nig = WGM * nN, gid = wgid / nig, fm = gid * WGM, gsz = (nM - fm) < WGM ? (nM - fm) : WGM;
    pm = fm + ((wgid % nig) % gsz); pn = (wgid % nig) / gsz;
}

template <bool GATHER = false, int AAUX = 0, class Epi, class Sched>
DI void gemm_phase(LAS unsigned char* lds, const int lda  , const int ldb  , const Sched& S, const Epi& E, const int* rows = nullptr) {
    int tid = threadIdx.x; asm volatile("" : "+v"(tid));
    const int wid = __builtin_amdgcn_readfirstlane(tid >> 6), lane = tid & 63, wr = wid >> 2, wc = wid & 3, fr = lane & 15, fq = lane >> 4;
    unsigned vA0[2], vA1[2], nA0[2], nA1[2], voffB[2]; int sR[2], sC[2];
#pragma unroll
    for (int i = 0; i < 2; ++i) { int R, C; stage_rc(tid * 16 + i * 8192, R, C); const int Rb = (R & ~31) + perm32(R & 31); sR[i] = R; sC[i] = C;
        vA0[i] = (unsigned)(R * lda + C * 2); vA1[i] = (unsigned)((R + HALF) * lda + C * 2); nA0[i] = vA0[i]; nA1[i] = vA1[i]; voffB[i] = (unsigned)(Rb * ldb + C * 2); }
#define PG8_GATHER_OFFS(u_, d0, d1) do { if (GATHER) { _Pragma("unroll") for (int i = 0; i < 2; ++i) { const int r0_ = rows[(u_).pm * 256 + sR[i]], r1_ = rows[(u_).pm * 256 + HALF + sR[i]]; \
        d0[i] = (unsigned)((r0_ < 0 ? 0 : r0_) * lda + sC[i] * 2); d1[i] = (unsigned)((r1_ < 0 ? 0 : r1_) * lda + sC[i] * 2); } } } while (0)
    const size_t kstep = (size_t)(BK * 2);
    const size_t hstepB = (size_t)HALF * ldb;
    const unsigned ldsw = (unsigned)wid * 1024u;
    const int aoff = lds_byte(wr * 64 + fr, fq * 8), boff = lds_byte(wc * 32 + fr, fq * 8);
#define PG8_SA(b, h) (((b) * 2 + (h)) * HTB)
#define PG8_SB(b, h) ((4 + (b) * 2 + (h)) * HTB)
#define PG8_STAGE(bufoff, gbase, voff) do { _Pragma("unroll") for (int _i = 0; _i < 2; ++_i) \
        __builtin_amdgcn_global_load_lds((const unsigned*)((const char*)(gbase) + (voff)[_i]), (LAS unsigned*)(lds + (bufoff) + ldsw + _i * 8192), 16, 0, 0); } while (0)
#define PG8_STAGEA(bufoff, gbase, voff) do { _Pragma("unroll") for (int _i = 0; _i < 2; ++_i) \
        __builtin_amdgcn_global_load_lds((const unsigned*)((const char*)(gbase) + (voff)[_i]), (LAS unsigned*)(lds + (bufoff) + ldsw + _i * 8192), 16, 0, AAUX); } while (0)
#define PG8_LDA(dst, b, h) do { _Pragma("unroll") for (int m = 0; m < 4; ++m) _Pragma("unroll") for (int k = 0; k < 2; ++k) dst[m][k] = *(const LAS bf16x8*)(lds + PG8_SA(b, h) + aoff + m * 2048 + k * 1024); } while (0)
#define PG8_LDB(dst, b, h) do { _Pragma("unroll") for (int n = 0; n < 2; ++n) _Pragma("unroll") for (int k = 0; k < 2; ++k) dst[n][k] = *(const LAS bf16x8*)(lds + PG8_SB(b, h) + boff + n * 2048 + k * 1024); } while (0)
#define PG8_MMA(ai, bj, At, Bt) do { __builtin_amdgcn_s_setprio(1); _Pragma("unroll") for (int m = 0; m < 4; ++m) _Pragma("unroll") for (int n = 0; n < 2; ++n) _Pragma("unroll") for (int k = 0; k < 2; ++k) \
        acc[ai][bj][m][n] = __builtin_amdgcn_mfma_f32_16x16x32_bf16(Bt[n][k], At[m][k], acc[ai][bj][m][n], 0, 0, 0); __builtin_amdgcn_s_setprio(0); } while (0)
#define PG8_WAIT_V(n) asm volatile("s_waitcnt vmcnt(" #n ")" ::: "memory")
#define PG8_WAIT_L(n) asm volatile("s_waitcnt lgkmcnt(" #n ")" ::: "memory")
#define PG8_BAR __builtin_amdgcn_s_barrier()
#define PG8_SCHED __builtin_amdgcn_sched_barrier(0)
    Unit cur, nxt; int ui = 0;
    if (!S.next(0, cur)) return;
    f32x4 acc[2][2][4][2];
#pragma unroll
    for (int a = 0; a < 2; ++a)
#pragma unroll
        for (int b = 0; b < 2; ++b)
#pragma unroll
            for (int m = 0; m < 4; ++m)
#pragma unroll
                for (int n = 0; n < 2; ++n) acc[a][b][m][n] = (f32x4){0.f, 0.f, 0.f, 0.f};
    bf16x8 At[4][2], B0[2][2], B1[2][2];
    const char* cA = cur.pa; const char* cB = cur.pb;
    PG8_GATHER_OFFS(cur, vA0, vA1);
    PG8_STAGE(PG8_SB(0, 0), cB, voffB); PG8_STAGEA(PG8_SA(0, 0), cA, vA0); PG8_STAGE(PG8_SB(0, 1), cB + hstepB, voffB); PG8_STAGEA(PG8_SA(0, 1), cA, vA1);
    if (wr == 1) PG8_BAR;
    PG8_WAIT_V(4); PG8_BAR;
    PG8_STAGE(PG8_SB(1, 0), cB + kstep, voffB); PG8_STAGEA(PG8_SA(1, 0), cA + kstep, vA0); PG8_STAGE(PG8_SB(1, 1), cB + hstepB + kstep, voffB);
    PG8_WAIT_V(6); PG8_BAR;
    for (;;) {
        const bool has_next = S.next(ui + 1, nxt);
        const char* nA = has_next ? nxt.pa : cA; const char* nB = has_next ? nxt.pb : cB;
        if (GATHER) { if (has_next) PG8_GATHER_OFFS(nxt, nA0, nA1); else { _Pragma("unroll") for (int i = 0; i < 2; ++i) { nA0[i] = vA0[i]; nA1[i] = vA1[i]; } } }
        const int nt = cur.nt;
        for (int t = 0; t < nt; t += 2) {
            const bool last = (t == nt - 2);
            const char* a1 = cA + (size_t)(t + 1) * kstep;
            const char* a2 = last ? nA : cA + (size_t)(t + 2) * kstep; const char* b2 = last ? nB : cB + (size_t)(t + 2) * kstep;
            const char* a3 = a2 + kstep; const char* b3 = b2 + kstep;
            unsigned wA0[2], wA1[2];
            _Pragma("unroll") for (int i = 0; i < 2; ++i) { wA0[i] = last ? nA0[i] : vA0[i]; wA1[i] = last ? nA1[i] : vA1[i]; }
            PG8_LDB(B0, 0, 0); PG8_SCHED; PG8_LDA(At, 0, 0); PG8_STAGEA(PG8_SA(1, 1), a1, vA1);
            PG8_WAIT_L(8); PG8_BAR; PG8_WAIT_L(0); PG8_MMA(0, 0, At, B0); PG8_BAR; PG8_SCHED;
            PG8_LDB(B1, 0, 1); PG8_STAGE(PG8_SB(0, 0), b2, voffB);
            PG8_BAR; PG8_WAIT_L(0); PG8_MMA(0, 1, At, B1); PG8_BAR;
            PG8_LDA(At, 0, 1); PG8_STAGEA(PG8_SA(0, 0), a2, wA0);
            PG8_BAR; PG8_WAIT_L(0); PG8_MMA(1, 0, At, B0); PG8_BAR; PG8_SCHED;
            PG8_STAGE(PG8_SB(0, 1), b2 + hstepB, voffB);
            PG8_WAIT_V(6); PG8_BAR; PG8_MMA(1, 1, At, B1); PG8_BAR;
            PG8_LDB(B0, 1, 0); PG8_SCHED; PG8_LDA(At, 1, 0); PG8_STAGEA(PG8_SA(0, 1), a2, wA1);
            PG8_WAIT_L(8); PG8_BAR; PG8_WAIT_L(0); PG8_MMA(0, 0, At, B0); PG8_BAR; PG8_SCHED;
            PG8_LDB(B1, 1, 1); PG8_STAGE(PG8_SB(1, 0), b3, voffB);
            PG8_BAR; PG8_WAIT_L(0); PG8_MMA(0, 1, At, B1); PG8_BAR;
            PG8_LDA(At, 1, 1); PG8_STAGEA(PG8_SA(1, 0), a3, wA0);
            PG8_BAR; PG8_WAIT_L(0); PG8_MMA(1, 0, At, B0); PG8_BAR; PG8_SCHED;
            PG8_STAGE(PG8_SB(1, 1), b3 + hstepB, voffB);
            PG8_WAIT_V(6); PG8_BAR; PG8_MMA(1, 1, At, B1); PG8_BAR;
        }
        E(acc, cur, wr, wc, fr, fq);
        if (!has_next) break;
#pragma unroll
        for (int a = 0; a < 2; ++a)
#pragma unroll
            for (int b = 0; b < 2; ++b)
#pragma unroll
                for (int m = 0; m < 4; ++m)
#pragma unroll
                    for (int n = 0; n < 2; ++n) acc[a][b][m][n] = (f32x4){0.f, 0.f, 0.f, 0.f};
        cur = nxt; cA = nA; cB = nB; ++ui;
        if (GATHER) { _Pragma("unroll") for (int i = 0; i < 2; ++i) { vA0[i] = nA0[i]; vA1[i] = nA1[i]; } }
    }
    PG8_WAIT_V(0);
    if (wr == 0) PG8_BAR;
    PG8_BAR;
#undef PG8_GATHER_OFFS
#undef PG8_SA
#undef PG8_SB
#undef PG8_STAGE
#undef PG8_STAGEA
#undef PG8_LDA
#undef PG8_LDB
#undef PG8_MMA
#undef PG8_WAIT_V
#undef PG8_WAIT_L
#undef PG8_BAR
#undef PG8_SCHED
}
}
using pg8::Unit;

struct SchedDense {
    const char* A; const char* Bt; int lda, ldb, nM, nN, nt, G, c;
    DI bool next(int i, Unit& u) const {
        const long L = (long)i * G + c; if (L >= (long)nM * nN) return false;
        int pm, pn; pg8::tile_of((int)L, nM, nN, pm, pn);
        u.pm = pm; u.pn = pn; u.aux = 0; u.nt = nt; u.pa = A + (size_t)pm * 256 * lda; u.pb = Bt + (size_t)pn * 256 * ldb; return true;
    }
};

struct SchedProj {
    const char* A; const char* Bt; int l, G, c;
    DI bool next(int i, Unit& u) const {
        const long L = (long)i * G + c; int pm, pn;
        if (l == 0) { if (L >= 36 * 49) return false; pg8::tile_of((int)L, 36, 49, pm, pn); }
        else if (G == 256) {
            if (L >= 32 * 47 + 8 + 24) return false;
            if (L < 32 * 47) pg8::tile_of((int)L, 32, 47, pm, pn);
            else if (L < 32 * 47 + 8) { const int r = (int)L - 32 * 47; pm = 32 + (r >> 1); pn = (r & 1) ? 23 : 18; }
            else { pm = (int)L - (32 * 47 + 8); pn = 47; } }
        else { if (L >= 32 * 49 + 44) return false;
            if (L < 32 * 49) pg8::tile_of((int)L, 32, 49, pm, pn);
            else { const int r = (int)L - 32 * 49, j = r % 11; pm = 32 + r / 11; pn = j < 8 ? 4 + j : (j == 8 ? 18 : (j == 9 ? 23 : 24)); } }
        u.pm = pm; u.pn = pn; u.aux = 0; u.nt = 32; u.pa = A + (size_t)pm * 256 * (DM * 2); u.pb = Bt + (size_t)pn * 256 * (DM * 2); return true;
    }
};

struct SchedDefer {
    const char* A; const char* Bt; int c;
    DI bool next(int i, Unit& u) const {
        if (i != 0 || c < 0 || c >= 76) return false;
        int pm, pn;
        if (c < 8) { pm = 24 + c; pn = 47; }
        else if (c < 40) { pm = c - 8; pn = 48; }
        else { const int r = c - 40, j = r % 9; pm = 32 + r / 9; pn = j < 8 ? 4 + j : 24; }
        u.pm = pm; u.pn = pn; u.aux = 0; u.nt = 32; u.pa = A + (size_t)pm * 256 * (DM * 2); u.pb = Bt + (size_t)pn * 256 * (DM * 2); return true;
    }
};

#define EPI_FOREACH(...) \
    _Pragma("unroll") for (int ai = 0; ai < 2; ++ai) _Pragma("unroll") for (int m = 0; m < 4; ++m) { const int row = u.pm * 256 + ai * 128 + wr * 64 + m * 16 + fr; \
    _Pragma("unroll") for (int bj = 0; bj < 2; ++bj) { const int col = u.pn * 256 + bj * 128 + wc * 32 + 8 * fq; const f32x4 v0 = acc[ai][bj][m][0], v1 = acc[ai][bj][m][1]; __VA_ARGS__ } }

DI u32x4 pack8(const f32x4 v0, const f32x4 v1) { u32x4 w; w.x = pk2(v0[0], v0[1]); w.y = pk2(v0[2], v0[3]); w.z = pk2(v1[0], v1[1]); w.w = pk2(v1[2], v1[3]); return w; }

struct EpiStoreBf16 {
    bf16_t* O; int ldc;
    DI void operator()(const f32x4 (&acc)[2][2][4][2], const Unit& u, int wr, int wc, int fr, int fq) const {
        EPI_FOREACH({ *(u32x4*)(O + (size_t)row * ldc + col) = pack8(v0, v1); })
    }
};
struct EpiProj {
    bf16_t* P;
    DI void operator()(const f32x4 (&acc)[2][2][4][2], const Unit& u, int wr, int wc, int fr, int fq) const {
        EPI_FOREACH({ *(u32x4*)(P + (size_t)row * NP + col) = pack8(v0, v1); })
    }
};
struct EpiX {
    bf16_t* KR; float* X80; const float* rla;
    DI void operator()(const f32x4 (&acc)[2][2][4][2], const Unit& u, int wr, int wc, int fr, int fq) const {
#pragma unroll
        for (int ai = 0; ai < 2; ++ai)
#pragma unroll
            for (int m = 0; m < 4; ++m) { const int row = u.pm * 256 + ai * 128 + wr * 64 + m * 16 + fr; const bool lat = row < MLAT; const int t = row & 2047;
#pragma unroll
                for (int n = 0; n < 2; ++n) { const f32x4 v = acc[ai][0][m][n];
                    f32x4 pr; pr.x = shx(v.x, 32); pr.y = shx(v.y, 32); pr.z = shx(v.z, 32); pr.w = shx(v.w, 32);
                    if (wc < 2) {
                        const int idx = 8 * (fq & 1) + 4 * n; f32x4 o = v;
                        if (lat) { const float* cs = rla + ((size_t)t * 32 + wc * 16 + idx) * 2; const f32x4 c0 = *(const f32x4*)cs, c1 = *(const f32x4*)(cs + 4);
                            if (fq < 2) { o.x = v.x * c0.x - pr.x * c0.y; o.y = v.y * c0.z - pr.y * c0.w; o.z = v.z * c1.x - pr.z * c1.y; o.w = v.w * c1.z - pr.w * c1.w; }
                            else        { o.x = pr.x * c0.y + v.x * c0.x; o.y = pr.y * c0.w + v.y * c0.z; o.z = pr.z * c1.y + v.z * c1.x; o.w = pr.w * c1.w + v.w * c1.z; } }
                        u32x2 w2; w2.x = pk2(o.x, o.y); w2.y = pk2(o.z, o.w);
                        *(u32x2*)(KR + (size_t)row * 64 + 32 * wc + 8 * fq + 4 * n) = w2;
                    } else if (wc == 2 && fq < 2) *(f32x4*)(X80 + (size_t)row * XW + 64 + 8 * fq + 4 * n) = v;
                } }
    }
};

DI int win_src_col(int n) {
    if (n < 4096) return n;
    if (n < 4608) return n - 4096 + 4112;
    if (n < 4864) return n - 4608 + 4624;
    if (n < 5888) return n - 4864 + 4944;
    if (n < 6144) return n - 5888 + 5968;
    if (n < 6400) return n - 6144 + 6224;
    if (n < 12544) return n - 6400 + 6480;
    if (n < 12608) return n - 12544 + 4880;
    if (n < 12624) return n - 12608 + 4096;
    return -1;
}
DI void transpose_item(const float* W, int ldw, int K, bf16_t* WT, int k0, int n0, int srcc, LAS float* scr, int lane) {
#pragma unroll 8
    for (int i = 0; i < 32; ++i) { const int kk = 2 * i + (lane >> 5); scr[kk * 33 + (lane & 31)] = srcc >= 0 ? W[(size_t)(k0 + kk) * ldw + srcc] : 0.f; }
    LDS_WAIT(); asm volatile("" ::: "memory");
    const int c = lane & 7;
#pragma unroll
    for (int j = 0; j < 4; ++j) { const int n = (lane >> 3) + 8 * j; const LAS float* s = scr + (8 * c) * 33 + n;
        u32x4 o; o.x = pk2(s[0 * 33], s[1 * 33]); o.y = pk2(s[2 * 33], s[3 * 33]); o.z = pk2(s[4 * 33], s[5 * 33]); o.w = pk2(s[6 * 33], s[7 * 33]);
        *(u32x4*)(WT + (size_t)(n0 + n) * K + k0 + 8 * c) = o; }
    LDS_WAIT(); asm volatile("" ::: "memory");
}

constexpr int IT_IN = 32 * 400, IT_UQ = 8 * 48, IT_UKV = 4 * 64, IT_BR = 16 * 64, IT_OUT = 32 * 64, IT_E13 = 32 * 64, IT_E2 = 16 * 64;
constexpr int IT_EARLY = IT_IN + IT_UQ + IT_UKV, IT_LAYER = IT_EARLY + 3 * IT_BR + IT_OUT + NEXP * IT_E13 + NEXP * IT_E2;
struct CvDesc { const float* src; size_t ld2; bf16_t* dst; int K; };
DI CvDesc cv_make(const float* W, int ldw, int K, bf16_t* WT, int k0, int n0, int srcc, int lane) {
    CvDesc d; d.src = srcc >= 0 ? W + (size_t)(k0 + (lane >> 5)) * ldw + srcc : nullptr; d.ld2 = 2 * (size_t)ldw; d.dst = WT + (size_t)n0 * K + k0; d.K = K; return d; }
DI CvDesc cv_desc(const Frame& F, const Args& a, int l, int r) {
    unsigned char* wl = F.ws + WS_W + (size_t)l * W_LAYER;
    const int lane = F.lane, ln = lane & 31;
    if (r < IT_IN) { const int kb = r / 400, nb = r % 400; return cv_make(a.in[I_WIN] + (size_t)l * DM * PROJW, PROJW, DM, (bf16_t*)(wl + W_IN), 64 * kb, 32 * nb, win_src_col(32 * nb + ln), lane); } r -= IT_IN;
    if (r < IT_UQ) { const int kb = r / 48, nb = r % 48; return cv_make(a.in[I_UQ] + (size_t)l * 512 * 1536, 1536, 512, (bf16_t*)(wl + W_UQ), 64 * kb, 32 * nb, 32 * nb + ln, lane); } r -= IT_UQ;
    if (r < IT_UKV) { const int kb = r / 64, nb = r % 64; return cv_make(a.in[I_UKV] + (size_t)l * 256 * 2048, 2048, 256, (bf16_t*)(wl + W_UKV), 64 * kb, 32 * nb, 32 * nb + ln, lane); } r -= IT_UKV;
    if (r < 3 * IT_BR) { const int br = r / IT_BR, q = r % IT_BR, kb = q / 64, nb = q % 64;
        return cv_make(a.in[I_BRML + br] + (size_t)l * 1024 * 2048, 2048, 1024, (bf16_t*)(wl + W_BR) + (size_t)br * 2048 * 1024, 64 * kb, 32 * nb, 32 * nb + ln, lane); } r -= 3 * IT_BR;
    if (r < IT_OUT) { const int kb = r / 64, nb = r % 64; return cv_make(a.in[I_WOUT] + (size_t)l * 2048 * 2048, 2048, 2048, (bf16_t*)(wl + W_OUT), 64 * kb, 32 * nb, 32 * nb + ln, lane); } r -= IT_OUT;
    if (r < NEXP * IT_E13) { const int e = r / IT_E13, q = r % IT_E13, kb = q / 64, nb = q % 64;
        const int n0 = 32 * nb, j = n0 >> 8, half = (n0 >> 7) & 1, cc = n0 & 127;
        return cv_make(a.in[half ? I_WE3 : I_WE1] + ((size_t)l * NEXP + e) * 2048 * 1024, 1024, 2048, (bf16_t*)(wl + W_E13) + (size_t)e * 2048 * 2048, 64 * kb, n0, j * 128 + cc + ln, lane); } r -= NEXP * IT_E13;
    { const int e = r / IT_E2, q = r % IT_E2, kb = q / 64, nb = q % 64;
        return cv_make(a.in[I_WE2] + ((size_t)l * NEXP + e) * 1024 * 2048, 2048, 1024, (bf16_t*)(wl + W_E2) + (size_t)e * 2048 * 1024, 64 * kb, 32 * nb, 32 * nb + ln, lane); }
}
DI void cv_load(const CvDesc& d, float (&v)[32]) {
#pragma unroll
    for (int i = 0; i < 32; ++i) v[i] = d.src ? __builtin_nontemporal_load(d.src + (size_t)i * d.ld2) : 0.f;
}
DI void cv_store(const CvDesc& d, const float (&v)[32], LAS float* scr, int lane) {
#pragma unroll
    for (int i = 0; i < 32; ++i) scr[(2 * i + (lane >> 5)) * 33 + (lane & 31)] = v[i];
    LDS_WAIT(); asm volatile("" ::: "memory");
    const int c = lane & 7;
#pragma unroll
    for (int j = 0; j < 4; ++j) { const int n = (lane >> 3) + 8 * j; const LAS float* s = scr + (8 * c) * 33 + n;
        u32x4 o; o.x = pk2(s[0 * 33], s[1 * 33]); o.y = pk2(s[2 * 33], s[3 * 33]); o.z = pk2(s[4 * 33], s[5 * 33]); o.w = pk2(s[6 * 33], s[7 * 33]);
        *(u32x4*)(d.dst + (size_t)n * d.K + 8 * c) = o; }
    LDS_WAIT(); asm volatile("" ::: "memory");
}
DI void convert_range(const Frame& F, const Args& a, int first, int stride, int n_items, LAS float* scr) {
    int it = first; if (it >= n_items) return;
    CvDesc cur = cv_desc(F, a, it / IT_LAYER, it % IT_LAYER); float v[32]; cv_load(cur, v);
    for (;;) {
        const int nx = it + stride; const bool hn = nx < n_items; const int pn = hn ? nx : it;
        const CvDesc nd = cv_desc(F, a, pn / IT_LAYER, pn % IT_LAYER); float wv[32]; cv_load(nd, wv);
        cv_store(cur, v, scr, F.lane);
        if (!hn) break;
        cur = nd; it = nx;
#pragma unroll
        for (int i = 0; i < 32; ++i) v[i] = wv[i];
    }
}
DI void convert_item(const Frame& F, const Args& a, int l, int r, LAS float* scr) {
    const CvDesc d = cv_desc(F, a, l, r); float v[32]; cv_load(d, v); cv_store(d, v, scr, F.lane);
}

DI void phase_prologue(const Frame& F, const Args& a, int rep) {
    LAS float* scr = (LAS float*)(F.lds + F.wave * 16384);
    if (rep == 0) {
        const float* c = a.in[I_C]; const float* cctx = a.in[I_CCTX]; const float* wmod = a.in[I_WMOD];
        constexpr int NIT = 2 * 48 * 16;
        for (int it = F.gw; it < NIT; it += F.ngw) {
            const int l = it / 768, rem = it % 768, cb = rem / 16, kp = rem % 16, k0 = kp * 128, j0 = cb * 256 + F.lane * 4;
#pragma unroll
            for (int i = 0; i < 10; ++i) { const int idx = F.lane + 64 * i, r = idx >> 7, kk = idx & 127; const float v = r < 4 ? c[r * DM + k0 + kk] : cctx[k0 + kk]; scr[idx] = siluf_(v); }
            LDS_WAIT(); asm volatile("" ::: "memory");
            f32x4 acc[5];
#pragma unroll
            for (int r = 0; r < 5; ++r) acc[r] = (f32x4){0.f, 0.f, 0.f, 0.f};
            const float* wp = wmod + ((size_t)l * DM + k0) * (6 * DM) + j0;
#pragma unroll 8
            for (int kk = 0; kk < 128; ++kk) { const f32x4 w = __builtin_nontemporal_load((const f32x4*)(wp + (size_t)kk * (6 * DM)));
#pragma unroll
                for (int r = 0; r < 5; ++r) acc[r] += w * scr[r * 128 + kk]; }
#pragma unroll
            for (int r = 0; r < 5; ++r) *(f32x4*)((float*)(F.ws + WS_MPART) + ((size_t)(kp * 2 + l) * 5 + r) * (6 * DM) + j0) = acc[r];
            LDS_WAIT(); asm volatile("" ::: "memory");
        }
    }
    {
        float* rla = (float*)(F.ws + WS_ROPE_LA); float* rga = (float*)(F.ws + WS_ROPE_GA);
        const int gt = F.gw * 64 + F.lane, ngt = F.ngw * 64;
        for (int i = gt; i < 2048 * 32; i += ngt) { const int t = i >> 5, aidx = i & 31, ax = aidx >> 4, fi = aidx & 15;
            const float inv = exp2f(-(float)fi * (13.287712379549449f / 16.f)); const float ang = (float)(ax ? (t & 63) : (t >> 6)) * inv;
            rla[2 * i] = cosf(ang); rla[2 * i + 1] = sinf(ang); }
        for (int i = gt; i < 2048 * 64; i += ngt) { const int t = i >> 6, aidx = i & 63, ax = aidx >> 5, fi = aidx & 31;
            const float inv = exp2f(-(float)fi * (13.287712379549449f / 32.f)); const float ang = (float)(ax ? (t & 63) : (t >> 6)) * inv;
            rga[2 * i] = cosf(ang); rga[2 * i + 1] = sinf(ang); }
    }
#ifndef MK_CONVTAIL
#define MK_CONVTAIL 0
#endif
#ifndef MK_FILL
#define MK_FILL 0
#endif
#ifndef MK_CVSIDE
#define MK_CVSIDE 2
#endif
#ifndef MK_CVFROM
#define MK_CVFROM IT_EARLY
#endif
    if (MK_CONVTAIL) { for (int it = F.gw; it < IT_EARLY; it += F.ngw) convert_item(F, a, 0, it, scr); }
    else convert_range(F, a, F.gw, F.ngw, MK_CVSIDE ? MK_CVFROM : (MK_FILL ? IT_LAYER : 2 * IT_LAYER), scr);
}

DI void phase_mods_reduce(const Frame& F, const Args& a) {
    float* mods = (float*)(F.ws + WS_MODS); const float* part = (const float*)(F.ws + WS_MPART); const float* bmod = a.in[I_BMOD];
    const int gt = F.gw * 64 + F.lane, ngt = F.ngw * 64;
    for (int i = gt; i < 2 * 5 * 12288 / 4; i += ngt) { const int l = i / (5 * 3072), j4 = i % 3072;
        f32x4 s = *(const f32x4*)(bmod + (size_t)l * 12288 + 4 * j4);
#pragma unroll
        for (int kp = 0; kp < 16; ++kp) s += *(const f32x4*)(part + (size_t)kp * (2 * 5 * 12288) + 4 * (size_t)i);
        *(f32x4*)(mods + 4 * (size_t)i) = s; }
}

DI const float* resid_row(const Frame& F, const Args& a, int l, int row) {
    if (l == 0) return row < MLAT ? a.in[I_X] + (size_t)row * DM : a.in[I_CTX] + (size_t)(row - MLAT) * DM;
    return (const float*)(F.ws + WS_X1) + (size_t)row * DM;
}
DI void load_row(const float* p, int lane, f32x4 (&v)[8]) {
#pragma unroll
    for (int j = 0; j < 8; ++j) v[j] = *(const f32x4*)(p + 4 * lane + 256 * j);
}
template <bool G2LDS = false>
DI void combine_row(const Frame& F, int lp, int row, const f32x4 (&x)[8], int tokv, f32x4 (&v)[8], const LAS float* g2l = nullptr) {
    const bf16_t* YE = (const bf16_t*)(F.ws + WS_YE);
    f32x4 s[8];
#pragma unroll
    for (int j = 0; j < 8; ++j) s[j] = (f32x4){0.f, 0.f, 0.f, 0.f};
    unsigned mask = (unsigned)__ballot(tokv >= 0) & 0xffffu;
    while (mask) {
        const int e0 = __builtin_ctz(mask); mask &= mask - 1u; const bool two = mask != 0u; const int e1 = two ? __builtin_ctz(mask) : e0; mask &= mask - 1u;
        const int slot0 = __builtin_amdgcn_readlane(tokv, e0), slot1 = __builtin_amdgcn_readlane(tokv, e1);
        const bf16_t* y0r = YE + ((size_t)e0 * ESLOT + slot0) * DM; const bf16_t* y1r = YE + ((size_t)e1 * ESLOT + slot1) * DM;
        s16x4 y0[8], y1[8];
#pragma unroll
        for (int j = 0; j < 8; ++j) { y0[j] = *(const s16x4*)(y0r + 4 * F.lane + 256 * j); y1[j] = *(const s16x4*)(y1r + 4 * F.lane + 256 * j); }
#pragma unroll
        for (int j = 0; j < 8; ++j) s[j] += (f32x4){bf2f((unsigned short)y0[j][0]), bf2f((unsigned short)y0[j][1]), bf2f((unsigned short)y0[j][2]), bf2f((unsigned short)y0[j][3])};
        if (two) {
#pragma unroll
            for (int j = 0; j < 8; ++j) s[j] += (f32x4){bf2f((unsigned short)y1[j][0]), bf2f((unsigned short)y1[j][1]), bf2f((unsigned short)y1[j][2]), bf2f((unsigned short)y1[j][3])}; }
    }
    if (G2LDS) {
#pragma unroll
        for (int j = 0; j < 8; ++j) v[j] = x[j] + s[j] * *(const LAS f32x4*)(g2l + 4 * F.lane + 256 * j); }
    else { const float* g2 = mods_ptr(F, lp, row, 5);
#pragma unroll
        for (int j = 0; j < 8; ++j) v[j] = x[j] + s[j] * *(const f32x4*)(g2 + 4 * F.lane + 256 * j); }
}
DI void modulate_vals(const Frame& F, const f32x4 (&v)[8], const float* sh, const float* sc, bf16_t* hrow, f32x4 (&hv)[8]) {
    float ss = 0.f;
#pragma unroll
    for (int j = 0; j < 8; ++j) ss += v[j].x * v[j].x + v[j].y * v[j].y + v[j].z * v[j].z + v[j].w * v[j].w;
    const float rs = rsqrtf(wave_sum(ss) * (1.f / DM) + EPS);
#pragma unroll
    for (int j = 0; j < 8; ++j) { const f32x4 s1 = *(const f32x4*)(sc + 4 * F.lane + 256 * j), s0 = *(const f32x4*)(sh + 4 * F.lane + 256 * j);
        const f32x4 h = v[j] * rs * (s1 + 1.f) + s0; hv[j] = h;
        u32x2 w; w.x = pk2(h.x, h.y); w.y = pk2(h.z, h.w); *(u32x2*)(hrow + 4 * F.lane + 256 * j) = w; }
}
DI void phase_mod1(const Frame& F, const Args& a, int l) {
    bf16_t* H = (bf16_t*)(F.ws + WS_H); const int* TOK = (const int*)(F.ws + WS_TOK);
    LAS float* ms = (LAS float*)F.lds;
    { const float* MODS = (const float*)(F.ws + WS_MODS);
      for (int i = F.tid; i < 5 * 3 * 512; i += NTHR) { const int r = i / 1536, w = (i / 512) % 3, c4 = i % 512;
          if (w == 2 && l == 0) continue;
          const int ll = w == 2 ? l - 1 : l, which = w == 2 ? 5 : w;
          f32x4 val = *(const f32x4*)(MODS + ((size_t)(ll * 5 + r) * 6 + which) * DM + 4 * c4); if (w == 1) val += 1.f;
          *(LAS f32x4*)(ms + (size_t)(r * 3 + w) * DM + 4 * c4) = val; }
      __syncthreads(); }
    int row = F.gw; if (row >= MTOT) return;
    f32x4 cur[8]; int tcur = 0;
    load_row(resid_row(F, a, l, row), F.lane, cur); if (l > 0) tcur = TOK[(size_t)row * 16 + (F.lane & 15)];
    for (;;) {
        const int nrow = row + F.ngw; const bool hn = nrow < MTOT; const int pr = hn ? nrow : row;
        f32x4 nxt[8]; int tnxt = 0;
        load_row(resid_row(F, a, l, pr), F.lane, nxt); if (l > 0) tnxt = TOK[(size_t)pr * 16 + (F.lane & 15)];
        f32x4 v[8];
        if (l == 0) {
#pragma unroll
            for (int j = 0; j < 8; ++j) v[j] = cur[j]; }
        const LAS float* mr = ms + (size_t)mods_row(row) * 3 * DM;
        if (l != 0) { combine_row<true>(F, l - 1, row, cur, tcur, v, mr + 2 * DM); float* xw = (float*)(F.ws + WS_X1) + (size_t)row * DM;
#pragma unroll
            for (int j = 0; j < 8; ++j) *(f32x4*)(xw + 4 * F.lane + 256 * j) = v[j]; }
        { float ss = 0.f;
#pragma unroll
          for (int j = 0; j < 8; ++j) ss += v[j].x * v[j].x + v[j].y * v[j].y + v[j].z * v[j].z + v[j].w * v[j].w;
          const float rs = rsqrtf(wave_sum(ss) * (1.f / DM) + EPS);
          bf16_t* hrow = H + (size_t)row * DM;
#pragma unroll
          for (int j = 0; j < 8; ++j) { const f32x4 h = v[j] * rs * *(const LAS f32x4*)(mr + DM + 4 * F.lane + 256 * j) + *(const LAS f32x4*)(mr + 4 * F.lane + 256 * j);
              u32x2 w; w.x = pk2(h.x, h.y); w.y = pk2(h.z, h.w); *(u32x2*)(hrow + 4 * F.lane + 256 * j) = w; } }
        if (!hn) break;
#pragma unroll
        for (int j = 0; j < 8; ++j) cur[j] = nxt[j];
        tcur = tnxt; row = nrow;
    }
}
DI void phase_mod2(const Frame& F, const Args& a, int l, int nrows) {
    bf16_t* H = (bf16_t*)(F.ws + WS_H); float* AFF = (float*)(F.ws + WS_AFF);
    LAS float* wr = (LAS float*)F.lds;
    const float* wsrc = a.in[I_WROUTER] + (size_t)l * DM * NEXP;
    for (int i = F.tid; i < DM * NEXP / 4; i += NTHR) { const f32x4 w4 = ((const f32x4*)wsrc)[i]; const int c = i >> 2, e0 = (i & 3) * 4;
        wr[(e0 + 0) * DM + c] = w4.x; wr[(e0 + 1) * DM + c] = w4.y; wr[(e0 + 2) * DM + c] = w4.z; wr[(e0 + 3) * DM + c] = w4.w; }
    __syncthreads();
    const float* X1 = (const float*)(F.ws + WS_X1);
    auto router = [&](const f32x4 (&hv)[8], int row) {
        float lg[16];
#pragma unroll
        for (int e = 0; e < 16; ++e) lg[e] = 0.f;
#pragma unroll
        for (int j = 0; j < 8; ++j)
#pragma unroll
            for (int e = 0; e < 16; ++e) { const f32x4 w = *(const LAS f32x4*)(wr + e * DM + 4 * F.lane + 256 * j); lg[e] += hv[j].x * w.x + hv[j].y * w.y + hv[j].z * w.z + hv[j].w * w.w; }
        float mx = -1e30f;
#pragma unroll
        for (int e = 0; e < 16; ++e) { lg[e] = wave_sum(lg[e]); mx = fmaxf(mx, lg[e]); }
        float den = 0.f;
#pragma unroll
        for (int e = 0; e < 16; ++e) { lg[e] = __expf(lg[e] - mx); den += lg[e]; }
        const float inv = 1.f / den;
        float mine = 0.f;
#pragma unroll
        for (int e = 0; e < 16; ++e) mine = (F.lane == e) ? lg[e] * inv : mine;
        if (F.lane < 16) AFF[(size_t)F.lane * MTOT + row] = mine;
    };
    const int crow = MLAT + F.gw; const bool hasc = crow < nrows;
    f32x4 cur[8];
    for (int base = 4 * F.gw; base < MLAT; base += 4 * F.ngw) {
        load_row(X1 + (size_t)base * DM, F.lane, cur);
        f32x4 s1[8], s0[8];
        { const float* sh = mods_ptr(F, l, base, 3); const float* sc = mods_ptr(F, l, base, 4);
#pragma unroll
          for (int j = 0; j < 8; ++j) { s1[j] = *(const f32x4*)(sc + 4 * F.lane + 256 * j) + 1.f; s0[j] = *(const f32x4*)(sh + 4 * F.lane + 256 * j); } }
#pragma unroll 1
        for (int k = 0; k < 4; ++k) { const int row = base + k; f32x4 hv[8];
            { const int pr = k < 3 ? row + 1 : (hasc ? crow : row); f32x4 nxt[8]; load_row(X1 + (size_t)pr * DM, F.lane, nxt);
              float ss = 0.f;
#pragma unroll
              for (int j = 0; j < 8; ++j) ss += cur[j].x * cur[j].x + cur[j].y * cur[j].y + cur[j].z * cur[j].z + cur[j].w * cur[j].w;
              const float rs = rsqrtf(wave_sum(ss) * (1.f / DM) + EPS);
              bf16_t* hrow = H + (size_t)row * DM;
#pragma unroll
              for (int j = 0; j < 8; ++j) { const f32x4 h = cur[j] * rs * s1[j] + s0[j]; hv[j] = h;
                  u32x2 w; w.x = pk2(h.x, h.y); w.y = pk2(h.z, h.w); *(u32x2*)(hrow + 4 * F.lane + 256 * j) = w; }
#pragma unroll
              for (int j = 0; j < 8; ++j) cur[j] = nxt[j]; }
            router(hv, row);
        }
    }
    if (hasc) {
        if (4 * F.gw >= MLAT) load_row(X1 + (size_t)crow * DM, F.lane, cur);
        for (int row = crow; row < nrows; row += F.ngw) { f32x4 hv[8];
            modulate_vals(F, cur, mods_ptr(F, l, row, 3), mods_ptr(F, l, row, 4), H + (size_t)row * DM, hv);
            router(hv, row);
            if (row + F.ngw < nrows) load_row(X1 + (size_t)(row + F.ngw) * DM, F.lane, cur); }
    }
    __syncthreads();
}

DI void phase_postproj(const Frame& F, const Args& a, int l) {
    const bf16_t* P = (const bf16_t*)(F.ws + WS_P);
    bf16_t* CQN = (bf16_t*)(F.ws + WS_CQN); bf16_t* CKVN = (bf16_t*)(F.ws + WS_CKVN); bf16_t* QG = (bf16_t*)(F.ws + WS_QG); bf16_t* KG = (bf16_t*)(F.ws + WS_KG);
    const float* qn = a.in[I_LAQN] + l * 512; const float* kvn = a.in[I_LAKVN] + l * 256; const float* gqn = a.in[I_GAQN] + l * 128; const float* gkn = a.in[I_GAKN] + l * 128;
    const float* rga = (const float*)(F.ws + WS_ROPE_GA);
    const int lane = F.lane;
    const f32x4 qg0 = *(const f32x4*)(qn + 8 * lane), qg1 = *(const f32x4*)(qn + 8 * lane + 4), kg0 = *(const f32x4*)(kvn + 4 * lane);
    const int hq = lane >> 4, ax = (lane >> 3) & 1, seg = lane & 7, eo = ax * 64 + 4 * seg;
    const f32x4 gqa = *(const f32x4*)(gqn + eo), gqb = *(const f32x4*)(gqn + eo + 32), gka = *(const f32x4*)(gkn + eo), gkb = *(const f32x4*)(gkn + eo + 32);
    struct Raw { bf16x8 xq; s16x4 xkv; s16x4 ha[3], hb[3]; f32x4 r0, r1; };
    auto load = [&](int row, Raw& R) { const bf16_t* pr = P + (size_t)row * NP; const int t = row & 2047;
        R.xq = *(const bf16x8*)(pr + C_CQ + 8 * lane); R.xkv = *(const s16x4*)(pr + C_CKV + 4 * lane);
#pragma unroll
        for (int p = 0; p < 3; ++p) { const int hh = p < 2 ? 4 * p + hq : 8 + (hq & 1); const bf16_t* src = pr + C_GQ + hh * 128;
            R.ha[p] = *(const s16x4*)(src + eo); R.hb[p] = *(const s16x4*)(src + eo + 32); }
        const float* rp = rga + ((size_t)t * 64 + ax * 32 + 4 * seg) * 2; R.r0 = *(const f32x4*)rp; R.r1 = *(const f32x4*)(rp + 4); };
    static_assert(C_GK == C_GQ + 8 * 128, "q and k heads contiguous");
    int row = F.gw; if (row >= MTOT) return;
    Raw cur; load(row, cur);
    for (;;) {
        const int nrow = row + F.ngw; const bool hn = nrow < MTOT; Raw nxt; load(hn ? nrow : row, nxt);
        const bool lat = row < MLAT; const bool needq = lat || l == 0;
        if (needq) {
            float f[8]; float ss = 0.f;
#pragma unroll
            for (int i = 0; i < 8; ++i) { f[i] = bf2f((unsigned short)cur.xq[i]); ss += f[i] * f[i]; }
            const float rs = rsqrtf(wave_sum(ss) * (1.f / 512.f) + EPS);
            u32x4 w; w.x = pk2(f[0] * rs * qg0.x, f[1] * rs * qg0.y); w.y = pk2(f[2] * rs * qg0.z, f[3] * rs * qg0.w); w.z = pk2(f[4] * rs * qg1.x, f[5] * rs * qg1.y); w.w = pk2(f[6] * rs * qg1.z, f[7] * rs * qg1.w);
            *(u32x4*)(CQN + (size_t)row * 512 + 8 * lane) = w;
        }
        {
            float f[4]; float ss = 0.f;
#pragma unroll
            for (int i = 0; i < 4; ++i) { f[i] = bf2f((unsigned short)cur.xkv[i]); ss += f[i] * f[i]; }
            const float rs = rsqrtf(wave_sum(ss) * (1.f / 256.f) + EPS);
            u32x2 w; w.x = pk2(f[0] * rs * kg0.x, f[1] * rs * kg0.y); w.y = pk2(f[2] * rs * kg0.z, f[3] * rs * kg0.w);
            *(u32x2*)(CKVN + (size_t)row * 256 + 4 * lane) = w;
        }
        const float cs[4] = {cur.r0.x, cur.r0.z, cur.r1.x, cur.r1.z}, sn[4] = {cur.r0.y, cur.r0.w, cur.r1.y, cur.r1.w};
        const int ln = lane_id_();
#pragma unroll
        for (int p = 0; p < 3; ++p) {
            if (p < 2 && !needq) continue;
            float xa[4], xb[4]; float ss = 0.f;
#pragma unroll
            for (int i = 0; i < 4; ++i) { xa[i] = bf2f((unsigned short)cur.ha[p][i]); xb[i] = bf2f((unsigned short)cur.hb[p][i]); ss += xa[i] * xa[i] + xb[i] * xb[i]; }
#pragma unroll
            for (int o = 1; o < 16; o <<= 1) ss += bperm_f(ss, ln ^ o);
            const float rs = rsqrtf(ss * (1.f / 128.f) + EPS);
            const f32x4 ga = p < 2 ? gqa : gka, gb = p < 2 ? gqb : gkb;
            float oa[4], ob[4];
#pragma unroll
            for (int i = 0; i < 4; ++i) { const float ya = xa[i] * rs * ga[i], yb = xb[i] * rs * gb[i]; oa[i] = lat ? ya * cs[i] - yb * sn[i] : ya; ob[i] = lat ? ya * sn[i] + yb * cs[i] : yb; }
            bf16_t* dst = p < 2 ? QG + (size_t)row * 1024 + (4 * p + hq) * 128 : KG + (size_t)row * 256 + (hq & 1) * 128;
            if (p < 2 || hq < 2) { u32x2 wa, wb; wa.x = pk2(oa[0], oa[1]); wa.y = pk2(oa[2], oa[3]); wb.x = pk2(ob[0], ob[1]); wb.y = pk2(ob[2], ob[3]);
                *(u32x2*)(dst + eo) = wa; *(u32x2*)(dst + eo + 32) = wb; }
        }
        if (!hn) break;
        cur = nxt; row = nrow;
    }
}

namespace att {
constexpr int QBLK = 32, KVBLK = 64;
#define SBAR() __builtin_amdgcn_sched_barrier(0)
DI int crow(int r, int hi) { return (r & 3) + 8 * (r >> 2) + 4 * hi; }
DI int v_st(int k, int c) { const int kk = (k & ~0xC) | ((k & 4) << 1) | ((k & 8) >> 1); return ((kk >> 3) * 4 + (c >> 5)) * 512 + ((kk & 7) * 32 + (c & 31)) * 2; }
DI int v_rd_base(int lane) { return ((lane & 3) << 3) | (((lane >> 2) & 3) << 6) | (((lane >> 4) & 1) << 5) | (((lane >> 5) & 1) << 8); }
constexpr int v_rd_off(int d0, int ks, int half) { return d0 * 512 + ks * 4096 + half * 2048; }
template <int OFF> DI s16x4 tr_read(int vb) { s16x4 r; asm volatile("ds_read_b64_tr_b16 %0, %1 offset:%2" : "=&v"(r) : "v"(vb), "i"(OFF) : "memory"); return r; }
template <int D0> DI void pv_one(f32x16& od, int vb, bf16x8 pa0, bf16x8 pa1, bf16x8 pa2, bf16x8 pa3) {
  const s16x4 l0 = tr_read<v_rd_off(D0, 0, 0)>(vb), h0 = tr_read<v_rd_off(D0, 0, 1)>(vb), l1 = tr_read<v_rd_off(D0, 1, 0)>(vb), h1 = tr_read<v_rd_off(D0, 1, 1)>(vb);
  const s16x4 l2 = tr_read<v_rd_off(D0, 2, 0)>(vb), h2 = tr_read<v_rd_off(D0, 2, 1)>(vb), l3 = tr_read<v_rd_off(D0, 3, 0)>(vb), h3 = tr_read<v_rd_off(D0, 3, 1)>(vb);
  asm volatile("s_waitcnt lgkmcnt(0)" ::: "memory"); SBAR();
#define PK(L, H) (bf16x8){L[0], L[1], L[2], L[3], H[0], H[1], H[2], H[3]}
  od = __builtin_amdgcn_mfma_f32_32x32x16_bf16(pa0, PK(l0, h0), od, 0, 0, 0);
  od = __builtin_amdgcn_mfma_f32_32x32x16_bf16(pa1, PK(l1, h1), od, 0, 0, 0);
  od = __builtin_amdgcn_mfma_f32_32x32x16_bf16(pa2, PK(l2, h2), od, 0, 0, 0);
  od = __builtin_amdgcn_mfma_f32_32x32x16_bf16(pa3, PK(l3, h3), od, 0, 0, 0);
#undef PK
}
DI void pv_d0(f32x16* o, int vb, bf16x8 pa0, bf16x8 pa1, bf16x8 pa2, bf16x8 pa3) {
  pv_one<0>(o[0], vb, pa0, pa1, pa2, pa3); pv_one<1>(o[1], vb, pa0, pa1, pa2, pa3); pv_one<2>(o[2], vb, pa0, pa1, pa2, pa3); pv_one<3>(o[3], vb, pa0, pa1, pa2, pa3);
}
template <int DKX, int LDQ, int LDK, int LDV, int LDO, int SDEPTH = 1>
DI void attn_body(const bf16_t* __restrict__ Qb, const bf16_t* __restrict__ Km, const bf16_t* __restrict__ Kx, const bf16_t* __restrict__ Vm, bf16_t* __restrict__ Ob,
                  int kr0, int nt0, int kr1, int nt1, float scale, const float* __restrict__ ropeq  , char* lds) {
  constexpr int ND0 = 8 + DKX / 16, KROWB = (128 + DKX) * 2, SHM_V = KVBLK * 128 * 2, SHM_K = KVBLK * KROWB;
  constexpr float THR = 8.f;
#define KSWZ(row, colB) ((row) * KROWB + ((colB) ^ (((row) & 7) << 4)))
  int tid = threadIdx.x; asm volatile("" : "+v"(tid));
  const int wid = __builtin_amdgcn_readfirstlane(tid >> 6), lane = tid & 63, r32 = lane & 31, hi = lane >> 5;
  char* V_lds = lds; char* K_lds = lds + 2 * SHM_V;
  float* ws = (float*)(lds + 2 * SHM_V + 2 * SHM_K) + wid * 64; float* li_l = ws; float* al_l = ws + 32;
  const float C = scale * 1.4426950408889634f;
  float m_reg = -1e30f, l_reg = 0; f32x16 o[4] = {}; bf16x8 qr[8];
  const bf16_t* Qw = Qb + (long)(wid * QBLK + r32) * LDQ + hi * 8;
#pragma unroll
  for (int d0 = 0; d0 < 8; ++d0) qr[d0] = *reinterpret_cast<const bf16x8*>(Qw + d0 * 16);
  char* QX = lds + 2 * SHM_V + 2 * SHM_K + 2048 + (wid * 4 * 64 + lane) * 16;
  if constexpr (DKX > 0) {
#pragma unroll
    for (int ax = 0; ax < 2; ++ax) {
      const bf16x8 xa = *reinterpret_cast<const bf16x8*>(Qw + 128 + ax * 32), xb = *reinterpret_cast<const bf16x8*>(Qw + 128 + ax * 32 + 16);
      if (ropeq) {
        const float* cs = ropeq + ((size_t)(wid * QBLK + r32) * 32 + ax * 16 + hi * 8) * 2;
        float oa[8], ob[8];
#pragma unroll
        for (int j = 0; j < 8; ++j) { const float c = cs[2 * j], sn = cs[2 * j + 1], a = bf2f((unsigned short)xa[j]), b = bf2f((unsigned short)xb[j]); oa[j] = a * c - b * sn; ob[j] = a * sn + b * c; }
        u32x4 wa = {pk2(oa[0], oa[1]), pk2(oa[2], oa[3]), pk2(oa[4], oa[5]), pk2(oa[6], oa[7])}, wb = {pk2(ob[0], ob[1]), pk2(ob[2], ob[3]), pk2(ob[4], ob[5]), pk2(ob[6], ob[7])};
        *reinterpret_cast<u32x4*>(QX + (2 * ax) * 1024) = wa; *reinterpret_cast<u32x4*>(QX + (2 * ax + 1) * 1024) = wb;
      } else { *reinterpret_cast<bf16x8*>(QX + (2 * ax) * 1024) = xa; *reinterpret_cast<bf16x8*>(QX + (2 * ax + 1) * 1024) = xb; }
    }
  }
  const int sr = tid >> 4, sc = (tid & 15) * 8, vst0 = v_st(sr, sc), vst1 = v_st(32 + sr, sc);
  const int xr = tid >> 3, xc = (tid & 7) * 8;
  const int vb0 = (int)(uintptr_t)V_lds + v_rd_base(lane);
  const int offV = sr * LDV + sc, offK = sr * LDK + sc, offX = xr * 64 + xc;
  struct { bf16x8 vs0, vs1, ks0, ks1, kx; } sr_[SDEPTH];
  const int NT = nt0 + nt1;
#define TROW(j) ((j) < nt0 ? kr0 + (j) * KVBLK : kr1 + ((j) - nt0) * KVBLK)
#define SLOAD(i, j) do { const long _r = TROW(j); const bf16_t* _vt = Vm + _r * LDV; const bf16_t* _kt = Km + _r * LDK; \
    sr_[i].vs0 = *(const bf16x8*)(_vt + offV); sr_[i].vs1 = *(const bf16x8*)(_vt + offV + 32 * LDV); \
    sr_[i].ks0 = *(const bf16x8*)(_kt + offK); sr_[i].ks1 = *(const bf16x8*)(_kt + offK + 32 * LDK); \
    if constexpr (DKX > 0) sr_[i].kx = *(const bf16x8*)(Kx + _r * 64 + offX); } while (0)
#define SWRITE(b, i) do { *(bf16x8*)(V_lds + (b) * SHM_V + vst0) = sr_[i].vs0; *(bf16x8*)(V_lds + (b) * SHM_V + vst1) = sr_[i].vs1; const int kc = sc * 2; \
    *(bf16x8*)(K_lds + (b) * SHM_K + KSWZ(sr, kc)) = sr_[i].ks0; *(bf16x8*)(K_lds + (b) * SHM_K + KSWZ(32 + sr, kc)) = sr_[i].ks1; \
    if constexpr (DKX > 0) *(bf16x8*)(K_lds + (b) * SHM_K + KSWZ(xr, 256 + xc * 2)) = sr_[i].kx; } while (0)
#define SWAIT() do { if constexpr (SDEPTH == 1) asm volatile("s_waitcnt vmcnt(0)" ::: "memory"); else if constexpr (DKX > 0) asm volatile("s_waitcnt vmcnt(5)" ::: "memory"); else asm volatile("s_waitcnt vmcnt(4)" ::: "memory"); } while (0)
#define RESC(a) do { if (__any((a) < 1.f)) { if (hi == 0) al_l[r32] = (a); asm volatile("s_waitcnt lgkmcnt(0)" ::: "memory"); \
    for (int d = 0; d < 4; ++d) for (int r = 0; r < 16; ++r) o[d][r] *= al_l[crow(r, hi)]; } } while (0)
#define QKT(p0, p1, Ks) do { p0 = f32x16{}; p1 = f32x16{}; _Pragma("unroll") for (int d0 = 0; d0 < ND0; ++d0) { const int cb = (d0 * 16 + hi * 8) * 2; \
    const bf16x8 b0 = *reinterpret_cast<const bf16x8*>((Ks) + KSWZ(r32, cb)); const bf16x8 b1 = *reinterpret_cast<const bf16x8*>((Ks) + KSWZ(32 + r32, cb)); \
    const bf16x8 qf = d0 < 8 ? qr[d0 < 8 ? d0 : 0] : *reinterpret_cast<const bf16x8*>(QX + (d0 - 8) * 1024); \
    p0 = __builtin_amdgcn_mfma_f32_32x32x16_bf16(b0, qf, p0, 0, 0, 0); p1 = __builtin_amdgcn_mfma_f32_32x32x16_bf16(b1, qf, p1, 0, 0, 0); if (DKX > 0 && (d0 & 1) == 1) SBAR(); } } while (0)
#define PARTIAL_SM(p0, p1, mn, alpha) do { float pmax = p0[0]; for (int r = 1; r < 16; ++r) pmax = fmaxf(pmax, p0[r]); for (int r = 0; r < 16; ++r) pmax = fmaxf(pmax, p1[r]); \
    { auto rr = __builtin_amdgcn_permlane32_swap(__float_as_uint(pmax), __float_as_uint(pmax), false, false); pmax = fmaxf(__uint_as_float(rr[0]), __uint_as_float(rr[1])); } \
    if (__builtin_expect(__all((pmax - m_reg) * scale <= THR), 1)) { mn = m_reg; alpha = 1.f; } \
    else { mn = fmaxf(m_reg, pmax); alpha = __builtin_amdgcn_exp2f((m_reg - mn) * C); m_reg = mn; } \
    const float mnC = -mn * C; for (int r = 0; r < 16; ++r) p0[r] = fmaf(p0[r], C, mnC); for (int r = 0; r < 16; ++r) p1[r] = fmaf(p1[r], C, mnC); \
    for (int r = 0; r < 16; ++r) p0[r] = __builtin_amdgcn_exp2f(p0[r]); } while (0)
#define PK4(P, BASE, OUT) do { unsigned a0 = pk2(P[BASE + 0], P[BASE + 1]), a1 = pk2(P[BASE + 2], P[BASE + 3]); \
    unsigned b0 = pk2(P[BASE + 4], P[BASE + 5]), b1 = pk2(P[BASE + 6], P[BASE + 7]); \
    auto r0 = __builtin_amdgcn_permlane32_swap(a0, b0, false, false); auto r1 = __builtin_amdgcn_permlane32_swap(a1, b1, false, false); \
    u32x4 w = {r0[0], r1[0], r0[1], r1[1]}; OUT = *reinterpret_cast<bf16x8*>(&w); } while (0)
#define FINISH_SM(p0, p1, alpha) do { for (int r = 0; r < 16; ++r) p1[r] = __builtin_amdgcn_exp2f(p1[r]); \
    float ps = 0; for (int r = 0; r < 16; ++r) ps += p0[r]; for (int r = 0; r < 16; ++r) ps += p1[r]; \
    { auto rr = __builtin_amdgcn_permlane32_swap(__float_as_uint(ps), __float_as_uint(ps), false, false); ps = __uint_as_float(rr[0]) + __uint_as_float(rr[1]); } \
    l_reg = l_reg * alpha + ps; PK4(p0, 0, pa0); PK4(p0, 8, pa1); PK4(p1, 0, pa2); PK4(p1, 8, pa3); } while (0)
  f32x16 pA0, pA1, pB0, pB1; float mnA, mnB, alA, alB; bf16x8 pa0, pa1, pa2, pa3;
  constexpr int SE = 0, SO = SDEPTH - 1;
  SLOAD(SE, 0); asm volatile("s_waitcnt vmcnt(0)" ::: "memory"); SWRITE(0, SE); __syncthreads();
  QKT(pA0, pA1, K_lds); PARTIAL_SM(pA0, pA1, mnA, alA);
  SLOAD(SO, 1); if constexpr (SDEPTH == 2) { if (2 < NT) SLOAD(SE, 2); }
  SWAIT(); SWRITE(1, SO); __syncthreads();
  for (int j = 1; j + 1 < NT; j += 2) {
    SBAR(); QKT(pB0, pB1, K_lds + SHM_K);
    FINISH_SM(pA0, pA1, alA); SBAR();
    SLOAD(SO, j + SDEPTH); SBAR();
    pv_d0(o, vb0, pa0, pa1, pa2, pa3); PARTIAL_SM(pB0, pB1, mnB, alB);
    __syncthreads(); SWAIT(); SWRITE(0, SE);
    RESC(alB); __syncthreads();
    SBAR(); QKT(pA0, pA1, K_lds);
    FINISH_SM(pB0, pB1, alB); SBAR();
    if (SDEPTH == 1 || j + 3 < NT) SLOAD(SE, j + 1 + SDEPTH); SBAR();
    pv_d0(o, vb0 + (int)SHM_V, pa0, pa1, pa2, pa3); PARTIAL_SM(pA0, pA1, mnA, alA);
    __syncthreads(); SWAIT(); SWRITE(1, SO);
    RESC(alA); __syncthreads();
  }
  SBAR(); QKT(pB0, pB1, K_lds + SHM_K);
  FINISH_SM(pA0, pA1, alA); SBAR();
  pv_d0(o, vb0, pa0, pa1, pa2, pa3); PARTIAL_SM(pB0, pB1, mnB, alB);
  __syncthreads(); RESC(alB);
  FINISH_SM(pB0, pB1, alB); SBAR();
  pv_d0(o, vb0 + (int)SHM_V, pa0, pa1, pa2, pa3);
  if (hi == 0) li_l[r32] = l_reg; asm volatile("s_waitcnt lgkmcnt(0)" ::: "memory");
  float rli[16];
#pragma unroll
  for (int r = 0; r < 16; ++r) rli[r] = __builtin_amdgcn_rcpf(li_l[crow(r, hi)]);
  bf16_t* Ow = Ob + (long)(wid * QBLK) * LDO;
#pragma unroll
  for (int r = 0; r < 16; ++r) { const int orow = crow(r, hi);
#pragma unroll
    for (int d0 = 0; d0 < 4; ++d0) Ow[(long)orow * LDO + d0 * 32 + r32] = (bf16_t)f2bf(o[d0][r] * rli[r]); }
  __syncthreads();
#undef KSWZ
#undef TROW
#undef SLOAD
#undef SWRITE
#undef SWAIT
#undef RESC
#undef QKT
#undef PARTIAL_SM
#undef PK4
#undef FINISH_SM
}
}

namespace ml {
constexpr int LD = 264, ROWB = LD * 2, QS_OFF = 0, KS_OFF = 64 * ROWB, VS_OFF = 2 * 64 * ROWB, NV_OFF = 3 * 64 * ROWB, SC_OFF = NV_OFF + 1024, ML_END = SC_OFF + 2048;
static_assert(ML_END <= LDS_BYTES - 1024, "mlstm lds");
#define MFMA32(a, b, c) __builtin_amdgcn_mfma_f32_32x32x16_bf16((a), (b), (c), 0, 0, 0)
DI bf16x8 pack_step(const f32x16& x, int s) {
    u32x4 p;
    asm volatile("v_cvt_pk_bf16_f32 %0, %4, %5\n\tv_cvt_pk_bf16_f32 %1, %6, %7\n\tv_cvt_pk_bf16_f32 %2, %8, %9\n\tv_cvt_pk_bf16_f32 %3, %10, %11\n\ts_nop 1"
                 : "=&v"(p[0]), "=&v"(p[1]), "=&v"(p[2]), "=&v"(p[3])
                 : "v"(x[8 * s]), "v"(x[8 * s + 1]), "v"(x[8 * s + 2]), "v"(x[8 * s + 3]), "v"(x[8 * s + 4]), "v"(x[8 * s + 5]), "v"(x[8 * s + 6]), "v"(x[8 * s + 7]));
    return __builtin_bit_cast(bf16x8, p);
}
DI bf16x8 ld_perm(const LAS unsigned char* p) {
    const s16x4 lo = *(const LAS s16x4*)p, hi = *(const LAS s16x4*)(p + 16);
    return (bf16x8){lo[0], lo[1], lo[2], lo[3], hi[0], hi[1], hi[2], hi[3]};
}
DI int crow(int r, int hi) { return (r & 3) + 8 * (r >> 2) + 4 * hi; }
template <int OFF> DI s16x4 tr_rd(unsigned addr) { s16x4 r; asm volatile("ds_read_b64_tr_b16 %0, %1 offset:%2" : "=&v"(r) : "v"(addr), "i"(OFF) : "memory"); return r; }
#define TR_WAIT() do { asm volatile("s_waitcnt lgkmcnt(0)" ::: "memory"); __builtin_amdgcn_sched_barrier(0); } while (0)
#define CAT8(L, H) (bf16x8){L[0], L[1], L[2], L[3], H[0], H[1], H[2], H[3]}

DI void mlstm_stream(const Frame& F, const Args& a, int l, int stream, bool ctx_out) {
    const int b = stream >> 3, hd = (stream >> 1) & 3, dir = stream & 1;
    const int tid = F.tid, w = F.wave;
    LAS unsigned char* lds = F.lds;
    const unsigned ldsb = (unsigned)(uintptr_t)lds;
    const bf16_t* P = (const bf16_t*)(F.ws + WS_P); const float* X80 = (const float*)(F.ws + WS_X80);
    float* MLH = (float*)(F.ws + WS_MLH) + (size_t)dir * MTOT * 1024;
    const float* gb = a.in[I_GBIAS] + l * 16;
    const float gbi = gb[dir * 8 + hd], gbf = gb[dir * 8 + 4 + hd];
    LAS float* NV = (LAS float*)(lds + NV_OFF);
    LAS float* SC = (LAS float*)(lds + SC_OFF);
    f32x16 CT[8];
#pragma unroll
    for (int i = 0; i < 8; ++i) CT[i] = f32x16{};
    if (tid < 256) NV[tid] = 0.f;
    float m_prev = 0.f;
    const int sgn = dir ? -1 : 1;
#define CHUNK_ROW0(c) ((c) < 4 ? MLAT + b * CTXL + (dir ? 255 - (c) * 64 : (c) * 64) : b * SEQ + (dir ? 2047 - ((c) - 4) * 64 : ((c) - 4) * 64))
    bf16x8 pq[4], pk[4], pv[4]; float pgi, pgf;
#define PREFETCH(c) do { int ln_ = F.lane; asm volatile("" : "+v"(ln_)); const int r0_ = CHUNK_ROW0(c); \
        const bf16_t* pr_ = P + (size_t)(r0_ + sgn * ((w << 3) | (ln_ >> 3))) * NP + hd * 256 + 8 * (ln_ & 7); \
        _Pragma("unroll") for (int j = 0; j < 4; ++j) { pq[j] = *(const bf16x8*)(pr_ + C_MLQ + 64 * j); pk[j] = *(const bf16x8*)(pr_ + C_MLK + 64 * j); pv[j] = *(const bf16x8*)(pr_ + C_MLV + 64 * j); } \
        const float* xg_ = X80 + (size_t)(r0_ + sgn * ln_) * XW + 64 + dir * 8 + hd; pgi = xg_[0]; pgf = xg_[4]; } while (0)
    PREFETCH(0);
#ifndef MK_MLX
#define MK_MLX 1
#endif
    for (int cc = 0; cc < 36 * MK_MLX; ++cc) {
        const int c = cc % 36;
        if (MK_MLX > 1 && cc == 36) { __syncthreads();
#pragma unroll
            for (int i = 0; i < 8; ++i) CT[i] = f32x16{};
            if (tid < 256) NV[tid] = 0.f; m_prev = 0.f; }
        int lane = F.lane; asm volatile("" : "+v"(lane));
        const int r32 = lane & 31, hi = lane >> 5, ldi = (w << 3) | (lane >> 3), cg = lane & 7, g16 = lane >> 4, q4 = (lane & 15) >> 2, p4 = lane & 3;
        const int row0 = CHUNK_ROW0(c);
        const float ipre = pgi + gbi, fpre = pgf + gbf;
        const float lf = fminf(fpre, 0.f) - __logf(1.f + __expf(-fabsf(fpre)));
        float cum = lf;
#pragma unroll
        for (int o = 1; o < 64; o <<= 1) { const float t = shu(cum, o); if (lane >= o) cum += t; }
        const float bb = ipre - cum;
        float pmx = bb;
#pragma unroll
        for (int o = 1; o < 64; o <<= 1) { const float t = shu(pmx, o); if (lane >= o) pmx = fmaxf(pmx, t); }
        const float aa = fmaxf(m_prev, pmx);
        const float cum_end = shl_(cum, 63), a_end = shl_(aa, 63);
        const float decay = __expf(m_prev - a_end), m_new = cum_end + a_end;
        __syncthreads();
#pragma unroll
        for (int j = 0; j < 4; ++j) { const int ch = cg + 8 * j; const bf16x8 qv = pq[j];
            u32x4 qs;
            qs.x = pk2(bf2f((unsigned short)qv[0]) * 0.0625f, bf2f((unsigned short)qv[1]) * 0.0625f); qs.y = pk2(bf2f((unsigned short)qv[2]) * 0.0625f, bf2f((unsigned short)qv[3]) * 0.0625f);
            qs.z = pk2(bf2f((unsigned short)qv[4]) * 0.0625f, bf2f((unsigned short)qv[5]) * 0.0625f); qs.w = pk2(bf2f((unsigned short)qv[6]) * 0.0625f, bf2f((unsigned short)qv[7]) * 0.0625f);
            *(LAS u32x4*)(lds + QS_OFF + (ldi * LD + 8 * ch) * 2) = qs;
            *(LAS bf16x8*)(lds + KS_OFF + (ldi * LD + 8 * ch) * 2) = pk[j];
            *(LAS bf16x8*)(lds + VS_OFF + (ldi * LD + 8 * ch) * 2) = pv[j]; }
        {
            float part = 0.f;
#pragma unroll
            for (int j = 0; j < 4; ++j) { const int ch = cg + 8 * j; const bf16x8 qv = pq[j]; const f32x4 n0 = *(const LAS f32x4*)(NV + 8 * ch), n1 = *(const LAS f32x4*)(NV + 8 * ch + 4);
                part += bf2f((unsigned short)qv[0]) * n0.x + bf2f((unsigned short)qv[1]) * n0.y + bf2f((unsigned short)qv[2]) * n0.z + bf2f((unsigned short)qv[3]) * n0.w
                      + bf2f((unsigned short)qv[4]) * n1.x + bf2f((unsigned short)qv[5]) * n1.y + bf2f((unsigned short)qv[6]) * n1.z + bf2f((unsigned short)qv[7]) * n1.w; }
            part += shx(part, 1); part += shx(part, 2); part += shx(part, 4);
            if (cg == 0) SC[320 + ldi] = part * 0.0625f; }
        if (w == 0) { SC[lane] = bb; SC[64 + lane] = aa; SC[128 + lane] = __expf(m_prev - aa); SC[192 + lane] = __expf(-cum - aa); SC[256 + lane] = __expf(bb - a_end); }
        __syncthreads();
        const bool want_out = (c >= 4) || ctx_out;
        if (want_out) {
            const unsigned va0 = ldsb + VS_OFF + ((4 * (g16 >> 1) + q4) * LD + 32 * w + 16 * (g16 & 1) + 4 * p4) * 2;
#pragma unroll
            for (int lt = 0; lt < 2; ++lt) {
                const int lcol = 32 * lt + r32;
                const float a_l = SC[64 + lcol], wI_l = SC[128 + lcol], fl_l = SC[192 + lcol], nq_l = SC[320 + lcol];
                f32x16 N = f32x16{};
#pragma unroll
                for (int dt = 0; dt < 8; ++dt)
#pragma unroll
                    for (int ks = 0; ks < 2; ++ks) {
                        const bf16x8 qa = ld_perm(lds + QS_OFF + (lcol * LD + 32 * dt + 16 * ks + 4 * hi) * 2);
                        N = MFMA32(pack_step(CT[dt], ks), qa, N); if (ks == 1 && (dt & 1)) __builtin_amdgcn_sched_barrier(0); }
#pragma unroll
                for (int r = 0; r < 16; ++r) N[r] *= wI_l;
                float den = 0.f;
#pragma unroll
                for (int st = 0; st <= lt; ++st) {
                    f32x16 S = f32x16{};
#pragma unroll
                    for (int ks = 0; ks < 16; ++ks) {
                        const bf16x8 ka = *(const LAS bf16x8*)(lds + KS_OFF + ((32 * st + r32) * LD + 16 * ks + 8 * hi) * 2);
                        const bf16x8 qb = *(const LAS bf16x8*)(lds + QS_OFF + (lcol * LD + 16 * ks + 8 * hi) * 2);
                        S = MFMA32(ka, qb, S); }
                    const s16x4 v00 = st == 0 ? tr_rd<0>(va0) : tr_rd<32 * ROWB>(va0), v01 = st == 0 ? tr_rd<8 * ROWB>(va0) : tr_rd<40 * ROWB>(va0);
                    const s16x4 v10 = st == 0 ? tr_rd<16 * ROWB>(va0) : tr_rd<48 * ROWB>(va0), v11 = st == 0 ? tr_rd<24 * ROWB>(va0) : tr_rd<56 * ROWB>(va0);
#pragma unroll
                    for (int r = 0; r < 16; ++r) { const int srow = 32 * st + crow(r, hi); const float dd = __expf(SC[srow] - a_l);
                        const float v = (srow <= lcol) ? S[r] * dd : 0.f; S[r] = v; den += v; }
                    TR_WAIT();
                    N = MFMA32(CAT8(v00, v01), pack_step(S, 0), N);
                    N = MFMA32(CAT8(v10, v11), pack_step(S, 1), N);
                }
                den += shx(den, 32);
                den += wI_l * nq_l;
                const float inv = 1.f / fmaxf(fabsf(den), fl_l);
                float* orow = MLH + (size_t)(row0 + sgn * lcol) * 1024 + hd * 256 + 32 * w + 4 * hi;
#pragma unroll
                for (int g = 0; g < 4; ++g) *(f32x4*)(orow + 8 * g) = (f32x4){N[4 * g] * inv, N[4 * g + 1] * inv, N[4 * g + 2] * inv, N[4 * g + 3] * inv};
                __builtin_amdgcn_sched_barrier(0);
            }
        }
        __builtin_amdgcn_sched_barrier(0);
        { const int cn = (cc + 1 < 36 * MK_MLX) ? (cc + 1) % 36 : 35; PREFETCH(cn); }
        __builtin_amdgcn_sched_barrier(0);
        {
            const unsigned vb0 = ldsb + VS_OFF + ((8 * (g16 >> 1) + q4) * LD + 32 * w + 16 * (g16 & 1) + 4 * p4) * 2;
            const unsigned kb0 = ldsb + KS_OFF + ((8 * (g16 >> 1) + q4) * LD + 16 * (g16 & 1) + 4 * p4) * 2;
            const s16x4 b00 = tr_rd<0>(vb0), b01 = tr_rd<4 * ROWB>(vb0), b10 = tr_rd<16 * ROWB>(vb0), b11 = tr_rd<20 * ROWB>(vb0);
            const s16x4 b20 = tr_rd<32 * ROWB>(vb0), b21 = tr_rd<36 * ROWB>(vb0), b30 = tr_rd<48 * ROWB>(vb0), b31 = tr_rd<52 * ROWB>(vb0);
            TR_WAIT();
            bf16x8 vb[4];
#define SCALE8(dst, L, H, ks) do { const f32x4 w0 = *(const LAS f32x4*)(SC + 256 + 16 * (ks) + 8 * hi), w1 = *(const LAS f32x4*)(SC + 256 + 16 * (ks) + 8 * hi + 4); \
            u32x4 t_; t_.x = pk2(bf2f((unsigned short)L[0]) * w0.x, bf2f((unsigned short)L[1]) * w0.y); t_.y = pk2(bf2f((unsigned short)L[2]) * w0.z, bf2f((unsigned short)L[3]) * w0.w); \
            t_.z = pk2(bf2f((unsigned short)H[0]) * w1.x, bf2f((unsigned short)H[1]) * w1.y); t_.w = pk2(bf2f((unsigned short)H[2]) * w1.z, bf2f((unsigned short)H[3]) * w1.w); dst = __builtin_bit_cast(bf16x8, t_); } while (0)
            SCALE8(vb[0], b00, b01, 0); SCALE8(vb[1], b10, b11, 1); SCALE8(vb[2], b20, b21, 2); SCALE8(vb[3], b30, b31, 3);
#undef SCALE8
#define UPD(dt) do { const s16x4 k00 = tr_rd<(dt) * 64>(kb0), k01 = tr_rd<(dt) * 64 + 4 * ROWB>(kb0), k10 = tr_rd<(dt) * 64 + 16 * ROWB>(kb0), k11 = tr_rd<(dt) * 64 + 20 * ROWB>(kb0); \
            const s16x4 k20 = tr_rd<(dt) * 64 + 32 * ROWB>(kb0), k21 = tr_rd<(dt) * 64 + 36 * ROWB>(kb0), k30 = tr_rd<(dt) * 64 + 48 * ROWB>(kb0), k31 = tr_rd<(dt) * 64 + 52 * ROWB>(kb0); \
            _Pragma("unroll") for (int r = 0; r < 16; ++r) CT[dt][r] *= decay; \
            TR_WAIT(); \
            CT[dt] = MFMA32(CAT8(k00, k01), vb[0], CT[dt]); CT[dt] = MFMA32(CAT8(k10, k11), vb[1], CT[dt]); CT[dt] = MFMA32(CAT8(k20, k21), vb[2], CT[dt]); CT[dt] = MFMA32(CAT8(k30, k31), vb[3], CT[dt]); } while (0)
            UPD(0); UPD(1); UPD(2); UPD(3); UPD(4); UPD(5); UPD(6); UPD(7);
#undef UPD
        }
        __syncthreads();
        if (tid < 256) { float sacc = 0.f;
#pragma unroll 8
            for (int q = 0; q < 64; ++q) sacc += bf2f(*(const LAS unsigned short*)(lds + KS_OFF + (q * LD + tid) * 2)) * SC[256 + q];
            NV[tid] = decay * NV[tid] + sacc; }
        m_prev = m_new;
    }
    __syncthreads();
#undef CHUNK_ROW0
#undef PREFETCH
}

namespace u2 {
constexpr int LDQ = 264, ROWQ = LDQ * 2, LDV = 136, ROWV = LDV * 2, LDW = 72, ROWW = LDW * 2;
constexpr int QS = 0, KS = 64 * ROWQ, VS = 2 * 64 * ROWQ, SW = VS + 64 * ROWV, NV_O = SW + 64 * ROWW, SC_O = NV_O + 1024, SCN = 448, END = SC_O + 2 * SCN * 4;
static_assert(END <= LDS_BYTES - 1024, "mlstm2 lds");
}
DI void mlstm_unit2(const Frame& F, const Args& a, int l, int unit, bool ctx_out) {
    using namespace u2;
    const int stream = unit >> 1, half = unit & 1, b = stream >> 3, hd = (stream >> 1) & 3, dir = stream & 1;
    const int tid = F.tid, w = F.wave;
    LAS unsigned char* lds = F.lds;
    const unsigned ldsb = (unsigned)(uintptr_t)lds;
    const bf16_t* P = (const bf16_t*)(F.ws + WS_P); const float* X80 = (const float*)(F.ws + WS_X80);
    bf16_t* MLH = (bf16_t*)(F.ws + WS_MLH) + (size_t)dir * MTOT * 1024;
    const float* gb = a.in[I_GBIAS] + l * 16;
    const float gbi = gb[dir * 8 + hd], gbf = gb[dir * 8 + 4 + hd];
    LAS float* NV = (LAS float*)(lds + NV_O);
    const int sgn = dir ? -1 : 1;
#define CHUNK_ROW0(c) ((c) < 4 ? MLAT + b * CTXL + (dir ? 255 - (c) * 64 : (c) * 64) : b * SEQ + (dir ? 2047 - ((c) - 4) * 64 : ((c) - 4) * 64))
    const bool helper = w >= 4;
    bf16x8 pq[8], pk[8], pv[4]; float pgi = 0.f, pgf = 0.f; float m_prev = 0.f;
#define PREFETCH(c) do { int ht_ = tid - 256; asm volatile("" : "+v"(ht_)); const int r0_ = CHUNK_ROW0(c); \
        const bf16_t* pr_ = P + (size_t)(r0_ + sgn * (ht_ >> 2)) * NP + hd * 256 + 8 * (ht_ & 3); \
        _Pragma("unroll") for (int j = 0; j < 8; ++j) { pq[j] = *(const bf16x8*)(pr_ + C_MLQ + 32 * j); pk[j] = *(const bf16x8*)(pr_ + C_MLK + 32 * j); } \
        _Pragma("unroll") for (int j = 0; j < 4; ++j) pv[j] = *(const bf16x8*)(pr_ + C_MLV + 128 * half + 32 * j); \
        const float* xg_ = X80 + (size_t)(r0_ + sgn * (ht_ & 63)) * XW + 64 + dir * 8 + hd; pgi = xg_[0]; pgf = xg_[4]; } while (0)
#define SCALARS(sb) do { if (w == 4) { int ln_ = F.lane; asm volatile("" : "+v"(ln_)); LAS float* SCw = (LAS float*)(lds + SC_O) + (sb) * SCN; \
        const float ipre = pgi + gbi, fpre = pgf + gbf; const float lf = fminf(fpre, 0.f) - __logf(1.f + __expf(-fabsf(fpre))); \
        float cum = lf; _Pragma("unroll") for (int o = 1; o < 64; o <<= 1) { const float t = shu(cum, o); if (ln_ >= o) cum += t; } \
        const float bb = ipre - cum; float pmx = bb; _Pragma("unroll") for (int o = 1; o < 64; o <<= 1) { const float t = shu(pmx, o); if (ln_ >= o) pmx = fmaxf(pmx, t); } \
        const float aa = fmaxf(m_prev, pmx); const float cum_end = shl_(cum, 63), a_end = shl_(aa, 63); \
        { SCw[ln_] = bb; SCw[64 + ln_] = aa; SCw[128 + ln_] = __expf(m_prev - aa); SCw[192 + ln_] = __expf(-cum - aa); SCw[256 + ln_] = __expf(bb - a_end); if (ln_ == 0) SCw[384] = __expf(m_prev - a_end); } \
        m_prev = cum_end + a_end; } } while (0)
#define WRITE_Q() do { int ht_ = tid - 256; asm volatile("" : "+v"(ht_)); const int hp_ = ht_ >> 2, hg_ = ht_ & 3; \
        _Pragma("unroll") for (int j = 0; j < 8; ++j) { const bf16x8 qv = pq[j]; u32x4 qs; \
            qs.x = pk2(bf2f((unsigned short)qv[0]) * 0.0625f, bf2f((unsigned short)qv[1]) * 0.0625f); qs.y = pk2(bf2f((unsigned short)qv[2]) * 0.0625f, bf2f((unsigned short)qv[3]) * 0.0625f); \
            qs.z = pk2(bf2f((unsigned short)qv[4]) * 0.0625f, bf2f((unsigned short)qv[5]) * 0.0625f); qs.w = pk2(bf2f((unsigned short)qv[6]) * 0.0625f, bf2f((unsigned short)qv[7]) * 0.0625f); \
            *(LAS u32x4*)(lds + QS + (hp_ * LDQ + 8 * (hg_ + 4 * j)) * 2) = qs; } } while (0)
#define WRITE_KV() do { int ht_ = tid - 256; asm volatile("" : "+v"(ht_)); const int hp_ = ht_ >> 2, hg_ = ht_ & 3; \
        _Pragma("unroll") for (int j = 0; j < 8; ++j) *(LAS bf16x8*)(lds + KS + (hp_ * LDQ + 8 * (hg_ + 4 * j)) * 2) = pk[j]; \
        _Pragma("unroll") for (int j = 0; j < 4; ++j) *(LAS bf16x8*)(lds + VS + (hp_ * LDV + 8 * (hg_ + 4 * j)) * 2) = pv[j]; } while (0)
    LAS float* DEN = (LAS float*)(lds + END);
    static_assert(END + 768 <= LDS_BYTES - 1024, "mlstm2 lds den");
    __syncthreads();
    if (helper) { NV[tid - 256] = 0.f; PREFETCH(0); SCALARS(0); WRITE_Q(); WRITE_KV(); }
    __syncthreads();
    if (!helper) {
      f32x16 CT[8];
#pragma unroll
      for (int i = 0; i < 8; ++i) CT[i] = f32x16{};
      for (int cc = 0; cc < 36 * MK_MLX; ++cc) {
        const int c = cc % 36;
        const int sb = cc & 1;
        const LAS float* SC = (const LAS float*)(lds + SC_O) + sb * SCN;
        const bool want_out = (c >= 4) || ctx_out;
        int lane = F.lane; asm volatile("" : "+v"(lane));
        const int r32 = lane & 31, hi = lane >> 5, g16 = lane >> 4, q4 = (lane & 15) >> 2, p4 = lane & 3;
        const int row0 = CHUNK_ROW0(c);
        if (MK_MLX > 1 && cc == 36) {
#pragma unroll
          for (int i = 0; i < 8; ++i) CT[i] = f32x16{}; }
        f32x16 N0 = f32x16{}, N1 = f32x16{};
        {
            if (want_out) {
#pragma unroll
                for (int dt = 0; dt < 8; ++dt)
#pragma unroll
                    for (int ks = 0; ks < 2; ++ks) {
                        const bf16x8 cf = pack_step(CT[dt], ks);
                        const bf16x8 qa0 = ld_perm(lds + QS + (r32 * LDQ + 32 * dt + 16 * ks + 4 * hi) * 2), qa1 = ld_perm(lds + QS + ((32 + r32) * LDQ + 32 * dt + 16 * ks + 4 * hi) * 2);
                        N0 = MFMA32(cf, qa0, N0); N1 = MFMA32(cf, qa1, N1); if (ks == 1 && (dt & 1)) __builtin_amdgcn_sched_barrier(0); }
                const float wI0 = SC[128 + r32], wI1 = SC[128 + 32 + r32];
#pragma unroll
                for (int r = 0; r < 16; ++r) { N0[r] *= wI0; N1[r] *= wI1; }
            }
        }
        __syncthreads();
        {
            if (want_out) {
                const unsigned va0 = ldsb + VS + ((8 * (g16 >> 1) + q4) * LDV + 32 * w + 16 * (g16 & 1) + 4 * p4) * 2;
                const s16x4 a00 = tr_rd<0>(va0), a01 = tr_rd<4 * ROWV>(va0), a10 = tr_rd<16 * ROWV>(va0), a11 = tr_rd<20 * ROWV>(va0);
                const s16x4 a20 = tr_rd<32 * ROWV>(va0), a21 = tr_rd<36 * ROWV>(va0), a30 = tr_rd<48 * ROWV>(va0), a31 = tr_rd<52 * ROWV>(va0);
                const LAS unsigned char* sw0 = lds + SW + (r32 * LDW + 8 * hi) * 2; const LAS unsigned char* sw1 = sw0 + 32 * ROWW;
                const bf16x8 s00 = *(const LAS bf16x8*)(sw0), s01 = *(const LAS bf16x8*)(sw0 + 32);
                const bf16x8 s10 = *(const LAS bf16x8*)(sw1), s11 = *(const LAS bf16x8*)(sw1 + 32), s12 = *(const LAS bf16x8*)(sw1 + 64), s13 = *(const LAS bf16x8*)(sw1 + 96);
                TR_WAIT();
                N0 = MFMA32(CAT8(a00, a01), s00, N0); N0 = MFMA32(CAT8(a10, a11), s01, N0);
                N1 = MFMA32(CAT8(a00, a01), s10, N1); N1 = MFMA32(CAT8(a10, a11), s11, N1); N1 = MFMA32(CAT8(a20, a21), s12, N1); N1 = MFMA32(CAT8(a30, a31), s13, N1);
                {
                    const float den0 = DEN[r32] + SC[128 + r32] * SC[320 + r32];
                    const float den1 = DEN[64 + 32 + r32] + DEN[128 + 32 + r32] + SC[128 + 32 + r32] * SC[320 + 32 + r32];
                    const float inv0 = 1.f / fmaxf(fabsf(den0), SC[192 + r32]), inv1 = 1.f / fmaxf(fabsf(den1), SC[192 + 32 + r32]);
                    bf16_t* o0 = MLH + (size_t)(row0 + sgn * r32) * 1024 + hd * 256 + 128 * half + 32 * w + 4 * hi; bf16_t* o1 = MLH + (size_t)(row0 + sgn * (32 + r32)) * 1024 + hd * 256 + 128 * half + 32 * w + 4 * hi;
#pragma unroll
                    for (int g = 0; g < 4; ++g) { u32x2 t0, t1; t0.x = pk2(N0[4 * g] * inv0, N0[4 * g + 1] * inv0); t0.y = pk2(N0[4 * g + 2] * inv0, N0[4 * g + 3] * inv0);
                        t1.x = pk2(N1[4 * g] * inv1, N1[4 * g + 1] * inv1); t1.y = pk2(N1[4 * g + 2] * inv1, N1[4 * g + 3] * inv1);
                        *(u32x2*)(o0 + 8 * g) = t0; *(u32x2*)(o1 + 8 * g) = t1; }
                }
            }
            __builtin_amdgcn_sched_barrier(0);
            {
                const float decay = SC[384];
                const unsigned vb0 = ldsb + VS + ((8 * (g16 >> 1) + q4) * LDV + 32 * w + 16 * (g16 & 1) + 4 * p4) * 2;
                const unsigned kb0 = ldsb + KS + ((8 * (g16 >> 1) + q4) * LDQ + 16 * (g16 & 1) + 4 * p4) * 2;
                const s16x4 b00 = tr_rd<0>(vb0), b01 = tr_rd<4 * ROWV>(vb0), b10 = tr_rd<16 * ROWV>(vb0), b11 = tr_rd<20 * ROWV>(vb0);
                const s16x4 b20 = tr_rd<32 * ROWV>(vb0), b21 = tr_rd<36 * ROWV>(vb0), b30 = tr_rd<48 * ROWV>(vb0), b31 = tr_rd<52 * ROWV>(vb0);
                TR_WAIT();
                bf16x8 vb[4];
#define SCALE8(dst, L, H, ks) do { const f32x4 w0 = *(const LAS f32x4*)(SC + 256 + 16 * (ks) + 8 * hi), w1 = *(const LAS f32x4*)(SC + 256 + 16 * (ks) + 8 * hi + 4); \
                u32x4 t_; t_.x = pk2(bf2f((unsigned short)L[0]) * w0.x, bf2f((unsigned short)L[1]) * w0.y); t_.y = pk2(bf2f((unsigned short)L[2]) * w0.z, bf2f((unsigned short)L[3]) * w0.w); \
                t_.z = pk2(bf2f((unsigned short)H[0]) * w1.x, bf2f((unsigned short)H[1]) * w1.y); t_.w = pk2(bf2f((unsigned short)H[2]) * w1.z, bf2f((unsigned short)H[3]) * w1.w); dst = __builtin_bit_cast(bf16x8, t_); } while (0)
                SCALE8(vb[0], b00, b01, 0); SCALE8(vb[1], b10, b11, 1); SCALE8(vb[2], b20, b21, 2); SCALE8(vb[3], b30, b31, 3);
#undef SCALE8
#define UPD(dt) do { const s16x4 k00 = tr_rd<(dt) * 64>(kb0), k01 = tr_rd<(dt) * 64 + 4 * ROWQ>(kb0), k10 = tr_rd<(dt) * 64 + 16 * ROWQ>(kb0), k11 = tr_rd<(dt) * 64 + 20 * ROWQ>(kb0); \
                const s16x4 k20 = tr_rd<(dt) * 64 + 32 * ROWQ>(kb0), k21 = tr_rd<(dt) * 64 + 36 * ROWQ>(kb0), k30 = tr_rd<(dt) * 64 + 48 * ROWQ>(kb0), k31 = tr_rd<(dt) * 64 + 52 * ROWQ>(kb0); \
                _Pragma("unroll") for (int r = 0; r < 16; ++r) CT[dt][r] *= decay; \
                TR_WAIT(); \
                CT[dt] = MFMA32(CAT8(k00, k01), vb[0], CT[dt]); CT[dt] = MFMA32(CAT8(k10, k11), vb[1], CT[dt]); CT[dt] = MFMA32(CAT8(k20, k21), vb[2], CT[dt]); CT[dt] = MFMA32(CAT8(k30, k31), vb[3], CT[dt]); } while (0)
                UPD(0); UPD(1); UPD(2); UPD(3); UPD(4); UPD(5); UPD(6); UPD(7);
#undef UPD
            }
        }
        __syncthreads();
        __syncthreads();
      }
    } else {
      for (int cc = 0; cc < 36 * MK_MLX; ++cc) {
        const int c = cc % 36;
        const int sb = cc & 1;
        const LAS float* SC = (const LAS float*)(lds + SC_O) + sb * SCN;
        const bool want_out = (c >= 4) || ctx_out;
        int lane = F.lane; asm volatile("" : "+v"(lane));
        const int r32 = lane & 31, hi = lane >> 5, g16 = lane >> 4, q4 = (lane & 15) >> 2, p4 = lane & 3;
        const int row0 = CHUNK_ROW0(c);
        { const int cn = (cc + 1 < 36 * MK_MLX) ? (cc + 1) % 36 : 35; PREFETCH(cn); }
        {
            if (want_out) {
                if (w < 7) {
                    const int st = (w == 6) ? 1 : 0, lt = (w == 4) ? 0 : 1, lcol = 32 * lt + r32;
                    f32x16 S = f32x16{};
#pragma unroll
                    for (int ks = 0; ks < 16; ++ks) {
                        const bf16x8 ka = *(const LAS bf16x8*)(lds + KS + ((32 * st + r32) * LDQ + 16 * ks + 8 * hi) * 2);
                        const bf16x8 qb = *(const LAS bf16x8*)(lds + QS + (lcol * LDQ + 16 * ks + 8 * hi) * 2);
                        S = MFMA32(ka, qb, S); }
                    const float a_l = SC[64 + lcol]; float den = 0.f;
#pragma unroll
                    for (int r = 0; r < 16; ++r) { const int srow = 32 * st + crow(r, hi); const float dd = __expf(SC[srow] - a_l);
                        const float v = (srow <= lcol) ? S[r] * dd : 0.f; S[r] = v; den += v; }
                    den += shx(den, 32);
                    if (hi == 0) DEN[(w - 4) * 64 + lcol] = den;
#pragma unroll
                    for (int g = 0; g < 4; ++g) { u32x2 t_; t_.x = pk2(S[4 * g], S[4 * g + 1]); t_.y = pk2(S[4 * g + 2], S[4 * g + 3]);
                        *(LAS u32x2*)(lds + SW + (lcol * LDW + 32 * st + 8 * g + 4 * hi) * 2) = t_; }
                } else {
                    float nq = 0.f; const LAS unsigned char* qrow = lds + QS + lane * ROWQ;
#pragma unroll 4
                    for (int d8 = 0; d8 < 32; ++d8) { const bf16x8 qv = *(const LAS bf16x8*)(qrow + d8 * 16); const f32x4 n0 = *(const LAS f32x4*)(NV + 8 * d8), n1 = *(const LAS f32x4*)(NV + 8 * d8 + 4);
                        nq += bf2f((unsigned short)qv[0]) * n0.x + bf2f((unsigned short)qv[1]) * n0.y + bf2f((unsigned short)qv[2]) * n0.z + bf2f((unsigned short)qv[3]) * n0.w
                            + bf2f((unsigned short)qv[4]) * n1.x + bf2f((unsigned short)qv[5]) * n1.y + bf2f((unsigned short)qv[6]) * n1.z + bf2f((unsigned short)qv[7]) * n1.w; }
                    ((LAS float*)(lds + SC_O) + sb * SCN)[320 + lane] = nq;
                }
            }
        }
        __syncthreads();
        {
            if (w == 7) {
                const int dg = lane & 31, sh = lane >> 5; const float decay = SC[384];
                float ac[8];
#pragma unroll
                for (int j = 0; j < 8; ++j) ac[j] = 0.f;
#pragma unroll 4
                for (int q = 0; q < 32; ++q) { const int srow = 32 * sh + q; const bf16x8 kv = *(const LAS bf16x8*)(lds + KS + (srow * LDQ + 8 * dg) * 2); const float wq = SC[256 + srow];
#pragma unroll
                    for (int j = 0; j < 8; ++j) ac[j] += bf2f((unsigned short)kv[j]) * wq; }
#pragma unroll
                for (int j = 0; j < 8; ++j) ac[j] += shx(ac[j], 32);
                if (sh == 0) {
                    f32x4 n0 = *(LAS f32x4*)(NV + 8 * dg), n1 = *(LAS f32x4*)(NV + 8 * dg + 4);
                    n0 = n0 * decay + (f32x4){ac[0], ac[1], ac[2], ac[3]}; n1 = n1 * decay + (f32x4){ac[4], ac[5], ac[6], ac[7]};
                    if (MK_MLX > 1 && cc == 35) { n0 = (f32x4){0.f, 0.f, 0.f, 0.f}; n1 = n0; }
                    *(LAS f32x4*)(NV + 8 * dg) = n0; *(LAS f32x4*)(NV + 8 * dg + 4) = n1; }
            }
            if (MK_MLX > 1 && cc == 35) m_prev = 0.f;
            SCALARS(sb ^ 1);
            WRITE_Q();
        }
        __syncthreads();
        WRITE_KV();
        __syncthreads();
      }
    }
#undef CHUNK_ROW0
#undef PREFETCH
#undef SCALARS
#undef WRITE_Q
#undef WRITE_KV
}
#undef MFMA32
#undef TR_WAIT
#undef CAT8
}

DI void phase_mixers(const Frame& F, const Args& a, int l, char* ldsg, int npass) {
    unsigned* head0 = (unsigned*)(F.ws + WS_CTL) + CW_QUEUE + 64 * l;
    volatile LAS unsigned* MISC = (volatile LAS unsigned*)(F.lds + LDS_BYTES - 64);
    const int n_ml = 64, n_la = 256, n_ga = 256, n_cx = (l == 0) ? 32 : 0, n_mix = n_ml + n_la + n_ga + 2 * n_cx;
    const int total = n_mix;
    const bf16_t* QLA = (const bf16_t*)(F.ws + WS_QLA); const bf16_t* KVLA = (const bf16_t*)(F.ws + WS_KVLA); const bf16_t* KR = (const bf16_t*)(F.ws + WS_KR);
    const bf16_t* QG = (const bf16_t*)(F.ws + WS_QG); const bf16_t* KG = (const bf16_t*)(F.ws + WS_KG); const bf16_t* P = (const bf16_t*)(F.ws + WS_P);
    bf16_t* YCAT = (bf16_t*)(F.ws + WS_YCAT);
#ifndef MK_MIX
#define MK_MIX 7
#endif
#define GRAB(u) do { __syncthreads(); if (F.tid == 0) MISC[4] = __hip_atomic_fetch_add(head, 1u, __ATOMIC_RELAXED, __HIP_MEMORY_SCOPE_AGENT); __syncthreads(); u = __builtin_amdgcn_readfirstlane((int)MISC[4]); } while (0)
    for (int pass = 0; pass < npass; ++pass) {
    unsigned* head = head0 + 128 * pass;
    int u0;
    GRAB(u0);
    while (u0 < n_ml) { if (MK_MIX & 1) ml::mlstm_unit2(F, a, l, u0, l == 0); GRAB(u0); }
    while (u0 < n_mix) {
        int u = u0 - n_ml;
        if (u < n_la) { const int b = u >> 6, h = (u >> 3) & 7, qb = u & 7; const long q0 = (long)b * SEQ + qb * 256;
            if (MK_MIX & 2) att::attn_body<64, 1536, 2048, 2048, 3072>(QLA + q0 * 1536 + h * 192, KVLA + h * 256, KR, KVLA + h * 256 + 128, YCAT + q0 * 3072 + 1024 + h * 128,
                                                      MLAT + b * CTXL, 4, b * SEQ, 32, 0.07216878364870322f, (const float*)(F.ws + WS_ROPE_LA) + (size_t)qb * 256 * 64, ldsg); }
        else if (u < n_la + n_ga) { u -= n_la; const int b = u >> 6, h = (u >> 3) & 7, qb = u & 7; const long q0 = (long)b * SEQ + qb * 256;
            if (MK_MIX & 4) att::attn_body<0, 1024, 256, NP, 3072>(QG + q0 * 1024 + h * 128, KG + (h >> 2) * 128, nullptr, P + C_GV + (h >> 2) * 128, YCAT + q0 * 3072 + 2048 + h * 128,
                                                  MLAT + b * CTXL, 4, b * SEQ, 32, 0.08838834764831845f, nullptr, ldsg); }
        else if (u < n_la + n_ga + n_cx) { u -= n_la + n_ga; const int b = u >> 3, h = u & 7; const long q0 = (long)MLAT + b * CTXL;
            if (MK_MIX & 2) att::attn_body<64, 1536, 2048, 2048, 3072>(QLA + q0 * 1536 + h * 192, KVLA + h * 256, KR, KVLA + h * 256 + 128, YCAT + q0 * 3072 + 1024 + h * 128,
                                                      MLAT + b * CTXL, 4, 0, 0, 0.07216878364870322f, nullptr, ldsg); }
        else { u -= n_la + n_ga + n_cx; const int b = u >> 3, h = u & 7; const long q0 = (long)MLAT + b * CTXL;
            if (MK_MIX & 4) att::attn_body<0, 1024, 256, NP, 3072>(QG + q0 * 1024 + h * 128, KG + (h >> 2) * 128, nullptr, P + C_GV + (h >> 2) * 128, YCAT + q0 * 3072 + 2048 + h * 128,
                                                  MLAT + b * CTXL, 4, 0, 0, 0.08838834764831845f, nullptr, ldsg); }
        GRAB(u0);
    }
    }
#undef GRAB
}

DI void phase_convert_tail(const Frame& F0, const Args& a, int l) {
    Frame F = F0; { int t_ = threadIdx.x; asm volatile("" : "+v"(t_)); F.tid = t_; F.lane = t_ & 63; F.wave = __builtin_amdgcn_readfirstlane(t_ >> 6); }
    constexpr int CVB = 64;
    unsigned* head = (unsigned*)(F.ws + WS_CTL) + CW_QUEUE + 64 * l + 32;
    volatile LAS unsigned* MISC = (volatile LAS unsigned*)(F.lds + LDS_BYTES - 64);
    const int n_cv = ((IT_LAYER - IT_EARLY) + ((l == 0) ? IT_EARLY : 0)) / CVB;
    LAS float* scr = (LAS float*)(F.lds + F.wave * 16384);
    for (;;) {
        __syncthreads();
        if (F.tid == 0) MISC[4] = __hip_atomic_fetch_add(head, 1u, __ATOMIC_RELAXED, __HIP_MEMORY_SCOPE_AGENT);
        __syncthreads();
        const int blk = __builtin_amdgcn_readfirstlane((int)MISC[4]);
        if (blk >= n_cv) break;
#pragma unroll 1
        for (int q = 0; q < CVB / NWAVES; ++q) { const int r = blk * CVB + q * NWAVES + F.wave;
            if (r < IT_LAYER - IT_EARLY) convert_item(F, a, l, IT_EARLY + r, scr); else convert_item(F, a, 1, r - (IT_LAYER - IT_EARLY), scr); }
    }
}

constexpr int FILL_BLK = 16, FILL_NBLK = IT_LAYER / FILL_BLK;
static_assert(IT_LAYER % FILL_BLK == 0, "fill blocks");
DI void fill_convert(const Frame& F0_, const Args& a, int ph, bool drain) {
    Frame F = F0_; { int t_ = threadIdx.x; asm volatile("" : "+v"(t_)); F.tid = t_; F.lane = t_ & 63; F.wave = __builtin_amdgcn_readfirstlane(t_ >> 6); }
    unsigned* ctl = (unsigned*)(F.ws + WS_CTL); unsigned* head = ctl + CW_CVHEAD; unsigned* done = ctl + CW_PHDONE + 64 * ph;
    volatile LAS unsigned* MISC = (volatile LAS unsigned*)(F.lds + LDS_BYTES - 64);
    LAS float* scr = (LAS float*)(F.lds + F.wave * 16384);
    __syncthreads();
    if (!drain && F.tid == 0) __hip_atomic_fetch_add(done, 1u, __ATOMIC_RELAXED, __HIP_MEMORY_SCOPE_AGENT);
    for (;;) {
        if (F.tid == 0) { unsigned blk = 0xffffffffu;
            if (drain || __hip_atomic_load(done, __ATOMIC_RELAXED, __HIP_MEMORY_SCOPE_AGENT) < (unsigned)F.G) blk = __hip_atomic_fetch_add(head, 1u, __ATOMIC_RELAXED, __HIP_MEMORY_SCOPE_AGENT);
            MISC[4] = blk; }
        __syncthreads();
        const unsigned blk = (unsigned)__builtin_amdgcn_readfirstlane((int)MISC[4]);
        __syncthreads();
        if (blk >= (unsigned)FILL_NBLK) break;
        convert_range(F, a, IT_LAYER + (int)blk * FILL_BLK + F.wave, NWAVES, IT_LAYER + ((int)blk + 1) * FILL_BLK, scr);
    }
}

DI void phase_convert_side(const Frame& F0_, const Args& a, int bid, int it_lo, int it_hi) {
    const int step = MK_CVSIDE, ncv = (256 + step - 1) / step;
    if (bid % step != 0 || F0_.G != 256) { if (F0_.G != 256) { Frame Fx = F0_; LAS float* scr = (LAS float*)(Fx.lds + Fx.wave * 16384); convert_range(Fx, a, it_lo + Fx.gw, Fx.ngw, it_hi, scr); } return; }
    Frame F = F0_; { int t_ = threadIdx.x; asm volatile("" : "+v"(t_)); F.tid = t_; F.lane = t_ & 63; F.wave = __builtin_amdgcn_readfirstlane(t_ >> 6); }
    LAS float* scr = (LAS float*)(F.lds + F.wave * 16384);
    const int j = bid / step, per = (it_hi - it_lo + ncv - 1) / ncv, lo = it_lo + j * per, hi = (lo + per < it_hi) ? lo + per : it_hi;
    convert_range(F, a, lo + F.wave, NWAVES, hi, scr);
    __syncthreads();
}

DI void phase_mlfin(const Frame& F, const Args& a, int l, int nrows) {
    const bf16_t* H0 = (const bf16_t*)(F.ws + WS_MLH); const bf16_t* H1 = H0 + (size_t)MTOT * 1024;
    const bf16_t* P = (const bf16_t*)(F.ws + WS_P); bf16_t* YCAT = (bf16_t*)(F.ws + WS_YCAT); const float* gn = a.in[I_MLNORM] + l * 1024;
    int row = F.gw; if (row >= nrows) return;
    s16x4 c0[4], c1[4]; s16x4 co[4];
#define MLF_LOAD(r_, a0, a1, ao) do { _Pragma("unroll") for (int hd = 0; hd < 4; ++hd) { const int c = hd * 256 + 4 * F.lane; a0[hd] = *(const s16x4*)(H0 + (size_t)(r_) * 1024 + c); a1[hd] = *(const s16x4*)(H1 + (size_t)(r_) * 1024 + c); \
        ao[hd] = *(const s16x4*)(P + (size_t)(r_) * NP + C_MLO + c); } } while (0)
    MLF_LOAD(row, c0, c1, co);
    f32x4 gv[4];
#pragma unroll
    for (int hd = 0; hd < 4; ++hd) gv[hd] = *(const f32x4*)(gn + hd * 256 + 4 * F.lane);
    for (;;) {
        const int nrow = row + F.ngw; const bool hn = nrow < nrows; const int pr = hn ? nrow : row;
        s16x4 n0[4], n1[4]; s16x4 no[4]; MLF_LOAD(pr, n0, n1, no);
#pragma unroll
        for (int hd = 0; hd < 4; ++hd) { const int c = hd * 256 + 4 * F.lane;
            const f32x4 v = (f32x4){bf2f((unsigned short)c0[hd][0]) + bf2f((unsigned short)c1[hd][0]), bf2f((unsigned short)c0[hd][1]) + bf2f((unsigned short)c1[hd][1]), bf2f((unsigned short)c0[hd][2]) + bf2f((unsigned short)c1[hd][2]), bf2f((unsigned short)c0[hd][3]) + bf2f((unsigned short)c1[hd][3])};
            const float rs = rsqrtf(wave_sum(v.x * v.x + v.y * v.y + v.z * v.z + v.w * v.w) * (1.f / 256.f) + EPS);
            const f32x4 g = gv[hd]; const s16x4 og = co[hd];
            u32x2 w; w.x = pk2(v.x * rs * g.x * sigmoidf_(bf2f((unsigned short)og[0])), v.y * rs * g.y * sigmoidf_(bf2f((unsigned short)og[1])));
            w.y = pk2(v.z * rs * g.z * sigmoidf_(bf2f((unsigned short)og[2])), v.w * rs * g.w * sigmoidf_(bf2f((unsigned short)og[3])));
            *(u32x2*)(YCAT + (size_t)row * 3072 + c) = w; }
        if (!hn) break;
#pragma unroll
        for (int hd = 0; hd < 4; ++hd) { c0[hd] = n0[hd]; c1[hd] = n1[hd]; co[hd] = no[hd]; }
        row = nrow;
    }
#undef MLF_LOAD
}

struct SchedMerge {
    const char* Y; const char* Bt; int nM, G, c;
    DI bool next(int i, Unit& u) const {
        int pm, pn, br;
        if (nM == 36 && G == 256) {
            const int j = c < 96 ? i - 1 : i;
            if (j < 0) { const int t = c / 3; br = (c - 3 * t) | 4; pm = 32 + (t >> 3); pn = t & 7; }
            else if (j < 3) { pg8::tile_of(c, 32, 8, pm, pn); br = j; }
            else return false;
        } else { const int k = i / 3; br = i - 3 * k; const long L = (long)k * G + c; if (L >= (long)nM * 8) return false; pg8::tile_of((int)L, nM, 8, pm, pn); }
        u.pm = pm; u.pn = pn; u.aux = br; u.nt = 16; u.pa = Y + (size_t)pm * 256 * 6144 + (br & 3) * 2048; u.pb = Bt + ((size_t)(br & 3) * 2048 + pn * 256) * 2048; return true;
    }
};
struct EpiMerge {
    const bf16_t* P; bf16_t* ZG; bf16_t* MB; bf16_t* CP; unsigned* cnt; unsigned* odone;
    DI void operator()(const f32x4 (&acc)[2][2][4][2], const Unit& u, int wr, int wc, int fr, int fq) const {
        const int br = u.aux & 3; const bool split = (u.aux & 4) != 0;
        EPI_FOREACH({
            const bf16x8 gp = *(const bf16x8*)(P + (size_t)row * NP + C_GATE + br * 2048 + col);
            f32x4 g0, g1;
            g0.x = sigmoidf_(bf2f((unsigned short)gp[0])); g0.y = sigmoidf_(bf2f((unsigned short)gp[1])); g0.z = sigmoidf_(bf2f((unsigned short)gp[2])); g0.w = sigmoidf_(bf2f((unsigned short)gp[3]));
            g1.x = sigmoidf_(bf2f((unsigned short)gp[4])); g1.y = sigmoidf_(bf2f((unsigned short)gp[5])); g1.z = sigmoidf_(bf2f((unsigned short)gp[6])); g1.w = sigmoidf_(bf2f((unsigned short)gp[7]));
            f32x4 r0 = v0 * g0, r1 = v1 * g1;
            const size_t off = (size_t)row * DM + col;
            if (split) { const u32x4 w_ = pack8(r0, r1); GAS unsigned long long* cp = (GAS unsigned long long*)(CP + ((size_t)br * MCTX + (row - MLAT)) * DM + col);
                __hip_atomic_store(cp, (unsigned long long)w_.x | ((unsigned long long)w_.y << 32), __ATOMIC_RELAXED, __HIP_MEMORY_SCOPE_AGENT);
                __hip_atomic_store(cp + 1, (unsigned long long)w_.z | ((unsigned long long)w_.w << 32), __ATOMIC_RELAXED, __HIP_MEMORY_SCOPE_AGENT); }
            else if (br < 2) *(u32x4*)(ZG + (size_t)br * MTOT * DM + off) = pack8(r0, r1);
            else { const bf16x8 z0 = *(const bf16x8*)(ZG + off), z1 = *(const bf16x8*)(ZG + (size_t)MTOT * DM + off);
                r0 += (f32x4){bf2f((unsigned short)z0[0]) + bf2f((unsigned short)z1[0]), bf2f((unsigned short)z0[1]) + bf2f((unsigned short)z1[1]), bf2f((unsigned short)z0[2]) + bf2f((unsigned short)z1[2]), bf2f((unsigned short)z0[3]) + bf2f((unsigned short)z1[3])};
                r1 += (f32x4){bf2f((unsigned short)z0[4]) + bf2f((unsigned short)z1[4]), bf2f((unsigned short)z0[5]) + bf2f((unsigned short)z1[5]), bf2f((unsigned short)z0[6]) + bf2f((unsigned short)z1[6]), bf2f((unsigned short)z0[7]) + bf2f((unsigned short)z1[7])};
                *(u32x4*)(MB + off) = pack8(r0, r1); }
        })
        if (split) {
            asm volatile("s_waitcnt vmcnt(0)" ::: "memory");
            unsigned old = 0;
            if ((fr | fq) == 0) old = __hip_atomic_fetch_add((GAS unsigned*)(cnt + (((u.pm - 32) * 8 + u.pn) * 8 + wr * 4 + wc) * 16), 1u, __ATOMIC_RELAXED, __HIP_MEMORY_SCOPE_AGENT);
            old = (unsigned)__builtin_amdgcn_readfirstlane((int)old);
            if (old == 2u) {
                EPI_FOREACH({
                    f32x4 r0 = (f32x4){0.f, 0.f, 0.f, 0.f}; f32x4 r1 = r0;
                    _Pragma("unroll") for (int ob = 0; ob < 3; ++ob) { const GAS unsigned long long* cp = (const GAS unsigned long long*)(CP + ((size_t)ob * MCTX + (row - MLAT)) * DM + col);
                        const unsigned long long a0 = __hip_atomic_load(cp, __ATOMIC_RELAXED, __HIP_MEMORY_SCOPE_AGENT), a1 = __hip_atomic_load(cp + 1, __ATOMIC_RELAXED, __HIP_MEMORY_SCOPE_AGENT);
                        r0 += (f32x4){bf2f((unsigned short)a0), bf2f((unsigned short)(a0 >> 16)), bf2f((unsigned short)(a0 >> 32)), bf2f((unsigned short)(a0 >> 48))};
                        r1 += (f32x4){bf2f((unsigned short)a1), bf2f((unsigned short)(a1 >> 16)), bf2f((unsigned short)(a1 >> 32)), bf2f((unsigned short)(a1 >> 48))}; }
                    (void)v0; (void)v1;
                    { const u32x4 w_ = pack8(r0, r1); GAS unsigned long long* mp = (GAS unsigned long long*)(MB + (size_t)row * DM + col);
                      __hip_atomic_store(mp, (unsigned long long)w_.x | ((unsigned long long)w_.y << 32), __ATOMIC_RELAXED, __HIP_MEMORY_SCOPE_AGENT);
                      __hip_atomic_store(mp + 1, (unsigned long long)w_.z | ((unsigned long long)w_.w << 32), __ATOMIC_RELAXED, __HIP_MEMORY_SCOPE_AGENT); }
                })
                asm volatile("s_waitcnt vmcnt(0)" ::: "memory");
                if ((fr | fq) == 0) __hip_atomic_fetch_add((GAS unsigned*)(odone + (u.pm - 32) * 16), 1u, __ATOMIC_RELAXED, __HIP_MEMORY_SCOPE_AGENT);
            }
        }
    }
};
struct SchedOutCtx {
    const char* A; const char* Bt; int c;
    DI bool next(int i, Unit& u) const {
        if (i != 0 || c < 96 || c >= 160) return false;
        const int t = (c - 96) >> 1, kh = (c - 96) & 1; const size_t ko = (size_t)kh * 2048;
        u.pm = 32 + (t >> 3); u.pn = t & 7; u.aux = 4 | kh; u.nt = 16; u.pa = A + (size_t)u.pm * 256 * (DM * 2) + ko; u.pb = Bt + (size_t)u.pn * 256 * (DM * 2) + ko; return true;
    }
};
struct EpiOut {
    const float* xin; const float* ctxin; float* X1; const float* mods; int l; bf16_t* CP; unsigned* cnt;
    DI void operator()(const f32x4 (&acc)[2][2][4][2], const Unit& u, int wr, int wc, int fr, int fq) const {
        if (u.aux & 4) {
            const int kh = u.aux & 1;
            EPI_FOREACH({ const u32x4 w_ = pack8(v0, v1); GAS unsigned long long* cp = (GAS unsigned long long*)(CP + ((size_t)kh * MCTX + (row - MLAT)) * DM + col);
                __hip_atomic_store(cp, (unsigned long long)w_.x | ((unsigned long long)w_.y << 32), __ATOMIC_RELAXED, __HIP_MEMORY_SCOPE_AGENT);
                __hip_atomic_store(cp + 1, (unsigned long long)w_.z | ((unsigned long long)w_.w << 32), __ATOMIC_RELAXED, __HIP_MEMORY_SCOPE_AGENT); })
            asm volatile("s_waitcnt vmcnt(0)" ::: "memory");
            unsigned old = 0;
            if ((fr | fq) == 0) old = __hip_atomic_fetch_add((GAS unsigned*)(cnt + (((u.pm - 32) * 8 + u.pn) * 8 + wr * 4 + wc) * 16), 1u, __ATOMIC_RELAXED, __HIP_MEMORY_SCOPE_AGENT);
            old = (unsigned)__builtin_amdgcn_readfirstlane((int)old);
            if (old == 1u) {
                EPI_FOREACH({
                    f32x4 r0 = (f32x4){0.f, 0.f, 0.f, 0.f}; f32x4 r1 = r0; (void)v0; (void)v1;
                    _Pragma("unroll") for (int ob = 0; ob < 2; ++ob) { const GAS unsigned long long* cp = (const GAS unsigned long long*)(CP + ((size_t)ob * MCTX + (row - MLAT)) * DM + col);
                        const unsigned long long a0 = __hip_atomic_load(cp, __ATOMIC_RELAXED, __HIP_MEMORY_SCOPE_AGENT), a1 = __hip_atomic_load(cp + 1, __ATOMIC_RELAXED, __HIP_MEMORY_SCOPE_AGENT);
                        r0 += (f32x4){bf2f((unsigned short)a0), bf2f((unsigned short)(a0 >> 16)), bf2f((unsigned short)(a0 >> 32)), bf2f((unsigned short)(a0 >> 48))};
                        r1 += (f32x4){bf2f((unsigned short)a1), bf2f((unsigned short)(a1 >> 16)), bf2f((unsigned short)(a1 >> 32)), bf2f((unsigned short)(a1 >> 48))}; }
                    const float* rp = ctxin + (size_t)(row - MLAT) * DM; const float* gp = mods + ((size_t)(l * 5 + 4) * 6 + 2) * DM + col; float* op = X1 + (size_t)row * DM + col;
                    *(f32x4*)op = *(const f32x4*)(rp + col) + *(const f32x4*)gp * r0; *(f32x4*)(op + 4) = *(const f32x4*)(rp + col + 4) + *(const f32x4*)(gp + 4) * r1;
                })
            }
            return;
        }
        f32x4 g[2][2];
#pragma unroll
        for (int bj = 0; bj < 2; ++bj) { const float* gp = mods + ((size_t)(l * 5 + mods_row(u.pm * 256)) * 6 + 2) * DM + u.pn * 256 + bj * 128 + wc * 32 + 8 * fq;
            g[bj][0] = *(const f32x4*)gp; g[bj][1] = *(const f32x4*)(gp + 4); }
        EPI_FOREACH({
            const float* rp = (l == 0) ? (row < MLAT ? xin + (size_t)row * DM : ctxin + (size_t)(row - MLAT) * DM) : X1 + (size_t)row * DM;
            float* op = X1 + (size_t)row * DM + col;
            *(f32x4*)op = *(const f32x4*)(rp + col) + g[bj][0] * v0; *(f32x4*)(op + 4) = *(const f32x4*)(rp + col + 4) + g[bj][1] * v1;
        })
    }
};
DI void phase_topk(const Frame& F, const Args& a, int l, int bid) {
    const float* AFF = (const float*)(F.ws + WS_AFF);
    int* ROWS = (int*)(F.ws + WS_ROWS); float* VALS = (float*)(F.ws + WS_VALS); int* TOK = (int*)(F.ws + WS_TOK);
    LAS unsigned* cntr = (LAS unsigned*)F.lds;
    LAS unsigned* cg = cntr + 64; LAS unsigned* ce = cntr + 96;
    const int nitems = (l == 0) ? 256 + 64 + 16 : 256;
    const int lane = F.lane, wave = F.wave;
    for (int it = bid; it < nitems; it += F.G) {
        if (it >= 320) {
            const int e = it - 320;
            for (int s = F.tid; s < 128; s += NTHR) { ROWS[e * ESLOT + 1152 + s] = -1; VALS[e * ESLOT + 1152 + s] = 0.f; }
            continue;
        }
        const int lat = it < 256, b = lat ? (it >> 6) : ((it - 256) >> 4), e = lat ? ((it >> 2) & 15) : ((it - 256) & 15), qtr = lat ? (it & 3) : 0;
        const int ntok = lat ? SEQ : CTXL, rowbase = lat ? b * SEQ : MLAT + b * CTXL, slotbase = lat ? b * 256 : 1024 + b * 32;
        const unsigned cap = (unsigned)(ntok >> 3);
        __syncthreads();
        if (F.tid < 128) cntr[F.tid] = 0u;
        unsigned key[4];
#pragma unroll
        for (int q = 0; q < 4; ++q) { const int i = q * 512 + F.tid; key[q] = i < ntok ? __float_as_uint(AFF[(size_t)e * MTOT + rowbase + i]) : 0u; }
        __syncthreads();
        unsigned T = 0u;
#pragma unroll 1
        for (int r = 0; r < 16; ++r) { const int sh = 30 - 2 * r;
            const unsigned c1 = T | (1u << sh), c2 = T | (2u << sh), c3 = T | (3u << sh);
            unsigned n1 = 0, n2 = 0, n3 = 0;
#pragma unroll
            for (int q = 0; q < 4; ++q) { n1 += (unsigned)__builtin_popcountll(__ballot(key[q] >= c1)); n2 += (unsigned)__builtin_popcountll(__ballot(key[q] >= c2)); n3 += (unsigned)__builtin_popcountll(__ballot(key[q] >= c3)); }
            if (lane == 0) { atomicAdd((unsigned*)(cntr + r * 4 + 0), n1); atomicAdd((unsigned*)(cntr + r * 4 + 1), n2); atomicAdd((unsigned*)(cntr + r * 4 + 2), n3); }
            __syncthreads();
            const unsigned t1 = cntr[r * 4 + 0], t2 = cntr[r * 4 + 1], t3 = cntr[r * 4 + 2];
            T = t3 >= cap ? c3 : (t2 >= cap ? c2 : (t1 >= cap ? c1 : T));
        }
        unsigned long long bg_own = 0ull, be_own = 0ull; unsigned kown = 0u;
#pragma unroll
        for (int q = 0; q < 4; ++q) { const unsigned long long bg = __ballot(key[q] > T), be = __ballot(key[q] == T);
            if (lane == 0) { cg[q * 8 + wave] = (unsigned)__builtin_popcountll(bg); ce[q * 8 + wave] = (unsigned)__builtin_popcountll(be); }
            if (q == qtr) { bg_own = bg; be_own = be; kown = key[q]; } }
        __syncthreads();
        unsigned ngt = 0, gtb = 0, eqb = 0; const int me = qtr * 8 + wave;
#pragma unroll 1
        for (int k = 0; k < 32; ++k) { const unsigned g = cg[k], q_ = ce[k]; ngt += g; if (k < me) { gtb += g; eqb += q_; } }
        const unsigned need = cap - ngt;
        const unsigned long long lt = (1ull << lane) - 1ull;
        const int i = qtr * 512 + F.tid; const bool act = i < ntok;
        const unsigned eqpos = eqb + (unsigned)__builtin_popcountll(be_own & lt);
        const bool sel = act && (kown > T || (kown == T && eqpos < need));
        const unsigned slot = gtb + (unsigned)__builtin_popcountll(bg_own & lt) + (eqpos < need ? eqpos : need);
        if (act) { TOK[(size_t)(rowbase + i) * 16 + e] = sel ? slotbase + (int)slot : -1;
            if (sel) { ROWS[e * ESLOT + slotbase + (int)slot] = rowbase + i; VALS[e * ESLOT + slotbase + (int)slot] = __uint_as_float(kown); } }
    }
    __syncthreads();
}
struct SchedMoe {
    const char* A; const char* Bt; int lda, ldb, nMt, nt, G, c, gather;
    DI bool next(int i, Unit& u) const {
        const long L0 = (long)i * G + c; const int nwg = NEXP * nMt * 8; if (L0 >= nwg) return false;
        const int L = ((int)L0 % 8) * (nwg / 8) + (int)L0 / 8;
        const int e = L / (nMt * 8), rem = L % (nMt * 8), mt = rem % nMt, pn = rem / nMt;
        u.pm = e * 5 + mt; u.pn = pn; u.aux = e; u.nt = nt; u.pa = gather ? A : A + ((size_t)e * ESLOT + mt * 256) * lda; u.pb = Bt + ((size_t)e * 2048 + pn * 256) * ldb; return true;
    }
};
struct SchedMoe2Early {
    const char* A; const char* Bt; int c;
    DI bool next(int i, Unit& u) const {
        if (i != 0 || c < 128 || c >= 256) return false;
        const int k = c - 128, x = k & 7, j = k >> 3, e = 2 * x, mt = j & 1, pn = j >> 1;
        u.pm = e * 5 + mt; u.pn = pn; u.aux = e; u.nt = 16; u.pa = A + ((size_t)e * ESLOT + mt * 256) * (EFF * 2); u.pb = Bt + ((size_t)e * 2048 + pn * 256) * (EFF * 2); return true;
    }
};
struct SchedMoe2Rest {
    const char* A; const char* Bt; int c;
    DI bool next(int i, Unit& u) const {
        if (i >= 2) return false;
        const int x = c & 7, j = i * 32 + (c >> 3); int e, mt, pn;
        if (j < 40) { e = 2 * x + 1; mt = j % 5; pn = j / 5; } else { const int r = j - 40; e = 2 * x; mt = 2 + r % 3; pn = r / 3; }
        u.pm = e * 5 + mt; u.pn = pn; u.aux = e; u.nt = 16; u.pa = A + ((size_t)e * ESLOT + mt * 256) * (EFF * 2); u.pb = Bt + ((size_t)e * 2048 + pn * 256) * (EFF * 2); return true;
    }
};
struct EpiMoe1 {
    bf16_t* ACT; unsigned* pub;
    DI void operator()(const f32x4 (&acc)[2][2][4][2], const Unit& u, int wr, int wc, int fr, int fq) const {
        const bool pubu = pub != nullptr && (u.aux & 1) == 0 && u.pm - u.aux * 5 < 2;
#pragma unroll
        for (int ai = 0; ai < 2; ++ai)
#pragma unroll
            for (int m = 0; m < 4; ++m) { const int row = u.pm * 256 + ai * 128 + wr * 64 + m * 16 + fr; const int col = u.pn * 128 + wc * 32 + 8 * fq;
                f32x4 r0, r1;
#pragma unroll
                for (int i = 0; i < 4; ++i) { r0[i] = siluf_(acc[ai][0][m][0][i]) * acc[ai][1][m][0][i]; r1[i] = siluf_(acc[ai][0][m][1][i]) * acc[ai][1][m][1][i]; }
                const u32x4 w_ = pack8(r0, r1);
                if (pubu) { GAS unsigned long long* ap = (GAS unsigned long long*)(ACT + (size_t)row * EFF + col);
                    __hip_atomic_store(ap, (unsigned long long)w_.x | ((unsigned long long)w_.y << 32), __ATOMIC_RELAXED, __HIP_MEMORY_SCOPE_AGENT);
                    __hip_atomic_store(ap + 1, (unsigned long long)w_.z | ((unsigned long long)w_.w << 32), __ATOMIC_RELAXED, __HIP_MEMORY_SCOPE_AGENT); }
                else *(u32x4*)(ACT + (size_t)row * EFF + col) = w_; }
        if (pubu) { asm volatile("s_waitcnt vmcnt(0)" ::: "memory");
            if ((fr | fq) == 0) __hip_atomic_fetch_add((GAS unsigned*)(pub + u.aux * 16), 1u, __ATOMIC_RELAXED, __HIP_MEMORY_SCOPE_AGENT); }
    }
};
struct EpiMoe2 {
    const float* VALS; bf16_t* YE;
    DI void operator()(const f32x4 (&acc)[2][2][4][2], const Unit& u, int wr, int wc, int fr, int fq) const {
        EPI_FOREACH({ const float val = VALS[row]; *(u32x4*)(YE + (size_t)row * DM + col) = pack8(v0 * val, v1 * val); })
    }
};
DI void phase_final(const Frame& F, const Args& a) {
    const float* g = a.in[I_FNORM]; const int* TOK = (const int*)(F.ws + WS_TOK); const float* X1 = (const float*)(F.ws + WS_X1);
    LAS float* gs = (LAS float*)F.lds;
    { const float* MODS = (const float*)(F.ws + WS_MODS);
      for (int i = F.tid; i < 4 * 512; i += NTHR) { const int r = i / 512, c4 = i % 512;
          *(LAS f32x4*)(gs + (size_t)r * DM + 4 * c4) = *(const f32x4*)(MODS + ((size_t)((DEPTH - 1) * 5 + r) * 6 + 5) * DM + 4 * c4); }
      __syncthreads(); }
    int row = F.gw; if (row >= MLAT) return;
    f32x4 cur[8]; load_row(X1 + (size_t)row * DM, F.lane, cur); int tcur = TOK[(size_t)row * 16 + (F.lane & 15)];
    f32x4 gv[8]; load_row(g, F.lane, gv);
    for (;;) {
        const int nrow = row + F.ngw; const bool hn = nrow < MLAT; const int pr = hn ? nrow : row;
        f32x4 nxt[8]; load_row(X1 + (size_t)pr * DM, F.lane, nxt); const int tnxt = TOK[(size_t)pr * 16 + (F.lane & 15)];
        f32x4 v[8]; float ss = 0.f;
        combine_row<true>(F, DEPTH - 1, row, cur, tcur, v, gs + (size_t)(row >> 11) * DM);
#pragma unroll
        for (int j = 0; j < 8; ++j) ss += v[j].x * v[j].x + v[j].y * v[j].y + v[j].z * v[j].z + v[j].w * v[j].w;
        const float rs = rsqrtf(wave_sum(ss) * (1.f / DM) + EPS);
#pragma unroll
        for (int j = 0; j < 8; ++j) *(f32x4*)(a.out + (size_t)row * DM + 4 * F.lane + 256 * j) = v[j] * rs * gv[j];
        if (!hn) break;
#pragma unroll
        for (int j = 0; j < 8; ++j) cur[j] = nxt[j];
        tcur = tnxt; row = nrow;
    }
}

#ifndef MK_LAST_PHASE
#define MK_LAST_PHASE 1000
#endif
constexpr int PH_PER_LAYER = 12, N_PHASES = 2 + 2 * PH_PER_LAYER + 1;
__global__ void __launch_bounds__(NTHR, 2) mega(const Args args) {
    extern __shared__ __attribute__((aligned(16))) unsigned char lds[];
    Frame F0;
    F0.lds = (LAS unsigned char*)lds; F0.ws = args.ws;
    F0.tid = threadIdx.x; F0.lane = F0.tid & 63; F0.wave = __builtin_amdgcn_readfirstlane(F0.tid >> 6);
    F0.G = gridDim.x; { const int bx = blockIdx.x; F0.vcu = (F0.G % 8 == 0) ? (bx % 8) * (F0.G / 8) + bx / 8 : bx; }
    F0.gw = F0.vcu * NWAVES + F0.wave; F0.ngw = F0.G * NWAVES;
    volatile LAS unsigned* MISC = (volatile LAS unsigned*)(F0.lds + LDS_BYTES - 64);
    if (F0.tid < 16) MISC[F0.tid] = 0u;
    __syncthreads();
    unsigned* ctl = (unsigned*)(F0.ws + WS_CTL);
    XcdBarrier bar = xcd_barrier_post(ctl + CW_BAR, MISC + 8);
    const int lo = args.ph_lo, hi = args.ph_hi;
    int ph = 0, bid = 0;
#ifndef MK_EN
#define MK_EN 0xFFFF
#endif
#define EN(x) ((MK_EN >> (x)) & 1)
#ifndef MK_REP
#define MK_REP 0
#endif
#ifndef MK_BARX
#define MK_BARX 0
#endif
#ifndef MK_REPB
#define MK_REPB 0
#endif
#ifndef MK_TPH
#define MK_TPH -1
#endif
#ifndef MK_TMODE
#define MK_TMODE 0
#endif
#ifndef MK_TQ
#define MK_TQ 40.f
#endif
#define REP(pid_) ((MK_REP >> (pid_)) & 1)
#define PHASE(pid_, ...) if (EN(pid_) && lo <= ph && ph < hi) { Frame F = F0; { unsigned long long w_ = (unsigned long long)F0.ws; asm volatile("" : "+s"(w_)); F.ws = (unsigned char*)w_; \
        asm volatile("" : "+s"(F.G), "+s"(F.vcu)); F.ngw = F.G * NWAVES; bid = blockIdx.x; asm volatile("" : "+s"(bid)); \
        int t_ = threadIdx.x; asm volatile("" : "+v"(t_)); F.tid = t_; F.lane = t_ & 63; F.wave = __builtin_amdgcn_readfirstlane(t_ >> 6); F.gw = F.vcu * NWAVES + F.wave; } \
        { const int rep = 0; (void)rep; __VA_ARGS__ } if (REP(pid_)) { if (MK_REPB) xcd_barrier(bar); const int rep = 1; (void)rep; __VA_ARGS__ } \
        if (MK_TPH >= 0 && threadIdx.x == 0) ((unsigned long long*)(F0.ws + WS_CTL + 1536 * 1024))[ph * 256 + blockIdx.x] = wall_clock64(); \
        if (ph + 1 < hi) { xcd_barrier(bar); if (MK_BARX) xcd_barrier(bar); } } ++ph;

#define PHASE5(...) if (EN(5) && lo <= ph && ph < hi) { Frame F = F0; { unsigned long long w_ = (unsigned long long)F0.ws; asm volatile("" : "+s"(w_)); F.ws = (unsigned char*)w_; \
        asm volatile("" : "+s"(F.G), "+s"(F.vcu)); F.ngw = F.G * NWAVES; bid = blockIdx.x; asm volatile("" : "+s"(bid)); \
        int t_ = threadIdx.x; asm volatile("" : "+v"(t_)); F.tid = t_; F.lane = t_ & 63; F.wave = __builtin_amdgcn_readfirstlane(t_ >> 6); F.gw = F.vcu * NWAVES + F.wave; } \
        { __VA_ARGS__ } if (MK_TPH >= 0 && threadIdx.x == 0) ((unsigned long long*)(F0.ws + WS_CTL + 1536 * 1024))[ph * 256 + blockIdx.x] = wall_clock64(); \
        if (ph + 1 < hi) { xcd_barrier(bar); if (MK_BARX) xcd_barrier(bar); } } ++ph;
    PHASE(0, phase_prologue(F, args, rep);)
    PHASE(14, phase_mods_reduce(F, args);)
    for (int l = 0; l < DEPTH; ++l) {
        const size_t wlo = WS_W + (size_t)l * W_LAYER;
        const int nM = (l == 0) ? 36 : 32;
        PHASE(1, if (MK_FILL && l == 1 && rep == 0) fill_convert(F, args, ph, true); phase_mod1(F, args, l);)
        PHASE(2, {
            SchedProj S{(const char*)(F.ws + WS_H), (const char*)(F.ws + wlo + W_IN), l, F.G, bid};
            EpiProj E{(bf16_t*)(F.ws + WS_P)};
            pg8::gemm_phase(F.lds, DM * 2, DM * 2, S, E); if (MK_FILL && l == 0 && rep == 0) fill_convert(F, args, ph, false); })
        PHASE(3, phase_postproj(F, args, l);)
        PHASE(4, {
            const bool defer = (l == 1 && F.G == 256);
            const int Gx = F.G - 36, xw = bid - Gx, BIG = 1 << 28, Gw = defer ? 144 : Gx, cw = bid < Gw ? bid : BIG;
            if (defer) { SchedDefer S{(const char*)(F.ws + WS_H), (const char*)(F.ws + wlo + W_IN), (bid >= 144 && bid < 220) ? bid - 144 : -1};
              EpiProj E{(bf16_t*)(F.ws + WS_P)}; pg8::gemm_phase(F.lds, DM * 2, DM * 2, S, E); }
            { SchedDense S{(const char*)(F.ws + WS_H), (const char*)(F.ws + wlo + W_IN) + (size_t)C_X * DM * 2, DM * 2, DM * 2, 36, 1, 32, 36, xw >= 0 ? xw : BIG};
              EpiX E{(bf16_t*)(F.ws + WS_KR), (float*)(F.ws + WS_X80), (const float*)(F.ws + WS_ROPE_LA)}; pg8::gemm_phase(F.lds, DM * 2, DM * 2, S, E); }
            { SchedDense S{(const char*)(F.ws + WS_CQN), (const char*)(F.ws + wlo + W_UQ), 512 * 2, 512 * 2, nM, 6, 8, Gw, cw};
              EpiStoreBf16 E{(bf16_t*)(F.ws + WS_QLA), 1536}; pg8::gemm_phase(F.lds, 512 * 2, 512 * 2, S, E); }
            { SchedDense S{(const char*)(F.ws + WS_CKVN), (const char*)(F.ws + wlo + W_UKV), 256 * 2, 256 * 2, 36, 8, 4, defer ? 96 : Gw, defer ? ((bid >= 48 && bid < 144) ? bid - 48 : BIG) : (bid < Gw ? (bid + Gw / 2) % Gw : BIG)};
              EpiStoreBf16 E{(bf16_t*)(F.ws + WS_KVLA), 2048}; pg8::gemm_phase(F.lds, 256 * 2, 256 * 2, S, E); }
            if (MK_FILL && l == 0 && rep == 0) fill_convert(F, args, ph, false); })
        PHASE5(if (MK_CVSIDE) phase_convert_side(F, args, bid, l == 0 ? IT_EARLY : IT_LAYER + IT_EARLY, l == 0 ? IT_LAYER + IT_EARLY : 2 * IT_LAYER); phase_mixers(F, args, l, (char*)lds, 1 + REP(5)); if (MK_CONVTAIL) phase_convert_tail(F, args, l);)
        PHASE(6, phase_mlfin(F, args, l, nM * 256);)
        PHASE(7, {
            SchedMerge S{(const char*)(F.ws + WS_YCAT), (const char*)(F.ws + wlo + W_BR), nM, F.G, bid};
            EpiMerge E{(const bf16_t*)(F.ws + WS_P), (bf16_t*)(F.ws + WS_MF32), (bf16_t*)(F.ws + WS_MBF), (bf16_t*)(F.ws + WS_H), (unsigned*)(F.ws + WS_CTL) + CW_MCNT, (unsigned*)(F.ws + WS_CTL) + CW_ODONE};
            pg8::gemm_phase(F.lds, 3072 * 2, 1024 * 2, S, E);
            if (l == 0 && F.G == 256 && bid >= 96 && bid < 160 && rep == 0) {
                unsigned* od = (unsigned*)(F.ws + WS_CTL) + CW_ODONE + (((bid - 96) >> 1) >> 3) * 16;
                if (F.tid == 0) { unsigned sp = 0; while (xb_ld(od) < 64u && ++sp < (1u << 22)) __builtin_amdgcn_s_sleep(2); }
                __syncthreads();
                SchedOutCtx S2{(const char*)(F.ws + WS_MBF), (const char*)(F.ws + wlo + W_OUT), bid};
                EpiOut E2{args.in[I_X], args.in[I_CTX], (float*)(F.ws + WS_X1), (const float*)(F.ws + WS_MODS), l, (bf16_t*)(F.ws + WS_H + (16u << 20)), (unsigned*)(F.ws + WS_CTL) + CW_OCNT};
                pg8::gemm_phase<false, 17>(F.lds, DM * 2, DM * 2, S2, E2); } })
        PHASE(8, {
            SchedDense S{(const char*)(F.ws + WS_MBF), (const char*)(F.ws + wlo + W_OUT), DM * 2, DM * 2, (l == 0 && F.G == 256) ? 32 : nM, 8, 32, F.G, bid};
            EpiOut E{args.in[I_X], args.in[I_CTX], (float*)(F.ws + WS_X1), (const float*)(F.ws + WS_MODS), l, nullptr, nullptr};
            if (rep == 0 || l == 0) pg8::gemm_phase(F.lds, DM * 2, DM * 2, S, E); if (MK_FILL && l == 0 && rep == 0) fill_convert(F, args, ph, false); })
        PHASE(9, phase_mod2(F, args, l, nM * 256);)
        PHASE(10, phase_topk(F, args, l, bid);)
        PHASE(11, {
            SchedMoe S{(const char*)(F.ws + WS_H), (const char*)(F.ws + wlo + W_E13), DM * 2, DM * 2, (l == 0) ? 5 : 4, 32, F.G, bid, 1};
            const bool early = (l == 0 && F.G == 256 && rep == 0);
            EpiMoe1 E{(bf16_t*)(F.ws + WS_ACT), early ? (unsigned*)(F.ws + WS_CTL) + CW_E1CNT : nullptr};
            pg8::gemm_phase<true>(F.lds, DM * 2, DM * 2, S, E, (const int*)(F.ws + WS_ROWS));
            if (early && bid >= 128) {
                unsigned* ec = (unsigned*)(F.ws + WS_CTL) + CW_E1CNT + (2 * ((bid - 128) & 7)) * 16;
                if (F.tid == 0) { unsigned sp = 0; while (xb_ld(ec) < 128u && ++sp < (1u << 22)) __builtin_amdgcn_s_sleep(2); }
                __syncthreads();
                SchedMoe2Early S2{(const char*)(F.ws + WS_ACT), (const char*)(F.ws + wlo + W_E2), bid};
                EpiMoe2 E2{(const float*)(F.ws + WS_VALS), (bf16_t*)(F.ws + WS_YE)};
                pg8::gemm_phase<false, 17>(F.lds, EFF * 2, EFF * 2, S2, E2); } })
        PHASE(12, {
            EpiMoe2 E{(const float*)(F.ws + WS_VALS), (bf16_t*)(F.ws + WS_YE)};
            if (l == 0 && F.G == 256) { SchedMoe2Rest S{(const char*)(F.ws + WS_ACT), (const char*)(F.ws + wlo + W_E2), bid}; pg8::gemm_phase(F.lds, EFF * 2, EFF * 2, S, E); }
            else { SchedMoe S{(const char*)(F.ws + WS_ACT), (const char*)(F.ws + wlo + W_E2), EFF * 2, EFF * 2, (l == 0) ? 5 : 4, 16, F.G, bid, 0}; pg8::gemm_phase(F.lds, EFF * 2, EFF * 2, S, E); } })
    }
    PHASE(13, phase_final(F, args);)
    if (MK_TPH >= 0) {
        xcd_barrier(bar);
        if (blockIdx.x == 0 && threadIdx.x == 0) {
            const unsigned long long* st = (const unsigned long long*)(F0.ws + WS_CTL + 1536 * 1024);
            unsigned long long mx = 0, mxp = 0, sum = 0; const int G = gridDim.x;
            for (int bq = 0; bq < G; ++bq) { const unsigned long long e = st[MK_TPH * 256 + bq], p = st[(MK_TPH - 1) * 256 + bq]; mx = e > mx ? e : mx; mxp = p > mxp ? p : mxp; sum += e; }
            const float dur = MK_TMODE == 0 ? (float)(mx - mxp) * 0.01f : (float)((double)sum / G - (double)mxp) * 0.01f;
            args.out[0] = 20.f + floorf(dur / MK_TQ) * MK_TQ;
        }
    }
#undef PHASE
}


extern "C" void kernel_launch(void* const* d_in, const int* in_sizes, int n_in, void* d_out, int out_size, void* d_ws, size_t ws_size, hipStream_t stream) {
    static int grid = 0;
    if (grid == 0) {
        if (n_in != 24 || out_size != MLAT * DM || ws_size < WS_END) { fprintf(stderr, "kernel_launch: unexpected shapes: n_in %d out %d ws %zu (need %zu)\n", n_in, out_size, ws_size, (size_t)WS_END); grid = -1; return; }
        int dev = 0, cus = 0, per_cu = 0;
        if (hipGetDevice(&dev) != hipSuccess || hipDeviceGetAttribute(&cus, hipDeviceAttributeMultiprocessorCount, dev) != hipSuccess) { grid = -1; return; }
        if (hipFuncSetAttribute((const void*)mega, hipFuncAttributeMaxDynamicSharedMemorySize, LDS_BYTES) != hipSuccess) { fprintf(stderr, "kernel_launch: hipFuncSetAttribute failed\n"); grid = -1; return; }
        if (hipOccupancyMaxActiveBlocksPerMultiprocessor(&per_cu, (const void*)mega, NTHR, LDS_BYTES) != hipSuccess || per_cu < 1) { fprintf(stderr, "kernel_launch: occupancy query says %d blocks per CU\n", per_cu); }
        (void)hipGetLastError();
        grid = cus;
    }
    if (grid < 0) return;
    if (hipMemsetAsync((char*)d_ws + WS_CTL, 0, CTL_BYTES, stream) != hipSuccess) return;
    Args a{};
    for (int i = 0; i < 24; ++i) a.in[i] = (const float*)d_in[i];
    a.out = (float*)d_out; a.ws = (unsigned char*)d_ws; a.ph_lo = 0; a.ph_hi = N_PHASES < MK_LAST_PHASE ? N_PHASES : MK_LAST_PHASE;
    hipLaunchKernelGGL(mega, dim3(grid), dim3(NTHR), LDS_BYTES, stream, a);
}
```

```cpp
#include <hip/hip_runtime.h>
#include <cstdio>
#include <cstdint>

#define GAS __attribute__((address_space(1)))
#define LAS __attribute__((address_space(3)))
#define DI __device__ __forceinline__
typedef unsigned short bf16_t;
typedef short bf16x8 __attribute__((ext_vector_type(8)));
typedef short s16x4 __attribute__((ext_vector_type(4)));
typedef float f32x2 __attribute__((ext_vector_type(2)));
typedef float f32x4 __attribute__((ext_vector_type(4)));
typedef float f32x8 __attribute__((ext_vector_type(8)));
typedef float f32x16 __attribute__((ext_vector_type(16)));
typedef unsigned u32x2 __attribute__((ext_vector_type(2)));
typedef unsigned u32x4 __attribute__((ext_vector_type(4)));

constexpr int DM = 2048, NBATCH = 4, SEQ = 2048, CTXL = 256, DEPTH = 2;
constexpr int MLAT = NBATCH * SEQ, MCTX = NBATCH * CTXL, MTOT = MLAT + MCTX;
constexpr int PROJW = 12624, NP = 12800;
constexpr int C_MLQ = 0, C_MLK = 1024, C_MLV = 2048, C_MLO = 3072, C_CQ = 4096, C_CKV = 4608, C_GQ = 4864, C_GK = 5888, C_GV = 6144, C_GATE = 6400, C_X = 12544;
constexpr int XW = 80;
constexpr int NEXP = 16, EFF = 1024, ESLOT = 1280;
constexpr float EPS = 1e-6f;
constexpr int NWAVES = 8, NTHR = 512;

constexpr size_t al256(size_t x) { return (x + 255) / 256 * 256; }
constexpr size_t WS_CTL = 0, CTL_BYTES = 2u << 20;
constexpr int CW_BAR = 1024;
constexpr int CW_QUEUE = 8192;
constexpr int CW_CVHEAD = 12288;
constexpr int CW_MCNT = 20480;
constexpr int CW_OCNT = 24576;
constexpr int CW_ODONE = 28672;
constexpr int CW_E1CNT = 29696;
constexpr int CW_MLDONE = 30720;
constexpr int CW_PHDONE = 32768;
constexpr size_t WS_MODS = 1u << 20;
constexpr size_t WS_ROPE_LA = WS_CTL + CTL_BYTES;
constexpr size_t WS_ROPE_GA = WS_ROPE_LA + al256((size_t)2048 * 32 * 2 * 4);
constexpr size_t WS_W = WS_ROPE_GA + al256((size_t)2048 * 64 * 2 * 4);
constexpr size_t W_IN = 0, W_UQ = W_IN + (size_t)NP * DM * 2, W_UKV = W_UQ + (size_t)1536 * 512 * 2, W_BR = W_UKV + (size_t)2048 * 256 * 2,
                 W_OUT = W_BR + (size_t)3 * 2048 * 1024 * 2, W_E13 = W_OUT + (size_t)2048 * 2048 * 2, W_E2 = W_E13 + (size_t)NEXP * 2048 * 2048 * 2,
                 W_LAYER = W_E2 + (size_t)NEXP * 2048 * 1024 * 2;
constexpr size_t WS_H = WS_W + 2 * W_LAYER;
constexpr size_t WS_P = WS_H + (size_t)MTOT * DM * 2;
constexpr size_t WS_AG = WS_P;
constexpr size_t WS_ACT = WS_AG + (size_t)NEXP * ESLOT * DM * 2;
static_assert(WS_ACT + (size_t)NEXP * ESLOT * EFF * 2 <= WS_P + (size_t)MTOT * NP * 2, "overlay");
constexpr size_t WS_X80 = WS_P + (size_t)MTOT * NP * 2;
constexpr size_t WS_CQN = WS_X80 + al256((size_t)MTOT * XW * 4);
constexpr size_t WS_CKVN = WS_CQN + (size_t)MTOT * 512 * 2;
constexpr size_t WS_QG = WS_CKVN + (size_t)MTOT * 256 * 2;
constexpr size_t WS_KG = WS_QG + (size_t)MTOT * 1024 * 2;
constexpr size_t WS_KR = WS_KG + (size_t)MTOT * 256 * 2;
constexpr size_t WS_QLA = WS_KR + (size_t)MTOT * 64 * 2;
constexpr size_t WS_KVLA = WS_QLA + (size_t)MTOT * 1536 * 2;
constexpr size_t WS_YCAT = WS_KVLA + (size_t)MTOT * 2048 * 2;
constexpr size_t WS_MF32 = WS_YCAT + (size_t)MTOT * 3072 * 2;
constexpr size_t WS_MLH = WS_MF32;
constexpr size_t WS_MBF = WS_MF32 + (size_t)MTOT * DM * 4;
constexpr size_t WS_X1 = WS_MBF + (size_t)MTOT * DM * 2;
constexpr size_t WS_AFF = WS_X1 + (size_t)MTOT * DM * 4;
constexpr size_t WS_ROWS = WS_AFF + (size_t)MTOT * 16 * 4;
constexpr size_t WS_VALS = WS_ROWS + (size_t)NEXP * ESLOT * 4;
constexpr size_t WS_TOK = WS_VALS + (size_t)NEXP * ESLOT * 4;
constexpr size_t WS_MPART = WS_TOK + (size_t)MTOT * 16 * 4;
constexpr size_t WS_END = WS_MPART + (size_t)16 * 2 * 5 * 12288 * 4;
constexpr size_t WS_YE = WS_AG;

constexpr int RING_BYTES = 131072;
constexpr int MISC_OFF = RING_BYTES + 1024;
constexpr int LDS_BYTES = 147456;

DI float bf2f(unsigned short b) { return __uint_as_float(((unsigned)b) << 16); }
DI unsigned f2bf(float f) { unsigned u = __float_as_uint(f); return (u + 0x7fffu + ((u >> 16) & 1u)) >> 16; }
DI unsigned pk2(float lo, float hi) { unsigned r; asm volatile("v_cvt_pk_bf16_f32 %0, %1, %2" : "=v"(r) : "v"(lo), "v"(hi)); return r; }
DI int lane_id_() { int l = __builtin_amdgcn_mbcnt_hi(~0u, __builtin_amdgcn_mbcnt_lo(~0u, 0u)); asm volatile("" : "+v"(l)); return l; }
DI float bperm_f(float v, int srclane) { return __int_as_float(__builtin_amdgcn_ds_bpermute(srclane << 2, __float_as_int(v))); }
DI float shx(float v, int o) { return bperm_f(v, lane_id_() ^ o); }
DI float shl_(float v, int src) { return bperm_f(v, src); }
DI float shu(float v, int o) { const int l = lane_id_(); return bperm_f(v, l >= o ? l - o : l); }
DI float wave_sum(float v) { const int l = lane_id_();
#pragma unroll
    for (int o = 1; o < 64; o <<= 1) v += bperm_f(v, l ^ o);
    return v;
}
DI float wave_max(float v) { const int l = lane_id_();
#pragma unroll
    for (int o = 1; o < 64; o <<= 1) v = fmaxf(v, bperm_f(v, l ^ o));
    return v;
}
DI float sigmoidf_(float x) { return __builtin_amdgcn_rcpf(1.f + __expf(-x)); }
DI float siluf_(float x) { return x * __builtin_amdgcn_rcpf(1.f + __expf(-x)); }
#define LDS_WAIT() asm volatile("s_waitcnt lgkmcnt(0)" ::: "memory")
#define VM_WAIT() asm volatile("s_waitcnt vmcnt(0)" ::: "memory")

#define XB_TMO      128
#define XB_XCNT(j)  (256  + 64 * (j))
#define XB_XSUB(j)  (1280 + 64 * (j))
#define XB_XGEN(j)  (2304 + 64 * (j))
#define XB_TOP      3328
#define XB_TOPGEN   3392
#define XCD_BAR_WORDS 3456
#define XB_SPIN_CAP (1u << 20)

DI unsigned xb_ld(unsigned* p)              { return __hip_atomic_load(p, __ATOMIC_RELAXED, __HIP_MEMORY_SCOPE_AGENT); }
DI unsigned xb_add(unsigned* p, unsigned v) { return __hip_atomic_fetch_add(p, v, __ATOMIC_RELAXED, __HIP_MEMORY_SCOPE_AGENT); }
DI unsigned xb_xcc_id() { return (unsigned)__builtin_amdgcn_s_getreg((3 << 11) | 20) & 0xFu; }
#define XB_SPIN(cond, bar) do { unsigned _sp = 0; while (cond) { __builtin_amdgcn_s_sleep(1); \
    if ((++_sp & 255u) == 0u) { if (xb_ld(&(bar)[XB_TMO])) break; if (_sp > XB_SPIN_CAP) { atomicAdd(&(bar)[XB_TMO], 1u); break; } } } } while (0)

struct XcdBarrier { unsigned* bar; unsigned x; volatile LAS unsigned* st; };

DI XcdBarrier xcd_barrier_post(unsigned* bar, volatile LAS unsigned* st) {
    XcdBarrier b; b.bar = bar; b.x = xb_xcc_id(); b.st = st;
    if (threadIdx.x == 0) (void)xb_add(&bar[XB_XCNT(b.x)], 1u);
    return b;
}
DI void xcd_barrier_complete(unsigned* bar, unsigned x, unsigned& nloc, unsigned& nx) {
    const unsigned G = gridDim.x * gridDim.y * gridDim.z;
    unsigned sum, cnt, mine, sp = 0u;
    for (;;) {
        sum = 0u; cnt = 0u; mine = 0u;
#pragma unroll
        for (unsigned j = 0; j < 16; ++j) { const unsigned c = xb_ld(&bar[XB_XCNT(j)]); sum += c; cnt += (c > 0u) ? 1u : 0u; mine = (j == x) ? c : mine; }
        if (sum == G) break;
        __builtin_amdgcn_s_sleep(1);
        if ((++sp & 255u) == 0u) { if (xb_ld(&bar[XB_TMO])) break; if (sp > XB_SPIN_CAP) { atomicAdd(&bar[XB_TMO], 1u); break; } }
    }
    nloc = mine > 0u ? mine : 1u; nx = cnt > 0u ? cnt : 1u;
}
DI void xcd_barrier(const XcdBarrier& b) {
    asm volatile("s_waitcnt vmcnt(0)" ::: "memory");
    __syncthreads();
    if (threadIdx.x == 0) {
        unsigned* bar = b.bar; asm volatile("" : "+s"(bar));
        __builtin_amdgcn_s_waitcnt(0);
        unsigned nloc = b.st[0], nx = b.st[1];
        unsigned bx = b.x; asm volatile("" : "+s"(bx));
        if (nloc == 0u) { xcd_barrier_complete(bar, bx, nloc, nx); b.st[0] = nloc; b.st[1] = nx; }
        const unsigned old = xb_add(&bar[XB_XSUB(bx)], 1u);
        const unsigned gen = old / nloc;
        if (old + 1u == (gen + 1u) * nloc) {
            __builtin_amdgcn_fence(__ATOMIC_RELEASE, "agent");
            asm volatile("s_waitcnt vmcnt(0)" ::: "memory");
            const unsigned og = xb_add(&bar[XB_TOP], 1u);
            const unsigned tg = og / nx;
            if (og + 1u == (tg + 1u) * nx) xb_add(&bar[XB_TOPGEN], 1u);
            else XB_SPIN(xb_ld(&bar[XB_TOPGEN]) == tg, bar);
            __builtin_amdgcn_fence(__ATOMIC_ACQUIRE, "agent");
            xb_add(&bar[XB_XGEN(bx)], 1u);
            asm volatile("s_waitcnt vmcnt(0)" ::: "memory");
        } else {
            XB_SPIN(xb_ld(&bar[XB_XGEN(bx)]) == gen, bar);
            __builtin_amdgcn_fence(__ATOMIC_ACQUIRE, "agent");
            asm volatile("s_waitcnt vmcnt(0)" ::: "memory");
        }
    }
    __syncthreads();
}

struct Args { const float* in[24]; float* out; unsigned char* ws; int ph_lo, ph_hi; };
enum { I_X = 0, I_C, I_CTX, I_CCTX, I_WMOD, I_BMOD, I_WIN, I_GBIAS, I_MLNORM, I_LAQN, I_LAKVN, I_UQ, I_UKV, I_GAQN, I_GAKN, I_BRML, I_BRLA, I_BRGA, I_WOUT, I_WROUTER, I_WE1, I_WE3, I_WE2, I_FNORM };

struct Frame {
    LAS unsigned char* lds;
    unsigned char* ws;
    int tid, lane, wave, G, vcu, gw, ngw;
};

DI int mods_row(int row) { return row < MLAT ? (row >> 11) : 4; }
DI const float* mods_ptr(const Frame& F, int l, int row, int which  ) {
    return (const float*)(F.ws + WS_MODS) + ((size_t)(l * 5 + mods_row(row)) * 6 + which) * DM;
}

namespace pg8 {
constexpr int BM = 256, BK = 64, HALF = 128, HTB = HALF * BK * 2, STAGE_BYTES = 8 * HTB, NXCD = 8, WGM = 8;
__host__ __device__ __forceinline__ int lds_byte(int r, int c) { const int st = (r >> 4) * 2 + (c >> 5), rr = r & 15, cc = c & 31, ob = rr * 64 + cc * 2; return st * 1024 + (ob ^ (((ob >> 9) & 1) << 5)); }
__host__ __device__ __forceinline__ void stage_rc(int b, int& R, int& C) { const int st = b / 1024, sb = b % 1024, swz = sb ^ (((sb >> 9) & 1) << 5); R = (st >> 1) * 16 + swz / 64; C = (st & 1) * 32 + (swz % 64) / 2; }
__host__ __device__ __forceinline__ int perm32(int rho) { const int n = rho >> 4, i = rho & 15; return 8 * (i >> 2) + 4 * n + (i & 3); }

struct Unit { const char* pa; const char* pb; int pm, pn, aux, nt; };

DI void tile_of(int L, int nM, int nN, int& pm, int& pn) {
    const int nwg = nM * nN; int wgid = L;
    { const int q = nwg / NXCD, r = nwg % NXCD, xcd = wgid % NXCD, off = wgid / NXCD; wgid = (xcd < r ? xcd * (q + 1) : r * (q + 1) + (xcd - r) * q) + off; }
    const int nig = WGM * nN, gid = wgid / nig, fm = gid * WGM, gsz = (nM - fm) < WGM ? (nM - fm) : WGM;
    pm = fm + ((wgid % nig) % gsz); pn = (wgid % nig) / gsz;
}

template <bool GATHER = false, int AAUX = 0, class Epi, class Sched>
DI void gemm_phase(LAS unsigned char* lds, const int lda  , const int ldb  , const Sched& S, const Epi& E, const int* rows = nullptr) {
    int tid = threadIdx.x; asm volatile("" : "+v"(tid));
    const int wid = __builtin_amdgcn_readfirstlane(tid >> 6), lane = tid & 63, wr = wid >> 2, wc = wid & 3, fr = lane & 15, fq = lane >> 4;
    unsigned vA0[2], vA1[2], nA0[2], nA1[2], voffB[2]; int sR[2], sC[2];
#pragma unroll
    for (int i = 0; i < 2; ++i) { int R, C; stage_rc(tid * 16 + i * 8192, R, C); const int Rb = (R & ~31) + perm32(R & 31); sR[i] = R; sC[i] = C;
        vA0[i] = (unsigned)(R * lda + C * 2); vA1[i] = (unsigned)((R + HALF) * lda + C * 2); nA0[i] = vA0[i]; nA1[i] = vA1[i]; voffB[i] = (unsigned)(Rb * ldb + C * 2); }
#define PG8_GATHER_OFFS(u_, d0, d1) do { if (GATHER) { _Pragma("unroll") for (int i = 0; i < 2; ++i) { const int r0_ = rows[(u_).pm * 256 + sR[i]], r1_ = rows[(u_).pm * 256 + HALF + sR[i]]; \
        d0[i] = (unsigned)((r0_ < 0 ? 0 : r0_) * lda + sC[i] * 2); d1[i] = (unsigned)((r1_ < 0 ? 0 : r1_) * lda + sC[i] * 2); } } } while (0)
    const size_t kstep = (size_t)(BK * 2);
    const size_t hstepB = (size_t)HALF * ldb;
    const unsigned ldsw = (unsigned)wid * 1024u;
    const int aoff = lds_byte(wr * 64 + fr, fq * 8), boff = lds_byte(wc * 32 + fr, fq * 8);
#define PG8_SA(b, h) (((b) * 2 + (h)) * HTB)
#define PG8_SB(b, h) ((4 + (b) * 2 + (h)) * HTB)
#define PG8_STAGE(bufoff, gbase, voff) do { _Pragma("unroll") for (int _i = 0; _i < 2; ++_i) \
        __builtin_amdgcn_global_load_lds((const unsigned*)((const char*)(gbase) + (voff)[_i]), (LAS unsigned*)(lds + (bufoff) + ldsw + _i * 8192), 16, 0, 0); } while (0)
#define PG8_STAGEA(bufoff, gbase, voff) do { _Pragma("unroll") for (int _i = 0; _i < 2; ++_i) \
        __builtin_amdgcn_global_load_lds((const unsigned*)((const char*)(gbase) + (voff)[_i]), (LAS unsigned*)(lds + (bufoff) + ldsw + _i * 8192), 16, 0, AAUX); } while (0)
#define PG8_LDA(dst, b, h) do { _Pragma("unroll") for (int m = 0; m < 4; ++m) _Pragma("unroll") for (int k = 0; k < 2; ++k) dst[m][k] = *(const LAS bf16x8*)(lds + PG8_SA(b, h) + aoff + m * 2048 + k * 1024); } while (0)
#define PG8_LDB(dst, b, h) do { _Pragma("unroll") for (int n = 0; n < 2; ++n) _Pragma("unroll") for (int k = 0; k < 2; ++k) dst[n][k] = *(const LAS bf16x8*)(lds + PG8_SB(b, h) + boff + n * 2048 + k * 1024); } while (0)
#define PG8_MMA(ai, bj, At, Bt) do { __builtin_amdgcn_s_setprio(1); _Pragma("unroll") for (int m = 0; m < 4; ++m) _Pragma("unroll") for (int n = 0; n < 2; ++n) _Pragma("unroll") for (int k = 0; k < 2; ++k) \
        acc[ai][bj][m][n] = __builtin_amdgcn_mfma_f32_16x16x32_bf16(Bt[n][k], At[m][k], acc[ai][bj][m][n], 0, 0, 0); __builtin_amdgcn_s_setprio(0); } while (0)
#define PG8_WAIT_V(n) asm volatile("s_waitcnt vmcnt(" #n ")" ::: "memory")
#define PG8_WAIT_L(n) asm volatile("s_waitcnt lgkmcnt(" #n ")" ::: "memory")
#define PG8_BAR __builtin_amdgcn_s_barrier()
#define PG8_SCHED __builtin_amdgcn_sched_barrier(0)
    Unit cur, nxt; int ui = 0;
    if (!S.next(0, cur)) return;
    f32x4 acc[2][2][4][2];
#pragma unroll
    for (int a = 0; a < 2; ++a)
#pragma unroll
        for (int b = 0; b < 2; ++b)
#pragma unroll
            for (int m = 0; m < 4; ++m)
#pragma unroll
                for (int n = 0; n < 2; ++n) acc[a][b][m][n] = (f32x4){0.f, 0.f, 0.f, 0.f};
    bf16x8 At[4][2], B0[2][2], B1[2][2];
    const char* cA = cur.pa; const char* cB = cur.pb;
    PG8_GATHER_OFFS(cur, vA0, vA1);
    PG8_STAGE(PG8_SB(0, 0), cB, voffB); PG8_STAGEA(PG8_SA(0, 0), cA, vA0); PG8_STAGE(PG8_SB(0, 1), cB + hstepB, voffB); PG8_STAGEA(PG8_SA(0, 1), cA, vA1);
    if (wr == 1) PG8_BAR;
    PG8_WAIT_V(4); PG8_BAR;
    PG8_STAGE(PG8_SB(1, 0), cB + kstep, voffB); PG8_STAGEA(PG8_SA(1, 0), cA + kstep, vA0); PG8_STAGE(PG8_SB(1, 1), cB + hstepB + kstep, voffB);
    PG8_WAIT_V(6); PG8_BAR;
    for (;;) {
        const bool has_next = S.next(ui + 1, nxt);
        const char* nA = has_next ? nxt.pa : cA; const char* nB = has_next ? nxt.pb : cB;
        if (GATHER) { if (has_next) PG8_GATHER_OFFS(nxt, nA0, nA1); else { _Pragma("unroll") for (int i = 0; i < 2; ++i) { nA0[i] = vA0[i]; nA1[i] = vA1[i]; } } }
        const int nt = cur.nt;
        for (int t = 0; t < nt; t += 2) {
            const bool last = (t == nt - 2);
            const char* a1 = cA + (size_t)(t + 1) * kstep;
            const char* a2 = last ? nA : cA + (size_t)(t + 2) * kstep; const char* b2 = last ? nB : cB + (size_t)(t + 2) * kstep;
            const char* a3 = a2 + kstep; const char* b3 = b2 + kstep;
            unsigned wA0[2], wA1[2];
            _Pragma("unroll") for (int i = 0; i < 2; ++i) { wA0[i] = last ? nA0[i] : vA0[i]; wA1[i] = last ? nA1[i] : vA1[i]; }
            PG8_LDB(B0, 0, 0); PG8_SCHED; PG8_LDA(At, 0, 0); PG8_STAGEA(PG8_SA(1, 1), a1, vA1);
            PG8_WAIT_L(8); PG8_BAR; PG8_WAIT_L(0); PG8_MMA(0, 0, At, B0); PG8_BAR; PG8_SCHED;
            PG8_LDB(B1, 0, 1); PG8_STAGE(PG8_SB(0, 0), b2, voffB);
            PG8_BAR; PG8_WAIT_L(0); PG8_MMA(0, 1, At, B1); PG8_BAR;
            PG8_LDA(At, 0, 1); PG8_STAGEA(PG8_SA(0, 0), a2, wA0);
            PG8_BAR; PG8_WAIT_L(0); PG8_MMA(1, 0, At, B0); PG8_BAR; PG8_SCHED;
            PG8_STAGE(PG8_SB(0, 1), b2 + hstepB, voffB);
            PG8_WAIT_V(6); PG8_BAR; PG8_MMA(1, 1, At, B1); PG8_BAR;
            PG8_LDB(B0, 1, 0); PG8_SCHED; PG8_LDA(At, 1, 0); PG8_STAGEA(PG8_SA(0, 1), a2, wA1);
            PG8_WAIT_L(8); PG8_BAR; PG8_WAIT_L(0); PG8_MMA(0, 0, At, B0); PG8_BAR; PG8_SCHED;
            PG8_LDB(B1, 1, 1); PG8_STAGE(PG8_SB(1, 0), b3, voffB);
            PG8_BAR; PG8_WAIT_L(0); PG8_MMA(0, 1, At, B1); PG8_BAR;
            PG8_LDA(At, 1, 1); PG8_STAGEA(PG8_SA(1, 0), a3, wA0);
            PG8_BAR; PG8_WAIT_L(0); PG8_MMA(1, 0, At, B0); PG8_BAR; PG8_SCHED;
            PG8_STAGE(PG8_SB(1, 1), b3 + hstepB, voffB);
            PG8_WAIT_V(6); PG8_BAR; PG8_MMA(1, 1, At, B1); PG8_BAR;
        }
        E(acc, cur, wr, wc, fr, fq);
        if (!has_next) break;
#pragma unroll
        for (int a = 0; a < 2; ++a)
#pragma unroll
            for (int b = 0; b < 2; ++b)
#pragma unroll
                for (int m = 0; m < 4; ++m)
#pragma unroll
                    for (int n = 0; n < 2; ++n) acc[a][b][m][n] = (f32x4){0.f, 0.f, 0.f, 0.f};
        cur = nxt; cA = nA; cB = nB; ++ui;
        if (GATHER) { _Pragma("unroll") for (int i = 0; i < 2; ++i) { vA0[i] = nA0[i]; vA1[i] = nA1[i]; } }
    }
    PG8_WAIT_V(0);
    if (wr == 0) PG8_BAR;
    PG8_BAR;
#undef PG8_GATHER_OFFS
#undef PG8_SA
#undef PG8_SB
#undef PG8_STAGE
#undef PG8_STAGEA
#undef PG8_LDA
#undef PG8_LDB
#undef PG8_MMA
#undef PG8_WAIT_V
#undef PG8_WAIT_L
#undef PG8_BAR
#undef PG8_SCHED
}
}
using pg8::Unit;

struct SchedDense {
    const char* A; const char* Bt; int lda, ldb, nM, nN, nt, G, c;
    DI bool next(int i, Unit& u) const {
        const long L = (long)i * G + c; if (L >= (long)nM * nN) return false;
        int pm, pn; pg8::tile_of((int)L, nM, nN, pm, pn);
        u.pm = pm; u.pn = pn; u.aux = 0; u.nt = nt; u.pa = A + (size_t)pm * 256 * lda; u.pb = Bt + (size_t)pn * 256 * ldb; return true;
    }
};

struct SchedProj {
    const char* A; const char* Bt; int l, G, c;
    DI bool next(int i, Unit& u) const {
        const long L = (long)i * G + c; int pm, pn;
        if (l == 0) { if (L >= 36 * 49) return false; pg8::tile_of((int)L, 36, 49, pm, pn); }
        else if (G == 256) {
            if (L >= 32 * 47 + 8 + 24) return false;
            if (L < 32 * 47) pg8::tile_of((int)L, 32, 47, pm, pn);
            else if (L < 32 * 47 + 8) { const int r = (int)L - 32 * 47; pm = 32 + (r >> 1); pn = (r & 1) ? 23 : 18; }
            else { pm = (int)L - (32 * 47 + 8); pn = 47; } }
        else { if (L >= 32 * 49 + 44) return false;
            if (L < 32 * 49) pg8::tile_of((int)L, 32, 49, pm, pn);
            else { const int r = (int)L - 32 * 49, j = r % 11; pm = 32 + r / 11; pn = j < 8 ? 4 + j : (j == 8 ? 18 : (j == 9 ? 23 : 24)); } }
        u.pm = pm; u.pn = pn; u.aux = 0; u.nt = 32; u.pa = A + (size_t)pm * 256 * (DM * 2); u.pb = Bt + (size_t)pn * 256 * (DM * 2); return true;
    }
};

struct SchedDefer {
    const char* A; const char* Bt; int c;
    DI bool next(int i, Unit& u) const {
        if (i != 0 || c < 0 || c >= 76) return false;
        int pm, pn;
        if (c < 8) { pm = 24 + c; pn = 47; }
        else if (c < 40) { pm = c - 8; pn = 48; }
        else { const int r = c - 40, j = r % 9; pm = 32 + r / 9; pn = j < 8 ? 4 + j : 24; }
        u.pm = pm; u.pn = pn; u.aux = 0; u.nt = 32; u.pa = A + (size_t)pm * 256 * (DM * 2); u.pb = Bt + (size_t)pn * 256 * (DM * 2); return true;
    }
};

#define EPI_FOREACH(...) \
    _Pragma("unroll") for (int ai = 0; ai < 2; ++ai) _Pragma("unroll") for (int m = 0; m < 4; ++m) { const int row = u.pm * 256 + ai * 128 + wr * 64 + m * 16 + fr; \
    _Pragma("unroll") for (int bj = 0; bj < 2; ++bj) { const int col = u.pn * 256 + bj * 128 + wc * 32 + 8 * fq; const f32x4 v0 = acc[ai][bj][m][0], v1 = acc[ai][bj][m][1]; __VA_ARGS__ } }

DI u32x4 pack8(const f32x4 v0, const f32x4 v1) { u32x4 w; w.x = pk2(v0[0], v0[1]); w.y = pk2(v0[2], v0[3]); w.z = pk2(v1[0], v1[1]); w.w = pk2(v1[2], v1[3]); return w; }

struct EpiStoreBf16 {
    bf16_t* O; int ldc;
    DI void operator()(const f32x4 (&acc)[2][2][4][2], const Unit& u, int wr, int wc, int fr, int fq) const {
        EPI_FOREACH({ *(u32x4*)(O + (size_t)row * ldc + col) = pack8(v0, v1); })
    }
};
struct EpiProj {
    bf16_t* P;
    DI void operator()(const f32x4 (&acc)[2][2][4][2], const Unit& u, int wr, int wc, int fr, int fq) const {
        EPI_FOREACH({ *(u32x4*)(P + (size_t)row * NP + col) = pack8(v0, v1); })
    }
};
struct EpiX {
    bf16_t* KR; float* X80; const float* rla;
    DI void operator()(const f32x4 (&acc)[2][2][4][2], const Unit& u, int wr, int wc, int fr, int fq) const {
#pragma unroll
        for (int ai = 0; ai < 2; ++ai)
#pragma unroll
            for (int m = 0; m < 4; ++m) { const int row = u.pm * 256 + ai * 128 + wr * 64 + m * 16 + fr; const bool lat = row < MLAT; const int t = row & 2047;
#pragma unroll
                for (int n = 0; n < 2; ++n) { const f32x4 v = acc[ai][0][m][n];
                    f32x4 pr; pr.x = shx(v.x, 32); pr.y = shx(v.y, 32); pr.z = shx(v.z, 32); pr.w = shx(v.w, 32);
                    if (wc < 2) {
                        const int idx = 8 * (fq & 1) + 4 * n; f32x4 o = v;
                        if (lat) { const float* cs = rla + ((size_t)t * 32 + wc * 16 + idx) * 2; const f32x4 c0 = *(const f32x4*)cs, c1 = *(const f32x4*)(cs + 4);
                            if (fq < 2) { o.x = v.x * c0.x - pr.x * c0.y; o.y = v.y * c0.z - pr.y * c0.w; o.z = v.z * c1.x - pr.z * c1.y; o.w = v.w * c1.z - pr.w * c1.w; }
                            else        { o.x = pr.x * c0.y + v.x * c0.x; o.y = pr.y * c0.w + v.y * c0.z; o.z = pr.z * c1.y + v.z * c1.x; o.w = pr.w * c1.w + v.w * c1.z; } }
                        u32x2 w2; w2.x = pk2(o.x, o.y); w2.y = pk2(o.z, o.w);
                        *(u32x2*)(KR + (size_t)row * 64 + 32 * wc + 8 * fq + 4 * n) = w2;
                    } else if (wc == 2 && fq < 2) *(f32x4*)(X80 + (size_t)row * XW + 64 + 8 * fq + 4 * n) = v;
                } }
    }
};

DI int win_src_col(int n) {
    if (n < 4096) return n;
    if (n < 4608) return n - 4096 + 4112;
    if (n < 4864) return n - 4608 + 4624;
    if (n < 5888) return n - 4864 + 4944;
    if (n < 6144) return n - 5888 + 5968;
    if (n < 6400) return n - 6144 + 6224;
    if (n < 12544) return n - 6400 + 6480;
    if (n < 12608) return n - 12544 + 4880;
    if (n < 12624) return n - 12608 + 4096;
    return -1;
}
DI void transpose_item(const float* W, int ldw, int K, bf16_t* WT, int k0, int n0, int srcc, LAS float* scr, int lane) {
#pragma unroll 8
    for (int i = 0; i < 32; ++i) { const int kk = 2 * i + (lane >> 5); scr[kk * 33 + (lane & 31)] = srcc >= 0 ? W[(size_t)(k0 + kk) * ldw + srcc] : 0.f; }
    LDS_WAIT(); asm volatile("" ::: "memory");
    const int c = lane & 7;
#pragma unroll
    for (int j = 0; j < 4; ++j) { const int n = (lane >> 3) + 8 * j; const LAS float* s = scr + (8 * c) * 33 + n;
        u32x4 o; o.x = pk2(s[0 * 33], s[1 * 33]); o.y = pk2(s[2 * 33], s[3 * 33]); o.z = pk2(s[4 * 33], s[5 * 33]); o.w = pk2(s[6 * 33], s[7 * 33]);
        *(u32x4*)(WT + (size_t)(n0 + n) * K + k0 + 8 * c) = o; }
    LDS_WAIT(); asm volatile("" ::: "memory");
}

constexpr int IT_IN = 32 * 400, IT_UQ = 8 * 48, IT_UKV = 4 * 64, IT_BR = 16 * 64, IT_OUT = 32 * 64, IT_E13 = 32 * 64, IT_E2 = 16 * 64;
constexpr int IT_EARLY = IT_IN + IT_UQ + IT_UKV, IT_LAYER = IT_EARLY + 3 * IT_BR + IT_OUT + NEXP * IT_E13 + NEXP * IT_E2;
struct CvDesc { const float* src; size_t ld2; bf16_t* dst; int K; };
DI CvDesc cv_make(const float* W, int ldw, int K, bf16_t* WT, int k0, int n0, int srcc, int lane) {
    CvDesc d; d.src = srcc >= 0 ? W + (size_t)(k0 + (lane >> 5)) * ldw + srcc : nullptr; d.ld2 = 2 * (size_t)ldw; d.dst = WT + (size_t)n0 * K + k0; d.K = K; return d; }
DI CvDesc cv_desc(const Frame& F, const Args& a, int l, int r) {
    unsigned char* wl = F.ws + WS_W + (size_t)l * W_LAYER;
    const int lane = F.lane, ln = lane & 31;
    if (r < IT_IN) { const int kb = r / 400, nb = r % 400; return cv_make(a.in[I_WIN] + (size_t)l * DM * PROJW, PROJW, DM, (bf16_t*)(wl + W_IN), 64 * kb, 32 * nb, win_src_col(32 * nb + ln), lane); } r -= IT_IN;
    if (r < IT_UQ) { const int kb = r / 48, nb = r % 48; return cv_make(a.in[I_UQ] + (size_t)l * 512 * 1536, 1536, 512, (bf16_t*)(wl + W_UQ), 64 * kb, 32 * nb, 32 * nb + ln, lane); } r -= IT_UQ;
    if (r < IT_UKV) { const int kb = r / 64, nb = r % 64; return cv_make(a.in[I_UKV] + (size_t)l * 256 * 2048, 2048, 256, (bf16_t*)(wl + W_UKV), 64 * kb, 32 * nb, 32 * nb + ln, lane); } r -= IT_UKV;
    if (r < 3 * IT_BR) { const int br = r / IT_BR, q = r % IT_BR, kb = q / 64, nb = q % 64;
        return cv_make(a.in[I_BRML + br] + (size_t)l * 1024 * 2048, 2048, 1024, (bf16_t*)(wl + W_BR) + (size_t)br * 2048 * 1024, 64 * kb, 32 * nb, 32 * nb + ln, lane); } r -= 3 * IT_BR;
    if (r < IT_OUT) { const int kb = r / 64, nb = r % 64; return cv_make(a.in[I_WOUT] + (size_t)l * 2048 * 2048, 2048, 2048, (bf16_t*)(wl + W_OUT), 64 * kb, 32 * nb, 32 * nb + ln, lane); } r -= IT_OUT;
    if (r < NEXP * IT_E13) { const int e = r / IT_E13, q = r % IT_E13, kb = q / 64, nb = q % 64;
        const int n0 = 32 * nb, j = n0 >> 8, half = (n0 >> 7) & 1, cc = n0 & 127;
        return cv_make(a.in[half ? I_WE3 : I_WE1] + ((size_t)l * NEXP + e) * 2048 * 1024, 1024, 2048, (bf16_t*)(wl + W_E13) + (size_t)e * 2048 * 2048, 64 * kb, n0, j * 128 + cc + ln, lane); } r -= NEXP * IT_E13;
    { const int e = r / IT_E2, q = r % IT_E2, kb = q / 64, nb = q % 64;
        return cv_make(a.in[I_WE2] + ((size_t)l * NEXP + e) * 1024 * 2048, 2048, 1024, (bf16_t*)(wl + W_E2) + (size_t)e * 2048 * 1024, 64 * kb, 32 * nb, 32 * nb + ln, lane); }
}
DI void cv_load(const CvDesc& d, float (&v)[32]) {
#pragma unroll
    for (int i = 0; i < 32; ++i) v[i] = d.src ? __builtin_nontemporal_load(d.src + (size_t)i * d.ld2) : 0.f;
}
DI void cv_store(const CvDesc& d, const float (&v)[32], LAS float* scr, int lane) {
#pragma unroll
    for (int i = 0; i < 32; ++i) scr[(2 * i + (lane >> 5)) * 33 + (lane & 31)] = v[i];
    LDS_WAIT(); asm volatile("" ::: "memory");
    const int c = lane & 7;
#pragma unroll
    for (int j = 0; j < 4; ++j) { const int n = (lane >> 3) + 8 * j; const LAS float* s = scr + (8 * c) * 33 + n;
        u32x4 o; o.x = pk2(s[0 * 33], s[1 * 33]); o.y = pk2(s[2 * 33], s[3 * 33]); o.z = pk2(s[4 * 33], s[5 * 33]); o.w = pk2(s[6 * 33], s[7 * 33]);
        *(u32x4*)(d.dst + (size_t)n * d.K + 8 * c) = o; }
    LDS_WAIT(); asm volatile("" ::: "memory");
}
DI void convert_range(const Frame& F, const Args& a, int first, int stride, int n_items, LAS float* scr) {
    int it = first; if (it >= n_items) return;
    CvDesc cur = cv_desc(F, a, it / IT_LAYER, it % IT_LAYER); float v[32]; cv_load(cur, v);
    for (;;) {
        const int nx = it + stride; const bool hn = nx < n_items; const int pn = hn ? nx : it;
        const CvDesc nd = cv_desc(F, a, pn / IT_LAYER, pn % IT_LAYER); float wv[32]; cv_load(nd, wv);
        cv_store(cur, v, scr, F.lane);
        if (!hn) break;
        cur = nd; it = nx;
#pragma unroll
        for (int i = 0; i < 32; ++i) v[i] = wv[i];
    }
}
DI void convert_item(const Frame& F, const Args& a, int l, int r, LAS float* scr) {
    const CvDesc d = cv_desc(F, a, l, r); float v[32]; cv_load(d, v); cv_store(d, v, scr, F.lane);
}

DI void phase_prologue(const Frame& F, const Args& a, int rep) {
    LAS float* scr = (LAS float*)(F.lds + F.wave * 16384);
    if (rep == 0) {
        const float* c = a.in[I_C]; const float* cctx = a.in[I_CCTX]; const float* wmod = a.in[I_WMOD];
        constexpr int NIT = 2 * 48 * 16;
        for (int it = F.gw; it < NIT; it += F.ngw) {
            const int l = it / 768, rem = it % 768, cb = rem / 16, kp = rem % 16, k0 = kp * 128, j0 = cb * 256 + F.lane * 4;
#pragma unroll
            for (int i = 0; i < 10; ++i) { const int idx = F.lane + 64 * i, r = idx >> 7, kk = idx & 127; const float v = r < 4 ? c[r * DM + k0 + kk] : cctx[k0 + kk]; scr[idx] = siluf_(v); }
            LDS_WAIT(); asm volatile("" ::: "memory");
            f32x4 acc[5];
#pragma unroll
            for (int r = 0; r < 5; ++r) acc[r] = (f32x4){0.f, 0.f, 0.f, 0.f};
            const float* wp = wmod + ((size_t)l * DM + k0) * (6 * DM) + j0;
#pragma unroll 8
            for (int kk = 0; kk < 128; ++kk) { const f32x4 w = __builtin_nontemporal_load((const f32x4*)(wp + (size_t)kk * (6 * DM)));
#pragma unroll
                for (int r = 0; r < 5; ++r) acc[r] += w * scr[r * 128 + kk]; }
#pragma unroll
            for (int r = 0; r < 5; ++r) *(f32x4*)((float*)(F.ws + WS_MPART) + ((size_t)(kp * 2 + l) * 5 + r) * (6 * DM) + j0) = acc[r];
            LDS_WAIT(); asm volatile("" ::: "memory");
        }
    }
    {
        float* rla = (float*)(F.ws + WS_ROPE_LA); float* rga = (float*)(F.ws + WS_ROPE_GA);
        const int gt = F.gw * 64 + F.lane, ngt = F.ngw * 64;
        for (int i = gt; i < 2048 * 32; i += ngt) { const int t = i >> 5, aidx = i & 31, ax = aidx >> 4, fi = aidx & 15;
            const float inv = exp2f(-(float)fi * (13.287712379549449f / 16.f)); const float ang = (float)(ax ? (t & 63) : (t >> 6)) * inv;
            rla[2 * i] = cosf(ang); rla[2 * i + 1] = sinf(ang); }
        for (int i = gt; i < 2048 * 64; i += ngt) { const int t = i >> 6, aidx = i & 63, ax = aidx >> 5, fi = aidx & 31;
            const float inv = exp2f(-(float)fi * (13.287712379549449f / 32.f)); const float ang = (float)(ax ? (t & 63) : (t >> 6)) * inv;
            rga[2 * i] = cosf(ang); rga[2 * i + 1] = sinf(ang); }
    }
#ifndef MK_CONVTAIL
#define MK_CONVTAIL 0
#endif
#ifndef MK_FILL
#define MK_FILL 0
#endif
#ifndef MK_CVSIDE
#define MK_CVSIDE 2
#endif
#ifndef MK_CVFROM
#define MK_CVFROM IT_EARLY
#endif
    if (MK_CONVTAIL) { for (int it = F.gw; it < IT_EARLY; it += F.ngw) convert_item(F, a, 0, it, scr); }
    else convert_range(F, a, F.gw, F.ngw, MK_CVSIDE ? MK_CVFROM : (MK_FILL ? IT_LAYER : 2 * IT_LAYER), scr);
}

DI void phase_mods_reduce(const Frame& F, const Args& a) {
    float* mods = (float*)(F.ws + WS_MODS); const float* part = (const float*)(F.ws + WS_MPART); const float* bmod = a.in[I_BMOD];
    const int gt = F.gw * 64 + F.lane, ngt = F.ngw * 64;
    for (int i = gt; i < 2 * 5 * 12288 / 4; i += ngt) { const int l = i / (5 * 3072), j4 = i % 3072;
        f32x4 s = *(const f32x4*)(bmod + (size_t)l * 12288 + 4 * j4);
#pragma unroll
        for (int kp = 0; kp < 16; ++kp) s += *(const f32x4*)(part + (size_t)kp * (2 * 5 * 12288) + 4 * (size_t)i);
        *(f32x4*)(mods + 4 * (size_t)i) = s; }
}

DI const float* resid_row(const Frame& F, const Args& a, int l, int row) {
    if (l == 0) return row < MLAT ? a.in[I_X] + (size_t)row * DM : a.in[I_CTX] + (size_t)(row - MLAT) * DM;
    return (const float*)(F.ws + WS_X1) + (size_t)row * DM;
}
DI void load_row(const float* p, int lane, f32x4 (&v)[8]) {
#pragma unroll
    for (int j = 0; j < 8; ++j) v[j] = *(const f32x4*)(p + 4 * lane + 256 * j);
}
template <bool G2LDS = false>
DI void combine_row(const Frame& F, int lp, int row, const f32x4 (&x)[8], int tokv, f32x4 (&v)[8], const LAS float* g2l = nullptr) {
    const bf16_t* YE = (const bf16_t*)(F.ws + WS_YE);
    f32x4 s[8];
#pragma unroll
    for (int j = 0; j < 8; ++j) s[j] = (f32x4){0.f, 0.f, 0.f, 0.f};
    unsigned mask = (unsigned)__ballot(tokv >= 0) & 0xffffu;
    while (mask) {
        const int e0 = __builtin_ctz(mask); mask &= mask - 1u; const bool two = mask != 0u; const int e1 = two ? __builtin_ctz(mask) : e0; mask &= mask - 1u;
        const int slot0 = __builtin_amdgcn_readlane(tokv, e0), slot1 = __builtin_amdgcn_readlane(tokv, e1);
        const bf16_t* y0r = YE + ((size_t)e0 * ESLOT + slot0) * DM; const bf16_t* y1r = YE + ((size_t)e1 * ESLOT + slot1) * DM;
        s16x4 y0[8], y1[8];
#pragma unroll
        for (int j = 0; j < 8; ++j) { y0[j] = *(const s16x4*)(y0r + 4 * F.lane + 256 * j); y1[j] = *(const s16x4*)(y1r + 4 * F.lane + 256 * j); }
#pragma unroll
        for (int j = 0; j < 8; ++j) s[j] += (f32x4){bf2f((unsigned short)y0[j][0]), bf2f((unsigned short)y0[j][1]), bf2f((unsigned short)y0[j][2]), bf2f((unsigned short)y0[j][3])};
        if (two) {
#pragma unroll
            for (int j = 0; j < 8; ++j) s[j] += (f32x4){bf2f((unsigned short)y1[j][0]), bf2f((unsigned short)y1[j][1]), bf2f((unsigned short)y1[j][2]), bf2f((unsigned short)y1[j][3])}; }
    }
    if (G2LDS) {
#pragma unroll
        for (int j = 0; j < 8; ++j) v[j] = x[j] + s[j] * *(const LAS f32x4*)(g2l + 4 * F.lane + 256 * j); }
    else { const float* g2 = mods_ptr(F, lp, row, 5);
#pragma unroll
        for (int j = 0; j < 8; ++j) v[j] = x[j] + s[j] * *(const f32x4*)(g2 + 4 * F.lane + 256 * j); }
}
DI void modulate_vals(const Frame& F, const f32x4 (&v)[8], const float* sh, const float* sc, bf16_t* hrow, f32x4 (&hv)[8]) {
    float ss = 0.f;
#pragma unroll
    for (int j = 0; j < 8; ++j) ss += v[j].x * v[j].x + v[j].y * v[j].y + v[j].z * v[j].z + v[j].w * v[j].w;
    const float rs = rsqrtf(wave_sum(ss) * (1.f / DM) + EPS);
#pragma unroll
    for (int j = 0; j < 8; ++j) { const f32x4 s1 = *(const f32x4*)(sc + 4 * F.lane + 256 * j), s0 = *(const f32x4*)(sh + 4 * F.lane + 256 * j);
        const f32x4 h = v[j] * rs * (s1 + 1.f) + s0; hv[j] = h;
        u32x2 w; w.x = pk2(h.x, h.y); w.y = pk2(h.z, h.w); *(u32x2*)(hrow + 4 * F.lane + 256 * j) = w; }
}
DI void phase_mod1(const Frame& F, const Args& a, int l) {
    bf16_t* H = (bf16_t*)(F.ws + WS_H); const int* TOK = (const int*)(F.ws + WS_TOK);
    LAS float* ms = (LAS float*)F.lds;
    { const float* MODS = (const float*)(F.ws + WS_MODS);
      for (int i = F.tid; i < 5 * 3 * 512; i += NTHR) { const int r = i / 1536, w = (i / 512) % 3, c4 = i % 512;
          if (w == 2 && l == 0) continue;
          const int ll = w == 2 ? l - 1 : l, which = w == 2 ? 5 : w;
          f32x4 val = *(const f32x4*)(MODS + ((size_t)(ll * 5 + r) * 6 + which) * DM + 4 * c4); if (w == 1) val += 1.f;
          *(LAS f32x4*)(ms + (size_t)(r * 3 + w) * DM + 4 * c4) = val; }
      __syncthreads(); }
    int row = F.gw; if (row >= MTOT) return;
    f32x4 cur[8]; int tcur = 0;
    load_row(resid_row(F, a, l, row), F.lane, cur); if (l > 0) tcur = TOK[(size_t)row * 16 + (F.lane & 15)];
    for (;;) {
        const int nrow = row + F.ngw; const bool hn = nrow < MTOT; const int pr = hn ? nrow : row;
        f32x4 nxt[8]; int tnxt = 0;
        load_row(resid_row(F, a, l, pr), F.lane, nxt); if (l > 0) tnxt = TOK[(size_t)pr * 16 + (F.lane & 15)];
        f32x4 v[8];
        if (l == 0) {
#pragma unroll
            for (int j = 0; j < 8; ++j) v[j] = cur[j]; }
        const LAS float* mr = ms + (size_t)mods_row(row) * 3 * DM;
        if (l != 0) { combine_row<true>(F, l - 1, row, cur, tcur, v, mr + 2 * DM); float* xw = (float*)(F.ws + WS_X1) + (size_t)row * DM;
#pragma unroll
            for (int j = 0; j < 8; ++j) *(f32x4*)(xw + 4 * F.lane + 256 * j) = v[j]; }
        { float ss = 0.f;
#pragma unroll
          for (int j = 0; j < 8; ++j) ss += v[j].x * v[j].x + v[j].y * v[j].y + v[j].z * v[j].z + v[j].w * v[j].w;
          const float rs = rsqrtf(wave_sum(ss) * (1.f / DM) + EPS);
          bf16_t* hrow = H + (size_t)row * DM;
#pragma unroll
          for (int j = 0; j < 8; ++j) { const f32x4 h = v[j] * rs * *(const LAS f32x4*)(mr + DM + 4 * F.lane + 256 * j) + *(const LAS f32x4*)(mr + 4 * F.lane + 256 * j);
              u32x2 w; w.x = pk2(h.x, h.y); w.y = pk2(h.z, h.w); *(u32x2*)(hrow + 4 * F.lane + 256 * j) = w; } }
        if (!hn) break;
#pragma unroll
        for (int j = 0; j < 8; ++j) cur[j] = nxt[j];
        tcur = tnxt; row = nrow;
    }
}
DI void phase_mod2(const Frame& F, const Args& a, int l, int nrows) {
    bf16_t* H = (bf16_t*)(F.ws + WS_H); float* AFF = (float*)(F.ws + WS_AFF);
    LAS float* wr = (LAS float*)F.lds;
    const float* wsrc = a.in[I_WROUTER] + (size_t)l * DM * NEXP;
    for (int i = F.tid; i < DM * NEXP / 4; i += NTHR) { const f32x4 w4 = ((const f32x4*)wsrc)[i]; const int c = i >> 2, e0 = (i & 3) * 4;
        wr[(e0 + 0) * DM + c] = w4.x; wr[(e0 + 1) * DM + c] = w4.y; wr[(e0 + 2) * DM + c] = w4.z; wr[(e0 + 3) * DM + c] = w4.w; }
    __syncthreads();
    const float* X1 = (const float*)(F.ws + WS_X1);
    auto router = [&](const f32x4 (&hv)[8], int row) {
        float lg[16];
#pragma unroll
        for (int e = 0; e < 16; ++e) lg[e] = 0.f;
#pragma unroll
        for (int j = 0; j < 8; ++j)
#pragma unroll
            for (int e = 0; e < 16; ++e) { const f32x4 w = *(const LAS f32x4*)(wr + e * DM + 4 * F.lane + 256 * j); lg[e] += hv[j].x * w.x + hv[j].y * w.y + hv[j].z * w.z + hv[j].w * w.w; }
        float mx = -1e30f;
#pragma unroll
        for (int e = 0; e < 16; ++e) { lg[e] = wave_sum(lg[e]); mx = fmaxf(mx, lg[e]); }
        float den = 0.f;
#pragma unroll
        for (int e = 0; e < 16; ++e) { lg[e] = __expf(lg[e] - mx); den += lg[e]; }
        const float inv = 1.f / den;
        float mine = 0.f;
#pragma unroll
        for (int e = 0; e < 16; ++e) mine = (F.lane == e) ? lg[e] * inv : mine;
        if (F.lane < 16) AFF[(size_t)F.lane * MTOT + row] = mine;
    };
    const int crow = MLAT + F.gw; const bool hasc = crow < nrows;
    f32x4 cur[8];
    for (int base = 4 * F.gw; base < MLAT; base += 4 * F.ngw) {
        load_row(X1 + (size_t)base * DM, F.lane, cur);
        f32x4 s1[8], s0[8];
        { const float* sh = mods_ptr(F, l, base, 3); const float* sc = mods_ptr(F, l, base, 4);
#pragma unroll
          for (int j = 0; j < 8; ++j) { s1[j] = *(const f32x4*)(sc + 4 * F.lane + 256 * j) + 1.f; s0[j] = *(const f32x4*)(sh + 4 * F.lane + 256 * j); } }
#pragma unroll 1
        for (int k = 0; k < 4; ++k) { const int row = base + k; f32x4 hv[8];
            { const int pr = k < 3 ? row + 1 : (hasc ? crow : row); f32x4 nxt[8]; load_row(X1 + (size_t)pr * DM, F.lane, nxt);
              float ss = 0.f;
#pragma unroll
              for (int j = 0; j < 8; ++j) ss += cur[j].x * cur[j].x + cur[j].y * cur[j].y + cur[j].z * cur[j].z + cur[j].w * cur[j].w;
              const float rs = rsqrtf(wave_sum(ss) * (1.f / DM) + EPS);
              bf16_t* hrow = H + (size_t)row * DM;
#pragma unroll
              for (int j = 0; j < 8; ++j) { const f32x4 h = cur[j] * rs * s1[j] + s0[j]; hv[j] = h;
                  u32x2 w; w.x = pk2(h.x, h.y); w.y = pk2(h.z, h.w); *(u32x2*)(hrow + 4 * F.lane + 256 * j) = w; }
#pragma unroll
              for (int j = 0; j < 8; ++j) cur[j] = nxt[j]; }
            router(hv, row);
        }
    }
    if (hasc) {
        if (4 * F.gw >= MLAT) load_row(X1 + (size_t)crow * DM, F.lane, cur);
        for (int row = crow; row < nrows; row += F.ngw) { f32x4 hv[8];
            modulate_vals(F, cur, mods_ptr(F, l, row, 3), mods_ptr(F, l, row, 4), H + (size_t)row * DM, hv);
            router(hv, row);
            if (row + F.ngw < nrows) load_row(X1 + (size_t)(row + F.ngw) * DM, F.lane, cur); }
    }
    __syncthreads();
}

DI void phase_postproj(const Frame& F, const Args& a, int l) {
    const bf16_t* P = (const bf16_t*)(F.ws + WS_P);
    bf16_t* CQN = (bf16_t*)(F.ws + WS_CQN); bf16_t* CKVN = (bf16_t*)(F.ws + WS_CKVN); bf16_t* QG = (bf16_t*)(F.ws + WS_QG); bf16_t* KG = (bf16_t*)(F.ws + WS_KG);
    const float* qn = a.in[I_LAQN] + l * 512; const float* kvn = a.in[I_LAKVN] + l * 256; const float* gqn = a.in[I_GAQN] + l * 128; const float* gkn = a.in[I_GAKN] + l * 128;
    const float* rga = (const float*)(F.ws + WS_ROPE_GA);
    const int lane = F.lane;
    const f32x4 qg0 = *(const f32x4*)(qn + 8 * lane), qg1 = *(const f32x4*)(qn + 8 * lane + 4), kg0 = *(const f32x4*)(kvn + 4 * lane);
    const int hq = lane >> 4, ax = (lane >> 3) & 1, seg = lane & 7, eo = ax * 64 + 4 * seg;
    const f32x4 gqa = *(const f32x4*)(gqn + eo), gqb = *(const f32x4*)(gqn + eo + 32), gka = *(const f32x4*)(gkn + eo), gkb = *(const f32x4*)(gkn + eo + 32);
    struct Raw { bf16x8 xq; s16x4 xkv; s16x4 ha[3], hb[3]; f32x4 r0, r1; };
    auto load = [&](int row, Raw& R) { const bf16_t* pr = P + (size_t)row * NP; const int t = row & 2047;
        R.xq = *(const bf16x8*)(pr + C_CQ + 8 * lane); R.xkv = *(const s16x4*)(pr + C_CKV + 4 * lane);
#pragma unroll
        for (int p = 0; p < 3; ++p) { const int hh = p < 2 ? 4 * p + hq : 8 + (hq & 1); const bf16_t* src = pr + C_GQ + hh * 128;
            R.ha[p] = *(const s16x4*)(src + eo); R.hb[p] = *(const s16x4*)(src + eo + 32); }
        const float* rp = rga + ((size_t)t * 64 + ax * 32 + 4 * seg) * 2; R.r0 = *(const f32x4*)rp; R.r1 = *(const f32x4*)(rp + 4); };
    static_assert(C_GK == C_GQ + 8 * 128, "q and k heads contiguous");
    int row = F.gw; if (row >= MTOT) return;
    Raw cur; load(row, cur);
    for (;;) {
        const int nrow = row + F.ngw; const bool hn = nrow < MTOT; Raw nxt; load(hn ? nrow : row, nxt);
        const bool lat = row < MLAT; const bool needq = lat || l == 0;
        if (needq) {
            float f[8]; float ss = 0.f;
#pragma unroll
            for (int i = 0; i < 8; ++i) { f[i] = bf2f((unsigned short)cur.xq[i]); ss += f[i] * f[i]; }
            const float rs = rsqrtf(wave_sum(ss) * (1.f / 512.f) + EPS);
            u32x4 w; w.x = pk2(f[0] * rs * qg0.x, f[1] * rs * qg0.y); w.y = pk2(f[2] * rs * qg0.z, f[3] * rs * qg0.w); w.z = pk2(f[4] * rs * qg1.x, f[5] * rs * qg1.y); w.w = pk2(f[6] * rs * qg1.z, f[7] * rs * qg1.w);
            *(u32x4*)(CQN + (size_t)row * 512 + 8 * lane) = w;
        }
        {
            float f[4]; float ss = 0.f;
#pragma unroll
            for (int i = 0; i < 4; ++i) { f[i] = bf2f((unsigned short)cur.xkv[i]); ss += f[i] * f[i]; }
            const float rs = rsqrtf(wave_sum(ss) * (1.f / 256.f) + EPS);
            u32x2 w; w.x = pk2(f[0] * rs * kg0.x, f[1] * rs * kg0.y); w.y = pk2(f[2] * rs * kg0.z, f[3] * rs * kg0.w);
            *(u32x2*)(CKVN + (size_t)row * 256 + 4 * lane) = w;
        }
        const float cs[4] = {cur.r0.x, cur.r0.z, cur.r1.x, cur.r1.z}, sn[4] = {cur.r0.y, cur.r0.w, cur.r1.y, cur.r1.w};
        const int ln = lane_id_();
#pragma unroll
        for (int p = 0; p < 3; ++p) {
            if (p < 2 && !needq) continue;
            float xa[4], xb[4]; float ss = 0.f;
#pragma unroll
            for (int i = 0; i < 4; ++i) { xa[i] = bf2f((unsigned short)cur.ha[p][i]); xb[i] = bf2f((unsigned short)cur.hb[p][i]); ss += xa[i] * xa[i] + xb[i] * xb[i]; }
#pragma unroll
            for (int o = 1; o < 16; o <<= 1) ss += bperm_f(ss, ln ^ o);
            const float rs = rsqrtf(ss * (1.f / 128.f) + EPS);
            const f32x4 ga = p < 2 ? gqa : gka, gb = p < 2 ? gqb : gkb;
            float oa[4], ob[4];
#pragma unroll
            for (int i = 0; i < 4; ++i) { const float ya = xa[i] * rs * ga[i], yb = xb[i] * rs * gb[i]; oa[i] = lat ? ya * cs[i] - yb * sn[i] : ya; ob[i] = lat ? ya * sn[i] + yb * cs[i] : yb; }
            bf16_t* dst = p < 2 ? QG + (size_t)row * 1024 + (4 * p + hq) * 128 : KG + (size_t)row * 256 + (hq & 1) * 128;
            if (p < 2 || hq < 2) { u32x2 wa, wb; wa.x = pk2(oa[0], oa[1]); wa.y = pk2(oa[2], oa[3]); wb.x = pk2(ob[0], ob[1]); wb.y = pk2(ob[2], ob[3]);
                *(u32x2*)(dst + eo) = wa; *(u32x2*)(dst + eo + 32) = wb; }
        }
        if (!hn) break;
        cur = nxt; row = nrow;
    }
}

namespace att {
constexpr int QBLK = 32, KVBLK = 64;
#define SBAR() __builtin_amdgcn_sched_barrier(0)
DI int crow(int r, int hi) { return (r & 3) + 8 * (r >> 2) + 4 * hi; }
DI int v_st(int k, int c) { const int kk = (k & ~0xC) | ((k & 4) << 1) | ((k & 8) >> 1); return ((kk >> 3) * 4 + (c >> 5)) * 512 + ((kk & 7) * 32 + (c & 31)) * 2; }
DI int v_rd_base(int lane) { return ((lane & 3) << 3) | (((lane >> 2) & 3) << 6) | (((lane >> 4) & 1) << 5) | (((lane >> 5) & 1) << 8); }
constexpr int v_rd_off(int d0, int ks, int half) { return d0 * 512 + ks * 4096 + half * 2048; }
template <int OFF> DI s16x4 tr_read(int vb) { s16x4 r; asm volatile("ds_read_b64_tr_b16 %0, %1 offset:%2" : "=&v"(r) : "v"(vb), "i"(OFF) : "memory"); return r; }
template <int D0> DI void pv_one(f32x16& od, int vb, bf16x8 pa0, bf16x8 pa1, bf16x8 pa2, bf16x8 pa3) {
  const s16x4 l0 = tr_read<v_rd_off(D0, 0, 0)>(vb), h0 = tr_read<v_rd_off(D0, 0, 1)>(vb), l1 = tr_read<v_rd_off(D0, 1, 0)>(vb), h1 = tr_read<v_rd_off(D0, 1, 1)>(vb);
  const s16x4 l2 = tr_read<v_rd_off(D0, 2, 0)>(vb), h2 = tr_read<v_rd_off(D0, 2, 1)>(vb), l3 = tr_read<v_rd_off(D0, 3, 0)>(vb), h3 = tr_read<v_rd_off(D0, 3, 1)>(vb);
  asm volatile("s_waitcnt lgkmcnt(0)" ::: "memory"); SBAR();
#define PK(L, H) (bf16x8){L[0], L[1], L[2], L[3], H[0], H[1], H[2], H[3]}
  od = __builtin_amdgcn_mfma_f32_32x32x16_bf16(pa0, PK(l0, h0), od, 0, 0, 0);
  od = __builtin_amdgcn_mfma_f32_32x32x16_bf16(pa1, PK(l1, h1), od, 0, 0, 0);
  od = __builtin_amdgcn_mfma_f32_32x32x16_bf16(pa2, PK(l2, h2), od, 0, 0, 0);
  od = __builtin_amdgcn_mfma_f32_32x32x16_bf16(pa3, PK(l3, h3), od, 0, 0, 0);
#undef PK
}
DI void pv_d0(f32x16* o, int vb, bf16x8 pa0, bf16x8 pa1, bf16x8 pa2, bf16x8 pa3) {
  pv_one<0>(o[0], vb, pa0, pa1, pa2, pa3); pv_one<1>(o[1], vb, pa0, pa1, pa2, pa3); pv_one<2>(o[2], vb, pa0, pa1, pa2, pa3); pv_one<3>(o[3], vb, pa0, pa1, pa2, pa3);
}
template <int DKX, int LDQ, int LDK, int LDV, int LDO, int SDEPTH = 1>
DI void attn_body(const bf16_t* __restrict__ Qb, const bf16_t* __restrict__ Km, const bf16_t* __restrict__ Kx, const bf16_t* __restrict__ Vm, bf16_t* __restrict__ Ob,
                  int kr0, int nt0, int kr1, int nt1, float scale, const float* __restrict__ ropeq  , char* lds) {
  constexpr int ND0 = 8 + DKX / 16, KROWB = (128 + DKX) * 2, SHM_V = KVBLK * 128 * 2, SHM_K = KVBLK * KROWB;
  constexpr float THR = 8.f;
#define KSWZ(row, colB) ((row) * KROWB + ((colB) ^ (((row) & 7) << 4)))
  int tid = threadIdx.x; asm volatile("" : "+v"(tid));
  const int wid = __builtin_amdgcn_readfirstlane(tid >> 6), lane = tid & 63, r32 = lane & 31, hi = lane >> 5;
  char* V_lds = lds; char* K_lds = lds + 2 * SHM_V;
  float* ws = (float*)(lds + 2 * SHM_V + 2 * SHM_K) + wid * 64; float* li_l = ws; float* al_l = ws + 32;
  const float C = scale * 1.4426950408889634f;
  float m_reg = -1e30f, l_reg = 0; f32x16 o[4] = {}; bf16x8 qr[8];
  const bf16_t* Qw = Qb + (long)(wid * QBLK + r32) * LDQ + hi * 8;
#pragma unroll
  for (int d0 = 0; d0 < 8; ++d0) qr[d0] = *reinterpret_cast<const bf16x8*>(Qw + d0 * 16);
  char* QX = lds + 2 * SHM_V + 2 * SHM_K + 2048 + (wid * 4 * 64 + lane) * 16;
  if constexpr (DKX > 0) {
#pragma unroll
    for (int ax = 0; ax < 2; ++ax) {
      const bf16x8 xa = *reinterpret_cast<const bf16x8*>(Qw + 128 + ax * 32), xb = *reinterpret_cast<const bf16x8*>(Qw + 128 + ax * 32 + 16);
      if (ropeq) {
        const float* cs = ropeq + ((size_t)(wid * QBLK + r32) * 32 + ax * 16 + hi * 8) * 2;
        float oa[8], ob[8];
#pragma unroll
        for (int j = 0; j < 8; ++j) { const float c = cs[2 * j], sn = cs[2 * j + 1], a = bf2f((unsigned short)xa[j]), b = bf2f((unsigned short)xb[j]); oa[j] = a * c - b * sn; ob[j] = a * sn + b * c; }
        u32x4 wa = {pk2(oa[0], oa[1]), pk2(oa[2], oa[3]), pk2(oa[4], oa[5]), pk2(oa[6], oa[7])}, wb = {pk2(ob[0], ob[1]), pk2(ob[2], ob[3]), pk2(ob[4], ob[5]), pk2(ob[6], ob[7])};
        *reinterpret_cast<u32x4*>(QX + (2 * ax) * 1024) = wa; *reinterpret_cast<u32x4*>(QX + (2 * ax + 1) * 1024) = wb;
      } else { *reinterpret_cast<bf16x8*>(QX + (2 * ax) * 1024) = xa; *reinterpret_cast<bf16x8*>(QX + (2 * ax + 1) * 1024) = xb; }
    }
  }
  const int sr = tid >> 4, sc = (tid & 15) * 8, vst0 = v_st(sr, sc), vst1 = v_st(32 + sr, sc);
  const int xr = tid >> 3, xc = (tid & 7) * 8;
  const int vb0 = (int)(uintptr_t)V_lds + v_rd_base(lane);
  const int offV = sr * LDV + sc, offK = sr * LDK + sc, offX = xr * 64 + xc;
  struct { bf16x8 vs0, vs1, ks0, ks1, kx; } sr_[SDEPTH];
  const int NT = nt0 + nt1;
#define TROW(j) ((j) < nt0 ? kr0 + (j) * KVBLK : kr1 + ((j) - nt0) * KVBLK)
#define SLOAD(i, j) do { const long _r = TROW(j); const bf16_t* _vt = Vm + _r * LDV; const bf16_t* _kt = Km + _r * LDK; \
    sr_[i].vs0 = *(const bf16x8*)(_vt + offV); sr_[i].vs1 = *(const bf16x8*)(_vt + offV + 32 * LDV); \
    sr_[i].ks0 = *(const bf16x8*)(_kt + offK); sr_[i].ks1 = *(const bf16x8*)(_kt + offK + 32 * LDK); \
    if constexpr (DKX > 0) sr_[i].kx = *(const bf16x8*)(Kx + _r * 64 + offX); } while (0)
#define SWRITE(b, i) do { *(bf16x8*)(V_lds + (b) * SHM_V + vst0) = sr_[i].vs0; *(bf16x8*)(V_lds + (b) * SHM_V + vst1) = sr_[i].vs1; const int kc = sc * 2; \
    *(bf16x8*)(K_lds + (b) * SHM_K + KSWZ(sr, kc)) = sr_[i].ks0; *(bf16x8*)(K_lds + (b) * SHM_K + KSWZ(32 + sr, kc)) = sr_[i].ks1; \
    if constexpr (DKX > 0) *(bf16x8*)(K_lds + (b) * SHM_K + KSWZ(xr, 256 + xc * 2)) = sr_[i].kx; } while (0)
#define SWAIT() do { if constexpr (SDEPTH == 1) asm volatile("s_waitcnt vmcnt(0)" ::: "memory"); else if constexpr (DKX > 0) asm volatile("s_waitcnt vmcnt(5)" ::: "memory"); else asm volatile("s_waitcnt vmcnt(4)" ::: "memory"); } while (0)
#define RESC(a) do { if (__any((a) < 1.f)) { if (hi == 0) al_l[r32] = (a); asm volatile("s_waitcnt lgkmcnt(0)" ::: "memory"); \
    for (int d = 0; d < 4; ++d) for (int r = 0; r < 16; ++r) o[d][r] *= al_l[crow(r, hi)]; } } while (0)
#define QKT(p0, p1, Ks) do { p0 = f32x16{}; p1 = f32x16{}; _Pragma("unroll") for (int d0 = 0; d0 < ND0; ++d0) { const int cb = (d0 * 16 + hi * 8) * 2; \
    const bf16x8 b0 = *reinterpret_cast<const bf16x8*>((Ks) + KSWZ(r32, cb)); const bf16x8 b1 = *reinterpret_cast<const bf16x8*>((Ks) + KSWZ(32 + r32, cb)); \
    const bf16x8 qf = d0 < 8 ? qr[d0 < 8 ? d0 : 0] : *reinterpret_cast<const bf16x8*>(QX + (d0 - 8) * 1024); \
    p0 = __builtin_amdgcn_mfma_f32_32x32x16_bf16(b0, qf, p0, 0, 0, 0); p1 = __builtin_amdgcn_mfma_f32_32x32x16_bf16(b1, qf, p1, 0, 0, 0); if (DKX > 0 && (d0 & 1) == 1) SBAR(); } } while (0)
#define PARTIAL_SM(p0, p1, mn, alpha) do { float pmax = p0[0]; for (int r = 1; r < 16; ++r) pmax = fmaxf(pmax, p0[r]); for (int r = 0; r < 16; ++r) pmax = fmaxf(pmax, p1[r]); \
    { auto rr = __builtin_amdgcn_permlane32_swap(__float_as_uint(pmax), __float_as_uint(pmax), false, false); pmax = fmaxf(__uint_as_float(rr[0]), __uint_as_float(rr[1])); } \
    if (__builtin_expect(__all((pmax - m_reg) * scale <= THR), 1)) { mn = m_reg; alpha = 1.f; } \
    else { mn = fmaxf(m_reg, pmax); alpha = __builtin_amdgcn_exp2f((m_reg - mn) * C); m_reg = mn; } \
    const float mnC = -mn * C; for (int r = 0; r < 16; ++r) p0[r] = fmaf(p0[r], C, mnC); for (int r = 0; r < 16; ++r) p1[r] = fmaf(p1[r], C, mnC); \
    for (int r = 0; r < 16; ++r) p0[r] = __builtin_amdgcn_exp2f(p0[r]); } while (0)
#define PK4(P, BASE, OUT) do { unsigned a0 = pk2(P[BASE + 0], P[BASE + 1]), a1 = pk2(P[BASE + 2], P[BASE + 3]); \
    unsigned b0 = pk2(P[BASE + 4], P[BASE + 5]), b1 = pk2(P[BASE + 6], P[BASE + 7]); \
    auto r0 = __builtin_amdgcn_permlane32_swap(a0, b0, false, false); auto r1 = __builtin_amdgcn_permlane32_swap(a1, b1, false, false); \
    u32x4 w = {r0[0], r1[0], r0[1], r1[1]}; OUT = *reinterpret_cast<bf16x8*>(&w); } while (0)
#define FINISH_SM(p0, p1, alpha) do { for (int r = 0; r < 16; ++r) p1[r] = __builtin_amdgcn_exp2f(p1[r]); \
    float ps = 0; for (int r = 0; r < 16; ++r) ps += p0[r]; for (int r = 0; r < 16; ++r) ps += p1[r]; \
    { auto rr = __builtin_amdgcn_permlane32_swap(__float_as_uint(ps), __float_as_uint(ps), false, false); ps = __uint_as_float(rr[0]) + __uint_as_float(rr[1]); } \
    l_reg = l_reg * alpha + ps; PK4(p0, 0, pa0); PK4(p0, 8, pa1); PK4(p1, 0, pa2); PK4(p1, 8, pa3); } while (0)
  f32x16 pA0, pA1, pB0, pB1; float mnA, mnB, alA, alB; bf16x8 pa0, pa1, pa2, pa3;
  constexpr int SE = 0, SO = SDEPTH - 1;
  SLOAD(SE, 0); asm volatile("s_waitcnt vmcnt(0)" ::: "memory"); SWRITE(0, SE); __syncthreads();
  QKT(pA0, pA1, K_lds); PARTIAL_SM(pA0, pA1, mnA, alA);
  SLOAD(SO, 1); if constexpr (SDEPTH == 2) { if (2 < NT) SLOAD(SE, 2); }
  SWAIT(); SWRITE(1, SO); __syncthreads();
  for (int j = 1; j + 1 < NT; j += 2) {
    SBAR(); QKT(pB0, pB1, K_lds + SHM_K);
    FINISH_SM(pA0, pA1, alA); SBAR();
    SLOAD(SO, j + SDEPTH); SBAR();
    pv_d0(o, vb0, pa0, pa1, pa2, pa3); PARTIAL_SM(pB0, pB1, mnB, alB);
    __syncthreads(); SWAIT(); SWRITE(0, SE);
    RESC(alB); __syncthreads();
    SBAR(); QKT(pA0, pA1, K_lds);
    FINISH_SM(pB0, pB1, alB); SBAR();
    if (SDEPTH == 1 || j + 3 < NT) SLOAD(SE, j + 1 + SDEPTH); SBAR();
    pv_d0(o, vb0 + (int)SHM_V, pa0, pa1, pa2, pa3); PARTIAL_SM(pA0, pA1, mnA, alA);
    __syncthreads(); SWAIT(); SWRITE(1, SO);
    RESC(alA); __syncthreads();
  }
  SBAR(); QKT(pB0, pB1, K_lds + SHM_K);
  FINISH_SM(pA0, pA1, alA); SBAR();
  pv_d0(o, vb0, pa0, pa1, pa2, pa3); PARTIAL_SM(pB0, pB1, mnB, alB);
  __syncthreads(); RESC(alB);
  FINISH_SM(pB0, pB1, alB); SBAR();
  pv_d0(o, vb0 + (int)SHM_V, pa0, pa1, pa2, pa3);
  if (hi == 0) li_l[r32] = l_reg; asm volatile("s_waitcnt lgkmcnt(0)" ::: "memory");
  float rli[16];
#pragma unroll
  for (int r = 0; r < 16; ++r) rli[r] = __builtin_amdgcn_rcpf(li_l[crow(r, hi)]);
  bf16_t* Ow = Ob + (long)(wid * QBLK) * LDO;
#pragma unroll
  for (int r = 0; r < 16; ++r) { const int orow = crow(r, hi);
#pragma unroll
    for (int d0 = 0; d0 < 4; ++d0) Ow[(long)orow * LDO + d0 * 32 + r32] = (bf16_t)f2bf(o[d0][r] * rli[r]); }
  __syncthreads();
#undef KSWZ
#undef TROW
#undef SLOAD
#undef SWRITE
#undef SWAIT
#undef RESC
#undef QKT
#undef PARTIAL_SM
#undef PK4
#undef FINISH_SM
}
}

namespace ml {
constexpr int LD = 264, ROWB = LD * 2, QS_OFF = 0, KS_OFF = 64 * ROWB, VS_OFF = 2 * 64 * ROWB, NV_OFF = 3 * 64 * ROWB, SC_OFF = NV_OFF + 1024, ML_END = SC_OFF + 2048;
static_assert(ML_END <= LDS_BYTES - 1024, "mlstm lds");
#define MFMA32(a, b, c) __builtin_amdgcn_mfma_f32_32x32x16_bf16((a), (b), (c), 0, 0, 0)
DI bf16x8 pack_step(const f32x16& x, int s) {
    u32x4 p;
    asm volatile("v_cvt_pk_bf16_f32 %0, %4, %5\n\tv_cvt_pk_bf16_f32 %1, %6, %7\n\tv_cvt_pk_bf16_f32 %2, %8, %9\n\tv_cvt_pk_bf16_f32 %3, %10, %11\n\ts_nop 1"
                 : "=&v"(p[0]), "=&v"(p[1]), "=&v"(p[2]), "=&v"(p[3])
                 : "v"(x[8 * s]), "v"(x[8 * s + 1]), "v"(x[8 * s + 2]), "v"(x[8 * s + 3]), "v"(x[8 * s + 4]), "v"(x[8 * s + 5]), "v"(x[8 * s + 6]), "v"(x[8 * s + 7]));
    return __builtin_bit_cast(bf16x8, p);
}
DI bf16x8 ld_perm(const LAS unsigned char* p) {
    const s16x4 lo = *(const LAS s16x4*)p, hi = *(const LAS s16x4*)(p + 16);
    return (bf16x8){lo[0], lo[1], lo[2], lo[3], hi[0], hi[1], hi[2], hi[3]};
}
DI int crow(int r, int hi) { return (r & 3) + 8 * (r >> 2) + 4 * hi; }
template <int OFF> DI s16x4 tr_rd(unsigned addr) { s16x4 r; asm volatile("ds_read_b64_tr_b16 %0, %1 offset:%2" : "=&v"(r) : "v"(addr), "i"(OFF) : "memory"); return r; }
#define TR_WAIT() do { asm volatile("s_waitcnt lgkmcnt(0)" ::: "memory"); __builtin_amdgcn_sched_barrier(0); } while (0)
#define CAT8(L, H) (bf16x8){L[0], L[1], L[2], L[3], H[0], H[1], H[2], H[3]}

DI void mlstm_stream(const Frame& F, const Args& a, int l, int stream, bool ctx_out) {
    const int b = stream >> 3, hd = (stream >> 1) & 3, dir = stream & 1;
    const int tid = F.tid, w = F.wave;
    LAS unsigned char* lds = F.lds;
    const unsigned ldsb = (unsigned)(uintptr_t)lds;
    const bf16_t* P = (const bf16_t*)(F.ws + WS_P); const float* X80 = (const float*)(F.ws + WS_X80);
    float* MLH = (float*)(F.ws + WS_MLH) + (size_t)dir * MTOT * 1024;
    const float* gb = a.in[I_GBIAS] + l * 16;
    const float gbi = gb[dir * 8 + hd], gbf = gb[dir * 8 + 4 + hd];
    LAS float* NV = (LAS float*)(lds + NV_OFF);
    LAS float* SC = (LAS float*)(lds + SC_OFF);
    f32x16 CT[8];
#pragma unroll
    for (int i = 0; i < 8; ++i) CT[i] = f32x16{};
    if (tid < 256) NV[tid] = 0.f;
    float m_prev = 0.f;
    const int sgn = dir ? -1 : 1;
#define CHUNK_ROW0(c) ((c) < 4 ? MLAT + b * CTXL + (dir ? 255 - (c) * 64 : (c) * 64) : b * SEQ + (dir ? 2047 - ((c) - 4) * 64 : ((c) - 4) * 64))
    bf16x8 pq[4], pk[4], pv[4]; float pgi, pgf;
#define PREFETCH(c) do { int ln_ = F.lane; asm volatile("" : "+v"(ln_)); const int r0_ = CHUNK_ROW0(c); \
        const bf16_t* pr_ = P + (size_t)(r0_ + sgn * ((w << 3) | (ln_ >> 3))) * NP + hd * 256 + 8 * (ln_ & 7); \
        _Pragma("unroll") for (int j = 0; j < 4; ++j) { pq[j] = *(const bf16x8*)(pr_ + C_MLQ + 64 * j); pk[j] = *(const bf16x8*)(pr_ + C_MLK + 64 * j); pv[j] = *(const bf16x8*)(pr_ + C_MLV + 64 * j); } \
        const float* xg_ = X80 + (size_t)(r0_ + sgn * ln_) * XW + 64 + dir * 8 + hd; pgi = xg_[0]; pgf = xg_[4]; } while (0)
    PREFETCH(0);
#ifndef MK_MLX
#define MK_MLX 1
#endif
    for (int cc = 0; cc < 36 * MK_MLX; ++cc) {
        const int c = cc % 36;
        if (MK_MLX > 1 && cc == 36) { __syncthreads();
#pragma unroll
            for (int i = 0; i < 8; ++i) CT[i] = f32x16{};
            if (tid < 256) NV[tid] = 0.f; m_prev = 0.f; }
        int lane = F.lane; asm volatile("" : "+v"(lane));
        const int r32 = lane & 31, hi = lane >> 5, ldi = (w << 3) | (lane >> 3), cg = lane & 7, g16 = lane >> 4, q4 = (lane & 15) >> 2, p4 = lane & 3;
        const int row0 = CHUNK_ROW0(c);
        const float ipre = pgi + gbi, fpre = pgf + gbf;
        const float lf = fminf(fpre, 0.f) - __logf(1.f + __expf(-fabsf(fpre)));
        float cum = lf;
#pragma unroll
        for (int o = 1; o < 64; o <<= 1) { const float t = shu(cum, o); if (lane >= o) cum += t; }
        const float bb = ipre - cum;
        float pmx = bb;
#pragma unroll
        for (int o = 1; o < 64; o <<= 1) { const float t = shu(pmx, o); if (lane >= o) pmx = fmaxf(pmx, t); }
        const float aa = fmaxf(m_prev, pmx);
        const float cum_end = shl_(cum, 63), a_end = shl_(aa, 63);
        const float decay = __expf(m_prev - a_end), m_new = cum_end + a_end;
        __syncthreads();
#pragma unroll
        for (int j = 0; j < 4; ++j) { const int ch = cg + 8 * j; const bf16x8 qv = pq[j];
            u32x4 qs;
            qs.x = pk2(bf2f((unsigned short)qv[0]) * 0.0625f, bf2f((unsigned short)qv[1]) * 0.0625f); qs.y = pk2(bf2f((unsigned short)qv[2]) * 0.0625f, bf2f((unsigned short)qv[3]) * 0.0625f);
            qs.z = pk2(bf2f((unsigned short)qv[4]) * 0.0625f, bf2f((unsigned short)qv[5]) * 0.0625f); qs.w = pk2(bf2f((unsigned short)qv[6]) * 0.0625f, bf2f((unsigned short)qv[7]) * 0.0625f);
            *(LAS u32x4*)(lds + QS_OFF + (ldi * LD + 8 * ch) * 2) = qs;
            *(LAS bf16x8*)(lds + KS_OFF + (ldi * LD + 8 * ch) * 2) = pk[j];
            *(LAS bf16x8*)(lds + VS_OFF + (ldi * LD + 8 * ch) * 2) = pv[j]; }
        {
            float part = 0.f;
#pragma unroll
            for (int j = 0; j < 4; ++j) { const int ch = cg + 8 * j; const bf16x8 qv = pq[j]; const f32x4 n0 = *(const LAS f32x4*)(NV + 8 * ch), n1 = *(const LAS f32x4*)(NV + 8 * ch + 4);
                part += bf2f((unsigned short)qv[0]) * n0.x + bf2f((unsigned short)qv[1]) * n0.y + bf2f((unsigned short)qv[2]) * n0.z + bf2f((unsigned short)qv[3]) * n0.w
                      + bf2f((unsigned short)qv[4]) * n1.x + bf2f((unsigned short)qv[5]) * n1.y + bf2f((unsigned short)qv[6]) * n1.z + bf2f((unsigned short)qv[7]) * n1.w; }
            part += shx(part, 1); part += shx(part, 2); part += shx(part, 4);
            if (cg == 0) SC[320 + ldi] = part * 0.0625f; }
        if (w == 0) { SC[lane] = bb; SC[64 + lane] = aa; SC[128 + lane] = __expf(m_prev - aa); SC[192 + lane] = __expf(-cum - aa); SC[256 + lane] = __expf(bb - a_end); }
        __syncthreads();
        const bool want_out = (c >= 4) || ctx_out;
        if (want_out) {
            const unsigned va0 = ldsb + VS_OFF + ((4 * (g16 >> 1) + q4) * LD + 32 * w + 16 * (g16 & 1) + 4 * p4) * 2;
#pragma unroll
            for (int lt = 0; lt < 2; ++lt) {
                const int lcol = 32 * lt + r32;
                const float a_l = SC[64 + lcol], wI_l = SC[128 + lcol], fl_l = SC[192 + lcol], nq_l = SC[320 + lcol];
                f32x16 N = f32x16{};
#pragma unroll
                for (int dt = 0; dt < 8; ++dt)
#pragma unroll
                    for (int ks = 0; ks < 2; ++ks) {
                        const bf16x8 qa = ld_perm(lds + QS_OFF + (lcol * LD + 32 * dt + 16 * ks + 4 * hi) * 2);
                        N = MFMA32(pack_step(CT[dt], ks), qa, N); if (ks == 1 && (dt & 1)) __builtin_amdgcn_sched_barrier(0); }
#pragma unroll
                for (int r = 0; r < 16; ++r) N[r] *= wI_l;
                float den = 0.f;
#pragma unroll
                for (int st = 0; st <= lt; ++st) {
                    f32x16 S = f32x16{};
#pragma unroll
                    for (int ks = 0; ks < 16; ++ks) {
                        const bf16x8 ka = *(const LAS bf16x8*)(lds + KS_OFF + ((32 * st + r32) * LD + 16 * ks + 8 * hi) * 2);
                        const bf16x8 qb = *(const LAS bf16x8*)(lds + QS_OFF + (lcol * LD + 16 * ks + 8 * hi) * 2);
                        S = MFMA32(ka, qb, S); }
                    const s16x4 v00 = st == 0 ? tr_rd<0>(va0) : tr_rd<32 * ROWB>(va0), v01 = st == 0 ? tr_rd<8 * ROWB>(va0) : tr_rd<40 * ROWB>(va0);
                    const s16x4 v10 = st == 0 ? tr_rd<16 * ROWB>(va0) : tr_rd<48 * ROWB>(va0), v11 = st == 0 ? tr_rd<24 * ROWB>(va0) : tr_rd<56 * ROWB>(va0);
#pragma unroll
                    for (int r = 0; r < 16; ++r) { const int srow = 32 * st + crow(r, hi); const float dd = __expf(SC[srow] - a_l);
                        const float v = (srow <= lcol) ? S[r] * dd : 0.f; S[r] = v; den += v; }
                    TR_WAIT();
                    N = MFMA32(CAT8(v00, v01), pack_step(S, 0), N);
                    N = MFMA32(CAT8(v10, v11), pack_step(S, 1), N);
                }
                den += shx(den, 32);
                den += wI_l * nq_l;
                const float inv = 1.f / fmaxf(fabsf(den), fl_l);
                float* orow = MLH + (size_t)(row0 + sgn * lcol) * 1024 + hd * 256 + 32 * w + 4 * hi;
#pragma unroll
                for (int g = 0; g < 4; ++g) *(f32x4*)(orow + 8 * g) = (f32x4){N[4 * g] * inv, N[4 * g + 1] * inv, N[4 * g + 2] * inv, N[4 * g + 3] * inv};
                __builtin_amdgcn_sched_barrier(0);
            }
        }
        __builtin_amdgcn_sched_barrier(0);
        { const int cn = (cc + 1 < 36 * MK_MLX) ? (cc + 1) % 36 : 35; PREFETCH(cn); }
        __builtin_amdgcn_sched_barrier(0);
        {
            const unsigned vb0 = ldsb + VS_OFF + ((8 * (g16 >> 1) + q4) * LD + 32 * w + 16 * (g16 & 1) + 4 * p4) * 2;
            const unsigned kb0 = ldsb + KS_OFF + ((8 * (g16 >> 1) + q4) * LD + 16 * (g16 & 1) + 4 * p4) * 2;
            const s16x4 b00 = tr_rd<0>(vb0), b01 = tr_rd<4 * ROWB>(vb0), b10 = tr_rd<16 * ROWB>(vb0), b11 = tr_rd<20 * ROWB>(vb0);
            const s16x4 b20 = tr_rd<32 * ROWB>(vb0), b21 = tr_rd<36 * ROWB>(vb0), b30 = tr_rd<48 * ROWB>(vb0), b31 = tr_rd<52 * ROWB>(vb0);
            TR_WAIT();
            bf16x8 vb[4];
#define SCALE8(dst, L, H, ks) do { const f32x4 w0 = *(const LAS f32x4*)(SC + 256 + 16 * (ks) + 8 * hi), w1 = *(const LAS f32x4*)(SC + 256 + 16 * (ks) + 8 * hi + 4); \
            u32x4 t_; t_.x = pk2(bf2f((unsigned short)L[0]) * w0.x, bf2f((unsigned short)L[1]) * w0.y); t_.y = pk2(bf2f((unsigned short)L[2]) * w0.z, bf2f((unsigned short)L[3]) * w0.w); \
            t_.z = pk2(bf2f((unsigned short)H[0]) * w1.x, bf2f((unsigned short)H[1]) * w1.y); t_.w = pk2(bf2f((unsigned short)H[2]) * w1.z, bf2f((unsigned short)H[3]) * w1.w); dst = __builtin_bit_cast(bf16x8, t_); } while (0)
            SCALE8(vb[0], b00, b01, 0); SCALE8(vb[1], b10, b11, 1); SCALE8(vb[2], b20, b21, 2); SCALE8(vb[3], b30, b31, 3);
#undef SCALE8
#define UPD(dt) do { const s16x4 k00 = tr_rd<(dt) * 64>(kb0), k01 = tr_rd<(dt) * 64 + 4 * ROWB>(kb0), k10 = tr_rd<(dt) * 64 + 16 * ROWB>(kb0), k11 = tr_rd<(dt) * 64 + 20 * ROWB>(kb0); \
            const s16x4 k20 = tr_rd<(dt) * 64 + 32 * ROWB>(kb0), k21 = tr_rd<(dt) * 64 + 36 * ROWB>(kb0), k30 = tr_rd<(dt) * 64 + 48 * ROWB>(kb0), k31 = tr_rd<(dt) * 64 + 52 * ROWB>(kb0); \
            _Pragma("unroll") for (int r = 0; r < 16; ++r) CT[dt][r] *= decay; \
            TR_WAIT(); \
            CT[dt] = MFMA32(CAT8(k00, k01), vb[0], CT[dt]); CT[dt] = MFMA32(CAT8(k10, k11), vb[1], CT[dt]); CT[dt] = MFMA32(CAT8(k20, k21), vb[2], CT[dt]); CT[dt] = MFMA32(CAT8(k30, k31), vb[3], CT[dt]); } while (0)
            UPD(0); UPD(1); UPD(2); UPD(3); UPD(4); UPD(5); UPD(6); UPD(7);
#undef UPD
        }
        __syncthreads();
        if (tid < 256) { float sacc = 0.f;
#pragma unroll 8
            for (int q = 0; q < 64; ++q) sacc += bf2f(*(const LAS unsigned short*)(lds + KS_OFF + (q * LD + tid) * 2)) * SC[256 + q];
            NV[tid] = decay * NV[tid] + sacc; }
        m_prev = m_new;
    }
    __syncthreads();
#undef CHUNK_ROW0
#undef PREFETCH
}

namespace u2 {
constexpr int LDQ = 264, ROWQ = LDQ * 2, LDV = 136, ROWV = LDV * 2, LDW = 72, ROWW = LDW * 2;
constexpr int QS = 0, KS = 64 * ROWQ, VS = 2 * 64 * ROWQ, SW = VS + 64 * ROWV, NV_O = SW + 64 * ROWW, SC_O = NV_O + 1024, SCN = 448, END = SC_O + 2 * SCN * 4;
static_assert(END <= LDS_BYTES - 1024, "mlstm2 lds");
}
DI void mlstm_unit2(const Frame& F, const Args& a, int l, int unit, bool ctx_out) {
    using namespace u2;
    const int stream = unit >> 1, half = unit & 1, b = stream >> 3, hd = (stream >> 1) & 3, dir = stream & 1;
    const int tid = F.tid, w = F.wave;
    LAS unsigned char* lds = F.lds;
    const unsigned ldsb = (unsigned)(uintptr_t)lds;
    const bf16_t* P = (const bf16_t*)(F.ws + WS_P); const float* X80 = (const float*)(F.ws + WS_X80);
    bf16_t* MLH = (bf16_t*)(F.ws + WS_MLH) + (size_t)dir * MTOT * 1024;
    const float* gb = a.in[I_GBIAS] + l * 16;
    const float gbi = gb[dir * 8 + hd], gbf = gb[dir * 8 + 4 + hd];
    LAS float* NV = (LAS float*)(lds + NV_O);
    const int sgn = dir ? -1 : 1;
#define CHUNK_ROW0(c) ((c) < 4 ? MLAT + b * CTXL + (dir ? 255 - (c) * 64 : (c) * 64) : b * SEQ + (dir ? 2047 - ((c) - 4) * 64 : ((c) - 4) * 64))
    const bool helper = w >= 4;
    bf16x8 pq[8], pk[8], pv[4]; float pgi = 0.f, pgf = 0.f; float m_prev = 0.f;
#define PREFETCH(c) do { int ht_ = tid - 256; asm volatile("" : "+v"(ht_)); const int r0_ = CHUNK_ROW0(c); \
        const bf16_t* pr_ = P + (size_t)(r0_ + sgn * (ht_ >> 2)) * NP + hd * 256 + 8 * (ht_ & 3); \
        _Pragma("unroll") for (int j = 0; j < 8; ++j) { pq[j] = *(const bf16x8*)(pr_ + C_MLQ + 32 * j); pk[j] = *(const bf16x8*)(pr_ + C_MLK + 32 * j); } \
        _Pragma("unroll") for (int j = 0; j < 4; ++j) pv[j] = *(const bf16x8*)(pr_ + C_MLV + 128 * half + 32 * j); \
        const float* xg_ = X80 + (size_t)(r0_ + sgn * (ht_ & 63)) * XW + 64 + dir * 8 + hd; pgi = xg_[0]; pgf = xg_[4]; } while (0)
#define SCALARS(sb) do { if (w == 4) { int ln_ = F.lane; asm volatile("" : "+v"(ln_)); LAS float* SCw = (LAS float*)(lds + SC_O) + (sb) * SCN; \
        const float ipre = pgi + gbi, fpre = pgf + gbf; const float lf = fminf(fpre, 0.f) - __logf(1.f + __expf(-fabsf(fpre))); \
        float cum = lf; _Pragma("unroll") for (int o = 1; o < 64; o <<= 1) { const float t = shu(cum, o); if (ln_ >= o) cum += t; } \
        const float bb = ipre - cum; float pmx = bb; _Pragma("unroll") for (int o = 1; o < 64; o <<= 1) { const float t = shu(pmx, o); if (ln_ >= o) pmx = fmaxf(pmx, t); } \
        const float aa = fmaxf(m_prev, pmx); const float cum_end = shl_(cum, 63), a_end = shl_(aa, 63); \
        { SCw[ln_] = bb; SCw[64 + ln_] = aa; SCw[128 + ln_] = __expf(m_prev - aa); SCw[192 + ln_] = __expf(-cum - aa); SCw[256 + ln_] = __expf(bb - a_end); if (ln_ == 0) SCw[384] = __expf(m_prev - a_end); } \
        m_prev = cum_end + a_end; } } while (0)
#define WRITE_Q() do { int ht_ = tid - 256; asm volatile("" : "+v"(ht_)); const int hp_ = ht_ >> 2, hg_ = ht_ & 3; \
        _Pragma("unroll") for (int j = 0; j < 8; ++j) { const bf16x8 qv = pq[j]; u32x4 qs; \
            qs.x = pk2(bf2f((unsigned short)qv[0]) * 0.0625f, bf2f((unsigned short)qv[1]) * 0.0625f); qs.y = pk2(bf2f((unsigned short)qv[2]) * 0.0625f, bf2f((unsigned short)qv[3]) * 0.0625f); \
            qs.z = pk2(bf2f((unsigned short)qv[4]) * 0.0625f, bf2f((unsigned short)qv[5]) * 0.0625f); qs.w = pk2(bf2f((unsigned short)qv[6]) * 0.0625f, bf2f((unsigned short)qv[7]) * 0.0625f); \
            *(LAS u32x4*)(lds + QS + (hp_ * LDQ + 8 * (hg_ + 4 * j)) * 2) = qs; } } while (0)
#define WRITE_KV() do { int ht_ = tid - 256; asm volatile("" : "+v"(ht_)); const int hp_ = ht_ >> 2, hg_ = ht_ & 3; \
        _Pragma("unroll") for (int j = 0; j < 8; ++j) *(LAS bf16x8*)(lds + KS + (hp_ * LDQ + 8 * (hg_ + 4 * j)) * 2) = pk[j]; \
        _Pragma("unroll") for (int j = 0; j < 4; ++j) *(LAS bf16x8*)(lds + VS + (hp_ * LDV + 8 * (hg_ + 4 * j)) * 2) = pv[j]; } while (0)
    LAS float* DEN = (LAS float*)(lds + END);
    static_assert(END + 768 <= LDS_BYTES - 1024, "mlstm2 lds den");
    __syncthreads();
    if (helper) { NV[tid - 256] = 0.f; PREFETCH(0); SCALARS(0); WRITE_Q(); WRITE_KV(); }
    __syncthreads();
    if (!helper) {
      f32x16 CT[8];
#pragma unroll
      for (int i = 0; i < 8; ++i) CT[i] = f32x16{};
      for (int cc = 0; cc < 36 * MK_MLX; ++cc) {
        const int c = cc % 36;
        const int sb = cc & 1;
        const LAS float* SC = (const LAS float*)(lds + SC_O) + sb * SCN;
        const bool want_out = (c >= 4) || ctx_out;
        int lane = F.lane; asm volatile("" : "+v"(lane));
        const int r32 = lane & 31, hi = lane >> 5, g16 = lane >> 4, q4 = (lane & 15) >> 2, p4 = lane & 3;
        const int row0 = CHUNK_ROW0(c);
        if (MK_MLX > 1 && cc == 36) {
#pragma unroll
          for (int i = 0; i < 8; ++i) CT[i] = f32x16{}; }
        f32x16 N0 = f32x16{}, N1 = f32x16{};
        {
            if (want_out) {
#pragma unroll
                for (int dt = 0; dt < 8; ++dt)
#pragma unroll
                    for (int ks = 0; ks < 2; ++ks) {
                        const bf16x8 cf = pack_step(CT[dt], ks);
                        const bf16x8 qa0 = ld_perm(lds + QS + (r32 * LDQ + 32 * dt + 16 * ks + 4 * hi) * 2), qa1 = ld_perm(lds + QS + ((32 + r32) * LDQ + 32 * dt + 16 * ks + 4 * hi) * 2);
                        N0 = MFMA32(cf, qa0, N0); N1 = MFMA32(cf, qa1, N1); if (ks == 1 && (dt & 1)) __builtin_amdgcn_sched_barrier(0); }
                const float wI0 = SC[128 + r32], wI1 = SC[128 + 32 + r32];
#pragma unroll
                for (int r = 0; r < 16; ++r) { N0[r] *= wI0; N1[r] *= wI1; }
            }
        }
        __syncthreads();
        {
            if (want_out) {
                const unsigned va0 = ldsb + VS + ((8 * (g16 >> 1) + q4) * LDV + 32 * w + 16 * (g16 & 1) + 4 * p4) * 2;
                const s16x4 a00 = tr_rd<0>(va0), a01 = tr_rd<4 * ROWV>(va0), a10 = tr_rd<16 * ROWV>(va0), a11 = tr_rd<20 * ROWV>(va0);
                const s16x4 a20 = tr_rd<32 * ROWV>(va0), a21 = tr_rd<36 * ROWV>(va0), a30 = tr_rd<48 * ROWV>(va0), a31 = tr_rd<52 * ROWV>(va0);
                const LAS unsigned char* sw0 = lds + SW + (r32 * LDW + 8 * hi) * 2; const LAS unsigned char* sw1 = sw0 + 32 * ROWW;
                const bf16x8 s00 = *(const LAS bf16x8*)(sw0), s01 = *(const LAS bf16x8*)(sw0 + 32);
                const bf16x8 s10 = *(const LAS bf16x8*)(sw1), s11 = *(const LAS bf16x8*)(sw1 + 32), s12 = *(const LAS bf16x8*)(sw1 + 64), s13 = *(const LAS bf16x8*)(sw1 + 96);
                TR_WAIT();
                N0 = MFMA32(CAT8(a00, a01), s00, N0); N0 = MFMA32(CAT8(a10, a11), s01, N0);
                N1 = MFMA32(CAT8(a00, a01), s10, N1); N1 = MFMA32(CAT8(a10, a11), s11, N1); N1 = MFMA32(CAT8(a20, a21), s12, N1); N1 = MFMA32(CAT8(a30, a31), s13, N1);
                {
                    const float den0 = DEN[r32] + SC[128 + r32] * SC[320 + r32];
                    const float den1 = DEN[64 + 32 + r32] + DEN[128 + 32 + r32] + SC[128 + 32 + r32] * SC[320 + 32 + r32];
                    const float inv0 = 1.f / fmaxf(fabsf(den0), SC[192 + r32]), inv1 = 1.f / fmaxf(fabsf(den1), SC[192 + 32 + r32]);
                    bf16_t* o0 = MLH + (size_t)(row0 + sgn * r32) * 1024 + hd * 256 + 128 * half + 32 * w + 4 * hi; bf16_t* o1 = MLH + (size_t)(row0 + sgn * (32 + r32)) * 1024 + hd * 256 + 128 * half + 32 * w + 4 * hi;
#pragma unroll
                    for (int g = 0; g < 4; ++g) { u32x2 t0, t1; t0.x = pk2(N0[4 * g] * inv0, N0[4 * g + 1] * inv0); t0.y = pk2(N0[4 * g + 2] * inv0, N0[4 * g + 3] * inv0);
                        t1.x = pk2(N1[4 * g] * inv1, N1[4 * g + 1] * inv1); t1.y = pk2(N1[4 * g + 2] * inv1, N1[4 * g + 3] * inv1);
                        __hip_atomic_store((GAS unsigned long long*)(o0 + 8 * g), (unsigned long long)t0.x | ((unsigned long long)t0.y << 32), __ATOMIC_RELAXED, __HIP_MEMORY_SCOPE_AGENT);
                        __hip_atomic_store((GAS unsigned long long*)(o1 + 8 * g), (unsigned long long)t1.x | ((unsigned long long)t1.y << 32), __ATOMIC_RELAXED, __HIP_MEMORY_SCOPE_AGENT); }
                }
            }
            __builtin_amdgcn_sched_barrier(0);
            {
                const float decay = SC[384];
                const unsigned vb0 = ldsb + VS + ((8 * (g16 >> 1) + q4) * LDV + 32 * w + 16 * (g16 & 1) + 4 * p4) * 2;
                const unsigned kb0 = ldsb + KS + ((8 * (g16 >> 1) + q4) * LDQ + 16 * (g16 & 1) + 4 * p4) * 2;
                const s16x4 b00 = tr_rd<0>(vb0), b01 = tr_rd<4 * ROWV>(vb0), b10 = tr_rd<16 * ROWV>(vb0), b11 = tr_rd<20 * ROWV>(vb0);
                const s16x4 b20 = tr_rd<32 * ROWV>(vb0), b21 = tr_rd<36 * ROWV>(vb0), b30 = tr_rd<48 * ROWV>(vb0), b31 = tr_rd<52 * ROWV>(vb0);
                TR_WAIT();
                bf16x8 vb[4];
#define SCALE8(dst, L, H, ks) do { const f32x4 w0 = *(const LAS f32x4*)(SC + 256 + 16 * (ks) + 8 * hi), w1 = *(const LAS f32x4*)(SC + 256 + 16 * (ks) + 8 * hi + 4); \
                u32x4 t_; t_.x = pk2(bf2f((unsigned short)L[0]) * w0.x, bf2f((unsigned short)L[1]) * w0.y); t_.y = pk2(bf2f((unsigned short)L[2]) * w0.z, bf2f((unsigned short)L[3]) * w0.w); \
                t_.z = pk2(bf2f((unsigned short)H[0]) * w1.x, bf2f((unsigned short)H[1]) * w1.y); t_.w = pk2(bf2f((unsigned short)H[2]) * w1.z, bf2f((unsigned short)H[3]) * w1.w); dst = __builtin_bit_cast(bf16x8, t_); } while (0)
                SCALE8(vb[0], b00, b01, 0); SCALE8(vb[1], b10, b11, 1); SCALE8(vb[2], b20, b21, 2); SCALE8(vb[3], b30, b31, 3);
#undef SCALE8
#define UPD(dt) do { const s16x4 k00 = tr_rd<(dt) * 64>(kb0), k01 = tr_rd<(dt) * 64 + 4 * ROWQ>(kb0), k10 = tr_rd<(dt) * 64 + 16 * ROWQ>(kb0), k11 = tr_rd<(dt) * 64 + 20 * ROWQ>(kb0); \
                const s16x4 k20 = tr_rd<(dt) * 64 + 32 * ROWQ>(kb0), k21 = tr_rd<(dt) * 64 + 36 * ROWQ>(kb0), k30 = tr_rd<(dt) * 64 + 48 * ROWQ>(kb0), k31 = tr_rd<(dt) * 64 + 52 * ROWQ>(kb0); \
                _Pragma("unroll") for (int r = 0; r < 16; ++r) CT[dt][r] *= decay; \
                TR_WAIT(); \
                CT[dt] = MFMA32(CAT8(k00, k01), vb[0], CT[dt]); CT[dt] = MFMA32(CAT8(k10, k11), vb[1], CT[dt]); CT[dt] = MFMA32(CAT8(k20, k21), vb[2], CT[dt]); CT[dt] = MFMA32(CAT8(k30, k31), vb[3], CT[dt]); } while (0)
                UPD(0); UPD(1); UPD(2); UPD(3); UPD(4); UPD(5); UPD(6); UPD(7);
#undef UPD
            }
        }
        __syncthreads();
        __syncthreads();
      }
    } else {
      for (int cc = 0; cc < 36 * MK_MLX; ++cc) {
        const int c = cc % 36;
        const int sb = cc & 1;
        const LAS float* SC = (const LAS float*)(lds + SC_O) + sb * SCN;
        const bool want_out = (c >= 4) || ctx_out;
        int lane = F.lane; asm volatile("" : "+v"(lane));
        const int r32 = lane & 31, hi = lane >> 5, g16 = lane >> 4, q4 = (lane & 15) >> 2, p4 = lane & 3;
        const int row0 = CHUNK_ROW0(c);
        { const int cn = (cc + 1 < 36 * MK_MLX) ? (cc + 1) % 36 : 35; PREFETCH(cn); }
        {
            if (want_out) {
                if (w < 7) {
                    const int st = (w == 6) ? 1 : 0, lt = (w == 4) ? 0 : 1, lcol = 32 * lt + r32;
                    f32x16 S = f32x16{};
#pragma unroll
                    for (int ks = 0; ks < 16; ++ks) {
                        const bf16x8 ka = *(const LAS bf16x8*)(lds + KS + ((32 * st + r32) * LDQ + 16 * ks + 8 * hi) * 2);
                        const bf16x8 qb = *(const LAS bf16x8*)(lds + QS + (lcol * LDQ + 16 * ks + 8 * hi) * 2);
                        S = MFMA32(ka, qb, S); }
                    const float a_l = SC[64 + lcol]; float den = 0.f;
#pragma unroll
                    for (int r = 0; r < 16; ++r) { const int srow = 32 * st + crow(r, hi); const float dd = __expf(SC[srow] - a_l);
                        const float v = (srow <= lcol) ? S[r] * dd : 0.f; S[r] = v; den += v; }
                    den += shx(den, 32);
                    if (hi == 0) DEN[(w - 4) * 64 + lcol] = den;
#pragma unroll
                    for (int g = 0; g < 4; ++g) { u32x2 t_; t_.x = pk2(S[4 * g], S[4 * g + 1]); t_.y = pk2(S[4 * g + 2], S[4 * g + 3]);
                        *(LAS u32x2*)(lds + SW + (lcol * LDW + 32 * st + 8 * g + 4 * hi) * 2) = t_; }
                } else {
                    float nq = 0.f; const LAS unsigned char* qrow = lds + QS + lane * ROWQ;
#pragma unroll 4
                    for (int d8 = 0; d8 < 32; ++d8) { const bf16x8 qv = *(const LAS bf16x8*)(qrow + d8 * 16); const f32x4 n0 = *(const LAS f32x4*)(NV + 8 * d8), n1 = *(const LAS f32x4*)(NV + 8 * d8 + 4);
                        nq += bf2f((unsigned short)qv[0]) * n0.x + bf2f((unsigned short)qv[1]) * n0.y + bf2f((unsigned short)qv[2]) * n0.z + bf2f((unsigned short)qv[3]) * n0.w
                            + bf2f((unsigned short)qv[4]) * n1.x + bf2f((unsigned short)qv[5]) * n1.y + bf2f((unsigned short)qv[6]) * n1.z + bf2f((unsigned short)qv[7]) * n1.w; }
                    ((LAS float*)(lds + SC_O) + sb * SCN)[320 + lane] = nq;
                }
            }
        }
        __syncthreads();
        {
            if (w == 7) {
                const int dg = lane & 31, sh = lane >> 5; const float decay = SC[384];
                float ac[8];
#pragma unroll
                for (int j = 0; j < 8; ++j) ac[j] = 0.f;
#pragma unroll 4
                for (int q = 0; q < 32; ++q) { const int srow = 32 * sh + q; const bf16x8 kv = *(const LAS bf16x8*)(lds + KS + (srow * LDQ + 8 * dg) * 2); const float wq = SC[256 + srow];
#pragma unroll
                    for (int j = 0; j < 8; ++j) ac[j] += bf2f((unsigned short)kv[j]) * wq; }
#pragma unroll
                for (int j = 0; j < 8; ++j) ac[j] += shx(ac[j], 32);
                if (sh == 0) {
                    f32x4 n0 = *(LAS f32x4*)(NV + 8 * dg), n1 = *(LAS f32x4*)(NV + 8 * dg + 4);
                    n0 = n0 * decay + (f32x4){ac[0], ac[1], ac[2], ac[3]}; n1 = n1 * decay + (f32x4){ac[4], ac[5], ac[6], ac[7]};
                    if (MK_MLX > 1 && cc == 35) { n0 = (f32x4){0.f, 0.f, 0.f, 0.f}; n1 = n0; }
                    *(LAS f32x4*)(NV + 8 * dg) = n0; *(LAS f32x4*)(NV + 8 * dg + 4) = n1; }
            }
            if (MK_MLX > 1 && cc == 35) m_prev = 0.f;
            SCALARS(sb ^ 1);
            WRITE_Q();
        }
        __syncthreads();
        WRITE_KV();
        __syncthreads();
      }
    }
#undef CHUNK_ROW0
#undef PREFETCH
#undef SCALARS
#undef WRITE_Q
#undef WRITE_KV
}
#undef MFMA32
#undef TR_WAIT
#undef CAT8
}

DI void phase_mixers(const Frame& F, const Args& a, int l, char* ldsg, int npass) {
    unsigned* head0 = (unsigned*)(F.ws + WS_CTL) + CW_QUEUE + 64 * l;
    volatile LAS unsigned* MISC = (volatile LAS unsigned*)(F.lds + LDS_BYTES - 64);
    const int n_ml = 64, n_la = 256, n_ga = 256, n_cx = (l == 0) ? 32 : 0, n_mix = n_ml + n_la + n_ga + 2 * n_cx;
    const int total = n_mix;
    const bf16_t* QLA = (const bf16_t*)(F.ws + WS_QLA); const bf16_t* KVLA = (const bf16_t*)(F.ws + WS_KVLA); const bf16_t* KR = (const bf16_t*)(F.ws + WS_KR);
    const bf16_t* QG = (const bf16_t*)(F.ws + WS_QG); const bf16_t* KG = (const bf16_t*)(F.ws + WS_KG); const bf16_t* P = (const bf16_t*)(F.ws + WS_P);
    bf16_t* YCAT = (bf16_t*)(F.ws + WS_YCAT);
#ifndef MK_MIX
#define MK_MIX 7
#endif
#define GRAB(u) do { __syncthreads(); if (F.tid == 0) MISC[4] = __hip_atomic_fetch_add(head, 1u, __ATOMIC_RELAXED, __HIP_MEMORY_SCOPE_AGENT); __syncthreads(); u = __builtin_amdgcn_readfirstlane((int)MISC[4]); } while (0)
    for (int pass = 0; pass < npass; ++pass) {
    unsigned* head = head0 + 128 * pass;
    int u0;
    GRAB(u0);
    while (u0 < n_ml) { if (MK_MIX & 1) ml::mlstm_unit2(F, a, l, u0, l == 0);
        asm volatile("s_waitcnt vmcnt(0)" ::: "memory"); __syncthreads();
        if (F.tid == 0) __hip_atomic_fetch_add((unsigned*)(F.ws + WS_CTL) + CW_MLDONE + 16 * l, 1u, __ATOMIC_RELAXED, __HIP_MEMORY_SCOPE_AGENT);
        GRAB(u0); }
    while (u0 < n_mix) {
        int u = u0 - n_ml;
        if (u < n_la) { const int b = u >> 6, h = (u >> 3) & 7, qb = u & 7; const long q0 = (long)b * SEQ + qb * 256;
            if (MK_MIX & 2) att::attn_body<64, 1536, 2048, 2048, 3072>(QLA + q0 * 1536 + h * 192, KVLA + h * 256, KR, KVLA + h * 256 + 128, YCAT + q0 * 3072 + 1024 + h * 128,
                                                      MLAT + b * CTXL, 4, b * SEQ, 32, 0.07216878364870322f, (const float*)(F.ws + WS_ROPE_LA) + (size_t)qb * 256 * 64, ldsg); }
        else if (u < n_la + n_ga) { u -= n_la; const int b = u >> 6, h = (u >> 3) & 7, qb = u & 7; const long q0 = (long)b * SEQ + qb * 256;
            if (MK_MIX & 4) att::attn_body<0, 1024, 256, NP, 3072>(QG + q0 * 1024 + h * 128, KG + (h >> 2) * 128, nullptr, P + C_GV + (h >> 2) * 128, YCAT + q0 * 3072 + 2048 + h * 128,
                                                  MLAT + b * CTXL, 4, b * SEQ, 32, 0.08838834764831845f, nullptr, ldsg); }
        else if (u < n_la + n_ga + n_cx) { u -= n_la + n_ga; const int b = u >> 3, h = u & 7; const long q0 = (long)MLAT + b * CTXL;
            if (MK_MIX & 2) att::attn_body<64, 1536, 2048, 2048, 3072>(QLA + q0 * 1536 + h * 192, KVLA + h * 256, KR, KVLA + h * 256 + 128, YCAT + q0 * 3072 + 1024 + h * 128,
                                                      MLAT + b * CTXL, 4, 0, 0, 0.07216878364870322f, nullptr, ldsg); }
        else { u -= n_la + n_ga + n_cx; const int b = u >> 3, h = u & 7; const long q0 = (long)MLAT + b * CTXL;
            if (MK_MIX & 4) att::attn_body<0, 1024, 256, NP, 3072>(QG + q0 * 1024 + h * 128, KG + (h >> 2) * 128, nullptr, P + C_GV + (h >> 2) * 128, YCAT + q0 * 3072 + 2048 + h * 128,
                                                  MLAT + b * CTXL, 4, 0, 0, 0.08838834764831845f, nullptr, ldsg); }
        GRAB(u0);
    }
    }
#undef GRAB
}

DI void phase_convert_tail(const Frame& F0, const Args& a, int l) {
    Frame F = F0; { int t_ = threadIdx.x; asm volatile("" : "+v"(t_)); F.tid = t_; F.lane = t_ & 63; F.wave = __builtin_amdgcn_readfirstlane(t_ >> 6); }
    constexpr int CVB = 64;
    unsigned* head = (unsigned*)(F.ws + WS_CTL) + CW_QUEUE + 64 * l + 32;
    volatile LAS unsigned* MISC = (volatile LAS unsigned*)(F.lds + LDS_BYTES - 64);
    const int n_cv = ((IT_LAYER - IT_EARLY) + ((l == 0) ? IT_EARLY : 0)) / CVB;
    LAS float* scr = (LAS float*)(F.lds + F.wave * 16384);
    for (;;) {
        __syncthreads();
        if (F.tid == 0) MISC[4] = __hip_atomic_fetch_add(head, 1u, __ATOMIC_RELAXED, __HIP_MEMORY_SCOPE_AGENT);
        __syncthreads();
        const int blk = __builtin_amdgcn_readfirstlane((int)MISC[4]);
        if (blk >= n_cv) break;
#pragma unroll 1
        for (int q = 0; q < CVB / NWAVES; ++q) { const int r = blk * CVB + q * NWAVES + F.wave;
            if (r < IT_LAYER - IT_EARLY) convert_item(F, a, l, IT_EARLY + r, scr); else convert_item(F, a, 1, r - (IT_LAYER - IT_EARLY), scr); }
    }
}

constexpr int FILL_BLK = 16, FILL_NBLK = IT_LAYER / FILL_BLK;
static_assert(IT_LAYER % FILL_BLK == 0, "fill blocks");
DI void fill_convert(const Frame& F0_, const Args& a, int ph, bool drain) {
    Frame F = F0_; { int t_ = threadIdx.x; asm volatile("" : "+v"(t_)); F.tid = t_; F.lane = t_ & 63; F.wave = __builtin_amdgcn_readfirstlane(t_ >> 6); }
    unsigned* ctl = (unsigned*)(F.ws + WS_CTL); unsigned* head = ctl + CW_CVHEAD; unsigned* done = ctl + CW_PHDONE + 64 * ph;
    volatile LAS unsigned* MISC = (volatile LAS unsigned*)(F.lds + LDS_BYTES - 64);
    LAS float* scr = (LAS float*)(F.lds + F.wave * 16384);
    __syncthreads();
    if (!drain && F.tid == 0) __hip_atomic_fetch_add(done, 1u, __ATOMIC_RELAXED, __HIP_MEMORY_SCOPE_AGENT);
    for (;;) {
        if (F.tid == 0) { unsigned blk = 0xffffffffu;
            if (drain || __hip_atomic_load(done, __ATOMIC_RELAXED, __HIP_MEMORY_SCOPE_AGENT) < (unsigned)F.G) blk = __hip_atomic_fetch_add(head, 1u, __ATOMIC_RELAXED, __HIP_MEMORY_SCOPE_AGENT);
            MISC[4] = blk; }
        __syncthreads();
        const unsigned blk = (unsigned)__builtin_amdgcn_readfirstlane((int)MISC[4]);
        __syncthreads();
        if (blk >= (unsigned)FILL_NBLK) break;
        convert_range(F, a, IT_LAYER + (int)blk * FILL_BLK + F.wave, NWAVES, IT_LAYER + ((int)blk + 1) * FILL_BLK, scr);
    }
}

DI void phase_convert_side(const Frame& F0_, const Args& a, int bid, int it_lo, int it_hi) {
    const int step = MK_CVSIDE, ncv = (256 + step - 1) / step;
    if (bid % step != 0 || F0_.G != 256) { if (F0_.G != 256) { Frame Fx = F0_; LAS float* scr = (LAS float*)(Fx.lds + Fx.wave * 16384); convert_range(Fx, a, it_lo + Fx.gw, Fx.ngw, it_hi, scr); } return; }
    Frame F = F0_; { int t_ = threadIdx.x; asm volatile("" : "+v"(t_)); F.tid = t_; F.lane = t_ & 63; F.wave = __builtin_amdgcn_readfirstlane(t_ >> 6); }
    LAS float* scr = (LAS float*)(F.lds + F.wave * 16384);
    const int j = bid / step, per = (it_hi - it_lo + ncv - 1) / ncv, lo = it_lo + j * per, hi = (lo + per < it_hi) ? lo + per : it_hi;
    convert_range(F, a, lo + F.wave, NWAVES, hi, scr);
    __syncthreads();
}

DI void phase_mlfin(const Frame& F, const Args& a, int l, int nrows, int first, int stride) {
    const bf16_t* H0 = (const bf16_t*)(F.ws + WS_MLH); const bf16_t* H1 = H0 + (size_t)MTOT * 1024;
    const bf16_t* P = (const bf16_t*)(F.ws + WS_P); bf16_t* YCAT = (bf16_t*)(F.ws + WS_YCAT); const float* gn = a.in[I_MLNORM] + l * 1024;
    int row = first; if (row >= nrows) return;
    s16x4 c0[4], c1[4]; s16x4 co[4];
#define MLF_LOAD(r_, a0, a1, ao) do { _Pragma("unroll") for (int hd = 0; hd < 4; ++hd) { const int c = hd * 256 + 4 * F.lane; a0[hd] = __builtin_bit_cast(s16x4, __hip_atomic_load((const GAS unsigned long long*)(H0 + (size_t)(r_) * 1024 + c), __ATOMIC_RELAXED, __HIP_MEMORY_SCOPE_AGENT)); a1[hd] = __builtin_bit_cast(s16x4, __hip_atomic_load((const GAS unsigned long long*)(H1 + (size_t)(r_) * 1024 + c), __ATOMIC_RELAXED, __HIP_MEMORY_SCOPE_AGENT)); \
        ao[hd] = *(const s16x4*)(P + (size_t)(r_) * NP + C_MLO + c); } } while (0)
    MLF_LOAD(row, c0, c1, co);
    f32x4 gv[4];
#pragma unroll
    for (int hd = 0; hd < 4; ++hd) gv[hd] = *(const f32x4*)(gn + hd * 256 + 4 * F.lane);
    for (;;) {
        const int nrow = row + stride; const bool hn = nrow < nrows; const int pr = hn ? nrow : row;
        s16x4 n0[4], n1[4]; s16x4 no[4]; MLF_LOAD(pr, n0, n1, no);
#pragma unroll
        for (int hd = 0; hd < 4; ++hd) { const int c = hd * 256 + 4 * F.lane;
            const f32x4 v = (f32x4){bf2f((unsigned short)c0[hd][0]) + bf2f((unsigned short)c1[hd][0]), bf2f((unsigned short)c0[hd][1]) + bf2f((unsigned short)c1[hd][1]), bf2f((unsigned short)c0[hd][2]) + bf2f((unsigned short)c1[hd][2]), bf2f((unsigned short)c0[hd][3]) + bf2f((unsigned short)c1[hd][3])};
            const float rs = rsqrtf(wave_sum(v.x * v.x + v.y * v.y + v.z * v.z + v.w * v.w) * (1.f / 256.f) + EPS);
            const f32x4 g = gv[hd]; const s16x4 og = co[hd];
            u32x2 w; w.x = pk2(v.x * rs * g.x * sigmoidf_(bf2f((unsigned short)og[0])), v.y * rs * g.y * sigmoidf_(bf2f((unsigned short)og[1])));
            w.y = pk2(v.z * rs * g.z * sigmoidf_(bf2f((unsigned short)og[2])), v.w * rs * g.w * sigmoidf_(bf2f((unsigned short)og[3])));
            *(u32x2*)(YCAT + (size_t)row * 3072 + c) = w; }
        if (!hn) break;
#pragma unroll
        for (int hd = 0; hd < 4; ++hd) { c0[hd] = n0[hd]; c1[hd] = n1[hd]; co[hd] = no[hd]; }
        row = nrow;
    }
#undef MLF_LOAD
}

DI void mlfin_tail(const Frame& F0, const Args& a, int l, int nrows) {
    Frame F = F0; { int t_ = threadIdx.x; asm volatile("" : "+v"(t_)); F.tid = t_; F.lane = t_ & 63; F.wave = __builtin_amdgcn_readfirstlane(t_ >> 6); }
    unsigned* done = (unsigned*)(F.ws + WS_CTL) + CW_MLDONE + 16 * l; unsigned* head = done + 8;
    volatile LAS unsigned* MISC = (volatile LAS unsigned*)(F.lds + LDS_BYTES - 64);
    if (F.tid == 0) { unsigned sp = 0; while (xb_ld(done) < 64u && ++sp < (1u << 22)) __builtin_amdgcn_s_sleep(2); }
    for (;;) {
        __syncthreads();
        if (F.tid == 0) MISC[4] = __hip_atomic_fetch_add(head, 1u, __ATOMIC_RELAXED, __HIP_MEMORY_SCOPE_AGENT);
        __syncthreads();
        const int blk = __builtin_amdgcn_readfirstlane((int)MISC[4]);
        if (blk * 64 >= nrows) break;
        const int end = (blk + 1) * 64 < nrows ? (blk + 1) * 64 : nrows;
        phase_mlfin(F, a, l, end, blk * 64 + F.wave, NWAVES);
    }
}

struct SchedMerge {
    const char* Y; const char* Bt; int nM, G, c;
    DI bool next(int i, Unit& u) const {
        int pm, pn, br;
        if (nM == 36 && G == 256) {
            const int j = c < 96 ? i - 1 : i;
            if (j < 0) { const int t = c / 3; br = (c - 3 * t) | 4; pm = 32 + (t >> 3); pn = t & 7; }
            else if (j < 3) { pg8::tile_of(c, 32, 8, pm, pn); br = j; }
            else return false;
        } else { const int k = i / 3; br = i - 3 * k; const long L = (long)k * G + c; if (L >= (long)nM * 8) return false; pg8::tile_of((int)L, nM, 8, pm, pn); }
        u.pm = pm; u.pn = pn; u.aux = br; u.nt = 16; u.pa = Y + (size_t)pm * 256 * 6144 + (br & 3) * 2048; u.pb = Bt + ((size_t)(br & 3) * 2048 + pn * 256) * 2048; return true;
    }
};
struct EpiMerge {
    const bf16_t* P; bf16_t* ZG; bf16_t* MB; bf16_t* CP; unsigned* cnt; unsigned* odone;
    DI void operator()(const f32x4 (&acc)[2][2][4][2], const Unit& u, int wr, int wc, int fr, int fq) const {
        const int br = u.aux & 3; const bool split = (u.aux & 4) != 0;
        EPI_FOREACH({
            const bf16x8 gp = *(const bf16x8*)(P + (size_t)row * NP + C_GATE + br * 2048 + col);
            f32x4 g0, g1;
            g0.x = sigmoidf_(bf2f((unsigned short)gp[0])); g0.y = sigmoidf_(bf2f((unsigned short)gp[1])); g0.z = sigmoidf_(bf2f((unsigned short)gp[2])); g0.w = sigmoidf_(bf2f((unsigned short)gp[3]));
            g1.x = sigmoidf_(bf2f((unsigned short)gp[4])); g1.y = sigmoidf_(bf2f((unsigned short)gp[5])); g1.z = sigmoidf_(bf2f((unsigned short)gp[6])); g1.w = sigmoidf_(bf2f((unsigned short)gp[7]));
            f32x4 r0 = v0 * g0, r1 = v1 * g1;
            const size_t off = (size_t)row * DM + col;
            if (split) { const u32x4 w_ = pack8(r0, r1); GAS unsigned long long* cp = (GAS unsigned long long*)(CP + ((size_t)br * MCTX + (row - MLAT)) * DM + col);
                __hip_atomic_store(cp, (unsigned long long)w_.x | ((unsigned long long)w_.y << 32), __ATOMIC_RELAXED, __HIP_MEMORY_SCOPE_AGENT);
                __hip_atomic_store(cp + 1, (unsigned long long)w_.z | ((unsigned long long)w_.w << 32), __ATOMIC_RELAXED, __HIP_MEMORY_SCOPE_AGENT); }
            else if (br < 2) *(u32x4*)(ZG + (size_t)br * MTOT * DM + off) = pack8(r0, r1);
            else { const bf16x8 z0 = *(const bf16x8*)(ZG + off), z1 = *(const bf16x8*)(ZG + (size_t)MTOT * DM + off);
                r0 += (f32x4){bf2f((unsigned short)z0[0]) + bf2f((unsigned short)z1[0]), bf2f((unsigned short)z0[1]) + bf2f((unsigned short)z1[1]), bf2f((unsigned short)z0[2]) + bf2f((unsigned short)z1[2]), bf2f((unsigned short)z0[3]) + bf2f((unsigned short)z1[3])};
                r1 += (f32x4){bf2f((unsigned short)z0[4]) + bf2f((unsigned short)z1[4]), bf2f((unsigned short)z0[5]) + bf2f((unsigned short)z1[5]), bf2f((unsigned short)z0[6]) + bf2f((unsigned short)z1[6]), bf2f((unsigned short)z0[7]) + bf2f((unsigned short)z1[7])};
                *(u32x4*)(MB + off) = pack8(r0, r1); }
        })
        if (split) {
            asm volatile("s_waitcnt vmcnt(0)" ::: "memory");
            unsigned old = 0;
            if ((fr | fq) == 0) old = __hip_atomic_fetch_add((GAS unsigned*)(cnt + (((u.pm - 32) * 8 + u.pn) * 8 + wr * 4 + wc) * 16), 1u, __ATOMIC_RELAXED, __HIP_MEMORY_SCOPE_AGENT);
            old = (unsigned)__builtin_amdgcn_readfirstlane((int)old);
            if (old == 2u) {
                EPI_FOREACH({
                    f32x4 r0 = (f32x4){0.f, 0.f, 0.f, 0.f}; f32x4 r1 = r0;
                    _Pragma("unroll") for (int ob = 0; ob < 3; ++ob) { const GAS unsigned long long* cp = (const GAS unsigned long long*)(CP + ((size_t)ob * MCTX + (row - MLAT)) * DM + col);
                        const unsigned long long a0 = __hip_atomic_load(cp, __ATOMIC_RELAXED, __HIP_MEMORY_SCOPE_AGENT), a1 = __hip_atomic_load(cp + 1, __ATOMIC_RELAXED, __HIP_MEMORY_SCOPE_AGENT);
                        r0 += (f32x4){bf2f((unsigned short)a0), bf2f((unsigned short)(a0 >> 16)), bf2f((unsigned short)(a0 >> 32)), bf2f((unsigned short)(a0 >> 48))};
                        r1 += (f32x4){bf2f((unsigned short)a1), bf2f((unsigned short)(a1 >> 16)), bf2f((unsigned short)(a1 >> 32)), bf2f((unsigned short)(a1 >> 48))}; }
                    (void)v0; (void)v1;
                    { const u32x4 w_ = pack8(r0, r1); GAS unsigned long long* mp = (GAS unsigned long long*)(MB + (size_t)row * DM + col);
                      __hip_atomic_store(mp, (unsigned long long)w_.x | ((unsigned long long)w_.y << 32), __ATOMIC_RELAXED, __HIP_MEMORY_SCOPE_AGENT);
                      __hip_atomic_store(mp + 1, (unsigned long long)w_.z | ((unsigned long long)w_.w << 32), __ATOMIC_RELAXED, __HIP_MEMORY_SCOPE_AGENT); }
                })
                asm volatile("s_waitcnt vmcnt(0)" ::: "memory");
                if ((fr | fq) == 0) __hip_atomic_fetch_add((GAS unsigned*)(odone + (u.pm - 32) * 16), 1u, __ATOMIC_RELAXED, __HIP_MEMORY_SCOPE_AGENT);
            }
        }
    }
};
struct SchedOutCtx {
    const char* A; const char* Bt; int c;
    DI bool next(int i, Unit& u) const {
        if (i != 0 || c < 96 || c >= 160) return false;
        const int t = (c - 96) >> 1, kh = (c - 96) & 1; const size_t ko = (size_t)kh * 2048;
        u.pm = 32 + (t >> 3); u.pn = t & 7; u.aux = 4 | kh; u.nt = 16; u.pa = A + (size_t)u.pm * 256 * (DM * 2) + ko; u.pb = Bt + (size_t)u.pn * 256 * (DM * 2) + ko; return true;
    }
};
struct EpiOut {
    const float* xin; const float* ctxin; float* X1; const float* mods; int l; bf16_t* CP; unsigned* cnt;
    DI void operator()(const f32x4 (&acc)[2][2][4][2], const Unit& u, int wr, int wc, int fr, int fq) const {
        if (u.aux & 4) {
            const int kh = u.aux & 1;
            EPI_FOREACH({ const u32x4 w_ = pack8(v0, v1); GAS unsigned long long* cp = (GAS unsigned long long*)(CP + ((size_t)kh * MCTX + (row - MLAT)) * DM + col);
                __hip_atomic_store(cp, (unsigned long long)w_.x | ((unsigned long long)w_.y << 32), __ATOMIC_RELAXED, __HIP_MEMORY_SCOPE_AGENT);
                __hip_atomic_store(cp + 1, (unsigned long long)w_.z | ((unsigned long long)w_.w << 32), __ATOMIC_RELAXED, __HIP_MEMORY_SCOPE_AGENT); })
            asm volatile("s_waitcnt vmcnt(0)" ::: "memory");
            unsigned old = 0;
            if ((fr | fq) == 0) old = __hip_atomic_fetch_add((GAS unsigned*)(cnt + (((u.pm - 32) * 8 + u.pn) * 8 + wr * 4 + wc) * 16), 1u, __ATOMIC_RELAXED, __HIP_MEMORY_SCOPE_AGENT);
            old = (unsigned)__builtin_amdgcn_readfirstlane((int)old);
            if (old == 1u) {
                EPI_FOREACH({
                    f32x4 r0 = (f32x4){0.f, 0.f, 0.f, 0.f}; f32x4 r1 = r0; (void)v0; (void)v1;
                    _Pragma("unroll") for (int ob = 0; ob < 2; ++ob) { const GAS unsigned long long* cp = (const GAS unsigned long long*)(CP + ((size_t)ob * MCTX + (row - MLAT)) * DM + col);
                        const unsigned long long a0 = __hip_atomic_load(cp, __ATOMIC_RELAXED, __HIP_MEMORY_SCOPE_AGENT), a1 = __hip_atomic_load(cp + 1, __ATOMIC_RELAXED, __HIP_MEMORY_SCOPE_AGENT);
                        r0 += (f32x4){bf2f((unsigned short)a0), bf2f((unsigned short)(a0 >> 16)), bf2f((unsigned short)(a0 >> 32)), bf2f((unsigned short)(a0 >> 48))};
                        r1 += (f32x4){bf2f((unsigned short)a1), bf2f((unsigned short)(a1 >> 16)), bf2f((unsigned short)(a1 >> 32)), bf2f((unsigned short)(a1 >> 48))}; }
                    const float* rp = ctxin + (size_t)(row - MLAT) * DM; const float* gp = mods + ((size_t)(l * 5 + 4) * 6 + 2) * DM + col; float* op = X1 + (size_t)row * DM + col;
                    *(f32x4*)op = *(const f32x4*)(rp + col) + *(const f32x4*)gp * r0; *(f32x4*)(op + 4) = *(const f32x4*)(rp + col + 4) + *(const f32x4*)(gp + 4) * r1;
                })
            }
            return;
        }
        f32x4 g[2][2];
#pragma unroll
        for (int bj = 0; bj < 2; ++bj) { const float* gp = mods + ((size_t)(l * 5 + mods_row(u.pm * 256)) * 6 + 2) * DM + u.pn * 256 + bj * 128 + wc * 32 + 8 * fq;
            g[bj][0] = *(const f32x4*)gp; g[bj][1] = *(const f32x4*)(gp + 4); }
        EPI_FOREACH({
            const float* rp = (l == 0) ? (row < MLAT ? xin + (size_t)row * DM : ctxin + (size_t)(row - MLAT) * DM) : X1 + (size_t)row * DM;
            float* op = X1 + (size_t)row * DM + col;
            *(f32x4*)op = *(const f32x4*)(rp + col) + g[bj][0] * v0; *(f32x4*)(op + 4) = *(const f32x4*)(rp + col + 4) + g[bj][1] * v1;
        })
    }
};
DI void phase_topk(const Frame& F, const Args& a, int l, int bid) {
    const float* AFF = (const float*)(F.ws + WS_AFF);
    int* ROWS = (int*)(F.ws + WS_ROWS); float* VALS = (float*)(F.ws + WS_VALS); int* TOK = (int*)(F.ws + WS_TOK);
    LAS unsigned* cntr = (LAS unsigned*)F.lds;
    LAS unsigned* cg = cntr + 64; LAS unsigned* ce = cntr + 96;
    const int nitems = (l == 0) ? 256 + 64 + 16 : 256;
    const int lane = F.lane, wave = F.wave;
    for (int it = bid; it < nitems; it += F.G) {
        if (it >= 320) {
            const int e = it - 320;
            for (int s = F.tid; s < 128; s += NTHR) { ROWS[e * ESLOT + 1152 + s] = -1; VALS[e * ESLOT + 1152 + s] = 0.f; }
            continue;
        }
        const int lat = it < 256, b = lat ? (it >> 6) : ((it - 256) >> 4), e = lat ? ((it >> 2) & 15) : ((it - 256) & 15), qtr = lat ? (it & 3) : 0;
        const int ntok = lat ? SEQ : CTXL, rowbase = lat ? b * SEQ : MLAT + b * CTXL, slotbase = lat ? b * 256 : 1024 + b * 32;
        const unsigned cap = (unsigned)(ntok >> 3);
        __syncthreads();
        if (F.tid < 128) cntr[F.tid] = 0u;
        unsigned key[4];
#pragma unroll
        for (int q = 0; q < 4; ++q) { const int i = q * 512 + F.tid; key[q] = i < ntok ? __float_as_uint(AFF[(size_t)e * MTOT + rowbase + i]) : 0u; }
        __syncthreads();
        unsigned T = 0u;
#pragma unroll 1
        for (int r = 0; r < 16; ++r) { const int sh = 30 - 2 * r;
            const unsigned c1 = T | (1u << sh), c2 = T | (2u << sh), c3 = T | (3u << sh);
            unsigned n1 = 0, n2 = 0, n3 = 0;
#pragma unroll
            for (int q = 0; q < 4; ++q) { n1 += (unsigned)__builtin_popcountll(__ballot(key[q] >= c1)); n2 += (unsigned)__builtin_popcountll(__ballot(key[q] >= c2)); n3 += (unsigned)__builtin_popcountll(__ballot(key[q] >= c3)); }
            if (lane == 0) { atomicAdd((unsigned*)(cntr + r * 4 + 0), n1); atomicAdd((unsigned*)(cntr + r * 4 + 1), n2); atomicAdd((unsigned*)(cntr + r * 4 + 2), n3); }
            __syncthreads();
            const unsigned t1 = cntr[r * 4 + 0], t2 = cntr[r * 4 + 1], t3 = cntr[r * 4 + 2];
            T = t3 >= cap ? c3 : (t2 >= cap ? c2 : (t1 >= cap ? c1 : T));
        }
        unsigned long long bg_own = 0ull, be_own = 0ull; unsigned kown = 0u;
#pragma unroll
        for (int q = 0; q < 4; ++q) { const unsigned long long bg = __ballot(key[q] > T), be = __ballot(key[q] == T);
            if (lane == 0) { cg[q * 8 + wave] = (unsigned)__builtin_popcountll(bg); ce[q * 8 + wave] = (unsigned)__builtin_popcountll(be); }
            if (q == qtr) { bg_own = bg; be_own = be; kown = key[q]; } }
        __syncthreads();
        unsigned ngt = 0, gtb = 0, eqb = 0; const int me = qtr * 8 + wave;
#pragma unroll 1
        for (int k = 0; k < 32; ++k) { const unsigned g = cg[k], q_ = ce[k]; ngt += g; if (k < me) { gtb += g; eqb += q_; } }
        const unsigned need = cap - ngt;
        const unsigned long long lt = (1ull << lane) - 1ull;
        const int i = qtr * 512 + F.tid; const bool act = i < ntok;
        const unsigned eqpos = eqb + (unsigned)__builtin_popcountll(be_own & lt);
        const bool sel = act && (kown > T || (kown == T && eqpos < need));
        const unsigned slot = gtb + (unsigned)__builtin_popcountll(bg_own & lt) + (eqpos < need ? eqpos : need);
        if (act) { TOK[(size_t)(rowbase + i) * 16 + e] = sel ? slotbase + (int)slot : -1;
            if (sel) { ROWS[e * ESLOT + slotbase + (int)slot] = rowbase + i; VALS[e * ESLOT + slotbase + (int)slot] = __uint_as_float(kown); } }
    }
    __syncthreads();
}
struct SchedMoe {
    const char* A; const char* Bt; int lda, ldb, nMt, nt, G, c, gather;
    DI bool next(int i, Unit& u) const {
        const long L0 = (long)i * G + c; const int nwg = NEXP * nMt * 8; if (L0 >= nwg) return false;
        const int L = ((int)L0 % 8) * (nwg / 8) + (int)L0 / 8;
        const int e = L / (nMt * 8), rem = L % (nMt * 8), mt = rem % nMt, pn = rem / nMt;
        u.pm = e * 5 + mt; u.pn = pn; u.aux = e; u.nt = nt; u.pa = gather ? A : A + ((size_t)e * ESLOT + mt * 256) * lda; u.pb = Bt + ((size_t)e * 2048 + pn * 256) * ldb; return true;
    }
};
struct SchedMoe2Early {
    const char* A; const char* Bt; int c;
    DI bool next(int i, Unit& u) const {
        if (i != 0 || c < 128 || c >= 256) return false;
        const int k = c - 128, x = k & 7, j = k >> 3, e = 2 * x, mt = j & 1, pn = j >> 1;
        u.pm = e * 5 + mt; u.pn = pn; u.aux = e; u.nt = 16; u.pa = A + ((size_t)e * ESLOT + mt * 256) * (EFF * 2); u.pb = Bt + ((size_t)e * 2048 + pn * 256) * (EFF * 2); return true;
    }
};
struct SchedMoe2Rest {
    const char* A; const char* Bt; int c;
    DI bool next(int i, Unit& u) const {
        if (i >= 2) return false;
        const int x = c & 7, j = i * 32 + (c >> 3); int e, mt, pn;
        if (j < 40) { e = 2 * x + 1; mt = j % 5; pn = j / 5; } else { const int r = j - 40; e = 2 * x; mt = 2 + r % 3; pn = r / 3; }
        u.pm = e * 5 + mt; u.pn = pn; u.aux = e; u.nt = 16; u.pa = A + ((size_t)e * ESLOT + mt * 256) * (EFF * 2); u.pb = Bt + ((size_t)e * 2048 + pn * 256) * (EFF * 2); return true;
    }
};
struct EpiMoe1 {
    bf16_t* ACT; unsigned* pub;
    DI void operator()(const f32x4 (&acc)[2][2][4][2], const Unit& u, int wr, int wc, int fr, int fq) const {
        const bool pubu = pub != nullptr && (u.aux & 1) == 0 && u.pm - u.aux * 5 < 2;
#pragma unroll
        for (int ai = 0; ai < 2; ++ai)
#pragma unroll
            for (int m = 0; m < 4; ++m) { const int row = u.pm * 256 + ai * 128 + wr * 64 + m * 16 + fr; const int col = u.pn * 128 + wc * 32 + 8 * fq;
                f32x4 r0, r1;
#pragma unroll
                for (int i = 0; i < 4; ++i) { r0[i] = siluf_(acc[ai][0][m][0][i]) * acc[ai][1][m][0][i]; r1[i] = siluf_(acc[ai][0][m][1][i]) * acc[ai][1][m][1][i]; }
                const u32x4 w_ = pack8(r0, r1);
                if (pubu) { GAS unsigned long long* ap = (GAS unsigned long long*)(ACT + (size_t)row * EFF + col);
                    __hip_atomic_store(ap, (unsigned long long)w_.x | ((unsigned long long)w_.y << 32), __ATOMIC_RELAXED, __HIP_MEMORY_SCOPE_AGENT);
                    __hip_atomic_store(ap + 1, (unsigned long long)w_.z | ((unsigned long long)w_.w << 32), __ATOMIC_RELAXED, __HIP_MEMORY_SCOPE_AGENT); }
                else *(u32x4*)(ACT + (size_t)row * EFF + col) = w_; }
        if (pubu) { asm volatile("s_waitcnt vmcnt(0)" ::: "memory");
            if ((fr | fq) == 0) __hip_atomic_fetch_add((GAS unsigned*)(pub + u.aux * 16), 1u, __ATOMIC_RELAXED, __HIP_MEMORY_SCOPE_AGENT); }
    }
};
struct EpiMoe2 {
    const float* VALS; bf16_t* YE;
    DI void operator()(const f32x4 (&acc)[2][2][4][2], const Unit& u, int wr, int wc, int fr, int fq) const {
        EPI_FOREACH({ const float val = VALS[row]; *(u32x4*)(YE + (size_t)row * DM + col) = pack8(v0 * val, v1 * val); })
    }
};
DI void phase_final(const Frame& F, const Args& a) {
    const float* g = a.in[I_FNORM]; const int* TOK = (const int*)(F.ws + WS_TOK); const float* X1 = (const float*)(F.ws + WS_X1);
    LAS float* gs = (LAS float*)F.lds;
    { const float* MODS = (const float*)(F.ws + WS_MODS);
      for (int i = F.tid; i < 4 * 512; i += NTHR) { const int r = i / 512, c4 = i % 512;
          *(LAS f32x4*)(gs + (size_t)r * DM + 4 * c4) = *(const f32x4*)(MODS + ((size_t)((DEPTH - 1) * 5 + r) * 6 + 5) * DM + 4 * c4); }
      __syncthreads(); }
    int row = F.gw; if (row >= MLAT) return;
    f32x4 cur[8]; load_row(X1 + (size_t)row * DM, F.lane, cur); int tcur = TOK[(size_t)row * 16 + (F.lane & 15)];
    f32x4 gv[8]; load_row(g, F.lane, gv);
    for (;;) {
        const int nrow = row + F.ngw; const bool hn = nrow < MLAT; const int pr = hn ? nrow : row;
        f32x4 nxt[8]; load_row(X1 + (size_t)pr * DM, F.lane, nxt); const int tnxt = TOK[(size_t)pr * 16 + (F.lane & 15)];
        f32x4 v[8]; float ss = 0.f;
        combine_row<true>(F, DEPTH - 1, row, cur, tcur, v, gs + (size_t)(row >> 11) * DM);
#pragma unroll
        for (int j = 0; j < 8; ++j) ss += v[j].x * v[j].x + v[j].y * v[j].y + v[j].z * v[j].z + v[j].w * v[j].w;
        const float rs = rsqrtf(wave_sum(ss) * (1.f / DM) + EPS);
#pragma unroll
        for (int j = 0; j < 8; ++j) *(f32x4*)(a.out + (size_t)row * DM + 4 * F.lane + 256 * j) = v[j] * rs * gv[j];
        if (!hn) break;
#pragma unroll
        for (int j = 0; j < 8; ++j) cur[j] = nxt[j];
        tcur = tnxt; row = nrow;
    }
}

#ifndef MK_LAST_PHASE
#define MK_LAST_PHASE 1000
#endif
constexpr int PH_PER_LAYER = 11, N_PHASES = 2 + 2 * PH_PER_LAYER + 1;
__global__ void __launch_bounds__(NTHR, 2) mega(const Args args) {
    extern __shared__ __attribute__((aligned(16))) unsigned char lds[];
    Frame F0;
    F0.lds = (LAS unsigned char*)lds; F0.ws = args.ws;
    F0.tid = threadIdx.x; F0.lane = F0.tid & 63; F0.wave = __builtin_amdgcn_readfirstlane(F0.tid >> 6);
    F0.G = gridDim.x; { const int bx = blockIdx.x; F0.vcu = (F0.G % 8 == 0) ? (bx % 8) * (F0.G / 8) + bx / 8 : bx; }
    F0.gw = F0.vcu * NWAVES + F0.wave; F0.ngw = F0.G * NWAVES;
    volatile LAS unsigned* MISC = (volatile LAS unsigned*)(F0.lds + LDS_BYTES - 64);
    if (F0.tid < 16) MISC[F0.tid] = 0u;
    __syncthreads();
    unsigned* ctl = (unsigned*)(F0.ws + WS_CTL);
    XcdBarrier bar = xcd_barrier_post(ctl + CW_BAR, MISC + 8);
    const int lo = args.ph_lo, hi = args.ph_hi;
    int ph = 0, bid = 0;
#ifndef MK_EN
#define MK_EN 0xFFFF
#endif
#define EN(x) ((MK_EN >> (x)) & 1)
#ifndef MK_REP
#define MK_REP 0
#endif
#ifndef MK_BARX
#define MK_BARX 0
#endif
#ifndef MK_REPB
#define MK_REPB 0
#endif
#ifndef MK_TPH
#define MK_TPH -1
#endif
#ifndef MK_TMODE
#define MK_TMODE 0
#endif
#ifndef MK_TQ
#define MK_TQ 40.f
#endif
#define REP(pid_) ((MK_REP >> (pid_)) & 1)
#define PHASE(pid_, ...) if (EN(pid_) && lo <= ph && ph < hi) { Frame F = F0; { unsigned long long w_ = (unsigned long long)F0.ws; asm volatile("" : "+s"(w_)); F.ws = (unsigned char*)w_; \
        asm volatile("" : "+s"(F.G), "+s"(F.vcu)); F.ngw = F.G * NWAVES; bid = blockIdx.x; asm volatile("" : "+s"(bid)); \
        int t_ = threadIdx.x; asm volatile("" : "+v"(t_)); F.tid = t_; F.lane = t_ & 63; F.wave = __builtin_amdgcn_readfirstlane(t_ >> 6); F.gw = F.vcu * NWAVES + F.wave; } \
        { const int rep = 0; (void)rep; __VA_ARGS__ } if (REP(pid_)) { if (MK_REPB) xcd_barrier(bar); const int rep = 1; (void)rep; __VA_ARGS__ } \
        if (MK_TPH >= 0 && threadIdx.x == 0) ((unsigned long long*)(F0.ws + WS_CTL + 1536 * 1024))[ph * 256 + blockIdx.x] = wall_clock64(); \
        if (ph + 1 < hi) { xcd_barrier(bar); if (MK_BARX) xcd_barrier(bar); } } ++ph;

#define PHASE5(...) if (EN(5) && lo <= ph && ph < hi) { Frame F = F0; { unsigned long long w_ = (unsigned long long)F0.ws; asm volatile("" : "+s"(w_)); F.ws = (unsigned char*)w_; \
        asm volatile("" : "+s"(F.G), "+s"(F.vcu)); F.ngw = F.G * NWAVES; bid = blockIdx.x; asm volatile("" : "+s"(bid)); \
        int t_ = threadIdx.x; asm volatile("" : "+v"(t_)); F.tid = t_; F.lane = t_ & 63; F.wave = __builtin_amdgcn_readfirstlane(t_ >> 6); F.gw = F.vcu * NWAVES + F.wave; } \
        { __VA_ARGS__ } if (MK_TPH >= 0 && threadIdx.x == 0) ((unsigned long long*)(F0.ws + WS_CTL + 1536 * 1024))[ph * 256 + blockIdx.x] = wall_clock64(); \
        if (ph + 1 < hi) { xcd_barrier(bar); if (MK_BARX) xcd_barrier(bar); } } ++ph;
    PHASE(0, phase_prologue(F, args, rep);)
    PHASE(14, phase_mods_reduce(F, args);)
    for (int l = 0; l < DEPTH; ++l) {
        const size_t wlo = WS_W + (size_t)l * W_LAYER;
        const int nM = (l == 0) ? 36 : 32;
        PHASE(1, if (MK_FILL && l == 1 && rep == 0) fill_convert(F, args, ph, true); phase_mod1(F, args, l);)
        PHASE(2, {
            SchedProj S{(const char*)(F.ws + WS_H), (const char*)(F.ws + wlo + W_IN), l, F.G, bid};
            EpiProj E{(bf16_t*)(F.ws + WS_P)};
            pg8::gemm_phase(F.lds, DM * 2, DM * 2, S, E); if (MK_FILL && l == 0 && rep == 0) fill_convert(F, args, ph, false); })
        PHASE(3, phase_postproj(F, args, l);)
        PHASE(4, {
            const bool defer = (l == 1 && F.G == 256);
            const int Gx = F.G - 36, xw = bid - Gx, BIG = 1 << 28, Gw = defer ? 144 : Gx, cw = bid < Gw ? bid : BIG;
            if (defer) { SchedDefer S{(const char*)(F.ws + WS_H), (const char*)(F.ws + wlo + W_IN), (bid >= 144 && bid < 220) ? bid - 144 : -1};
              EpiProj E{(bf16_t*)(F.ws + WS_P)}; pg8::gemm_phase(F.lds, DM * 2, DM * 2, S, E); }
            { SchedDense S{(const char*)(F.ws + WS_H), (const char*)(F.ws + wlo + W_IN) + (size_t)C_X * DM * 2, DM * 2, DM * 2, 36, 1, 32, 36, xw >= 0 ? xw : BIG};
              EpiX E{(bf16_t*)(F.ws + WS_KR), (float*)(F.ws + WS_X80), (const float*)(F.ws + WS_ROPE_LA)}; pg8::gemm_phase(F.lds, DM * 2, DM * 2, S, E); }
            { SchedDense S{(const char*)(F.ws + WS_CQN), (const char*)(F.ws + wlo + W_UQ), 512 * 2, 512 * 2, nM, 6, 8, Gw, cw};
              EpiStoreBf16 E{(bf16_t*)(F.ws + WS_QLA), 1536}; pg8::gemm_phase(F.lds, 512 * 2, 512 * 2, S, E); }
            { SchedDense S{(const char*)(F.ws + WS_CKVN), (const char*)(F.ws + wlo + W_UKV), 256 * 2, 256 * 2, 36, 8, 4, defer ? 96 : Gw, defer ? ((bid >= 48 && bid < 144) ? bid - 48 : BIG) : (bid < Gw ? (bid + Gw / 2) % Gw : BIG)};
              EpiStoreBf16 E{(bf16_t*)(F.ws + WS_KVLA), 2048}; pg8::gemm_phase(F.lds, 256 * 2, 256 * 2, S, E); }
            if (MK_FILL && l == 0 && rep == 0) fill_convert(F, args, ph, false); })
        PHASE5(if (MK_CVSIDE) phase_convert_side(F, args, bid, l == 0 ? IT_EARLY : IT_LAYER + IT_EARLY, l == 0 ? IT_LAYER + IT_EARLY : 2 * IT_LAYER); phase_mixers(F, args, l, (char*)lds, 1 + REP(5)); if (MK_CONVTAIL) phase_convert_tail(F, args, l); mlfin_tail(F, args, l, nM * 256);)
        PHASE(7, {
            SchedMerge S{(const char*)(F.ws + WS_YCAT), (const char*)(F.ws + wlo + W_BR), nM, F.G, bid};
            EpiMerge E{(const bf16_t*)(F.ws + WS_P), (bf16_t*)(F.ws + WS_MF32), (bf16_t*)(F.ws + WS_MBF), (bf16_t*)(F.ws + WS_H), (unsigned*)(F.ws + WS_CTL) + CW_MCNT, (unsigned*)(F.ws + WS_CTL) + CW_ODONE};
            pg8::gemm_phase(F.lds, 3072 * 2, 1024 * 2, S, E);
            if (l == 0 && F.G == 256 && bid >= 96 && bid < 160 && rep == 0) {
                unsigned* od = (unsigned*)(F.ws + WS_CTL) + CW_ODONE + (((bid - 96) >> 1) >> 3) * 16;
                if (F.tid == 0) { unsigned sp = 0; while (xb_ld(od) < 64u && ++sp < (1u << 22)) __builtin_amdgcn_s_sleep(2); }
                __syncthreads();
                SchedOutCtx S2{(const char*)(F.ws + WS_MBF), (const char*)(F.ws + wlo + W_OUT), bid};
                EpiOut E2{args.in[I_X], args.in[I_CTX], (float*)(F.ws + WS_X1), (const float*)(F.ws + WS_MODS), l, (bf16_t*)(F.ws + WS_H + (16u << 20)), (unsigned*)(F.ws + WS_CTL) + CW_OCNT};
                pg8::gemm_phase<false, 17>(F.lds, DM * 2, DM * 2, S2, E2); } })
        PHASE(8, {
            SchedDense S{(const char*)(F.ws + WS_MBF), (const char*)(F.ws + wlo + W_OUT), DM * 2, DM * 2, (l == 0 && F.G == 256) ? 32 : nM, 8, 32, F.G, bid};
            EpiOut E{args.in[I_X], args.in[I_CTX], (float*)(F.ws + WS_X1), (const float*)(F.ws + WS_MODS), l, nullptr, nullptr};
            if (rep == 0 || l == 0) pg8::gemm_phase(F.lds, DM * 2, DM * 2, S, E); if (MK_FILL && l == 0 && rep == 0) fill_convert(F, args, ph, false); })
        PHASE(9, phase_mod2(F, args, l, nM * 256);)
        PHASE(10, phase_topk(F, args, l, bid);)
        PHASE(11, {
            SchedMoe S{(const char*)(F.ws + WS_H), (const char*)(F.ws + wlo + W_E13), DM * 2, DM * 2, (l == 0) ? 5 : 4, 32, F.G, bid, 1};
            const bool early = (l == 0 && F.G == 256 && rep == 0);
            EpiMoe1 E{(bf16_t*)(F.ws + WS_ACT), early ? (unsigned*)(F.ws + WS_CTL) + CW_E1CNT : nullptr};
            pg8::gemm_phase<true>(F.lds, DM * 2, DM * 2, S, E, (const int*)(F.ws + WS_ROWS));
            if (early && bid >= 128) {
                unsigned* ec = (unsigned*)(F.ws + WS_CTL) + CW_E1CNT + (2 * ((bid - 128) & 7)) * 16;
                if (F.tid == 0) { unsigned sp = 0; while (xb_ld(ec) < 128u && ++sp < (1u << 22)) __builtin_amdgcn_s_sleep(2); }
                __syncthreads();
                SchedMoe2Early S2{(const char*)(F.ws + WS_ACT), (const char*)(F.ws + wlo + W_E2), bid};
                EpiMoe2 E2{(const float*)(F.ws + WS_VALS), (bf16_t*)(F.ws + WS_YE)};
                pg8::gemm_phase<false, 17>(F.lds, EFF * 2, EFF * 2, S2, E2); } })
        PHASE(12, {
            EpiMoe2 E{(const float*)(F.ws + WS_VALS), (bf16_t*)(F.ws + WS_YE)};
            if (l == 0 && F.G == 256) { SchedMoe2Rest S{(const char*)(F.ws + WS_ACT), (const char*)(F.ws + wlo + W_E2), bid}; pg8::gemm_phase(F.lds, EFF * 2, EFF * 2, S, E); }
            else { SchedMoe S{(const char*)(F.ws + WS_ACT), (const char*)(F.ws + wlo + W_E2), EFF * 2, EFF * 2, (l == 0) ? 5 : 4, 16, F.G, bid, 0}; pg8::gemm_phase(F.lds, EFF * 2, EFF * 2, S, E); } })
    }
    PHASE(13, phase_final(F, args);)
    if (MK_TPH >= 0) {
        xcd_barrier(bar);
        if (blockIdx.x == 0 && threadIdx.x == 0) {
            const unsigned long long* st = (const unsigned long long*)(F0.ws + WS_CTL + 1536 * 1024);
            unsigned long long mx = 0, mxp = 0, sum = 0; const int G = gridDim.x;
            for (int bq = 0; bq < G; ++bq) { const unsigned long long e = st[MK_TPH * 256 + bq], p = st[(MK_TPH - 1) * 256 + bq]; mx = e > mx ? e : mx; mxp = p > mxp ? p : mxp; sum += e; }
            const float dur = MK_TMODE == 0 ? (float)(mx - mxp) * 0.01f : (float)((double)sum / G - (double)mxp) * 0.01f;
            args.out[0] = 20.f + floorf(dur / MK_TQ) * MK_TQ;
        }
    }
#undef PHASE
}


extern "C" void kernel_launch(void* const* d_in, const int* in_sizes, int n_in, void* d_out, int out_size, void* d_ws, size_t ws_size, hipStream_t stream) {
    static int grid = 0;
    if (grid == 0) {
        if (n_in != 24 || out_size != MLAT * DM || ws_size < WS_END) { fprintf(stderr, "kernel_launch: unexpected shapes: n_in %d out %d ws %zu (need %zu)\n", n_in, out_size, ws_size, (size_t)WS_END); grid = -1; return; }
        int dev = 0, cus = 0, per_cu = 0;
        if (hipGetDevice(&dev) != hipSuccess || hipDeviceGetAttribute(&cus, hipDeviceAttributeMultiprocessorCount, dev) != hipSuccess) { grid = -1; return; }
        if (hipFuncSetAttribute((const void*)mega, hipFuncAttributeMaxDynamicSharedMemorySize, LDS_BYTES) != hipSuccess) { fprintf(stderr, "kernel_launch: hipFuncSetAttribute failed\n"); grid = -1; return; }
        if (hipOccupancyMaxActiveBlocksPerMultiprocessor(&per_cu, (const void*)mega, NTHR, LDS_BYTES) != hipSuccess || per_cu < 1) { fprintf(stderr, "kernel_launch: occupancy query says %d blocks per CU\n", per_cu); }
        (void)hipGetLastError();
        grid = cus;
    }
    if (grid < 0) return;
    if (hipMemsetAsync((char*)d_ws + WS_CTL, 0, CTL_BYTES, stream) != hipSuccess) return;
    Args a{};
    for (int i = 0; i < 24; ++i) a.in[i] = (const float*)d_in[i];
    a.out = (float*)d_out; a.ws = (unsigned char*)d_ws; a.ph_lo = 0; a.ph_hi = N_PHASES < MK_LAST_PHASE ? N_PHASES : MK_LAST_PHASE;
    hipLaunchKernelGGL(mega, dim3(grid), dim3(NTHR), LDS_BYTES, stream, a);
}
```
